# Optimizing an MI355X kernel written in HIP

```python
import math
import jax, jax.numpy as jnp
from jax import lax
import numpy as np

D_MODEL = 4096
BATCH = 2
SEQ = 4096
DEPTH = 2

N_A_LAYERS = DEPTH // 2
N_B_LAYERS = DEPTH - N_A_LAYERS
EPS = 1e-6

GDN_HEAD_DIM = 128
GDN_HEADS = D_MODEL // GDN_HEAD_DIM
GDN_WIDTH = GDN_HEADS * GDN_HEAD_DIM
GDN_IN_COLS = 4 * GDN_WIDTH + 2 * GDN_HEADS
CONV_WIDTH = 4
CHUNK = 64

DIFF_HEAD_DIM = 128
DIFF_HEADS = D_MODEL // (2 * DIFF_HEAD_DIM)
DIFF_V_DIM = 2 * DIFF_HEAD_DIM
DIFF_QK_WIDTH = DIFF_HEADS * 2 * DIFF_HEAD_DIM
DIFF_V_WIDTH = DIFF_HEADS * DIFF_V_DIM
Q_BLOCK = 128

PEER_HEADS = 8
PEER_KEYS = 128
PEER_EXPERTS = PEER_KEYS * PEER_KEYS
PEER_HALF = 128
PEER_QUERY_DIM = 2 * PEER_HALF
PEER_TOPK = 16
PEER_TOKEN_BLOCK = 64

kernel_name = "yoco_gdn_diffattn_peer"


def rms_norm(x, gain):
    xf = x.astype(jnp.float32)
    y = xf * lax.rsqrt(jnp.mean(xf * xf, axis=-1, keepdims=True) + EPS)
    return (y * gain.astype(jnp.float32)).astype(x.dtype)


def l2_norm(x):
    xf = x.astype(jnp.float32)
    return xf * lax.rsqrt(jnp.sum(xf * xf, axis=-1, keepdims=True) + EPS)


def causal_depthwise_conv(x, w):
    s = x.shape[1]
    xp = jnp.pad(x, ((0, 0), (CONV_WIDTH - 1, 0), (0, 0)))
    return sum(xp[:, j:j + s] * w[j] for j in range(CONV_WIDTH))


def gated_delta_rule(q, k, v, g, beta):
    b, s, h, dk = q.shape
    dv = v.shape[-1]
    n = s // CHUNK

    def to_chunks(t):
        t = t.reshape(b, n, CHUNK, h, *t.shape[3:])
        return jnp.moveaxis(t, (1, 3), (0, 2))

    q = to_chunks(q) * (dk ** -0.5)
    k, v = to_chunks(k), to_chunks(v)
    g_cum = jnp.cumsum(to_chunks(g), axis=-1)
    beta = to_chunks(beta)
    incl = jnp.tril(jnp.ones((CHUNK, CHUNK), dtype=bool))
    strict = jnp.tril(jnp.ones((CHUNK, CHUNK), dtype=bool), -1)
    decay = jnp.exp(jnp.where(incl, g_cum[..., :, None] - g_cum[..., None, :], -jnp.inf))
    k_beta = k * beta[..., None]
    a_mat = jnp.where(strict, jnp.einsum('nbhcd,nbhed->nbhce', k_beta, k) * decay, 0.0)
    eye = jnp.eye(CHUNK, dtype=jnp.float32)
    t_mat = lax.linalg.triangular_solve(eye + a_mat, jnp.broadcast_to(eye, a_mat.shape),
                                        left_side=True, lower=True)
    u = jnp.einsum('nbhce,nbhef->nbhcf', t_mat, v * beta[..., None])
    w = jnp.einsum('nbhce,nbhed->nbhcd', t_mat, k_beta * jnp.exp(g_cum)[..., None])
    qk = jnp.where(incl, jnp.einsum('nbhcd,nbhed->nbhce', q, k) * decay, 0.0)

    def step(state, xs):
        q_c, k_c, u_c, w_c, g_c, qk_c = xs
        v_new = u_c - jnp.einsum('bhcd,bhde->bhce', w_c, state)
        o = (jnp.einsum('bhcd,bhde->bhce', q_c * jnp.exp(g_c)[..., None], state)
             + jnp.einsum('bhce,bhef->bhcf', qk_c, v_new))
        g_last = g_c[..., -1]
        k_dec = k_c * jnp.exp(g_last[..., None] - g_c)[..., None]
        state = state * jnp.exp(g_last)[..., None, None] + jnp.einsum('bhcd,bhce->bhde', k_dec, v_new)
        return state, o

    state0 = jnp.zeros((b, h, dk, dv), jnp.float32)
    _, o = lax.scan(step, state0, (q, k, u, w, g_cum, qk))
    return jnp.moveaxis(o, (0, 2), (1, 3)).reshape(b, s, h, dv)


def gated_deltanet_mixer(h, w_in, conv_w, a_log, dt_bias, o_gain, w_out):
    b, s, _ = h.shape
    proj = h @ w_in
    qkv = proj[..., :3 * GDN_WIDTH]
    z = proj[..., 3 * GDN_WIDTH:4 * GDN_WIDTH]
    beta_raw = proj[..., 4 * GDN_WIDTH:4 * GDN_WIDTH + GDN_HEADS]
    a_raw = proj[..., 4 * GDN_WIDTH + GDN_HEADS:]
    qkv = jax.nn.silu(causal_depthwise_conv(qkv, conv_w))
    q, k, v = jnp.split(qkv, 3, axis=-1)
    shp = (b, s, GDN_HEADS, GDN_HEAD_DIM)
    q, k = l2_norm(q.reshape(shp)), l2_norm(k.reshape(shp))
    v = v.reshape(shp).astype(jnp.float32)
    beta = jax.nn.sigmoid(beta_raw.astype(jnp.float32))
    g = -jnp.exp(a_log.astype(jnp.float32)) * jax.nn.softplus(
        a_raw.astype(jnp.float32) + dt_bias.astype(jnp.float32))
    o = gated_delta_rule(q, k, v, g, beta)
    o = rms_norm(o, o_gain) * jax.nn.silu(z.reshape(shp).astype(jnp.float32))
    return o.reshape(b, s, GDN_WIDTH).astype(h.dtype) @ w_out


def shared_kv(h_stream, kv_gain, w_kv, k_gain):
    b, s, _ = h_stream.shape
    kv = rms_norm(h_stream, kv_gain) @ w_kv
    k = rms_norm(kv[..., :DIFF_QK_WIDTH].reshape(b, s, DIFF_HEADS, 2, DIFF_HEAD_DIM), k_gain)
    v = kv[..., DIFF_QK_WIDTH:].reshape(b, s, DIFF_HEADS, DIFF_V_DIM)
    return k.astype(jnp.float32), v.astype(jnp.float32)


def diff_attention_mixer(h, k, v, w_q, q_gain, lam_q1, lam_k1, lam_q2, lam_k2, sub_gain, w_o, lambda_init):
    b, s, _ = h.shape
    q = rms_norm((h @ w_q).reshape(b, s, DIFF_HEADS, 2, DIFF_HEAD_DIM), q_gain).astype(jnp.float32)
    lam = (jnp.exp(jnp.sum(lam_q1.astype(jnp.float32) * lam_k1.astype(jnp.float32)))
           - jnp.exp(jnp.sum(lam_q2.astype(jnp.float32) * lam_k2.astype(jnp.float32))) + lambda_init)
    scale = DIFF_HEAD_DIM ** -0.5
    nb = s // Q_BLOCK
    qb = q.reshape(b, nb, Q_BLOCK, DIFF_HEADS, 2, DIFF_HEAD_DIM).swapaxes(0, 1)
    key_pos = jnp.arange(s)

    def block(args):
        q_blk, i = args
        scores = jnp.einsum('bqhcd,bkhcd->bhcqk', q_blk, k) * scale
        q_pos = i * Q_BLOCK + jnp.arange(Q_BLOCK)
        mask = key_pos[None, :] <= q_pos[:, None]
        p = jax.nn.softmax(jnp.where(mask, scores, -jnp.inf), axis=-1)
        attn = p[:, :, 0] - lam * p[:, :, 1]
        return jnp.einsum('bhqk,bkhe->bqhe', attn, v)

    o = lax.map(block, (qb, jnp.arange(nb)))
    o = o.swapaxes(0, 1).reshape(b, s, DIFF_HEADS, DIFF_V_DIM)
    o = rms_norm(o, sub_gain) * (1.0 - lambda_init)
    return o.reshape(b, s, DIFF_V_WIDTH).astype(h.dtype) @ w_o


def peer_channel_mixer(h, w_query, sub_keys1, sub_keys2, expert_u, expert_v):
    b, s, dm = h.shape
    t = b * s
    x = h.reshape(t, dm)
    qry = (x @ w_query).reshape(t, PEER_HEADS, 2, PEER_HALF).astype(jnp.float32)
    s1 = jnp.einsum('thd,hnd->thn', qry[:, :, 0], sub_keys1.astype(jnp.float32))
    s2 = jnp.einsum('thd,hnd->thn', qry[:, :, 1], sub_keys2.astype(jnp.float32))
    v1, i1 = lax.top_k(s1, PEER_TOPK)
    v2, i2 = lax.top_k(s2, PEER_TOPK)
    cand = (v1[..., :, None] + v2[..., None, :]).reshape(t, PEER_HEADS, PEER_TOPK * PEER_TOPK)
    cand_idx = (i1[..., :, None] * PEER_KEYS + i2[..., None, :]).reshape(t, PEER_HEADS, PEER_TOPK * PEER_TOPK)
    top_s, pos = lax.top_k(cand, PEER_TOPK)
    experts = jnp.take_along_axis(cand_idx, pos, axis=-1)
    gates = jax.nn.softmax(top_s, axis=-1)
    nblk = t // PEER_TOKEN_BLOCK
    hk = PEER_HEADS * PEER_TOPK

    def block(args):
        x_b, e_b, g_b = args
        act = jax.nn.gelu(jnp.einsum('td,tkd->tk', x_b, expert_u[e_b]).astype(jnp.float32),
                          approximate=False)
        return jnp.einsum('tk,tkd->td', (g_b * act).astype(x_b.dtype), expert_v[e_b])

    y = lax.map(block, (x.reshape(nblk, PEER_TOKEN_BLOCK, dm),
                        experts.reshape(nblk, PEER_TOKEN_BLOCK, hk),
                        gates.reshape(nblk, PEER_TOKEN_BLOCK, hk)))
    return y.reshape(b, s, dm)


def setup_inputs(seed: int = 0) -> dict:
    key = jax.random.key(seed)
    ks = jax.random.split(key, 32)
    f32 = jnp.float32

    def nrm(k, shape, scale):
        return jax.random.normal(k, shape, f32) * scale

    def gain(k, shape):
        return 1.0 + 0.01 * jax.random.normal(k, shape, f32)

    dsc = D_MODEL ** -0.5
    dt = jnp.exp(jax.random.uniform(ks[5], (N_A_LAYERS, GDN_HEADS), f32,
                                    minval=math.log(1e-3), maxval=math.log(1e-1)))
    return {
        "x": nrm(ks[0], (BATCH, SEQ, D_MODEL), 1.0),
        "a_norm": gain(ks[1], (N_A_LAYERS, D_MODEL)),
        "a_w_in": nrm(ks[2], (N_A_LAYERS, D_MODEL, GDN_IN_COLS), dsc),
        "a_conv": nrm(ks[3], (N_A_LAYERS, CONV_WIDTH, 3 * GDN_WIDTH), CONV_WIDTH ** -0.5),
        "a_log": jnp.log(jax.random.uniform(ks[4], (N_A_LAYERS, GDN_HEADS), f32, minval=1.0, maxval=16.0)),
        "a_dt_bias": dt + jnp.log(-jnp.expm1(-dt)),
        "a_out_norm": gain(ks[6], (N_A_LAYERS, GDN_HEAD_DIM)),
        "a_w_out": nrm(ks[7], (N_A_LAYERS, GDN_WIDTH, D_MODEL), GDN_WIDTH ** -0.5),
        "kv_norm": gain(ks[8], (D_MODEL,)),
        "kv_w": nrm(ks[9], (D_MODEL, DIFF_QK_WIDTH + DIFF_V_WIDTH), dsc),
        "kv_k_norm": gain(ks[10], (DIFF_HEAD_DIM,)),
        "b_norm": gain(ks[11], (N_B_LAYERS, D_MODEL)),
        "b_w_q": nrm(ks[12], (N_B_LAYERS, D_MODEL, DIFF_QK_WIDTH), dsc),
        "b_q_norm": gain(ks[13], (N_B_LAYERS, DIFF_HEAD_DIM)),
        "b_lam_q1": nrm(ks[14], (N_B_LAYERS, DIFF_HEAD_DIM), 0.1),
        "b_lam_k1": nrm(ks[15], (N_B_LAYERS, DIFF_HEAD_DIM), 0.1),
        "b_lam_q2": nrm(ks[16], (N_B_LAYERS, DIFF_HEAD_DIM), 0.1),
        "b_lam_k2": nrm(ks[17], (N_B_LAYERS, DIFF_HEAD_DIM), 0.1),
        "b_sub_norm": gain(ks[18], (N_B_LAYERS, DIFF_V_DIM)),
        "b_w_o": nrm(ks[19], (N_B_LAYERS, DIFF_V_WIDTH, D_MODEL), DIFF_V_WIDTH ** -0.5),
        "f_norm": gain(ks[20], (DEPTH, D_MODEL)),
        "f_w_query": nrm(ks[21], (DEPTH, D_MODEL, PEER_HEADS * PEER_QUERY_DIM), dsc),
        "f_sub_keys1": nrm(ks[22], (DEPTH, PEER_HEADS, PEER_KEYS, PEER_HALF), PEER_HALF ** -0.5),
        "f_sub_keys2": nrm(ks[23], (DEPTH, PEER_HEADS, PEER_KEYS, PEER_HALF), PEER_HALF ** -0.5),
        "f_expert_u": nrm(ks[24], (DEPTH, PEER_EXPERTS, D_MODEL), dsc),
        "f_expert_v": nrm(ks[25], (DEPTH, PEER_EXPERTS, D_MODEL), PEER_HEADS ** -0.5),
    }


def reference(x, a_norm, a_w_in, a_conv, a_log, a_dt_bias, a_out_norm, a_w_out,
              kv_norm, kv_w, kv_k_norm,
              b_norm, b_w_q, b_q_norm, b_lam_q1, b_lam_k1, b_lam_q2, b_lam_k2, b_sub_norm, b_w_o,
              f_norm, f_w_query, f_sub_keys1, f_sub_keys2, f_expert_u, f_expert_v):
    k_shared = v_shared = None
    for i in range(DEPTH):
        if i < N_A_LAYERS:
            x = x + gated_deltanet_mixer(rms_norm(x, a_norm[i]), a_w_in[i], a_conv[i], a_log[i],
                                         a_dt_bias[i], a_out_norm[i], a_w_out[i])
        else:
            j = i - N_A_LAYERS
            if j == 0:
                k_shared, v_shared = shared_kv(x, kv_norm, kv_w, kv_k_norm)
            lambda_init = 0.8 - 0.6 * math.exp(-0.3 * i)
            x = x + diff_attention_mixer(rms_norm(x, b_norm[j]), k_shared, v_shared, b_w_q[j], b_q_norm[j],
                                         b_lam_q1[j], b_lam_k1[j], b_lam_q2[j], b_lam_k2[j],
                                         b_sub_norm[j], b_w_o[j], lambda_init)
        x = x + peer_channel_mixer(rms_norm(x, f_norm[i]), f_w_query[i], f_sub_keys1[i], f_sub_keys2[i],
                                   f_expert_u[i], f_expert_v[i])
    return x
```

```cpp
#include <hip/hip_runtime.h>
#include <hip/hip_bf16.h>
#include <cstdio>
#include <cstdint>

#define LAS __attribute__((address_space(3)))
#define GAS __attribute__((address_space(1)))
typedef unsigned short bfr;
typedef short s8v __attribute__((ext_vector_type(8)));
typedef float f4v __attribute__((ext_vector_type(4)));
typedef unsigned u4v __attribute__((ext_vector_type(4)));
typedef unsigned u2v __attribute__((ext_vector_type(2)));
typedef int i4v __attribute__((ext_vector_type(4)));

#ifndef F8_PROJ0
#define F8_PROJ0 0
#endif
#ifndef F8_KVQ
#define F8_KVQ 1
#endif
constexpr int NB = 2, SEQ = 4096, DM = 4096, NT = NB * SEQ;
constexpr int GH = 32, GD = 128, GIN = 16448, CH = 64, NCH = SEQ / CH;
constexpr int AH = 16, AD = 128, AV = 256;
constexpr int PH = 8, PK = 128, PE = 16384, PQ = 2048, PTOP = 16;
constexpr float EPS = 1e-6f;
constexpr float LAMBDA_INIT = 0.35550906759f;
constexpr float SU = 64.f, SA = 64.f, SV = 4.f;

constexpr size_t MiB = 1u << 20;
constexpr size_t WS_CTL   = 0;
constexpr size_t WS_WTIN  = 1 * MiB;
constexpr size_t WS_WTBD  = WS_WTIN + 128 * MiB;
constexpr size_t WS_WTOUT = WS_WTBD + 1 * MiB;
constexpr size_t WS_WTKVQ = WS_WTOUT + 32 * MiB;
constexpr size_t WS_WTO   = WS_WTKVQ + 96 * MiB;
constexpr size_t WS_WTQRY = WS_WTO + 32 * MiB;
constexpr size_t WS_WTKEY = WS_WTQRY + 32 * MiB;
constexpr size_t WS_U     = WS_WTKEY + 16 * MiB;
constexpr size_t WS_VT    = WS_U + 128 * MiB;
constexpr size_t WS_A2    = WS_VT + 128 * MiB;
constexpr size_t WS_XN8   = WS_A2 + 128 * MiB;
constexpr size_t WS_XN    = WS_XN8 + 32 * MiB;
constexpr size_t WS_BIG   = WS_XN + 64 * MiB;
constexpr size_t WS_R     = WS_BIG + 256 * MiB;
constexpr size_t WS_QRY   = WS_R + 352 * MiB;
constexpr size_t WS_SC    = WS_QRY + 32 * MiB;
constexpr size_t WS_BD    = WS_SC + 64 * MiB;
constexpr size_t WS_EG    = WS_BD + 2 * MiB;
constexpr size_t WS_G     = WS_EG + 1 * MiB;
constexpr size_t WS_END   = WS_G + 256 * MiB;
constexpr size_t R_W = 0, R_U = 64 * MiB, R_QG = 128 * MiB, R_KD = 192 * MiB, R_QK = 256 * MiB, R_O = 288 * MiB;
constexpr size_t R_QH = 0, R_KH = 64 * MiB, R_VH = 128 * MiB, R_OH = 192 * MiB;
static_assert(WS_END <= (size_t)1790 * MiB, "workspace map");

constexpr int CW_BAR = 4096;
constexpr size_t CTL_ZERO_BYTES = 1 * MiB;

constexpr int LDS_BYTES = 147456;
constexpr int MISC_OFF = 146944;

typedef float f2v_ __attribute__((ext_vector_type(2)));
typedef __bf16 b2v_ __attribute__((ext_vector_type(2)));
__device__ __forceinline__ unsigned cvtpk(float lo, float hi) { const b2v_ r = __builtin_convertvector((f2v_){lo, hi}, b2v_); return __builtin_bit_cast(unsigned, r); }
__device__ __forceinline__ unsigned cvt4_fp8(float a, float b, float c, float d) { int w = 0; w = __builtin_amdgcn_cvt_pk_fp8_f32(a, b, w, false); w = __builtin_amdgcn_cvt_pk_fp8_f32(c, d, w, true); return (unsigned)w; }
__device__ __forceinline__ float bflo(unsigned w) { return __uint_as_float(w << 16); }
__device__ __forceinline__ float bfhi(unsigned w) { return __uint_as_float(w & 0xffff0000u); }
__device__ __forceinline__ float bf1(bfr b) { return __uint_as_float(((unsigned)b) << 16); }
__device__ __forceinline__ bfr f2bf1(float f) { return (bfr)(cvtpk(f, 0.f) & 0xffffu); }
__device__ __forceinline__ float wave_sum(float v) {
#pragma unroll
    for (int o = 1; o < 64; o <<= 1) v += __shfl_xor(v, o);
    return v;
}
__device__ __forceinline__ f4v zero_acc() { f4v z = {0.f, 0.f, 0.f, 0.f}; asm volatile("" : "+v"(z)); return z; }
#define MFMA_SETTLE(acc) asm volatile("s_nop 7\n\ts_nop 7" : "+v"(acc))
#define LDS_WAIT() asm volatile("s_waitcnt lgkmcnt(0)" ::: "memory")
#define VM_WAIT() asm volatile("s_waitcnt vmcnt(0)" ::: "memory")
#define XB_TMO      128
#define XB_XCNT(j)  (256  + 64 * (j))
#define XB_XSUB(j)  (1280 + 64 * (j))
#define XB_XGEN(j)  (2304 + 64 * (j))
#define XB_TOP      3328
#define XB_TOPGEN   3392
#define XCD_BAR_WORDS 3456
#define XB_SPIN_CAP (1u << 18)

__device__ __forceinline__ unsigned xb_ld(unsigned* p)              { return __hip_atomic_load(p, __ATOMIC_RELAXED, __HIP_MEMORY_SCOPE_AGENT); }
__device__ __forceinline__ unsigned xb_add(unsigned* p, unsigned v) { return __hip_atomic_fetch_add(p, v, __ATOMIC_RELAXED, __HIP_MEMORY_SCOPE_AGENT); }
__device__ __forceinline__ unsigned xb_xcc_id() { return (unsigned)__builtin_amdgcn_s_getreg((3 << 11) | 20) & 0xFu; }
#define XB_SPIN(cond, bar) do { unsigned _sp = 0; while (cond) { __builtin_amdgcn_s_sleep(1); \
    if ((++_sp & 255u) == 0u) { if (xb_ld(&(bar)[XB_TMO])) break; if (_sp > XB_SPIN_CAP) { atomicAdd(&(bar)[XB_TMO], 1u); break; } } } } while (0)

struct XcdBarrier {
    unsigned* bar; unsigned x;
    volatile LAS unsigned* st;
};

__device__ __forceinline__ XcdBarrier xcd_barrier_post(unsigned* bar, volatile LAS unsigned* st) {
    XcdBarrier b; b.bar = bar; b.x = xb_xcc_id(); b.st = st;
    if (threadIdx.x == 0) (void)xb_add(&bar[XB_XCNT(b.x)], 1u);
    return b;
}
__device__ __forceinline__ void xcd_barrier_complete(unsigned* bar, unsigned x, unsigned& nloc, unsigned& nx) {
    const unsigned G = gridDim.x * gridDim.y * gridDim.z;
    unsigned sum, cnt, mine, sp = 0u;
    for (;;) {
        sum = 0u; cnt = 0u; mine = 0u;
#pragma unroll
        for (unsigned j = 0; j < 16; ++j) { const unsigned c = xb_ld(&bar[XB_XCNT(j)]); sum += c; cnt += (c > 0u) ? 1u : 0u; mine = (j == x) ? c : mine; }
        if (sum == G) break;
        __builtin_amdgcn_s_sleep(1);
        if ((++sp & 255u) == 0u) { if (xb_ld(&bar[XB_TMO])) break; if (sp > XB_SPIN_CAP) { atomicAdd(&bar[XB_TMO], 1u); break; } }
    }
    nloc = mine > 0u ? mine : 1u; nx = cnt > 0u ? cnt : 1u;
}

__device__ __forceinline__ void xcd_barrier(const XcdBarrier& b) {
    asm volatile("s_waitcnt vmcnt(0)" ::: "memory");
    __syncthreads();
    if (threadIdx.x == 0) {
        unsigned* bar = b.bar;
        __builtin_amdgcn_s_waitcnt(0);
        unsigned nloc = b.st[0], nx = b.st[1];
        if (nloc == 0u) { xcd_barrier_complete(bar, b.x, nloc, nx); b.st[0] = nloc; b.st[1] = nx; }
        const unsigned old = xb_add(&bar[XB_XSUB(b.x)], 1u);
        const unsigned gen = old / nloc;
        if (old + 1u == (gen + 1u) * nloc) {
            __builtin_amdgcn_fence(__ATOMIC_RELEASE, "agent");
            asm volatile("s_waitcnt vmcnt(0)" ::: "memory");
            const unsigned og = xb_add(&bar[XB_TOP], 1u);
            const unsigned tg = og / nx;
            if (og + 1u == (tg + 1u) * nx) xb_add(&bar[XB_TOPGEN], 1u);
            else XB_SPIN(xb_ld(&bar[XB_TOPGEN]) == tg, bar);
            __builtin_amdgcn_fence(__ATOMIC_ACQUIRE, "agent");
            xb_add(&bar[XB_XGEN(b.x)], 1u);
            asm volatile("s_waitcnt vmcnt(0)" ::: "memory");
        } else {
            XB_SPIN(xb_ld(&bar[XB_XGEN(b.x)]) == gen, bar);
            __builtin_amdgcn_fence(__ATOMIC_ACQUIRE, "agent");
            asm volatile("s_waitcnt vmcnt(0)" ::: "memory");
        }
    }
    __syncthreads();
}
namespace pg8 {
#define PG8_LAS __attribute__((address_space(3)))
typedef unsigned short bf16_t;
typedef short bf16x8 __attribute__((ext_vector_type(8)));
typedef float f32x4 __attribute__((ext_vector_type(4)));
typedef unsigned u32x4 __attribute__((ext_vector_type(4)));
typedef int i32x4 __attribute__((ext_vector_type(4)));
typedef int i32x8 __attribute__((ext_vector_type(8)));
typedef unsigned u32x2 __attribute__((ext_vector_type(2)));
constexpr int BM = 256, BK = 64, HALF = 128, HTB = HALF * BK * 2  , STAGE_BYTES = 8 * HTB, NXCD = 8, WGM = 8;

__host__ __device__ __forceinline__ int lds_byte(int r, int c) { const int st = (r >> 4) * 2 + (c >> 5), rr = r & 15, cc = c & 31, ob = rr * 64 + cc * 2; return st * 1024 + (ob ^ (((ob >> 9) & 1) << 5)); }
__host__ __device__ __forceinline__ void stage_rc(int b, int& R, int& C) { const int st = b / 1024, sb = b % 1024, swz = sb ^ (((sb >> 9) & 1) << 5); R = (st >> 1) * 16 + swz / 64; C = (st & 1) * 32 + (swz % 64) / 2; }
__host__ __device__ __forceinline__ int perm32(int rho) { const int n = rho >> 4, i = rho & 15; return 8 * (i >> 2) + 4 * n + (i & 3); }

struct Unit { int pm, pn; };
struct Gemm { const bf16_t* A; const bf16_t* Bt; int M, N, K; };

struct StaticOrder {
    int nM, nN, nwg, G, c;
    __host__ __device__ void init(int M, int N, int G_, int c_) { nM = M / BM; nN = N / BM; nwg = nM * nN; G = G_; c = c_; }
    __host__ __device__ bool next(int i, Unit& u) const {
        const long L = (long)i * G + c; if (L >= nwg) return false;
        int wgid = (int)L; { const int q = nwg / NXCD, r = nwg % NXCD, xcd = wgid % NXCD, off = wgid / NXCD; wgid = (xcd < r ? xcd * (q + 1) : r * (q + 1) + (xcd - r) * q) + off; }
        const int nig = WGM * nN, gid = wgid / nig, fm = gid * WGM, gsz = (nM - fm) < WGM ? (nM - fm) : WGM;
        u.pm = fm + ((wgid % nig) % gsz); u.pn = (wgid % nig) / gsz; return true;
    }
    __device__ __forceinline__ void a_ready(const Unit&) const {}
    __device__ __forceinline__ void done(const Unit&) const {}
};

__device__ __forceinline__ unsigned cvt_pk_bf16(float lo, float hi) { unsigned r; asm volatile("v_cvt_pk_bf16_f32 %0, %1, %2" : "=v"(r) : "v"(lo), "v"(hi)); return r; }
typedef float f32x2 __attribute__((ext_vector_type(2)));
__device__ __forceinline__ f32x2 gelu_pk(f32x2 v) {
    const f32x2 av = __builtin_elementwise_abs(v), d = av * 0.2316418882f + 1.0f;
    f32x2 t; t.x = __builtin_amdgcn_rcpf(d.x); t.y = __builtin_amdgcn_rcpf(d.y);
    f32x2 q = t * 0.5307027145f + (-0.7265760135f); q = q * t + 0.7107068705f; q = q * t + (-0.142248368f); q = q * t + 0.127414796f; q = q * t;
    const f32x2 s = (v * v) * (-0.72134752044f);
    f32x2 e; e.x = __builtin_amdgcn_exp2f(s.x); e.y = __builtin_amdgcn_exp2f(s.y);
    const f32x2 m = v * (q * e), r = v - m;
    f32x2 o; o.x = v.x < 0.f ? m.x : r.x; o.y = v.y < 0.f ? m.y : r.y; return o;
}

template <int ACT  > struct EpiBf16 {
    static constexpr bool PERM = true, AFTER_DRAIN = false; static_assert(ACT == 0 || ACT == 1, "EpiBf16: ACT is 0 (none) or 1 (gelu_pk)");
    bf16_t* O; int ldc; const float* bias; int split_cols; size_t split_stride; float scale0;
    __device__ __forceinline__ void operator()(const f32x4 (&acc)[2][2][4][2], const Unit& u, int wr, int wc, int fr, int fq) const {
        const int row0 = u.pm * BM + wr * 64 + fr; int colt = u.pn * BM; bf16_t* base = O;
        float sc = 1.f; if (split_cols) { const int t = colt / split_cols; base += (size_t)t * split_stride; colt -= t * split_cols; if (t == 0) sc = scale0; }
        const int col0 = colt + wc * 32 + 8 * fq, bcol0 = u.pn * BM + wc * 32 + 8 * fq;
        f32x4 bv[2][2];
#pragma unroll
        for (int bj = 0; bj < 2; ++bj)
#pragma unroll
            for (int n = 0; n < 2; ++n) bv[bj][n] = bias ? *(const f32x4*)(bias + bcol0 + bj * HALF + 4 * n) : (f32x4){0.f, 0.f, 0.f, 0.f};
#pragma unroll
        for (int ai = 0; ai < 2; ++ai)
#pragma unroll
            for (int m = 0; m < 4; ++m) { bf16_t* rowp = base + (size_t)(row0 + ai * HALF + m * 16) * ldc + col0;
#pragma unroll
                for (int bj = 0; bj < 2; ++bj) { f32x4 v0 = acc[ai][bj][m][0] + bv[bj][0], v1 = acc[ai][bj][m][1] + bv[bj][1];
                    if (ACT == 1) { f32x2 a = gelu_pk((f32x2){v0[0], v0[1]}), b = gelu_pk((f32x2){v0[2], v0[3]}), c = gelu_pk((f32x2){v1[0], v1[1]}), d = gelu_pk((f32x2){v1[2], v1[3]});
                        v0 = (f32x4){a.x, a.y, b.x, b.y}; v1 = (f32x4){c.x, c.y, d.x, d.y}; }
                    v0 = v0 * sc; v1 = v1 * sc; u32x4 w; w.x = cvt_pk_bf16(v0[0], v0[1]); w.y = cvt_pk_bf16(v0[2], v0[3]); w.z = cvt_pk_bf16(v1[0], v1[1]); w.w = cvt_pk_bf16(v1[2], v1[3]);
                    *(u32x4*)(rowp + bj * HALF) = w; } }
    }
};
struct EpiRes {
    static constexpr bool PERM = false, AFTER_DRAIN = false;
    const float* base; float* out; int ldc; float scale;
    __device__ __forceinline__ void operator()(const f32x4 (&acc)[2][2][4][2], const Unit& u, int wr, int wc, int fr, int fq) const {
        const int row0 = u.pm * BM + wr * 64 + fr, col0 = u.pn * BM + wc * 32 + 4 * fq;
#pragma unroll
        for (int ai = 0; ai < 2; ++ai)
#pragma unroll
            for (int m = 0; m < 4; ++m) { const size_t off = (size_t)(row0 + ai * HALF + m * 16) * ldc + col0;
                f32x4 bs[2][2];
#pragma unroll
                for (int bj = 0; bj < 2; ++bj)
#pragma unroll
                    for (int n = 0; n < 2; ++n) bs[bj][n] = *(const f32x4*)(base + off + bj * HALF + n * 16);
#pragma unroll
                for (int bj = 0; bj < 2; ++bj)
#pragma unroll
                    for (int n = 0; n < 2; ++n) *(f32x4*)(out + off + bj * HALF + n * 16) = bs[bj][n] + acc[ai][bj][m][n] * scale;
                asm volatile("" ::: "memory"); }
    }
};
struct EpiStF32 {
    static constexpr bool PERM = false, AFTER_DRAIN = false;
    float* C; int ldc;
    __device__ __forceinline__ void operator()(const f32x4 (&acc)[2][2][4][2], const Unit& u, int wr, int wc, int fr, int fq) const {
        const int row0 = u.pm * BM + wr * 64 + fr, col0 = u.pn * BM + wc * 32 + 4 * fq;
#pragma unroll
        for (int ai = 0; ai < 2; ++ai)
#pragma unroll
            for (int m = 0; m < 4; ++m) { float* rowp = C + (size_t)(row0 + ai * HALF + m * 16) * ldc + col0;
#pragma unroll
                for (int bj = 0; bj < 2; ++bj)
#pragma unroll
                    for (int n = 0; n < 2; ++n) *(f32x4*)(rowp + bj * HALF + n * 16) = acc[ai][bj][m][n]; }
    }
};
struct EpiGate {
    static constexpr bool PERM = true, AFTER_DRAIN = false;
    bf16_t* G; int ldc;
    __device__ __forceinline__ void operator()(const f32x4 (&acc)[2][2][4][2], const Unit& u, int wr, int wc, int fr, int fq) const {
        const int row0 = u.pm * BM + wr * 64 + fr, col0 = u.pn * BM + wc * 32 + 8 * fq;
#pragma unroll
        for (int ai = 0; ai < 2; ++ai)
#pragma unroll
            for (int m = 0; m < 4; ++m) { bf16_t* rowp = G + (size_t)(row0 + ai * HALF + m * 16) * ldc + col0;
                u32x4 g[2];
#pragma unroll
                for (int bj = 0; bj < 2; ++bj) g[bj] = *(const u32x4*)(rowp + bj * HALF);
#pragma unroll
                for (int bj = 0; bj < 2; ++bj) {
                    if ((g[bj].x | g[bj].y | g[bj].z | g[bj].w) != 0u) {
                        const f32x4 v0 = acc[ai][bj][m][0], v1 = acc[ai][bj][m][1];
                        const f32x2 a = gelu_pk((f32x2){v0[0], v0[1]}), b = gelu_pk((f32x2){v0[2], v0[3]}), c = gelu_pk((f32x2){v1[0], v1[1]}), d = gelu_pk((f32x2){v1[2], v1[3]});
                        u32x4 w;
                        w.x = cvt_pk_bf16(a.x * __uint_as_float(g[bj].x << 16), a.y * __uint_as_float(g[bj].x & 0xffff0000u));
                        w.y = cvt_pk_bf16(b.x * __uint_as_float(g[bj].y << 16), b.y * __uint_as_float(g[bj].y & 0xffff0000u));
                        w.z = cvt_pk_bf16(c.x * __uint_as_float(g[bj].z << 16), c.y * __uint_as_float(g[bj].z & 0xffff0000u));
                        w.w = cvt_pk_bf16(d.x * __uint_as_float(g[bj].w << 16), d.y * __uint_as_float(g[bj].w & 0xffff0000u));
                        *(u32x4*)(rowp + bj * HALF) = w;
                    }
                } }
    }
};
struct EpiGate8 {
    static constexpr bool PERM = true, AFTER_DRAIN = false;
    bf16_t* G; unsigned char* A2; int ldc; float hscale, oscale;
    __device__ __forceinline__ void operator()(const f32x4 (&acc)[2][2][4][2], const Unit& u, int wr, int wc, int fr, int fq) const {
        const int row0 = u.pm * BM + wr * 64 + fr, col0 = u.pn * BM + wc * 32 + 8 * fq;
#pragma unroll
        for (int ai = 0; ai < 2; ++ai)
#pragma unroll
            for (int m = 0; m < 4; ++m) { const size_t ro = (size_t)(row0 + ai * HALF + m * 16) * ldc + col0;
                u32x4 g[2];
#pragma unroll
                for (int bj = 0; bj < 2; ++bj) g[bj] = *(const u32x4*)(G + ro + bj * HALF);
#pragma unroll
                for (int bj = 0; bj < 2; ++bj) {
                    u32x2 w = {0u, 0u};
                    if ((g[bj].x | g[bj].y | g[bj].z | g[bj].w) != 0u) {
                        const f32x4 v0 = acc[ai][bj][m][0] * hscale, v1 = acc[ai][bj][m][1] * hscale;
                        const f32x2 a = gelu_pk((f32x2){v0[0], v0[1]}), b = gelu_pk((f32x2){v0[2], v0[3]}), c = gelu_pk((f32x2){v1[0], v1[1]}), d = gelu_pk((f32x2){v1[2], v1[3]});
                        float y[8] = {a.x * __uint_as_float(g[bj].x << 16), a.y * __uint_as_float(g[bj].x & 0xffff0000u), b.x * __uint_as_float(g[bj].y << 16), b.y * __uint_as_float(g[bj].y & 0xffff0000u),
                                      c.x * __uint_as_float(g[bj].z << 16), c.y * __uint_as_float(g[bj].z & 0xffff0000u), d.x * __uint_as_float(g[bj].w << 16), d.y * __uint_as_float(g[bj].w & 0xffff0000u)};
#pragma unroll
                        for (int k = 0; k < 8; ++k) y[k] = fminf(fmaxf(y[k] * oscale, -440.f), 440.f);
                        int lo = 0, hi = 0;
                        lo = __builtin_amdgcn_cvt_pk_fp8_f32(y[0], y[1], lo, false); lo = __builtin_amdgcn_cvt_pk_fp8_f32(y[2], y[3], lo, true);
                        hi = __builtin_amdgcn_cvt_pk_fp8_f32(y[4], y[5], hi, false); hi = __builtin_amdgcn_cvt_pk_fp8_f32(y[6], y[7], hi, true);
                        w.x = (unsigned)lo; w.y = (unsigned)hi;
                        *(u32x4*)(G + ro + bj * HALF) = (u32x4){0u, 0u, 0u, 0u};
                    }
                    *(u32x2*)(A2 + ro + bj * HALF) = w;
                } }
    }
};
template <class Epi, class Sched, bool ALIGN_EPI = false, bool SP2 = false, bool F8 = false>
__device__ __forceinline__ void gemm_phase(PG8_LAS unsigned char* lds, const Gemm g, const Sched& S, const Epi& E) {
    const int tid = threadIdx.x, wid = __builtin_amdgcn_readfirstlane(tid >> 6), lane = tid & 63, wr = wid >> 2, wc = wid & 3, fr = lane & 15, fq = lane >> 4;
    const int K = g.K, nt = K / BK;
    unsigned voffA[2], voffB[2];
#pragma unroll
    for (int i = 0; i < 2; ++i) { int R, C; stage_rc(tid * 16 + i * 8192, R, C); const int Rb = Epi::PERM ? ((R & ~31) + perm32(R & 31)) : R;
        voffA[i] = (unsigned)(R * K + C) * 2u; voffB[i] = (unsigned)(Rb * K + C) * 2u; }
    const size_t kstep = (size_t)(BK * 2);
    const size_t hstep = (size_t)HALF * K * 2;
    const size_t tstep = 2 * hstep;
    const unsigned ldsw = (unsigned)wid * 1024u;
    const int aoff = lds_byte(wr * 64 + fr, fq * 8), boff = lds_byte(wc * 32 + fr, fq * 8);
#define PG8_SA(b, h) (((b) * 2 + (h)) * HTB)
#define PG8_SB(b, h) ((4 + (b) * 2 + (h)) * HTB)
#define PG8_STAGE(bufoff, gbase, voff) do { _Pragma("unroll") for (int _i = 0; _i < 2; ++_i) \
        __builtin_amdgcn_global_load_lds((const unsigned*)((const char*)(gbase) + (voff)[_i]), (PG8_LAS unsigned*)(lds + (bufoff) + ldsw + _i * 8192), 16, 0, 0); } while (0)
#define PG8_LDA(dst, b, h) do { if constexpr (F8) { _Pragma("unroll") for (int m = 0; m < 4; ++m) { const i32x4 lo_ = *(const PG8_LAS i32x4*)(lds + PG8_SA(b, h) + aoff + m * 2048), hi_ = *(const PG8_LAS i32x4*)(lds + PG8_SA(b, h) + aoff + m * 2048 + 1024); \
        dst##_8[m] = __builtin_shufflevector(lo_, hi_, 0, 1, 2, 3, 4, 5, 6, 7); } } else { _Pragma("unroll") for (int m = 0; m < 4; ++m) _Pragma("unroll") for (int k = 0; k < 2; ++k) dst[m][k] = *(const PG8_LAS bf16x8*)(lds + PG8_SA(b, h) + aoff + m * 2048 + k * 1024); } } while (0)
#define PG8_LDB(dst, b, h) do { if constexpr (F8) { _Pragma("unroll") for (int n = 0; n < 2; ++n) { const i32x4 lo_ = *(const PG8_LAS i32x4*)(lds + PG8_SB(b, h) + boff + n * 2048), hi_ = *(const PG8_LAS i32x4*)(lds + PG8_SB(b, h) + boff + n * 2048 + 1024); \
        dst##_8[n] = __builtin_shufflevector(lo_, hi_, 0, 1, 2, 3, 4, 5, 6, 7); } } else { _Pragma("unroll") for (int n = 0; n < 2; ++n) _Pragma("unroll") for (int k = 0; k < 2; ++k) dst[n][k] = *(const PG8_LAS bf16x8*)(lds + PG8_SB(b, h) + boff + n * 2048 + k * 1024); } } while (0)
#define PG8_MMA(ai, bj, At, Bt) do { __builtin_amdgcn_s_setprio(1); if constexpr (F8) { _Pragma("unroll") for (int m = 0; m < 4; ++m) _Pragma("unroll") for (int n = 0; n < 2; ++n) \
        asm volatile("v_mfma_f32_16x16x128_f8f6f4 %0, %1, %2, %0" : "+v"(acc[ai][bj][m][n]) : "v"(Bt##_8[n]), "v"(At##_8[m])); } \
    else { _Pragma("unroll") for (int m = 0; m < 4; ++m) _Pragma("unroll") for (int n = 0; n < 2; ++n) _Pragma("unroll") for (int k = 0; k < 2; ++k) \
        acc[ai][bj][m][n] = __builtin_amdgcn_mfma_f32_16x16x32_bf16(Bt[n][k], At[m][k], acc[ai][bj][m][n], 0, 0, 0); } __builtin_amdgcn_s_setprio(0); } while (0)
#define PG8_WAIT_V(n) asm volatile("s_waitcnt vmcnt(" #n ")" ::: "memory")
#define PG8_WAIT_L(n) asm volatile("s_waitcnt lgkmcnt(" #n ")" ::: "memory")
#define PG8_BAR __builtin_amdgcn_s_barrier()
#define PG8_SCHED __builtin_amdgcn_sched_barrier(0)
    Unit cur, nxt; int ui = 0;
    if (!S.next(0, cur)) return;
    f32x4 acc[2][2][4][2];
#pragma unroll
    for (int a = 0; a < 2; ++a)
#pragma unroll
        for (int b = 0; b < 2; ++b)
#pragma unroll
            for (int m = 0; m < 4; ++m)
#pragma unroll
                for (int n = 0; n < 2; ++n) acc[a][b][m][n] = (f32x4){0.f, 0.f, 0.f, 0.f};
    const int f8_scale_one = 0x7F7F7F7F;
    bf16x8 At[4][2], B0[2][2], B1[2][2]; i32x8 At_8[4], B0_8[2], B1_8[2];
    const char* cA = (const char*)g.A + (size_t)cur.pm * tstep; const char* cB = (const char*)g.Bt + (size_t)cur.pn * tstep;
    S.a_ready(cur);
    if constexpr (SP2) {
        PG8_STAGE(PG8_SB(0, 0), cB, voffB); PG8_STAGE(PG8_SB(0, 1), cB + hstep, voffB); PG8_STAGE(PG8_SA(0, 0), cA, voffA); PG8_STAGE(PG8_SA(0, 1), cA + hstep, voffA);
        if (wr == 1) PG8_BAR;
        PG8_WAIT_V(2); PG8_BAR;
        PG8_STAGE(PG8_SB(1, 0), cB + kstep, voffB); PG8_STAGE(PG8_SA(1, 0), cA + kstep, voffA); PG8_STAGE(PG8_SB(1, 1), cB + hstep + kstep, voffB);
        PG8_WAIT_V(6); PG8_BAR;
    } else {
        PG8_STAGE(PG8_SB(0, 0), cB, voffB); PG8_STAGE(PG8_SA(0, 0), cA, voffA); PG8_STAGE(PG8_SB(0, 1), cB + hstep, voffB); PG8_STAGE(PG8_SA(0, 1), cA + hstep, voffA);
        if (wr == 1) PG8_BAR;
        PG8_WAIT_V(4); PG8_BAR;
        PG8_STAGE(PG8_SB(1, 0), cB + kstep, voffB); PG8_STAGE(PG8_SA(1, 0), cA + kstep, voffA); PG8_STAGE(PG8_SB(1, 1), cB + hstep + kstep, voffB);
        PG8_WAIT_V(6); PG8_BAR;
    }
    for (;;) {
        const bool has_next = S.next(ui + 1, nxt);
        const char* nA = has_next ? (const char*)g.A + (size_t)nxt.pm * tstep : cA; const char* nB = has_next ? (const char*)g.Bt + (size_t)nxt.pn * tstep : cB;
        for (int t = 0; t < nt; t += 2) {
            const bool last = (t == nt - 2);
            const char* a1 = cA + (size_t)(t + 1) * kstep;
            const char* a2 = last ? nA : cA + (size_t)(t + 2) * kstep; const char* b2 = last ? nB : cB + (size_t)(t + 2) * kstep;
            const char* a3 = a2 + kstep; const char* b3 = b2 + kstep;
            if (last && has_next) S.a_ready(nxt);
            if constexpr (SP2) {
            PG8_LDB(B0, 0, 0); PG8_LDB(B1, 0, 1); PG8_SCHED; PG8_LDA(At, 0, 0); PG8_STAGE(PG8_SA(1, 1), a1 + hstep, voffA);
            PG8_WAIT_V(8); PG8_WAIT_L(0); PG8_BAR; PG8_MMA(0, 0, At, B0); PG8_MMA(0, 1, At, B1); PG8_BAR; PG8_SCHED;
            PG8_LDA(At, 0, 1); PG8_STAGE(PG8_SB(0, 0), b2, voffB); PG8_STAGE(PG8_SB(0, 1), b2 + hstep, voffB); PG8_STAGE(PG8_SA(0, 0), a2, voffA);
            PG8_WAIT_V(8); PG8_WAIT_L(0); PG8_BAR; PG8_MMA(1, 0, At, B0); PG8_MMA(1, 1, At, B1); PG8_BAR; PG8_SCHED;
            PG8_LDB(B0, 1, 0); PG8_LDB(B1, 1, 1); PG8_SCHED; PG8_LDA(At, 1, 0); PG8_STAGE(PG8_SA(0, 1), a2 + hstep, voffA);
            PG8_WAIT_V(8); PG8_WAIT_L(0); PG8_BAR; PG8_MMA(0, 0, At, B0); PG8_MMA(0, 1, At, B1); PG8_BAR; PG8_SCHED;
            PG8_LDA(At, 1, 1); PG8_STAGE(PG8_SB(1, 0), b3, voffB); PG8_STAGE(PG8_SB(1, 1), b3 + hstep, voffB); PG8_STAGE(PG8_SA(1, 0), a3, voffA);
            PG8_WAIT_V(8); PG8_WAIT_L(0); PG8_BAR; PG8_MMA(1, 0, At, B0); PG8_MMA(1, 1, At, B1); PG8_BAR; PG8_SCHED;
            } else {
            PG8_LDB(B0, 0, 0); PG8_SCHED; PG8_LDA(At, 0, 0); PG8_STAGE(PG8_SA(1, 1), a1 + hstep, voffA);
            PG8_WAIT_L(8); PG8_BAR; PG8_WAIT_L(0); PG8_MMA(0, 0, At, B0); PG8_BAR; PG8_SCHED;
            PG8_LDB(B1, 0, 1); PG8_STAGE(PG8_SB(0, 0), b2, voffB);
            PG8_BAR; PG8_WAIT_L(0); PG8_MMA(0, 1, At, B1); PG8_BAR;
            PG8_LDA(At, 0, 1); PG8_STAGE(PG8_SA(0, 0), a2, voffA);
            PG8_BAR; PG8_WAIT_L(0); PG8_MMA(1, 0, At, B0); PG8_BAR; PG8_SCHED;
            PG8_STAGE(PG8_SB(0, 1), b2 + hstep, voffB);
            PG8_WAIT_V(6); PG8_BAR; PG8_MMA(1, 1, At, B1); PG8_BAR;
            PG8_LDB(B0, 1, 0); PG8_SCHED; PG8_LDA(At, 1, 0); PG8_STAGE(PG8_SA(0, 1), a2 + hstep, voffA);
            PG8_WAIT_L(8); PG8_BAR; PG8_WAIT_L(0); PG8_MMA(0, 0, At, B0); PG8_BAR; PG8_SCHED;
            PG8_LDB(B1, 1, 1); PG8_STAGE(PG8_SB(1, 0), b3, voffB);
            PG8_BAR; PG8_WAIT_L(0); PG8_MMA(0, 1, At, B1); PG8_BAR;
            PG8_LDA(At, 1, 1); PG8_STAGE(PG8_SA(1, 0), a3, voffA);
            PG8_BAR; PG8_WAIT_L(0); PG8_MMA(1, 0, At, B0); PG8_BAR; PG8_SCHED;
            PG8_STAGE(PG8_SB(1, 1), b3 + hstep, voffB);
            PG8_WAIT_V(6); PG8_BAR; PG8_MMA(1, 1, At, B1); PG8_BAR;
            }
        }
        if constexpr (ALIGN_EPI) { if (wr == 0) PG8_BAR; }
        if constexpr (!Epi::AFTER_DRAIN) { E(acc, cur, wr, wc, fr, fq); S.done(cur); }
        if (!has_next) break;
#pragma unroll
        for (int a = 0; a < 2; ++a)
#pragma unroll
            for (int b = 0; b < 2; ++b)
#pragma unroll
                for (int m = 0; m < 4; ++m)
#pragma unroll
                    for (int n = 0; n < 2; ++n) acc[a][b][m][n] = (f32x4){0.f, 0.f, 0.f, 0.f};
        cur = nxt; cA = nA; cB = nB; ++ui;
        if constexpr (ALIGN_EPI) { if (wr == 1) PG8_BAR; }
    }
    PG8_WAIT_V(0);
    if constexpr (!ALIGN_EPI) { if (wr == 0) PG8_BAR; }
    PG8_BAR;
    if constexpr (Epi::AFTER_DRAIN) { E.fused(acc, cur, wr, wc, fr, fq, lds, wid, lane); S.done(cur); }
#undef PG8_SA
#undef PG8_SB
#undef PG8_STAGE
#undef PG8_LDA
#undef PG8_LDB
#undef PG8_MMA
#undef PG8_WAIT_V
#undef PG8_WAIT_L
#undef PG8_BAR
#undef PG8_SCHED
}
}
namespace att {
constexpr int D = 128;
constexpr int WINDOW = 4096;
constexpr float THR = 8.f;
constexpr bool WSKIP = false;
constexpr float SCALE = 0.08838834764831845f;
constexpr int NW = 8, QBLK = 32, KVBLK = 64, QB = NW * QBLK;
constexpr int SHM_V = KVBLK * D * 2, SHM_K = KVBLK * D * 2;
constexpr int LDS_BYTES = 2 * SHM_V + 2 * SHM_K + NW * 64 * 4;
using bf16 = __hip_bfloat16;
typedef short bf16x8 __attribute__((ext_vector_type(8)));
typedef short s16x4 __attribute__((ext_vector_type(4)));
typedef float f32x16 __attribute__((ext_vector_type(16)));
typedef float f32x4 __attribute__((ext_vector_type(4)));
typedef unsigned u32x4 __attribute__((ext_vector_type(4)));
template <class A, class Bt> struct same_t { static constexpr bool v = false; };
template <class A> struct same_t<A, A> { static constexpr bool v = true; };

#define KSWZ(row, colB) ((row) * 256 + ((colB) ^ (((row) & 7) << 4)))
#define SBAR() __builtin_amdgcn_sched_barrier(0)
__device__ __forceinline__ int v_st(int k, int c) { const int kk = (k & ~0xC) | ((k & 4) << 1) | ((k & 8) >> 1); return ((kk >> 3) * 4 + (c >> 5)) * 512 + ((kk & 7) * 32 + (c & 31)) * 2; }
__device__ __forceinline__ int v_rd_base(int lane) { return ((lane & 3) << 3) | (((lane >> 2) & 3) << 6) | (((lane >> 4) & 1) << 5) | (((lane >> 5) & 1) << 8); }
constexpr int v_rd_off(int d0, int ks, int half) { return d0 * 512 + ks * 4096 + half * 2048; }
__device__ __forceinline__ int crow(int r, int hi) { return (r & 3) + 8 * (r >> 2) + 4 * hi; }
__device__ __forceinline__ unsigned cvtpk(float lo, float hi) {
    unsigned r; asm volatile("v_cvt_pk_bf16_f32 %0, %1, %2" : "=v"(r) : "v"(lo), "v"(hi)); return r;
}
__device__ __forceinline__ bf16x8 pack8(f32x4 a, f32x4 b) {
    u32x4 w = {cvtpk(a[0], a[1]), cvtpk(a[2], a[3]), cvtpk(b[0], b[1]), cvtpk(b[2], b[3])};
    return *reinterpret_cast<bf16x8*>(&w);
}
template <class T> __device__ __forceinline__ bf16x8 load8(const T* p) {
    if constexpr (same_t<T, float>::v) { return pack8(*(const f32x4*)p, *(const f32x4*)(p + 4)); }
    else { return *reinterpret_cast<const bf16x8*>(p); }
}
__device__ __forceinline__ void mask_tile(f32x16& p0, f32x16& p1, int dq, unsigned W) {
    const float NEG = -__builtin_inff();
#pragma unroll
    for (int r = 0; r < 16; ++r) {
        const int c = (r & 3) + 8 * (r >> 2);
        if ((unsigned)(dq - c) >= W) p0[r] = NEG;
        if ((unsigned)(dq - c - 32) >= W) p1[r] = NEG;
    }
}
__device__ __forceinline__ void partialSM(f32x16& p0, f32x16& p1, float& m_reg, float& mn, float& alpha) {
    float pmax = p0[0]; for (int r = 1; r < 16; ++r) pmax = fmaxf(pmax, p0[r]); for (int r = 0; r < 16; ++r) pmax = fmaxf(pmax, p1[r]);
    { auto rr = __builtin_amdgcn_permlane32_swap(__float_as_uint(pmax), __float_as_uint(pmax), false, false);
      pmax = fmaxf(__uint_as_float(rr[0]), __uint_as_float(rr[1])); }
    constexpr float C2 = 1.4426950408889634f * SCALE;
    if (__builtin_expect(__all((pmax - m_reg) * SCALE <= THR), 1)) { mn = m_reg; alpha = 1.f; }
    else { mn = fmaxf(m_reg, pmax); alpha = __builtin_amdgcn_exp2f((m_reg - mn) * C2); m_reg = mn; }
    const float mnL = -mn * C2;
    for (int r = 0; r < 16; ++r) p0[r] = fmaf(p0[r], C2, mnL); for (int r = 0; r < 16; ++r) p1[r] = fmaf(p1[r], C2, mnL);
    for (int r = 0; r < 16; ++r) p0[r] = __builtin_amdgcn_exp2f(p0[r]);
}
__device__ __forceinline__ void finishSM(f32x16& p0, f32x16& p1, float alpha, float& l_reg, bf16x8& pa0, bf16x8& pa1, bf16x8& pa2, bf16x8& pa3) {
    for (int r = 0; r < 16; ++r) p1[r] = __builtin_amdgcn_exp2f(p1[r]);
    float ps = 0; for (int r = 0; r < 16; ++r) ps += p0[r]; for (int r = 0; r < 16; ++r) ps += p1[r];
    { auto rr = __builtin_amdgcn_permlane32_swap(__float_as_uint(ps), __float_as_uint(ps), false, false);
      ps = __uint_as_float(rr[0]) + __uint_as_float(rr[1]); }
    l_reg = l_reg * alpha + ps;
#define PK4(P, B_, OUT) do { unsigned a0 = cvtpk(P[B_+0], P[B_+1]), a1 = cvtpk(P[B_+2], P[B_+3]);                          \
        unsigned b0 = cvtpk(P[B_+4], P[B_+5]), b1 = cvtpk(P[B_+6], P[B_+7]);                                             \
        auto r0 = __builtin_amdgcn_permlane32_swap(a0, b0, false, false); auto r1 = __builtin_amdgcn_permlane32_swap(a1, b1, false, false); \
        u32x4 w = {r0[0], r1[0], r0[1], r1[1]}; OUT = *reinterpret_cast<bf16x8*>(&w); } while (0)
    PK4(p0, 0, pa0); PK4(p0, 8, pa1); PK4(p1, 0, pa2); PK4(p1, 8, pa3);
#undef PK4
}
template <int KB, bool SK>
__device__ __forceinline__ void qkt(f32x16& p0, f32x16& p1, const char* K_lds, int r32, int hi, const bf16x8* qr, bool act) {
    if (SK && !act) { const float NEG = -__builtin_inff();
#pragma unroll
        for (int r = 0; r < 16; ++r) { p0[r] = NEG; p1[r] = NEG; } return; }
    p0 = f32x16{}; p1 = f32x16{};
    const char* kb[4];
#pragma unroll
    for (int dd = 0; dd < 4; ++dd) kb[dd] = K_lds + KB * SHM_K + KSWZ(r32, (dd * 16 + hi * 8) * 2);
#pragma unroll
    for (int d0 = 0; d0 < 8; ++d0) { const char* a = kb[d0 & 3] + (d0 >> 2) * 128;
        bf16x8 b0 = *reinterpret_cast<const bf16x8*>(a);
        bf16x8 b1 = *reinterpret_cast<const bf16x8*>(a + 32 * 256);
        p0 = __builtin_amdgcn_mfma_f32_32x32x16_bf16(b0, qr[d0], p0, 0, 0, 0);
        p1 = __builtin_amdgcn_mfma_f32_32x32x16_bf16(b1, qr[d0], p1, 0, 0, 0); }
}
template <int VB, bool SK>
__device__ __forceinline__ void pv_tile(f32x16* o, int vb0, bf16x8 pa0, bf16x8 pa1, bf16x8 pa2, bf16x8 pa3, bool act) {
    if (SK && !act) return;
#define TRRD(dst, off) asm volatile("ds_read_b64_tr_b16 %0, %1 offset:%2" : "=&v"(dst) : "v"(vb0), "i"(off) : "memory")
#define PV_D0(d0) do { s16x4 l0, l1, l2, l3, h0, h1, h2, h3; constexpr int b_ = VB * SHM_V + v_rd_off(d0, 0, 0);     \
        TRRD(l0, b_); TRRD(h0, b_ + 2048); TRRD(l1, b_ + 4096); TRRD(h1, b_ + 6144); TRRD(l2, b_ + 8192); TRRD(h2, b_ + 10240); TRRD(l3, b_ + 12288); TRRD(h3, b_ + 14336); \
        asm volatile("s_waitcnt lgkmcnt(0)" ::: "memory"); SBAR();                 \
        o[d0] = __builtin_amdgcn_mfma_f32_32x32x16_bf16(pa0, (bf16x8){l0[0], l0[1], l0[2], l0[3], h0[0], h0[1], h0[2], h0[3]}, o[d0], 0, 0, 0);   \
        o[d0] = __builtin_amdgcn_mfma_f32_32x32x16_bf16(pa1, (bf16x8){l1[0], l1[1], l1[2], l1[3], h1[0], h1[1], h1[2], h1[3]}, o[d0], 0, 0, 0);   \
        o[d0] = __builtin_amdgcn_mfma_f32_32x32x16_bf16(pa2, (bf16x8){l2[0], l2[1], l2[2], l2[3], h2[0], h2[1], h2[2], h2[3]}, o[d0], 0, 0, 0);   \
        o[d0] = __builtin_amdgcn_mfma_f32_32x32x16_bf16(pa3, (bf16x8){l3[0], l3[1], l3[2], l3[3], h3[0], h3[1], h3[2], h3[3]}, o[d0], 0, 0, 0); } while (0)
    PV_D0(0); PV_D0(1); PV_D0(2); PV_D0(3);
#undef PV_D0
#undef TRRD
}

template <class TIn, class TOut> struct BlockRef { const TIn* Q; const TIn* K; const TIn* V; TOut* O; int P0; };
template <class TIn> struct Seam {
    bf16x8 qr[8];
    bf16x8 st_v0, st_v1, st_k0, st_k1; f32x4 sf0, sf1, sf2, sf3;
    f32x4 tq[16];
};
__device__ __forceinline__ int swa_jlo(int P0, int W) { const int lowk = P0 - W + 1; return lowk > 0 ? lowk / KVBLK : 0; }
#define ROW(p, k0, rr) ((p) + (size_t)((k0) + (rr)) * D + sc)
#define VMW() asm volatile("s_waitcnt vmcnt(0)" ::: "memory")
#define VMWN(n) asm volatile("s_waitcnt vmcnt(%0)" :: "i"(n) : "memory")
#define SLOAD_H(Kp, Vp, k0) do { S.st_v0 = load8<TIn>(ROW(Vp, k0, sr)); S.st_v1 = load8<TIn>(ROW(Vp, k0, 32 + sr));              \
                         S.st_k0 = load8<TIn>(ROW(Kp, k0, sr)); S.st_k1 = load8<TIn>(ROW(Kp, k0, 32 + sr)); } while (0)
#define SWRITE_HK(bf) do { *(bf16x8*)(K_lds + (bf) * SHM_K + kws) = S.st_k0; *(bf16x8*)(K_lds + (bf) * SHM_K + kws + 32 * 256) = S.st_k1; } while (0)
#define SWRITE_HV(bf) do { *(bf16x8*)(V_lds + (bf) * SHM_V + vst0) = S.st_v0; *(bf16x8*)(V_lds + (bf) * SHM_V + vst1) = S.st_v1; } while (0)
#define SWRITE_H(bf) do { SWRITE_HV(bf); SWRITE_HK(bf); } while (0)
#define SLOAD_F(p, k0) do { S.sf0 = *(const f32x4*)ROW(p, k0, sr); S.sf1 = *(const f32x4*)(ROW(p, k0, sr) + 4);                \
                            S.sf2 = *(const f32x4*)ROW(p, k0, 32 + sr); S.sf3 = *(const f32x4*)(ROW(p, k0, 32 + sr) + 4); } while (0)
#define SWRITE_KF(bf) do { *(bf16x8*)(K_lds + (bf) * SHM_K + kws) = pack8(S.sf0, S.sf1); *(bf16x8*)(K_lds + (bf) * SHM_K + kws + 32 * 256) = pack8(S.sf2, S.sf3); } while (0)
#define SWRITE_VF(bf) do { *(bf16x8*)(V_lds + (bf) * SHM_V + vst0) = pack8(S.sf0, S.sf1); *(bf16x8*)(V_lds + (bf) * SHM_V + vst1) = pack8(S.sf2, S.sf3); } while (0)
template <class TIn, class TOut>
__device__ __forceinline__ void causal_swa_prime(const BlockRef<TIn, TOut>& cur, int W, char* lds, Seam<TIn>& S) {
    constexpr bool F32 = same_t<TIn, float>::v;
    const int tid = threadIdx.x, wid = __builtin_amdgcn_readfirstlane(tid >> 6), lane = tid & 63, r32 = lane & 31, hi = lane >> 5;
    const int sr = tid >> 4, sc = (tid & 15) * 8, kws = KSWZ(sr, sc * 2); char* K_lds = lds + 2 * SHM_V;
    const int kb0 = swa_jlo(cur.P0, W) * KVBLK;
    for (int d0 = 0; d0 < 8; ++d0) S.qr[d0] = load8<TIn>(cur.Q + (size_t)(wid * QBLK + r32) * D + d0 * 16 + hi * 8);
    if constexpr (F32) { SLOAD_F((const float*)cur.K, kb0); VMW(); SWRITE_KF(0); SBAR(); SLOAD_F((const float*)cur.V, kb0); }
    else { SLOAD_H(cur.K, cur.V, kb0); VMW(); SWRITE_HK(0); }
    __syncthreads();
}
template <class TIn, class TOut>
__device__ __forceinline__ void causal_swa_block(const BlockRef<TIn, TOut>& cur, const BlockRef<TIn, TOut>& nxt, int skv, int W, char* lds, Seam<TIn>& S) {
    constexpr bool F32 = same_t<TIn, float>::v;
    const int tid = threadIdx.x, wid = __builtin_amdgcn_readfirstlane(tid >> 6), lane = tid & 63, r32 = lane & 31, hi = lane >> 5;
    const int j_lo = swa_jlo(cur.P0, W);
    int j_hi = (cur.P0 + QB - 1) / KVBLK + 1; if (j_hi > skv / KVBLK) j_hi = skv / KVBLK;
    const int NT = j_hi - j_lo;
    const int kbn = swa_jlo(nxt.P0, W) * KVBLK;
    const int qlo = cur.P0 + wid * QBLK, qm = qlo + r32 - 4 * hi;
    char* V_lds = lds; char* K_lds = lds + 2 * SHM_V;
    float* ws = (float*)(lds + 2 * SHM_V + 2 * SHM_K) + wid * 64; float* li_l = ws, * al_l = ws + 32;
    float m_reg = -1e30f, l_reg = 0; f32x16 o[4] = {};
    const int sr = tid >> 4, sc = (tid & 15) * 8, vst0 = v_st(sr, sc), vst1 = v_st(32 + sr, sc), kws = KSWZ(sr, sc * 2);
    const int vb0 = (int)(uintptr_t)V_lds + v_rd_base(lane);
    const TIn* Kh = cur.K; const TIn* Vh = cur.V;
#define RESC(a) do { if (__any((a) < 1.f)) { if (hi == 0) al_l[r32] = (a); asm volatile("s_waitcnt lgkmcnt(0)" ::: "memory");              \
                     for (int d_ = 0; d_ < 4; ++d_) for (int r = 0; r < 16; ++r) o[d_][r] *= al_l[crow(r, hi)]; } } while (0)
#define KBASE(t) ((j_lo + (t)) * KVBLK)
#define ACT(t) (KBASE(t) <= qlo + QBLK - 1 && KBASE(t) + KVBLK - 1 >= qlo - W + 1)
#define MASKT(P0_, P1_, t) do { const int kb_ = KBASE(t); if ((!SK || ACT(t)) && (kb_ + KVBLK - 1 > qlo || kb_ <= qlo + QBLK - 1 - W)) mask_tile(P0_, P1_, qm - kb_, (unsigned)W); } while (0)
    constexpr int NQL = F32 ? 16 : 8;
    constexpr bool SK = WSKIP && !F32;
#define SEAM_K0() do { VMWN(NQL); if constexpr (F32) { SWRITE_KF(0); SBAR(); SLOAD_F((const float*)nxt.V, kbn); } else { SWRITE_HK(0); } SBAR(); } while (0)
    f32x16 pA0, pA1, pB0, pB1; float mnA, mnB, alA, alB; bf16x8 pa0, pa1, pa2, pa3;
    if constexpr (F32) { VMW(); SWRITE_VF(0); SBAR(); } else { SWRITE_HV(0); SBAR(); }
    if (NT > 1) { if constexpr (F32) SLOAD_F((const float*)Kh, KBASE(1)); else SLOAD_H(Kh, Vh, KBASE(1)); }
    SBAR(); qkt<0, SK>(pA0, pA1, K_lds, r32, hi, S.qr, ACT(0));
    if constexpr (F32) { if (NT > 1) { VMW(); SWRITE_KF(1); SBAR(); SLOAD_F((const float*)Vh, KBASE(1)); } }
    MASKT(pA0, pA1, 0); partialSM(pA0, pA1, m_reg, mnA, alA);
    if (NT > 1) { VMW(); if constexpr (F32) { SWRITE_VF(1); SBAR(); if (NT > 2) SLOAD_F((const float*)Kh, KBASE(2)); } else SWRITE_H(1); }
    __syncthreads();
#define HALF_STEP(PX0, PX1, mnX, alX, PY0, PY1, alY, t, KB, VB, SB) do {                                                      \
        SBAR(); qkt<KB, SK>(PX0, PX1, K_lds, r32, hi, S.qr, ACT(t));                                             \
        finishSM(PY0, PY1, alY, l_reg, pa0, pa1, pa2, pa3); SBAR();                                                           \
        if ((t) + 1 < NT) { if constexpr (F32) { VMW(); SWRITE_KF(SB); SBAR(); SLOAD_F((const float*)Vh, KBASE((t) + 1)); }  \
                            else { SLOAD_H(Kh, Vh, KBASE((t) + 1)); } SBAR(); }                                               \
        pv_tile<VB, SK>(o, vb0, pa0, pa1, pa2, pa3, ACT((t) - 1)); MASKT(PX0, PX1, (t)); partialSM(PX0, PX1, m_reg, mnX, alX);                                        \
        __syncthreads();                                                                                                      \
        if ((t) + 1 < NT) { VMW(); if constexpr (F32) { SWRITE_VF(SB); SBAR(); if ((t) + 2 < NT) SLOAD_F((const float*)Kh, KBASE((t) + 2)); } \
                            else { SWRITE_H(SB); } }                                                                          \
        RESC(alX); __syncthreads(); } while (0)
    for (int t = 1; t + 1 < NT; t += 2) {
        HALF_STEP(pB0, pB1, mnB, alB, pA0, pA1, alA, t, 1, 0, 0);
        HALF_STEP(pA0, pA1, mnA, alA, pB0, pB1, alB, t + 1, 0, 1, 1);
    }
    const bool even = (NT & 1) == 0;
    if (even) { SBAR(); qkt<1, SK>(pB0, pB1, K_lds, r32, hi, S.qr, ACT(NT - 1)); SBAR(); }
#define QROW(e) (nxt.Q + (size_t)(wid * QBLK + r32) * D + ((e) >> 1) * 16 + hi * 8 + ((e) & 1) * 4)
    if constexpr (F32) { SLOAD_F((const float*)nxt.K, kbn); SBAR();
#pragma unroll
        for (int e = 0; e < 8; ++e) S.tq[e] = *(const f32x4*)QROW(e); }
    else { SLOAD_H(nxt.K, nxt.V, kbn); SBAR();
#pragma unroll
        for (int d0 = 0; d0 < 8; ++d0) S.qr[d0] = load8<TIn>(nxt.Q + (size_t)(wid * QBLK + r32) * D + d0 * 16 + hi * 8); }
    SBAR();
    finishSM(pA0, pA1, alA, l_reg, pa0, pa1, pa2, pa3); SBAR();
    if constexpr (F32) {
#pragma unroll
        for (int e = 8; e < 16; ++e) S.tq[e] = *(const f32x4*)QROW(e); SBAR(); }
#undef QROW
    pv_tile<0, SK>(o, vb0, pa0, pa1, pa2, pa3, ACT(even ? NT - 2 : NT - 1));
    if (even) { MASKT(pB0, pB1, NT - 1); partialSM(pB0, pB1, m_reg, mnB, alB); __syncthreads(); RESC(alB);
        finishSM(pB0, pB1, alB, l_reg, pa0, pa1, pa2, pa3); SBAR(); pv_tile<1, SK>(o, vb0, pa0, pa1, pa2, pa3, ACT(NT - 1)); }
    SBAR(); SEAM_K0();
    if (hi == 0) li_l[r32] = l_reg; asm volatile("s_waitcnt lgkmcnt(0)" ::: "memory");
    float rli[16];
#pragma unroll
    for (int r = 0; r < 16; ++r) rli[r] = __builtin_amdgcn_rcpf(li_l[crow(r, hi)]);
    TOut* Ow = cur.O + (size_t)(wid * QBLK) * D;
#pragma unroll
    for (int r = 0; r < 16; ++r) { const int orow = crow(r, hi);
#pragma unroll
        for (int d0 = 0; d0 < 4; ++d0) { const float v = o[d0][r] * rli[r];
            if constexpr (same_t<TOut, float>::v) { Ow[(size_t)orow * D + d0 * 32 + r32] = v; }
            else { const float vn = __shfl_xor(v, 1);
                   if ((r32 & 1) == 0) *(unsigned*)(Ow + (size_t)orow * D + d0 * 32 + r32) = cvtpk(v, vn); } } }
    if constexpr (F32) {
#pragma unroll
        for (int d0 = 0; d0 < 8; ++d0) S.qr[d0] = pack8(S.tq[2 * d0], S.tq[2 * d0 + 1]); }
    __syncthreads();
#undef RESC
#undef KBASE
#undef ACT
#undef MASKT
#undef SEAM_K0
#undef HALF_STEP
}
#undef ROW
#undef VMW
#undef VMWN
#undef SLOAD_H
#undef SWRITE_HK
#undef SWRITE_HV
#undef SWRITE_H
#undef SLOAD_F
#undef SWRITE_KF
#undef SWRITE_VF
}
struct Ctx { LAS unsigned char* lds; int tid, lane, wave, vcu, G; };

__device__ __forceinline__ void tr_item(const float* __restrict__ src, size_t ldn, const float* __restrict__ gain, bfr* __restrict__ dst, int K,
                                        int k0, int nsrc0, int drow0, LAS float* scr, int lane) {
    const int r4 = lane >> 4, c4 = (lane & 15) * 4;
    f4v v[16];
#pragma unroll
    for (int i = 0; i < 16; ++i) v[i] = *(const f4v*)(src + (size_t)(k0 + 4 * i + r4) * ldn + nsrc0 + c4);
#pragma unroll
    for (int i = 0; i < 16; ++i) { const int k = 4 * i + r4; const float gk = gain ? gain[k0 + k] : 1.f;
        LAS float* s = scr + k * 65 + c4; s[0] = v[i][0] * gk; s[1] = v[i][1] * gk; s[2] = v[i][2] * gk; s[3] = v[i][3] * gk; }
    LDS_WAIT(); asm volatile("" ::: "memory");
    const int c = lane & 7;
#pragma unroll
    for (int jj = 0; jj < 8; ++jj) { const int n = (lane >> 3) + 8 * jj; const LAS float* s = scr + (8 * c) * 65 + n;
        u4v o; o.x = cvtpk(s[0 * 65], s[1 * 65]); o.y = cvtpk(s[2 * 65], s[3 * 65]); o.z = cvtpk(s[4 * 65], s[5 * 65]); o.w = cvtpk(s[6 * 65], s[7 * 65]);
        *(u4v*)(dst + (size_t)(drow0 + n) * K + k0 + 8 * c) = o; }
    LDS_WAIT(); asm volatile("" ::: "memory");
}
__device__ __forceinline__ void tr_item8(const float* __restrict__ src, size_t ldn, float sc, const float* __restrict__ gain, unsigned char* __restrict__ dst, int K, int k0, int nsrc0, int drow0, LAS float* scr, int lane) {
    const int r4 = lane >> 4, c4 = (lane & 15) * 4;
    f4v v[16];
#pragma unroll
    for (int i = 0; i < 16; ++i) v[i] = *(const f4v*)(src + (size_t)(k0 + 4 * i + r4) * ldn + nsrc0 + c4);
#pragma unroll
    for (int i = 0; i < 16; ++i) { const int k = 4 * i + r4; const float gk = gain ? gain[k0 + k] * sc : sc; LAS float* s = scr + k * 65 + c4; s[0] = v[i][0] * gk; s[1] = v[i][1] * gk; s[2] = v[i][2] * gk; s[3] = v[i][3] * gk; }
    LDS_WAIT(); asm volatile("" ::: "memory");
    const int c = lane & 3;
#pragma unroll
    for (int jj = 0; jj < 4; ++jj) { const int n = (lane >> 2) + 16 * jj; const LAS float* s = scr + (16 * c) * 65 + n;
        u4v o; o.x = cvt4_fp8(s[0 * 65], s[1 * 65], s[2 * 65], s[3 * 65]); o.y = cvt4_fp8(s[4 * 65], s[5 * 65], s[6 * 65], s[7 * 65]);
        o.z = cvt4_fp8(s[8 * 65], s[9 * 65], s[10 * 65], s[11 * 65]); o.w = cvt4_fp8(s[12 * 65], s[13 * 65], s[14 * 65], s[15 * 65]);
        *(u4v*)(dst + (size_t)(drow0 + n) * K + k0 + 16 * c) = o; }
    LDS_WAIT(); asm volatile("" ::: "memory");
}
__device__ __forceinline__ void tr_job8(const float* __restrict__ src, size_t ldn, float sc, const float* __restrict__ gain, unsigned char* __restrict__ dst, int K, int ncols, LAS float* scr, int lane, int gw, int NGW, int nsrc0 = 0) {
    const int nn = ncols / 64, ni = (K / 64) * nn;
    for (int it = gw; it < ni; it += NGW) { const int kb = it / nn, nb = it - kb * nn; tr_item8(src, ldn, sc, gain, dst, K, kb * 64, nsrc0 + nb * 64, nb * 64, scr, lane); }
}
__device__ __forceinline__ void tr_job(const float* __restrict__ src, size_t ldn, const float* __restrict__ gain, bfr* __restrict__ dst, int K, int ncols, int nsrc0, int drow0,
                                       LAS float* scr, int lane, int gw, int NGW) {
    const int nn = ncols / 64, ni = (K / 64) * nn;
    for (int it = gw; it < ni; it += NGW) { const int kb = it / nn, nb = it - kb * nn;
        tr_item(src, ldn, gain, dst, K, kb * 64, nsrc0 + nb * 64, drow0 + nb * 64, scr, lane); }
}
struct KArgs {
    const float* in[26]; float* out; unsigned char* ws; int ph_lo, ph_hi, li, pad;
};
struct Ptrs {
    LAS unsigned long long* tbl;
    __device__ __forceinline__ unsigned long long get(int k) const { const unsigned long long v = tbl[k];
        return ((unsigned long long)(unsigned)__builtin_amdgcn_readfirstlane((int)(unsigned)(v >> 32)) << 32) | (unsigned)__builtin_amdgcn_readfirstlane((int)(unsigned)v); }
    __device__ __forceinline__ const float* in_(int k) const { return (const float*)get(k); }
    __device__ __forceinline__ float* out_() const { return (float*)get(26); }
    __device__ __forceinline__ unsigned char* ws_() const { return (unsigned char*)get(27); }
};
__device__ __forceinline__ void p_convert(const Ctx& C, const Ptrs& P) {
    LAS float* scr = (LAS float*)(C.lds + C.wave * 16640);
    const int gw = C.vcu * 8 + C.wave, NGW = C.G * 8;
    unsigned char* ws = P.ws_();
#if F8_PROJ0 == 1
    tr_job8(P.in_(2), (size_t)GIN, SU, P.in_(1), ws + WS_WTIN, DM, 16384, scr, C.lane, gw, NGW);
#elif F8_PROJ0 == 2
    tr_job(P.in_(2), (size_t)GIN, P.in_(1), (bfr*)(ws + WS_WTIN), DM, 8192, 0, 0, scr, C.lane, gw, NGW);
    tr_job8(P.in_(2), (size_t)GIN, SU, P.in_(1), ws + WS_WTIN + (size_t)8192 * DM * 2, DM, 8192, scr, C.lane, gw, NGW, 8192);
#elif F8_PROJ0 == 3
    tr_job8(P.in_(2), (size_t)GIN, SU, P.in_(1), ws + WS_WTIN, DM, 8192, scr, C.lane, gw, NGW, 0);
    tr_job(P.in_(2), (size_t)GIN, P.in_(1), (bfr*)(ws + WS_WTIN + (size_t)8192 * DM), DM, 8192, 8192, 0, scr, C.lane, gw, NGW);
#else
    tr_job(P.in_(2), (size_t)GIN, P.in_(1), (bfr*)(ws + WS_WTIN), DM, 16384, 0, 0, scr, C.lane, gw, NGW);
#endif
    tr_job(P.in_(2), (size_t)GIN, P.in_(1), (bfr*)(ws + WS_WTBD), DM, 64, 16384, 0, scr, C.lane, gw, NGW);
    tr_job(P.in_(7), (size_t)DM, nullptr, (bfr*)(ws + WS_WTOUT), DM, DM, 0, 0, scr, C.lane, gw, NGW);
#if F8_KVQ
    tr_job8(P.in_(9), (size_t)8192, SU, P.in_(8), ws + WS_WTKVQ, DM, DM, scr, C.lane, gw, NGW, 0);
    tr_job8(P.in_(12), (size_t)DM, SU, P.in_(11), ws + WS_WTKVQ + (size_t)DM * DM, DM, DM, scr, C.lane, gw, NGW, 0);
    tr_job(P.in_(9), (size_t)8192, P.in_(8), (bfr*)(ws + WS_WTKVQ + (size_t)2 * DM * DM), DM, DM, DM, 0, scr, C.lane, gw, NGW);
#else
    tr_job(P.in_(9), (size_t)8192, P.in_(8), (bfr*)(ws + WS_WTKVQ), DM, 8192, 0, 0, scr, C.lane, gw, NGW);
    tr_job(P.in_(12), (size_t)DM, P.in_(11), (bfr*)(ws + WS_WTKVQ), DM, DM, 0, 8192, scr, C.lane, gw, NGW);
#endif
    tr_job(P.in_(19), (size_t)DM, nullptr, (bfr*)(ws + WS_WTO), DM, DM, 0, 0, scr, C.lane, gw, NGW);
    tr_job(P.in_(21), (size_t)PQ, P.in_(20), (bfr*)(ws + WS_WTQRY), DM, PQ, 0, 0, scr, C.lane, gw, NGW);
    tr_job(P.in_(21) + (size_t)DM * PQ, (size_t)PQ, P.in_(20) + DM, (bfr*)(ws + WS_WTQRY) + (size_t)PQ * DM, DM, PQ, 0, 0, scr, C.lane, gw, NGW);
    tr_job8(P.in_(25), (size_t)DM, SV, nullptr, ws + WS_VT, PE, DM, scr, C.lane, gw, NGW);
    tr_job8(P.in_(25) + (size_t)PE * DM, (size_t)DM, SV, nullptr, ws + WS_VT + (size_t)DM * PE, PE, DM, scr, C.lane, gw, NGW);
    {
        const size_t gt = (size_t)C.vcu * 512 + C.tid, GT = (size_t)C.G * 512;
        for (int l = 0; l < 2; ++l) {
            const float* src = P.in_(24) + (size_t)l * PE * DM; const float* gain = P.in_(20) + l * DM; unsigned char* dst = ws + WS_U + (size_t)l * PE * DM;
            for (size_t i = gt; i < (size_t)PE * DM / 16; i += GT) {
                const f4v a = *(const f4v*)(src + i * 16), b = *(const f4v*)(src + i * 16 + 4), c = *(const f4v*)(src + i * 16 + 8), d = *(const f4v*)(src + i * 16 + 12);
                const int dd = (int)((i * 16) & (DM - 1)); const f4v ga = *(const f4v*)(gain + dd) * SU, gb = *(const f4v*)(gain + dd + 4) * SU, gc = *(const f4v*)(gain + dd + 8) * SU, gd = *(const f4v*)(gain + dd + 12) * SU;
                u4v o; o.x = cvt4_fp8(a[0] * ga[0], a[1] * ga[1], a[2] * ga[2], a[3] * ga[3]); o.y = cvt4_fp8(b[0] * gb[0], b[1] * gb[1], b[2] * gb[2], b[3] * gb[3]);
                o.z = cvt4_fp8(c[0] * gc[0], c[1] * gc[1], c[2] * gc[2], c[3] * gc[3]); o.w = cvt4_fp8(d[0] * gd[0], d[1] * gd[1], d[2] * gd[2], d[3] * gd[3]);
                *(u4v*)(dst + i * 16) = o; }
        }
        for (int l = 0; l < 2; ++l) {
            bfr* dst = (bfr*)(ws + WS_WTKEY) + (size_t)l * PQ * PQ;
            for (size_t i = gt; i < (size_t)PQ * PQ / 8; i += GT) {
                const int row = (int)((i * 8) / PQ), col = (int)((i * 8) % PQ); u4v o = {0u, 0u, 0u, 0u};
                if ((row >> 7) == (col >> 7)) { const int blk = row >> 7, h = blk >> 1, half = blk & 1, n = row & 127, d = col & 127;
                    const float* src = (half ? P.in_(23) : P.in_(22)) + (((size_t)l * PH + h) * PK + n) * 128 + d;
                    const f4v a = *(const f4v*)src, b = *(const f4v*)(src + 4);
                    o.x = cvtpk(a[0], a[1]); o.y = cvtpk(a[2], a[3]); o.z = cvtpk(b[0], b[1]); o.w = cvtpk(b[2], b[3]); }
                *(u4v*)(dst + i * 8) = o; }
        }
    }
}

__device__ __forceinline__ void p_norm_rows(const Ctx& C, const float* __restrict__ src, bfr* __restrict__ dst, unsigned char* __restrict__ dst8) {
    const int gw = C.vcu * 8 + C.wave, NGW = C.G * 8;
    for (int row = gw; row < NT; row += NGW) {
        const f4v* p = (const f4v*)(src + (size_t)row * DM);
        f4v a[8], b[8]; float ss = 0.f;
#pragma unroll
        for (int j = 0; j < 8; ++j) { a[j] = p[j * 128 + 2 * C.lane]; b[j] = p[j * 128 + 2 * C.lane + 1]; }
#pragma unroll
        for (int j = 0; j < 8; ++j) ss += (a[j][0] * a[j][0] + a[j][1] * a[j][1]) + (a[j][2] * a[j][2] + a[j][3] * a[j][3]) + (b[j][0] * b[j][0] + b[j][1] * b[j][1]) + (b[j][2] * b[j][2] + b[j][3] * b[j][3]);
        const float r = __builtin_amdgcn_rsqf(wave_sum(ss) * (1.f / DM) + EPS);
        u4v* o = (u4v*)(dst + (size_t)row * DM);
#pragma unroll
        for (int j = 0; j < 8; ++j) { u4v w; w.x = cvtpk(a[j][0] * r, a[j][1] * r); w.y = cvtpk(a[j][2] * r, a[j][3] * r); w.z = cvtpk(b[j][0] * r, b[j][1] * r); w.w = cvtpk(b[j][2] * r, b[j][3] * r);
            o[j * 64 + C.lane] = w;
            if (dst8) { u2v w8; w8.x = cvt4_fp8(a[j][0] * r, a[j][1] * r, a[j][2] * r, a[j][3] * r); w8.y = cvt4_fp8(b[j][0] * r, b[j][1] * r, b[j][2] * r, b[j][3] * r); ((u2v*)(dst8 + (size_t)row * DM))[j * 64 + C.lane] = w8; } }
    }
}

__device__ __forceinline__ void p_bd(const Ctx& C, const bfr* __restrict__ XN, const bfr* __restrict__ WB, float* __restrict__ BD) {
    LAS float* red = (LAS float*)C.lds;
    const int r = C.lane & 15, q = C.lane >> 4, rt = C.wave >> 2, kq = C.wave & 3;
    for (int blk = C.vcu; blk < NT / 32; blk += C.G) {
        const bfr* ap = XN + (size_t)(blk * 32 + rt * 16 + r) * DM + kq * 1024 + q * 8;
        const bfr* bp = WB + (size_t)r * DM + kq * 1024 + q * 8;
        f4v acc[4] = {zero_acc(), zero_acc(), zero_acc(), zero_acc()};
#pragma unroll 4
        for (int ks = 0; ks < 32; ++ks) {
            const s8v a = *(const s8v*)(ap + ks * 32);
#pragma unroll
            for (int nt = 0; nt < 4; ++nt) { const s8v b = *(const s8v*)(bp + (size_t)nt * 16 * DM + ks * 32); acc[nt] = __builtin_amdgcn_mfma_f32_16x16x32_bf16(a, b, acc[nt], 0, 0, 0); }
            MFMA_SETTLE(acc[0]); MFMA_SETTLE(acc[1]); MFMA_SETTLE(acc[2]); MFMA_SETTLE(acc[3]);
        }
        MFMA_SETTLE(acc[0]); MFMA_SETTLE(acc[1]); MFMA_SETTLE(acc[2]); MFMA_SETTLE(acc[3]);
#pragma unroll
        for (int nt = 0; nt < 4; ++nt)
#pragma unroll
            for (int i = 0; i < 4; ++i) red[C.wave * 1024 + (4 * q + i) * 64 + nt * 16 + r] = -acc[nt][i];
        __syncthreads();
#pragma unroll
        for (int i = 0; i < 4; ++i) { const int idx = C.tid * 4 + i, t2 = idx >> 10, rem = idx & 1023;
            const float s = -((red[(t2 * 4 + 0) * 1024 + rem] + red[(t2 * 4 + 1) * 1024 + rem]) + (red[(t2 * 4 + 2) * 1024 + rem] + red[(t2 * 4 + 3) * 1024 + rem]));
            BD[(size_t)(blk * 32 + t2 * 16 + (rem >> 6)) * 64 + (rem & 63)] = s; }
        __syncthreads();
    }
}
__device__ __forceinline__ int kq_off(int row, int chunk) { return row * 256 + ((chunk ^ (row & 7)) << 4); }
__device__ __forceinline__ int xt_off(int col, int chunk) { return col * 128 + ((chunk ^ (col & 7)) << 4); }
__device__ __forceinline__ void p_gdn_prep(const Ctx& C, const Ptrs& P) {
    unsigned char* ws = P.ws_();
    const bfr* PROJ = (const bfr*)(ws + WS_BIG); const float* BD = (const float*)(ws + WS_BD);
    const float* convw = P.in_(3); const float* alog = P.in_(4); const float* dtb = P.in_(5);
    bfr* Wg = (bfr*)(ws + WS_R + R_W); bfr* Ug = (bfr*)(ws + WS_R + R_U); bfr* QGg = (bfr*)(ws + WS_R + R_QG); bfr* KDg = (bfr*)(ws + WS_R + R_KD); bfr* QKg = (bfr*)(ws + WS_R + R_QK);
    float* EGg = (float*)(ws + WS_EG);
    LAS float* sCW = (LAS float*)(C.lds + 82944);
    for (int wq = C.vcu; wq < NB * GH * 4; wq += C.G) {
        const int bh = wq >> 2, cg = wq & 3, h = bh & 31, b = bh >> 5;
        for (int i = C.tid; i < 1536; i += 512) { const int part = i >> 9, tap = (i >> 7) & 3, ch = i & 127; sCW[i] = convw[tap * 12288 + part * 4096 + h * 128 + ch]; }
        __syncthreads();
        for (int it = 0; it < 8; ++it) {
            int tid = C.tid; asm volatile("" : "+v"(tid));
            const int hw = tid >> 8, lt = tid & 255, lane = tid & 63, lw = (tid >> 6) & 3;
            const int c = cg * 16 + it * 2 + hw, unit = bh * 64 + c, t0 = b * SEQ + c * CH;
            LAS unsigned char* hb = C.lds + hw * 41472;
            LAS unsigned char* sK = hb; LAS unsigned char* sQ = hb + 16384; LAS unsigned char* sX = hb;
            LAS unsigned char* sAM = hb + 32768; LAS float* sB = (LAS float*)(hb + 40960); LAS float* sG = (LAS float*)(hb + 41216);
            LAS float* scr = (LAS float*)(C.lds + 89088 + (tid >> 6) * 4352);
            LAS float* sAD = (LAS float*)(C.lds + 123904 + hw * 4096);
            if (lt < 64) {
                const int t = t0 + lt; const float braw = BD[(size_t)t * 64 + h], araw = BD[(size_t)t * 64 + 32 + h];
                const float beta = 1.f / (1.f + expf(-braw)); const float xx = araw + dtb[h]; const float sp = fmaxf(xx, 0.f) + log1pf(expf(-fabsf(xx)));
                float g = -expf(alog[h]) * sp;
#pragma unroll
                for (int o = 1; o < 64; o <<= 1) { const float y = __shfl_up(g, o); if (lane >= o) g += y; }
                sB[lt] = beta; sG[lt] = g;
            }
            __syncthreads();
            const int tk = lt >> 2, cs = lt & 3;
            const float beta = sB[tk], gc = sG[tk], gl = sG[63]; const float eg = expf(gc), ed = expf(gl - gc), bg = beta * eg;
            u4v kbg[4], vbt[4];
#pragma unroll
            for (int part = 0; part < 3; ++part) {
                float y[32];
#pragma unroll
                for (int i = 0; i < 32; ++i) y[i] = 0.f;
#pragma unroll
                for (int j = 0; j < 4; ++j) {
                    const int s = c * CH + tk - 3 + j;
                    if (s >= 0) {
                        const bfr* row = PROJ + (size_t)(b * SEQ + s) * 16384 + part * 4096 + h * 128 + cs * 32;
#pragma unroll
                        for (int q4 = 0; q4 < 4; ++q4) { const u4v x = *(const u4v*)(row + 8 * q4); const LAS float* wp = sCW + part * 512 + j * 128 + cs * 32 + 8 * q4;
                            const f4v w0 = *(const LAS f4v*)wp, w1 = *(const LAS f4v*)(wp + 4);
                            y[8 * q4 + 0] += bflo(x.x) * w0[0]; y[8 * q4 + 1] += bfhi(x.x) * w0[1]; y[8 * q4 + 2] += bflo(x.y) * w0[2]; y[8 * q4 + 3] += bfhi(x.y) * w0[3];
                            y[8 * q4 + 4] += bflo(x.z) * w1[0]; y[8 * q4 + 5] += bfhi(x.z) * w1[1]; y[8 * q4 + 6] += bflo(x.w) * w1[2]; y[8 * q4 + 7] += bfhi(x.w) * w1[3]; }
                    }
                }
                float ss = 0.f;
#pragma unroll
                for (int i = 0; i < 32; ++i) { y[i] = y[i] * __builtin_amdgcn_rcpf(1.f + __expf(-y[i])); ss += y[i] * y[i]; }
                if (part < 2) {
                    ss += __shfl_xor(ss, 1); ss += __shfl_xor(ss, 2);
                    const float rn = __builtin_amdgcn_rsqf(ss + EPS) * (part == 0 ? 0.08838834764831845f : 1.f); const float gs = part == 0 ? eg : ed;
                    LAS unsigned char* dstl = part == 0 ? sQ : sK; bfr* dstg = (part == 0 ? QGg : KDg) + (size_t)unit * 8192 + tk * 128 + cs * 32;
#pragma unroll
                    for (int q4 = 0; q4 < 4; ++q4) { float z[8];
#pragma unroll
                        for (int i = 0; i < 8; ++i) z[i] = y[8 * q4 + i] * rn;
                        u4v w; w.x = cvtpk(z[0], z[1]); w.y = cvtpk(z[2], z[3]); w.z = cvtpk(z[4], z[5]); w.w = cvtpk(z[6], z[7]);
                        *(LAS u4v*)(dstl + kq_off(tk, cs * 4 + q4)) = w;
                        u4v g; g.x = cvtpk(z[0] * gs, z[1] * gs); g.y = cvtpk(z[2] * gs, z[3] * gs); g.z = cvtpk(z[4] * gs, z[5] * gs); g.w = cvtpk(z[6] * gs, z[7] * gs);
                        *(u4v*)(dstg + 8 * q4) = g;
                        if (part == 1) { kbg[q4].x = cvtpk(z[0] * bg, z[1] * bg); kbg[q4].y = cvtpk(z[2] * bg, z[3] * bg); kbg[q4].z = cvtpk(z[4] * bg, z[5] * bg); kbg[q4].w = cvtpk(z[6] * bg, z[7] * bg); } }
                } else {
#pragma unroll
                    for (int q4 = 0; q4 < 4; ++q4) { vbt[q4].x = cvtpk(y[8 * q4] * beta, y[8 * q4 + 1] * beta); vbt[q4].y = cvtpk(y[8 * q4 + 2] * beta, y[8 * q4 + 3] * beta);
                        vbt[q4].z = cvtpk(y[8 * q4 + 4] * beta, y[8 * q4 + 5] * beta); vbt[q4].w = cvtpk(y[8 * q4 + 6] * beta, y[8 * q4 + 7] * beta); }
                }
            }
            __syncthreads();
            {
                const int r = lane & 15, q = lane >> 4, mt = lw;
                s8v ak[4], aq[4];
#pragma unroll
                for (int ks = 0; ks < 4; ++ks) { ak[ks] = *(const LAS s8v*)(sK + kq_off(16 * mt + r, 4 * ks + q)); aq[ks] = *(const LAS s8v*)(sQ + kq_off(16 * mt + r, 4 * ks + q)); }
                float gi[4], bi[4];
#pragma unroll
                for (int e = 0; e < 4; ++e) { gi[e] = sG[16 * mt + 4 * q + e]; bi[e] = sB[16 * mt + 4 * q + e]; }
                for (int nt = 0; nt < 4; ++nt) {
                    const int j = 16 * nt + r;
                    if (nt <= mt) {
                        f4v ck = zero_acc(), cq = zero_acc();
#pragma unroll
                        for (int ks = 0; ks < 4; ++ks) { const s8v bb = *(const LAS s8v*)(sK + kq_off(16 * nt + r, 4 * ks + q));
                            ck = __builtin_amdgcn_mfma_f32_16x16x32_bf16(ak[ks], bb, ck, 0, 0, 0); cq = __builtin_amdgcn_mfma_f32_16x16x32_bf16(aq[ks], bb, cq, 0, 0, 0); }
                        MFMA_SETTLE(ck); MFMA_SETTLE(cq);
                        const float gj = sG[j];
#pragma unroll
                        for (int e = 0; e < 4; ++e) { const int i = 16 * mt + 4 * q + e; const float dec = expf(fminf(gi[e] - gj, 0.f));
                            const float av = (i > j) ? bi[e] * ck[e] * dec : 0.f;
                            *(LAS bfr*)(sAM + xt_off(i, j >> 3) + (j & 7) * 2) = f2bf1(av);
                            if (nt == mt) sAD[mt * 256 + (4 * q + e) * 16 + r] = av;
                            QKg[(size_t)unit * 4096 + i * 64 + j] = f2bf1((i >= j) ? cq[e] * dec : 0.f); }
                    } else {
#pragma unroll
                        for (int e = 0; e < 4; ++e) QKg[(size_t)unit * 4096 + (16 * mt + 4 * q + e) * 64 + j] = (bfr)0;
                    }
                }
            }
            __syncthreads();
            {
                const int ro = ((tk >> 3)), rb = (tk & 7) * 2;
#pragma unroll
                for (int q4 = 0; q4 < 4; ++q4) {
                    const unsigned vv[4] = {vbt[q4].x, vbt[q4].y, vbt[q4].z, vbt[q4].w}, kk[4] = {kbg[q4].x, kbg[q4].y, kbg[q4].z, kbg[q4].w};
#pragma unroll
                    for (int i = 0; i < 8; ++i) { const int ch = cs * 32 + q4 * 8 + i;
                        *(LAS bfr*)(sX + xt_off(ch, ro) + rb) = (bfr)((i & 1) ? (vv[i >> 1] >> 16) : (vv[i >> 1] & 0xffffu));
                        *(LAS bfr*)(sX + xt_off(128 + ch, ro) + rb) = (bfr)((i & 1) ? (kk[i >> 1] >> 16) : (kk[i >> 1] & 0xffffu)); }
                }
            }
            __syncthreads();
            {
                const int r = lane & 15, q = lane >> 4;
                float x[64];
#pragma unroll
                for (int bk = 0; bk < 4; ++bk) {
                    float corr[16];
#pragma unroll
                    for (int i = 0; i < 16; ++i) corr[i] = 0.f;
                    if (bk > 0) {
                        f4v acc[4] = {zero_acc(), zero_acc(), zero_acc(), zero_acc()};
#pragma unroll
                        for (int ks = 0; ks < (16 * bk + 31) / 32; ++ks) {
                            s8v a = *(const LAS s8v*)(sAM + xt_off(16 * bk + r, 4 * ks + q));
                            if (32 * ks + 8 * q >= 16 * bk) a = (s8v){0, 0, 0, 0, 0, 0, 0, 0};
#pragma unroll
                            for (int nt = 0; nt < 4; ++nt) { const s8v bx = *(const LAS s8v*)(sX + xt_off(64 * lw + 16 * nt + r, 4 * ks + q)); acc[nt] = __builtin_amdgcn_mfma_f32_16x16x32_bf16(a, bx, acc[nt], 0, 0, 0); }
                        }
                        MFMA_SETTLE(acc[0]); MFMA_SETTLE(acc[1]); MFMA_SETTLE(acc[2]); MFMA_SETTLE(acc[3]);
#pragma unroll
                        for (int nt = 0; nt < 4; ++nt)
#pragma unroll
                            for (int e = 0; e < 4; ++e) scr[(16 * nt + r) * 17 + 4 * q + e] = -acc[nt][e];
                        LDS_WAIT(); asm volatile("" ::: "memory");
#pragma unroll
                        for (int i = 0; i < 16; ++i) corr[i] = scr[lane * 17 + i];
                    }
                    const u4v r0 = *(const LAS u4v*)(sX + xt_off(lt, 2 * bk)), r1 = *(const LAS u4v*)(sX + xt_off(lt, 2 * bk + 1));
                    const float rhs[16] = {bflo(r0.x), bfhi(r0.x), bflo(r0.y), bfhi(r0.y), bflo(r0.z), bfhi(r0.z), bflo(r0.w), bfhi(r0.w), bflo(r1.x), bfhi(r1.x), bflo(r1.y), bfhi(r1.y), bflo(r1.z), bfhi(r1.z), bflo(r1.w), bfhi(r1.w)};
                    float xb[16];
#pragma unroll
                    for (int i = 0; i < 16; ++i) {
                        float v = rhs[i] + corr[i];
                        const u4v a0 = *(const LAS u4v*)(sAM + xt_off(16 * bk + i, 2 * bk)), a1 = *(const LAS u4v*)(sAM + xt_off(16 * bk + i, 2 * bk + 1));
                        const float am[16] = {bflo(a0.x), bfhi(a0.x), bflo(a0.y), bfhi(a0.y), bflo(a0.z), bfhi(a0.z), bflo(a0.w), bfhi(a0.w), bflo(a1.x), bfhi(a1.x), bflo(a1.y), bfhi(a1.y), bflo(a1.z), bfhi(a1.z), bflo(a1.w), bfhi(a1.w)};
#pragma unroll
                        for (int j = 0; j < 16; ++j) if (j < i) v -= am[j] * xb[j];
                        xb[i] = v; x[16 * bk + i] = v;
                    }
                    u4v w0, w1; w0.x = cvtpk(xb[0], xb[1]); w0.y = cvtpk(xb[2], xb[3]); w0.z = cvtpk(xb[4], xb[5]); w0.w = cvtpk(xb[6], xb[7]);
                    w1.x = cvtpk(xb[8], xb[9]); w1.y = cvtpk(xb[10], xb[11]); w1.z = cvtpk(xb[12], xb[13]); w1.w = cvtpk(xb[14], xb[15]);
                    *(LAS u4v*)(sX + xt_off(lt, 2 * bk)) = w0; *(LAS u4v*)(sX + xt_off(lt, 2 * bk + 1)) = w1;
                    LDS_WAIT(); asm volatile("" ::: "memory");
                }
                bfr* dst = (lt < 128 ? Ug : Wg) + (size_t)unit * 8192 + (lt & 127);
#pragma unroll
                for (int i = 0; i < 64; ++i) dst[i * 128] = f2bf1(x[i]);
                if (lt == 0) EGg[unit] = expf(sG[63]);
            }
            __syncthreads();
        }
    }
}

__device__ __forceinline__ void p_gdn_scan(const Ctx& C, const Ptrs& P) {
    unsigned char* ws = P.ws_();
    const GAS bfr* Wg = (const GAS bfr*)(ws + WS_R + R_W); const GAS bfr* Ug = (const GAS bfr*)(ws + WS_R + R_U); const GAS bfr* QGg = (const GAS bfr*)(ws + WS_R + R_QG); const GAS bfr* KDg = (const GAS bfr*)(ws + WS_R + R_KD);
    const GAS bfr* QKg = (const GAS bfr*)(ws + WS_R + R_QK); GAS bfr* Og = (GAS bfr*)(ws + WS_R + R_O); const GAS float* EGg = (const GAS float*)(ws + WS_EG);
    const int tid = C.tid, lane = C.lane, wave = C.wave, r = lane & 15, q = lane >> 4, mt = wave & 3, nt = wave >> 2;
    LAS bfr* sST = (LAS bfr*)(C.lds + 131072); LAS bfr* sVN = (LAS bfr*)(C.lds + 139776);
#define SC_W(bb)  ((LAS bfr*)(C.lds + (bb) * 65536))
#define SC_QG(bb) ((LAS bfr*)(C.lds + (bb) * 65536 + 17408))
#define SC_KD(bb) ((LAS bfr*)(C.lds + (bb) * 65536 + 34816))
#define SC_QK(bb) ((LAS bfr*)(C.lds + (bb) * 65536 + 52224))
#define SC_U(bb)  ((LAS bfr*)(C.lds + (bb) * 65536 + 61440))
#define SC_LOAD(n) do { const size_t ub = (size_t)(bh * 64 + (n)) * 8192; \
        rW0 = *(const GAS u4v*)(Wg + ub + (size_t)tid * 8); rW1 = *(const GAS u4v*)(Wg + ub + (size_t)(tid + 512) * 8); \
        rQ0 = *(const GAS u4v*)(QGg + ub + (size_t)tid * 8); rQ1 = *(const GAS u4v*)(QGg + ub + (size_t)(tid + 512) * 8); \
        rK0 = *(const GAS u4v*)(KDg + ub + (size_t)tid * 8); rK1 = *(const GAS u4v*)(KDg + ub + (size_t)(tid + 512) * 8); \
        rQK = *(const GAS u4v*)(QKg + (size_t)(bh * 64 + (n)) * 4096 + (size_t)tid * 8); \
        if (tid < 256) rU = *(const GAS u4v*)(Ug + ub + (size_t)(tid >> 2) * 128 + es * 32 + (tid & 3) * 8); } while (0)
#define SC_WRITE(bb) do { const int c0 = tid, c1 = tid + 512; \
        *(LAS u4v*)(SC_W(bb) + (c0 >> 4) * 136 + (c0 & 15) * 8) = rW0; *(LAS u4v*)(SC_W(bb) + (c1 >> 4) * 136 + (c1 & 15) * 8) = rW1; \
        *(LAS u4v*)(SC_QG(bb) + (c0 >> 4) * 136 + (c0 & 15) * 8) = rQ0; *(LAS u4v*)(SC_QG(bb) + (c1 >> 4) * 136 + (c1 & 15) * 8) = rQ1; \
        *(LAS u4v*)(SC_KD(bb) + (c0 >> 4) * 136 + (c0 & 15) * 8) = rK0; *(LAS u4v*)(SC_KD(bb) + (c1 >> 4) * 136 + (c1 & 15) * 8) = rK1; \
        *(LAS u4v*)(SC_QK(bb) + (tid >> 3) * 72 + (tid & 7) * 8) = rQK; \
        if (tid < 256) *(LAS u4v*)(SC_U(bb) + (tid >> 2) * 32 + (tid & 3) * 8) = rU; } while (0)
    for (int task = C.vcu; task < NB * GH * 4; task += C.G) {
        const int bh = task >> 2, es = task & 3, h = bh & 31, b = bh >> 5;
        u4v rW0, rW1, rQ0, rQ1, rK0, rK1, rQK, rU = {0u, 0u, 0u, 0u};
        f4v S0 = {0.f, 0.f, 0.f, 0.f}, S1 = {0.f, 0.f, 0.f, 0.f};
        LAS float* sEG = (LAS float*)(C.lds + 144384);
        if (tid < 64) sEG[tid] = EGg[bh * 64 + tid];
        SC_LOAD(0); SC_WRITE(0); SC_LOAD(1);
        for (int n = 0; n < NCH; ++n) {
            const int bb = n & 1;
            {
                MFMA_SETTLE(S0); MFMA_SETTLE(S1);
                u2v w0, w1; w0.x = cvtpk(S0[0], S0[1]); w0.y = cvtpk(S0[2], S0[3]); w1.x = cvtpk(S1[0], S1[1]); w1.y = cvtpk(S1[2], S1[3]);
                *(LAS u2v*)(sST + (r) * 136 + 16 * wave + 4 * q) = w0; *(LAS u2v*)(sST + (16 + r) * 136 + 16 * wave + 4 * q) = w1;
            }
            __syncthreads();
            if (n + 1 < NCH) { if (bb) SC_WRITE(0); else SC_WRITE(1); if (n + 2 < NCH) SC_LOAD(n + 2); }
            f4v acc1 = zero_acc(), acc2 = zero_acc();
            const LAS bfr* pW = SC_W(bb) + (16 * mt + r) * 136 + 8 * q; const LAS bfr* pQ = SC_QG(bb) + (16 * mt + r) * 136 + 8 * q; const LAS bfr* pS = sST + (16 * nt + r) * 136 + 8 * q;
#pragma unroll
            for (int ks = 0; ks < 4; ++ks) { const s8v a1 = *(const LAS s8v*)(pW + 32 * ks), a2 = *(const LAS s8v*)(pQ + 32 * ks), bs = *(const LAS s8v*)(pS + 32 * ks);
                acc1 = __builtin_amdgcn_mfma_f32_16x16x32_bf16(a1, bs, acc1, 0, 0, 0); acc2 = __builtin_amdgcn_mfma_f32_16x16x32_bf16(a2, bs, acc2, 0, 0, 0); }
            MFMA_SETTLE(acc1);
            {
                const LAS bfr* pU = SC_U(bb) + (16 * mt + 4 * q) * 32 + 16 * nt + r;
                const float v0 = bf1(pU[0]) - acc1[0], v1 = bf1(pU[32]) - acc1[1], v2 = bf1(pU[64]) - acc1[2], v3 = bf1(pU[96]) - acc1[3];
                u2v w; w.x = cvtpk(v0, v1); w.y = cvtpk(v2, v3);
                *(LAS u2v*)(sVN + (16 * nt + r) * 72 + 16 * mt + 4 * q) = w;
            }
            __syncthreads();
            {
                const LAS bfr* pA = SC_QK(bb) + (16 * mt + r) * 72 + 8 * q; const LAS bfr* pV = sVN + (16 * nt + r) * 72 + 8 * q;
#pragma unroll
                for (int ks = 0; ks < 2; ++ks) { const s8v a = *(const LAS s8v*)(pA + 32 * ks), bv = *(const LAS s8v*)(pV + 32 * ks); acc2 = __builtin_amdgcn_mfma_f32_16x16x32_bf16(a, bv, acc2, 0, 0, 0); }
                MFMA_SETTLE(acc2);
                GAS bfr* po = Og + (size_t)(b * SEQ + n * CH + 16 * mt + 4 * q) * DM + h * 128 + es * 32 + 16 * nt + r;
                po[0] = f2bf1(acc2[0]); po[DM] = f2bf1(acc2[1]); po[2 * DM] = f2bf1(acc2[2]); po[3 * DM] = f2bf1(acc2[3]);
            }
            {
                const float eg = sEG[n];
                S0 *= eg; S1 *= eg;
                const LAS bfr* pK = SC_KD(bb) + (8 * q) * 136 + 16 * wave + r; const LAS bfr* pV0 = sVN + r * 72 + 8 * q; const LAS bfr* pV1 = sVN + (16 + r) * 72 + 8 * q;
#pragma unroll
                for (int ks = 0; ks < 2; ++ks) {
                    s8v a;
#pragma unroll
                    for (int i = 0; i < 8; ++i) a[i] = (short)pK[(32 * ks + i) * 136];
                    const s8v b0 = *(const LAS s8v*)(pV0 + 32 * ks), b1 = *(const LAS s8v*)(pV1 + 32 * ks);
                    S0 = __builtin_amdgcn_mfma_f32_16x16x32_bf16(a, b0, S0, 0, 0, 0); S1 = __builtin_amdgcn_mfma_f32_16x16x32_bf16(a, b1, S1, 0, 0, 0);
                }
            }
        }
        __syncthreads();
    }
#undef SC_W
#undef SC_QG
#undef SC_KD
#undef SC_QK
#undef SC_U
#undef SC_LOAD
#undef SC_WRITE
}

#define S2_OFF_QG 17408
#define S2_OFF_QK 34816
#define S2_OFF_KT 44032
#define S2_OFF_U  62464
#define S2_BUF    66560
__device__ __forceinline__ s8v s2_frag(const LAS bfr* rowp, int q) {
    const u2v lo = *(const LAS u2v*)(rowp + 4 * q), hi = *(const LAS u2v*)(rowp + 16 + 4 * q);
    const u4v w = {lo.x, lo.y, hi.x, hi.y}; return __builtin_bit_cast(s8v, w);
}
__device__ __forceinline__ s8v s2_fragx(const LAS bfr* rowp, int g0, int g1) {
    const u2v lo = *(const LAS u2v*)(rowp + 4 * g0), hi = *(const LAS u2v*)(rowp + 4 * g1);
    const u4v w = {lo.x, lo.y, hi.x, hi.y}; return __builtin_bit_cast(s8v, w);
}
__device__ __forceinline__ s8v s2_pack(const f4v& a, const f4v& b) { const u4v w = {cvtpk(a[0], a[1]), cvtpk(a[2], a[3]), cvtpk(b[0], b[1]), cvtpk(b[2], b[3])}; return __builtin_bit_cast(s8v, w); }
__device__ __forceinline__ void p_gdn_scan2(const Ctx& C, const Ptrs& P) {
    unsigned char* ws = P.ws_();
    const GAS bfr* Wg = (const GAS bfr*)(ws + WS_R + R_W); const GAS bfr* Ug = (const GAS bfr*)(ws + WS_R + R_U); const GAS bfr* QGg = (const GAS bfr*)(ws + WS_R + R_QG); const GAS bfr* KDg = (const GAS bfr*)(ws + WS_R + R_KD);
    const GAS bfr* QKg = (const GAS bfr*)(ws + WS_R + R_QK); GAS bfr* Og = (GAS bfr*)(ws + WS_R + R_O); const GAS float* EGg = (const GAS float*)(ws + WS_EG);
    const int tid = C.tid, lane = C.lane, wave = C.wave, r = lane & 15, q = lane >> 4;
    LAS float* sEG = (LAS float*)(C.lds + 2 * S2_BUF);
    for (int task = C.vcu; task < NB * GH * 4; task += C.G) {
        const int bh = task >> 2, es = task & 3, h = bh & 31, b = bh >> 5;
        if (tid < 64) sEG[tid] = EGg[bh * 64 + tid];
        if (wave >= 2) {
            const int lt = tid - 128;
            u4v ra[10], rb[10];
#define S2_SRC(n, k) ({ const int c_ = lt + 384 * (k); const size_t ub_ = (size_t)(bh * 64 + (n)) * 8192; const GAS bfr* p_; \
        if (c_ < 1024) p_ = Wg + ub_ + (size_t)c_ * 8; else if (c_ < 2048) p_ = QGg + ub_ + (size_t)(c_ - 1024) * 8; \
        else if (c_ < 2560) p_ = QKg + (size_t)(bh * 64 + (n)) * 4096 + (size_t)(c_ - 2048) * 8; \
        else if (c_ < 2816) p_ = Ug + ub_ + (size_t)((c_ - 2560) >> 2) * 128 + es * 32 + ((c_ - 2560) & 3) * 8; else p_ = KDg + ub_ + (size_t)(c_ - 2816) * 8; p_; })
#define S2_LOAD(R, n) do { _Pragma("unroll") for (int k_ = 0; k_ < 10; ++k_) R[k_] = *(const GAS u4v*)S2_SRC(n, k_); } while (0)
#define S2_WRITE(R, bb) do { LAS unsigned char* B_ = C.lds + (bb) * S2_BUF; _Pragma("unroll") for (int k_ = 0; k_ < 10; ++k_) { const int c_ = lt + 384 * k_; \
        if (c_ < 1024) *(LAS u4v*)((LAS bfr*)B_ + (c_ >> 4) * 136 + (c_ & 15) * 8) = R[k_]; \
        else if (c_ < 2048) *(LAS u4v*)((LAS bfr*)(B_ + S2_OFF_QG) + ((c_ - 1024) >> 4) * 136 + ((c_ - 1024) & 15) * 8) = R[k_]; \
        else if (c_ < 2560) *(LAS u4v*)((LAS bfr*)(B_ + S2_OFF_QK) + ((c_ - 2048) >> 3) * 72 + ((c_ - 2048) & 7) * 8) = R[k_]; \
        else if (c_ < 2816) *(LAS u4v*)((LAS bfr*)(B_ + S2_OFF_U) + ((c_ - 2560) >> 2) * 32 + ((c_ - 2560) & 3) * 8) = R[k_]; \
        else { const int j_ = (c_ - 2816) >> 4, d8_ = ((c_ - 2816) & 15) * 8; LAS bfr* kt_ = (LAS bfr*)(B_ + S2_OFF_KT) + d8_ * 72 + (((j_ >> 2) ^ ((d8_ >> 4) & 7)) << 2) + (j_ & 3); const unsigned w_[4] = {R[k_].x, R[k_].y, R[k_].z, R[k_].w}; \
            _Pragma("unroll") for (int i_ = 0; i_ < 8; ++i_) kt_[i_ * 72] = (bfr)((i_ & 1) ? (w_[i_ >> 1] >> 16) : (w_[i_ >> 1] & 0xffffu)); } } } while (0)
            u4v rc[10];
            S2_LOAD(ra, 0); S2_WRITE(ra, 0);
            S2_LOAD(rb, 1); S2_LOAD(rc, 2); S2_LOAD(ra, 3);
            __syncthreads();
#define S2_STEP(R, bb, n_) if ((n_) < NCH) { if ((n_) + 1 < NCH) S2_WRITE(R, bb); if ((n_) + 4 < NCH) S2_LOAD(R, (n_) + 4); __syncthreads(); }
            for (int n = 0; n < NCH; n += 6) {
                S2_STEP(rb, 1, n) S2_STEP(rc, 0, n + 1) S2_STEP(ra, 1, n + 2) S2_STEP(rb, 0, n + 3) S2_STEP(rc, 1, n + 4) S2_STEP(ra, 0, n + 5)
            }
#undef S2_STEP
#undef S2_SRC
#undef S2_LOAD
#undef S2_WRITE
        } else {
            const int nt = wave;
            f4v S[8];
#pragma unroll
            for (int w = 0; w < 8; ++w) S[w] = zero_acc();
            __syncthreads();
            for (int n = 0; n < NCH; ++n) {
                const LAS unsigned char* B = C.lds + (n & 1) * S2_BUF;
                const LAS bfr* sW = (const LAS bfr*)B; const LAS bfr* sQG = (const LAS bfr*)(B + S2_OFF_QG); const LAS bfr* sQK = (const LAS bfr*)(B + S2_OFF_QK);
                const LAS bfr* sKT = (const LAS bfr*)(B + S2_OFF_KT); const LAS bfr* sU = (const LAS bfr*)(B + S2_OFF_U);
                s8v Bs[4];
#pragma unroll
                for (int ks = 0; ks < 4; ++ks) Bs[ks] = s2_pack(S[2 * ks], S[2 * ks + 1]);
                f4v a1[4], a2[4];
#pragma unroll
                for (int mt = 0; mt < 4; ++mt) { a1[mt] = zero_acc(); a2[mt] = zero_acc();
#pragma unroll
                    for (int ks = 0; ks < 4; ++ks) { const s8v fw = s2_frag(sW + (16 * mt + r) * 136 + 32 * ks, q), fq = s2_frag(sQG + (16 * mt + r) * 136 + 32 * ks, q);
                        a1[mt] = __builtin_amdgcn_mfma_f32_16x16x32_bf16(fw, Bs[ks], a1[mt], 0, 0, 0); a2[mt] = __builtin_amdgcn_mfma_f32_16x16x32_bf16(fq, Bs[ks], a2[mt], 0, 0, 0); } }
                f4v vn[4];
#pragma unroll
                for (int mt = 0; mt < 4; ++mt) { MFMA_SETTLE(a1[mt]); const LAS bfr* pU = sU + (16 * mt + 4 * q) * 32 + 16 * nt + r;
                    vn[mt] = (f4v){bf1(pU[0]) - a1[mt][0], bf1(pU[32]) - a1[mt][1], bf1(pU[64]) - a1[mt][2], bf1(pU[96]) - a1[mt][3]}; }
                s8v Bv[2];
#pragma unroll
                for (int k2 = 0; k2 < 2; ++k2) Bv[k2] = s2_pack(vn[2 * k2], vn[2 * k2 + 1]);
#pragma unroll
                for (int mt = 0; mt < 4; ++mt) {
#pragma unroll
                    for (int k2 = 0; k2 < 2; ++k2) { const s8v fa = s2_frag(sQK + (16 * mt + r) * 72 + 32 * k2, q); a2[mt] = __builtin_amdgcn_mfma_f32_16x16x32_bf16(fa, Bv[k2], a2[mt], 0, 0, 0); }
                    MFMA_SETTLE(a2[mt]);
                    GAS bfr* po = Og + (size_t)(b * SEQ + n * CH + 16 * mt + 4 * q) * DM + h * 128 + es * 32 + 16 * nt + r;
                    po[0] = f2bf1(a2[mt][0]); po[DM] = f2bf1(a2[mt][1]); po[2 * DM] = f2bf1(a2[mt][2]); po[3 * DM] = f2bf1(a2[mt][3]); }
                const float eg = sEG[n];
#pragma unroll
                for (int w = 0; w < 8; ++w) { S[w] *= eg;
#pragma unroll
                    for (int k2 = 0; k2 < 2; ++k2) { const s8v fk = s2_fragx(sKT + (16 * w + r) * 72 + 32 * k2, q ^ w, (4 + q) ^ w); S[w] = __builtin_amdgcn_mfma_f32_16x16x32_bf16(fk, Bv[k2], S[w], 0, 0, 0); }
                    MFMA_SETTLE(S[w]); }
                __syncthreads();
            }
        }
        __syncthreads();
    }
}
#undef S2_OFF_QG
#undef S2_OFF_QK
#undef S2_OFF_KT
#undef S2_OFF_U
#undef S2_BUF

__device__ __forceinline__ void p_gdn_onorm(const Ctx& C, const Ptrs& P) {
    unsigned char* ws = P.ws_(); const bfr* Og = (const bfr*)(ws + WS_R + R_O); const bfr* PROJ = (const bfr*)(ws + WS_BIG); bfr* AO = (bfr*)(ws + WS_XN); const float* og = P.in_(6);
    const size_t gt = (size_t)C.vcu * 512 + C.tid, GT = (size_t)C.G * 512;
    for (size_t idx0 = gt; idx0 < (size_t)NT * DM / 8; idx0 += 4 * GT) {
        u4v o8[4], z8[4];
#pragma unroll
        for (int b4 = 0; b4 < 4; ++b4) { const size_t idx = idx0 + b4 * GT; const size_t t = idx >> 9; const int hh = (int)(idx >> 4) & 31, i = (int)idx & 15;
            o8[b4] = *(const u4v*)(Og + t * DM + hh * 128 + 8 * i); z8[b4] = *(const u4v*)(PROJ + t * 16384 + 12288 + hh * 128 + 8 * i); }
        const int i = (int)idx0 & 15;
        const f4v g0 = *(const f4v*)(og + 8 * i), g1 = *(const f4v*)(og + 8 * i + 4); const float g[8] = {g0[0], g0[1], g0[2], g0[3], g1[0], g1[1], g1[2], g1[3]};
#pragma unroll
        for (int b4 = 0; b4 < 4; ++b4) { const size_t idx = idx0 + b4 * GT; const size_t t = idx >> 9; const int hh = (int)(idx >> 4) & 31;
            float o[8] = {bflo(o8[b4].x), bfhi(o8[b4].x), bflo(o8[b4].y), bfhi(o8[b4].y), bflo(o8[b4].z), bfhi(o8[b4].z), bflo(o8[b4].w), bfhi(o8[b4].w)};
            float z[8] = {bflo(z8[b4].x), bfhi(z8[b4].x), bflo(z8[b4].y), bfhi(z8[b4].y), bflo(z8[b4].z), bfhi(z8[b4].z), bflo(z8[b4].w), bfhi(z8[b4].w)};
            float ss = 0.f;
#pragma unroll
            for (int k = 0; k < 8; ++k) ss += o[k] * o[k];
            ss += __shfl_xor(ss, 1); ss += __shfl_xor(ss, 2); ss += __shfl_xor(ss, 4); ss += __shfl_xor(ss, 8);
            const float rn = __builtin_amdgcn_rsqf(ss * (1.f / 128.f) + EPS);
            float y[8];
#pragma unroll
            for (int k = 0; k < 8; ++k) y[k] = o[k] * rn * g[k] * (z[k] * __builtin_amdgcn_rcpf(1.f + __expf(-z[k])));
            u4v w; w.x = cvtpk(y[0], y[1]); w.y = cvtpk(y[2], y[3]); w.z = cvtpk(y[4], y[5]); w.w = cvtpk(y[6], y[7]);
            *(u4v*)(AO + t * DM + hh * 128 + 8 * i) = w; }
    }
}
__device__ __forceinline__ unsigned mono_key(float x) { const unsigned u = __float_as_uint(x); return u ^ ((unsigned)((int)u >> 31) | 0x80000000u); }
#define KEY_INS(K, key) do { unsigned x_ = (key); _Pragma("unroll") for (int s_ = 0; s_ < 16; ++s_) { const unsigned hi_ = max(K[s_], x_); x_ = min(K[s_], x_); K[s_] = hi_; } } while (0)
__device__ __forceinline__ void p_route(const Ctx& C, const Ptrs& P) {
    unsigned char* ws = P.ws_(); const float* SC = (const float*)(ws + WS_SC); bfr* G = (bfr*)(ws + WS_G);
    LAS unsigned char* wl = C.lds + C.wave * 16384;
    LAS int* sE = (LAS int*)(wl); LAS float* sGt = (LAS float*)(wl + 2048); LAS float* sV1 = (LAS float*)(wl + 4096); LAS float* sV2 = (LAS float*)(wl + 8192); LAS int* sI = (LAS int*)(wl + 12288);
    const int lane = C.lane, gw = C.vcu * 8 + C.wave, NGW = C.G * 8;
    for (int wt = gw; wt < NT / 4; wt += NGW) {
        const int tl = lane >> 4, t = wt * 4 + tl;
        unsigned k1[16];
#pragma unroll
        for (int i = 0; i < 16; ++i) k1[i] = 0u;
        const float* base = SC + (size_t)t * PQ + (lane & 15) * 128;
        for (int e = 0; e < 128; e += 4) { const f4v x4 = *(const f4v*)(base + e);
            KEY_INS(k1, (mono_key(x4[0]) & ~127u) | (unsigned)(127 - e)); KEY_INS(k1, (mono_key(x4[1]) & ~127u) | (unsigned)(126 - e));
            KEY_INS(k1, (mono_key(x4[2]) & ~127u) | (unsigned)(125 - e)); KEY_INS(k1, (mono_key(x4[3]) & ~127u) | (unsigned)(124 - e)); }
        const bool h0 = (lane & 1) == 0;
        float v1[16], v2[16];
#pragma unroll
        for (int i = 0; i < 16; ++i) { const int id = 127 - (int)(k1[i] & 127u); const float vv = base[id];
            const float ov = __shfl_xor(vv, 1); const int oi = __shfl_xor(id, 1);
            v1[i] = h0 ? vv : ov; v2[i] = h0 ? ov : vv; const int ia = h0 ? id : oi, ib = h0 ? oi : id;
            sV1[i * 64 + lane] = v1[i]; sV2[i * 64 + lane] = v2[i]; sI[i * 64 + lane] = ia | (ib << 8); }
        unsigned k2[16];
#pragma unroll
        for (int i = 0; i < 16; ++i) k2[i] = 0u;
#pragma unroll
        for (int a = 0; a < 16; ++a)
#pragma unroll
            for (int b = 0; b < 16; ++b)
                if ((a + 1) * (b + 1) <= 16) KEY_INS(k2, (mono_key(v1[a] + v2[b]) & ~255u) | (unsigned)(255 - (a * 16 + b)));
        LDS_WAIT(); asm volatile("" ::: "memory");
        float ts[16]; int te[16]; float mx = -__builtin_inff();
#pragma unroll
        for (int i = 0; i < 16; ++i) { const int code = 255 - (int)(k2[i] & 255u), a = code >> 4, b = code & 15;
            ts[i] = sV1[a * 64 + lane] + sV2[b * 64 + lane]; te[i] = (sI[a * 64 + lane] & 0xff) * 128 + (sI[b * 64 + lane] >> 8); mx = fmaxf(mx, ts[i]); }
        float sum = 0.f;
#pragma unroll
        for (int i = 0; i < 16; ++i) { ts[i] = __expf(ts[i] - mx); sum += ts[i]; }
        const float inv = 1.f / sum;
        if (h0) { const int hb = ((lane >> 1) & 7) * 16;
#pragma unroll
            for (int i = 0; i < 16; ++i) { sE[tl * 128 + hb + i] = te[i]; sGt[tl * 128 + hb + i] = ts[i] * inv; } }
        LDS_WAIT(); asm volatile("" ::: "memory");
        for (int k = 0; k < 4; ++k) {
            const size_t tt = (size_t)wt * 4 + k; u4v* row = (u4v*)(G + tt * PE); const u4v z = {0u, 0u, 0u, 0u};
#pragma unroll 8
            for (int j = 0; j < 32; ++j) row[j * 64 + lane] = z;
            const int e0 = sE[k * 128 + lane], e1 = sE[k * 128 + 64 + lane]; float t0 = 0.f, t1 = 0.f; bool f0 = true, f1 = true;
            for (int j = 0; j < 128; j += 4) { const i4v ej = *(const LAS i4v*)(sE + k * 128 + j); const f4v gj = *(const LAS f4v*)(sGt + k * 128 + j);
                if (ej.x == e0) { t0 += gj[0]; if (j + 0 < lane) f0 = false; } if (ej.y == e0) { t0 += gj[1]; if (j + 1 < lane) f0 = false; }
                if (ej.z == e0) { t0 += gj[2]; if (j + 2 < lane) f0 = false; } if (ej.w == e0) { t0 += gj[3]; if (j + 3 < lane) f0 = false; }
                if (ej.x == e1) { t1 += gj[0]; if (j + 0 < lane + 64) f1 = false; } if (ej.y == e1) { t1 += gj[1]; if (j + 1 < lane + 64) f1 = false; }
                if (ej.z == e1) { t1 += gj[2]; if (j + 2 < lane + 64) f1 = false; } if (ej.w == e1) { t1 += gj[3]; if (j + 3 < lane + 64) f1 = false; } }
            VM_WAIT();
            if (f0) G[tt * PE + e0] = f2bf1(t0);
            if (f1) G[tt * PE + e1] = f2bf1(t1);
        }
        LDS_WAIT(); asm volatile("" ::: "memory");
    }
}

typedef _Float16 h2v __attribute__((ext_vector_type(2)));
__device__ __forceinline__ void p_sroute(const Ctx& C, const Ptrs& P, int layer) {
    unsigned char* ws = P.ws_(); const bfr* QRY = (const bfr*)(ws + WS_QRY); const bfr* KEY = (const bfr*)(ws + WS_WTKEY) + (size_t)layer * PQ * PQ; bfr* G = (bfr*)(ws + WS_G);
    const int lane = C.lane, wave = C.wave, r = lane & 15, q = lane >> 4;
    LAS unsigned char* wl = C.lds + wave * 16640;
    LAS _Float16* sS = (LAS _Float16*)wl;
    LAS float* sV1 = (LAS float*)(wl); LAS float* sV2 = (LAS float*)(wl + 4096); LAS int* sI = (LAS int*)(wl + 8192);
    LAS int* sE = (LAS int*)(C.lds); LAS float* sGt = (LAS float*)(C.lds + 16384);
    LAS unsigned* bm = (LAS unsigned*)(C.lds + 32768 + wave * 3200); LAS unsigned* cnt = bm + 512; LAS int* le = (LAS int*)(bm + 516); LAS float* lg = (LAS float*)(bm + 516 + 128);
    for (int blk = C.vcu; blk < NT / 32; blk += C.G) {
        const int t0 = blk * 32;
#pragma unroll
        for (int hf = 0; hf < 2; ++hf) {
            const int hh = wave * 2 + hf;
            s8v a[2][4];
#pragma unroll
            for (int mt = 0; mt < 2; ++mt)
#pragma unroll
                for (int ks = 0; ks < 4; ++ks) a[mt][ks] = *(const s8v*)(QRY + (size_t)(t0 + 16 * mt + r) * PQ + hh * 128 + 32 * ks + 8 * q);
#pragma unroll
            for (int nt = 0; nt < 8; ++nt) {
                s8v b[4];
#pragma unroll
                for (int ks = 0; ks < 4; ++ks) b[ks] = *(const s8v*)(KEY + (size_t)(hh * 128 + 16 * nt + r) * PQ + hh * 128 + 32 * ks + 8 * q);
                f4v c0 = zero_acc(), c1 = zero_acc();
#pragma unroll
                for (int ks = 0; ks < 4; ++ks) { c0 = __builtin_amdgcn_mfma_f32_16x16x32_bf16(a[0][ks], b[ks], c0, 0, 0, 0); c1 = __builtin_amdgcn_mfma_f32_16x16x32_bf16(a[1][ks], b[ks], c1, 0, 0, 0); MFMA_SETTLE(c0); MFMA_SETTLE(c1); }
                MFMA_SETTLE(c0); MFMA_SETTLE(c1);
#pragma unroll
                for (int e = 0; e < 4; ++e) { sS[(32 * hf + 4 * q + e) * 130 + 16 * nt + r] = (_Float16)c0[e]; sS[(32 * hf + 16 + 4 * q + e) * 130 + 16 * nt + r] = (_Float16)c1[e]; }
            }
        }
        LDS_WAIT(); asm volatile("" ::: "memory");
        unsigned k1[16];
#pragma unroll
        for (int i = 0; i < 16; ++i) k1[i] = 0u;
        const LAS h2v* lp = (const LAS h2v*)(sS + lane * 130);
        for (int e = 0; e < 128; e += 8) {
#pragma unroll
            for (int u = 0; u < 4; ++u) { const h2v x2 = lp[(e >> 1) + u];
                KEY_INS(k1, (mono_key((float)x2[0]) & ~127u) | (unsigned)(127 - e - 2 * u)); KEY_INS(k1, (mono_key((float)x2[1]) & ~127u) | (unsigned)(126 - e - 2 * u)); }
        }
        const bool h0 = lane < 32;
        float v1[16], v2[16]; int ids[16]; float vals[16];
#pragma unroll
        for (int i = 0; i < 16; ++i) { ids[i] = 127 - (int)(k1[i] & 127u); vals[i] = (float)sS[lane * 130 + ids[i]]; }
        LDS_WAIT(); asm volatile("" ::: "memory");
#pragma unroll
        for (int i = 0; i < 16; ++i) { const float ov = __shfl_xor(vals[i], 32); const int oi = __shfl_xor(ids[i], 32);
            v1[i] = h0 ? vals[i] : ov; v2[i] = h0 ? ov : vals[i]; const int ia = h0 ? ids[i] : oi, ib = h0 ? oi : ids[i];
            sV1[i * 64 + lane] = v1[i]; sV2[i * 64 + lane] = v2[i]; sI[i * 64 + lane] = ia | (ib << 8); }
        unsigned k2[16];
#pragma unroll
        for (int b = 0; b < 16; ++b) k2[b] = (mono_key(v1[0] + v2[b]) & ~255u) | (unsigned)(255 - b);
#pragma unroll
        for (int a = 1; a < 16; ++a)
#pragma unroll
            for (int b = 0; b < 16; ++b)
                if ((a + 1) * (b + 1) <= 16) KEY_INS(k2, (mono_key(v1[a] + v2[b]) & ~255u) | (unsigned)(255 - (a * 16 + b)));
        LDS_WAIT(); asm volatile("" ::: "memory");
        float ts[16]; int te[16]; float mx = -__builtin_inff();
#pragma unroll
        for (int i = 0; i < 16; ++i) { const int code = 255 - (int)(k2[i] & 255u), a = code >> 4, b = code & 15;
            ts[i] = sV1[a * 64 + lane] + sV2[b * 64 + lane]; te[i] = (sI[a * 64 + lane] & 0xff) * 128 + (sI[b * 64 + lane] >> 8); mx = fmaxf(mx, ts[i]); }
        float sum = 0.f;
#pragma unroll
        for (int i = 0; i < 16; ++i) { ts[i] = __expf(ts[i] - mx); sum += ts[i]; }
        const float inv = 1.f / sum;
        __syncthreads();
        if (h0) {
#pragma unroll
            for (int i = 0; i < 16; ++i) { sE[lane * 128 + wave * 16 + i] = te[i]; sGt[lane * 128 + wave * 16 + i] = ts[i] * inv; } }
        __syncthreads();
        for (int k = 0; k < 4; ++k) {
            const int tl = wave * 4 + k; const size_t tt = (size_t)t0 + tl;
            if (layer == 0) { u4v* row = (u4v*)(G + tt * PE); const u4v z = {0u, 0u, 0u, 0u};
#pragma unroll 8
                for (int j = 0; j < 32; ++j) row[j * 64 + lane] = z; }
            const int e0 = sE[tl * 128 + lane], e1 = sE[tl * 128 + 64 + lane]; float t0s = sGt[tl * 128 + lane], t1s = sGt[tl * 128 + 64 + lane];
#pragma unroll
            for (int j = 0; j < 8; ++j) bm[j * 64 + lane] = 0u;
            if (lane == 0) *cnt = 0u;
            LDS_WAIT(); asm volatile("" ::: "memory");
            const unsigned b0 = 1u << (e0 & 31), b1 = 1u << (e1 & 31);
            const bool d0 = (__hip_atomic_fetch_or(bm + (e0 >> 5), b0, __ATOMIC_RELAXED, __HIP_MEMORY_SCOPE_WORKGROUP) & b0) != 0u;
            const bool d1 = (__hip_atomic_fetch_or(bm + (e1 >> 5), b1, __ATOMIC_RELAXED, __HIP_MEMORY_SCOPE_WORKGROUP) & b1) != 0u;
            if (d0) { const unsigned sl = __hip_atomic_fetch_add(cnt, 1u, __ATOMIC_RELAXED, __HIP_MEMORY_SCOPE_WORKGROUP); le[sl] = e0; lg[sl] = t0s; }
            if (d1) { const unsigned sl = __hip_atomic_fetch_add(cnt, 1u, __ATOMIC_RELAXED, __HIP_MEMORY_SCOPE_WORKGROUP); le[sl] = e1; lg[sl] = t1s; }
            LDS_WAIT(); asm volatile("" ::: "memory");
            const int nd = (int)__builtin_amdgcn_readfirstlane((int)*cnt);
            for (int j = 0; j < nd; ++j) { const int ej = le[j]; const float gj = lg[j]; if (ej == e0 && !d0) t0s += gj; if (ej == e1 && !d1) t1s += gj; }
            const bool f0 = !d0, f1 = !d1;
            VM_WAIT();
            if (f0) G[tt * PE + e0] = f2bf1(t0s);
            if (f1) G[tt * PE + e1] = f2bf1(t1s);
        }
        __syncthreads();
    }
}

constexpr int KIND_V = F8_KVQ ? 2 : 1;
__device__ __forceinline__ void p_headprep(const Ctx& C, const Ptrs& P) {
    unsigned char* ws = P.ws_(); const bfr* KVQ = (const bfr*)(ws + WS_BIG); bfr* Qh = (bfr*)(ws + WS_R + R_QH); bfr* Kh = (bfr*)(ws + WS_R + R_KH); bfr* Vh = (bfr*)(ws + WS_R + R_VH);
    const float* kg = P.in_(10); const float* qg = P.in_(13);
    const size_t gt = (size_t)C.vcu * 512 + C.tid, GT = (size_t)C.G * 512;
    for (size_t idx0 = gt; idx0 < (size_t)NT * 1536; idx0 += 4 * GT) {
        u4v x8[4];
#pragma unroll
        for (int b4 = 0; b4 < 4; ++b4) { const size_t idx = idx0 + b4 * GT; const size_t t = idx / 1536; const int rem = (int)(idx - t * 1536), vec = rem >> 4, i = rem & 15;
            x8[b4] = *(const u4v*)(KVQ + t * 12288 + vec * 128 + 8 * i); }
#pragma unroll
        for (int b4 = 0; b4 < 4; ++b4) { const size_t idx = idx0 + b4 * GT; const size_t t = idx / 1536; const int rem = (int)(idx - t * 1536), vec = rem >> 4, i = rem & 15, kind = vec >> 5, sh = vec & 31;
            float x[8] = {bflo(x8[b4].x), bfhi(x8[b4].x), bflo(x8[b4].y), bfhi(x8[b4].y), bflo(x8[b4].z), bfhi(x8[b4].z), bflo(x8[b4].w), bfhi(x8[b4].w)};
            float ss = 0.f;
#pragma unroll
            for (int k = 0; k < 8; ++k) ss += x[k] * x[k];
            ss += __shfl_xor(ss, 1); ss += __shfl_xor(ss, 2); ss += __shfl_xor(ss, 4); ss += __shfl_xor(ss, 8);
            u4v w = x8[b4];
            if (kind != KIND_V) { const float rn = __builtin_amdgcn_rsqf(ss * (1.f / 128.f) + EPS); const float* gp = (kind == 0 ? kg : qg) + 8 * i; const f4v g0 = *(const f4v*)gp, g1 = *(const f4v*)(gp + 4);
                w.x = cvtpk(x[0] * rn * g0[0], x[1] * rn * g0[1]); w.y = cvtpk(x[2] * rn * g0[2], x[3] * rn * g0[3]); w.z = cvtpk(x[4] * rn * g1[0], x[5] * rn * g1[1]); w.w = cvtpk(x[6] * rn * g1[2], x[7] * rn * g1[3]); }
            const size_t b = t >> 12, s = t & 4095; bfr* dst = (kind == 0 ? Kh : (kind == KIND_V ? Vh : Qh)) + ((b * 32 + sh) * SEQ + s) * 128 + 8 * i;
            *(u4v*)dst = w; }
    }
}

__device__ __forceinline__ att::BlockRef<att::bf16, att::bf16> attn_ref(const att::bf16* Qh, const att::bf16* Kh, const att::bf16* Vh, att::bf16* Oh, int bhp, int qb) {
    const int b = bhp >> 6, hd = (bhp >> 2) & 15, c = (bhp >> 1) & 1, vh = bhp & 1;
    att::BlockRef<att::bf16, att::bf16> r;
    r.Q = Qh + ((size_t)(b * 32 + hd * 2 + c) * SEQ + (size_t)qb * 256) * 128; r.K = Kh + (size_t)(b * 32 + hd * 2 + c) * SEQ * 128; r.V = Vh + (size_t)(b * 32 + hd * 2 + vh) * SEQ * 128;
    r.O = Oh + ((size_t)bhp * SEQ + (size_t)qb * 256) * 128; r.P0 = qb * 256;
    return r;
}
__device__ __forceinline__ void p_attn(const Ctx& C, const Ptrs& P) {
    unsigned char* ws = P.ws_(); const att::bf16* Qh = (const att::bf16*)(ws + WS_R + R_QH); const att::bf16* Kh = (const att::bf16*)(ws + WS_R + R_KH); const att::bf16* Vh = (const att::bf16*)(ws + WS_R + R_VH);
    att::bf16* Oh = (att::bf16*)(ws + WS_R + R_OH);
    extern __shared__ __attribute__((aligned(16))) char lds_sym[]; char* lds = lds_sym;
    constexpr int total = 128 * 8;
    int L = C.vcu; if (L >= total) return;
    int pass = 0;
    att::BlockRef<att::bf16, att::bf16> cur = attn_ref(Qh, Kh, Vh, Oh, L >> 3, L & 7);
    att::Seam<att::bf16> S;
    att::causal_swa_prime<att::bf16, att::bf16>(cur, SEQ, lds, S);
    for (;;) {
        const bool more_pass = pass == 0, more_item = L + C.G < total, last = !more_pass && !more_item;
        int passn = pass + 1, Ln = L;
        if (!more_pass) { passn = 0; Ln = more_item ? L + C.G : L; }
        const att::BlockRef<att::bf16, att::bf16> nxt = last ? cur : attn_ref(Qh, Kh, Vh, Oh, Ln >> 3, passn ? 15 - (Ln & 7) : (Ln & 7));
        att::causal_swa_block<att::bf16, att::bf16>(cur, nxt, SEQ, SEQ, lds, S);
        if (last) break;
        cur = nxt; pass = passn; L = Ln;
    }
    __syncthreads();
}

__device__ __forceinline__ void p_combine(const Ctx& C, const Ptrs& P) {
    unsigned char* ws = P.ws_(); const bfr* Oh = (const bfr*)(ws + WS_R + R_OH); bfr* AO = (bfr*)(ws + WS_XN); const float* sg = P.in_(18);
    float lam;
    { const float* q1 = P.in_(14); const float* k1 = P.in_(15); const float* q2 = P.in_(16); const float* k2 = P.in_(17); const int l = C.lane;
      const float d1 = wave_sum(q1[l] * k1[l] + q1[l + 64] * k1[l + 64]), d2 = wave_sum(q2[l] * k2[l] + q2[l + 64] * k2[l + 64]);
      lam = expf(d1) - expf(d2) + LAMBDA_INIT; }
    const size_t gt = (size_t)C.vcu * 512 + C.tid, GT = (size_t)C.G * 512;
    for (size_t idx0 = gt; idx0 < (size_t)NT * 512; idx0 += 4 * GT) {
        u4v a8[4], b8[4];
#pragma unroll
        for (int b4 = 0; b4 < 4; ++b4) { const size_t idx = idx0 + b4 * GT; const size_t t = idx >> 9, b = t >> 12, s = t & 4095; const int hd = (int)(idx >> 5) & 15, i = (int)idx & 31, vh = i >> 4, d = (8 * i) & 127;
            const size_t o0i = ((((b * 16 + hd) * 2 + 0) * 2 + vh) * SEQ + s) * 128 + d, o1i = ((((b * 16 + hd) * 2 + 1) * 2 + vh) * SEQ + s) * 128 + d;
            a8[b4] = *(const u4v*)(Oh + o0i); b8[b4] = *(const u4v*)(Oh + o1i); }
        const int i = (int)idx0 & 31;
        const f4v g0 = *(const f4v*)(sg + 8 * i), g1 = *(const f4v*)(sg + 8 * i + 4);
#pragma unroll
        for (int b4 = 0; b4 < 4; ++b4) { const size_t idx = idx0 + b4 * GT; const size_t t = idx >> 9; const int hd = (int)(idx >> 5) & 15;
            float o[8] = {bflo(a8[b4].x) - lam * bflo(b8[b4].x), bfhi(a8[b4].x) - lam * bfhi(b8[b4].x), bflo(a8[b4].y) - lam * bflo(b8[b4].y), bfhi(a8[b4].y) - lam * bfhi(b8[b4].y),
                          bflo(a8[b4].z) - lam * bflo(b8[b4].z), bfhi(a8[b4].z) - lam * bfhi(b8[b4].z), bflo(a8[b4].w) - lam * bflo(b8[b4].w), bfhi(a8[b4].w) - lam * bfhi(b8[b4].w)};
            float ss = 0.f;
#pragma unroll
            for (int k = 0; k < 8; ++k) ss += o[k] * o[k];
            ss += __shfl_xor(ss, 1); ss += __shfl_xor(ss, 2); ss += __shfl_xor(ss, 4); ss += __shfl_xor(ss, 8); ss += __shfl_xor(ss, 16);
            const float rn = __builtin_amdgcn_rsqf(ss * (1.f / 256.f) + EPS) * (1.f - LAMBDA_INIT);
            u4v w; w.x = cvtpk(o[0] * rn * g0[0], o[1] * rn * g0[1]); w.y = cvtpk(o[2] * rn * g0[2], o[3] * rn * g0[3]); w.z = cvtpk(o[4] * rn * g1[0], o[5] * rn * g1[1]); w.w = cvtpk(o[6] * rn * g1[2], o[7] * rn * g1[3]);
            *(u4v*)(AO + t * DM + hd * 256 + 8 * i) = w; }
    }
}
constexpr int NPH_LAYER = 13, NPHASE = 1 + 2 * NPH_LAYER;
#ifndef MK_PER_PHASE
#define MK_PER_PHASE 0
#endif

__global__ void __launch_bounds__(512, 2) trunk_fwd(KArgs KA) {
    extern __shared__ __attribute__((aligned(16))) unsigned char lds_raw[];
    Ctx C; C.lds = (LAS unsigned char*)lds_raw; C.tid = threadIdx.x; C.lane = C.tid & 63; C.wave = __builtin_amdgcn_readfirstlane(C.tid >> 6);
    C.G = gridDim.x; { const int bx = blockIdx.x; C.vcu = (C.G % 8 == 0) ? (bx % 8) * (C.G / 8) + bx / 8 : bx; }
    volatile LAS unsigned* MISC = (volatile LAS unsigned*)(C.lds + MISC_OFF);
    for (int u = C.tid; u < (LDS_BYTES - MISC_OFF) / 4; u += 512) MISC[u] = 0u;
    __syncthreads();
    Ptrs P; P.tbl = (LAS unsigned long long*)(C.lds + MISC_OFF + 128);
    if (C.tid < 28) P.tbl[C.tid] = ((const unsigned long long*)&KA)[C.tid];
    __syncthreads();
    unsigned* ctl = (unsigned*)(P.ws_() + WS_CTL);
    const int lo = KA.ph_lo, hi = KA.ph_hi;
    XcdBarrier bar; bar.bar = ctl + CW_BAR + KA.li * XCD_BAR_WORDS; bar.x = 0; bar.st = MISC + 8;
    if (hi - lo > 1) bar = xcd_barrier_post(ctl + CW_BAR + KA.li * XCD_BAR_WORDS, MISC + 8);
#define IN(k) (lo <= (k) && (k) < hi)
#define SEAM(k) do { if (IN(k) && IN((k) + 1)) xcd_barrier(bar); } while (0)
    unsigned char* ws = P.ws_();
    bfr* XN = (bfr*)(ws + WS_XN); bfr* BIG = (bfr*)(ws + WS_BIG);
    const int hb = (int)blockIdx.x;

    if (IN(0)) { p_convert(C, P); __syncthreads(); }
    SEAM(0);
    {
        constexpr int layer = 0;
        const int pb = 1 + layer * NPH_LAYER;
        if (IN(pb + 0)) p_norm_rows(C, layer == 0 ? P.in_(0) : (const float*)P.out_(), XN, ((layer == 0 && F8_PROJ0 != 0) || (layer == 1 && F8_KVQ != 0)) ? ws + WS_XN8 : nullptr);
        SEAM(pb + 0);
        if (IN(pb + 1)) {
            const int N = layer == 0 ? 16384 : 12288;
            if (layer == 0 && F8_PROJ0 == 2) {
                { pg8::Gemm g{XN, (const bfr*)(ws + WS_WTIN), NT, 8192, DM}; pg8::StaticOrder S; S.init(NT, 8192, C.G, hb);
                  pg8::EpiBf16<0> E{BIG, N, nullptr, 0, 0, 1.f};
                  pg8::gemm_phase<pg8::EpiBf16<0>, pg8::StaticOrder, true, true>((PG8_LAS unsigned char*)C.lds, g, S, E); }
                __syncthreads();
                { pg8::Gemm g{(const bfr*)(ws + WS_XN8), (const bfr*)(ws + WS_WTIN + (size_t)8192 * DM * 2), NT, 8192, DM / 2}; pg8::StaticOrder S; S.init(NT, 8192, C.G, hb);
                  pg8::EpiBf16<0> E{BIG + 8192, N, nullptr, 8192, 0, 1.f / SU};
                  pg8::gemm_phase<pg8::EpiBf16<0>, pg8::StaticOrder, true, true, true>((PG8_LAS unsigned char*)C.lds, g, S, E); }
            } else if (layer == 0 && F8_PROJ0 == 4) {
                { pg8::Gemm g{(const bfr*)(ws + WS_XN8), (const bfr*)(ws + WS_WTIN), NT, 4096, DM / 2}; pg8::StaticOrder S; S.init(NT, 4096, C.G, hb);
                  pg8::EpiBf16<0> E{BIG, N, nullptr, 4096, 0, 1.f / SU};
                  pg8::gemm_phase<pg8::EpiBf16<0>, pg8::StaticOrder, true, true, true>((PG8_LAS unsigned char*)C.lds, g, S, E); }
                __syncthreads();
                { pg8::Gemm g{XN, (const bfr*)(ws + WS_WTIN + (size_t)4096 * DM), NT, 12288, DM}; pg8::StaticOrder S; S.init(NT, 12288, C.G, hb);
                  pg8::EpiBf16<0> E{BIG + 4096, N, nullptr, 0, 0, 1.f};
                  pg8::gemm_phase<pg8::EpiBf16<0>, pg8::StaticOrder, true, true>((PG8_LAS unsigned char*)C.lds, g, S, E); }
            } else if (layer == 0 && F8_PROJ0 == 3) {
                { pg8::Gemm g{(const bfr*)(ws + WS_XN8), (const bfr*)(ws + WS_WTIN), NT, 8192, DM / 2}; pg8::StaticOrder S; S.init(NT, 8192, C.G, hb);
                  pg8::EpiBf16<0> E{BIG, N, nullptr, 8192, 0, 1.f / SU};
                  pg8::gemm_phase<pg8::EpiBf16<0>, pg8::StaticOrder, true, true, true>((PG8_LAS unsigned char*)C.lds, g, S, E); }
                __syncthreads();
                { pg8::Gemm g{XN, (const bfr*)(ws + WS_WTIN + (size_t)8192 * DM), NT, 8192, DM}; pg8::StaticOrder S; S.init(NT, 8192, C.G, hb);
                  pg8::EpiBf16<0> E{BIG + 8192, N, nullptr, 0, 0, 1.f};
                  pg8::gemm_phase<pg8::EpiBf16<0>, pg8::StaticOrder, true, true>((PG8_LAS unsigned char*)C.lds, g, S, E); }
            } else if (layer == 0 && F8_PROJ0 == 1) {
                pg8::Gemm g{(const bfr*)(ws + WS_XN8), (const bfr*)(ws + WS_WTIN), NT, N, DM / 2}; pg8::StaticOrder S; S.init(NT, N, C.G, hb);
                pg8::EpiBf16<0> E{BIG, N, nullptr, N, 0, 1.f / SU};
                pg8::gemm_phase<pg8::EpiBf16<0>, pg8::StaticOrder, true, true, true>((PG8_LAS unsigned char*)C.lds, g, S, E);
            } else if (layer == 1 && F8_KVQ) {
                { pg8::Gemm g{(const bfr*)(ws + WS_XN8), (const bfr*)(ws + WS_WTKVQ), NT, 8192, DM / 2}; pg8::StaticOrder S; S.init(NT, 8192, C.G, hb);
                  pg8::EpiBf16<0> E{BIG, N, nullptr, 8192, 0, 1.f / SU};
                  pg8::gemm_phase<pg8::EpiBf16<0>, pg8::StaticOrder, true, true, true>((PG8_LAS unsigned char*)C.lds, g, S, E); }
                __syncthreads();
                { pg8::Gemm g{XN, (const bfr*)(ws + WS_WTKVQ + (size_t)2 * DM * DM), NT, DM, DM}; pg8::StaticOrder S; S.init(NT, DM, C.G, hb);
                  pg8::EpiBf16<0> E{BIG + 8192, N, nullptr, 0, 0, 1.f};
                  pg8::gemm_phase<pg8::EpiBf16<0>, pg8::StaticOrder, true, true>((PG8_LAS unsigned char*)C.lds, g, S, E); }
            } else {
                pg8::Gemm g{XN, (const bfr*)(ws + (layer == 0 ? WS_WTIN : WS_WTKVQ)), NT, N, DM}; pg8::StaticOrder S; S.init(NT, N, C.G, hb);
                pg8::EpiBf16<0> E{BIG, N, nullptr, 0, 0, 1.f};
                pg8::gemm_phase<pg8::EpiBf16<0>, pg8::StaticOrder, true, true>((PG8_LAS unsigned char*)C.lds, g, S, E);
            }
        }
        SEAM(pb + 1);
        if (IN(pb + 2)) { if (layer == 0) p_bd(C, XN, (const bfr*)(ws + WS_WTBD), (float*)(ws + WS_BD)); else p_headprep(C, P); }
        SEAM(pb + 2);
        if (IN(pb + 3)) { if (layer == 0) p_gdn_prep(C, P); else p_attn(C, P); }
        SEAM(pb + 3);
        if (IN(pb + 4)) { if (layer == 0) p_gdn_scan2(C, P); else p_combine(C, P); }
        SEAM(pb + 4);
        if (IN(pb + 5)) { if (layer == 0) p_gdn_onorm(C, P); }
        SEAM(pb + 5);
        if (IN(pb + 6)) {
            pg8::Gemm g{XN, (const bfr*)(ws + (layer == 0 ? WS_WTOUT : WS_WTO)), NT, DM, DM}; pg8::StaticOrder S; S.init(NT, DM, C.G, hb);
            pg8::EpiRes E{layer == 0 ? P.in_(0) : (const float*)P.out_(), P.out_(), DM, 1.f};
            pg8::gemm_phase<pg8::EpiRes, pg8::StaticOrder, true, true>((PG8_LAS unsigned char*)C.lds, g, S, E);
        }
        SEAM(pb + 6);
        if (IN(pb + 7)) p_norm_rows(C, (const float*)P.out_(), XN, ws + WS_XN8);
        SEAM(pb + 7);
        if (IN(pb + 8)) {
            pg8::Gemm g{XN, (const bfr*)(ws + WS_WTQRY) + (size_t)layer * PQ * DM, NT, PQ, DM}; pg8::StaticOrder S; S.init(NT, PQ, C.G, hb);
            pg8::EpiBf16<0> E{(bfr*)(ws + WS_QRY), PQ, nullptr, 0, 0, 1.f};
            pg8::gemm_phase<pg8::EpiBf16<0>, pg8::StaticOrder, true, true>((PG8_LAS unsigned char*)C.lds, g, S, E);
        }
        SEAM(pb + 8);
        if (IN(pb + 9)) { p_sroute(C, P, layer); }
        SEAM(pb + 9); if (IN(pb + 9) && !IN(pb + 10) && IN(pb + 11)) xcd_barrier(bar);
        if (IN(pb + 11)) {
            pg8::Gemm g{(const bfr*)(ws + WS_XN8), (const bfr*)(ws + WS_U + (size_t)layer * PE * DM), NT, PE, DM / 2}; pg8::StaticOrder S; S.init(NT, PE, C.G, hb);
            pg8::EpiGate8 E{(bfr*)(ws + WS_G), ws + WS_A2, PE, 1.f / SU, SA};
            pg8::gemm_phase<pg8::EpiGate8, pg8::StaticOrder, true, true, true>((PG8_LAS unsigned char*)C.lds, g, S, E);
        }
        SEAM(pb + 11);
        if (IN(pb + 12)) {
            pg8::Gemm g{(const bfr*)(ws + WS_A2), (const bfr*)(ws + WS_VT + (size_t)layer * DM * PE), NT, DM, PE / 2}; pg8::StaticOrder S; S.init(NT, DM, C.G, hb);
            pg8::EpiRes E{(const float*)P.out_(), P.out_(), DM, 1.f / (SA * SV)};
            pg8::gemm_phase<pg8::EpiRes, pg8::StaticOrder, true, true, true>((PG8_LAS unsigned char*)C.lds, g, S, E);
        }
        SEAM(pb + 12);
    }
    {
        constexpr int layer = 1;
        const int pb = 1 + layer * NPH_LAYER;
        if (IN(pb + 0)) p_norm_rows(C, layer == 0 ? P.in_(0) : (const float*)P.out_(), XN, ((layer == 0 && F8_PROJ0 != 0) || (layer == 1 && F8_KVQ != 0)) ? ws + WS_XN8 : nullptr);
        SEAM(pb + 0);
        if (IN(pb + 1)) {
            const int N = layer == 0 ? 16384 : 12288;
            if (layer == 0 && F8_PROJ0 == 2) {
                { pg8::Gemm g{XN, (const bfr*)(ws + WS_WTIN), NT, 8192, DM}; pg8::StaticOrder S; S.init(NT, 8192, C.G, hb);
                  pg8::EpiBf16<0> E{BIG, N, nullptr, 0, 0, 1.f};
                  pg8::gemm_phase<pg8::EpiBf16<0>, pg8::StaticOrder, true, true>((PG8_LAS unsigned char*)C.lds, g, S, E); }
                __syncthreads();
                { pg8::Gemm g{(const bfr*)(ws + WS_XN8), (const bfr*)(ws + WS_WTIN + (size_t)8192 * DM * 2), NT, 8192, DM / 2}; pg8::StaticOrder S; S.init(NT, 8192, C.G, hb);
                  pg8::EpiBf16<0> E{BIG + 8192, N, nullptr, 8192, 0, 1.f / SU};
                  pg8::gemm_phase<pg8::EpiBf16<0>, pg8::StaticOrder, true, true, true>((PG8_LAS unsigned char*)C.lds, g, S, E); }
            } else if (layer == 0 && F8_PROJ0 == 4) {
                { pg8::Gemm g{(const bfr*)(ws + WS_XN8), (const bfr*)(ws + WS_WTIN), NT, 4096, DM / 2}; pg8::StaticOrder S; S.init(NT, 4096, C.G, hb);
                  pg8::EpiBf16<0> E{BIG, N, nullptr, 4096, 0, 1.f / SU};
                  pg8::gemm_phase<pg8::EpiBf16<0>, pg8::StaticOrder, true, true, true>((PG8_LAS unsigned char*)C.lds, g, S, E); }
                __syncthreads();
                { pg8::Gemm g{XN, (const bfr*)(ws + WS_WTIN + (size_t)4096 * DM), NT, 12288, DM}; pg8::StaticOrder S; S.init(NT, 12288, C.G, hb);
                  pg8::EpiBf16<0> E{BIG + 4096, N, nullptr, 0, 0, 1.f};
                  pg8::gemm_phase<pg8::EpiBf16<0>, pg8::StaticOrder, true, true>((PG8_LAS unsigned char*)C.lds, g, S, E); }
            } else if (layer == 0 && F8_PROJ0 == 3) {
                { pg8::Gemm g{(const bfr*)(ws + WS_XN8), (const bfr*)(ws + WS_WTIN), NT, 8192, DM / 2}; pg8::StaticOrder S; S.init(NT, 8192, C.G, hb);
                  pg8::EpiBf16<0> E{BIG, N, nullptr, 8192, 0, 1.f / SU};
                  pg8::gemm_phase<pg8::EpiBf16<0>, pg8::StaticOrder, true, true, true>((PG8_LAS unsigned char*)C.lds, g, S, E); }
                __syncthreads();
                { pg8::Gemm g{XN, (const bfr*)(ws + WS_WTIN + (size_t)8192 * DM), NT, 8192, DM}; pg8::StaticOrder S; S.init(NT, 8192, C.G, hb);
                  pg8::EpiBf16<0> E{BIG + 8192, N, nullptr, 0, 0, 1.f};
                  pg8::gemm_phase<pg8::EpiBf16<0>, pg8::StaticOrder, true, true>((PG8_LAS unsigned char*)C.lds, g, S, E); }
            } else if (layer == 0 && F8_PROJ0 == 1) {
                pg8::Gemm g{(const bfr*)(ws + WS_XN8), (const bfr*)(ws + WS_WTIN), NT, N, DM / 2}; pg8::StaticOrder S; S.init(NT, N, C.G, hb);
                pg8::EpiBf16<0> E{BIG, N, nullptr, N, 0, 1.f / SU};
                pg8::gemm_phase<pg8::EpiBf16<0>, pg8::StaticOrder, true, true, true>((PG8_LAS unsigned char*)C.lds, g, S, E);
            } else if (layer == 1 && F8_KVQ) {
                { pg8::Gemm g{(const bfr*)(ws + WS_XN8), (const bfr*)(ws + WS_WTKVQ), NT, 8192, DM / 2}; pg8::StaticOrder S; S.init(NT, 8192, C.G, hb);
                  pg8::EpiBf16<0> E{BIG, N, nullptr, 8192, 0, 1.f / SU};
                  pg8::gemm_phase<pg8::EpiBf16<0>, pg8::StaticOrder, true, true, true>((PG8_LAS unsigned char*)C.lds, g, S, E); }
                __syncthreads();
                { pg8::Gemm g{XN, (const bfr*)(ws + WS_WTKVQ + (size_t)2 * DM * DM), NT, DM, DM}; pg8::StaticOrder S; S.init(NT, DM, C.G, hb);
                  pg8::EpiBf16<0> E{BIG + 8192, N, nullptr, 0, 0, 1.f};
                  pg8::gemm_phase<pg8::EpiBf16<0>, pg8::StaticOrder, true, true>((PG8_LAS unsigned char*)C.lds, g, S, E); }
            } else {
                pg8::Gemm g{XN, (const bfr*)(ws + (layer == 0 ? WS_WTIN : WS_WTKVQ)), NT, N, DM}; pg8::StaticOrder S; S.init(NT, N, C.G, hb);
                pg8::EpiBf16<0> E{BIG, N, nullptr, 0, 0, 1.f};
                pg8::gemm_phase<pg8::EpiBf16<0>, pg8::StaticOrder, true, true>((PG8_LAS unsigned char*)C.lds, g, S, E);
            }
        }
        SEAM(pb + 1);
        if (IN(pb + 2)) { if (layer == 0) p_bd(C, XN, (const bfr*)(ws + WS_WTBD), (float*)(ws + WS_BD)); else p_headprep(C, P); }
        SEAM(pb + 2);
        if (IN(pb + 3)) { if (layer == 0) p_gdn_prep(C, P); else p_attn(C, P); }
        SEAM(pb + 3);
        if (IN(pb + 4)) { if (layer == 0) p_gdn_scan2(C, P); else p_combine(C, P); }
        SEAM(pb + 4);
        if (IN(pb + 5)) { if (layer == 0) p_gdn_onorm(C, P); }
        SEAM(pb + 5);
        if (IN(pb + 6)) {
            pg8::Gemm g{XN, (const bfr*)(ws + (layer == 0 ? WS_WTOUT : WS_WTO)), NT, DM, DM}; pg8::StaticOrder S; S.init(NT, DM, C.G, hb);
            pg8::EpiRes E{layer == 0 ? P.in_(0) : (const float*)P.out_(), P.out_(), DM, 1.f};
            pg8::gemm_phase<pg8::EpiRes, pg8::StaticOrder, true, true>((PG8_LAS unsigned char*)C.lds, g, S, E);
        }
        SEAM(pb + 6);
        if (IN(pb + 7)) p_norm_rows(C, (const float*)P.out_(), XN, ws + WS_XN8);
        SEAM(pb + 7);
        if (IN(pb + 8)) {
            pg8::Gemm g{XN, (const bfr*)(ws + WS_WTQRY) + (size_t)layer * PQ * DM, NT, PQ, DM}; pg8::StaticOrder S; S.init(NT, PQ, C.G, hb);
            pg8::EpiBf16<0> E{(bfr*)(ws + WS_QRY), PQ, nullptr, 0, 0, 1.f};
            pg8::gemm_phase<pg8::EpiBf16<0>, pg8::StaticOrder, true, true>((PG8_LAS unsigned char*)C.lds, g, S, E);
        }
        SEAM(pb + 8);
        if (IN(pb + 9)) { p_sroute(C, P, layer); }
        SEAM(pb + 9); if (IN(pb + 9) && !IN(pb + 10) && IN(pb + 11)) xcd_barrier(bar);
        if (IN(pb + 11)) {
            pg8::Gemm g{(const bfr*)(ws + WS_XN8), (const bfr*)(ws + WS_U + (size_t)layer * PE * DM), NT, PE, DM / 2}; pg8::StaticOrder S; S.init(NT, PE, C.G, hb);
            pg8::EpiGate8 E{(bfr*)(ws + WS_G), ws + WS_A2, PE, 1.f / SU, SA};
            pg8::gemm_phase<pg8::EpiGate8, pg8::StaticOrder, true, true, true>((PG8_LAS unsigned char*)C.lds, g, S, E);
        }
        SEAM(pb + 11);
        if (IN(pb + 12)) {
            pg8::Gemm g{(const bfr*)(ws + WS_A2), (const bfr*)(ws + WS_VT + (size_t)layer * DM * PE), NT, DM, PE / 2}; pg8::StaticOrder S; S.init(NT, DM, C.G, hb);
            pg8::EpiRes E{(const float*)P.out_(), P.out_(), DM, 1.f / (SA * SV)};
            pg8::gemm_phase<pg8::EpiRes, pg8::StaticOrder, true, true, true>((PG8_LAS unsigned char*)C.lds, g, S, E);
        }
        SEAM(pb + 12);
    }
#undef IN
#undef SEAM
}

extern "C" void kernel_launch(void* const* d_in, const int* in_sizes, int n_in, void* d_out, int out_size, void* d_ws, size_t ws_size, hipStream_t stream) {
    static int grid = 0;
    if (grid == 0) {
        if (n_in != 26 || out_size != NT * DM || ws_size < WS_END) { fprintf(stderr, "kernel_launch: unexpected problem (n_in %d, out %d, ws %zu < %zu)\n", n_in, out_size, ws_size, (size_t)WS_END); grid = -1; return; }
        int dev = 0, cus = 0;
        if (hipGetDevice(&dev) != hipSuccess || hipDeviceGetAttribute(&cus, hipDeviceAttributeMultiprocessorCount, dev) != hipSuccess || cus <= 0) { grid = -1; return; }
        if (hipFuncSetAttribute((const void*)trunk_fwd, hipFuncAttributeMaxDynamicSharedMemorySize, LDS_BYTES) != hipSuccess) { fprintf(stderr, "kernel_launch: hipFuncSetAttribute failed\n"); grid = -1; return; }
        int per_cu = 0;
        if (hipOccupancyMaxActiveBlocksPerMultiprocessor(&per_cu, (const void*)trunk_fwd, 512, LDS_BYTES) != hipSuccess || per_cu < 1) { fprintf(stderr, "kernel_launch: occupancy query says %d blocks per CU\n", per_cu); }
        (void)hipGetLastError();
        grid = cus;
    }
    if (grid < 0) return;
    (void)in_sizes;
    if (hipMemsetAsync((char*)d_ws + WS_CTL, 0, CTL_ZERO_BYTES, stream) != hipSuccess) return;
    KArgs p{};
    for (int i = 0; i < 26; ++i) p.in[i] = (const float*)d_in[i];
    p.out = (float*)d_out; p.ws = (unsigned char*)d_ws;
#if MK_PER_PHASE
    for (int ph = 0; ph < NPHASE; ++ph) {
        if (ph == 1 + 5 + NPH_LAYER || ph == 1 + 10 || ph == 1 + 10 + NPH_LAYER) continue;
        p.ph_lo = ph; p.ph_hi = ph + 1; p.li = 0; p.pad = 0;
        hipLaunchKernelGGL(trunk_fwd, dim3(grid), dim3(512), LDS_BYTES, stream, p);
    }
#else
    p.ph_lo = 0; p.ph_hi = NPHASE; p.li = 0; p.pad = 0;
    hipLaunchKernelGGL(trunk_fwd, dim3(grid), dim3(512), LDS_BYTES, stream, p);
#endif
}
```

```cpp
#include <hip/hip_runtime.h>
#include <hip/hip_bf16.h>
#include <cstdio>
#include <cstdint>

#define LAS __attribute__((address_space(3)))
#define GAS __attribute__((address_space(1)))
typedef unsigned short bfr;
typedef short s8v __attribute__((ext_vector_type(8)));
typedef float f4v __attribute__((ext_vector_type(4)));
typedef unsigned u4v __attribute__((ext_vector_type(4)));
typedef unsigned u2v __attribute__((ext_vector_type(2)));
typedef int i4v __attribute__((ext_vector_type(4)));

#ifndef F8_PROJ0
#define F8_PROJ0 3
#endif
#ifndef F8_KVQ
#define F8_KVQ 2
#endif
#ifndef F8_OUT
#define F8_OUT 1
#endif
constexpr int NB = 2, SEQ = 4096, DM = 4096, NT = NB * SEQ;
constexpr int GH = 32, GD = 128, GIN = 16448, CH = 64, NCH = SEQ / CH;
constexpr int AH = 16, AD = 128, AV = 256;
constexpr int PH = 8, PK = 128, PE = 16384, PQ = 2048, PTOP = 16;
constexpr float EPS = 1e-6f;
constexpr float LAMBDA_INIT = 0.35550906759f;
constexpr float SU = 64.f, SA = 64.f, SV = 4.f, SO = 16.f;

constexpr size_t MiB = 1u << 20;
constexpr size_t WS_CTL   = 0;
constexpr size_t WS_WTIN  = 1 * MiB;
constexpr size_t WS_WTBD  = WS_WTIN + 128 * MiB;
constexpr size_t WS_WTOUT = WS_WTBD + 1 * MiB;
constexpr size_t WS_WTKVQ = WS_WTOUT + 32 * MiB;
constexpr size_t WS_WTO   = WS_WTKVQ + 96 * MiB;
constexpr size_t WS_WTQRY = WS_WTO + 32 * MiB;
constexpr size_t WS_WTKEY = WS_WTQRY + 32 * MiB;
constexpr size_t WS_U     = WS_WTKEY + 16 * MiB;
constexpr size_t WS_VT    = WS_U + 128 * MiB;
constexpr size_t WS_A2    = WS_VT + 128 * MiB;
constexpr size_t WS_XN8   = WS_A2 + 128 * MiB;
constexpr size_t WS_XN    = WS_XN8 + 32 * MiB;
constexpr size_t WS_BIG   = WS_XN + 64 * MiB;
constexpr size_t WS_R     = WS_BIG + 256 * MiB;
constexpr size_t WS_QRY   = WS_R + 352 * MiB;
constexpr size_t WS_SC    = WS_QRY + 32 * MiB;
constexpr size_t WS_BD    = WS_SC + 64 * MiB;
constexpr size_t WS_EG    = WS_BD + 2 * MiB;
constexpr size_t WS_G     = WS_EG + 1 * MiB;
constexpr size_t WS_END   = WS_G + 256 * MiB;
constexpr size_t R_W = 0, R_U = 64 * MiB, R_QG = 128 * MiB, R_KD = 192 * MiB, R_QK = 256 * MiB, R_O = 288 * MiB;
constexpr size_t R_QH = 0, R_KH = 64 * MiB, R_VH = 128 * MiB, R_OH = 192 * MiB;
static_assert(WS_END <= (size_t)1790 * MiB, "workspace map");

constexpr int CW_BAR = 4096;
constexpr size_t CTL_ZERO_BYTES = 1 * MiB;

constexpr int LDS_BYTES = 147456;
constexpr int MISC_OFF = 146944;

typedef float f2v_ __attribute__((ext_vector_type(2)));
typedef __bf16 b2v_ __attribute__((ext_vector_type(2)));
__device__ __forceinline__ unsigned cvtpk(float lo, float hi) { const b2v_ r = __builtin_convertvector((f2v_){lo, hi}, b2v_); return __builtin_bit_cast(unsigned, r); }
__device__ __forceinline__ unsigned cvt4_fp8(float a, float b, float c, float d) { int w = 0; w = __builtin_amdgcn_cvt_pk_fp8_f32(a, b, w, false); w = __builtin_amdgcn_cvt_pk_fp8_f32(c, d, w, true); return (unsigned)w; }
__device__ __forceinline__ float bflo(unsigned w) { return __uint_as_float(w << 16); }
__device__ __forceinline__ float bfhi(unsigned w) { return __uint_as_float(w & 0xffff0000u); }
__device__ __forceinline__ float bf1(bfr b) { return __uint_as_float(((unsigned)b) << 16); }
__device__ __forceinline__ bfr f2bf1(float f) { return (bfr)(cvtpk(f, 0.f) & 0xffffu); }
__device__ __forceinline__ float wave_sum(float v) {
#pragma unroll
    for (int o = 1; o < 64; o <<= 1) v += __shfl_xor(v, o);
    return v;
}
__device__ __forceinline__ f4v zero_acc() { f4v z = {0.f, 0.f, 0.f, 0.f}; asm volatile("" : "+v"(z)); return z; }
#define MFMA_SETTLE(acc) asm volatile("s_nop 7\n\ts_nop 7" : "+v"(acc))
#define LDS_WAIT() asm volatile("s_waitcnt lgkmcnt(0)" ::: "memory")
#define VM_WAIT() asm volatile("s_waitcnt vmcnt(0)" ::: "memory")
#define XB_TMO      128
#define XB_XCNT(j)  (256  + 64 * (j))
#define XB_XSUB(j)  (1280 + 64 * (j))
#define XB_XGEN(j)  (2304 + 64 * (j))
#define XB_TOP      3328
#define XB_TOPGEN   3392
#define XCD_BAR_WORDS 3456
#define XB_SPIN_CAP (1u << 18)

__device__ __forceinline__ unsigned xb_ld(unsigned* p)              { return __hip_atomic_load(p, __ATOMIC_RELAXED, __HIP_MEMORY_SCOPE_AGENT); }
__device__ __forceinline__ unsigned xb_add(unsigned* p, unsigned v) { return __hip_atomic_fetch_add(p, v, __ATOMIC_RELAXED, __HIP_MEMORY_SCOPE_AGENT); }
__device__ __forceinline__ unsigned xb_xcc_id() { return (unsigned)__builtin_amdgcn_s_getreg((3 << 11) | 20) & 0xFu; }
#define XB_SPIN(cond, bar) do { unsigned _sp = 0; while (cond) { __builtin_amdgcn_s_sleep(1); \
    if ((++_sp & 255u) == 0u) { if (xb_ld(&(bar)[XB_TMO])) break; if (_sp > XB_SPIN_CAP) { atomicAdd(&(bar)[XB_TMO], 1u); break; } } } } while (0)

struct XcdBarrier {
    unsigned* bar; unsigned x;
    volatile LAS unsigned* st;
};

__device__ __forceinline__ XcdBarrier xcd_barrier_post(unsigned* bar, volatile LAS unsigned* st) {
    XcdBarrier b; b.bar = bar; b.x = xb_xcc_id(); b.st = st;
    if (threadIdx.x == 0) (void)xb_add(&bar[XB_XCNT(b.x)], 1u);
    return b;
}
__device__ __forceinline__ void xcd_barrier_complete(unsigned* bar, unsigned x, unsigned& nloc, unsigned& nx) {
    const unsigned G = gridDim.x * gridDim.y * gridDim.z;
    unsigned sum, cnt, mine, sp = 0u;
    for (;;) {
        sum = 0u; cnt = 0u; mine = 0u;
#pragma unroll
        for (unsigned j = 0; j < 16; ++j) { const unsigned c = xb_ld(&bar[XB_XCNT(j)]); sum += c; cnt += (c > 0u) ? 1u : 0u; mine = (j == x) ? c : mine; }
        if (sum == G) break;
        __builtin_amdgcn_s_sleep(1);
        if ((++sp & 255u) == 0u) { if (xb_ld(&bar[XB_TMO])) break; if (sp > XB_SPIN_CAP) { atomicAdd(&bar[XB_TMO], 1u); break; } }
    }
    nloc = mine > 0u ? mine : 1u; nx = cnt > 0u ? cnt : 1u;
}

__device__ __forceinline__ void xcd_barrier(const XcdBarrier& b) {
    asm volatile("s_waitcnt vmcnt(0)" ::: "memory");
    __syncthreads();
    if (threadIdx.x == 0) {
        unsigned* bar = b.bar;
        __builtin_amdgcn_s_waitcnt(0);
        unsigned nloc = b.st[0], nx = b.st[1];
        if (nloc == 0u) { xcd_barrier_complete(bar, b.x, nloc, nx); b.st[0] = nloc; b.st[1] = nx; }
        const unsigned old = xb_add(&bar[XB_XSUB(b.x)], 1u);
        const unsigned gen = old / nloc;
        if (old + 1u == (gen + 1u) * nloc) {
            __builtin_amdgcn_fence(__ATOMIC_RELEASE, "agent");
            asm volatile("s_waitcnt vmcnt(0)" ::: "memory");
            const unsigned og = xb_add(&bar[XB_TOP], 1u);
            const unsigned tg = og / nx;
            if (og + 1u == (tg + 1u) * nx) xb_add(&bar[XB_TOPGEN], 1u);
            else XB_SPIN(xb_ld(&bar[XB_TOPGEN]) == tg, bar);
            __builtin_amdgcn_fence(__ATOMIC_ACQUIRE, "agent");
            xb_add(&bar[XB_XGEN(b.x)], 1u);
            asm volatile("s_waitcnt vmcnt(0)" ::: "memory");
        } else {
            XB_SPIN(xb_ld(&bar[XB_XGEN(b.x)]) == gen, bar);
            __builtin_amdgcn_fence(__ATOMIC_ACQUIRE, "agent");
            asm volatile("s_waitcnt vmcnt(0)" ::: "memory");
        }
    }
    __syncthreads();
}
namespace pg8 {
#define PG8_LAS __attribute__((address_space(3)))
typedef unsigned short bf16_t;
typedef short bf16x8 __attribute__((ext_vector_type(8)));
typedef float f32x4 __attribute__((ext_vector_type(4)));
typedef unsigned u32x4 __attribute__((ext_vector_type(4)));
typedef int i32x4 __attribute__((ext_vector_type(4)));
typedef int i32x8 __attribute__((ext_vector_type(8)));
typedef unsigned u32x2 __attribute__((ext_vector_type(2)));
constexpr int BM = 256, BK = 64, HALF = 128, HTB = HALF * BK * 2  , STAGE_BYTES = 8 * HTB, NXCD = 8, WGM = 8;

__host__ __device__ __forceinline__ int lds_byte(int r, int c) { const int st = (r >> 4) * 2 + (c >> 5), rr = r & 15, cc = c & 31, ob = rr * 64 + cc * 2; return st * 1024 + (ob ^ (((ob >> 9) & 1) << 5)); }
__host__ __device__ __forceinline__ void stage_rc(int b, int& R, int& C) { const int st = b / 1024, sb = b % 1024, swz = sb ^ (((sb >> 9) & 1) << 5); R = (st >> 1) * 16 + swz / 64; C = (st & 1) * 32 + (swz % 64) / 2; }
__host__ __device__ __forceinline__ int perm32(int rho) { const int n = rho >> 4, i = rho & 15; return 8 * (i >> 2) + 4 * n + (i & 3); }

struct Unit { int pm, pn; };
struct Gemm { const bf16_t* A; const bf16_t* Bt; int M, N, K; };

struct StaticOrder {
    int nM, nN, nwg, G, c;
    __host__ __device__ void init(int M, int N, int G_, int c_) { nM = M / BM; nN = N / BM; nwg = nM * nN; G = G_; c = c_; }
    __host__ __device__ bool next(int i, Unit& u) const {
        const long L = (long)i * G + c; if (L >= nwg) return false;
        int wgid = (int)L; { const int q = nwg / NXCD, r = nwg % NXCD, xcd = wgid % NXCD, off = wgid / NXCD; wgid = (xcd < r ? xcd * (q + 1) : r * (q + 1) + (xcd - r) * q) + off; }
        const int nig = WGM * nN, gid = wgid / nig, fm = gid * WGM, gsz = (nM - fm) < WGM ? (nM - fm) : WGM;
        u.pm = fm + ((wgid % nig) % gsz); u.pn = (wgid % nig) / gsz; return true;
    }
    __device__ __forceinline__ void a_ready(const Unit&) const {}
    __device__ __forceinline__ void done(const Unit&) const {}
};

__device__ __forceinline__ unsigned cvt_pk_bf16(float lo, float hi) { unsigned r; asm volatile("v_cvt_pk_bf16_f32 %0, %1, %2" : "=v"(r) : "v"(lo), "v"(hi)); return r; }
typedef float f32x2 __attribute__((ext_vector_type(2)));
__device__ __forceinline__ f32x2 gelu_pk(f32x2 v) {
    const f32x2 av = __builtin_elementwise_abs(v), d = av * 0.2316418882f + 1.0f;
    f32x2 t; t.x = __builtin_amdgcn_rcpf(d.x); t.y = __builtin_amdgcn_rcpf(d.y);
    f32x2 q = t * 0.5307027145f + (-0.7265760135f); q = q * t + 0.7107068705f; q = q * t + (-0.142248368f); q = q * t + 0.127414796f; q = q * t;
    const f32x2 s = (v * v) * (-0.72134752044f);
    f32x2 e; e.x = __builtin_amdgcn_exp2f(s.x); e.y = __builtin_amdgcn_exp2f(s.y);
    const f32x2 m = v * (q * e), r = v - m;
    f32x2 o; o.x = v.x < 0.f ? m.x : r.x; o.y = v.y < 0.f ? m.y : r.y; return o;
}

template <int ACT  > struct EpiBf16 {
    static constexpr bool PERM = true, AFTER_DRAIN = false; static_assert(ACT == 0 || ACT == 1, "EpiBf16: ACT is 0 (none) or 1 (gelu_pk)");
    bf16_t* O; int ldc; const float* bias; int split_cols; size_t split_stride; float scale0;
    __device__ __forceinline__ void operator()(const f32x4 (&acc)[2][2][4][2], const Unit& u, int wr, int wc, int fr, int fq) const {
        const int row0 = u.pm * BM + wr * 64 + fr; int colt = u.pn * BM; bf16_t* base = O;
        float sc = 1.f; if (split_cols) { const int t = colt / split_cols; base += (size_t)t * split_stride; colt -= t * split_cols; if (t == 0) sc = scale0; }
        const int col0 = colt + wc * 32 + 8 * fq, bcol0 = u.pn * BM + wc * 32 + 8 * fq;
        f32x4 bv[2][2];
#pragma unroll
        for (int bj = 0; bj < 2; ++bj)
#pragma unroll
            for (int n = 0; n < 2; ++n) bv[bj][n] = bias ? *(const f32x4*)(bias + bcol0 + bj * HALF + 4 * n) : (f32x4){0.f, 0.f, 0.f, 0.f};
#pragma unroll
        for (int ai = 0; ai < 2; ++ai)
#pragma unroll
            for (int m = 0; m < 4; ++m) { bf16_t* rowp = base + (size_t)(row0 + ai * HALF + m * 16) * ldc + col0;
#pragma unroll
                for (int bj = 0; bj < 2; ++bj) { f32x4 v0 = acc[ai][bj][m][0] + bv[bj][0], v1 = acc[ai][bj][m][1] + bv[bj][1];
                    if (ACT == 1) { f32x2 a = gelu_pk((f32x2){v0[0], v0[1]}), b = gelu_pk((f32x2){v0[2], v0[3]}), c = gelu_pk((f32x2){v1[0], v1[1]}), d = gelu_pk((f32x2){v1[2], v1[3]});
                        v0 = (f32x4){a.x, a.y, b.x, b.y}; v1 = (f32x4){c.x, c.y, d.x, d.y}; }
                    v0 = v0 * sc; v1 = v1 * sc; u32x4 w; w.x = cvt_pk_bf16(v0[0], v0[1]); w.y = cvt_pk_bf16(v0[2], v0[3]); w.z = cvt_pk_bf16(v1[0], v1[1]); w.w = cvt_pk_bf16(v1[2], v1[3]);
                    *(u32x4*)(rowp + bj * HALF) = w; } }
    }
};
struct EpiRes {
    static constexpr bool PERM = false, AFTER_DRAIN = false;
    const float* base; float* out; int ldc; float scale;
    __device__ __forceinline__ void operator()(const f32x4 (&acc)[2][2][4][2], const Unit& u, int wr, int wc, int fr, int fq) const {
        const int row0 = u.pm * BM + wr * 64 + fr, col0 = u.pn * BM + wc * 32 + 4 * fq;
#pragma unroll
        for (int ai = 0; ai < 2; ++ai)
#pragma unroll
            for (int m = 0; m < 4; ++m) { const size_t off = (size_t)(row0 + ai * HALF + m * 16) * ldc + col0;
                f32x4 bs[2][2];
#pragma unroll
                for (int bj = 0; bj < 2; ++bj)
#pragma unroll
                    for (int n = 0; n < 2; ++n) bs[bj][n] = *(const f32x4*)(base + off + bj * HALF + n * 16);
#pragma unroll
                for (int bj = 0; bj < 2; ++bj)
#pragma unroll
                    for (int n = 0; n < 2; ++n) *(f32x4*)(out + off + bj * HALF + n * 16) = bs[bj][n] + acc[ai][bj][m][n] * scale;
                asm volatile("" ::: "memory"); }
    }
};
struct EpiStF32 {
    static constexpr bool PERM = false, AFTER_DRAIN = false;
    float* C; int ldc;
    __device__ __forceinline__ void operator()(const f32x4 (&acc)[2][2][4][2], const Unit& u, int wr, int wc, int fr, int fq) const {
        const int row0 = u.pm * BM + wr * 64 + fr, col0 = u.pn * BM + wc * 32 + 4 * fq;
#pragma unroll
        for (int ai = 0; ai < 2; ++ai)
#pragma unroll
            for (int m = 0; m < 4; ++m) { float* rowp = C + (size_t)(row0 + ai * HALF + m * 16) * ldc + col0;
#pragma unroll
                for (int bj = 0; bj < 2; ++bj)
#pragma unroll
                    for (int n = 0; n < 2; ++n) *(f32x4*)(rowp + bj * HALF + n * 16) = acc[ai][bj][m][n]; }
    }
};
struct EpiGate {
    static constexpr bool PERM = true, AFTER_DRAIN = false;
    bf16_t* G; int ldc;
    __device__ __forceinline__ void operator()(const f32x4 (&acc)[2][2][4][2], const Unit& u, int wr, int wc, int fr, int fq) const {
        const int row0 = u.pm * BM + wr * 64 + fr, col0 = u.pn * BM + wc * 32 + 8 * fq;
#pragma unroll
        for (int ai = 0; ai < 2; ++ai)
#pragma unroll
            for (int m = 0; m < 4; ++m) { bf16_t* rowp = G + (size_t)(row0 + ai * HALF + m * 16) * ldc + col0;
                u32x4 g[2];
#pragma unroll
                for (int bj = 0; bj < 2; ++bj) g[bj] = *(const u32x4*)(rowp + bj * HALF);
#pragma unroll
                for (int bj = 0; bj < 2; ++bj) {
                    if ((g[bj].x | g[bj].y | g[bj].z | g[bj].w) != 0u) {
                        const f32x4 v0 = acc[ai][bj][m][0], v1 = acc[ai][bj][m][1];
                        const f32x2 a = gelu_pk((f32x2){v0[0], v0[1]}), b = gelu_pk((f32x2){v0[2], v0[3]}), c = gelu_pk((f32x2){v1[0], v1[1]}), d = gelu_pk((f32x2){v1[2], v1[3]});
                        u32x4 w;
                        w.x = cvt_pk_bf16(a.x * __uint_as_float(g[bj].x << 16), a.y * __uint_as_float(g[bj].x & 0xffff0000u));
                        w.y = cvt_pk_bf16(b.x * __uint_as_float(g[bj].y << 16), b.y * __uint_as_float(g[bj].y & 0xffff0000u));
                        w.z = cvt_pk_bf16(c.x * __uint_as_float(g[bj].z << 16), c.y * __uint_as_float(g[bj].z & 0xffff0000u));
                        w.w = cvt_pk_bf16(d.x * __uint_as_float(g[bj].w << 16), d.y * __uint_as_float(g[bj].w & 0xffff0000u));
                        *(u32x4*)(rowp + bj * HALF) = w;
                    }
                } }
    }
};
struct EpiGate8 {
    static constexpr bool PERM = true, AFTER_DRAIN = false;
    bf16_t* G; unsigned char* A2; int ldc; float hscale, oscale;
    __device__ __forceinline__ void operator()(const f32x4 (&acc)[2][2][4][2], const Unit& u, int wr, int wc, int fr, int fq) const {
        const int row0 = u.pm * BM + wr * 64 + fr, col0 = u.pn * BM + wc * 32 + 8 * fq;
#pragma unroll
        for (int ai = 0; ai < 2; ++ai)
#pragma unroll
            for (int m = 0; m < 4; ++m) { const size_t ro = (size_t)(row0 + ai * HALF + m * 16) * ldc + col0;
                u32x4 g[2];
#pragma unroll
                for (int bj = 0; bj < 2; ++bj) g[bj] = *(const u32x4*)(G + ro + bj * HALF);
#pragma unroll
                for (int bj = 0; bj < 2; ++bj) {
                    u32x2 w = {0u, 0u};
                    if ((g[bj].x | g[bj].y | g[bj].z | g[bj].w) != 0u) {
                        const f32x4 v0 = acc[ai][bj][m][0] * hscale, v1 = acc[ai][bj][m][1] * hscale;
                        const f32x2 a = gelu_pk((f32x2){v0[0], v0[1]}), b = gelu_pk((f32x2){v0[2], v0[3]}), c = gelu_pk((f32x2){v1[0], v1[1]}), d = gelu_pk((f32x2){v1[2], v1[3]});
                        float y[8] = {a.x * __uint_as_float(g[bj].x << 16), a.y * __uint_as_float(g[bj].x & 0xffff0000u), b.x * __uint_as_float(g[bj].y << 16), b.y * __uint_as_float(g[bj].y & 0xffff0000u),
                                      c.x * __uint_as_float(g[bj].z << 16), c.y * __uint_as_float(g[bj].z & 0xffff0000u), d.x * __uint_as_float(g[bj].w << 16), d.y * __uint_as_float(g[bj].w & 0xffff0000u)};
#pragma unroll
                        for (int k = 0; k < 8; ++k) y[k] = fminf(fmaxf(y[k] * oscale, -440.f), 440.f);
                        int lo = 0, hi = 0;
                        lo = __builtin_amdgcn_cvt_pk_fp8_f32(y[0], y[1], lo, false); lo = __builtin_amdgcn_cvt_pk_fp8_f32(y[2], y[3], lo, true);
                        hi = __builtin_amdgcn_cvt_pk_fp8_f32(y[4], y[5], hi, false); hi = __builtin_amdgcn_cvt_pk_fp8_f32(y[6], y[7], hi, true);
                        w.x = (unsigned)lo; w.y = (unsigned)hi;
                        *(u32x4*)(G + ro + bj * HALF) = (u32x4){0u, 0u, 0u, 0u};
                    }
                    *(u32x2*)(A2 + ro + bj * HALF) = w;
                } }
    }
};
template <class Epi, class Sched, bool ALIGN_EPI = false, bool SP2 = false, bool F8 = false>
__device__ __forceinline__ void gemm_phase(PG8_LAS unsigned char* lds, const Gemm g, const Sched& S, const Epi& E) {
    const int tid = threadIdx.x, wid = __builtin_amdgcn_readfirstlane(tid >> 6), lane = tid & 63, wr = wid >> 2, wc = wid & 3, fr = lane & 15, fq = lane >> 4;
    const int K = g.K, nt = K / BK;
    unsigned voffA[2], voffB[2];
#pragma unroll
    for (int i = 0; i < 2; ++i) { int R, C; stage_rc(tid * 16 + i * 8192, R, C); const int Rb = Epi::PERM ? ((R & ~31) + perm32(R & 31)) : R;
        voffA[i] = (unsigned)(R * K + C) * 2u; voffB[i] = (unsigned)(Rb * K + C) * 2u; }
    const size_t kstep = (size_t)(BK * 2);
    const size_t hstep = (size_t)HALF * K * 2;
    const size_t tstep = 2 * hstep;
    const unsigned ldsw = (unsigned)wid * 1024u;
    const int aoff = lds_byte(wr * 64 + fr, fq * 8), boff = lds_byte(wc * 32 + fr, fq * 8);
#define PG8_SA(b, h) (((b) * 2 + (h)) * HTB)
#define PG8_SB(b, h) ((4 + (b) * 2 + (h)) * HTB)
#define PG8_STAGE(bufoff, gbase, voff) do { _Pragma("unroll") for (int _i = 0; _i < 2; ++_i) \
        __builtin_amdgcn_global_load_lds((const unsigned*)((const char*)(gbase) + (voff)[_i]), (PG8_LAS unsigned*)(lds + (bufoff) + ldsw + _i * 8192), 16, 0, 0); } while (0)
#define PG8_LDA(dst, b, h) do { if constexpr (F8) { _Pragma("unroll") for (int m = 0; m < 4; ++m) { const i32x4 lo_ = *(const PG8_LAS i32x4*)(lds + PG8_SA(b, h) + aoff + m * 2048), hi_ = *(const PG8_LAS i32x4*)(lds + PG8_SA(b, h) + aoff + m * 2048 + 1024); \
        dst##_8[m] = __builtin_shufflevector(lo_, hi_, 0, 1, 2, 3, 4, 5, 6, 7); } } else { _Pragma("unroll") for (int m = 0; m < 4; ++m) _Pragma("unroll") for (int k = 0; k < 2; ++k) dst[m][k] = *(const PG8_LAS bf16x8*)(lds + PG8_SA(b, h) + aoff + m * 2048 + k * 1024); } } while (0)
#define PG8_LDB(dst, b, h) do { if constexpr (F8) { _Pragma("unroll") for (int n = 0; n < 2; ++n) { const i32x4 lo_ = *(const PG8_LAS i32x4*)(lds + PG8_SB(b, h) + boff + n * 2048), hi_ = *(const PG8_LAS i32x4*)(lds + PG8_SB(b, h) + boff + n * 2048 + 1024); \
        dst##_8[n] = __builtin_shufflevector(lo_, hi_, 0, 1, 2, 3, 4, 5, 6, 7); } } else { _Pragma("unroll") for (int n = 0; n < 2; ++n) _Pragma("unroll") for (int k = 0; k < 2; ++k) dst[n][k] = *(const PG8_LAS bf16x8*)(lds + PG8_SB(b, h) + boff + n * 2048 + k * 1024); } } while (0)
#define PG8_MMA(ai, bj, At, Bt) do { __builtin_amdgcn_s_setprio(1); if constexpr (F8) { _Pragma("unroll") for (int m = 0; m < 4; ++m) _Pragma("unroll") for (int n = 0; n < 2; ++n) \
        asm volatile("v_mfma_f32_16x16x128_f8f6f4 %0, %1, %2, %0" : "+v"(acc[ai][bj][m][n]) : "v"(Bt##_8[n]), "v"(At##_8[m])); } \
    else { _Pragma("unroll") for (int m = 0; m < 4; ++m) _Pragma("unroll") for (int n = 0; n < 2; ++n) _Pragma("unroll") for (int k = 0; k < 2; ++k) \
        acc[ai][bj][m][n] = __builtin_amdgcn_mfma_f32_16x16x32_bf16(Bt[n][k], At[m][k], acc[ai][bj][m][n], 0, 0, 0); } __builtin_amdgcn_s_setprio(0); } while (0)
#define PG8_WAIT_V(n) asm volatile("s_waitcnt vmcnt(" #n ")" ::: "memory")
#define PG8_WAIT_L(n) asm volatile("s_waitcnt lgkmcnt(" #n ")" ::: "memory")
#define PG8_BAR __builtin_amdgcn_s_barrier()
#define PG8_SCHED __builtin_amdgcn_sched_barrier(0)
    Unit cur, nxt; int ui = 0;
    if (!S.next(0, cur)) return;
    f32x4 acc[2][2][4][2];
#pragma unroll
    for (int a = 0; a < 2; ++a)
#pragma unroll
        for (int b = 0; b < 2; ++b)
#pragma unroll
            for (int m = 0; m < 4; ++m)
#pragma unroll
                for (int n = 0; n < 2; ++n) acc[a][b][m][n] = (f32x4){0.f, 0.f, 0.f, 0.f};
    const int f8_scale_one = 0x7F7F7F7F;
    bf16x8 At[4][2], B0[2][2], B1[2][2]; i32x8 At_8[4], B0_8[2], B1_8[2];
    const char* cA = (const char*)g.A + (size_t)cur.pm * tstep; const char* cB = (const char*)g.Bt + (size_t)cur.pn * tstep;
    S.a_ready(cur);
    if constexpr (SP2) {
        PG8_STAGE(PG8_SB(0, 0), cB, voffB); PG8_STAGE(PG8_SB(0, 1), cB + hstep, voffB); PG8_STAGE(PG8_SA(0, 0), cA, voffA); PG8_STAGE(PG8_SA(0, 1), cA + hstep, voffA);
        if (wr == 1) PG8_BAR;
        PG8_WAIT_V(2); PG8_BAR;
        PG8_STAGE(PG8_SB(1, 0), cB + kstep, voffB); PG8_STAGE(PG8_SA(1, 0), cA + kstep, voffA); PG8_STAGE(PG8_SB(1, 1), cB + hstep + kstep, voffB);
        PG8_WAIT_V(6); PG8_BAR;
    } else {
        PG8_STAGE(PG8_SB(0, 0), cB, voffB); PG8_STAGE(PG8_SA(0, 0), cA, voffA); PG8_STAGE(PG8_SB(0, 1), cB + hstep, voffB); PG8_STAGE(PG8_SA(0, 1), cA + hstep, voffA);
        if (wr == 1) PG8_BAR;
        PG8_WAIT_V(4); PG8_BAR;
        PG8_STAGE(PG8_SB(1, 0), cB + kstep, voffB); PG8_STAGE(PG8_SA(1, 0), cA + kstep, voffA); PG8_STAGE(PG8_SB(1, 1), cB + hstep + kstep, voffB);
        PG8_WAIT_V(6); PG8_BAR;
    }
    for (;;) {
        const bool has_next = S.next(ui + 1, nxt);
        const char* nA = has_next ? (const char*)g.A + (size_t)nxt.pm * tstep : cA; const char* nB = has_next ? (const char*)g.Bt + (size_t)nxt.pn * tstep : cB;
        for (int t = 0; t < nt; t += 2) {
            const bool last = (t == nt - 2);
            const char* a1 = cA + (size_t)(t + 1) * kstep;
            const char* a2 = last ? nA : cA + (size_t)(t + 2) * kstep; const char* b2 = last ? nB : cB + (size_t)(t + 2) * kstep;
            const char* a3 = a2 + kstep; const char* b3 = b2 + kstep;
            if (last && has_next) S.a_ready(nxt);
            if constexpr (SP2) {
            PG8_LDB(B0, 0, 0); PG8_LDB(B1, 0, 1); PG8_SCHED; PG8_LDA(At, 0, 0); PG8_STAGE(PG8_SA(1, 1), a1 + hstep, voffA);
            PG8_WAIT_V(8); PG8_WAIT_L(0); PG8_BAR; PG8_MMA(0, 0, At, B0); PG8_MMA(0, 1, At, B1); PG8_BAR; PG8_SCHED;
            PG8_LDA(At, 0, 1); PG8_STAGE(PG8_SB(0, 0), b2, voffB); PG8_STAGE(PG8_SB(0, 1), b2 + hstep, voffB); PG8_STAGE(PG8_SA(0, 0), a2, voffA);
            PG8_WAIT_V(8); PG8_WAIT_L(0); PG8_BAR; PG8_MMA(1, 0, At, B0); PG8_MMA(1, 1, At, B1); PG8_BAR; PG8_SCHED;
            PG8_LDB(B0, 1, 0); PG8_LDB(B1, 1, 1); PG8_SCHED; PG8_LDA(At, 1, 0); PG8_STAGE(PG8_SA(0, 1), a2 + hstep, voffA);
            PG8_WAIT_V(8); PG8_WAIT_L(0); PG8_BAR; PG8_MMA(0, 0, At, B0); PG8_MMA(0, 1, At, B1); PG8_BAR; PG8_SCHED;
            PG8_LDA(At, 1, 1); PG8_STAGE(PG8_SB(1, 0), b3, voffB); PG8_STAGE(PG8_SB(1, 1), b3 + hstep, voffB); PG8_STAGE(PG8_SA(1, 0), a3, voffA);
            PG8_WAIT_V(8); PG8_WAIT_L(0); PG8_BAR; PG8_MMA(1, 0, At, B0); PG8_MMA(1, 1, At, B1); PG8_BAR; PG8_SCHED;
            } else {
            PG8_LDB(B0, 0, 0); PG8_SCHED; PG8_LDA(At, 0, 0); PG8_STAGE(PG8_SA(1, 1), a1 + hstep, voffA);
            PG8_WAIT_L(8); PG8_BAR; PG8_WAIT_L(0); PG8_MMA(0, 0, At, B0); PG8_BAR; PG8_SCHED;
            PG8_LDB(B1, 0, 1); PG8_STAGE(PG8_SB(0, 0), b2, voffB);
            PG8_BAR; PG8_WAIT_L(0); PG8_MMA(0, 1, At, B1); PG8_BAR;
            PG8_LDA(At, 0, 1); PG8_STAGE(PG8_SA(0, 0), a2, voffA);
            PG8_BAR; PG8_WAIT_L(0); PG8_MMA(1, 0, At, B0); PG8_BAR; PG8_SCHED;
            PG8_STAGE(PG8_SB(0, 1), b2 + hstep, voffB);
            PG8_WAIT_V(6); PG8_BAR; PG8_MMA(1, 1, At, B1); PG8_BAR;
            PG8_LDB(B0, 1, 0); PG8_SCHED; PG8_LDA(At, 1, 0); PG8_STAGE(PG8_SA(0, 1), a2 + hstep, voffA);
            PG8_WAIT_L(8); PG8_BAR; PG8_WAIT_L(0); PG8_MMA(0, 0, At, B0); PG8_BAR; PG8_SCHED;
            PG8_LDB(B1, 1, 1); PG8_STAGE(PG8_SB(1, 0), b3, voffB);
            PG8_BAR; PG8_WAIT_L(0); PG8_MMA(0, 1, At, B1); PG8_BAR;
            PG8_LDA(At, 1, 1); PG8_STAGE(PG8_SA(1, 0), a3, voffA);
            PG8_BAR; PG8_WAIT_L(0); PG8_MMA(1, 0, At, B0); PG8_BAR; PG8_SCHED;
            PG8_STAGE(PG8_SB(1, 1), b3 + hstep, voffB);
            PG8_WAIT_V(6); PG8_BAR; PG8_MMA(1, 1, At, B1); PG8_BAR;
            }
        }
        if constexpr (ALIGN_EPI) { if (wr == 0) PG8_BAR; }
        if constexpr (!Epi::AFTER_DRAIN) { E(acc, cur, wr, wc, fr, fq); S.done(cur); }
        if (!has_next) break;
#pragma unroll
        for (int a = 0; a < 2; ++a)
#pragma unroll
            for (int b = 0; b < 2; ++b)
#pragma unroll
                for (int m = 0; m < 4; ++m)
#pragma unroll
                    for (int n = 0; n < 2; ++n) acc[a][b][m][n] = (f32x4){0.f, 0.f, 0.f, 0.f};
        cur = nxt; cA = nA; cB = nB; ++ui;
        if constexpr (ALIGN_EPI) { if (wr == 1) PG8_BAR; }
    }
    PG8_WAIT_V(0);
    if constexpr (!ALIGN_EPI) { if (wr == 0) PG8_BAR; }
    PG8_BAR;
    if constexpr (Epi::AFTER_DRAIN) { E.fused(acc, cur, wr, wc, fr, fq, lds, wid, lane); S.done(cur); }
#undef PG8_SA
#undef PG8_SB
#undef PG8_STAGE
#undef PG8_LDA
#undef PG8_LDB
#undef PG8_MMA
#undef PG8_WAIT_V
#undef PG8_WAIT_L
#undef PG8_BAR
#undef PG8_SCHED
}
}
namespace att {
constexpr int D = 128;
constexpr int WINDOW = 4096;
constexpr float THR = 8.f;
constexpr bool WSKIP = false;
constexpr float SCALE = 0.08838834764831845f;
constexpr int NW = 8, QBLK = 32, KVBLK = 64, QB = NW * QBLK;
constexpr int SHM_V = KVBLK * D * 2, SHM_K = KVBLK * D * 2;
constexpr int LDS_BYTES = 2 * SHM_V + 2 * SHM_K + NW * 64 * 4;
using bf16 = __hip_bfloat16;
typedef short bf16x8 __attribute__((ext_vector_type(8)));
typedef short s16x4 __attribute__((ext_vector_type(4)));
typedef float f32x16 __attribute__((ext_vector_type(16)));
typedef float f32x4 __attribute__((ext_vector_type(4)));
typedef unsigned u32x4 __attribute__((ext_vector_type(4)));
template <class A, class Bt> struct same_t { static constexpr bool v = false; };
template <class A> struct same_t<A, A> { static constexpr bool v = true; };

#define KSWZ(row, colB) ((row) * 256 + ((colB) ^ (((row) & 7) << 4)))
#define SBAR() __builtin_amdgcn_sched_barrier(0)
__device__ __forceinline__ int v_st(int k, int c) { const int kk = (k & ~0xC) | ((k & 4) << 1) | ((k & 8) >> 1); return ((kk >> 3) * 4 + (c >> 5)) * 512 + ((kk & 7) * 32 + (c & 31)) * 2; }
__device__ __forceinline__ int v_rd_base(int lane) { return ((lane & 3) << 3) | (((lane >> 2) & 3) << 6) | (((lane >> 4) & 1) << 5) | (((lane >> 5) & 1) << 8); }
constexpr int v_rd_off(int d0, int ks, int half) { return d0 * 512 + ks * 4096 + half * 2048; }
__device__ __forceinline__ int crow(int r, int hi) { return (r & 3) + 8 * (r >> 2) + 4 * hi; }
__device__ __forceinline__ unsigned cvtpk(float lo, float hi) {
    unsigned r; asm volatile("v_cvt_pk_bf16_f32 %0, %1, %2" : "=v"(r) : "v"(lo), "v"(hi)); return r;
}
__device__ __forceinline__ bf16x8 pack8(f32x4 a, f32x4 b) {
    u32x4 w = {cvtpk(a[0], a[1]), cvtpk(a[2], a[3]), cvtpk(b[0], b[1]), cvtpk(b[2], b[3])};
    return *reinterpret_cast<bf16x8*>(&w);
}
template <class T> __device__ __forceinline__ bf16x8 load8(const T* p) {
    if constexpr (same_t<T, float>::v) { return pack8(*(const f32x4*)p, *(const f32x4*)(p + 4)); }
    else { return *reinterpret_cast<const bf16x8*>(p); }
}
__device__ __forceinline__ void mask_tile(f32x16& p0, f32x16& p1, int dq, unsigned W) {
    const float NEG = -__builtin_inff();
#pragma unroll
    for (int r = 0; r < 16; ++r) {
        const int c = (r & 3) + 8 * (r >> 2);
        if ((unsigned)(dq - c) >= W) p0[r] = NEG;
        if ((unsigned)(dq - c - 32) >= W) p1[r] = NEG;
    }
}
__device__ __forceinline__ void partialSM(f32x16& p0, f32x16& p1, float& m_reg, float& mn, float& alpha) {
    float pmax = p0[0]; for (int r = 1; r < 16; ++r) pmax = fmaxf(pmax, p0[r]); for (int r = 0; r < 16; ++r) pmax = fmaxf(pmax, p1[r]);
    { auto rr = __builtin_amdgcn_permlane32_swap(__float_as_uint(pmax), __float_as_uint(pmax), false, false);
      pmax = fmaxf(__uint_as_float(rr[0]), __uint_as_float(rr[1])); }
    constexpr float C2 = 1.4426950408889634f * SCALE;
    if (__builtin_expect(__all((pmax - m_reg) * SCALE <= THR), 1)) { mn = m_reg; alpha = 1.f; }
    else { mn = fmaxf(m_reg, pmax); alpha = __builtin_amdgcn_exp2f((m_reg - mn) * C2); m_reg = mn; }
    const float mnL = -mn * C2;
    for (int r = 0; r < 16; ++r) p0[r] = fmaf(p0[r], C2, mnL); for (int r = 0; r < 16; ++r) p1[r] = fmaf(p1[r], C2, mnL);
    for (int r = 0; r < 16; ++r) p0[r] = __builtin_amdgcn_exp2f(p0[r]);
}
__device__ __forceinline__ void finishSM(f32x16& p0, f32x16& p1, float alpha, float& l_reg, bf16x8& pa0, bf16x8& pa1, bf16x8& pa2, bf16x8& pa3) {
    for (int r = 0; r < 16; ++r) p1[r] = __builtin_amdgcn_exp2f(p1[r]);
    float ps = 0; for (int r = 0; r < 16; ++r) ps += p0[r]; for (int r = 0; r < 16; ++r) ps += p1[r];
    { auto rr = __builtin_amdgcn_permlane32_swap(__float_as_uint(ps), __float_as_uint(ps), false, false);
      ps = __uint_as_float(rr[0]) + __uint_as_float(rr[1]); }
    l_reg = l_reg * alpha + ps;
#define PK4(P, B_, OUT) do { unsigned a0 = cvtpk(P[B_+0], P[B_+1]), a1 = cvtpk(P[B_+2], P[B_+3]);                          \
        unsigned b0 = cvtpk(P[B_+4], P[B_+5]), b1 = cvtpk(P[B_+6], P[B_+7]);                                             \
        auto r0 = __builtin_amdgcn_permlane32_swap(a0, b0, false, false); auto r1 = __builtin_amdgcn_permlane32_swap(a1, b1, false, false); \
        u32x4 w = {r0[0], r1[0], r0[1], r1[1]}; OUT = *reinterpret_cast<bf16x8*>(&w); } while (0)
    PK4(p0, 0, pa0); PK4(p0, 8, pa1); PK4(p1, 0, pa2); PK4(p1, 8, pa3);
#undef PK4
}
template <int KB, bool SK>
__device__ __forceinline__ void qkt(f32x16& p0, f32x16& p1, const char* K_lds, int r32, int hi, const bf16x8* qr, bool act) {
    if (SK && !act) { const float NEG = -__builtin_inff();
#pragma unroll
        for (int r = 0; r < 16; ++r) { p0[r] = NEG; p1[r] = NEG; } return; }
    p0 = f32x16{}; p1 = f32x16{};
    const char* kb[4];
#pragma unroll
    for (int dd = 0; dd < 4; ++dd) kb[dd] = K_lds + KB * SHM_K + KSWZ(r32, (dd * 16 + hi * 8) * 2);
#pragma unroll
    for (int d0 = 0; d0 < 8; ++d0) { const char* a = kb[d0 & 3] + (d0 >> 2) * 128;
        bf16x8 b0 = *reinterpret_cast<const bf16x8*>(a);
        bf16x8 b1 = *reinterpret_cast<const bf16x8*>(a + 32 * 256);
        p0 = __builtin_amdgcn_mfma_f32_32x32x16_bf16(b0, qr[d0], p0, 0, 0, 0);
        p1 = __builtin_amdgcn_mfma_f32_32x32x16_bf16(b1, qr[d0], p1, 0, 0, 0); }
}
template <int VB, bool SK>
__device__ __forceinline__ void pv_tile(f32x16* o, int vb0, bf16x8 pa0, bf16x8 pa1, bf16x8 pa2, bf16x8 pa3, bool act) {
    if (SK && !act) return;
#define TRRD(dst, off) asm volatile("ds_read_b64_tr_b16 %0, %1 offset:%2" : "=&v"(dst) : "v"(vb0), "i"(off) : "memory")
#define PV_D0(d0) do { s16x4 l0, l1, l2, l3, h0, h1, h2, h3; constexpr int b_ = VB * SHM_V + v_rd_off(d0, 0, 0);     \
        TRRD(l0, b_); TRRD(h0, b_ + 2048); TRRD(l1, b_ + 4096); TRRD(h1, b_ + 6144); TRRD(l2, b_ + 8192); TRRD(h2, b_ + 10240); TRRD(l3, b_ + 12288); TRRD(h3, b_ + 14336); \
        asm volatile("s_waitcnt lgkmcnt(0)" ::: "memory"); SBAR();                 \
        o[d0] = __builtin_amdgcn_mfma_f32_32x32x16_bf16(pa0, (bf16x8){l0[0], l0[1], l0[2], l0[3], h0[0], h0[1], h0[2], h0[3]}, o[d0], 0, 0, 0);   \
        o[d0] = __builtin_amdgcn_mfma_f32_32x32x16_bf16(pa1, (bf16x8){l1[0], l1[1], l1[2], l1[3], h1[0], h1[1], h1[2], h1[3]}, o[d0], 0, 0, 0);   \
        o[d0] = __builtin_amdgcn_mfma_f32_32x32x16_bf16(pa2, (bf16x8){l2[0], l2[1], l2[2], l2[3], h2[0], h2[1], h2[2], h2[3]}, o[d0], 0, 0, 0);   \
        o[d0] = __builtin_amdgcn_mfma_f32_32x32x16_bf16(pa3, (bf16x8){l3[0], l3[1], l3[2], l3[3], h3[0], h3[1], h3[2], h3[3]}, o[d0], 0, 0, 0); } while (0)
    PV_D0(0); PV_D0(1); PV_D0(2); PV_D0(3);
#undef PV_D0
#undef TRRD
}

template <class TIn, class TOut> struct BlockRef { const TIn* Q; const TIn* K; const TIn* V; TOut* O; int P0; };
template <class TIn> struct Seam {
    bf16x8 qr[8];
    bf16x8 st_v0, st_v1, st_k0, st_k1; f32x4 sf0, sf1, sf2, sf3;
    f32x4 tq[16];
};
__device__ __forceinline__ int swa_jlo(int P0, int W) { const int lowk = P0 - W + 1; return lowk > 0 ? lowk / KVBLK : 0; }
#define ROW(p, k0, rr) ((p) + (size_t)((k0) + (rr)) * D + sc)
#define VMW() asm volatile("s_waitcnt vmcnt(0)" ::: "memory")
#define VMWN(n) asm volatile("s_waitcnt vmcnt(%0)" :: "i"(n) : "memory")
#define SLOAD_H(Kp, Vp, k0) do { S.st_v0 = load8<TIn>(ROW(Vp, k0, sr)); S.st_v1 = load8<TIn>(ROW(Vp, k0, 32 + sr));              \
                         S.st_k0 = load8<TIn>(ROW(Kp, k0, sr)); S.st_k1 = load8<TIn>(ROW(Kp, k0, 32 + sr)); } while (0)
#define SWRITE_HK(bf) do { *(bf16x8*)(K_lds + (bf) * SHM_K + kws) = S.st_k0; *(bf16x8*)(K_lds + (bf) * SHM_K + kws + 32 * 256) = S.st_k1; } while (0)
#define SWRITE_HV(bf) do { *(bf16x8*)(V_lds + (bf) * SHM_V + vst0) = S.st_v0; *(bf16x8*)(V_lds + (bf) * SHM_V + vst1) = S.st_v1; } while (0)
#define SWRITE_H(bf) do { SWRITE_HV(bf); SWRITE_HK(bf); } while (0)
#define SLOAD_F(p, k0) do { S.sf0 = *(const f32x4*)ROW(p, k0, sr); S.sf1 = *(const f32x4*)(ROW(p, k0, sr) + 4);                \
                            S.sf2 = *(const f32x4*)ROW(p, k0, 32 + sr); S.sf3 = *(const f32x4*)(ROW(p, k0, 32 + sr) + 4); } while (0)
#define SWRITE_KF(bf) do { *(bf16x8*)(K_lds + (bf) * SHM_K + kws) = pack8(S.sf0, S.sf1); *(bf16x8*)(K_lds + (bf) * SHM_K + kws + 32 * 256) = pack8(S.sf2, S.sf3); } while (0)
#define SWRITE_VF(bf) do { *(bf16x8*)(V_lds + (bf) * SHM_V + vst0) = pack8(S.sf0, S.sf1); *(bf16x8*)(V_lds + (bf) * SHM_V + vst1) = pack8(S.sf2, S.sf3); } while (0)
template <class TIn, class TOut>
__device__ __forceinline__ void causal_swa_prime(const BlockRef<TIn, TOut>& cur, int W, char* lds, Seam<TIn>& S) {
    constexpr bool F32 = same_t<TIn, float>::v;
    const int tid = threadIdx.x, wid = __builtin_amdgcn_readfirstlane(tid >> 6), lane = tid & 63, r32 = lane & 31, hi = lane >> 5;
    const int sr = tid >> 4, sc = (tid & 15) * 8, kws = KSWZ(sr, sc * 2); char* K_lds = lds + 2 * SHM_V;
    const int kb0 = swa_jlo(cur.P0, W) * KVBLK;
    for (int d0 = 0; d0 < 8; ++d0) S.qr[d0] = load8<TIn>(cur.Q + (size_t)(wid * QBLK + r32) * D + d0 * 16 + hi * 8);
    if constexpr (F32) { SLOAD_F((const float*)cur.K, kb0); VMW(); SWRITE_KF(0); SBAR(); SLOAD_F((const float*)cur.V, kb0); }
    else { SLOAD_H(cur.K, cur.V, kb0); VMW(); SWRITE_HK(0); }
    __syncthreads();
}
template <class TIn, class TOut>
__device__ __forceinline__ void causal_swa_block(const BlockRef<TIn, TOut>& cur, const BlockRef<TIn, TOut>& nxt, int skv, int W, char* lds, Seam<TIn>& S) {
    constexpr bool F32 = same_t<TIn, float>::v;
    const int tid = threadIdx.x, wid = __builtin_amdgcn_readfirstlane(tid >> 6), lane = tid & 63, r32 = lane & 31, hi = lane >> 5;
    const int j_lo = swa_jlo(cur.P0, W);
    int j_hi = (cur.P0 + QB - 1) / KVBLK + 1; if (j_hi > skv / KVBLK) j_hi = skv / KVBLK;
    const int NT = j_hi - j_lo;
    const int kbn = swa_jlo(nxt.P0, W) * KVBLK;
    const int qlo = cur.P0 + wid * QBLK, qm = qlo + r32 - 4 * hi;
    char* V_lds = lds; char* K_lds = lds + 2 * SHM_V;
    float* ws = (float*)(lds + 2 * SHM_V + 2 * SHM_K) + wid * 64; float* li_l = ws, * al_l = ws + 32;
    float m_reg = -1e30f, l_reg = 0; f32x16 o[4] = {};
    const int sr = tid >> 4, sc = (tid & 15) * 8, vst0 = v_st(sr, sc), vst1 = v_st(32 + sr, sc), kws = KSWZ(sr, sc * 2);
    const int vb0 = (int)(uintptr_t)V_lds + v_rd_base(lane);
    const TIn* Kh = cur.K; const TIn* Vh = cur.V;
#define RESC(a) do { if (__any((a) < 1.f)) { if (hi == 0) al_l[r32] = (a); asm volatile("s_waitcnt lgkmcnt(0)" ::: "memory");              \
                     for (int d_ = 0; d_ < 4; ++d_) for (int r = 0; r < 16; ++r) o[d_][r] *= al_l[crow(r, hi)]; } } while (0)
#define KBASE(t) ((j_lo + (t)) * KVBLK)
#define ACT(t) (KBASE(t) <= qlo + QBLK - 1 && KBASE(t) + KVBLK - 1 >= qlo - W + 1)
#define MASKT(P0_, P1_, t) do { const int kb_ = KBASE(t); if ((!SK || ACT(t)) && (kb_ + KVBLK - 1 > qlo || kb_ <= qlo + QBLK - 1 - W)) mask_tile(P0_, P1_, qm - kb_, (unsigned)W); } while (0)
    constexpr int NQL = F32 ? 16 : 8;
    constexpr bool SK = WSKIP && !F32;
#define SEAM_K0() do { VMWN(NQL); if constexpr (F32) { SWRITE_KF(0); SBAR(); SLOAD_F((const float*)nxt.V, kbn); } else { SWRITE_HK(0); } SBAR(); } while (0)
    f32x16 pA0, pA1, pB0, pB1; float mnA, mnB, alA, alB; bf16x8 pa0, pa1, pa2, pa3;
    if constexpr (F32) { VMW(); SWRITE_VF(0); SBAR(); } else { SWRITE_HV(0); SBAR(); }
    if (NT > 1) { if constexpr (F32) SLOAD_F((const float*)Kh, KBASE(1)); else SLOAD_H(Kh, Vh, KBASE(1)); }
    SBAR(); qkt<0, SK>(pA0, pA1, K_lds, r32, hi, S.qr, ACT(0));
    if constexpr (F32) { if (NT > 1) { VMW(); SWRITE_KF(1); SBAR(); SLOAD_F((const float*)Vh, KBASE(1)); } }
    MASKT(pA0, pA1, 0); partialSM(pA0, pA1, m_reg, mnA, alA);
    if (NT > 1) { VMW(); if constexpr (F32) { SWRITE_VF(1); SBAR(); if (NT > 2) SLOAD_F((const float*)Kh, KBASE(2)); } else SWRITE_H(1); }
    __syncthreads();
#define HALF_STEP(PX0, PX1, mnX, alX, PY0, PY1, alY, t, KB, VB, SB) do {                                                      \
        SBAR(); qkt<KB, SK>(PX0, PX1, K_lds, r32, hi, S.qr, ACT(t));                                             \
        finishSM(PY0, PY1, alY, l_reg, pa0, pa1, pa2, pa3); SBAR();                                                           \
        if ((t) + 1 < NT) { if constexpr (F32) { VMW(); SWRITE_KF(SB); SBAR(); SLOAD_F((const float*)Vh, KBASE((t) + 1)); }  \
                            else { SLOAD_H(Kh, Vh, KBASE((t) + 1)); } SBAR(); }                                               \
        pv_tile<VB, SK>(o, vb0, pa0, pa1, pa2, pa3, ACT((t) - 1)); MASKT(PX0, PX1, (t)); partialSM(PX0, PX1, m_reg, mnX, alX);                                        \
        __syncthreads();                                                                                                      \
        if ((t) + 1 < NT) { VMW(); if constexpr (F32) { SWRITE_VF(SB); SBAR(); if ((t) + 2 < NT) SLOAD_F((const float*)Kh, KBASE((t) + 2)); } \
                            else { SWRITE_H(SB); } }                                                                          \
        RESC(alX); __syncthreads(); } while (0)
    for (int t = 1; t + 1 < NT; t += 2) {
        HALF_STEP(pB0, pB1, mnB, alB, pA0, pA1, alA, t, 1, 0, 0);
        HALF_STEP(pA0, pA1, mnA, alA, pB0, pB1, alB, t + 1, 0, 1, 1);
    }
    const bool even = (NT & 1) == 0;
    if (even) { SBAR(); qkt<1, SK>(pB0, pB1, K_lds, r32, hi, S.qr, ACT(NT - 1)); SBAR(); }
#define QROW(e) (nxt.Q + (size_t)(wid * QBLK + r32) * D + ((e) >> 1) * 16 + hi * 8 + ((e) & 1) * 4)
    if constexpr (F32) { SLOAD_F((const float*)nxt.K, kbn); SBAR();
#pragma unroll
        for (int e = 0; e < 8; ++e) S.tq[e] = *(const f32x4*)QROW(e); }
    else { SLOAD_H(nxt.K, nxt.V, kbn); SBAR();
#pragma unroll
        for (int d0 = 0; d0 < 8; ++d0) S.qr[d0] = load8<TIn>(nxt.Q + (size_t)(wid * QBLK + r32) * D + d0 * 16 + hi * 8); }
    SBAR();
    finishSM(pA0, pA1, alA, l_reg, pa0, pa1, pa2, pa3); SBAR();
    if constexpr (F32) {
#pragma unroll
        for (int e = 8; e < 16; ++e) S.tq[e] = *(const f32x4*)QROW(e); SBAR(); }
#undef QROW
    pv_tile<0, SK>(o, vb0, pa0, pa1, pa2, pa3, ACT(even ? NT - 2 : NT - 1));
    if (even) { MASKT(pB0, pB1, NT - 1); partialSM(pB0, pB1, m_reg, mnB, alB); __syncthreads(); RESC(alB);
        finishSM(pB0, pB1, alB, l_reg, pa0, pa1, pa2, pa3); SBAR(); pv_tile<1, SK>(o, vb0, pa0, pa1, pa2, pa3, ACT(NT - 1)); }
    SBAR(); SEAM_K0();
    if (hi == 0) li_l[r32] = l_reg; asm volatile("s_waitcnt lgkmcnt(0)" ::: "memory");
    float rli[16];
#pragma unroll
    for (int r = 0; r < 16; ++r) rli[r] = __builtin_amdgcn_rcpf(li_l[crow(r, hi)]);
    TOut* Ow = cur.O + (size_t)(wid * QBLK) * D;
#pragma unroll
    for (int r = 0; r < 16; ++r) { const int orow = crow(r, hi);
#pragma unroll
        for (int d0 = 0; d0 < 4; ++d0) { const float v = o[d0][r] * rli[r];
            if constexpr (same_t<TOut, float>::v) { Ow[(size_t)orow * D + d0 * 32 + r32] = v; }
            else { const float vn = __shfl_xor(v, 1);
                   if ((r32 & 1) == 0) *(unsigned*)(Ow + (size_t)orow * D + d0 * 32 + r32) = cvtpk(v, vn); } } }
    if constexpr (F32) {
#pragma unroll
        for (int d0 = 0; d0 < 8; ++d0) S.qr[d0] = pack8(S.tq[2 * d0], S.tq[2 * d0 + 1]); }
    __syncthreads();
#undef RESC
#undef KBASE
#undef ACT
#undef MASKT
#undef SEAM_K0
#undef HALF_STEP
}
#undef ROW
#undef VMW
#undef VMWN
#undef SLOAD_H
#undef SWRITE_HK
#undef SWRITE_HV
#undef SWRITE_H
#undef SLOAD_F
#undef SWRITE_KF
#undef SWRITE_VF
}
struct Ctx { LAS unsigned char* lds; int tid, lane, wave, vcu, G; };

__device__ __forceinline__ void tr_item(const float* __restrict__ src, size_t ldn, const float* __restrict__ gain, bfr* __restrict__ dst, int K,
                                        int k0, int nsrc0, int drow0, LAS float* scr, int lane) {
    const int r4 = lane >> 4, c4 = (lane & 15) * 4;
    f4v v[16];
#pragma unroll
    for (int i = 0; i < 16; ++i) v[i] = *(const f4v*)(src + (size_t)(k0 + 4 * i + r4) * ldn + nsrc0 + c4);
#pragma unroll
    for (int i = 0; i < 16; ++i) { const int k = 4 * i + r4; const float gk = gain ? gain[k0 + k] : 1.f;
        LAS float* s = scr + k * 65 + c4; s[0] = v[i][0] * gk; s[1] = v[i][1] * gk; s[2] = v[i][2] * gk; s[3] = v[i][3] * gk; }
    LDS_WAIT(); asm volatile("" ::: "memory");
    const int c = lane & 7;
#pragma unroll
    for (int jj = 0; jj < 8; ++jj) { const int n = (lane >> 3) + 8 * jj; const LAS float* s = scr + (8 * c) * 65 + n;
        u4v o; o.x = cvtpk(s[0 * 65], s[1 * 65]); o.y = cvtpk(s[2 * 65], s[3 * 65]); o.z = cvtpk(s[4 * 65], s[5 * 65]); o.w = cvtpk(s[6 * 65], s[7 * 65]);
        *(u4v*)(dst + (size_t)(drow0 + n) * K + k0 + 8 * c) = o; }
    LDS_WAIT(); asm volatile("" ::: "memory");
}
__device__ __forceinline__ void tr_item8(const float* __restrict__ src, size_t ldn, float sc, const float* __restrict__ gain, unsigned char* __restrict__ dst, int K, int k0, int nsrc0, int drow0, LAS float* scr, int lane) {
    const int r4 = lane >> 4, c4 = (lane & 15) * 4;
    f4v v[16];
#pragma unroll
    for (int i = 0; i < 16; ++i) v[i] = *(const f4v*)(src + (size_t)(k0 + 4 * i + r4) * ldn + nsrc0 + c4);
#pragma unroll
    for (int i = 0; i < 16; ++i) { const int k = 4 * i + r4; const float gk = gain ? gain[k0 + k] * sc : sc; LAS float* s = scr + k * 65 + c4; s[0] = v[i][0] * gk; s[1] = v[i][1] * gk; s[2] = v[i][2] * gk; s[3] = v[i][3] * gk; }
    LDS_WAIT(); asm volatile("" ::: "memory");
    const int c = lane & 3;
#pragma unroll
    for (int jj = 0; jj < 4; ++jj) { const int n = (lane >> 2) + 16 * jj; const LAS float* s = scr + (16 * c) * 65 + n;
        u4v o; o.x = cvt4_fp8(s[0 * 65], s[1 * 65], s[2 * 65], s[3 * 65]); o.y = cvt4_fp8(s[4 * 65], s[5 * 65], s[6 * 65], s[7 * 65]);
        o.z = cvt4_fp8(s[8 * 65], s[9 * 65], s[10 * 65], s[11 * 65]); o.w = cvt4_fp8(s[12 * 65], s[13 * 65], s[14 * 65], s[15 * 65]);
        *(u4v*)(dst + (size_t)(drow0 + n) * K + k0 + 16 * c) = o; }
    LDS_WAIT(); asm volatile("" ::: "memory");
}
__device__ __forceinline__ void tr_job8(const float* __restrict__ src, size_t ldn, float sc, const float* __restrict__ gain, unsigned char* __restrict__ dst, int K, int ncols, LAS float* scr, int lane, int gw, int NGW, int nsrc0 = 0) {
    const int nn = ncols / 64, ni = (K / 64) * nn;
    for (int it = gw; it < ni; it += NGW) { const int kb = it / nn, nb = it - kb * nn; tr_item8(src, ldn, sc, gain, dst, K, kb * 64, nsrc0 + nb * 64, nb * 64, scr, lane); }
}
__device__ __forceinline__ void tr_job(const float* __restrict__ src, size_t ldn, const float* __restrict__ gain, bfr* __restrict__ dst, int K, int ncols, int nsrc0, int drow0,
                                       LAS float* scr, int lane, int gw, int NGW) {
    const int nn = ncols / 64, ni = (K / 64) * nn;
    for (int it = gw; it < ni; it += NGW) { const int kb = it / nn, nb = it - kb * nn;
        tr_item(src, ldn, gain, dst, K, kb * 64, nsrc0 + nb * 64, drow0 + nb * 64, scr, lane); }
}
struct KArgs {
    const float* in[26]; float* out; unsigned char* ws; int ph_lo, ph_hi, li, pad;
};
struct Ptrs {
    LAS unsigned long long* tbl;
    __device__ __forceinline__ unsigned long long get(int k) const { const unsigned long long v = tbl[k];
        return ((unsigned long long)(unsigned)__builtin_amdgcn_readfirstlane((int)(unsigned)(v >> 32)) << 32) | (unsigned)__builtin_amdgcn_readfirstlane((int)(unsigned)v); }
    __device__ __forceinline__ const float* in_(int k) const { return (const float*)get(k); }
    __device__ __forceinline__ float* out_() const { return (float*)get(26); }
    __device__ __forceinline__ unsigned char* ws_() const { return (unsigned char*)get(27); }
};
__device__ __forceinline__ void p_convert(const Ctx& C, const Ptrs& P) {
    LAS float* scr = (LAS float*)(C.lds + C.wave * 16640);
    const int gw = C.vcu * 8 + C.wave, NGW = C.G * 8;
    unsigned char* ws = P.ws_();
#if F8_PROJ0 == 1
    tr_job8(P.in_(2), (size_t)GIN, SU, P.in_(1), ws + WS_WTIN, DM, 16384, scr, C.lane, gw, NGW);
#elif F8_PROJ0 == 2
    tr_job(P.in_(2), (size_t)GIN, P.in_(1), (bfr*)(ws + WS_WTIN), DM, 8192, 0, 0, scr, C.lane, gw, NGW);
    tr_job8(P.in_(2), (size_t)GIN, SU, P.in_(1), ws + WS_WTIN + (size_t)8192 * DM * 2, DM, 8192, scr, C.lane, gw, NGW, 8192);
#elif F8_PROJ0 == 3
    tr_job8(P.in_(2), (size_t)GIN, SU, P.in_(1), ws + WS_WTIN, DM, 8192, scr, C.lane, gw, NGW, 0);
    tr_job(P.in_(2), (size_t)GIN, P.in_(1), (bfr*)(ws + WS_WTIN + (size_t)8192 * DM), DM, 8192, 8192, 0, scr, C.lane, gw, NGW);
#else
    tr_job(P.in_(2), (size_t)GIN, P.in_(1), (bfr*)(ws + WS_WTIN), DM, 16384, 0, 0, scr, C.lane, gw, NGW);
#endif
    tr_job(P.in_(2), (size_t)GIN, P.in_(1), (bfr*)(ws + WS_WTBD), DM, 64, 16384, 0, scr, C.lane, gw, NGW);
#if F8_OUT
    tr_job8(P.in_(7), (size_t)DM, SU, nullptr, ws + WS_WTOUT, DM, DM, scr, C.lane, gw, NGW, 0);
#else
    tr_job(P.in_(7), (size_t)DM, nullptr, (bfr*)(ws + WS_WTOUT), DM, DM, 0, 0, scr, C.lane, gw, NGW);
#endif
#if F8_KVQ
    tr_job8(P.in_(9), (size_t)8192, SU, P.in_(8), ws + WS_WTKVQ, DM, DM, scr, C.lane, gw, NGW, 0);
    tr_job8(P.in_(12), (size_t)DM, SU, P.in_(11), ws + WS_WTKVQ + (size_t)DM * DM, DM, DM, scr, C.lane, gw, NGW, 0);
#if F8_KVQ == 2
    tr_job8(P.in_(9), (size_t)8192, SU, P.in_(8), ws + WS_WTKVQ + (size_t)2 * DM * DM, DM, DM, scr, C.lane, gw, NGW, DM);
#else
    tr_job(P.in_(9), (size_t)8192, P.in_(8), (bfr*)(ws + WS_WTKVQ + (size_t)2 * DM * DM), DM, DM, DM, 0, scr, C.lane, gw, NGW);
#endif
#else
    tr_job(P.in_(9), (size_t)8192, P.in_(8), (bfr*)(ws + WS_WTKVQ), DM, 8192, 0, 0, scr, C.lane, gw, NGW);
    tr_job(P.in_(12), (size_t)DM, P.in_(11), (bfr*)(ws + WS_WTKVQ), DM, DM, 0, 8192, scr, C.lane, gw, NGW);
#endif
#if F8_OUT
    tr_job8(P.in_(19), (size_t)DM, SU, nullptr, ws + WS_WTO, DM, DM, scr, C.lane, gw, NGW, 0);
#else
    tr_job(P.in_(19), (size_t)DM, nullptr, (bfr*)(ws + WS_WTO), DM, DM, 0, 0, scr, C.lane, gw, NGW);
#endif
    tr_job(P.in_(21), (size_t)PQ, P.in_(20), (bfr*)(ws + WS_WTQRY), DM, PQ, 0, 0, scr, C.lane, gw, NGW);
    tr_job(P.in_(21) + (size_t)DM * PQ, (size_t)PQ, P.in_(20) + DM, (bfr*)(ws + WS_WTQRY) + (size_t)PQ * DM, DM, PQ, 0, 0, scr, C.lane, gw, NGW);
    tr_job8(P.in_(25), (size_t)DM, SV, nullptr, ws + WS_VT, PE, DM, scr, C.lane, gw, NGW);
    tr_job8(P.in_(25) + (size_t)PE * DM, (size_t)DM, SV, nullptr, ws + WS_VT + (size_t)DM * PE, PE, DM, scr, C.lane, gw, NGW);
    {
        const size_t gt = (size_t)C.vcu * 512 + C.tid, GT = (size_t)C.G * 512;
        for (int l = 0; l < 2; ++l) {
            const float* src = P.in_(24) + (size_t)l * PE * DM; const float* gain = P.in_(20) + l * DM; unsigned char* dst = ws + WS_U + (size_t)l * PE * DM;
            for (size_t i = gt; i < (size_t)PE * DM / 16; i += GT) {
                const f4v a = *(const f4v*)(src + i * 16), b = *(const f4v*)(src + i * 16 + 4), c = *(const f4v*)(src + i * 16 + 8), d = *(const f4v*)(src + i * 16 + 12);
                const int dd = (int)((i * 16) & (DM - 1)); const f4v ga = *(const f4v*)(gain + dd) * SU, gb = *(const f4v*)(gain + dd + 4) * SU, gc = *(const f4v*)(gain + dd + 8) * SU, gd = *(const f4v*)(gain + dd + 12) * SU;
                u4v o; o.x = cvt4_fp8(a[0] * ga[0], a[1] * ga[1], a[2] * ga[2], a[3] * ga[3]); o.y = cvt4_fp8(b[0] * gb[0], b[1] * gb[1], b[2] * gb[2], b[3] * gb[3]);
                o.z = cvt4_fp8(c[0] * gc[0], c[1] * gc[1], c[2] * gc[2], c[3] * gc[3]); o.w = cvt4_fp8(d[0] * gd[0], d[1] * gd[1], d[2] * gd[2], d[3] * gd[3]);
                *(u4v*)(dst + i * 16) = o; }
        }
        for (int l = 0; l < 2; ++l) {
            bfr* dst = (bfr*)(ws + WS_WTKEY) + (size_t)l * PQ * PQ;
            for (size_t i = gt; i < (size_t)PQ * PQ / 8; i += GT) {
                const int row = (int)((i * 8) / PQ), col = (int)((i * 8) % PQ); u4v o = {0u, 0u, 0u, 0u};
                if ((row >> 7) == (col >> 7)) { const int blk = row >> 7, h = blk >> 1, half = blk & 1, n = row & 127, d = col & 127;
                    const float* src = (half ? P.in_(23) : P.in_(22)) + (((size_t)l * PH + h) * PK + n) * 128 + d;
                    const f4v a = *(const f4v*)src, b = *(const f4v*)(src + 4);
                    o.x = cvtpk(a[0], a[1]); o.y = cvtpk(a[2], a[3]); o.z = cvtpk(b[0], b[1]); o.w = cvtpk(b[2], b[3]); }
                *(u4v*)(dst + i * 8) = o; }
        }
    }
}

__device__ __forceinline__ void p_norm_rows(const Ctx& C, const float* __restrict__ src, bfr* __restrict__ dst, unsigned char* __restrict__ dst8) {
    const int gw = C.vcu * 8 + C.wave, NGW = C.G * 8;
    for (int row = gw; row < NT; row += NGW) {
        const f4v* p = (const f4v*)(src + (size_t)row * DM);
        f4v a[8], b[8]; float ss = 0.f;
#pragma unroll
        for (int j = 0; j < 8; ++j) { a[j] = p[j * 128 + 2 * C.lane]; b[j] = p[j * 128 + 2 * C.lane + 1]; }
#pragma unroll
        for (int j = 0; j < 8; ++j) ss += (a[j][0] * a[j][0] + a[j][1] * a[j][1]) + (a[j][2] * a[j][2] + a[j][3] * a[j][3]) + (b[j][0] * b[j][0] + b[j][1] * b[j][1]) + (b[j][2] * b[j][2] + b[j][3] * b[j][3]);
        const float r = __builtin_amdgcn_rsqf(wave_sum(ss) * (1.f / DM) + EPS);
        u4v* o = (u4v*)(dst + (size_t)row * DM);
#pragma unroll
        for (int j = 0; j < 8; ++j) { u4v w; w.x = cvtpk(a[j][0] * r, a[j][1] * r); w.y = cvtpk(a[j][2] * r, a[j][3] * r); w.z = cvtpk(b[j][0] * r, b[j][1] * r); w.w = cvtpk(b[j][2] * r, b[j][3] * r);
            o[j * 64 + C.lane] = w;
            if (dst8) { u2v w8; w8.x = cvt4_fp8(a[j][0] * r, a[j][1] * r, a[j][2] * r, a[j][3] * r); w8.y = cvt4_fp8(b[j][0] * r, b[j][1] * r, b[j][2] * r, b[j][3] * r); ((u2v*)(dst8 + (size_t)row * DM))[j * 64 + C.lane] = w8; } }
    }
}

__device__ __forceinline__ void p_bd(const Ctx& C, const bfr* __restrict__ XN, const bfr* __restrict__ WB, float* __restrict__ BD) {
    LAS float* red = (LAS float*)C.lds;
    const int r = C.lane & 15, q = C.lane >> 4, rt = C.wave >> 2, kq = C.wave & 3;
    for (int blk = C.vcu; blk < NT / 32; blk += C.G) {
        const bfr* ap = XN + (size_t)(blk * 32 + rt * 16 + r) * DM + kq * 1024 + q * 8;
        const bfr* bp = WB + (size_t)r * DM + kq * 1024 + q * 8;
        f4v acc[4] = {zero_acc(), zero_acc(), zero_acc(), zero_acc()};
#pragma unroll 4
        for (int ks = 0; ks < 32; ++ks) {
            const s8v a = *(const s8v*)(ap + ks * 32);
#pragma unroll
            for (int nt = 0; nt < 4; ++nt) { const s8v b = *(const s8v*)(bp + (size_t)nt * 16 * DM + ks * 32); acc[nt] = __builtin_amdgcn_mfma_f32_16x16x32_bf16(a, b, acc[nt], 0, 0, 0); }
            MFMA_SETTLE(acc[0]); MFMA_SETTLE(acc[1]); MFMA_SETTLE(acc[2]); MFMA_SETTLE(acc[3]);
        }
        MFMA_SETTLE(acc[0]); MFMA_SETTLE(acc[1]); MFMA_SETTLE(acc[2]); MFMA_SETTLE(acc[3]);
#pragma unroll
        for (int nt = 0; nt < 4; ++nt)
#pragma unroll
            for (int i = 0; i < 4; ++i) red[C.wave * 1024 + (4 * q + i) * 64 + nt * 16 + r] = -acc[nt][i];
        __syncthreads();
#pragma unroll
        for (int i = 0; i < 4; ++i) { const int idx = C.tid * 4 + i, t2 = idx >> 10, rem = idx & 1023;
            const float s = -((red[(t2 * 4 + 0) * 1024 + rem] + red[(t2 * 4 + 1) * 1024 + rem]) + (red[(t2 * 4 + 2) * 1024 + rem] + red[(t2 * 4 + 3) * 1024 + rem]));
            BD[(size_t)(blk * 32 + t2 * 16 + (rem >> 6)) * 64 + (rem & 63)] = s; }
        __syncthreads();
    }
}
__device__ __forceinline__ int kq_off(int row, int chunk) { return row * 256 + ((chunk ^ (row & 7)) << 4); }
__device__ __forceinline__ int xt_off(int col, int chunk) { return col * 128 + ((chunk ^ (col & 7)) << 4); }
__device__ __forceinline__ void p_gdn_prep(const Ctx& C, const Ptrs& P) {
    unsigned char* ws = P.ws_();
    const bfr* PROJ = (const bfr*)(ws + WS_BIG); const float* BD = (const float*)(ws + WS_BD);
    const float* convw = P.in_(3); const float* alog = P.in_(4); const float* dtb = P.in_(5);
    bfr* Wg = (bfr*)(ws + WS_R + R_W); bfr* Ug = (bfr*)(ws + WS_R + R_U); bfr* QGg = (bfr*)(ws + WS_R + R_QG); bfr* KDg = (bfr*)(ws + WS_R + R_KD); bfr* QKg = (bfr*)(ws + WS_R + R_QK);
    float* EGg = (float*)(ws + WS_EG);
    LAS float* sCW = (LAS float*)(C.lds + 82944);
    for (int wq = C.vcu; wq < NB * GH * 4; wq += C.G) {
        const int bh = wq >> 2, cg = wq & 3, h = bh & 31, b = bh >> 5;
        for (int i = C.tid; i < 1536; i += 512) { const int part = i >> 9, tap = (i >> 7) & 3, ch = i & 127; sCW[i] = convw[tap * 12288 + part * 4096 + h * 128 + ch]; }
        __syncthreads();
        for (int it = 0; it < 8; ++it) {
            int tid = C.tid; asm volatile("" : "+v"(tid));
            const int hw = tid >> 8, lt = tid & 255, lane = tid & 63, lw = (tid >> 6) & 3;
            const int c = cg * 16 + it * 2 + hw, unit = bh * 64 + c, t0 = b * SEQ + c * CH;
            LAS unsigned char* hb = C.lds + hw * 41472;
            LAS unsigned char* sK = hb; LAS unsigned char* sQ = hb + 16384; LAS unsigned char* sX = hb;
            LAS unsigned char* sAM = hb + 32768; LAS float* sB = (LAS float*)(hb + 40960); LAS float* sG = (LAS float*)(hb + 41216);
            LAS float* scr = (LAS float*)(C.lds + 89088 + (tid >> 6) * 4352);
            LAS float* sAD = (LAS float*)(C.lds + 123904 + hw * 4096);
            if (lt < 64) {
                const int t = t0 + lt; const float braw = BD[(size_t)t * 64 + h], araw = BD[(size_t)t * 64 + 32 + h];
                const float beta = 1.f / (1.f + expf(-braw)); const float xx = araw + dtb[h]; const float sp = fmaxf(xx, 0.f) + log1pf(expf(-fabsf(xx)));
                float g = -expf(alog[h]) * sp;
#pragma unroll
                for (int o = 1; o < 64; o <<= 1) { const float y = __shfl_up(g, o); if (lane >= o) g += y; }
                sB[lt] = beta; sG[lt] = g;
            }
            __syncthreads();
            const int tk = lt >> 2, cs = lt & 3;
            const float beta = sB[tk], gc = sG[tk], gl = sG[63]; const float eg = expf(gc), ed = expf(gl - gc), bg = beta * eg;
            u4v kbg[4], vbt[4];
#pragma unroll
            for (int part = 0; part < 3; ++part) {
                float y[32];
#pragma unroll
                for (int i = 0; i < 32; ++i) y[i] = 0.f;
#pragma unroll
                for (int j = 0; j < 4; ++j) {
                    const int s = c * CH + tk - 3 + j;
                    if (s >= 0) {
                        const bfr* row = PROJ + (size_t)(b * SEQ + s) * 16384 + part * 4096 + h * 128 + cs * 32;
#pragma unroll
                        for (int q4 = 0; q4 < 4; ++q4) { const u4v x = *(const u4v*)(row + 8 * q4); const LAS float* wp = sCW + part * 512 + j * 128 + cs * 32 + 8 * q4;
                            const f4v w0 = *(const LAS f4v*)wp, w1 = *(const LAS f4v*)(wp + 4);
                            y[8 * q4 + 0] += bflo(x.x) * w0[0]; y[8 * q4 + 1] += bfhi(x.x) * w0[1]; y[8 * q4 + 2] += bflo(x.y) * w0[2]; y[8 * q4 + 3] += bfhi(x.y) * w0[3];
                            y[8 * q4 + 4] += bflo(x.z) * w1[0]; y[8 * q4 + 5] += bfhi(x.z) * w1[1]; y[8 * q4 + 6] += bflo(x.w) * w1[2]; y[8 * q4 + 7] += bfhi(x.w) * w1[3]; }
                    }
                }
                float ss = 0.f;
#pragma unroll
                for (int i = 0; i < 32; ++i) { y[i] = y[i] * __builtin_amdgcn_rcpf(1.f + __expf(-y[i])); ss += y[i] * y[i]; }
                if (part < 2) {
                    ss += __shfl_xor(ss, 1); ss += __shfl_xor(ss, 2);
                    const float rn = __builtin_amdgcn_rsqf(ss + EPS) * (part == 0 ? 0.08838834764831845f : 1.f); const float gs = part == 0 ? eg : ed;
                    LAS unsigned char* dstl = part == 0 ? sQ : sK; bfr* dstg = (part == 0 ? QGg : KDg) + (size_t)unit * 8192 + tk * 128 + cs * 32;
#pragma unroll
                    for (int q4 = 0; q4 < 4; ++q4) { float z[8];
#pragma unroll
                        for (int i = 0; i < 8; ++i) z[i] = y[8 * q4 + i] * rn;
                        u4v w; w.x = cvtpk(z[0], z[1]); w.y = cvtpk(z[2], z[3]); w.z = cvtpk(z[4], z[5]); w.w = cvtpk(z[6], z[7]);
                        *(LAS u4v*)(dstl + kq_off(tk, cs * 4 + q4)) = w;
                        u4v g; g.x = cvtpk(z[0] * gs, z[1] * gs); g.y = cvtpk(z[2] * gs, z[3] * gs); g.z = cvtpk(z[4] * gs, z[5] * gs); g.w = cvtpk(z[6] * gs, z[7] * gs);
                        *(u4v*)(dstg + 8 * q4) = g;
                        if (part == 1) { kbg[q4].x = cvtpk(z[0] * bg, z[1] * bg); kbg[q4].y = cvtpk(z[2] * bg, z[3] * bg); kbg[q4].z = cvtpk(z[4] * bg, z[5] * bg); kbg[q4].w = cvtpk(z[6] * bg, z[7] * bg); } }
                } else {
#pragma unroll
                    for (int q4 = 0; q4 < 4; ++q4) { vbt[q4].x = cvtpk(y[8 * q4] * beta, y[8 * q4 + 1] * beta); vbt[q4].y = cvtpk(y[8 * q4 + 2] * beta, y[8 * q4 + 3] * beta);
                        vbt[q4].z = cvtpk(y[8 * q4 + 4] * beta, y[8 * q4 + 5] * beta); vbt[q4].w = cvtpk(y[8 * q4 + 6] * beta, y[8 * q4 + 7] * beta); }
                }
            }
            __syncthreads();
            {
                const int r = lane & 15, q = lane >> 4, mt = lw;
                s8v ak[4], aq[4];
#pragma unroll
                for (int ks = 0; ks < 4; ++ks) { ak[ks] = *(const LAS s8v*)(sK + kq_off(16 * mt + r, 4 * ks + q)); aq[ks] = *(const LAS s8v*)(sQ + kq_off(16 * mt + r, 4 * ks + q)); }
                float gi[4], bi[4];
#pragma unroll
                for (int e = 0; e < 4; ++e) { gi[e] = sG[16 * mt + 4 * q + e]; bi[e] = sB[16 * mt + 4 * q + e]; }
                for (int nt = 0; nt < 4; ++nt) {
                    const int j = 16 * nt + r;
                    if (nt <= mt) {
                        f4v ck = zero_acc(), cq = zero_acc();
#pragma unroll
                        for (int ks = 0; ks < 4; ++ks) { const s8v bb = *(const LAS s8v*)(sK + kq_off(16 * nt + r, 4 * ks + q));
                            ck = __builtin_amdgcn_mfma_f32_16x16x32_bf16(ak[ks], bb, ck, 0, 0, 0); cq = __builtin_amdgcn_mfma_f32_16x16x32_bf16(aq[ks], bb, cq, 0, 0, 0); }
                        MFMA_SETTLE(ck); MFMA_SETTLE(cq);
                        const float gj = sG[j];
#pragma unroll
                        for (int e = 0; e < 4; ++e) { const int i = 16 * mt + 4 * q + e; const float dec = expf(fminf(gi[e] - gj, 0.f));
                            const float av = (i > j) ? bi[e] * ck[e] * dec : 0.f;
                            *(LAS bfr*)(sAM + xt_off(i, j >> 3) + (j & 7) * 2) = f2bf1(av);
                            if (nt == mt) sAD[mt * 256 + (4 * q + e) * 16 + r] = av;
                            QKg[(size_t)unit * 4096 + i * 64 + j] = f2bf1((i >= j) ? cq[e] * dec : 0.f); }
                    } else {
#pragma unroll
                        for (int e = 0; e < 4; ++e) QKg[(size_t)unit * 4096 + (16 * mt + 4 * q + e) * 64 + j] = (bfr)0;
                    }
                }
            }
            __syncthreads();
            {
                const int ro = ((tk >> 3)), rb = (tk & 7) * 2;
#pragma unroll
                for (int q4 = 0; q4 < 4; ++q4) {
                    const unsigned vv[4] = {vbt[q4].x, vbt[q4].y, vbt[q4].z, vbt[q4].w}, kk[4] = {kbg[q4].x, kbg[q4].y, kbg[q4].z, kbg[q4].w};
#pragma unroll
                    for (int i = 0; i < 8; ++i) { const int ch = cs * 32 + q4 * 8 + i;
                        *(LAS bfr*)(sX + xt_off(ch, ro) + rb) = (bfr)((i & 1) ? (vv[i >> 1] >> 16) : (vv[i >> 1] & 0xffffu));
                        *(LAS bfr*)(sX + xt_off(128 + ch, ro) + rb) = (bfr)((i & 1) ? (kk[i >> 1] >> 16) : (kk[i >> 1] & 0xffffu)); }
                }
            }
            __syncthreads();
            {
                const int r = lane & 15, q = lane >> 4;
                float x[64];
#pragma unroll
                for (int bk = 0; bk < 4; ++bk) {
                    float corr[16];
#pragma unroll
                    for (int i = 0; i < 16; ++i) corr[i] = 0.f;
                    if (bk > 0) {
                        f4v acc[4] = {zero_acc(), zero_acc(), zero_acc(), zero_acc()};
#pragma unroll
                        for (int ks = 0; ks < (16 * bk + 31) / 32; ++ks) {
                            s8v a = *(const LAS s8v*)(sAM + xt_off(16 * bk + r, 4 * ks + q));
                            if (32 * ks + 8 * q >= 16 * bk) a = (s8v){0, 0, 0, 0, 0, 0, 0, 0};
#pragma unroll
                            for (int nt = 0; nt < 4; ++nt) { const s8v bx = *(const LAS s8v*)(sX + xt_off(64 * lw + 16 * nt + r, 4 * ks + q)); acc[nt] = __builtin_amdgcn_mfma_f32_16x16x32_bf16(a, bx, acc[nt], 0, 0, 0); }
                        }
                        MFMA_SETTLE(acc[0]); MFMA_SETTLE(acc[1]); MFMA_SETTLE(acc[2]); MFMA_SETTLE(acc[3]);
#pragma unroll
                        for (int nt = 0; nt < 4; ++nt)
#pragma unroll
                            for (int e = 0; e < 4; ++e) scr[(16 * nt + r) * 17 + 4 * q + e] = -acc[nt][e];
                        LDS_WAIT(); asm volatile("" ::: "memory");
#pragma unroll
                        for (int i = 0; i < 16; ++i) corr[i] = scr[lane * 17 + i];
                    }
                    const u4v r0 = *(const LAS u4v*)(sX + xt_off(lt, 2 * bk)), r1 = *(const LAS u4v*)(sX + xt_off(lt, 2 * bk + 1));
                    const float rhs[16] = {bflo(r0.x), bfhi(r0.x), bflo(r0.y), bfhi(r0.y), bflo(r0.z), bfhi(r0.z), bflo(r0.w), bfhi(r0.w), bflo(r1.x), bfhi(r1.x), bflo(r1.y), bfhi(r1.y), bflo(r1.z), bfhi(r1.z), bflo(r1.w), bfhi(r1.w)};
                    float xb[16];
#pragma unroll
                    for (int i = 0; i < 16; ++i) {
                        float v = rhs[i] + corr[i];
                        const u4v a0 = *(const LAS u4v*)(sAM + xt_off(16 * bk + i, 2 * bk)), a1 = *(const LAS u4v*)(sAM + xt_off(16 * bk + i, 2 * bk + 1));
                        const float am[16] = {bflo(a0.x), bfhi(a0.x), bflo(a0.y), bfhi(a0.y), bflo(a0.z), bfhi(a0.z), bflo(a0.w), bfhi(a0.w), bflo(a1.x), bfhi(a1.x), bflo(a1.y), bfhi(a1.y), bflo(a1.z), bfhi(a1.z), bflo(a1.w), bfhi(a1.w)};
#pragma unroll
                        for (int j = 0; j < 16; ++j) if (j < i) v -= am[j] * xb[j];
                        xb[i] = v; x[16 * bk + i] = v;
                    }
                    u4v w0, w1; w0.x = cvtpk(xb[0], xb[1]); w0.y = cvtpk(xb[2], xb[3]); w0.z = cvtpk(xb[4], xb[5]); w0.w = cvtpk(xb[6], xb[7]);
                    w1.x = cvtpk(xb[8], xb[9]); w1.y = cvtpk(xb[10], xb[11]); w1.z = cvtpk(xb[12], xb[13]); w1.w = cvtpk(xb[14], xb[15]);
                    *(LAS u4v*)(sX + xt_off(lt, 2 * bk)) = w0; *(LAS u4v*)(sX + xt_off(lt, 2 * bk + 1)) = w1;
                    LDS_WAIT(); asm volatile("" ::: "memory");
                }
                bfr* dst = (lt < 128 ? Ug : Wg) + (size_t)unit * 8192 + (lt & 127);
#pragma unroll
                for (int i = 0; i < 64; ++i) dst[i * 128] = f2bf1(x[i]);
                if (lt == 0) EGg[unit] = expf(sG[63]);
            }
            __syncthreads();
        }
    }
}

__device__ __forceinline__ void p_gdn_scan(const Ctx& C, const Ptrs& P) {
    unsigned char* ws = P.ws_();
    const GAS bfr* Wg = (const GAS bfr*)(ws + WS_R + R_W); const GAS bfr* Ug = (const GAS bfr*)(ws + WS_R + R_U); const GAS bfr* QGg = (const GAS bfr*)(ws + WS_R + R_QG); const GAS bfr* KDg = (const GAS bfr*)(ws + WS_R + R_KD);
    const GAS bfr* QKg = (const GAS bfr*)(ws + WS_R + R_QK); GAS bfr* Og = (GAS bfr*)(ws + WS_R + R_O); const GAS float* EGg = (const GAS float*)(ws + WS_EG);
    const int tid = C.tid, lane = C.lane, wave = C.wave, r = lane & 15, q = lane >> 4, mt = wave & 3, nt = wave >> 2;
    LAS bfr* sST = (LAS bfr*)(C.lds + 131072); LAS bfr* sVN = (LAS bfr*)(C.lds + 139776);
#define SC_W(bb)  ((LAS bfr*)(C.lds + (bb) * 65536))
#define SC_QG(bb) ((LAS bfr*)(C.lds + (bb) * 65536 + 17408))
#define SC_KD(bb) ((LAS bfr*)(C.lds + (bb) * 65536 + 34816))
#define SC_QK(bb) ((LAS bfr*)(C.lds + (bb) * 65536 + 52224))
#define SC_U(bb)  ((LAS bfr*)(C.lds + (bb) * 65536 + 61440))
#define SC_LOAD(n) do { const size_t ub = (size_t)(bh * 64 + (n)) * 8192; \
        rW0 = *(const GAS u4v*)(Wg + ub + (size_t)tid * 8); rW1 = *(const GAS u4v*)(Wg + ub + (size_t)(tid + 512) * 8); \
        rQ0 = *(const GAS u4v*)(QGg + ub + (size_t)tid * 8); rQ1 = *(const GAS u4v*)(QGg + ub + (size_t)(tid + 512) * 8); \
        rK0 = *(const GAS u4v*)(KDg + ub + (size_t)tid * 8); rK1 = *(const GAS u4v*)(KDg + ub + (size_t)(tid + 512) * 8); \
        rQK = *(const GAS u4v*)(QKg + (size_t)(bh * 64 + (n)) * 4096 + (size_t)tid * 8); \
        if (tid < 256) rU = *(const GAS u4v*)(Ug + ub + (size_t)(tid >> 2) * 128 + es * 32 + (tid & 3) * 8); } while (0)
#define SC_WRITE(bb) do { const int c0 = tid, c1 = tid + 512; \
        *(LAS u4v*)(SC_W(bb) + (c0 >> 4) * 136 + (c0 & 15) * 8) = rW0; *(LAS u4v*)(SC_W(bb) + (c1 >> 4) * 136 + (c1 & 15) * 8) = rW1; \
        *(LAS u4v*)(SC_QG(bb) + (c0 >> 4) * 136 + (c0 & 15) * 8) = rQ0; *(LAS u4v*)(SC_QG(bb) + (c1 >> 4) * 136 + (c1 & 15) * 8) = rQ1; \
        *(LAS u4v*)(SC_KD(bb) + (c0 >> 4) * 136 + (c0 & 15) * 8) = rK0; *(LAS u4v*)(SC_KD(bb) + (c1 >> 4) * 136 + (c1 & 15) * 8) = rK1; \
        *(LAS u4v*)(SC_QK(bb) + (tid >> 3) * 72 + (tid & 7) * 8) = rQK; \
        if (tid < 256) *(LAS u4v*)(SC_U(bb) + (tid >> 2) * 32 + (tid & 3) * 8) = rU; } while (0)
    for (int task = C.vcu; task < NB * GH * 4; task += C.G) {
        const int bh = task >> 2, es = task & 3, h = bh & 31, b = bh >> 5;
        u4v rW0, rW1, rQ0, rQ1, rK0, rK1, rQK, rU = {0u, 0u, 0u, 0u};
        f4v S0 = {0.f, 0.f, 0.f, 0.f}, S1 = {0.f, 0.f, 0.f, 0.f};
        LAS float* sEG = (LAS float*)(C.lds + 144384);
        if (tid < 64) sEG[tid] = EGg[bh * 64 + tid];
        SC_LOAD(0); SC_WRITE(0); SC_LOAD(1);
        for (int n = 0; n < NCH; ++n) {
            const int bb = n & 1;
            {
                MFMA_SETTLE(S0); MFMA_SETTLE(S1);
                u2v w0, w1; w0.x = cvtpk(S0[0], S0[1]); w0.y = cvtpk(S0[2], S0[3]); w1.x = cvtpk(S1[0], S1[1]); w1.y = cvtpk(S1[2], S1[3]);
                *(LAS u2v*)(sST + (r) * 136 + 16 * wave + 4 * q) = w0; *(LAS u2v*)(sST + (16 + r) * 136 + 16 * wave + 4 * q) = w1;
            }
            __syncthreads();
            if (n + 1 < NCH) { if (bb) SC_WRITE(0); else SC_WRITE(1); if (n + 2 < NCH) SC_LOAD(n + 2); }
            f4v acc1 = zero_acc(), acc2 = zero_acc();
            const LAS bfr* pW = SC_W(bb) + (16 * mt + r) * 136 + 8 * q; const LAS bfr* pQ = SC_QG(bb) + (16 * mt + r) * 136 + 8 * q; const LAS bfr* pS = sST + (16 * nt + r) * 136 + 8 * q;
#pragma unroll
            for (int ks = 0; ks < 4; ++ks) { const s8v a1 = *(const LAS s8v*)(pW + 32 * ks), a2 = *(const LAS s8v*)(pQ + 32 * ks), bs = *(const LAS s8v*)(pS + 32 * ks);
                acc1 = __builtin_amdgcn_mfma_f32_16x16x32_bf16(a1, bs, acc1, 0, 0, 0); acc2 = __builtin_amdgcn_mfma_f32_16x16x32_bf16(a2, bs, acc2, 0, 0, 0); }
            MFMA_SETTLE(acc1);
            {
                const LAS bfr* pU = SC_U(bb) + (16 * mt + 4 * q) * 32 + 16 * nt + r;
                const float v0 = bf1(pU[0]) - acc1[0], v1 = bf1(pU[32]) - acc1[1], v2 = bf1(pU[64]) - acc1[2], v3 = bf1(pU[96]) - acc1[3];
                u2v w; w.x = cvtpk(v0, v1); w.y = cvtpk(v2, v3);
                *(LAS u2v*)(sVN + (16 * nt + r) * 72 + 16 * mt + 4 * q) = w;
            }
            __syncthreads();
            {
                const LAS bfr* pA = SC_QK(bb) + (16 * mt + r) * 72 + 8 * q; const LAS bfr* pV = sVN + (16 * nt + r) * 72 + 8 * q;
#pragma unroll
                for (int ks = 0; ks < 2; ++ks) { const s8v a = *(const LAS s8v*)(pA + 32 * ks), bv = *(const LAS s8v*)(pV + 32 * ks); acc2 = __builtin_amdgcn_mfma_f32_16x16x32_bf16(a, bv, acc2, 0, 0, 0); }
                MFMA_SETTLE(acc2);
                GAS bfr* po = Og + (size_t)(b * SEQ + n * CH + 16 * mt + 4 * q) * DM + h * 128 + es * 32 + 16 * nt + r;
                po[0] = f2bf1(acc2[0]); po[DM] = f2bf1(acc2[1]); po[2 * DM] = f2bf1(acc2[2]); po[3 * DM] = f2bf1(acc2[3]);
            }
            {
                const float eg = sEG[n];
                S0 *= eg; S1 *= eg;
                const LAS bfr* pK = SC_KD(bb) + (8 * q) * 136 + 16 * wave + r; const LAS bfr* pV0 = sVN + r * 72 + 8 * q; const LAS bfr* pV1 = sVN + (16 + r) * 72 + 8 * q;
#pragma unroll
                for (int ks = 0; ks < 2; ++ks) {
                    s8v a;
#pragma unroll
                    for (int i = 0; i < 8; ++i) a[i] = (short)pK[(32 * ks + i) * 136];
                    const s8v b0 = *(const LAS s8v*)(pV0 + 32 * ks), b1 = *(const LAS s8v*)(pV1 + 32 * ks);
                    S0 = __builtin_amdgcn_mfma_f32_16x16x32_bf16(a, b0, S0, 0, 0, 0); S1 = __builtin_amdgcn_mfma_f32_16x16x32_bf16(a, b1, S1, 0, 0, 0);
                }
            }
        }
        __syncthreads();
    }
#undef SC_W
#undef SC_QG
#undef SC_KD
#undef SC_QK
#undef SC_U
#undef SC_LOAD
#undef SC_WRITE
}

#define S2_OFF_QG 17408
#define S2_OFF_QK 34816
#define S2_OFF_KT 44032
#define S2_OFF_U  62464
#define S2_BUF    66560
__device__ __forceinline__ s8v s2_frag(const LAS bfr* rowp, int q) {
    const u2v lo = *(const LAS u2v*)(rowp + 4 * q), hi = *(const LAS u2v*)(rowp + 16 + 4 * q);
    const u4v w = {lo.x, lo.y, hi.x, hi.y}; return __builtin_bit_cast(s8v, w);
}
__device__ __forceinline__ s8v s2_fragx(const LAS bfr* rowp, int g0, int g1) {
    const u2v lo = *(const LAS u2v*)(rowp + 4 * g0), hi = *(const LAS u2v*)(rowp + 4 * g1);
    const u4v w = {lo.x, lo.y, hi.x, hi.y}; return __builtin_bit_cast(s8v, w);
}
__device__ __forceinline__ s8v s2_pack(const f4v& a, const f4v& b) { const u4v w = {cvtpk(a[0], a[1]), cvtpk(a[2], a[3]), cvtpk(b[0], b[1]), cvtpk(b[2], b[3])}; return __builtin_bit_cast(s8v, w); }
template <int MODE = 0>
__device__ __forceinline__ void p_gdn_scan2(const Ctx& C, const Ptrs& P) {
    unsigned char* ws = P.ws_();
    const GAS bfr* Wg = (const GAS bfr*)(ws + WS_R + R_W); const GAS bfr* Ug = (const GAS bfr*)(ws + WS_R + R_U); const GAS bfr* QGg = (const GAS bfr*)(ws + WS_R + R_QG); const GAS bfr* KDg = (const GAS bfr*)(ws + WS_R + R_KD);
    const GAS bfr* QKg = (const GAS bfr*)(ws + WS_R + R_QK); GAS bfr* Og = (GAS bfr*)(ws + (MODE ? WS_SC : WS_R + R_O)); const GAS float* EGg = (const GAS float*)(ws + WS_EG);
    const int tid = C.tid, lane = C.lane, wave = C.wave, r = lane & 15, q = lane >> 4;
    LAS float* sEG = (LAS float*)(C.lds + 2 * S2_BUF);
    for (int task = C.vcu; task < NB * GH * 4; task += C.G) {
        const int bh = task >> 2, es = task & 3, h = bh & 31, b = bh >> 5;
        if (tid < 64) sEG[tid] = EGg[bh * 64 + tid];
        if (wave >= 2) {
            const int lw = __builtin_amdgcn_readfirstlane((tid - 128) & ~63);
            __builtin_assume(lw >= 0 && lw <= 320);
            const GAS unsigned char* RB = (const GAS unsigned char*)(ws + WS_R);
            const unsigned l16 = lane * 16, lU = (lane >> 2) * 256 + (lane & 3) * 16 + es * 64;
            const unsigned lrow = (lane >> 4) * 272 + (lane & 15) * 16, lqk = (lane >> 3) * 144 + (lane & 7) * 16, lkt = (lane & 15) * 8 * 144 + (lane >> 4) * 2;
            const int lsw = (lane & 15) >> 1;
            u4v ra[10], rb[10];
#define S2_LOAD(R, n) do { const unsigned ua_ = (unsigned)(bh * 64 + ((MODE == 2 || MODE == 4) ? 0 : (n))) * 16384u; _Pragma("unroll") for (int k_ = 0; k_ < 10; ++k_) { const int c0_ = lw + 384 * k_; \
        if (c0_ < 1024) R[k_] = *(const GAS u4v*)(RB + (size_t)((unsigned)R_W + ua_ + c0_ * 16) + l16); \
        else if (c0_ < 2048) R[k_] = *(const GAS u4v*)(RB + (size_t)((unsigned)R_QG + ua_ + (c0_ - 1024) * 16) + l16); \
        else if (c0_ < 2560) R[k_] = *(const GAS u4v*)(RB + (size_t)((unsigned)R_QK + (ua_ >> 1) + (c0_ - 2048) * 16) + l16); \
        else if (c0_ < 2816) R[k_] = *(const GAS u4v*)(RB + (size_t)((unsigned)R_U + ua_ + ((c0_ - 2560) >> 2) * 256) + lU); \
        else R[k_] = *(const GAS u4v*)(RB + (size_t)((unsigned)R_KD + ua_ + (c0_ - 2816) * 16) + l16); } } while (0)
#define S2_WRITE(R, bb) do { LAS unsigned char* B_ = C.lds + (bb) * S2_BUF; _Pragma("unroll") for (int k_ = 0; k_ < 10; ++k_) { const int c0_ = lw + 384 * k_; \
        if (c0_ < 1024) *(LAS u4v*)(B_ + (c0_ >> 4) * 272 + lrow) = R[k_]; \
        else if (c0_ < 2048) *(LAS u4v*)(B_ + S2_OFF_QG + ((c0_ - 1024) >> 4) * 272 + lrow) = R[k_]; \
        else if (c0_ < 2560) *(LAS u4v*)(B_ + S2_OFF_QK + ((c0_ - 2048) >> 3) * 144 + lqk) = R[k_]; \
        else if (c0_ < 2816) *(LAS u4v*)(B_ + S2_OFF_U + (c0_ - 2560) * 16 + l16) = R[k_]; \
        else { const int g_ = (c0_ - 2816) >> 6; LAS bfr* kt_ = (LAS bfr*)(B_ + S2_OFF_KT + lkt + ((g_ ^ lsw) << 3)); const unsigned w_[4] = {R[k_].x, R[k_].y, R[k_].z, R[k_].w}; \
            _Pragma("unroll") for (int i_ = 0; i_ < 8; ++i_) kt_[i_ * 72] = (bfr)((i_ & 1) ? (w_[i_ >> 1] >> 16) : (w_[i_ >> 1] & 0xffffu)); } } } while (0)
            u4v rc[10];
            S2_LOAD(ra, 0); S2_WRITE(ra, 0);
            S2_LOAD(rb, 1); S2_LOAD(rc, 2); S2_LOAD(ra, 3);
            __syncthreads();
#define S2_STEP(R, bb, n_) { S2_WRITE(R, bb); S2_LOAD(R, (n_) + 4); __syncthreads(); }
            for (int n = 0; n < NCH - 4; n += 6) {
                S2_STEP(rb, 1, n) S2_STEP(rc, 0, n + 1) S2_STEP(ra, 1, n + 2) S2_STEP(rb, 0, n + 3) S2_STEP(rc, 1, n + 4) S2_STEP(ra, 0, n + 5)
            }
            static_assert((NCH - 4) % 6 == 0, "scan loader schedule");
            S2_WRITE(rb, 1); __syncthreads(); S2_WRITE(rc, 0); __syncthreads(); S2_WRITE(ra, 1); __syncthreads(); __syncthreads();
#undef S2_STEP
#undef S2_LOAD
#undef S2_WRITE
        } else {
            const int nt = wave;
            f4v S[8];
#pragma unroll
            for (int w = 0; w < 8; ++w) S[w] = zero_acc();
            __syncthreads();
            for (int n = 0; n < NCH; ++n) {
                if (MODE == 3 || MODE == 4) { __syncthreads(); continue; }
                const LAS unsigned char* B = C.lds + (n & 1) * S2_BUF;
                const LAS bfr* sW = (const LAS bfr*)B; const LAS bfr* sQG = (const LAS bfr*)(B + S2_OFF_QG); const LAS bfr* sQK = (const LAS bfr*)(B + S2_OFF_QK);
                const LAS bfr* sKT = (const LAS bfr*)(B + S2_OFF_KT); const LAS bfr* sU = (const LAS bfr*)(B + S2_OFF_U);
#define S2_STAGE() asm volatile("" ::: "memory")
#define S2_LOADQ(F, mt) do { _Pragma("unroll") for (int ks = 0; ks < 4; ++ks) { F[ks] = s2_frag(sW + (16 * (mt) + r) * 136 + 32 * ks, q); F[4 + ks] = s2_frag(sQG + (16 * (mt) + r) * 136 + 32 * ks, q); } } while (0)
#define S2_MMQ(F, mt) do { _Pragma("unroll") for (int ks = 0; ks < 4; ++ks) { a1[mt] = __builtin_amdgcn_mfma_f32_16x16x32_bf16(F[ks], Bs[ks], a1[mt], 0, 0, 0); \
        a2[mt] = __builtin_amdgcn_mfma_f32_16x16x32_bf16(F[4 + ks], Bs[ks], a2[mt], 0, 0, 0); } } while (0)
                s8v fA[8], fB[8];
                S2_LOADQ(fA, 0); S2_LOADQ(fB, 1);
                s8v Bs[4];
#pragma unroll
                for (int ks = 0; ks < 4; ++ks) Bs[ks] = s2_pack(S[2 * ks], S[2 * ks + 1]);
                f4v a1[4], a2[4];
#pragma unroll
                for (int mt = 0; mt < 4; ++mt) { a1[mt] = zero_acc(); a2[mt] = zero_acc(); }
                S2_STAGE();
                S2_MMQ(fA, 0); S2_STAGE(); S2_LOADQ(fA, 2); S2_STAGE();
                S2_MMQ(fB, 1); S2_STAGE(); S2_LOADQ(fB, 3);
                bfr ur[16]; s8v fa[8];
#pragma unroll
                for (int mt = 0; mt < 4; ++mt) { const LAS bfr* pU = sU + (16 * mt + 4 * q) * 32 + 16 * nt + r; ur[4 * mt] = pU[0]; ur[4 * mt + 1] = pU[32]; ur[4 * mt + 2] = pU[64]; ur[4 * mt + 3] = pU[96]; }
                S2_STAGE();
                S2_MMQ(fA, 2); S2_STAGE();
#pragma unroll
                for (int mt = 0; mt < 4; ++mt)
#pragma unroll
                    for (int k2 = 0; k2 < 2; ++k2) fa[2 * mt + k2] = s2_frag(sQK + (16 * mt + r) * 72 + 32 * k2, q);
                S2_STAGE();
                S2_MMQ(fB, 3); S2_STAGE();
#undef S2_LOADQ
#undef S2_MMQ
                s8v fk[16];
#pragma unroll
                for (int w = 0; w < 8; ++w)
#pragma unroll
                    for (int k2 = 0; k2 < 2; ++k2) fk[2 * w + k2] = s2_fragx(sKT + (16 * w + r) * 72 + 32 * k2, q ^ w, (4 + q) ^ w);
                const float eg = sEG[n];
                S2_STAGE();
                f4v vn[4];
#pragma unroll
                for (int mt = 0; mt < 4; ++mt) vn[mt] = (f4v){bf1(ur[4 * mt]) - a1[mt][0], bf1(ur[4 * mt + 1]) - a1[mt][1], bf1(ur[4 * mt + 2]) - a1[mt][2], bf1(ur[4 * mt + 3]) - a1[mt][3]};
                s8v Bv[2];
#pragma unroll
                for (int k2 = 0; k2 < 2; ++k2) Bv[k2] = s2_pack(vn[2 * k2], vn[2 * k2 + 1]);
#pragma unroll
                for (int k2 = 0; k2 < 2; ++k2)
#pragma unroll
                    for (int mt = 0; mt < 4; ++mt) a2[mt] = __builtin_amdgcn_mfma_f32_16x16x32_bf16(fa[2 * mt + k2], Bv[k2], a2[mt], 0, 0, 0);
#pragma unroll
                for (int w = 0; w < 8; ++w) S[w] *= eg;
#pragma unroll
                for (int k2 = 0; k2 < 2; ++k2)
#pragma unroll
                    for (int w = 0; w < 8; ++w) S[w] = __builtin_amdgcn_mfma_f32_16x16x32_bf16(fk[2 * w + k2], Bv[k2], S[w], 0, 0, 0);
#pragma unroll
                for (int mt = 0; mt < 4; ++mt) {
                    GAS bfr* po = Og + (size_t)(b * SEQ + n * CH + 16 * mt + 4 * q) * DM + h * 128 + es * 32 + 16 * nt + r;
                    po[0] = f2bf1(a2[mt][0]); po[DM] = f2bf1(a2[mt][1]); po[2 * DM] = f2bf1(a2[mt][2]); po[3 * DM] = f2bf1(a2[mt][3]); }
#undef S2_STAGE
                MFMA_SETTLE(S[7]);
                __syncthreads();
            }
        }
        __syncthreads();
    }
}
#undef S2_OFF_QG
#undef S2_OFF_QK
#undef S2_OFF_KT
#undef S2_OFF_U
#undef S2_BUF

__device__ __forceinline__ void p_gdn_onorm(const Ctx& C, const Ptrs& P) {
    unsigned char* ws = P.ws_(); const bfr* Og = (const bfr*)(ws + WS_R + R_O); const bfr* PROJ = (const bfr*)(ws + WS_BIG); bfr* AO = (bfr*)(ws + WS_XN); const float* og = P.in_(6);
    const size_t gt = (size_t)C.vcu * 512 + C.tid, GT = (size_t)C.G * 512;
    for (size_t idx0 = gt; idx0 < (size_t)NT * DM / 8; idx0 += 4 * GT) {
        u4v o8[4], z8[4];
#pragma unroll
        for (int b4 = 0; b4 < 4; ++b4) { const size_t idx = idx0 + b4 * GT; const size_t t = idx >> 9; const int hh = (int)(idx >> 4) & 31, i = (int)idx & 15;
            o8[b4] = *(const u4v*)(Og + t * DM + hh * 128 + 8 * i); z8[b4] = *(const u4v*)(PROJ + t * 16384 + 12288 + hh * 128 + 8 * i); }
        const int i = (int)idx0 & 15;
        const f4v g0 = *(const f4v*)(og + 8 * i), g1 = *(const f4v*)(og + 8 * i + 4); const float g[8] = {g0[0], g0[1], g0[2], g0[3], g1[0], g1[1], g1[2], g1[3]};
#pragma unroll
        for (int b4 = 0; b4 < 4; ++b4) { const size_t idx = idx0 + b4 * GT; const size_t t = idx >> 9; const int hh = (int)(idx >> 4) & 31;
            float o[8] = {bflo(o8[b4].x), bfhi(o8[b4].x), bflo(o8[b4].y), bfhi(o8[b4].y), bflo(o8[b4].z), bfhi(o8[b4].z), bflo(o8[b4].w), bfhi(o8[b4].w)};
            float z[8] = {bflo(z8[b4].x), bfhi(z8[b4].x), bflo(z8[b4].y), bfhi(z8[b4].y), bflo(z8[b4].z), bfhi(z8[b4].z), bflo(z8[b4].w), bfhi(z8[b4].w)};
            float ss = 0.f;
#pragma unroll
            for (int k = 0; k < 8; ++k) ss += o[k] * o[k];
            ss += __shfl_xor(ss, 1); ss += __shfl_xor(ss, 2); ss += __shfl_xor(ss, 4); ss += __shfl_xor(ss, 8);
            const float rn = __builtin_amdgcn_rsqf(ss * (1.f / 128.f) + EPS);
            float y[8];
#pragma unroll
            for (int k = 0; k < 8; ++k) y[k] = o[k] * rn * g[k] * (z[k] * __builtin_amdgcn_rcpf(1.f + __expf(-z[k])));
#if F8_OUT
#pragma unroll
            for (int k = 0; k < 8; ++k) y[k] = fminf(fmaxf(y[k] * SO, -440.f), 440.f);
            u2v w; w.x = cvt4_fp8(y[0], y[1], y[2], y[3]); w.y = cvt4_fp8(y[4], y[5], y[6], y[7]);
            *(u2v*)(ws + WS_XN8 + t * DM + hh * 128 + 8 * i) = w; }
#else
            u4v w; w.x = cvtpk(y[0], y[1]); w.y = cvtpk(y[2], y[3]); w.z = cvtpk(y[4], y[5]); w.w = cvtpk(y[6], y[7]);
            *(u4v*)(AO + t * DM + hh * 128 + 8 * i) = w; }
#endif
    }
}
__device__ __forceinline__ unsigned mono_key(float x) { const unsigned u = __float_as_uint(x); return u ^ ((unsigned)((int)u >> 31) | 0x80000000u); }
#define KEY_INS(K, key) do { unsigned x_ = (key); _Pragma("unroll") for (int s_ = 0; s_ < 16; ++s_) { const unsigned hi_ = max(K[s_], x_); x_ = min(K[s_], x_); K[s_] = hi_; } } while (0)
__device__ __forceinline__ void p_route(const Ctx& C, const Ptrs& P) {
    unsigned char* ws = P.ws_(); const float* SC = (const float*)(ws + WS_SC); bfr* G = (bfr*)(ws + WS_G);
    LAS unsigned char* wl = C.lds + C.wave * 16384;
    LAS int* sE = (LAS int*)(wl); LAS float* sGt = (LAS float*)(wl + 2048); LAS float* sV1 = (LAS float*)(wl + 4096); LAS float* sV2 = (LAS float*)(wl + 8192); LAS int* sI = (LAS int*)(wl + 12288);
    const int lane = C.lane, gw = C.vcu * 8 + C.wave, NGW = C.G * 8;
    for (int wt = gw; wt < NT / 4; wt += NGW) {
        const int tl = lane >> 4, t = wt * 4 + tl;
        unsigned k1[16];
#pragma unroll
        for (int i = 0; i < 16; ++i) k1[i] = 0u;
        const float* base = SC + (size_t)t * PQ + (lane & 15) * 128;
        for (int e = 0; e < 128; e += 4) { const f4v x4 = *(const f4v*)(base + e);
            KEY_INS(k1, (mono_key(x4[0]) & ~127u) | (unsigned)(127 - e)); KEY_INS(k1, (mono_key(x4[1]) & ~127u) | (unsigned)(126 - e));
            KEY_INS(k1, (mono_key(x4[2]) & ~127u) | (unsigned)(125 - e)); KEY_INS(k1, (mono_key(x4[3]) & ~127u) | (unsigned)(124 - e)); }
        const bool h0 = (lane & 1) == 0;
        float v1[16], v2[16];
#pragma unroll
        for (int i = 0; i < 16; ++i) { const int id = 127 - (int)(k1[i] & 127u); const float vv = base[id];
            const float ov = __shfl_xor(vv, 1); const int oi = __shfl_xor(id, 1);
            v1[i] = h0 ? vv : ov; v2[i] = h0 ? ov : vv; const int ia = h0 ? id : oi, ib = h0 ? oi : id;
            sV1[i * 64 + lane] = v1[i]; sV2[i * 64 + lane] = v2[i]; sI[i * 64 + lane] = ia | (ib << 8); }
        unsigned k2[16];
#pragma unroll
        for (int i = 0; i < 16; ++i) k2[i] = 0u;
#pragma unroll
        for (int a = 0; a < 16; ++a)
#pragma unroll
            for (int b = 0; b < 16; ++b)
                if ((a + 1) * (b + 1) <= 16) KEY_INS(k2, (mono_key(v1[a] + v2[b]) & ~255u) | (unsigned)(255 - (a * 16 + b)));
        LDS_WAIT(); asm volatile("" ::: "memory");
        float ts[16]; int te[16]; float mx = -__builtin_inff();
#pragma unroll
        for (int i = 0; i < 16; ++i) { const int code = 255 - (int)(k2[i] & 255u), a = code >> 4, b = code & 15;
            ts[i] = sV1[a * 64 + lane] + sV2[b * 64 + lane]; te[i] = (sI[a * 64 + lane] & 0xff) * 128 + (sI[b * 64 + lane] >> 8); mx = fmaxf(mx, ts[i]); }
        float sum = 0.f;
#pragma unroll
        for (int i = 0; i < 16; ++i) { ts[i] = __expf(ts[i] - mx); sum += ts[i]; }
        const float inv = 1.f / sum;
        if (h0) { const int hb = ((lane >> 1) & 7) * 16;
#pragma unroll
            for (int i = 0; i < 16; ++i) { sE[tl * 128 + hb + i] = te[i]; sGt[tl * 128 + hb + i] = ts[i] * inv; } }
        LDS_WAIT(); asm volatile("" ::: "memory");
        for (int k = 0; k < 4; ++k) {
            const size_t tt = (size_t)wt * 4 + k; u4v* row = (u4v*)(G + tt * PE); const u4v z = {0u, 0u, 0u, 0u};
#pragma unroll 8
            for (int j = 0; j < 32; ++j) row[j * 64 + lane] = z;
            const int e0 = sE[k * 128 + lane], e1 = sE[k * 128 + 64 + lane]; float t0 = 0.f, t1 = 0.f; bool f0 = true, f1 = true;
            for (int j = 0; j < 128; j += 4) { const i4v ej = *(const LAS i4v*)(sE + k * 128 + j); const f4v gj = *(const LAS f4v*)(sGt + k * 128 + j);
                if (ej.x == e0) { t0 += gj[0]; if (j + 0 < lane) f0 = false; } if (ej.y == e0) { t0 += gj[1]; if (j + 1 < lane) f0 = false; }
                if (ej.z == e0) { t0 += gj[2]; if (j + 2 < lane) f0 = false; } if (ej.w == e0) { t0 += gj[3]; if (j + 3 < lane) f0 = false; }
                if (ej.x == e1) { t1 += gj[0]; if (j + 0 < lane + 64) f1 = false; } if (ej.y == e1) { t1 += gj[1]; if (j + 1 < lane + 64) f1 = false; }
                if (ej.z == e1) { t1 += gj[2]; if (j + 2 < lane + 64) f1 = false; } if (ej.w == e1) { t1 += gj[3]; if (j + 3 < lane + 64) f1 = false; } }
            VM_WAIT();
            if (f0) G[tt * PE + e0] = f2bf1(t0);
            if (f1) G[tt * PE + e1] = f2bf1(t1);
        }
        LDS_WAIT(); asm volatile("" ::: "memory");
    }
}

typedef _Float16 h2v __attribute__((ext_vector_type(2)));
__device__ __forceinline__ void p_sroute(const Ctx& C, const Ptrs& P, int layer) {
    unsigned char* ws = P.ws_(); const bfr* QRY = (const bfr*)(ws + WS_QRY); const bfr* KEY = (const bfr*)(ws + WS_WTKEY) + (size_t)layer * PQ * PQ; bfr* G = (bfr*)(ws + WS_G);
    const int lane = C.lane, wave = C.wave, r = lane & 15, q = lane >> 4;
    LAS unsigned char* wl = C.lds + wave * 16640;
    LAS _Float16* sS = (LAS _Float16*)wl;
    LAS float* sV1 = (LAS float*)(wl); LAS float* sV2 = (LAS float*)(wl + 4096); LAS int* sI = (LAS int*)(wl + 8192);
    LAS int* sE = (LAS int*)(C.lds); LAS float* sGt = (LAS float*)(C.lds + 16384);
    LAS unsigned* bm = (LAS unsigned*)(C.lds + 32768 + wave * 3200); LAS unsigned* cnt = bm + 512; LAS int* le = (LAS int*)(bm + 516); LAS float* lg = (LAS float*)(bm + 516 + 128);
    for (int blk = C.vcu; blk < NT / 32; blk += C.G) {
        const int t0 = blk * 32;
#pragma unroll
        for (int hf = 0; hf < 2; ++hf) {
            const int hh = wave * 2 + hf;
            s8v a[2][4];
#pragma unroll
            for (int mt = 0; mt < 2; ++mt)
#pragma unroll
                for (int ks = 0; ks < 4; ++ks) a[mt][ks] = *(const s8v*)(QRY + (size_t)(t0 + 16 * mt + r) * PQ + hh * 128 + 32 * ks + 8 * q);
#pragma unroll
            for (int nt = 0; nt < 8; ++nt) {
                s8v b[4];
#pragma unroll
                for (int ks = 0; ks < 4; ++ks) b[ks] = *(const s8v*)(KEY + (size_t)(hh * 128 + 16 * nt + r) * PQ + hh * 128 + 32 * ks + 8 * q);
                f4v c0 = zero_acc(), c1 = zero_acc();
#pragma unroll
                for (int ks = 0; ks < 4; ++ks) { c0 = __builtin_amdgcn_mfma_f32_16x16x32_bf16(a[0][ks], b[ks], c0, 0, 0, 0); c1 = __builtin_amdgcn_mfma_f32_16x16x32_bf16(a[1][ks], b[ks], c1, 0, 0, 0); MFMA_SETTLE(c0); MFMA_SETTLE(c1); }
                MFMA_SETTLE(c0); MFMA_SETTLE(c1);
#pragma unroll
                for (int e = 0; e < 4; ++e) { sS[(32 * hf + 4 * q + e) * 130 + 16 * nt + r] = (_Float16)c0[e]; sS[(32 * hf + 16 + 4 * q + e) * 130 + 16 * nt + r] = (_Float16)c1[e]; }
            }
        }
        LDS_WAIT(); asm volatile("" ::: "memory");
        unsigned k1[16];
#pragma unroll
        for (int i = 0; i < 16; ++i) k1[i] = 0u;
        const LAS h2v* lp = (const LAS h2v*)(sS + lane * 130);
        for (int e = 0; e < 128; e += 8) {
#pragma unroll
            for (int u = 0; u < 4; ++u) { const h2v x2 = lp[(e >> 1) + u];
                KEY_INS(k1, (mono_key((float)x2[0]) & ~127u) | (unsigned)(127 - e - 2 * u)); KEY_INS(k1, (mono_key((float)x2[1]) & ~127u) | (unsigned)(126 - e - 2 * u)); }
        }
        const bool h0 = lane < 32;
        float v1[16], v2[16]; int ids[16]; float vals[16];
#pragma unroll
        for (int i = 0; i < 16; ++i) { ids[i] = 127 - (int)(k1[i] & 127u); vals[i] = (float)sS[lane * 130 + ids[i]]; }
        LDS_WAIT(); asm volatile("" ::: "memory");
#pragma unroll
        for (int i = 0; i < 16; ++i) { const float ov = __shfl_xor(vals[i], 32); const int oi = __shfl_xor(ids[i], 32);
            v1[i] = h0 ? vals[i] : ov; v2[i] = h0 ? ov : vals[i]; const int ia = h0 ? ids[i] : oi, ib = h0 ? oi : ids[i];
            sV1[i * 64 + lane] = v1[i]; sV2[i * 64 + lane] = v2[i]; sI[i * 64 + lane] = ia | (ib << 8); }
        unsigned k2[16];
#pragma unroll
        for (int b = 0; b < 16; ++b) k2[b] = (mono_key(v1[0] + v2[b]) & ~255u) | (unsigned)(255 - b);
#pragma unroll
        for (int a = 1; a < 16; ++a)
#pragma unroll
            for (int b = 0; b < 16; ++b)
                if ((a + 1) * (b + 1) <= 16) KEY_INS(k2, (mono_key(v1[a] + v2[b]) & ~255u) | (unsigned)(255 - (a * 16 + b)));
        LDS_WAIT(); asm volatile("" ::: "memory");
        float ts[16]; int te[16]; float mx = -__builtin_inff();
#pragma unroll
        for (int i = 0; i < 16; ++i) { const int code = 255 - (int)(k2[i] & 255u), a = code >> 4, b = code & 15;
            ts[i] = sV1[a * 64 + lane] + sV2[b * 64 + lane]; te[i] = (sI[a * 64 + lane] & 0xff) * 128 + (sI[b * 64 + lane] >> 8); mx = fmaxf(mx, ts[i]); }
        float sum = 0.f;
#pragma unroll
        for (int i = 0; i < 16; ++i) { ts[i] = __expf(ts[i] - mx); sum += ts[i]; }
        const float inv = 1.f / sum;
        __syncthreads();
        if (h0) {
#pragma unroll
            for (int i = 0; i < 16; ++i) { sE[lane * 128 + wave * 16 + i] = te[i]; sGt[lane * 128 + wave * 16 + i] = ts[i] * inv; } }
        __syncthreads();
        for (int k = 0; k < 4; ++k) {
            const int tl = wave * 4 + k; const size_t tt = (size_t)t0 + tl;
            if (layer == 0) { u4v* row = (u4v*)(G + tt * PE); const u4v z = {0u, 0u, 0u, 0u};
#pragma unroll 8
                for (int j = 0; j < 32; ++j) row[j * 64 + lane] = z; }
            const int e0 = sE[tl * 128 + lane], e1 = sE[tl * 128 + 64 + lane]; float t0s = sGt[tl * 128 + lane], t1s = sGt[tl * 128 + 64 + lane];
#pragma unroll
            for (int j = 0; j < 8; ++j) bm[j * 64 + lane] = 0u;
            if (lane == 0) *cnt = 0u;
            LDS_WAIT(); asm volatile("" ::: "memory");
            const unsigned b0 = 1u << (e0 & 31), b1 = 1u << (e1 & 31);
            const bool d0 = (__hip_atomic_fetch_or(bm + (e0 >> 5), b0, __ATOMIC_RELAXED, __HIP_MEMORY_SCOPE_WORKGROUP) & b0) != 0u;
            const bool d1 = (__hip_atomic_fetch_or(bm + (e1 >> 5), b1, __ATOMIC_RELAXED, __HIP_MEMORY_SCOPE_WORKGROUP) & b1) != 0u;
            if (d0) { const unsigned sl = __hip_atomic_fetch_add(cnt, 1u, __ATOMIC_RELAXED, __HIP_MEMORY_SCOPE_WORKGROUP); le[sl] = e0; lg[sl] = t0s; }
            if (d1) { const unsigned sl = __hip_atomic_fetch_add(cnt, 1u, __ATOMIC_RELAXED, __HIP_MEMORY_SCOPE_WORKGROUP); le[sl] = e1; lg[sl] = t1s; }
            LDS_WAIT(); asm volatile("" ::: "memory");
            const int nd = (int)__builtin_amdgcn_readfirstlane((int)*cnt);
            for (int j = 0; j < nd; ++j) { const int ej = le[j]; const float gj = lg[j]; if (ej == e0 && !d0) t0s += gj; if (ej == e1 && !d1) t1s += gj; }
            const bool f0 = !d0, f1 = !d1;
            VM_WAIT();
            if (f0) G[tt * PE + e0] = f2bf1(t0s);
            if (f1) G[tt * PE + e1] = f2bf1(t1s);
        }
        __syncthreads();
    }
}

constexpr int KIND_V = F8_KVQ ? 2 : 1;
__device__ __forceinline__ void p_headprep(const Ctx& C, const Ptrs& P) {
    unsigned char* ws = P.ws_(); const bfr* KVQ = (const bfr*)(ws + WS_BIG); bfr* Qh = (bfr*)(ws + WS_R + R_QH); bfr* Kh = (bfr*)(ws + WS_R + R_KH); bfr* Vh = (bfr*)(ws + WS_R + R_VH);
    const float* kg = P.in_(10); const float* qg = P.in_(13);
    const size_t gt = (size_t)C.vcu * 512 + C.tid, GT = (size_t)C.G * 512;
    for (size_t idx0 = gt; idx0 < (size_t)NT * 1536; idx0 += 4 * GT) {
        u4v x8[4];
#pragma unroll
        for (int b4 = 0; b4 < 4; ++b4) { const size_t idx = idx0 + b4 * GT; const size_t t = idx / 1536; const int rem = (int)(idx - t * 1536), vec = rem >> 4, i = rem & 15;
            x8[b4] = *(const u4v*)(KVQ + t * 12288 + vec * 128 + 8 * i); }
#pragma unroll
        for (int b4 = 0; b4 < 4; ++b4) { const size_t idx = idx0 + b4 * GT; const size_t t = idx / 1536; const int rem = (int)(idx - t * 1536), vec = rem >> 4, i = rem & 15, kind = vec >> 5, sh = vec & 31;
            float x[8] = {bflo(x8[b4].x), bfhi(x8[b4].x), bflo(x8[b4].y), bfhi(x8[b4].y), bflo(x8[b4].z), bfhi(x8[b4].z), bflo(x8[b4].w), bfhi(x8[b4].w)};
            float ss = 0.f;
#pragma unroll
            for (int k = 0; k < 8; ++k) ss += x[k] * x[k];
            ss += __shfl_xor(ss, 1); ss += __shfl_xor(ss, 2); ss += __shfl_xor(ss, 4); ss += __shfl_xor(ss, 8);
            u4v w = x8[b4];
            if (kind != KIND_V) { const float rn = __builtin_amdgcn_rsqf(ss * (1.f / 128.f) + EPS); const float* gp = (kind == 0 ? kg : qg) + 8 * i; const f4v g0 = *(const f4v*)gp, g1 = *(const f4v*)(gp + 4);
                w.x = cvtpk(x[0] * rn * g0[0], x[1] * rn * g0[1]); w.y = cvtpk(x[2] * rn * g0[2], x[3] * rn * g0[3]); w.z = cvtpk(x[4] * rn * g1[0], x[5] * rn * g1[1]); w.w = cvtpk(x[6] * rn * g1[2], x[7] * rn * g1[3]); }
            const size_t b = t >> 12, s = t & 4095; bfr* dst = (kind == 0 ? Kh : (kind == KIND_V ? Vh : Qh)) + ((b * 32 + sh) * SEQ + s) * 128 + 8 * i;
            *(u4v*)dst = w; }
    }
}

__device__ __forceinline__ att::BlockRef<att::bf16, att::bf16> attn_ref(const att::bf16* Qh, const att::bf16* Kh, const att::bf16* Vh, att::bf16* Oh, int bhp, int qb) {
    const int b = bhp >> 6, hd = (bhp >> 2) & 15, c = (bhp >> 1) & 1, vh = bhp & 1;
    att::BlockRef<att::bf16, att::bf16> r;
    r.Q = Qh + ((size_t)(b * 32 + hd * 2 + c) * SEQ + (size_t)qb * 256) * 128; r.K = Kh + (size_t)(b * 32 + hd * 2 + c) * SEQ * 128; r.V = Vh + (size_t)(b * 32 + hd * 2 + vh) * SEQ * 128;
    r.O = Oh + ((size_t)bhp * SEQ + (size_t)qb * 256) * 128; r.P0 = qb * 256;
    return r;
}
__device__ __forceinline__ void p_attn(const Ctx& C, const Ptrs& P) {
    unsigned char* ws = P.ws_(); const att::bf16* Qh = (const att::bf16*)(ws + WS_R + R_QH); const att::bf16* Kh = (const att::bf16*)(ws + WS_R + R_KH); const att::bf16* Vh = (const att::bf16*)(ws + WS_R + R_VH);
    att::bf16* Oh = (att::bf16*)(ws + WS_R + R_OH);
    extern __shared__ __attribute__((aligned(16))) char lds_sym[]; char* lds = lds_sym;
    constexpr int total = 128 * 8;
    int L = C.vcu; if (L >= total) return;
    int pass = 0;
    att::BlockRef<att::bf16, att::bf16> cur = attn_ref(Qh, Kh, Vh, Oh, L >> 3, L & 7);
    att::Seam<att::bf16> S;
    att::causal_swa_prime<att::bf16, att::bf16>(cur, SEQ, lds, S);
    for (;;) {
        const bool more_pass = pass == 0, more_item = L + C.G < total, last = !more_pass && !more_item;
        int passn = pass + 1, Ln = L;
        if (!more_pass) { passn = 0; Ln = more_item ? L + C.G : L; }
        const att::BlockRef<att::bf16, att::bf16> nxt = last ? cur : attn_ref(Qh, Kh, Vh, Oh, Ln >> 3, passn ? 15 - (Ln & 7) : (Ln & 7));
        att::causal_swa_block<att::bf16, att::bf16>(cur, nxt, SEQ, SEQ, lds, S);
        if (last) break;
        cur = nxt; pass = passn; L = Ln;
    }
    __syncthreads();
}

__device__ __forceinline__ void p_combine(const Ctx& C, const Ptrs& P) {
    unsigned char* ws = P.ws_(); const bfr* Oh = (const bfr*)(ws + WS_R + R_OH); bfr* AO = (bfr*)(ws + WS_XN); const float* sg = P.in_(18);
    float lam;
    { const float* q1 = P.in_(14); const float* k1 = P.in_(15); const float* q2 = P.in_(16); const float* k2 = P.in_(17); const int l = C.lane;
      const float d1 = wave_sum(q1[l] * k1[l] + q1[l + 64] * k1[l + 64]), d2 = wave_sum(q2[l] * k2[l] + q2[l + 64] * k2[l + 64]);
      lam = expf(d1) - expf(d2) + LAMBDA_INIT; }
    const size_t gt = (size_t)C.vcu * 512 + C.tid, GT = (size_t)C.G * 512;
    for (size_t idx0 = gt; idx0 < (size_t)NT * 512; idx0 += 4 * GT) {
        u4v a8[4], b8[4];
#pragma unroll
        for (int b4 = 0; b4 < 4; ++b4) { const size_t idx = idx0 + b4 * GT; const size_t t = idx >> 9, b = t >> 12, s = t & 4095; const int hd = (int)(idx >> 5) & 15, i = (int)idx & 31, vh = i >> 4, d = (8 * i) & 127;
            const size_t o0i = ((((b * 16 + hd) * 2 + 0) * 2 + vh) * SEQ + s) * 128 + d, o1i = ((((b * 16 + hd) * 2 + 1) * 2 + vh) * SEQ + s) * 128 + d;
            a8[b4] = *(const u4v*)(Oh + o0i); b8[b4] = *(const u4v*)(Oh + o1i); }
        const int i = (int)idx0 & 31;
        const f4v g0 = *(const f4v*)(sg + 8 * i), g1 = *(const f4v*)(sg + 8 * i + 4);
#pragma unroll
        for (int b4 = 0; b4 < 4; ++b4) { const size_t idx = idx0 + b4 * GT; const size_t t = idx >> 9; const int hd = (int)(idx >> 5) & 15;
            float o[8] = {bflo(a8[b4].x) - lam * bflo(b8[b4].x), bfhi(a8[b4].x) - lam * bfhi(b8[b4].x), bflo(a8[b4].y) - lam * bflo(b8[b4].y), bfhi(a8[b4].y) - lam * bfhi(b8[b4].y),
                          bflo(a8[b4].z) - lam * bflo(b8[b4].z), bfhi(a8[b4].z) - lam * bfhi(b8[b4].z), bflo(a8[b4].w) - lam * bflo(b8[b4].w), bfhi(a8[b4].w) - lam * bfhi(b8[b4].w)};
            float ss = 0.f;
#pragma unroll
            for (int k = 0; k < 8; ++k) ss += o[k] * o[k];
            ss += __shfl_xor(ss, 1); ss += __shfl_xor(ss, 2); ss += __shfl_xor(ss, 4); ss += __shfl_xor(ss, 8); ss += __shfl_xor(ss, 16);
            const float rn = __builtin_amdgcn_rsqf(ss * (1.f / 256.f) + EPS) * (1.f - LAMBDA_INIT);
#if F8_OUT
            const float rs = rn * SO; float y[8] = {o[0] * rs * g0[0], o[1] * rs * g0[1], o[2] * rs * g0[2], o[3] * rs * g0[3], o[4] * rs * g1[0], o[5] * rs * g1[1], o[6] * rs * g1[2], o[7] * rs * g1[3]};
#pragma unroll
            for (int k = 0; k < 8; ++k) y[k] = fminf(fmaxf(y[k], -440.f), 440.f);
            u2v w; w.x = cvt4_fp8(y[0], y[1], y[2], y[3]); w.y = cvt4_fp8(y[4], y[5], y[6], y[7]);
            *(u2v*)(ws + WS_XN8 + t * DM + hd * 256 + 8 * i) = w; }
#else
            u4v w; w.x = cvtpk(o[0] * rn * g0[0], o[1] * rn * g0[1]); w.y = cvtpk(o[2] * rn * g0[2], o[3] * rn * g0[3]); w.z = cvtpk(o[4] * rn * g1[0], o[5] * rn * g1[1]); w.w = cvtpk(o[6] * rn * g1[2], o[7] * rn * g1[3]);
            *(u4v*)(AO + t * DM + hd * 256 + 8 * i) = w; }
#endif
    }
}
constexpr int NPH_LAYER = 13, NPHASE = 1 + 2 * NPH_LAYER;
#ifndef MK_PER_PHASE
#define MK_PER_PHASE 0
#endif

__global__ void __launch_bounds__(512, 2) trunk_fwd(KArgs KA) {
    extern __shared__ __attribute__((aligned(16))) unsigned char lds_raw[];
    Ctx C; C.lds = (LAS unsigned char*)lds_raw; C.tid = threadIdx.x; C.lane = C.tid & 63; C.wave = __builtin_amdgcn_readfirstlane(C.tid >> 6);
    C.G = gridDim.x; { const int bx = blockIdx.x; C.vcu = (C.G % 8 == 0) ? (bx % 8) * (C.G / 8) + bx / 8 : bx; }
    volatile LAS unsigned* MISC = (volatile LAS unsigned*)(C.lds + MISC_OFF);
    for (int u = C.tid; u < (LDS_BYTES - MISC_OFF) / 4; u += 512) MISC[u] = 0u;
    __syncthreads();
    Ptrs P; P.tbl = (LAS unsigned long long*)(C.lds + MISC_OFF + 128);
    if (C.tid < 28) P.tbl[C.tid] = ((const unsigned long long*)&KA)[C.tid];
    __syncthreads();
    unsigned* ctl = (unsigned*)(P.ws_() + WS_CTL);
    const int lo = KA.ph_lo, hi = KA.ph_hi;
    XcdBarrier bar; bar.bar = ctl + CW_BAR + KA.li * XCD_BAR_WORDS; bar.x = 0; bar.st = MISC + 8;
    if (hi - lo > 1) bar = xcd_barrier_post(ctl + CW_BAR + KA.li * XCD_BAR_WORDS, MISC + 8);
#define IN(k) (lo <= (k) && (k) < hi)
#define SEAM(k) do { if (IN(k) && IN((k) + 1)) xcd_barrier(bar); } while (0)
    unsigned char* ws = P.ws_();
    bfr* XN = (bfr*)(ws + WS_XN); bfr* BIG = (bfr*)(ws + WS_BIG);
    const int hb = (int)blockIdx.x;

    if (IN(0)) { p_convert(C, P); __syncthreads(); }
    SEAM(0);
    {
        constexpr int layer = 0;
        const int pb = 1 + layer * NPH_LAYER;
        if (IN(pb + 0)) p_norm_rows(C, layer == 0 ? P.in_(0) : (const float*)P.out_(), XN, ((layer == 0 && F8_PROJ0 != 0) || (layer == 1 && F8_KVQ != 0)) ? ws + WS_XN8 : nullptr);
        SEAM(pb + 0);
        if (IN(pb + 1)) {
            const int N = layer == 0 ? 16384 : 12288;
            if (layer == 0 && F8_PROJ0 == 2) {
                { pg8::Gemm g{XN, (const bfr*)(ws + WS_WTIN), NT, 8192, DM}; pg8::StaticOrder S; S.init(NT, 8192, C.G, hb);
                  pg8::EpiBf16<0> E{BIG, N, nullptr, 0, 0, 1.f};
                  pg8::gemm_phase<pg8::EpiBf16<0>, pg8::StaticOrder, true, true>((PG8_LAS unsigned char*)C.lds, g, S, E); }
                __syncthreads();
                { pg8::Gemm g{(const bfr*)(ws + WS_XN8), (const bfr*)(ws + WS_WTIN + (size_t)8192 * DM * 2), NT, 8192, DM / 2}; pg8::StaticOrder S; S.init(NT, 8192, C.G, hb);
                  pg8::EpiBf16<0> E{BIG + 8192, N, nullptr, 8192, 0, 1.f / SU};
                  pg8::gemm_phase<pg8::EpiBf16<0>, pg8::StaticOrder, true, true, true>((PG8_LAS unsigned char*)C.lds, g, S, E); }
            } else if (layer == 0 && F8_PROJ0 == 4) {
                { pg8::Gemm g{(const bfr*)(ws + WS_XN8), (const bfr*)(ws + WS_WTIN), NT, 4096, DM / 2}; pg8::StaticOrder S; S.init(NT, 4096, C.G, hb);
                  pg8::EpiBf16<0> E{BIG, N, nullptr, 4096, 0, 1.f / SU};
                  pg8::gemm_phase<pg8::EpiBf16<0>, pg8::StaticOrder, true, true, true>((PG8_LAS unsigned char*)C.lds, g, S, E); }
                __syncthreads();
                { pg8::Gemm g{XN, (const bfr*)(ws + WS_WTIN + (size_t)4096 * DM), NT, 12288, DM}; pg8::StaticOrder S; S.init(NT, 12288, C.G, hb);
                  pg8::EpiBf16<0> E{BIG + 4096, N, nullptr, 0, 0, 1.f};
                  pg8::gemm_phase<pg8::EpiBf16<0>, pg8::StaticOrder, true, true>((PG8_LAS unsigned char*)C.lds, g, S, E); }
            } else if (layer == 0 && F8_PROJ0 == 3) {
                { pg8::Gemm g{(const bfr*)(ws + WS_XN8), (const bfr*)(ws + WS_WTIN), NT, 8192, DM / 2}; pg8::StaticOrder S; S.init(NT, 8192, C.G, hb);
                  pg8::EpiBf16<0> E{BIG, N, nullptr, 8192, 0, 1.f / SU};
                  pg8::gemm_phase<pg8::EpiBf16<0>, pg8::StaticOrder, true, true, true>((PG8_LAS unsigned char*)C.lds, g, S, E); }
                __syncthreads();
                { pg8::Gemm g{XN, (const bfr*)(ws + WS_WTIN + (size_t)8192 * DM), NT, 8192, DM}; pg8::StaticOrder S; S.init(NT, 8192, C.G, hb);
                  pg8::EpiBf16<0> E{BIG + 8192, N, nullptr, 0, 0, 1.f};
                  pg8::gemm_phase<pg8::EpiBf16<0>, pg8::StaticOrder, true, true>((PG8_LAS unsigned char*)C.lds, g, S, E); }
            } else if (layer == 0 && F8_PROJ0 == 1) {
                pg8::Gemm g{(const bfr*)(ws + WS_XN8), (const bfr*)(ws + WS_WTIN), NT, N, DM / 2}; pg8::StaticOrder S; S.init(NT, N, C.G, hb);
                pg8::EpiBf16<0> E{BIG, N, nullptr, N, 0, 1.f / SU};
                pg8::gemm_phase<pg8::EpiBf16<0>, pg8::StaticOrder, true, true, true>((PG8_LAS unsigned char*)C.lds, g, S, E);
            } else if (layer == 1 && F8_KVQ == 2) {
                pg8::Gemm g{(const bfr*)(ws + WS_XN8), (const bfr*)(ws + WS_WTKVQ), NT, N, DM / 2}; pg8::StaticOrder S; S.init(NT, N, C.G, hb);
                pg8::EpiBf16<0> E{BIG, N, nullptr, N, 0, 1.f / SU};
                pg8::gemm_phase<pg8::EpiBf16<0>, pg8::StaticOrder, true, true, true>((PG8_LAS unsigned char*)C.lds, g, S, E);
            } else if (layer == 1 && F8_KVQ) {
                { pg8::Gemm g{(const bfr*)(ws + WS_XN8), (const bfr*)(ws + WS_WTKVQ), NT, 8192, DM / 2}; pg8::StaticOrder S; S.init(NT, 8192, C.G, hb);
                  pg8::EpiBf16<0> E{BIG, N, nullptr, 8192, 0, 1.f / SU};
                  pg8::gemm_phase<pg8::EpiBf16<0>, pg8::StaticOrder, true, true, true>((PG8_LAS unsigned char*)C.lds, g, S, E); }
                __syncthreads();
                { pg8::Gemm g{XN, (const bfr*)(ws + WS_WTKVQ + (size_t)2 * DM * DM), NT, DM, DM}; pg8::StaticOrder S; S.init(NT, DM, C.G, hb);
                  pg8::EpiBf16<0> E{BIG + 8192, N, nullptr, 0, 0, 1.f};
                  pg8::gemm_phase<pg8::EpiBf16<0>, pg8::StaticOrder, true, true>((PG8_LAS unsigned char*)C.lds, g, S, E); }
            } else {
                pg8::Gemm g{XN, (const bfr*)(ws + (layer == 0 ? WS_WTIN : WS_WTKVQ)), NT, N, DM}; pg8::StaticOrder S; S.init(NT, N, C.G, hb);
                pg8::EpiBf16<0> E{BIG, N, nullptr, 0, 0, 1.f};
                pg8::gemm_phase<pg8::EpiBf16<0>, pg8::StaticOrder, true, true>((PG8_LAS unsigned char*)C.lds, g, S, E);
            }
        }
        SEAM(pb + 1);
        if (IN(pb + 2)) { if (layer == 0) p_bd(C, XN, (const bfr*)(ws + WS_WTBD), (float*)(ws + WS_BD)); else p_headprep(C, P); }
        SEAM(pb + 2);
        if (IN(pb + 3)) { if (layer == 0) p_gdn_prep(C, P); else p_attn(C, P); }
        SEAM(pb + 3);
        if (IN(pb + 4)) { if (layer == 0) p_gdn_scan(C, P); else p_combine(C, P); }
        SEAM(pb + 4);
        if (IN(pb + 5)) { if (layer == 0) p_gdn_onorm(C, P); }
        if (layer == 0) SEAM(pb + 5);
        if (IN(pb + 6)) {
#if F8_OUT
            pg8::Gemm g{(const bfr*)(ws + WS_XN8), (const bfr*)(ws + (layer == 0 ? WS_WTOUT : WS_WTO)), NT, DM, DM / 2}; pg8::StaticOrder S; S.init(NT, DM, C.G, hb);
            pg8::EpiRes E{layer == 0 ? P.in_(0) : (const float*)P.out_(), P.out_(), DM, 1.f / (SO * SU)};
            pg8::gemm_phase<pg8::EpiRes, pg8::StaticOrder, true, true, true>((PG8_LAS unsigned char*)C.lds, g, S, E);
#else
            pg8::Gemm g{XN, (const bfr*)(ws + (layer == 0 ? WS_WTOUT : WS_WTO)), NT, DM, DM}; pg8::StaticOrder S; S.init(NT, DM, C.G, hb);
            pg8::EpiRes E{layer == 0 ? P.in_(0) : (const float*)P.out_(), P.out_(), DM, 1.f};
            pg8::gemm_phase<pg8::EpiRes, pg8::StaticOrder, true, true>((PG8_LAS unsigned char*)C.lds, g, S, E);
#endif
        }
        SEAM(pb + 6);
        if (IN(pb + 7)) p_norm_rows(C, (const float*)P.out_(), XN, ws + WS_XN8);
        SEAM(pb + 7);
        if (IN(pb + 8)) {
            pg8::Gemm g{XN, (const bfr*)(ws + WS_WTQRY) + (size_t)layer * PQ * DM, NT, PQ, DM}; pg8::StaticOrder S; S.init(NT, PQ, C.G, hb);
            pg8::EpiBf16<0> E{(bfr*)(ws + WS_QRY), PQ, nullptr, 0, 0, 1.f};
            pg8::gemm_phase<pg8::EpiBf16<0>, pg8::StaticOrder, true, true>((PG8_LAS unsigned char*)C.lds, g, S, E);
        }
        SEAM(pb + 8);
        if (IN(pb + 9)) { p_sroute(C, P, layer); }
        SEAM(pb + 9); if (IN(pb + 9) && !IN(pb + 10) && IN(pb + 11)) xcd_barrier(bar);
        if (IN(pb + 11)) {
            pg8::Gemm g{(const bfr*)(ws + WS_XN8), (const bfr*)(ws + WS_U + (size_t)layer * PE * DM), NT, PE, DM / 2}; pg8::StaticOrder S; S.init(NT, PE, C.G, hb);
            pg8::EpiGate8 E{(bfr*)(ws + WS_G), ws + WS_A2, PE, 1.f / SU, SA};
            pg8::gemm_phase<pg8::EpiGate8, pg8::StaticOrder, true, true, true>((PG8_LAS unsigned char*)C.lds, g, S, E);
        }
        SEAM(pb + 11);
        if (IN(pb + 12)) {
            pg8::Gemm g{(const bfr*)(ws + WS_A2), (const bfr*)(ws + WS_VT + (size_t)layer * DM * PE), NT, DM, PE / 2}; pg8::StaticOrder S; S.init(NT, DM, C.G, hb);
            pg8::EpiRes E{(const float*)P.out_(), P.out_(), DM, 1.f / (SA * SV)};
            pg8::gemm_phase<pg8::EpiRes, pg8::StaticOrder, true, true, true>((PG8_LAS unsigned char*)C.lds, g, S, E);
        }
        SEAM(pb + 12);
    }
    {
        constexpr int layer = 1;
        const int pb = 1 + layer * NPH_LAYER;
        if (IN(pb + 0)) p_norm_rows(C, layer == 0 ? P.in_(0) : (const float*)P.out_(), XN, ((layer == 0 && F8_PROJ0 != 0) || (layer == 1 && F8_KVQ != 0)) ? ws + WS_XN8 : nullptr);
        SEAM(pb + 0);
        if (IN(pb + 1)) {
            const int N = layer == 0 ? 16384 : 12288;
            if (layer == 0 && F8_PROJ0 == 2) {
                { pg8::Gemm g{XN, (const bfr*)(ws + WS_WTIN), NT, 8192, DM}; pg8::StaticOrder S; S.init(NT, 8192, C.G, hb);
                  pg8::EpiBf16<0> E{BIG, N, nullptr, 0, 0, 1.f};
                  pg8::gemm_phase<pg8::EpiBf16<0>, pg8::StaticOrder, true, true>((PG8_LAS unsigned char*)C.lds, g, S, E); }
                __syncthreads();
                { pg8::Gemm g{(const bfr*)(ws + WS_XN8), (const bfr*)(ws + WS_WTIN + (size_t)8192 * DM * 2), NT, 8192, DM / 2}; pg8::StaticOrder S; S.init(NT, 8192, C.G, hb);
                  pg8::EpiBf16<0> E{BIG + 8192, N, nullptr, 8192, 0, 1.f / SU};
                  pg8::gemm_phase<pg8::EpiBf16<0>, pg8::StaticOrder, true, true, true>((PG8_LAS unsigned char*)C.lds, g, S, E); }
            } else if (layer == 0 && F8_PROJ0 == 4) {
                { pg8::Gemm g{(const bfr*)(ws + WS_XN8), (const bfr*)(ws + WS_WTIN), NT, 4096, DM / 2}; pg8::StaticOrder S; S.init(NT, 4096, C.G, hb);
                  pg8::EpiBf16<0> E{BIG, N, nullptr, 4096, 0, 1.f / SU};
                  pg8::gemm_phase<pg8::EpiBf16<0>, pg8::StaticOrder, true, true, true>((PG8_LAS unsigned char*)C.lds, g, S, E); }
                __syncthreads();
                { pg8::Gemm g{XN, (const bfr*)(ws + WS_WTIN + (size_t)4096 * DM), NT, 12288, DM}; pg8::StaticOrder S; S.init(NT, 12288, C.G, hb);
                  pg8::EpiBf16<0> E{BIG + 4096, N, nullptr, 0, 0, 1.f};
                  pg8::gemm_phase<pg8::EpiBf16<0>, pg8::StaticOrder, true, true>((PG8_LAS unsigned char*)C.lds, g, S, E); }
            } else if (layer == 0 && F8_PROJ0 == 3) {
                { pg8::Gemm g{(const bfr*)(ws + WS_XN8), (const bfr*)(ws + WS_WTIN), NT, 8192, DM / 2}; pg8::StaticOrder S; S.init(NT, 8192, C.G, hb);
                  pg8::EpiBf16<0> E{BIG, N, nullptr, 8192, 0, 1.f / SU};
                  pg8::gemm_phase<pg8::EpiBf16<0>, pg8::StaticOrder, true, true, true>((PG8_LAS unsigned char*)C.lds, g, S, E); }
                __syncthreads();
                { pg8::Gemm g{XN, (const bfr*)(ws + WS_WTIN + (size_t)8192 * DM), NT, 8192, DM}; pg8::StaticOrder S; S.init(NT, 8192, C.G, hb);
                  pg8::EpiBf16<0> E{BIG + 8192, N, nullptr, 0, 0, 1.f};
                  pg8::gemm_phase<pg8::EpiBf16<0>, pg8::StaticOrder, true, true>((PG8_LAS unsigned char*)C.lds, g, S, E); }
            } else if (layer == 0 && F8_PROJ0 == 1) {
                pg8::Gemm g{(const bfr*)(ws + WS_XN8), (const bfr*)(ws + WS_WTIN), NT, N, DM / 2}; pg8::StaticOrder S; S.init(NT, N, C.G, hb);
                pg8::EpiBf16<0> E{BIG, N, nullptr, N, 0, 1.f / SU};
                pg8::gemm_phase<pg8::EpiBf16<0>, pg8::StaticOrder, true, true, true>((PG8_LAS unsigned char*)C.lds, g, S, E);
            } else if (layer == 1 && F8_KVQ == 2) {
                pg8::Gemm g{(const bfr*)(ws + WS_XN8), (const bfr*)(ws + WS_WTKVQ), NT, N, DM / 2}; pg8::StaticOrder S; S.init(NT, N, C.G, hb);
                pg8::EpiBf16<0> E{BIG, N, nullptr, N, 0, 1.f / SU};
                pg8::gemm_phase<pg8::EpiBf16<0>, pg8::StaticOrder, true, true, true>((PG8_LAS unsigned char*)C.lds, g, S, E);
            } else if (layer == 1 && F8_KVQ) {
                { pg8::Gemm g{(const bfr*)(ws + WS_XN8), (const bfr*)(ws + WS_WTKVQ), NT, 8192, DM / 2}; pg8::StaticOrder S; S.init(NT, 8192, C.G, hb);
                  pg8::EpiBf16<0> E{BIG, N, nullptr, 8192, 0, 1.f / SU};
                  pg8::gemm_phase<pg8::EpiBf16<0>, pg8::StaticOrder, true, true, true>((PG8_LAS unsigned char*)C.lds, g, S, E); }
                __syncthreads();
                { pg8::Gemm g{XN, (const bfr*)(ws + WS_WTKVQ + (size_t)2 * DM * DM), NT, DM, DM}; pg8::StaticOrder S; S.init(NT, DM, C.G, hb);
                  pg8::EpiBf16<0> E{BIG + 8192, N, nullptr, 0, 0, 1.f};
                  pg8::gemm_phase<pg8::EpiBf16<0>, pg8::StaticOrder, true, true>((PG8_LAS unsigned char*)C.lds, g, S, E); }
            } else {
                pg8::Gemm g{XN, (const bfr*)(ws + (layer == 0 ? WS_WTIN : WS_WTKVQ)), NT, N, DM}; pg8::StaticOrder S; S.init(NT, N, C.G, hb);
                pg8::EpiBf16<0> E{BIG, N, nullptr, 0, 0, 1.f};
                pg8::gemm_phase<pg8::EpiBf16<0>, pg8::StaticOrder, true, true>((PG8_LAS unsigned char*)C.lds, g, S, E);
            }
        }
        SEAM(pb + 1);
        if (IN(pb + 2)) { if (layer == 0) p_bd(C, XN, (const bfr*)(ws + WS_WTBD), (float*)(ws + WS_BD)); else p_headprep(C, P); }
        SEAM(pb + 2);
        if (IN(pb + 3)) { if (layer == 0) p_gdn_prep(C, P); else p_attn(C, P); }
        SEAM(pb + 3);
        if (IN(pb + 4)) { if (layer == 0) p_gdn_scan(C, P); else p_combine(C, P); }
        SEAM(pb + 4);
        if (IN(pb + 5)) { if (layer == 0) p_gdn_onorm(C, P); }
        if (layer == 0) SEAM(pb + 5);
        if (IN(pb + 6)) {
#if F8_OUT
            pg8::Gemm g{(const bfr*)(ws + WS_XN8), (const bfr*)(ws + (layer == 0 ? WS_WTOUT : WS_WTO)), NT, DM, DM / 2}; pg8::StaticOrder S; S.init(NT, DM, C.G, hb);
            pg8::EpiRes E{layer == 0 ? P.in_(0) : (const float*)P.out_(), P.out_(), DM, 1.f / (SO * SU)};
            pg8::gemm_phase<pg8::EpiRes, pg8::StaticOrder, true, true, true>((PG8_LAS unsigned char*)C.lds, g, S, E);
#else
            pg8::Gemm g{XN, (const bfr*)(ws + (layer == 0 ? WS_WTOUT : WS_WTO)), NT, DM, DM}; pg8::StaticOrder S; S.init(NT, DM, C.G, hb);
            pg8::EpiRes E{layer == 0 ? P.in_(0) : (const float*)P.out_(), P.out_(), DM, 1.f};
            pg8::gemm_phase<pg8::EpiRes, pg8::StaticOrder, true, true>((PG8_LAS unsigned char*)C.lds, g, S, E);
#endif
        }
        SEAM(pb + 6);
        if (IN(pb + 7)) p_norm_rows(C, (const float*)P.out_(), XN, ws + WS_XN8);
        SEAM(pb + 7);
        if (IN(pb + 8)) {
            pg8::Gemm g{XN, (const bfr*)(ws + WS_WTQRY) + (size_t)layer * PQ * DM, NT, PQ, DM}; pg8::StaticOrder S; S.init(NT, PQ, C.G, hb);
            pg8::EpiBf16<0> E{(bfr*)(ws + WS_QRY), PQ, nullptr, 0, 0, 1.f};
            pg8::gemm_phase<pg8::EpiBf16<0>, pg8::StaticOrder, true, true>((PG8_LAS unsigned char*)C.lds, g, S, E);
        }
        SEAM(pb + 8);
        if (IN(pb + 9)) { p_sroute(C, P, layer); }
        SEAM(pb + 9); if (IN(pb + 9) && !IN(pb + 10) && IN(pb + 11)) xcd_barrier(bar);
        if (IN(pb + 11)) {
            pg8::Gemm g{(const bfr*)(ws + WS_XN8), (const bfr*)(ws + WS_U + (size_t)layer * PE * DM), NT, PE, DM / 2}; pg8::StaticOrder S; S.init(NT, PE, C.G, hb);
            pg8::EpiGate8 E{(bfr*)(ws + WS_G), ws + WS_A2, PE, 1.f / SU, SA};
            pg8::gemm_phase<pg8::EpiGate8, pg8::StaticOrder, true, true, true>((PG8_LAS unsigned char*)C.lds, g, S, E);
        }
        SEAM(pb + 11);
        if (IN(pb + 12)) {
            pg8::Gemm g{(const bfr*)(ws + WS_A2), (const bfr*)(ws + WS_VT + (size_t)layer * DM * PE), NT, DM, PE / 2}; pg8::StaticOrder S; S.init(NT, DM, C.G, hb);
            pg8::EpiRes E{(const float*)P.out_(), P.out_(), DM, 1.f / (SA * SV)};
            pg8::gemm_phase<pg8::EpiRes, pg8::StaticOrder, true, true, true>((PG8_LAS unsigned char*)C.lds, g, S, E);
        }
        SEAM(pb + 12);
    }
#undef IN
#undef SEAM
}

extern "C" void kernel_launch(void* const* d_in, const int* in_sizes, int n_in, void* d_out, int out_size, void* d_ws, size_t ws_size, hipStream_t stream) {
    static int grid = 0;
    if (grid == 0) {
        if (n_in != 26 || out_size != NT * DM || ws_size < WS_END) { fprintf(stderr, "kernel_launch: unexpected problem (n_in %d, out %d, ws %zu < %zu)\n", n_in, out_size, ws_size, (size_t)WS_END); grid = -1; return; }
        int dev = 0, cus = 0;
        if (hipGetDevice(&dev) != hipSuccess || hipDeviceGetAttribute(&cus, hipDeviceAttributeMultiprocessorCount, dev) != hipSuccess || cus <= 0) { grid = -1; return; }
        if (hipFuncSetAttribute((const void*)trunk_fwd, hipFuncAttributeMaxDynamicSharedMemorySize, LDS_BYTES) != hipSuccess) { fprintf(stderr, "kernel_launch: hipFuncSetAttribute failed\n"); grid = -1; return; }
        int per_cu = 0;
        if (hipOccupancyMaxActiveBlocksPerMultiprocessor(&per_cu, (const void*)trunk_fwd, 512, LDS_BYTES) != hipSuccess || per_cu < 1) { fprintf(stderr, "kernel_launch: occupancy query says %d blocks per CU\n", per_cu); }
        (void)hipGetLastError();
        grid = cus;
    }
    if (grid < 0) return;
    (void)in_sizes;
    if (hipMemsetAsync((char*)d_ws + WS_CTL, 0, CTL_ZERO_BYTES, stream) != hipSuccess) return;
    KArgs p{};
    for (int i = 0; i < 26; ++i) p.in[i] = (const float*)d_in[i];
    p.out = (float*)d_out; p.ws = (unsigned char*)d_ws;
#if MK_PER_PHASE
    for (int ph = 0; ph < NPHASE; ++ph) {
        if (ph == 1 + 5 + NPH_LAYER || ph == 1 + 10 || ph == 1 + 10 + NPH_LAYER) continue;
        p.ph_lo = ph; p.ph_hi = ph + 1; p.li = 0; p.pad = 0;
        hipLaunchKernelGGL(trunk_fwd, dim3(grid), dim3(512), LDS_BYTES, stream, p);
    }
#else
    p.ph_lo = 0; p.ph_hi = NPHASE; p.li = 0; p.pad = 0;
    hipLaunchKernelGGL(trunk_fwd, dim3(grid), dim3(512), LDS_BYTES, stream, p);
#endif
}
```

```cpp
#include <hip/hip_runtime.h>
#include <hip/hip_bf16.h>
#include <cstdio>
#include <cstdint>

#define LAS __attribute__((address_space(3)))
#define GAS __attribute__((address_space(1)))
typedef unsigned short bfr;
typedef short s8v __attribute__((ext_vector_type(8)));
typedef float f4v __attribute__((ext_vector_type(4)));
typedef unsigned u4v __attribute__((ext_vector_type(4)));
typedef unsigned u2v __attribute__((ext_vector_type(2)));
typedef int i4v __attribute__((ext_vector_type(4)));

#ifndef F8_PROJ0
#define F8_PROJ0 3
#endif
#ifndef F8_KVQ
#define F8_KVQ 2
#endif
#ifndef F8_OUT0
#define F8_OUT0 1
#endif
#ifndef F8_OUT1
#define F8_OUT1 1
#endif
#ifndef F8_OUT
#define F8_OUT (F8_OUT0 || F8_OUT1)
#endif
#ifndef STAGGER_G1
#define STAGGER_G1 0
#endif
constexpr int NB = 2, SEQ = 4096, DM = 4096, NT = NB * SEQ;
constexpr int GH = 32, GD = 128, GIN = 16448, CH = 64, NCH = SEQ / CH;
constexpr int AH = 16, AD = 128, AV = 256;
constexpr int PH = 8, PK = 128, PE = 16384, PQ = 2048, PTOP = 16;
constexpr float EPS = 1e-6f;
constexpr float LAMBDA_INIT = 0.35550906759f;
constexpr float SU = 64.f, SA = 64.f, SV = 4.f, SO = 16.f;

constexpr size_t MiB = 1u << 20;
constexpr size_t WS_CTL   = 0;
constexpr size_t WS_WTIN  = 1 * MiB;
constexpr size_t WS_WTBD  = WS_WTIN + 128 * MiB;
constexpr size_t WS_WTOUT = WS_WTBD + 1 * MiB;
constexpr size_t WS_WTKVQ = WS_WTOUT + 32 * MiB;
constexpr size_t WS_WTO   = WS_WTKVQ + 96 * MiB;
constexpr size_t WS_WTQRY = WS_WTO + 32 * MiB;
constexpr size_t WS_WTKEY = WS_WTQRY + 32 * MiB;
constexpr size_t WS_U     = WS_WTKEY + 16 * MiB;
constexpr size_t WS_VT    = WS_U + 128 * MiB;
constexpr size_t WS_A2    = WS_VT + 128 * MiB;
constexpr size_t WS_XN8   = WS_A2 + 128 * MiB;
constexpr size_t WS_XN    = WS_XN8 + 32 * MiB;
constexpr size_t WS_BIG   = WS_XN + 64 * MiB;
constexpr size_t WS_R     = WS_BIG + 256 * MiB;
constexpr size_t WS_QRY   = WS_R + 352 * MiB;
constexpr size_t WS_SC    = WS_QRY + 32 * MiB;
constexpr size_t WS_BD    = WS_SC + 64 * MiB;
constexpr size_t WS_EG    = WS_BD + 2 * MiB;
constexpr size_t WS_G     = WS_EG + 1 * MiB;
constexpr size_t WS_END   = WS_G + 256 * MiB;
constexpr size_t R_W = 0, R_U = 64 * MiB, R_QG = 128 * MiB, R_KD = 192 * MiB, R_QK = 256 * MiB, R_O = 288 * MiB;
constexpr size_t R_QH = 0, R_KH = 64 * MiB, R_VH = 128 * MiB, R_OH = 192 * MiB;
static_assert(WS_END <= (size_t)1790 * MiB, "workspace map");

constexpr int CW_BAR = 4096;
constexpr size_t CTL_ZERO_BYTES = 1 * MiB;

constexpr int LDS_BYTES = 147456;
constexpr int MISC_OFF = 146944;

typedef float f2v_ __attribute__((ext_vector_type(2)));
typedef __bf16 b2v_ __attribute__((ext_vector_type(2)));
__device__ __forceinline__ unsigned cvtpk(float lo, float hi) { const b2v_ r = __builtin_convertvector((f2v_){lo, hi}, b2v_); return __builtin_bit_cast(unsigned, r); }
__device__ __forceinline__ unsigned cvt4_fp8(float a, float b, float c, float d) { int w = 0; w = __builtin_amdgcn_cvt_pk_fp8_f32(a, b, w, false); w = __builtin_amdgcn_cvt_pk_fp8_f32(c, d, w, true); return (unsigned)w; }
__device__ __forceinline__ float bflo(unsigned w) { return __uint_as_float(w << 16); }
__device__ __forceinline__ float bfhi(unsigned w) { return __uint_as_float(w & 0xffff0000u); }
__device__ __forceinline__ float bf1(bfr b) { return __uint_as_float(((unsigned)b) << 16); }
__device__ __forceinline__ bfr f2bf1(float f) { return (bfr)(cvtpk(f, 0.f) & 0xffffu); }
__device__ __forceinline__ float wave_sum(float v) {
#pragma unroll
    for (int o = 1; o < 64; o <<= 1) v += __shfl_xor(v, o);
    return v;
}
__device__ __forceinline__ f4v zero_acc() { f4v z = {0.f, 0.f, 0.f, 0.f}; asm volatile("" : "+v"(z)); return z; }
#define MFMA_SETTLE(acc) asm volatile("s_nop 7\n\ts_nop 7" : "+v"(acc))
#define LDS_WAIT() asm volatile("s_waitcnt lgkmcnt(0)" ::: "memory")
#define VM_WAIT() asm volatile("s_waitcnt vmcnt(0)" ::: "memory")
#define XB_TMO      128
#define XB_XCNT(j)  (256  + 64 * (j))
#define XB_XSUB(j)  (1280 + 64 * (j))
#define XB_XGEN(j)  (2304 + 64 * (j))
#define XB_TOP      3328
#define XB_TOPGEN   3392
#define XCD_BAR_WORDS 3456
#define XB_SPIN_CAP (1u << 18)

__device__ __forceinline__ unsigned xb_ld(unsigned* p)              { return __hip_atomic_load(p, __ATOMIC_RELAXED, __HIP_MEMORY_SCOPE_AGENT); }
__device__ __forceinline__ unsigned xb_add(unsigned* p, unsigned v) { return __hip_atomic_fetch_add(p, v, __ATOMIC_RELAXED, __HIP_MEMORY_SCOPE_AGENT); }
__device__ __forceinline__ unsigned xb_xcc_id() { return (unsigned)__builtin_amdgcn_s_getreg((3 << 11) | 20) & 0xFu; }
#define XB_SPIN(cond, bar) do { unsigned _sp = 0; while (cond) { __builtin_amdgcn_s_sleep(1); \
    if ((++_sp & 255u) == 0u) { if (xb_ld(&(bar)[XB_TMO])) break; if (_sp > XB_SPIN_CAP) { atomicAdd(&(bar)[XB_TMO], 1u); break; } } } } while (0)

struct XcdBarrier {
    unsigned* bar; unsigned x;
    volatile LAS unsigned* st;
};

__device__ __forceinline__ XcdBarrier xcd_barrier_post(unsigned* bar, volatile LAS unsigned* st) {
    XcdBarrier b; b.bar = bar; b.x = xb_xcc_id(); b.st = st;
    if (threadIdx.x == 0) (void)xb_add(&bar[XB_XCNT(b.x)], 1u);
    return b;
}
__device__ __forceinline__ void xcd_barrier_complete(unsigned* bar, unsigned x, unsigned& nloc, unsigned& nx) {
    const unsigned G = gridDim.x * gridDim.y * gridDim.z;
    unsigned sum, cnt, mine, sp = 0u;
    for (;;) {
        sum = 0u; cnt = 0u; mine = 0u;
#pragma unroll
        for (unsigned j = 0; j < 16; ++j) { const unsigned c = xb_ld(&bar[XB_XCNT(j)]); sum += c; cnt += (c > 0u) ? 1u : 0u; mine = (j == x) ? c : mine; }
        if (sum == G) break;
        __builtin_amdgcn_s_sleep(1);
        if ((++sp & 255u) == 0u) { if (xb_ld(&bar[XB_TMO])) break; if (sp > XB_SPIN_CAP) { atomicAdd(&bar[XB_TMO], 1u); break; } }
    }
    nloc = mine > 0u ? mine : 1u; nx = cnt > 0u ? cnt : 1u;
}

__device__ __forceinline__ void xcd_barrier(const XcdBarrier& b) {
    asm volatile("s_waitcnt vmcnt(0)" ::: "memory");
    __syncthreads();
    if (threadIdx.x == 0) {
        unsigned* bar = b.bar;
        __builtin_amdgcn_s_waitcnt(0);
        unsigned nloc = b.st[0], nx = b.st[1];
        if (nloc == 0u) { xcd_barrier_complete(bar, b.x, nloc, nx); b.st[0] = nloc; b.st[1] = nx; }
        const unsigned old = xb_add(&bar[XB_XSUB(b.x)], 1u);
        const unsigned gen = old / nloc;
        if (old + 1u == (gen + 1u) * nloc) {
            __builtin_amdgcn_fence(__ATOMIC_RELEASE, "agent");
            asm volatile("s_waitcnt vmcnt(0)" ::: "memory");
            const unsigned og = xb_add(&bar[XB_TOP], 1u);
            const unsigned tg = og / nx;
            if (og + 1u == (tg + 1u) * nx) xb_add(&bar[XB_TOPGEN], 1u);
            else XB_SPIN(xb_ld(&bar[XB_TOPGEN]) == tg, bar);
            __builtin_amdgcn_fence(__ATOMIC_ACQUIRE, "agent");
            xb_add(&bar[XB_XGEN(b.x)], 1u);
            asm volatile("s_waitcnt vmcnt(0)" ::: "memory");
        } else {
            XB_SPIN(xb_ld(&bar[XB_XGEN(b.x)]) == gen, bar);
            __builtin_amdgcn_fence(__ATOMIC_ACQUIRE, "agent");
            asm volatile("s_waitcnt vmcnt(0)" ::: "memory");
        }
    }
    __syncthreads();
}
namespace pg8 {
#define PG8_LAS __attribute__((address_space(3)))
typedef unsigned short bf16_t;
typedef short bf16x8 __attribute__((ext_vector_type(8)));
typedef float f32x4 __attribute__((ext_vector_type(4)));
typedef unsigned u32x4 __attribute__((ext_vector_type(4)));
typedef int i32x4 __attribute__((ext_vector_type(4)));
typedef int i32x8 __attribute__((ext_vector_type(8)));
typedef unsigned u32x2 __attribute__((ext_vector_type(2)));
constexpr int BM = 256, BK = 64, HALF = 128, HTB = HALF * BK * 2  , STAGE_BYTES = 8 * HTB, NXCD = 8, WGM = 8;

__host__ __device__ __forceinline__ int lds_byte(int r, int c) { const int st = (r >> 4) * 2 + (c >> 5), rr = r & 15, cc = c & 31, ob = rr * 64 + cc * 2; return st * 1024 + (ob ^ (((ob >> 9) & 1) << 5)); }
__host__ __device__ __forceinline__ void stage_rc(int b, int& R, int& C) { const int st = b / 1024, sb = b % 1024, swz = sb ^ (((sb >> 9) & 1) << 5); R = (st >> 1) * 16 + swz / 64; C = (st & 1) * 32 + (swz % 64) / 2; }
__host__ __device__ __forceinline__ int perm32(int rho) { const int n = rho >> 4, i = rho & 15; return 8 * (i >> 2) + 4 * n + (i & 3); }

struct Unit { int pm, pn; };
struct Gemm { const bf16_t* A; const bf16_t* Bt; int M, N, K; };

struct StaticOrder {
    int nM, nN, nwg, G, c;
    __host__ __device__ void init(int M, int N, int G_, int c_) { nM = M / BM; nN = N / BM; nwg = nM * nN; G = G_; c = c_; }
    __host__ __device__ bool next(int i, Unit& u) const {
        const long L = (long)i * G + c; if (L >= nwg) return false;
        int wgid = (int)L; { const int q = nwg / NXCD, r = nwg % NXCD, xcd = wgid % NXCD, off = wgid / NXCD; wgid = (xcd < r ? xcd * (q + 1) : r * (q + 1) + (xcd - r) * q) + off; }
        const int nig = WGM * nN, gid = wgid / nig, fm = gid * WGM, gsz = (nM - fm) < WGM ? (nM - fm) : WGM;
        u.pm = fm + ((wgid % nig) % gsz); u.pn = (wgid % nig) / gsz; return true;
    }
    __device__ __forceinline__ void a_ready(const Unit&) const {}
    __device__ __forceinline__ void done(const Unit&) const {}
};

__device__ __forceinline__ unsigned cvt_pk_bf16(float lo, float hi) { unsigned r; asm volatile("v_cvt_pk_bf16_f32 %0, %1, %2" : "=v"(r) : "v"(lo), "v"(hi)); return r; }
typedef float f32x2 __attribute__((ext_vector_type(2)));
__device__ __forceinline__ f32x2 gelu_pk(f32x2 v) {
    const f32x2 av = __builtin_elementwise_abs(v), d = av * 0.2316418882f + 1.0f;
    f32x2 t; t.x = __builtin_amdgcn_rcpf(d.x); t.y = __builtin_amdgcn_rcpf(d.y);
    f32x2 q = t * 0.5307027145f + (-0.7265760135f); q = q * t + 0.7107068705f; q = q * t + (-0.142248368f); q = q * t + 0.127414796f; q = q * t;
    const f32x2 s = (v * v) * (-0.72134752044f);
    f32x2 e; e.x = __builtin_amdgcn_exp2f(s.x); e.y = __builtin_amdgcn_exp2f(s.y);
    const f32x2 m = v * (q * e), r = v - m;
    f32x2 o; o.x = v.x < 0.f ? m.x : r.x; o.y = v.y < 0.f ? m.y : r.y; return o;
}

template <int ACT  > struct EpiBf16 {
    static constexpr bool PERM = true, AFTER_DRAIN = false; static_assert(ACT == 0 || ACT == 1, "EpiBf16: ACT is 0 (none) or 1 (gelu_pk)");
    bf16_t* O; int ldc; const float* bias; int split_cols; size_t split_stride; float scale0;
    __device__ __forceinline__ void operator()(const f32x4 (&acc)[2][2][4][2], const Unit& u, int wr, int wc, int fr, int fq) const {
        const int row0 = u.pm * BM + wr * 64 + fr; int colt = u.pn * BM; bf16_t* base = O;
        float sc = 1.f; if (split_cols) { const int t = colt / split_cols; base += (size_t)t * split_stride; colt -= t * split_cols; if (t == 0) sc = scale0; }
        const int col0 = colt + wc * 32 + 8 * fq, bcol0 = u.pn * BM + wc * 32 + 8 * fq;
        f32x4 bv[2][2];
#pragma unroll
        for (int bj = 0; bj < 2; ++bj)
#pragma unroll
            for (int n = 0; n < 2; ++n) bv[bj][n] = bias ? *(const f32x4*)(bias + bcol0 + bj * HALF + 4 * n) : (f32x4){0.f, 0.f, 0.f, 0.f};
#pragma unroll
        for (int ai = 0; ai < 2; ++ai)
#pragma unroll
            for (int m = 0; m < 4; ++m) { bf16_t* rowp = base + (size_t)(row0 + ai * HALF + m * 16) * ldc + col0;
#pragma unroll
                for (int bj = 0; bj < 2; ++bj) { f32x4 v0 = acc[ai][bj][m][0] + bv[bj][0], v1 = acc[ai][bj][m][1] + bv[bj][1];
                    if (ACT == 1) { f32x2 a = gelu_pk((f32x2){v0[0], v0[1]}), b = gelu_pk((f32x2){v0[2], v0[3]}), c = gelu_pk((f32x2){v1[0], v1[1]}), d = gelu_pk((f32x2){v1[2], v1[3]});
                        v0 = (f32x4){a.x, a.y, b.x, b.y}; v1 = (f32x4){c.x, c.y, d.x, d.y}; }
                    v0 = v0 * sc; v1 = v1 * sc; u32x4 w; w.x = cvt_pk_bf16(v0[0], v0[1]); w.y = cvt_pk_bf16(v0[2], v0[3]); w.z = cvt_pk_bf16(v1[0], v1[1]); w.w = cvt_pk_bf16(v1[2], v1[3]);
                    *(u32x4*)(rowp + bj * HALF) = w; } }
    }
};
struct EpiRes {
    static constexpr bool PERM = false, AFTER_DRAIN = false;
    const float* base; float* out; int ldc; float scale;
    __device__ __forceinline__ void operator()(const f32x4 (&acc)[2][2][4][2], const Unit& u, int wr, int wc, int fr, int fq) const {
        const int row0 = u.pm * BM + wr * 64 + fr, col0 = u.pn * BM + wc * 32 + 4 * fq;
#pragma unroll
        for (int ai = 0; ai < 2; ++ai)
#pragma unroll
            for (int m = 0; m < 4; ++m) { const size_t off = (size_t)(row0 + ai * HALF + m * 16) * ldc + col0;
                f32x4 bs[2][2];
#pragma unroll
                for (int bj = 0; bj < 2; ++bj)
#pragma unroll
                    for (int n = 0; n < 2; ++n) bs[bj][n] = *(const f32x4*)(base + off + bj * HALF + n * 16);
#pragma unroll
                for (int bj = 0; bj < 2; ++bj)
#pragma unroll
                    for (int n = 0; n < 2; ++n) *(f32x4*)(out + off + bj * HALF + n * 16) = bs[bj][n] + acc[ai][bj][m][n] * scale;
                asm volatile("" ::: "memory"); }
    }
};
struct EpiStF32 {
    static constexpr bool PERM = false, AFTER_DRAIN = false;
    float* C; int ldc;
    __device__ __forceinline__ void operator()(const f32x4 (&acc)[2][2][4][2], const Unit& u, int wr, int wc, int fr, int fq) const {
        const int row0 = u.pm * BM + wr * 64 + fr, col0 = u.pn * BM + wc * 32 + 4 * fq;
#pragma unroll
        for (int ai = 0; ai < 2; ++ai)
#pragma unroll
            for (int m = 0; m < 4; ++m) { float* rowp = C + (size_t)(row0 + ai * HALF + m * 16) * ldc + col0;
#pragma unroll
                for (int bj = 0; bj < 2; ++bj)
#pragma unroll
                    for (int n = 0; n < 2; ++n) *(f32x4*)(rowp + bj * HALF + n * 16) = acc[ai][bj][m][n]; }
    }
};
struct EpiGate {
    static constexpr bool PERM = true, AFTER_DRAIN = false;
    bf16_t* G; int ldc;
    __device__ __forceinline__ void operator()(const f32x4 (&acc)[2][2][4][2], const Unit& u, int wr, int wc, int fr, int fq) const {
        const int row0 = u.pm * BM + wr * 64 + fr, col0 = u.pn * BM + wc * 32 + 8 * fq;
#pragma unroll
        for (int ai = 0; ai < 2; ++ai)
#pragma unroll
            for (int m = 0; m < 4; ++m) { bf16_t* rowp = G + (size_t)(row0 + ai * HALF + m * 16) * ldc + col0;
                u32x4 g[2];
#pragma unroll
                for (int bj = 0; bj < 2; ++bj) g[bj] = *(const u32x4*)(rowp + bj * HALF);
#pragma unroll
                for (int bj = 0; bj < 2; ++bj) {
                    if ((g[bj].x | g[bj].y | g[bj].z | g[bj].w) != 0u) {
                        const f32x4 v0 = acc[ai][bj][m][0], v1 = acc[ai][bj][m][1];
                        const f32x2 a = gelu_pk((f32x2){v0[0], v0[1]}), b = gelu_pk((f32x2){v0[2], v0[3]}), c = gelu_pk((f32x2){v1[0], v1[1]}), d = gelu_pk((f32x2){v1[2], v1[3]});
                        u32x4 w;
                        w.x = cvt_pk_bf16(a.x * __uint_as_float(g[bj].x << 16), a.y * __uint_as_float(g[bj].x & 0xffff0000u));
                        w.y = cvt_pk_bf16(b.x * __uint_as_float(g[bj].y << 16), b.y * __uint_as_float(g[bj].y & 0xffff0000u));
                        w.z = cvt_pk_bf16(c.x * __uint_as_float(g[bj].z << 16), c.y * __uint_as_float(g[bj].z & 0xffff0000u));
                        w.w = cvt_pk_bf16(d.x * __uint_as_float(g[bj].w << 16), d.y * __uint_as_float(g[bj].w & 0xffff0000u));
                        *(u32x4*)(rowp + bj * HALF) = w;
                    }
                } }
    }
};
template <int MODE = 0>
struct EpiGate8 {
    static constexpr bool PERM = true, AFTER_DRAIN = false;
    bf16_t* G; unsigned char* A2; int ldc; float hscale, oscale;
    __device__ __forceinline__ void operator()(const f32x4 (&acc)[2][2][4][2], const Unit& u, int wr, int wc, int fr, int fq) const {
        const int row0 = u.pm * BM + wr * 64 + fr, col0 = u.pn * BM + wc * 32 + 8 * fq;
#pragma unroll
        for (int ai = 0; ai < 2; ++ai)
#pragma unroll
            for (int m = 0; m < 4; ++m) { const size_t ro = (size_t)(row0 + ai * HALF + m * 16) * ldc + col0;
                u32x4 g[2];
#pragma unroll
                for (int bj = 0; bj < 2; ++bj) g[bj] = (MODE == 2 || MODE == 3) ? (u32x4){0x3f803f80u, 0x3f803f80u, 0x3f803f80u, 0x3f803f80u} : *(const u32x4*)(G + ro + bj * HALF);
#pragma unroll
                for (int bj = 0; bj < 2; ++bj) {
                    u32x2 w = {0u, 0u};
                    if ((g[bj].x | g[bj].y | g[bj].z | g[bj].w) != 0u) {
                        const f32x4 v0 = acc[ai][bj][m][0] * hscale, v1 = acc[ai][bj][m][1] * hscale;
                        const f32x2 a = MODE == 3 ? (f32x2){v0[0], v0[1]} : gelu_pk((f32x2){v0[0], v0[1]}), b = MODE == 3 ? (f32x2){v0[2], v0[3]} : gelu_pk((f32x2){v0[2], v0[3]}), c = MODE == 3 ? (f32x2){v1[0], v1[1]} : gelu_pk((f32x2){v1[0], v1[1]}), d = MODE == 3 ? (f32x2){v1[2], v1[3]} : gelu_pk((f32x2){v1[2], v1[3]});
                        float y[8] = {a.x * __uint_as_float(g[bj].x << 16), a.y * __uint_as_float(g[bj].x & 0xffff0000u), b.x * __uint_as_float(g[bj].y << 16), b.y * __uint_as_float(g[bj].y & 0xffff0000u),
                                      c.x * __uint_as_float(g[bj].z << 16), c.y * __uint_as_float(g[bj].z & 0xffff0000u), d.x * __uint_as_float(g[bj].w << 16), d.y * __uint_as_float(g[bj].w & 0xffff0000u)};
#pragma unroll
                        for (int k = 0; k < 8; ++k) y[k] = fminf(fmaxf(y[k] * oscale, -440.f), 440.f);
                        int lo = 0, hi = 0;
                        lo = __builtin_amdgcn_cvt_pk_fp8_f32(y[0], y[1], lo, false); lo = __builtin_amdgcn_cvt_pk_fp8_f32(y[2], y[3], lo, true);
                        hi = __builtin_amdgcn_cvt_pk_fp8_f32(y[4], y[5], hi, false); hi = __builtin_amdgcn_cvt_pk_fp8_f32(y[6], y[7], hi, true);
                        w.x = (unsigned)lo; w.y = (unsigned)hi;
                        if (MODE == 0) *(u32x4*)(G + ro + bj * HALF) = (u32x4){0u, 0u, 0u, 0u};
                    }
                    *(u32x2*)(A2 + ro + bj * HALF) = w;
                } }
    }
};

struct EpiGate8C {
    static constexpr bool PERM = true, AFTER_DRAIN = false;
    static constexpr int REC_OFF = STAGE_BYTES, REC_WAVE = 1984, REC_DW = 10, CAP = REC_WAVE / (4 * REC_DW);
    bf16_t* G; unsigned char* A2; int ldc; float hscale, oscale;
    __device__ __forceinline__ void one(unsigned h0, unsigned h1, unsigned h2, unsigned h3, unsigned g0, unsigned g1, unsigned g2, unsigned g3, unsigned off) const {
        const f32x2 a = gelu_pk((f32x2){__uint_as_float(h0 << 16), __uint_as_float(h0 & 0xffff0000u)}), b = gelu_pk((f32x2){__uint_as_float(h1 << 16), __uint_as_float(h1 & 0xffff0000u)}),
                    c = gelu_pk((f32x2){__uint_as_float(h2 << 16), __uint_as_float(h2 & 0xffff0000u)}), d = gelu_pk((f32x2){__uint_as_float(h3 << 16), __uint_as_float(h3 & 0xffff0000u)});
        float y[8] = {a.x * __uint_as_float(g0 << 16), a.y * __uint_as_float(g0 & 0xffff0000u), b.x * __uint_as_float(g1 << 16), b.y * __uint_as_float(g1 & 0xffff0000u),
                      c.x * __uint_as_float(g2 << 16), c.y * __uint_as_float(g2 & 0xffff0000u), d.x * __uint_as_float(g3 << 16), d.y * __uint_as_float(g3 & 0xffff0000u)};
#pragma unroll
        for (int k = 0; k < 8; ++k) y[k] = fminf(fmaxf(y[k] * oscale, -440.f), 440.f);
        int lo = 0, hi = 0;
        lo = __builtin_amdgcn_cvt_pk_fp8_f32(y[0], y[1], lo, false); lo = __builtin_amdgcn_cvt_pk_fp8_f32(y[2], y[3], lo, true);
        hi = __builtin_amdgcn_cvt_pk_fp8_f32(y[4], y[5], hi, false); hi = __builtin_amdgcn_cvt_pk_fp8_f32(y[6], y[7], hi, true);
        *(u32x2*)(A2 + off) = (u32x2){(unsigned)lo, (unsigned)hi};
        *(u32x4*)(G + off) = (u32x4){0u, 0u, 0u, 0u};
    }
    __device__ __forceinline__ void flush(PG8_LAS unsigned* rec, int cnt, int lane) const {
        asm volatile("s_waitcnt lgkmcnt(0)" ::: "memory");
        if (lane < cnt) { const PG8_LAS unsigned* r = rec + lane * REC_DW;
            const u32x2 h01 = *(const PG8_LAS u32x2*)r, h23 = *(const PG8_LAS u32x2*)(r + 2), g01 = *(const PG8_LAS u32x2*)(r + 4), g23 = *(const PG8_LAS u32x2*)(r + 6); const unsigned off = r[8];
            one(h01.x, h01.y, h23.x, h23.y, g01.x, g01.y, g23.x, g23.y, off); }
        asm volatile("s_waitcnt lgkmcnt(0)" ::: "memory");
    }
    __device__ __forceinline__ void operator()(const f32x4 (&acc)[2][2][4][2], const Unit& u, int wr, int wc, int fr, int fq) const {
        extern __shared__ __attribute__((aligned(16))) char pg8_lds_sym[];
        const int lane = fq * 16 + fr;
        PG8_LAS unsigned* rec = (PG8_LAS unsigned*)((PG8_LAS char*)pg8_lds_sym + REC_OFF + (wr * 4 + wc) * REC_WAVE);
        const int row0 = u.pm * BM + wr * 64 + fr, col0 = u.pn * BM + wc * 32 + 8 * fq;
        int cnt = 0;
#pragma unroll
        for (int ai = 0; ai < 2; ++ai) {
            u32x4 gall[4][2];
#pragma unroll
            for (int m = 0; m < 4; ++m) { const unsigned ro = (unsigned)(row0 + ai * HALF + m * 16) * (unsigned)ldc + (unsigned)col0;
#pragma unroll
                for (int bj = 0; bj < 2; ++bj) gall[m][bj] = *(const u32x4*)(G + ro + bj * HALF); }
            asm volatile("" ::: "memory");
#pragma unroll
            for (int m = 0; m < 4; ++m) { const unsigned ro = (unsigned)(row0 + ai * HALF + m * 16) * (unsigned)ldc + (unsigned)col0;
                const u32x4 g[2] = {gall[m][0], gall[m][1]};
#pragma unroll
                for (int bj = 0; bj < 2; ++bj) {
                    const bool nz = (g[bj].x | g[bj].y | g[bj].z | g[bj].w) != 0u;
                    const unsigned long long bal = __builtin_amdgcn_ballot_w64(nz);
                    const int np = __builtin_popcountll(bal);
                    const f32x4 v0 = acc[ai][bj][m][0] * hscale, v1 = acc[ai][bj][m][1] * hscale;
                    const unsigned h0 = cvt_pk_bf16(v0[0], v0[1]), h1 = cvt_pk_bf16(v0[2], v0[3]), h2 = cvt_pk_bf16(v1[0], v1[1]), h3 = cvt_pk_bf16(v1[2], v1[3]);
                    if (np > CAP) {
                        if (nz) one(h0, h1, h2, h3, g[bj].x, g[bj].y, g[bj].z, g[bj].w, ro + bj * HALF); else *(u32x2*)(A2 + ro + bj * HALF) = (u32x2){0u, 0u};
                        continue; }
                    if (cnt + np > CAP) { flush(rec, cnt, lane); cnt = 0; }
                    if (nz) { const int slot = cnt + (int)__builtin_amdgcn_mbcnt_hi((unsigned)(bal >> 32), __builtin_amdgcn_mbcnt_lo((unsigned)bal, 0u));
                        PG8_LAS unsigned* r = rec + slot * REC_DW;
                        *(PG8_LAS u32x2*)r = (u32x2){h0, h1}; *(PG8_LAS u32x2*)(r + 2) = (u32x2){h2, h3}; *(PG8_LAS u32x2*)(r + 4) = (u32x2){g[bj].x, g[bj].y}; *(PG8_LAS u32x2*)(r + 6) = (u32x2){g[bj].z, g[bj].w}; r[8] = ro + bj * HALF; }
                    else *(u32x2*)(A2 + ro + bj * HALF) = (u32x2){0u, 0u};
                    cnt += np;
                } }
        }
        flush(rec, cnt, lane);
    }
};
template <class Epi, class Sched, bool ALIGN_EPI = false, bool SP2 = false, bool F8 = false>
__device__ __forceinline__ void gemm_phase(PG8_LAS unsigned char* lds, const Gemm g, const Sched& S, const Epi& E) {
    const int tid = threadIdx.x, wid = __builtin_amdgcn_readfirstlane(tid >> 6), lane = tid & 63, wr = wid >> 2, wc = wid & 3, fr = lane & 15, fq = lane >> 4;
    const int K = g.K, nt = K / BK;
    unsigned voffA[2], voffB[2];
#pragma unroll
    for (int i = 0; i < 2; ++i) { int R, C; stage_rc(tid * 16 + i * 8192, R, C); const int Rb = Epi::PERM ? ((R & ~31) + perm32(R & 31)) : R;
        voffA[i] = (unsigned)(R * K + C) * 2u; voffB[i] = (unsigned)(Rb * K + C) * 2u; }
    const size_t kstep = (size_t)(BK * 2);
    const size_t hstep = (size_t)HALF * K * 2;
    const size_t tstep = 2 * hstep;
    const unsigned ldsw = (unsigned)wid * 1024u;
    const int aoff = lds_byte(wr * 64 + fr, fq * 8), boff = lds_byte(wc * 32 + fr, fq * 8);
#define PG8_SA(b, h) (((b) * 2 + (h)) * HTB)
#define PG8_SB(b, h) ((4 + (b) * 2 + (h)) * HTB)
#define PG8_STAGE(bufoff, gbase, voff) do { _Pragma("unroll") for (int _i = 0; _i < 2; ++_i) \
        __builtin_amdgcn_global_load_lds((const unsigned*)((const char*)(gbase) + (voff)[_i]), (PG8_LAS unsigned*)(lds + (bufoff) + ldsw + _i * 8192), 16, 0, 0); } while (0)
#define PG8_LDA(dst, b, h) do { if constexpr (F8) { _Pragma("unroll") for (int m = 0; m < 4; ++m) { const i32x4 lo_ = *(const PG8_LAS i32x4*)(lds + PG8_SA(b, h) + aoff + m * 2048), hi_ = *(const PG8_LAS i32x4*)(lds + PG8_SA(b, h) + aoff + m * 2048 + 1024); \
        dst##_8[m] = __builtin_shufflevector(lo_, hi_, 0, 1, 2, 3, 4, 5, 6, 7); } } else { _Pragma("unroll") for (int m = 0; m < 4; ++m) _Pragma("unroll") for (int k = 0; k < 2; ++k) dst[m][k] = *(const PG8_LAS bf16x8*)(lds + PG8_SA(b, h) + aoff + m * 2048 + k * 1024); } } while (0)
#define PG8_LDB(dst, b, h) do { if constexpr (F8) { _Pragma("unroll") for (int n = 0; n < 2; ++n) { const i32x4 lo_ = *(const PG8_LAS i32x4*)(lds + PG8_SB(b, h) + boff + n * 2048), hi_ = *(const PG8_LAS i32x4*)(lds + PG8_SB(b, h) + boff + n * 2048 + 1024); \
        dst##_8[n] = __builtin_shufflevector(lo_, hi_, 0, 1, 2, 3, 4, 5, 6, 7); } } else { _Pragma("unroll") for (int n = 0; n < 2; ++n) _Pragma("unroll") for (int k = 0; k < 2; ++k) dst[n][k] = *(const PG8_LAS bf16x8*)(lds + PG8_SB(b, h) + boff + n * 2048 + k * 1024); } } while (0)
#define PG8_MMA(ai, bj, At, Bt) do { __builtin_amdgcn_s_setprio(1); if constexpr (F8) { _Pragma("unroll") for (int m = 0; m < 4; ++m) _Pragma("unroll") for (int n = 0; n < 2; ++n) \
        asm volatile("v_mfma_f32_16x16x128_f8f6f4 %0, %1, %2, %0" : "+v"(acc[ai][bj][m][n]) : "v"(Bt##_8[n]), "v"(At##_8[m])); } \
    else { _Pragma("unroll") for (int m = 0; m < 4; ++m) _Pragma("unroll") for (int n = 0; n < 2; ++n) _Pragma("unroll") for (int k = 0; k < 2; ++k) \
        acc[ai][bj][m][n] = __builtin_amdgcn_mfma_f32_16x16x32_bf16(Bt[n][k], At[m][k], acc[ai][bj][m][n], 0, 0, 0); } __builtin_amdgcn_s_setprio(0); } while (0)
#define PG8_WAIT_V(n) asm volatile("s_waitcnt vmcnt(" #n ")" ::: "memory")
#define PG8_WAIT_L(n) asm volatile("s_waitcnt lgkmcnt(" #n ")" ::: "memory")
#define PG8_BAR __builtin_amdgcn_s_barrier()
#define PG8_SCHED __builtin_amdgcn_sched_barrier(0)
    Unit cur, nxt; int ui = 0;
    if (!S.next(0, cur)) return;
    f32x4 acc[2][2][4][2];
#pragma unroll
    for (int a = 0; a < 2; ++a)
#pragma unroll
        for (int b = 0; b < 2; ++b)
#pragma unroll
            for (int m = 0; m < 4; ++m)
#pragma unroll
                for (int n = 0; n < 2; ++n) acc[a][b][m][n] = (f32x4){0.f, 0.f, 0.f, 0.f};
    const int f8_scale_one = 0x7F7F7F7F;
    bf16x8 At[4][2], B0[2][2], B1[2][2]; i32x8 At_8[4], B0_8[2], B1_8[2];
    const char* cA = (const char*)g.A + (size_t)cur.pm * tstep; const char* cB = (const char*)g.Bt + (size_t)cur.pn * tstep;
    S.a_ready(cur);
    if constexpr (SP2) {
        PG8_STAGE(PG8_SB(0, 0), cB, voffB); PG8_STAGE(PG8_SB(0, 1), cB + hstep, voffB); PG8_STAGE(PG8_SA(0, 0), cA, voffA); PG8_STAGE(PG8_SA(0, 1), cA + hstep, voffA);
        if (wr == 1) PG8_BAR;
        PG8_WAIT_V(2); PG8_BAR;
        PG8_STAGE(PG8_SB(1, 0), cB + kstep, voffB); PG8_STAGE(PG8_SA(1, 0), cA + kstep, voffA); PG8_STAGE(PG8_SB(1, 1), cB + hstep + kstep, voffB);
        PG8_WAIT_V(6); PG8_BAR;
    } else {
        PG8_STAGE(PG8_SB(0, 0), cB, voffB); PG8_STAGE(PG8_SA(0, 0), cA, voffA); PG8_STAGE(PG8_SB(0, 1), cB + hstep, voffB); PG8_STAGE(PG8_SA(0, 1), cA + hstep, voffA);
        if (wr == 1) PG8_BAR;
        PG8_WAIT_V(4); PG8_BAR;
        PG8_STAGE(PG8_SB(1, 0), cB + kstep, voffB); PG8_STAGE(PG8_SA(1, 0), cA + kstep, voffA); PG8_STAGE(PG8_SB(1, 1), cB + hstep + kstep, voffB);
        PG8_WAIT_V(6); PG8_BAR;
    }
    for (;;) {
        const bool has_next = S.next(ui + 1, nxt);
        const char* nA = has_next ? (const char*)g.A + (size_t)nxt.pm * tstep : cA; const char* nB = has_next ? (const char*)g.Bt + (size_t)nxt.pn * tstep : cB;
        for (int t = 0; t < nt; t += 2) {
            const bool last = (t == nt - 2);
            const char* a1 = cA + (size_t)(t + 1) * kstep;
            const char* a2 = last ? nA : cA + (size_t)(t + 2) * kstep; const char* b2 = last ? nB : cB + (size_t)(t + 2) * kstep;
            const char* a3 = a2 + kstep; const char* b3 = b2 + kstep;
            if (last && has_next) S.a_ready(nxt);
            if constexpr (SP2) {
            PG8_LDB(B0, 0, 0); PG8_LDB(B1, 0, 1); PG8_SCHED; PG8_LDA(At, 0, 0); PG8_STAGE(PG8_SA(1, 1), a1 + hstep, voffA);
            PG8_WAIT_V(8); PG8_WAIT_L(0); PG8_BAR; PG8_MMA(0, 0, At, B0); PG8_MMA(0, 1, At, B1); PG8_BAR; PG8_SCHED;
            PG8_LDA(At, 0, 1); PG8_STAGE(PG8_SB(0, 0), b2, voffB); PG8_STAGE(PG8_SB(0, 1), b2 + hstep, voffB); PG8_STAGE(PG8_SA(0, 0), a2, voffA);
            PG8_WAIT_V(8); PG8_WAIT_L(0); PG8_BAR; PG8_MMA(1, 0, At, B0); PG8_MMA(1, 1, At, B1); PG8_BAR; PG8_SCHED;
            PG8_LDB(B0, 1, 0); PG8_LDB(B1, 1, 1); PG8_SCHED; PG8_LDA(At, 1, 0); PG8_STAGE(PG8_SA(0, 1), a2 + hstep, voffA);
            PG8_WAIT_V(8); PG8_WAIT_L(0); PG8_BAR; PG8_MMA(0, 0, At, B0); PG8_MMA(0, 1, At, B1); PG8_BAR; PG8_SCHED;
            PG8_LDA(At, 1, 1); PG8_STAGE(PG8_SB(1, 0), b3, voffB); PG8_STAGE(PG8_SB(1, 1), b3 + hstep, voffB); PG8_STAGE(PG8_SA(1, 0), a3, voffA);
            PG8_WAIT_V(8); PG8_WAIT_L(0); PG8_BAR; PG8_MMA(1, 0, At, B0); PG8_MMA(1, 1, At, B1); PG8_BAR; PG8_SCHED;
            } else {
            PG8_LDB(B0, 0, 0); PG8_SCHED; PG8_LDA(At, 0, 0); PG8_STAGE(PG8_SA(1, 1), a1 + hstep, voffA);
            PG8_WAIT_L(8); PG8_BAR; PG8_WAIT_L(0); PG8_MMA(0, 0, At, B0); PG8_BAR; PG8_SCHED;
            PG8_LDB(B1, 0, 1); PG8_STAGE(PG8_SB(0, 0), b2, voffB);
            PG8_BAR; PG8_WAIT_L(0); PG8_MMA(0, 1, At, B1); PG8_BAR;
            PG8_LDA(At, 0, 1); PG8_STAGE(PG8_SA(0, 0), a2, voffA);
            PG8_BAR; PG8_WAIT_L(0); PG8_MMA(1, 0, At, B0); PG8_BAR; PG8_SCHED;
            PG8_STAGE(PG8_SB(0, 1), b2 + hstep, voffB);
            PG8_WAIT_V(6); PG8_BAR; PG8_MMA(1, 1, At, B1); PG8_BAR;
            PG8_LDB(B0, 1, 0); PG8_SCHED; PG8_LDA(At, 1, 0); PG8_STAGE(PG8_SA(0, 1), a2 + hstep, voffA);
            PG8_WAIT_L(8); PG8_BAR; PG8_WAIT_L(0); PG8_MMA(0, 0, At, B0); PG8_BAR; PG8_SCHED;
            PG8_LDB(B1, 1, 1); PG8_STAGE(PG8_SB(1, 0), b3, voffB);
            PG8_BAR; PG8_WAIT_L(0); PG8_MMA(0, 1, At, B1); PG8_BAR;
            PG8_LDA(At, 1, 1); PG8_STAGE(PG8_SA(1, 0), a3, voffA);
            PG8_BAR; PG8_WAIT_L(0); PG8_MMA(1, 0, At, B0); PG8_BAR; PG8_SCHED;
            PG8_STAGE(PG8_SB(1, 1), b3 + hstep, voffB);
            PG8_WAIT_V(6); PG8_BAR; PG8_MMA(1, 1, At, B1); PG8_BAR;
            }
        }
        if constexpr (ALIGN_EPI) { if (wr == 0) PG8_BAR; }
        if constexpr (!Epi::AFTER_DRAIN) { E(acc, cur, wr, wc, fr, fq); S.done(cur); }
        if (!has_next) break;
#pragma unroll
        for (int a = 0; a < 2; ++a)
#pragma unroll
            for (int b = 0; b < 2; ++b)
#pragma unroll
                for (int m = 0; m < 4; ++m)
#pragma unroll
                    for (int n = 0; n < 2; ++n) acc[a][b][m][n] = (f32x4){0.f, 0.f, 0.f, 0.f};
        cur = nxt; cA = nA; cB = nB; ++ui;
        if constexpr (ALIGN_EPI) { if (wr == 1) PG8_BAR; }
    }
    PG8_WAIT_V(0);
    if constexpr (!ALIGN_EPI) { if (wr == 0) PG8_BAR; }
    PG8_BAR;
    if constexpr (Epi::AFTER_DRAIN) { E.fused(acc, cur, wr, wc, fr, fq, lds, wid, lane); S.done(cur); }
#undef PG8_SA
#undef PG8_SB
#undef PG8_STAGE
#undef PG8_LDA
#undef PG8_LDB
#undef PG8_MMA
#undef PG8_WAIT_V
#undef PG8_WAIT_L
#undef PG8_BAR
#undef PG8_SCHED
}
}
namespace att {
constexpr int D = 128;
constexpr int WINDOW = 4096;
constexpr float THR = 8.f;
constexpr bool WSKIP = false;
constexpr float SCALE = 0.08838834764831845f;
constexpr int NW = 8, QBLK = 32, KVBLK = 64, QB = NW * QBLK;
constexpr int SHM_V = KVBLK * D * 2, SHM_K = KVBLK * D * 2;
constexpr int LDS_BYTES = 2 * SHM_V + 2 * SHM_K + NW * 64 * 4;
using bf16 = __hip_bfloat16;
typedef short bf16x8 __attribute__((ext_vector_type(8)));
typedef short s16x4 __attribute__((ext_vector_type(4)));
typedef float f32x16 __attribute__((ext_vector_type(16)));
typedef float f32x4 __attribute__((ext_vector_type(4)));
typedef unsigned u32x4 __attribute__((ext_vector_type(4)));
template <class A, class Bt> struct same_t { static constexpr bool v = false; };
template <class A> struct same_t<A, A> { static constexpr bool v = true; };

#define KSWZ(row, colB) ((row) * 256 + ((colB) ^ (((row) & 7) << 4)))
#define SBAR() __builtin_amdgcn_sched_barrier(0)
__device__ __forceinline__ int v_st(int k, int c) { const int kk = (k & ~0xC) | ((k & 4) << 1) | ((k & 8) >> 1); return ((kk >> 3) * 4 + (c >> 5)) * 512 + ((kk & 7) * 32 + (c & 31)) * 2; }
__device__ __forceinline__ int v_rd_base(int lane) { return ((lane & 3) << 3) | (((lane >> 2) & 3) << 6) | (((lane >> 4) & 1) << 5) | (((lane >> 5) & 1) << 8); }
constexpr int v_rd_off(int d0, int ks, int half) { return d0 * 512 + ks * 4096 + half * 2048; }
__device__ __forceinline__ int crow(int r, int hi) { return (r & 3) + 8 * (r >> 2) + 4 * hi; }
__device__ __forceinline__ unsigned cvtpk(float lo, float hi) {
    unsigned r; asm volatile("v_cvt_pk_bf16_f32 %0, %1, %2" : "=v"(r) : "v"(lo), "v"(hi)); return r;
}
__device__ __forceinline__ bf16x8 pack8(f32x4 a, f32x4 b) {
    u32x4 w = {cvtpk(a[0], a[1]), cvtpk(a[2], a[3]), cvtpk(b[0], b[1]), cvtpk(b[2], b[3])};
    return *reinterpret_cast<bf16x8*>(&w);
}
template <class T> __device__ __forceinline__ bf16x8 load8(const T* p) {
    if constexpr (same_t<T, float>::v) { return pack8(*(const f32x4*)p, *(const f32x4*)(p + 4)); }
    else { return *reinterpret_cast<const bf16x8*>(p); }
}
__device__ __forceinline__ void mask_tile(f32x16& p0, f32x16& p1, int dq, unsigned W) {
    const float NEG = -__builtin_inff();
#pragma unroll
    for (int r = 0; r < 16; ++r) {
        const int c = (r & 3) + 8 * (r >> 2);
        if ((unsigned)(dq - c) >= W) p0[r] = NEG;
        if ((unsigned)(dq - c - 32) >= W) p1[r] = NEG;
    }
}
__device__ __forceinline__ void partialSM(f32x16& p0, f32x16& p1, float& m_reg, float& mn, float& alpha) {
    float pmax = p0[0]; for (int r = 1; r < 16; ++r) pmax = fmaxf(pmax, p0[r]); for (int r = 0; r < 16; ++r) pmax = fmaxf(pmax, p1[r]);
    { auto rr = __builtin_amdgcn_permlane32_swap(__float_as_uint(pmax), __float_as_uint(pmax), false, false);
      pmax = fmaxf(__uint_as_float(rr[0]), __uint_as_float(rr[1])); }
    constexpr float C2 = 1.4426950408889634f * SCALE;
    if (__builtin_expect(__all((pmax - m_reg) * SCALE <= THR), 1)) { mn = m_reg; alpha = 1.f; }
    else { mn = fmaxf(m_reg, pmax); alpha = __builtin_amdgcn_exp2f((m_reg - mn) * C2); m_reg = mn; }
    const float mnL = -mn * C2;
    for (int r = 0; r < 16; ++r) p0[r] = fmaf(p0[r], C2, mnL); for (int r = 0; r < 16; ++r) p1[r] = fmaf(p1[r], C2, mnL);
    for (int r = 0; r < 16; ++r) p0[r] = __builtin_amdgcn_exp2f(p0[r]);
}
__device__ __forceinline__ void finishSM(f32x16& p0, f32x16& p1, float alpha, float& l_reg, bf16x8& pa0, bf16x8& pa1, bf16x8& pa2, bf16x8& pa3) {
    for (int r = 0; r < 16; ++r) p1[r] = __builtin_amdgcn_exp2f(p1[r]);
    float ps = 0; for (int r = 0; r < 16; ++r) ps += p0[r]; for (int r = 0; r < 16; ++r) ps += p1[r];
    { auto rr = __builtin_amdgcn_permlane32_swap(__float_as_uint(ps), __float_as_uint(ps), false, false);
      ps = __uint_as_float(rr[0]) + __uint_as_float(rr[1]); }
    l_reg = l_reg * alpha + ps;
#define PK4(P, B_, OUT) do { unsigned a0 = cvtpk(P[B_+0], P[B_+1]), a1 = cvtpk(P[B_+2], P[B_+3]);                          \
        unsigned b0 = cvtpk(P[B_+4], P[B_+5]), b1 = cvtpk(P[B_+6], P[B_+7]);                                             \
        auto r0 = __builtin_amdgcn_permlane32_swap(a0, b0, false, false); auto r1 = __builtin_amdgcn_permlane32_swap(a1, b1, false, false); \
        u32x4 w = {r0[0], r1[0], r0[1], r1[1]}; OUT = *reinterpret_cast<bf16x8*>(&w); } while (0)
    PK4(p0, 0, pa0); PK4(p0, 8, pa1); PK4(p1, 0, pa2); PK4(p1, 8, pa3);
#undef PK4
}
template <int KB, bool SK>
__device__ __forceinline__ void qkt(f32x16& p0, f32x16& p1, const char* K_lds, int r32, int hi, const bf16x8* qr, bool act) {
    if (SK && !act) { const float NEG = -__builtin_inff();
#pragma unroll
        for (int r = 0; r < 16; ++r) { p0[r] = NEG; p1[r] = NEG; } return; }
    p0 = f32x16{}; p1 = f32x16{};
    const char* kb[4];
#pragma unroll
    for (int dd = 0; dd < 4; ++dd) kb[dd] = K_lds + KB * SHM_K + KSWZ(r32, (dd * 16 + hi * 8) * 2);
#pragma unroll
    for (int d0 = 0; d0 < 8; ++d0) { const char* a = kb[d0 & 3] + (d0 >> 2) * 128;
        bf16x8 b0 = *reinterpret_cast<const bf16x8*>(a);
        bf16x8 b1 = *reinterpret_cast<const bf16x8*>(a + 32 * 256);
        p0 = __builtin_amdgcn_mfma_f32_32x32x16_bf16(b0, qr[d0], p0, 0, 0, 0);
        p1 = __builtin_amdgcn_mfma_f32_32x32x16_bf16(b1, qr[d0], p1, 0, 0, 0); }
}
template <int VB, bool SK>
__device__ __forceinline__ void pv_tile(f32x16* o, int vb0, bf16x8 pa0, bf16x8 pa1, bf16x8 pa2, bf16x8 pa3, bool act) {
    if (SK && !act) return;
#define TRRD(dst, off) asm volatile("ds_read_b64_tr_b16 %0, %1 offset:%2" : "=&v"(dst) : "v"(vb0), "i"(off) : "memory")
#define PV_D0(d0) do { s16x4 l0, l1, l2, l3, h0, h1, h2, h3; constexpr int b_ = VB * SHM_V + v_rd_off(d0, 0, 0);     \
        TRRD(l0, b_); TRRD(h0, b_ + 2048); TRRD(l1, b_ + 4096); TRRD(h1, b_ + 6144); TRRD(l2, b_ + 8192); TRRD(h2, b_ + 10240); TRRD(l3, b_ + 12288); TRRD(h3, b_ + 14336); \
        asm volatile("s_waitcnt lgkmcnt(0)" ::: "memory"); SBAR();                 \
        o[d0] = __builtin_amdgcn_mfma_f32_32x32x16_bf16(pa0, (bf16x8){l0[0], l0[1], l0[2], l0[3], h0[0], h0[1], h0[2], h0[3]}, o[d0], 0, 0, 0);   \
        o[d0] = __builtin_amdgcn_mfma_f32_32x32x16_bf16(pa1, (bf16x8){l1[0], l1[1], l1[2], l1[3], h1[0], h1[1], h1[2], h1[3]}, o[d0], 0, 0, 0);   \
        o[d0] = __builtin_amdgcn_mfma_f32_32x32x16_bf16(pa2, (bf16x8){l2[0], l2[1], l2[2], l2[3], h2[0], h2[1], h2[2], h2[3]}, o[d0], 0, 0, 0);   \
        o[d0] = __builtin_amdgcn_mfma_f32_32x32x16_bf16(pa3, (bf16x8){l3[0], l3[1], l3[2], l3[3], h3[0], h3[1], h3[2], h3[3]}, o[d0], 0, 0, 0); } while (0)
    PV_D0(0); PV_D0(1); PV_D0(2); PV_D0(3);
#undef PV_D0
#undef TRRD
}

template <class TIn, class TOut> struct BlockRef { const TIn* Q; const TIn* K; const TIn* V; TOut* O; int P0; };
template <class TIn> struct Seam {
    bf16x8 qr[8];
    bf16x8 st_v0, st_v1, st_k0, st_k1; f32x4 sf0, sf1, sf2, sf3;
    f32x4 tq[16];
};
__device__ __forceinline__ int swa_jlo(int P0, int W) { const int lowk = P0 - W + 1; return lowk > 0 ? lowk / KVBLK : 0; }
#define ROW(p, k0, rr) ((p) + (size_t)((k0) + (rr)) * D + sc)
#define VMW() asm volatile("s_waitcnt vmcnt(0)" ::: "memory")
#define VMWN(n) asm volatile("s_waitcnt vmcnt(%0)" :: "i"(n) : "memory")
#define SLOAD_H(Kp, Vp, k0) do { S.st_v0 = load8<TIn>(ROW(Vp, k0, sr)); S.st_v1 = load8<TIn>(ROW(Vp, k0, 32 + sr));              \
                         S.st_k0 = load8<TIn>(ROW(Kp, k0, sr)); S.st_k1 = load8<TIn>(ROW(Kp, k0, 32 + sr)); } while (0)
#define SWRITE_HK(bf) do { *(bf16x8*)(K_lds + (bf) * SHM_K + kws) = S.st_k0; *(bf16x8*)(K_lds + (bf) * SHM_K + kws + 32 * 256) = S.st_k1; } while (0)
#define SWRITE_HV(bf) do { *(bf16x8*)(V_lds + (bf) * SHM_V + vst0) = S.st_v0; *(bf16x8*)(V_lds + (bf) * SHM_V + vst1) = S.st_v1; } while (0)
#define SWRITE_H(bf) do { SWRITE_HV(bf); SWRITE_HK(bf); } while (0)
#define SLOAD_F(p, k0) do { S.sf0 = *(const f32x4*)ROW(p, k0, sr); S.sf1 = *(const f32x4*)(ROW(p, k0, sr) + 4);                \
                            S.sf2 = *(const f32x4*)ROW(p, k0, 32 + sr); S.sf3 = *(const f32x4*)(ROW(p, k0, 32 + sr) + 4); } while (0)
#define SWRITE_KF(bf) do { *(bf16x8*)(K_lds + (bf) * SHM_K + kws) = pack8(S.sf0, S.sf1); *(bf16x8*)(K_lds + (bf) * SHM_K + kws + 32 * 256) = pack8(S.sf2, S.sf3); } while (0)
#define SWRITE_VF(bf) do { *(bf16x8*)(V_lds + (bf) * SHM_V + vst0) = pack8(S.sf0, S.sf1); *(bf16x8*)(V_lds + (bf) * SHM_V + vst1) = pack8(S.sf2, S.sf3); } while (0)
template <class TIn, class TOut>
__device__ __forceinline__ void causal_swa_prime(const BlockRef<TIn, TOut>& cur, int W, char* lds, Seam<TIn>& S) {
    constexpr bool F32 = same_t<TIn, float>::v;
    const int tid = threadIdx.x, wid = __builtin_amdgcn_readfirstlane(tid >> 6), lane = tid & 63, r32 = lane & 31, hi = lane >> 5;
    const int sr = tid >> 4, sc = (tid & 15) * 8, kws = KSWZ(sr, sc * 2); char* K_lds = lds + 2 * SHM_V;
    const int kb0 = swa_jlo(cur.P0, W) * KVBLK;
    for (int d0 = 0; d0 < 8; ++d0) S.qr[d0] = load8<TIn>(cur.Q + (size_t)(wid * QBLK + r32) * D + d0 * 16 + hi * 8);
    if constexpr (F32) { SLOAD_F((const float*)cur.K, kb0); VMW(); SWRITE_KF(0); SBAR(); SLOAD_F((const float*)cur.V, kb0); }
    else { SLOAD_H(cur.K, cur.V, kb0); VMW(); SWRITE_HK(0); }
    __syncthreads();
}
template <class TIn, class TOut>
__device__ __forceinline__ void causal_swa_block(const BlockRef<TIn, TOut>& cur, const BlockRef<TIn, TOut>& nxt, int skv, int W, char* lds, Seam<TIn>& S) {
    constexpr bool F32 = same_t<TIn, float>::v;
    const int tid = threadIdx.x, wid = __builtin_amdgcn_readfirstlane(tid >> 6), lane = tid & 63, r32 = lane & 31, hi = lane >> 5;
    const int j_lo = swa_jlo(cur.P0, W);
    int j_hi = (cur.P0 + QB - 1) / KVBLK + 1; if (j_hi > skv / KVBLK) j_hi = skv / KVBLK;
    const int NT = j_hi - j_lo;
    const int kbn = swa_jlo(nxt.P0, W) * KVBLK;
    const int qlo = cur.P0 + wid * QBLK, qm = qlo + r32 - 4 * hi;
    char* V_lds = lds; char* K_lds = lds + 2 * SHM_V;
    float* ws = (float*)(lds + 2 * SHM_V + 2 * SHM_K) + wid * 64; float* li_l = ws, * al_l = ws + 32;
    float m_reg = -1e30f, l_reg = 0; f32x16 o[4] = {};
    const int sr = tid >> 4, sc = (tid & 15) * 8, vst0 = v_st(sr, sc), vst1 = v_st(32 + sr, sc), kws = KSWZ(sr, sc * 2);
    const int vb0 = (int)(uintptr_t)V_lds + v_rd_base(lane);
    const TIn* Kh = cur.K; const TIn* Vh = cur.V;
#define RESC(a) do { if (__any((a) < 1.f)) { if (hi == 0) al_l[r32] = (a); asm volatile("s_waitcnt lgkmcnt(0)" ::: "memory");              \
                     for (int d_ = 0; d_ < 4; ++d_) for (int r = 0; r < 16; ++r) o[d_][r] *= al_l[crow(r, hi)]; } } while (0)
#define KBASE(t) ((j_lo + (t)) * KVBLK)
#define ACT(t) (KBASE(t) <= qlo + QBLK - 1 && KBASE(t) + KVBLK - 1 >= qlo - W + 1)
#define MASKT(P0_, P1_, t) do { const int kb_ = KBASE(t); if ((!SK || ACT(t)) && (kb_ + KVBLK - 1 > qlo || kb_ <= qlo + QBLK - 1 - W)) mask_tile(P0_, P1_, qm - kb_, (unsigned)W); } while (0)
    constexpr int NQL = F32 ? 16 : 8;
    constexpr bool SK = WSKIP && !F32;
#define SEAM_K0() do { VMWN(NQL); if constexpr (F32) { SWRITE_KF(0); SBAR(); SLOAD_F((const float*)nxt.V, kbn); } else { SWRITE_HK(0); } SBAR(); } while (0)
    f32x16 pA0, pA1, pB0, pB1; float mnA, mnB, alA, alB; bf16x8 pa0, pa1, pa2, pa3;
    if constexpr (F32) { VMW(); SWRITE_VF(0); SBAR(); } else { SWRITE_HV(0); SBAR(); }
    if (NT > 1) { if constexpr (F32) SLOAD_F((const float*)Kh, KBASE(1)); else SLOAD_H(Kh, Vh, KBASE(1)); }
    SBAR(); qkt<0, SK>(pA0, pA1, K_lds, r32, hi, S.qr, ACT(0));
    if constexpr (F32) { if (NT > 1) { VMW(); SWRITE_KF(1); SBAR(); SLOAD_F((const float*)Vh, KBASE(1)); } }
    MASKT(pA0, pA1, 0); partialSM(pA0, pA1, m_reg, mnA, alA);
    if (NT > 1) { VMW(); if constexpr (F32) { SWRITE_VF(1); SBAR(); if (NT > 2) SLOAD_F((const float*)Kh, KBASE(2)); } else SWRITE_H(1); }
    __syncthreads();
#define HALF_STEP(PX0, PX1, mnX, alX, PY0, PY1, alY, t, KB, VB, SB) do {                                                      \
        SBAR(); qkt<KB, SK>(PX0, PX1, K_lds, r32, hi, S.qr, ACT(t));                                             \
        finishSM(PY0, PY1, alY, l_reg, pa0, pa1, pa2, pa3); SBAR();                                                           \
        if ((t) + 1 < NT) { if constexpr (F32) { VMW(); SWRITE_KF(SB); SBAR(); SLOAD_F((const float*)Vh, KBASE((t) + 1)); }  \
                            else { SLOAD_H(Kh, Vh, KBASE((t) + 1)); } SBAR(); }                                               \
        pv_tile<VB, SK>(o, vb0, pa0, pa1, pa2, pa3, ACT((t) - 1)); MASKT(PX0, PX1, (t)); partialSM(PX0, PX1, m_reg, mnX, alX);                                        \
        __syncthreads();                                                                                                      \
        if ((t) + 1 < NT) { VMW(); if constexpr (F32) { SWRITE_VF(SB); SBAR(); if ((t) + 2 < NT) SLOAD_F((const float*)Kh, KBASE((t) + 2)); } \
                            else { SWRITE_H(SB); } }                                                                          \
        RESC(alX); __syncthreads(); } while (0)
    for (int t = 1; t + 1 < NT; t += 2) {
        HALF_STEP(pB0, pB1, mnB, alB, pA0, pA1, alA, t, 1, 0, 0);
        HALF_STEP(pA0, pA1, mnA, alA, pB0, pB1, alB, t + 1, 0, 1, 1);
    }
    const bool even = (NT & 1) == 0;
    if (even) { SBAR(); qkt<1, SK>(pB0, pB1, K_lds, r32, hi, S.qr, ACT(NT - 1)); SBAR(); }
#define QROW(e) (nxt.Q + (size_t)(wid * QBLK + r32) * D + ((e) >> 1) * 16 + hi * 8 + ((e) & 1) * 4)
    if constexpr (F32) { SLOAD_F((const float*)nxt.K, kbn); SBAR();
#pragma unroll
        for (int e = 0; e < 8; ++e) S.tq[e] = *(const f32x4*)QROW(e); }
    else { SLOAD_H(nxt.K, nxt.V, kbn); SBAR();
#pragma unroll
        for (int d0 = 0; d0 < 8; ++d0) S.qr[d0] = load8<TIn>(nxt.Q + (size_t)(wid * QBLK + r32) * D + d0 * 16 + hi * 8); }
    SBAR();
    finishSM(pA0, pA1, alA, l_reg, pa0, pa1, pa2, pa3); SBAR();
    if constexpr (F32) {
#pragma unroll
        for (int e = 8; e < 16; ++e) S.tq[e] = *(const f32x4*)QROW(e); SBAR(); }
#undef QROW
    pv_tile<0, SK>(o, vb0, pa0, pa1, pa2, pa3, ACT(even ? NT - 2 : NT - 1));
    if (even) { MASKT(pB0, pB1, NT - 1); partialSM(pB0, pB1, m_reg, mnB, alB); __syncthreads(); RESC(alB);
        finishSM(pB0, pB1, alB, l_reg, pa0, pa1, pa2, pa3); SBAR(); pv_tile<1, SK>(o, vb0, pa0, pa1, pa2, pa3, ACT(NT - 1)); }
    SBAR(); SEAM_K0();
    if (hi == 0) li_l[r32] = l_reg; asm volatile("s_waitcnt lgkmcnt(0)" ::: "memory");
    float rli[16];
#pragma unroll
    for (int r = 0; r < 16; ++r) rli[r] = __builtin_amdgcn_rcpf(li_l[crow(r, hi)]);
    TOut* Ow = cur.O + (size_t)(wid * QBLK) * D;
#pragma unroll
    for (int r = 0; r < 16; ++r) { const int orow = crow(r, hi);
#pragma unroll
        for (int d0 = 0; d0 < 4; ++d0) { const float v = o[d0][r] * rli[r];
            if constexpr (same_t<TOut, float>::v) { Ow[(size_t)orow * D + d0 * 32 + r32] = v; }
            else { const float vn = __shfl_xor(v, 1);
                   if ((r32 & 1) == 0) *(unsigned*)(Ow + (size_t)orow * D + d0 * 32 + r32) = cvtpk(v, vn); } } }
    if constexpr (F32) {
#pragma unroll
        for (int d0 = 0; d0 < 8; ++d0) S.qr[d0] = pack8(S.tq[2 * d0], S.tq[2 * d0 + 1]); }
    __syncthreads();
#undef RESC
#undef KBASE
#undef ACT
#undef MASKT
#undef SEAM_K0
#undef HALF_STEP
}
#undef ROW
#undef VMW
#undef VMWN
#undef SLOAD_H
#undef SWRITE_HK
#undef SWRITE_HV
#undef SWRITE_H
#undef SLOAD_F
#undef SWRITE_KF
#undef SWRITE_VF
}
struct Ctx { LAS unsigned char* lds; int tid, lane, wave, vcu, G; };

__device__ __forceinline__ void tr_item(const float* __restrict__ src, size_t ldn, const float* __restrict__ gain, bfr* __restrict__ dst, int K,
                                        int k0, int nsrc0, int drow0, LAS float* scr, int lane) {
    const int r4 = lane >> 4, c4 = (lane & 15) * 4;
    f4v v[16];
#pragma unroll
    for (int i = 0; i < 16; ++i) v[i] = *(const f4v*)(src + (size_t)(k0 + 4 * i + r4) * ldn + nsrc0 + c4);
#pragma unroll
    for (int i = 0; i < 16; ++i) { const int k = 4 * i + r4; const float gk = gain ? gain[k0 + k] : 1.f;
        LAS float* s = scr + k * 65 + c4; s[0] = v[i][0] * gk; s[1] = v[i][1] * gk; s[2] = v[i][2] * gk; s[3] = v[i][3] * gk; }
    LDS_WAIT(); asm volatile("" ::: "memory");
    const int c = lane & 7;
#pragma unroll
    for (int jj = 0; jj < 8; ++jj) { const int n = (lane >> 3) + 8 * jj; const LAS float* s = scr + (8 * c) * 65 + n;
        u4v o; o.x = cvtpk(s[0 * 65], s[1 * 65]); o.y = cvtpk(s[2 * 65], s[3 * 65]); o.z = cvtpk(s[4 * 65], s[5 * 65]); o.w = cvtpk(s[6 * 65], s[7 * 65]);
        *(u4v*)(dst + (size_t)(drow0 + n) * K + k0 + 8 * c) = o; }
    LDS_WAIT(); asm volatile("" ::: "memory");
}
__device__ __forceinline__ void tr_item8(const float* __restrict__ src, size_t ldn, float sc, const float* __restrict__ gain, unsigned char* __restrict__ dst, int K, int k0, int nsrc0, int drow0, LAS float* scr, int lane) {
    const int r4 = lane >> 4, c4 = (lane & 15) * 4;
    f4v v[16];
#pragma unroll
    for (int i = 0; i < 16; ++i) v[i] = *(const f4v*)(src + (size_t)(k0 + 4 * i + r4) * ldn + nsrc0 + c4);
#pragma unroll
    for (int i = 0; i < 16; ++i) { const int k = 4 * i + r4; const float gk = gain ? gain[k0 + k] * sc : sc; LAS float* s = scr + k * 65 + c4; s[0] = v[i][0] * gk; s[1] = v[i][1] * gk; s[2] = v[i][2] * gk; s[3] = v[i][3] * gk; }
    LDS_WAIT(); asm volatile("" ::: "memory");
    const int c = lane & 3;
#pragma unroll
    for (int jj = 0; jj < 4; ++jj) { const int n = (lane >> 2) + 16 * jj; const LAS float* s = scr + (16 * c) * 65 + n;
        u4v o; o.x = cvt4_fp8(s[0 * 65], s[1 * 65], s[2 * 65], s[3 * 65]); o.y = cvt4_fp8(s[4 * 65], s[5 * 65], s[6 * 65], s[7 * 65]);
        o.z = cvt4_fp8(s[8 * 65], s[9 * 65], s[10 * 65], s[11 * 65]); o.w = cvt4_fp8(s[12 * 65], s[13 * 65], s[14 * 65], s[15 * 65]);
        *(u4v*)(dst + (size_t)(drow0 + n) * K + k0 + 16 * c) = o; }
    LDS_WAIT(); asm volatile("" ::: "memory");
}
__device__ __forceinline__ void tr_job8(const float* __restrict__ src, size_t ldn, float sc, const float* __restrict__ gain, unsigned char* __restrict__ dst, int K, int ncols, LAS float* scr, int lane, int gw, int NGW, int nsrc0 = 0) {
    const int nn = ncols / 64, ni = (K / 64) * nn;
    for (int it = gw; it < ni; it += NGW) { const int kb = it / nn, nb = it - kb * nn; tr_item8(src, ldn, sc, gain, dst, K, kb * 64, nsrc0 + nb * 64, nb * 64, scr, lane); }
}
__device__ __forceinline__ void tr_job(const float* __restrict__ src, size_t ldn, const float* __restrict__ gain, bfr* __restrict__ dst, int K, int ncols, int nsrc0, int drow0,
                                       LAS float* scr, int lane, int gw, int NGW) {
    const int nn = ncols / 64, ni = (K / 64) * nn;
    for (int it = gw; it < ni; it += NGW) { const int kb = it / nn, nb = it - kb * nn;
        tr_item(src, ldn, gain, dst, K, kb * 64, nsrc0 + nb * 64, drow0 + nb * 64, scr, lane); }
}
struct KArgs {
    const float* in[26]; float* out; unsigned char* ws; int ph_lo, ph_hi, li, pad;
};
struct Ptrs {
    LAS unsigned long long* tbl;
    __device__ __forceinline__ unsigned long long get(int k) const { const unsigned long long v = tbl[k];
        return ((unsigned long long)(unsigned)__builtin_amdgcn_readfirstlane((int)(unsigned)(v >> 32)) << 32) | (unsigned)__builtin_amdgcn_readfirstlane((int)(unsigned)v); }
    __device__ __forceinline__ const float* in_(int k) const { return (const float*)get(k); }
    __device__ __forceinline__ float* out_() const { return (float*)get(26); }
    __device__ __forceinline__ unsigned char* ws_() const { return (unsigned char*)get(27); }
};
__device__ __forceinline__ void p_convert(const Ctx& C, const Ptrs& P) {
    LAS float* scr = (LAS float*)(C.lds + C.wave * 16640);
    const int gw = C.vcu * 8 + C.wave, NGW = C.G * 8;
    unsigned char* ws = P.ws_();
#if F8_PROJ0 == 1
    tr_job8(P.in_(2), (size_t)GIN, SU, P.in_(1), ws + WS_WTIN, DM, 16384, scr, C.lane, gw, NGW);
#elif F8_PROJ0 == 2
    tr_job(P.in_(2), (size_t)GIN, P.in_(1), (bfr*)(ws + WS_WTIN), DM, 8192, 0, 0, scr, C.lane, gw, NGW);
    tr_job8(P.in_(2), (size_t)GIN, SU, P.in_(1), ws + WS_WTIN + (size_t)8192 * DM * 2, DM, 8192, scr, C.lane, gw, NGW, 8192);
#elif F8_PROJ0 == 3
    tr_job8(P.in_(2), (size_t)GIN, SU, P.in_(1), ws + WS_WTIN, DM, 8192, scr, C.lane, gw, NGW, 0);
    tr_job(P.in_(2), (size_t)GIN, P.in_(1), (bfr*)(ws + WS_WTIN + (size_t)8192 * DM), DM, 8192, 8192, 0, scr, C.lane, gw, NGW);
#else
    tr_job(P.in_(2), (size_t)GIN, P.in_(1), (bfr*)(ws + WS_WTIN), DM, 16384, 0, 0, scr, C.lane, gw, NGW);
#endif
    tr_job(P.in_(2), (size_t)GIN, P.in_(1), (bfr*)(ws + WS_WTBD), DM, 64, 16384, 0, scr, C.lane, gw, NGW);
#if F8_OUT0
    tr_job8(P.in_(7), (size_t)DM, SU, nullptr, ws + WS_WTOUT, DM, DM, scr, C.lane, gw, NGW, 0);
#else
    tr_job(P.in_(7), (size_t)DM, nullptr, (bfr*)(ws + WS_WTOUT), DM, DM, 0, 0, scr, C.lane, gw, NGW);
#endif
#if F8_KVQ
    tr_job8(P.in_(9), (size_t)8192, SU, P.in_(8), ws + WS_WTKVQ, DM, DM, scr, C.lane, gw, NGW, 0);
    tr_job8(P.in_(12), (size_t)DM, SU, P.in_(11), ws + WS_WTKVQ + (size_t)DM * DM, DM, DM, scr, C.lane, gw, NGW, 0);
#if F8_KVQ == 2
    tr_job8(P.in_(9), (size_t)8192, SU, P.in_(8), ws + WS_WTKVQ + (size_t)2 * DM * DM, DM, DM, scr, C.lane, gw, NGW, DM);
#else
    tr_job(P.in_(9), (size_t)8192, P.in_(8), (bfr*)(ws + WS_WTKVQ + (size_t)2 * DM * DM), DM, DM, DM, 0, scr, C.lane, gw, NGW);
#endif
#else
    tr_job(P.in_(9), (size_t)8192, P.in_(8), (bfr*)(ws + WS_WTKVQ), DM, 8192, 0, 0, scr, C.lane, gw, NGW);
    tr_job(P.in_(12), (size_t)DM, P.in_(11), (bfr*)(ws + WS_WTKVQ), DM, DM, 0, 8192, scr, C.lane, gw, NGW);
#endif
#if F8_OUT1
    tr_job8(P.in_(19), (size_t)DM, SU, nullptr, ws + WS_WTO, DM, DM, scr, C.lane, gw, NGW, 0);
#else
    tr_job(P.in_(19), (size_t)DM, nullptr, (bfr*)(ws + WS_WTO), DM, DM, 0, 0, scr, C.lane, gw, NGW);
#endif
    tr_job(P.in_(21), (size_t)PQ, P.in_(20), (bfr*)(ws + WS_WTQRY), DM, PQ, 0, 0, scr, C.lane, gw, NGW);
    tr_job(P.in_(21) + (size_t)DM * PQ, (size_t)PQ, P.in_(20) + DM, (bfr*)(ws + WS_WTQRY) + (size_t)PQ * DM, DM, PQ, 0, 0, scr, C.lane, gw, NGW);
    tr_job8(P.in_(25), (size_t)DM, SV, nullptr, ws + WS_VT, PE, DM, scr, C.lane, gw, NGW);
    tr_job8(P.in_(25) + (size_t)PE * DM, (size_t)DM, SV, nullptr, ws + WS_VT + (size_t)DM * PE, PE, DM, scr, C.lane, gw, NGW);
    {
        const size_t gt = (size_t)C.vcu * 512 + C.tid, GT = (size_t)C.G * 512;
        for (int l = 0; l < 2; ++l) {
            const float* src = P.in_(24) + (size_t)l * PE * DM; const float* gain = P.in_(20) + l * DM; unsigned char* dst = ws + WS_U + (size_t)l * PE * DM;
            for (size_t i = gt; i < (size_t)PE * DM / 16; i += GT) {
                const f4v a = *(const f4v*)(src + i * 16), b = *(const f4v*)(src + i * 16 + 4), c = *(const f4v*)(src + i * 16 + 8), d = *(const f4v*)(src + i * 16 + 12);
                const int dd = (int)((i * 16) & (DM - 1)); const f4v ga = *(const f4v*)(gain + dd) * SU, gb = *(const f4v*)(gain + dd + 4) * SU, gc = *(const f4v*)(gain + dd + 8) * SU, gd = *(const f4v*)(gain + dd + 12) * SU;
                u4v o; o.x = cvt4_fp8(a[0] * ga[0], a[1] * ga[1], a[2] * ga[2], a[3] * ga[3]); o.y = cvt4_fp8(b[0] * gb[0], b[1] * gb[1], b[2] * gb[2], b[3] * gb[3]);
                o.z = cvt4_fp8(c[0] * gc[0], c[1] * gc[1], c[2] * gc[2], c[3] * gc[3]); o.w = cvt4_fp8(d[0] * gd[0], d[1] * gd[1], d[2] * gd[2], d[3] * gd[3]);
                *(u4v*)(dst + i * 16) = o; }
        }
        for (int l = 0; l < 2; ++l) {
            bfr* dst = (bfr*)(ws + WS_WTKEY) + (size_t)l * PQ * PQ;
            for (size_t i = gt; i < (size_t)PQ * PQ / 8; i += GT) {
                const int row = (int)((i * 8) / PQ), col = (int)((i * 8) % PQ); u4v o = {0u, 0u, 0u, 0u};
                if ((row >> 7) == (col >> 7)) { const int blk = row >> 7, h = blk >> 1, half = blk & 1, n = row & 127, d = col & 127;
                    const float* src = (half ? P.in_(23) : P.in_(22)) + (((size_t)l * PH + h) * PK + n) * 128 + d;
                    const f4v a = *(const f4v*)src, b = *(const f4v*)(src + 4);
                    o.x = cvtpk(a[0], a[1]); o.y = cvtpk(a[2], a[3]); o.z = cvtpk(b[0], b[1]); o.w = cvtpk(b[2], b[3]); }
                *(u4v*)(dst + i * 8) = o; }
        }
    }
}

__device__ __forceinline__ void p_norm_rows(const Ctx& C, const float* __restrict__ src, bfr* __restrict__ dst, unsigned char* __restrict__ dst8) {
    const int gw = C.vcu * 8 + C.wave, NGW = C.G * 8;
    for (int row = gw; row < NT; row += NGW) {
        const f4v* p = (const f4v*)(src + (size_t)row * DM);
        f4v a[8], b[8]; float ss = 0.f;
#pragma unroll
        for (int j = 0; j < 8; ++j) { a[j] = p[j * 128 + 2 * C.lane]; b[j] = p[j * 128 + 2 * C.lane + 1]; }
#pragma unroll
        for (int j = 0; j < 8; ++j) ss += (a[j][0] * a[j][0] + a[j][1] * a[j][1]) + (a[j][2] * a[j][2] + a[j][3] * a[j][3]) + (b[j][0] * b[j][0] + b[j][1] * b[j][1]) + (b[j][2] * b[j][2] + b[j][3] * b[j][3]);
        const float r = __builtin_amdgcn_rsqf(wave_sum(ss) * (1.f / DM) + EPS);
        u4v* o = (u4v*)(dst + (size_t)row * DM);
#pragma unroll
        for (int j = 0; j < 8; ++j) { u4v w; w.x = cvtpk(a[j][0] * r, a[j][1] * r); w.y = cvtpk(a[j][2] * r, a[j][3] * r); w.z = cvtpk(b[j][0] * r, b[j][1] * r); w.w = cvtpk(b[j][2] * r, b[j][3] * r);
            o[j * 64 + C.lane] = w;
            if (dst8) { u2v w8; w8.x = cvt4_fp8(a[j][0] * r, a[j][1] * r, a[j][2] * r, a[j][3] * r); w8.y = cvt4_fp8(b[j][0] * r, b[j][1] * r, b[j][2] * r, b[j][3] * r); ((u2v*)(dst8 + (size_t)row * DM))[j * 64 + C.lane] = w8; } }
    }
}

__device__ __forceinline__ void p_bd(const Ctx& C, const bfr* __restrict__ XN, const bfr* __restrict__ WB, float* __restrict__ BD) {
    LAS float* red = (LAS float*)C.lds;
    const int r = C.lane & 15, q = C.lane >> 4, rt = C.wave >> 2, kq = C.wave & 3;
    for (int blk = C.vcu; blk < NT / 32; blk += C.G) {
        const bfr* ap = XN + (size_t)(blk * 32 + rt * 16 + r) * DM + kq * 1024 + q * 8;
        const bfr* bp = WB + (size_t)r * DM + kq * 1024 + q * 8;
        f4v acc[4] = {zero_acc(), zero_acc(), zero_acc(), zero_acc()};
#pragma unroll 4
        for (int ks = 0; ks < 32; ++ks) {
            const s8v a = *(const s8v*)(ap + ks * 32);
#pragma unroll
            for (int nt = 0; nt < 4; ++nt) { const s8v b = *(const s8v*)(bp + (size_t)nt * 16 * DM + ks * 32); acc[nt] = __builtin_amdgcn_mfma_f32_16x16x32_bf16(a, b, acc[nt], 0, 0, 0); }
            MFMA_SETTLE(acc[0]); MFMA_SETTLE(acc[1]); MFMA_SETTLE(acc[2]); MFMA_SETTLE(acc[3]);
        }
        MFMA_SETTLE(acc[0]); MFMA_SETTLE(acc[1]); MFMA_SETTLE(acc[2]); MFMA_SETTLE(acc[3]);
#pragma unroll
        for (int nt = 0; nt < 4; ++nt)
#pragma unroll
            for (int i = 0; i < 4; ++i) red[C.wave * 1024 + (4 * q + i) * 64 + nt * 16 + r] = -acc[nt][i];
        __syncthreads();
#pragma unroll
        for (int i = 0; i < 4; ++i) { const int idx = C.tid * 4 + i, t2 = idx >> 10, rem = idx & 1023;
            const float s = -((red[(t2 * 4 + 0) * 1024 + rem] + red[(t2 * 4 + 1) * 1024 + rem]) + (red[(t2 * 4 + 2) * 1024 + rem] + red[(t2 * 4 + 3) * 1024 + rem]));
            BD[(size_t)(blk * 32 + t2 * 16 + (rem >> 6)) * 64 + (rem & 63)] = s; }
        __syncthreads();
    }
}
__device__ __forceinline__ int kq_off(int row, int chunk) { return row * 256 + ((chunk ^ (row & 7)) << 4); }
__device__ __forceinline__ int xt_off(int col, int chunk) { return col * 128 + ((chunk ^ (col & 7)) << 4); }
__device__ __forceinline__ void p_gdn_prep(const Ctx& C, const Ptrs& P) {
    unsigned char* ws = P.ws_();
    const bfr* PROJ = (const bfr*)(ws + WS_BIG); const float* BD = (const float*)(ws + WS_BD);
    const float* convw = P.in_(3); const float* alog = P.in_(4); const float* dtb = P.in_(5);
    bfr* Wg = (bfr*)(ws + WS_R + R_W); bfr* Ug = (bfr*)(ws + WS_R + R_U); bfr* QGg = (bfr*)(ws + WS_R + R_QG); bfr* KDg = (bfr*)(ws + WS_R + R_KD); bfr* QKg = (bfr*)(ws + WS_R + R_QK);
    float* EGg = (float*)(ws + WS_EG);
    LAS float* sCW = (LAS float*)(C.lds + 82944);
    for (int wq = C.vcu; wq < NB * GH * 4; wq += C.G) {
        const int bh = wq >> 2, cg = wq & 3, h = bh & 31, b = bh >> 5;
        for (int i = C.tid; i < 1536; i += 512) { const int part = i >> 9, tap = (i >> 7) & 3, ch = i & 127; sCW[i] = convw[tap * 12288 + part * 4096 + h * 128 + ch]; }
        __syncthreads();
        for (int it = 0; it < 8; ++it) {
            int tid = C.tid; asm volatile("" : "+v"(tid));
            const int hw = tid >> 8, lt = tid & 255, lane = tid & 63, lw = (tid >> 6) & 3;
            const int c = cg * 16 + it * 2 + hw, unit = bh * 64 + c, t0 = b * SEQ + c * CH;
            LAS unsigned char* hb = C.lds + hw * 41472;
            LAS unsigned char* sK = hb; LAS unsigned char* sQ = hb + 16384; LAS unsigned char* sX = hb;
            LAS unsigned char* sAM = hb + 32768; LAS float* sB = (LAS float*)(hb + 40960); LAS float* sG = (LAS float*)(hb + 41216);
            LAS float* scr = (LAS float*)(C.lds + 89088 + (tid >> 6) * 4352);
            LAS float* sAD = (LAS float*)(C.lds + 123904 + hw * 4096);
            if (lt < 64) {
                const int t = t0 + lt; const float braw = BD[(size_t)t * 64 + h], araw = BD[(size_t)t * 64 + 32 + h];
                const float beta = 1.f / (1.f + expf(-braw)); const float xx = araw + dtb[h]; const float sp = fmaxf(xx, 0.f) + log1pf(expf(-fabsf(xx)));
                float g = -expf(alog[h]) * sp;
#pragma unroll
                for (int o = 1; o < 64; o <<= 1) { const float y = __shfl_up(g, o); if (lane >= o) g += y; }
                sB[lt] = beta; sG[lt] = g;
            }
            __syncthreads();
            const int tk = lt >> 2, cs = lt & 3;
            const float beta = sB[tk], gc = sG[tk], gl = sG[63]; const float eg = expf(gc), ed = expf(gl - gc), bg = beta * eg;
            u4v kbg[4], vbt[4];
#pragma unroll
            for (int part = 0; part < 3; ++part) {
                float y[32];
#pragma unroll
                for (int i = 0; i < 32; ++i) y[i] = 0.f;
#pragma unroll
                for (int j = 0; j < 4; ++j) {
                    const int s = c * CH + tk - 3 + j;
                    if (s >= 0) {
                        const bfr* row = PROJ + (size_t)(b * SEQ + s) * 16384 + part * 4096 + h * 128 + cs * 32;
#pragma unroll
                        for (int q4 = 0; q4 < 4; ++q4) { const u4v x = *(const u4v*)(row + 8 * q4); const LAS float* wp = sCW + part * 512 + j * 128 + cs * 32 + 8 * q4;
                            const f4v w0 = *(const LAS f4v*)wp, w1 = *(const LAS f4v*)(wp + 4);
                            y[8 * q4 + 0] += bflo(x.x) * w0[0]; y[8 * q4 + 1] += bfhi(x.x) * w0[1]; y[8 * q4 + 2] += bflo(x.y) * w0[2]; y[8 * q4 + 3] += bfhi(x.y) * w0[3];
                            y[8 * q4 + 4] += bflo(x.z) * w1[0]; y[8 * q4 + 5] += bfhi(x.z) * w1[1]; y[8 * q4 + 6] += bflo(x.w) * w1[2]; y[8 * q4 + 7] += bfhi(x.w) * w1[3]; }
                    }
                }
                float ss = 0.f;
#pragma unroll
                for (int i = 0; i < 32; ++i) { y[i] = y[i] * __builtin_amdgcn_rcpf(1.f + __expf(-y[i])); ss += y[i] * y[i]; }
                if (part < 2) {
                    ss += __shfl_xor(ss, 1); ss += __shfl_xor(ss, 2);
                    const float rn = __builtin_amdgcn_rsqf(ss + EPS) * (part == 0 ? 0.08838834764831845f : 1.f); const float gs = part == 0 ? eg : ed;
                    LAS unsigned char* dstl = part == 0 ? sQ : sK; bfr* dstg = (part == 0 ? QGg : KDg) + (size_t)unit * 8192 + tk * 128 + cs * 32;
#pragma unroll
                    for (int q4 = 0; q4 < 4; ++q4) { float z[8];
#pragma unroll
                        for (int i = 0; i < 8; ++i) z[i] = y[8 * q4 + i] * rn;
                        u4v w; w.x = cvtpk(z[0], z[1]); w.y = cvtpk(z[2], z[3]); w.z = cvtpk(z[4], z[5]); w.w = cvtpk(z[6], z[7]);
                        *(LAS u4v*)(dstl + kq_off(tk, cs * 4 + q4)) = w;
                        u4v g; g.x = cvtpk(z[0] * gs, z[1] * gs); g.y = cvtpk(z[2] * gs, z[3] * gs); g.z = cvtpk(z[4] * gs, z[5] * gs); g.w = cvtpk(z[6] * gs, z[7] * gs);
                        *(u4v*)(dstg + 8 * q4) = g;
                        if (part == 1) { kbg[q4].x = cvtpk(z[0] * bg, z[1] * bg); kbg[q4].y = cvtpk(z[2] * bg, z[3] * bg); kbg[q4].z = cvtpk(z[4] * bg, z[5] * bg); kbg[q4].w = cvtpk(z[6] * bg, z[7] * bg); } }
                } else {
#pragma unroll
                    for (int q4 = 0; q4 < 4; ++q4) { vbt[q4].x = cvtpk(y[8 * q4] * beta, y[8 * q4 + 1] * beta); vbt[q4].y = cvtpk(y[8 * q4 + 2] * beta, y[8 * q4 + 3] * beta);
                        vbt[q4].z = cvtpk(y[8 * q4 + 4] * beta, y[8 * q4 + 5] * beta); vbt[q4].w = cvtpk(y[8 * q4 + 6] * beta, y[8 * q4 + 7] * beta); }
                }
            }
            __syncthreads();
            {
                const int r = lane & 15, q = lane >> 4, mt = lw;
                s8v ak[4], aq[4];
#pragma unroll
                for (int ks = 0; ks < 4; ++ks) { ak[ks] = *(const LAS s8v*)(sK + kq_off(16 * mt + r, 4 * ks + q)); aq[ks] = *(const LAS s8v*)(sQ + kq_off(16 * mt + r, 4 * ks + q)); }
                float gi[4], bi[4];
#pragma unroll
                for (int e = 0; e < 4; ++e) { gi[e] = sG[16 * mt + 4 * q + e]; bi[e] = sB[16 * mt + 4 * q + e]; }
                for (int nt = 0; nt < 4; ++nt) {
                    const int j = 16 * nt + r;
                    if (nt <= mt) {
                        f4v ck = zero_acc(), cq = zero_acc();
#pragma unroll
                        for (int ks = 0; ks < 4; ++ks) { const s8v bb = *(const LAS s8v*)(sK + kq_off(16 * nt + r, 4 * ks + q));
                            ck = __builtin_amdgcn_mfma_f32_16x16x32_bf16(ak[ks], bb, ck, 0, 0, 0); cq = __builtin_amdgcn_mfma_f32_16x16x32_bf16(aq[ks], bb, cq, 0, 0, 0); }
                        MFMA_SETTLE(ck); MFMA_SETTLE(cq);
                        const float gj = sG[j];
#pragma unroll
                        for (int e = 0; e < 4; ++e) { const int i = 16 * mt + 4 * q + e; const float dec = expf(fminf(gi[e] - gj, 0.f));
                            const float av = (i > j) ? bi[e] * ck[e] * dec : 0.f;
                            *(LAS bfr*)(sAM + xt_off(i, j >> 3) + (j & 7) * 2) = f2bf1(av);
                            if (nt == mt) sAD[mt * 256 + (4 * q + e) * 16 + r] = av;
                            QKg[(size_t)unit * 4096 + i * 64 + j] = f2bf1((i >= j) ? cq[e] * dec : 0.f); }
                    } else {
#pragma unroll
                        for (int e = 0; e < 4; ++e) QKg[(size_t)unit * 4096 + (16 * mt + 4 * q + e) * 64 + j] = (bfr)0;
                    }
                }
            }
            __syncthreads();
            {
                const int ro = ((tk >> 3)), rb = (tk & 7) * 2;
#pragma unroll
                for (int q4 = 0; q4 < 4; ++q4) {
                    const unsigned vv[4] = {vbt[q4].x, vbt[q4].y, vbt[q4].z, vbt[q4].w}, kk[4] = {kbg[q4].x, kbg[q4].y, kbg[q4].z, kbg[q4].w};
#pragma unroll
                    for (int i = 0; i < 8; ++i) { const int ch = cs * 32 + q4 * 8 + i;
                        *(LAS bfr*)(sX + xt_off(ch, ro) + rb) = (bfr)((i & 1) ? (vv[i >> 1] >> 16) : (vv[i >> 1] & 0xffffu));
                        *(LAS bfr*)(sX + xt_off(128 + ch, ro) + rb) = (bfr)((i & 1) ? (kk[i >> 1] >> 16) : (kk[i >> 1] & 0xffffu)); }
                }
            }
            __syncthreads();
            {
                const int r = lane & 15, q = lane >> 4;
                float x[64];
#pragma unroll
                for (int bk = 0; bk < 4; ++bk) {
                    float corr[16];
#pragma unroll
                    for (int i = 0; i < 16; ++i) corr[i] = 0.f;
                    if (bk > 0) {
                        f4v acc[4] = {zero_acc(), zero_acc(), zero_acc(), zero_acc()};
#pragma unroll
                        for (int ks = 0; ks < (16 * bk + 31) / 32; ++ks) {
                            s8v a = *(const LAS s8v*)(sAM + xt_off(16 * bk + r, 4 * ks + q));
                            if (32 * ks + 8 * q >= 16 * bk) a = (s8v){0, 0, 0, 0, 0, 0, 0, 0};
#pragma unroll
                            for (int nt = 0; nt < 4; ++nt) { const s8v bx = *(const LAS s8v*)(sX + xt_off(64 * lw + 16 * nt + r, 4 * ks + q)); acc[nt] = __builtin_amdgcn_mfma_f32_16x16x32_bf16(a, bx, acc[nt], 0, 0, 0); }
                        }
                        MFMA_SETTLE(acc[0]); MFMA_SETTLE(acc[1]); MFMA_SETTLE(acc[2]); MFMA_SETTLE(acc[3]);
#pragma unroll
                        for (int nt = 0; nt < 4; ++nt)
#pragma unroll
                            for (int e = 0; e < 4; ++e) scr[(16 * nt + r) * 17 + 4 * q + e] = -acc[nt][e];
                        LDS_WAIT(); asm volatile("" ::: "memory");
#pragma unroll
                        for (int i = 0; i < 16; ++i) corr[i] = scr[lane * 17 + i];
                    }
                    const u4v r0 = *(const LAS u4v*)(sX + xt_off(lt, 2 * bk)), r1 = *(const LAS u4v*)(sX + xt_off(lt, 2 * bk + 1));
                    const float rhs[16] = {bflo(r0.x), bfhi(r0.x), bflo(r0.y), bfhi(r0.y), bflo(r0.z), bfhi(r0.z), bflo(r0.w), bfhi(r0.w), bflo(r1.x), bfhi(r1.x), bflo(r1.y), bfhi(r1.y), bflo(r1.z), bfhi(r1.z), bflo(r1.w), bfhi(r1.w)};
                    float xb[16];
#pragma unroll
                    for (int i = 0; i < 16; ++i) {
                        float v = rhs[i] + corr[i];
                        const u4v a0 = *(const LAS u4v*)(sAM + xt_off(16 * bk + i, 2 * bk)), a1 = *(const LAS u4v*)(sAM + xt_off(16 * bk + i, 2 * bk + 1));
                        const float am[16] = {bflo(a0.x), bfhi(a0.x), bflo(a0.y), bfhi(a0.y), bflo(a0.z), bfhi(a0.z), bflo(a0.w), bfhi(a0.w), bflo(a1.x), bfhi(a1.x), bflo(a1.y), bfhi(a1.y), bflo(a1.z), bfhi(a1.z), bflo(a1.w), bfhi(a1.w)};
#pragma unroll
                        for (int j = 0; j < 16; ++j) if (j < i) v -= am[j] * xb[j];
                        xb[i] = v; x[16 * bk + i] = v;
                    }
                    u4v w0, w1; w0.x = cvtpk(xb[0], xb[1]); w0.y = cvtpk(xb[2], xb[3]); w0.z = cvtpk(xb[4], xb[5]); w0.w = cvtpk(xb[6], xb[7]);
                    w1.x = cvtpk(xb[8], xb[9]); w1.y = cvtpk(xb[10], xb[11]); w1.z = cvtpk(xb[12], xb[13]); w1.w = cvtpk(xb[14], xb[15]);
                    *(LAS u4v*)(sX + xt_off(lt, 2 * bk)) = w0; *(LAS u4v*)(sX + xt_off(lt, 2 * bk + 1)) = w1;
                    LDS_WAIT(); asm volatile("" ::: "memory");
                }
                bfr* dst = (lt < 128 ? Ug : Wg) + (size_t)unit * 8192 + (lt & 127);
#pragma unroll
                for (int i = 0; i < 64; ++i) dst[i * 128] = f2bf1(x[i]);
                if (lt == 0) EGg[unit] = expf(sG[63]);
            }
            __syncthreads();
        }
    }
}

__device__ __forceinline__ void p_gdn_scan(const Ctx& C, const Ptrs& P) {
    unsigned char* ws = P.ws_();
    const GAS bfr* Wg = (const GAS bfr*)(ws + WS_R + R_W); const GAS bfr* Ug = (const GAS bfr*)(ws + WS_R + R_U); const GAS bfr* QGg = (const GAS bfr*)(ws + WS_R + R_QG); const GAS bfr* KDg = (const GAS bfr*)(ws + WS_R + R_KD);
    const GAS bfr* QKg = (const GAS bfr*)(ws + WS_R + R_QK); GAS bfr* Og = (GAS bfr*)(ws + WS_R + R_O); const GAS float* EGg = (const GAS float*)(ws + WS_EG);
    const int tid = C.tid, lane = C.lane, wave = C.wave, r = lane & 15, q = lane >> 4, mt = wave & 3, nt = wave >> 2;
    LAS bfr* sST = (LAS bfr*)(C.lds + 131072); LAS bfr* sVN = (LAS bfr*)(C.lds + 139776);
#define SC_W(bb)  ((LAS bfr*)(C.lds + (bb) * 65536))
#define SC_QG(bb) ((LAS bfr*)(C.lds + (bb) * 65536 + 17408))
#define SC_KD(bb) ((LAS bfr*)(C.lds + (bb) * 65536 + 34816))
#define SC_QK(bb) ((LAS bfr*)(C.lds + (bb) * 65536 + 52224))
#define SC_U(bb)  ((LAS bfr*)(C.lds + (bb) * 65536 + 61440))
#define SC_LOAD(n) do { const size_t ub = (size_t)(bh * 64 + (n)) * 8192; \
        rW0 = *(const GAS u4v*)(Wg + ub + (size_t)tid * 8); rW1 = *(const GAS u4v*)(Wg + ub + (size_t)(tid + 512) * 8); \
        rQ0 = *(const GAS u4v*)(QGg + ub + (size_t)tid * 8); rQ1 = *(const GAS u4v*)(QGg + ub + (size_t)(tid + 512) * 8); \
        rK0 = *(const GAS u4v*)(KDg + ub + (size_t)tid * 8); rK1 = *(const GAS u4v*)(KDg + ub + (size_t)(tid + 512) * 8); \
        rQK = *(const GAS u4v*)(QKg + (size_t)(bh * 64 + (n)) * 4096 + (size_t)tid * 8); \
        if (tid < 256) rU = *(const GAS u4v*)(Ug + ub + (size_t)(tid >> 2) * 128 + es * 32 + (tid & 3) * 8); } while (0)
#define SC_WRITE(bb) do { const int c0 = tid, c1 = tid + 512; \
        *(LAS u4v*)(SC_W(bb) + (c0 >> 4) * 136 + (c0 & 15) * 8) = rW0; *(LAS u4v*)(SC_W(bb) + (c1 >> 4) * 136 + (c1 & 15) * 8) = rW1; \
        *(LAS u4v*)(SC_QG(bb) + (c0 >> 4) * 136 + (c0 & 15) * 8) = rQ0; *(LAS u4v*)(SC_QG(bb) + (c1 >> 4) * 136 + (c1 & 15) * 8) = rQ1; \
        *(LAS u4v*)(SC_KD(bb) + (c0 >> 4) * 136 + (c0 & 15) * 8) = rK0; *(LAS u4v*)(SC_KD(bb) + (c1 >> 4) * 136 + (c1 & 15) * 8) = rK1; \
        *(LAS u4v*)(SC_QK(bb) + (tid >> 3) * 72 + (tid & 7) * 8) = rQK; \
        if (tid < 256) *(LAS u4v*)(SC_U(bb) + (tid >> 2) * 32 + (tid & 3) * 8) = rU; } while (0)
    for (int task = C.vcu; task < NB * GH * 4; task += C.G) {
        const int bh = task >> 2, es = task & 3, h = bh & 31, b = bh >> 5;
        u4v rW0, rW1, rQ0, rQ1, rK0, rK1, rQK, rU = {0u, 0u, 0u, 0u};
        f4v S0 = {0.f, 0.f, 0.f, 0.f}, S1 = {0.f, 0.f, 0.f, 0.f};
        LAS float* sEG = (LAS float*)(C.lds + 144384);
        if (tid < 64) sEG[tid] = EGg[bh * 64 + tid];
        SC_LOAD(0); SC_WRITE(0); SC_LOAD(1);
        for (int n = 0; n < NCH; ++n) {
            const int bb = n & 1;
            {
                MFMA_SETTLE(S0); MFMA_SETTLE(S1);
                u2v w0, w1; w0.x = cvtpk(S0[0], S0[1]); w0.y = cvtpk(S0[2], S0[3]); w1.x = cvtpk(S1[0], S1[1]); w1.y = cvtpk(S1[2], S1[3]);
                *(LAS u2v*)(sST + (r) * 136 + 16 * wave + 4 * q) = w0; *(LAS u2v*)(sST + (16 + r) * 136 + 16 * wave + 4 * q) = w1;
            }
            __syncthreads();
            if (n + 1 < NCH) { if (bb) SC_WRITE(0); else SC_WRITE(1); if (n + 2 < NCH) SC_LOAD(n + 2); }
            f4v acc1 = zero_acc(), acc2 = zero_acc();
            const LAS bfr* pW = SC_W(bb) + (16 * mt + r) * 136 + 8 * q; const LAS bfr* pQ = SC_QG(bb) + (16 * mt + r) * 136 + 8 * q; const LAS bfr* pS = sST + (16 * nt + r) * 136 + 8 * q;
#pragma unroll
            for (int ks = 0; ks < 4; ++ks) { const s8v a1 = *(const LAS s8v*)(pW + 32 * ks), a2 = *(const LAS s8v*)(pQ + 32 * ks), bs = *(const LAS s8v*)(pS + 32 * ks);
                acc1 = __builtin_amdgcn_mfma_f32_16x16x32_bf16(a1, bs, acc1, 0, 0, 0); acc2 = __builtin_amdgcn_mfma_f32_16x16x32_bf16(a2, bs, acc2, 0, 0, 0); }
            MFMA_SETTLE(acc1);
            {
                const LAS bfr* pU = SC_U(bb) + (16 * mt + 4 * q) * 32 + 16 * nt + r;
                const float v0 = bf1(pU[0]) - acc1[0], v1 = bf1(pU[32]) - acc1[1], v2 = bf1(pU[64]) - acc1[2], v3 = bf1(pU[96]) - acc1[3];
                u2v w; w.x = cvtpk(v0, v1); w.y = cvtpk(v2, v3);
                *(LAS u2v*)(sVN + (16 * nt + r) * 72 + 16 * mt + 4 * q) = w;
            }
            __syncthreads();
            {
                const LAS bfr* pA = SC_QK(bb) + (16 * mt + r) * 72 + 8 * q; const LAS bfr* pV = sVN + (16 * nt + r) * 72 + 8 * q;
#pragma unroll
                for (int ks = 0; ks < 2; ++ks) { const s8v a = *(const LAS s8v*)(pA + 32 * ks), bv = *(const LAS s8v*)(pV + 32 * ks); acc2 = __builtin_amdgcn_mfma_f32_16x16x32_bf16(a, bv, acc2, 0, 0, 0); }
                MFMA_SETTLE(acc2);
                GAS bfr* po = Og + (size_t)(b * SEQ + n * CH + 16 * mt + 4 * q) * DM + h * 128 + es * 32 + 16 * nt + r;
                po[0] = f2bf1(acc2[0]); po[DM] = f2bf1(acc2[1]); po[2 * DM] = f2bf1(acc2[2]); po[3 * DM] = f2bf1(acc2[3]);
            }
            {
                const float eg = sEG[n];
                S0 *= eg; S1 *= eg;
                const LAS bfr* pK = SC_KD(bb) + (8 * q) * 136 + 16 * wave + r; const LAS bfr* pV0 = sVN + r * 72 + 8 * q; const LAS bfr* pV1 = sVN + (16 + r) * 72 + 8 * q;
#pragma unroll
                for (int ks = 0; ks < 2; ++ks) {
                    s8v a;
#pragma unroll
                    for (int i = 0; i < 8; ++i) a[i] = (short)pK[(32 * ks + i) * 136];
                    const s8v b0 = *(const LAS s8v*)(pV0 + 32 * ks), b1 = *(const LAS s8v*)(pV1 + 32 * ks);
                    S0 = __builtin_amdgcn_mfma_f32_16x16x32_bf16(a, b0, S0, 0, 0, 0); S1 = __builtin_amdgcn_mfma_f32_16x16x32_bf16(a, b1, S1, 0, 0, 0);
                }
            }
        }
        __syncthreads();
    }
#undef SC_W
#undef SC_QG
#undef SC_KD
#undef SC_QK
#undef SC_U
#undef SC_LOAD
#undef SC_WRITE
}

#define S2_OFF_QG 17408
#define S2_OFF_QK 34816
#define S2_OFF_KT 44032
#define S2_OFF_U  62464
#define S2_BUF    66560
__device__ __forceinline__ s8v s2_frag(const LAS bfr* rowp, int q) {
    const u2v lo = *(const LAS u2v*)(rowp + 4 * q), hi = *(const LAS u2v*)(rowp + 16 + 4 * q);
    const u4v w = {lo.x, lo.y, hi.x, hi.y}; return __builtin_bit_cast(s8v, w);
}
__device__ __forceinline__ s8v s2_fragx(const LAS bfr* rowp, int g0, int g1) {
    const u2v lo = *(const LAS u2v*)(rowp + 4 * g0), hi = *(const LAS u2v*)(rowp + 4 * g1);
    const u4v w = {lo.x, lo.y, hi.x, hi.y}; return __builtin_bit_cast(s8v, w);
}
__device__ __forceinline__ s8v s2_pack(const f4v& a, const f4v& b) { const u4v w = {cvtpk(a[0], a[1]), cvtpk(a[2], a[3]), cvtpk(b[0], b[1]), cvtpk(b[2], b[3])}; return __builtin_bit_cast(s8v, w); }
template <int MODE = 0>
__device__ __forceinline__ void p_gdn_scan2(const Ctx& C, const Ptrs& P) {
    unsigned char* ws = P.ws_();
    const GAS bfr* Wg = (const GAS bfr*)(ws + WS_R + R_W); const GAS bfr* Ug = (const GAS bfr*)(ws + WS_R + R_U); const GAS bfr* QGg = (const GAS bfr*)(ws + WS_R + R_QG); const GAS bfr* KDg = (const GAS bfr*)(ws + WS_R + R_KD);
    const GAS bfr* QKg = (const GAS bfr*)(ws + WS_R + R_QK); GAS bfr* Og = (GAS bfr*)(ws + (MODE ? WS_SC : WS_R + R_O)); const GAS float* EGg = (const GAS float*)(ws + WS_EG);
    const int tid = C.tid, lane = C.lane, wave = C.wave, r = lane & 15, q = lane >> 4;
    LAS float* sEG = (LAS float*)(C.lds + 2 * S2_BUF);
    for (int task = C.vcu; task < NB * GH * 4; task += C.G) {
        const int bh = task >> 2, es = task & 3, h = bh & 31, b = bh >> 5;
        if (tid < 64) sEG[tid] = EGg[bh * 64 + tid];
        if (wave >= 2) {
            const int lw = __builtin_amdgcn_readfirstlane((tid - 128) & ~63);
            __builtin_assume(lw >= 0 && lw <= 320);
            const GAS unsigned char* RB = (const GAS unsigned char*)(ws + WS_R);
            const unsigned l16 = lane * 16, lU = (lane >> 2) * 256 + (lane & 3) * 16 + es * 64;
            const unsigned lrow = (lane >> 4) * 272 + (lane & 15) * 16, lqk = (lane >> 3) * 144 + (lane & 7) * 16, lkt = (lane & 15) * 8 * 144 + (lane >> 4) * 2;
            const int lsw = (lane & 15) >> 1;
            u4v ra[10], rb[10];
#define S2_LOAD(R, n) do { const unsigned ua_ = (unsigned)(bh * 64 + ((MODE == 2 || MODE == 4) ? 0 : (n))) * 16384u; _Pragma("unroll") for (int k_ = 0; k_ < 10; ++k_) { const int c0_ = lw + 384 * k_; \
        if (c0_ < 1024) R[k_] = *(const GAS u4v*)(RB + (size_t)((unsigned)R_W + ua_ + c0_ * 16) + l16); \
        else if (c0_ < 2048) R[k_] = *(const GAS u4v*)(RB + (size_t)((unsigned)R_QG + ua_ + (c0_ - 1024) * 16) + l16); \
        else if (c0_ < 2560) R[k_] = *(const GAS u4v*)(RB + (size_t)((unsigned)R_QK + (ua_ >> 1) + (c0_ - 2048) * 16) + l16); \
        else if (c0_ < 2816) R[k_] = *(const GAS u4v*)(RB + (size_t)((unsigned)R_U + ua_ + ((c0_ - 2560) >> 2) * 256) + lU); \
        else R[k_] = *(const GAS u4v*)(RB + (size_t)((unsigned)R_KD + ua_ + (c0_ - 2816) * 16) + l16); } } while (0)
#define S2_WRITE(R, bb) do { LAS unsigned char* B_ = C.lds + (bb) * S2_BUF; _Pragma("unroll") for (int k_ = 0; k_ < 10; ++k_) { const int c0_ = lw + 384 * k_; \
        if (c0_ < 1024) *(LAS u4v*)(B_ + (c0_ >> 4) * 272 + lrow) = R[k_]; \
        else if (c0_ < 2048) *(LAS u4v*)(B_ + S2_OFF_QG + ((c0_ - 1024) >> 4) * 272 + lrow) = R[k_]; \
        else if (c0_ < 2560) *(LAS u4v*)(B_ + S2_OFF_QK + ((c0_ - 2048) >> 3) * 144 + lqk) = R[k_]; \
        else if (c0_ < 2816) *(LAS u4v*)(B_ + S2_OFF_U + (c0_ - 2560) * 16 + l16) = R[k_]; \
        else { const int g_ = (c0_ - 2816) >> 6; LAS bfr* kt_ = (LAS bfr*)(B_ + S2_OFF_KT + lkt + ((g_ ^ lsw) << 3)); const unsigned w_[4] = {R[k_].x, R[k_].y, R[k_].z, R[k_].w}; \
            _Pragma("unroll") for (int i_ = 0; i_ < 8; ++i_) kt_[i_ * 72] = (bfr)((i_ & 1) ? (w_[i_ >> 1] >> 16) : (w_[i_ >> 1] & 0xffffu)); } } } while (0)
            u4v rc[10];
            S2_LOAD(ra, 0); S2_WRITE(ra, 0);
            S2_LOAD(rb, 1); S2_LOAD(rc, 2); S2_LOAD(ra, 3);
            __syncthreads();
#define S2_STEP(R, bb, n_) { S2_WRITE(R, bb); S2_LOAD(R, (n_) + 4); __syncthreads(); }
            for (int n = 0; n < NCH - 4; n += 6) {
                S2_STEP(rb, 1, n) S2_STEP(rc, 0, n + 1) S2_STEP(ra, 1, n + 2) S2_STEP(rb, 0, n + 3) S2_STEP(rc, 1, n + 4) S2_STEP(ra, 0, n + 5)
            }
            static_assert((NCH - 4) % 6 == 0, "scan loader schedule");
            S2_WRITE(rb, 1); __syncthreads(); S2_WRITE(rc, 0); __syncthreads(); S2_WRITE(ra, 1); __syncthreads(); __syncthreads();
#undef S2_STEP
#undef S2_LOAD
#undef S2_WRITE
        } else {
            const int nt = wave;
            f4v S[8];
#pragma unroll
            for (int w = 0; w < 8; ++w) S[w] = zero_acc();
            __syncthreads();
            for (int n = 0; n < NCH; ++n) {
                if (MODE == 3 || MODE == 4) { __syncthreads(); continue; }
                const LAS unsigned char* B = C.lds + (n & 1) * S2_BUF;
                const LAS bfr* sW = (const LAS bfr*)B; const LAS bfr* sQG = (const LAS bfr*)(B + S2_OFF_QG); const LAS bfr* sQK = (const LAS bfr*)(B + S2_OFF_QK);
                const LAS bfr* sKT = (const LAS bfr*)(B + S2_OFF_KT); const LAS bfr* sU = (const LAS bfr*)(B + S2_OFF_U);
#define S2_STAGE() asm volatile("" ::: "memory")
#define S2_LOADQ(F, mt) do { _Pragma("unroll") for (int ks = 0; ks < 4; ++ks) { F[ks] = s2_frag(sW + (16 * (mt) + r) * 136 + 32 * ks, q); F[4 + ks] = s2_frag(sQG + (16 * (mt) + r) * 136 + 32 * ks, q); } } while (0)
#define S2_MMQ(F, mt) do { _Pragma("unroll") for (int ks = 0; ks < 4; ++ks) { a1[mt] = __builtin_amdgcn_mfma_f32_16x16x32_bf16(F[ks], Bs[ks], a1[mt], 0, 0, 0); \
        a2[mt] = __builtin_amdgcn_mfma_f32_16x16x32_bf16(F[4 + ks], Bs[ks], a2[mt], 0, 0, 0); } } while (0)
                s8v fA[8], fB[8];
                S2_LOADQ(fA, 0); S2_LOADQ(fB, 1);
                s8v Bs[4];
#pragma unroll
                for (int ks = 0; ks < 4; ++ks) Bs[ks] = s2_pack(S[2 * ks], S[2 * ks + 1]);
                f4v a1[4], a2[4];
#pragma unroll
                for (int mt = 0; mt < 4; ++mt) { a1[mt] = zero_acc(); a2[mt] = zero_acc(); }
                S2_STAGE();
                S2_MMQ(fA, 0); S2_STAGE(); S2_LOADQ(fA, 2); S2_STAGE();
                S2_MMQ(fB, 1); S2_STAGE(); S2_LOADQ(fB, 3);
                bfr ur[16]; s8v fa[8];
#pragma unroll
                for (int mt = 0; mt < 4; ++mt) { const LAS bfr* pU = sU + (16 * mt + 4 * q) * 32 + 16 * nt + r; ur[4 * mt] = pU[0]; ur[4 * mt + 1] = pU[32]; ur[4 * mt + 2] = pU[64]; ur[4 * mt + 3] = pU[96]; }
                S2_STAGE();
                S2_MMQ(fA, 2); S2_STAGE();
#pragma unroll
                for (int mt = 0; mt < 4; ++mt)
#pragma unroll
                    for (int k2 = 0; k2 < 2; ++k2) fa[2 * mt + k2] = s2_frag(sQK + (16 * mt + r) * 72 + 32 * k2, q);
                S2_STAGE();
                S2_MMQ(fB, 3); S2_STAGE();
#undef S2_LOADQ
#undef S2_MMQ
                s8v fk[16];
#pragma unroll
                for (int w = 0; w < 8; ++w)
#pragma unroll
                    for (int k2 = 0; k2 < 2; ++k2) fk[2 * w + k2] = s2_fragx(sKT + (16 * w + r) * 72 + 32 * k2, q ^ w, (4 + q) ^ w);
                const float eg = sEG[n];
                S2_STAGE();
                f4v vn[4];
#pragma unroll
                for (int mt = 0; mt < 4; ++mt) vn[mt] = (f4v){bf1(ur[4 * mt]) - a1[mt][0], bf1(ur[4 * mt + 1]) - a1[mt][1], bf1(ur[4 * mt + 2]) - a1[mt][2], bf1(ur[4 * mt + 3]) - a1[mt][3]};
                s8v Bv[2];
#pragma unroll
                for (int k2 = 0; k2 < 2; ++k2) Bv[k2] = s2_pack(vn[2 * k2], vn[2 * k2 + 1]);
#pragma unroll
                for (int k2 = 0; k2 < 2; ++k2)
#pragma unroll
                    for (int mt = 0; mt < 4; ++mt) a2[mt] = __builtin_amdgcn_mfma_f32_16x16x32_bf16(fa[2 * mt + k2], Bv[k2], a2[mt], 0, 0, 0);
#pragma unroll
                for (int w = 0; w < 8; ++w) S[w] *= eg;
#pragma unroll
                for (int k2 = 0; k2 < 2; ++k2)
#pragma unroll
                    for (int w = 0; w < 8; ++w) S[w] = __builtin_amdgcn_mfma_f32_16x16x32_bf16(fk[2 * w + k2], Bv[k2], S[w], 0, 0, 0);
#pragma unroll
                for (int mt = 0; mt < 4; ++mt) {
                    GAS bfr* po = Og + (size_t)(b * SEQ + n * CH + 16 * mt + 4 * q) * DM + h * 128 + es * 32 + 16 * nt + r;
                    po[0] = f2bf1(a2[mt][0]); po[DM] = f2bf1(a2[mt][1]); po[2 * DM] = f2bf1(a2[mt][2]); po[3 * DM] = f2bf1(a2[mt][3]); }
#undef S2_STAGE
                MFMA_SETTLE(S[7]);
                __syncthreads();
            }
        }
        __syncthreads();
    }
}
#undef S2_OFF_QG
#undef S2_OFF_QK
#undef S2_OFF_KT
#undef S2_OFF_U
#undef S2_BUF

__device__ __forceinline__ void p_gdn_onorm(const Ctx& C, const Ptrs& P) {
    unsigned char* ws = P.ws_(); const bfr* Og = (const bfr*)(ws + WS_R + R_O); const bfr* PROJ = (const bfr*)(ws + WS_BIG); bfr* AO = (bfr*)(ws + WS_XN); const float* og = P.in_(6);
    const size_t gt = (size_t)C.vcu * 512 + C.tid, GT = (size_t)C.G * 512;
    for (size_t idx0 = gt; idx0 < (size_t)NT * DM / 8; idx0 += 4 * GT) {
        u4v o8[4], z8[4];
#pragma unroll
        for (int b4 = 0; b4 < 4; ++b4) { const size_t idx = idx0 + b4 * GT; const size_t t = idx >> 9; const int hh = (int)(idx >> 4) & 31, i = (int)idx & 15;
            o8[b4] = *(const u4v*)(Og + t * DM + hh * 128 + 8 * i); z8[b4] = *(const u4v*)(PROJ + t * 16384 + 12288 + hh * 128 + 8 * i); }
        const int i = (int)idx0 & 15;
        const f4v g0 = *(const f4v*)(og + 8 * i), g1 = *(const f4v*)(og + 8 * i + 4); const float g[8] = {g0[0], g0[1], g0[2], g0[3], g1[0], g1[1], g1[2], g1[3]};
#pragma unroll
        for (int b4 = 0; b4 < 4; ++b4) { const size_t idx = idx0 + b4 * GT; const size_t t = idx >> 9; const int hh = (int)(idx >> 4) & 31;
            float o[8] = {bflo(o8[b4].x), bfhi(o8[b4].x), bflo(o8[b4].y), bfhi(o8[b4].y), bflo(o8[b4].z), bfhi(o8[b4].z), bflo(o8[b4].w), bfhi(o8[b4].w)};
            float z[8] = {bflo(z8[b4].x), bfhi(z8[b4].x), bflo(z8[b4].y), bfhi(z8[b4].y), bflo(z8[b4].z), bfhi(z8[b4].z), bflo(z8[b4].w), bfhi(z8[b4].w)};
            float ss = 0.f;
#pragma unroll
            for (int k = 0; k < 8; ++k) ss += o[k] * o[k];
            ss += __shfl_xor(ss, 1); ss += __shfl_xor(ss, 2); ss += __shfl_xor(ss, 4); ss += __shfl_xor(ss, 8);
            const float rn = __builtin_amdgcn_rsqf(ss * (1.f / 128.f) + EPS);
            float y[8];
#pragma unroll
            for (int k = 0; k < 8; ++k) y[k] = o[k] * rn * g[k] * (z[k] * __builtin_amdgcn_rcpf(1.f + __expf(-z[k])));
#if F8_OUT0
#pragma unroll
            for (int k = 0; k < 8; ++k) y[k] = fminf(fmaxf(y[k] * SO, -440.f), 440.f);
            u2v w; w.x = cvt4_fp8(y[0], y[1], y[2], y[3]); w.y = cvt4_fp8(y[4], y[5], y[6], y[7]);
            *(u2v*)(ws + WS_XN8 + t * DM + hh * 128 + 8 * i) = w; }
#else
            u4v w; w.x = cvtpk(y[0], y[1]); w.y = cvtpk(y[2], y[3]); w.z = cvtpk(y[4], y[5]); w.w = cvtpk(y[6], y[7]);
            *(u4v*)(AO + t * DM + hh * 128 + 8 * i) = w; }
#endif
    }
}
__device__ __forceinline__ unsigned mono_key(float x) { const unsigned u = __float_as_uint(x); return u ^ ((unsigned)((int)u >> 31) | 0x80000000u); }
#define KEY_INS(K, key) do { unsigned x_ = (key); _Pragma("unroll") for (int s_ = 0; s_ < 16; ++s_) { const unsigned hi_ = max(K[s_], x_); x_ = min(K[s_], x_); K[s_] = hi_; } } while (0)
__device__ __forceinline__ void p_route(const Ctx& C, const Ptrs& P) {
    unsigned char* ws = P.ws_(); const float* SC = (const float*)(ws + WS_SC); bfr* G = (bfr*)(ws + WS_G);
    LAS unsigned char* wl = C.lds + C.wave * 16384;
    LAS int* sE = (LAS int*)(wl); LAS float* sGt = (LAS float*)(wl + 2048); LAS float* sV1 = (LAS float*)(wl + 4096); LAS float* sV2 = (LAS float*)(wl + 8192); LAS int* sI = (LAS int*)(wl + 12288);
    const int lane = C.lane, gw = C.vcu * 8 + C.wave, NGW = C.G * 8;
    for (int wt = gw; wt < NT / 4; wt += NGW) {
        const int tl = lane >> 4, t = wt * 4 + tl;
        unsigned k1[16];
#pragma unroll
        for (int i = 0; i < 16; ++i) k1[i] = 0u;
        const float* base = SC + (size_t)t * PQ + (lane & 15) * 128;
        for (int e = 0; e < 128; e += 4) { const f4v x4 = *(const f4v*)(base + e);
            KEY_INS(k1, (mono_key(x4[0]) & ~127u) | (unsigned)(127 - e)); KEY_INS(k1, (mono_key(x4[1]) & ~127u) | (unsigned)(126 - e));
            KEY_INS(k1, (mono_key(x4[2]) & ~127u) | (unsigned)(125 - e)); KEY_INS(k1, (mono_key(x4[3]) & ~127u) | (unsigned)(124 - e)); }
        const bool h0 = (lane & 1) == 0;
        float v1[16], v2[16];
#pragma unroll
        for (int i = 0; i < 16; ++i) { const int id = 127 - (int)(k1[i] & 127u); const float vv = base[id];
            const float ov = __shfl_xor(vv, 1); const int oi = __shfl_xor(id, 1);
            v1[i] = h0 ? vv : ov; v2[i] = h0 ? ov : vv; const int ia = h0 ? id : oi, ib = h0 ? oi : id;
            sV1[i * 64 + lane] = v1[i]; sV2[i * 64 + lane] = v2[i]; sI[i * 64 + lane] = ia | (ib << 8); }
        unsigned k2[16];
#pragma unroll
        for (int i = 0; i < 16; ++i) k2[i] = 0u;
#pragma unroll
        for (int a = 0; a < 16; ++a)
#pragma unroll
            for (int b = 0; b < 16; ++b)
                if ((a + 1) * (b + 1) <= 16) KEY_INS(k2, (mono_key(v1[a] + v2[b]) & ~255u) | (unsigned)(255 - (a * 16 + b)));
        LDS_WAIT(); asm volatile("" ::: "memory");
        float ts[16]; int te[16]; float mx = -__builtin_inff();
#pragma unroll
        for (int i = 0; i < 16; ++i) { const int code = 255 - (int)(k2[i] & 255u), a = code >> 4, b = code & 15;
            ts[i] = sV1[a * 64 + lane] + sV2[b * 64 + lane]; te[i] = (sI[a * 64 + lane] & 0xff) * 128 + (sI[b * 64 + lane] >> 8); mx = fmaxf(mx, ts[i]); }
        float sum = 0.f;
#pragma unroll
        for (int i = 0; i < 16; ++i) { ts[i] = __expf(ts[i] - mx); sum += ts[i]; }
        const float inv = 1.f / sum;
        if (h0) { const int hb = ((lane >> 1) & 7) * 16;
#pragma unroll
            for (int i = 0; i < 16; ++i) { sE[tl * 128 + hb + i] = te[i]; sGt[tl * 128 + hb + i] = ts[i] * inv; } }
        LDS_WAIT(); asm volatile("" ::: "memory");
        for (int k = 0; k < 4; ++k) {
            const size_t tt = (size_t)wt * 4 + k; u4v* row = (u4v*)(G + tt * PE); const u4v z = {0u, 0u, 0u, 0u};
#pragma unroll 8
            for (int j = 0; j < 32; ++j) row[j * 64 + lane] = z;
            const int e0 = sE[k * 128 + lane], e1 = sE[k * 128 + 64 + lane]; float t0 = 0.f, t1 = 0.f; bool f0 = true, f1 = true;
            for (int j = 0; j < 128; j += 4) { const i4v ej = *(const LAS i4v*)(sE + k * 128 + j); const f4v gj = *(const LAS f4v*)(sGt + k * 128 + j);
                if (ej.x == e0) { t0 += gj[0]; if (j + 0 < lane) f0 = false; } if (ej.y == e0) { t0 += gj[1]; if (j + 1 < lane) f0 = false; }
                if (ej.z == e0) { t0 += gj[2]; if (j + 2 < lane) f0 = false; } if (ej.w == e0) { t0 += gj[3]; if (j + 3 < lane) f0 = false; }
                if (ej.x == e1) { t1 += gj[0]; if (j + 0 < lane + 64) f1 = false; } if (ej.y == e1) { t1 += gj[1]; if (j + 1 < lane + 64) f1 = false; }
                if (ej.z == e1) { t1 += gj[2]; if (j + 2 < lane + 64) f1 = false; } if (ej.w == e1) { t1 += gj[3]; if (j + 3 < lane + 64) f1 = false; } }
            VM_WAIT();
            if (f0) G[tt * PE + e0] = f2bf1(t0);
            if (f1) G[tt * PE + e1] = f2bf1(t1);
        }
        LDS_WAIT(); asm volatile("" ::: "memory");
    }
}

typedef _Float16 h2v __attribute__((ext_vector_type(2)));
__device__ __forceinline__ void p_sroute(const Ctx& C, const Ptrs& P, int layer) {
    unsigned char* ws = P.ws_(); const bfr* QRY = (const bfr*)(ws + WS_QRY); const bfr* KEY = (const bfr*)(ws + WS_WTKEY) + (size_t)layer * PQ * PQ; bfr* G = (bfr*)(ws + WS_G);
    const int lane = C.lane, wave = C.wave, r = lane & 15, q = lane >> 4;
    LAS unsigned char* wl = C.lds + wave * 16640;
    LAS _Float16* sS = (LAS _Float16*)wl;
    LAS float* sV1 = (LAS float*)(wl); LAS float* sV2 = (LAS float*)(wl + 4096); LAS int* sI = (LAS int*)(wl + 8192);
    LAS int* sE = (LAS int*)(C.lds); LAS float* sGt = (LAS float*)(C.lds + 16384);
    LAS unsigned* bm = (LAS unsigned*)(C.lds + 32768 + wave * 3200); LAS unsigned* cnt = bm + 512; LAS int* le = (LAS int*)(bm + 516); LAS float* lg = (LAS float*)(bm + 516 + 128);
    for (int blk = C.vcu; blk < NT / 32; blk += C.G) {
        const int t0 = blk * 32;
#pragma unroll
        for (int hf = 0; hf < 2; ++hf) {
            const int hh = wave * 2 + hf;
            s8v a[2][4];
#pragma unroll
            for (int mt = 0; mt < 2; ++mt)
#pragma unroll
                for (int ks = 0; ks < 4; ++ks) a[mt][ks] = *(const s8v*)(QRY + (size_t)(t0 + 16 * mt + r) * PQ + hh * 128 + 32 * ks + 8 * q);
#pragma unroll
            for (int nt = 0; nt < 8; ++nt) {
                s8v b[4];
#pragma unroll
                for (int ks = 0; ks < 4; ++ks) b[ks] = *(const s8v*)(KEY + (size_t)(hh * 128 + 16 * nt + r) * PQ + hh * 128 + 32 * ks + 8 * q);
                f4v c0 = zero_acc(), c1 = zero_acc();
#pragma unroll
                for (int ks = 0; ks < 4; ++ks) { c0 = __builtin_amdgcn_mfma_f32_16x16x32_bf16(a[0][ks], b[ks], c0, 0, 0, 0); c1 = __builtin_amdgcn_mfma_f32_16x16x32_bf16(a[1][ks], b[ks], c1, 0, 0, 0); MFMA_SETTLE(c0); MFMA_SETTLE(c1); }
                MFMA_SETTLE(c0); MFMA_SETTLE(c1);
#pragma unroll
                for (int e = 0; e < 4; ++e) { sS[(32 * hf + 4 * q + e) * 130 + 16 * nt + r] = (_Float16)c0[e]; sS[(32 * hf + 16 + 4 * q + e) * 130 + 16 * nt + r] = (_Float16)c1[e]; }
            }
        }
        LDS_WAIT(); asm volatile("" ::: "memory");
        unsigned k1[16];
#pragma unroll
        for (int i = 0; i < 16; ++i) k1[i] = 0u;
        const LAS h2v* lp = (const LAS h2v*)(sS + lane * 130);
        for (int e = 0; e < 128; e += 8) {
#pragma unroll
            for (int u = 0; u < 4; ++u) { const h2v x2 = lp[(e >> 1) + u];
                KEY_INS(k1, (mono_key((float)x2[0]) & ~127u) | (unsigned)(127 - e - 2 * u)); KEY_INS(k1, (mono_key((float)x2[1]) & ~127u) | (unsigned)(126 - e - 2 * u)); }
        }
        const bool h0 = lane < 32;
        float v1[16], v2[16]; int ids[16]; float vals[16];
#pragma unroll
        for (int i = 0; i < 16; ++i) { ids[i] = 127 - (int)(k1[i] & 127u); vals[i] = (float)sS[lane * 130 + ids[i]]; }
        LDS_WAIT(); asm volatile("" ::: "memory");
#pragma unroll
        for (int i = 0; i < 16; ++i) { const float ov = __shfl_xor(vals[i], 32); const int oi = __shfl_xor(ids[i], 32);
            v1[i] = h0 ? vals[i] : ov; v2[i] = h0 ? ov : vals[i]; const int ia = h0 ? ids[i] : oi, ib = h0 ? oi : ids[i];
            sV1[i * 64 + lane] = v1[i]; sV2[i * 64 + lane] = v2[i]; sI[i * 64 + lane] = ia | (ib << 8); }
        unsigned k2[16];
#pragma unroll
        for (int b = 0; b < 16; ++b) k2[b] = (mono_key(v1[0] + v2[b]) & ~255u) | (unsigned)(255 - b);
#pragma unroll
        for (int a = 1; a < 16; ++a)
#pragma unroll
            for (int b = 0; b < 16; ++b)
                if ((a + 1) * (b + 1) <= 16) KEY_INS(k2, (mono_key(v1[a] + v2[b]) & ~255u) | (unsigned)(255 - (a * 16 + b)));
        LDS_WAIT(); asm volatile("" ::: "memory");
        float ts[16]; int te[16]; float mx = -__builtin_inff();
#pragma unroll
        for (int i = 0; i < 16; ++i) { const int code = 255 - (int)(k2[i] & 255u), a = code >> 4, b = code & 15;
            ts[i] = sV1[a * 64 + lane] + sV2[b * 64 + lane]; te[i] = (sI[a * 64 + lane] & 0xff) * 128 + (sI[b * 64 + lane] >> 8); mx = fmaxf(mx, ts[i]); }
        float sum = 0.f;
#pragma unroll
        for (int i = 0; i < 16; ++i) { ts[i] = __expf(ts[i] - mx); sum += ts[i]; }
        const float inv = 1.f / sum;
        __syncthreads();
        if (h0) {
#pragma unroll
            for (int i = 0; i < 16; ++i) { sE[lane * 128 + wave * 16 + i] = te[i]; sGt[lane * 128 + wave * 16 + i] = ts[i] * inv; } }
        __syncthreads();
        for (int k = 0; k < 4; ++k) {
            const int tl = wave * 4 + k; const size_t tt = (size_t)t0 + tl;
            if (layer == 0) { u4v* row = (u4v*)(G + tt * PE); const u4v z = {0u, 0u, 0u, 0u};
#pragma unroll 8
                for (int j = 0; j < 32; ++j) row[j * 64 + lane] = z; }
            const int e0 = sE[tl * 128 + lane], e1 = sE[tl * 128 + 64 + lane]; float t0s = sGt[tl * 128 + lane], t1s = sGt[tl * 128 + 64 + lane];
#pragma unroll
            for (int j = 0; j < 8; ++j) bm[j * 64 + lane] = 0u;
            if (lane == 0) *cnt = 0u;
            LDS_WAIT(); asm volatile("" ::: "memory");
            const unsigned b0 = 1u << (e0 & 31), b1 = 1u << (e1 & 31);
            const bool d0 = (__hip_atomic_fetch_or(bm + (e0 >> 5), b0, __ATOMIC_RELAXED, __HIP_MEMORY_SCOPE_WORKGROUP) & b0) != 0u;
            const bool d1 = (__hip_atomic_fetch_or(bm + (e1 >> 5), b1, __ATOMIC_RELAXED, __HIP_MEMORY_SCOPE_WORKGROUP) & b1) != 0u;
            if (d0) { const unsigned sl = __hip_atomic_fetch_add(cnt, 1u, __ATOMIC_RELAXED, __HIP_MEMORY_SCOPE_WORKGROUP); le[sl] = e0; lg[sl] = t0s; }
            if (d1) { const unsigned sl = __hip_atomic_fetch_add(cnt, 1u, __ATOMIC_RELAXED, __HIP_MEMORY_SCOPE_WORKGROUP); le[sl] = e1; lg[sl] = t1s; }
            LDS_WAIT(); asm volatile("" ::: "memory");
            const int nd = (int)__builtin_amdgcn_readfirstlane((int)*cnt);
            for (int j = 0; j < nd; ++j) { const int ej = le[j]; const float gj = lg[j]; if (ej == e0 && !d0) t0s += gj; if (ej == e1 && !d1) t1s += gj; }
            const bool f0 = !d0, f1 = !d1;
            VM_WAIT();
            if (f0) G[tt * PE + e0] = f2bf1(t0s);
            if (f1) G[tt * PE + e1] = f2bf1(t1s);
        }
        __syncthreads();
    }
}

constexpr int KIND_V = F8_KVQ ? 2 : 1;
__device__ __forceinline__ void p_headprep(const Ctx& C, const Ptrs& P) {
    unsigned char* ws = P.ws_(); const bfr* KVQ = (const bfr*)(ws + WS_BIG); bfr* Qh = (bfr*)(ws + WS_R + R_QH); bfr* Kh = (bfr*)(ws + WS_R + R_KH); bfr* Vh = (bfr*)(ws + WS_R + R_VH);
    const float* kg = P.in_(10); const float* qg = P.in_(13);
    const size_t gt = (size_t)C.vcu * 512 + C.tid, GT = (size_t)C.G * 512;
    for (size_t idx0 = gt; idx0 < (size_t)NT * 1536; idx0 += 4 * GT) {
        u4v x8[4];
#pragma unroll
        for (int b4 = 0; b4 < 4; ++b4) { const size_t idx = idx0 + b4 * GT; const size_t t = idx / 1536; const int rem = (int)(idx - t * 1536), vec = rem >> 4, i = rem & 15;
            x8[b4] = *(const u4v*)(KVQ + t * 12288 + vec * 128 + 8 * i); }
#pragma unroll
        for (int b4 = 0; b4 < 4; ++b4) { const size_t idx = idx0 + b4 * GT; const size_t t = idx / 1536; const int rem = (int)(idx - t * 1536), vec = rem >> 4, i = rem & 15, kind = vec >> 5, sh = vec & 31;
            float x[8] = {bflo(x8[b4].x), bfhi(x8[b4].x), bflo(x8[b4].y), bfhi(x8[b4].y), bflo(x8[b4].z), bfhi(x8[b4].z), bflo(x8[b4].w), bfhi(x8[b4].w)};
            float ss = 0.f;
#pragma unroll
            for (int k = 0; k < 8; ++k) ss += x[k] * x[k];
            ss += __shfl_xor(ss, 1); ss += __shfl_xor(ss, 2); ss += __shfl_xor(ss, 4); ss += __shfl_xor(ss, 8);
            u4v w = x8[b4];
            if (kind != KIND_V) { const float rn = __builtin_amdgcn_rsqf(ss * (1.f / 128.f) + EPS); const float* gp = (kind == 0 ? kg : qg) + 8 * i; const f4v g0 = *(const f4v*)gp, g1 = *(const f4v*)(gp + 4);
                w.x = cvtpk(x[0] * rn * g0[0], x[1] * rn * g0[1]); w.y = cvtpk(x[2] * rn * g0[2], x[3] * rn * g0[3]); w.z = cvtpk(x[4] * rn * g1[0], x[5] * rn * g1[1]); w.w = cvtpk(x[6] * rn * g1[2], x[7] * rn * g1[3]); }
            const size_t b = t >> 12, s = t & 4095; bfr* dst = (kind == 0 ? Kh : (kind == KIND_V ? Vh : Qh)) + ((b * 32 + sh) * SEQ + s) * 128 + 8 * i;
            *(u4v*)dst = w; }
    }
}

__device__ __forceinline__ att::BlockRef<att::bf16, att::bf16> attn_ref(const att::bf16* Qh, const att::bf16* Kh, const att::bf16* Vh, att::bf16* Oh, int bhp, int qb) {
    const int b = bhp >> 6, hd = (bhp >> 2) & 15, c = (bhp >> 1) & 1, vh = bhp & 1;
    att::BlockRef<att::bf16, att::bf16> r;
    r.Q = Qh + ((size_t)(b * 32 + hd * 2 + c) * SEQ + (size_t)qb * 256) * 128; r.K = Kh + (size_t)(b * 32 + hd * 2 + c) * SEQ * 128; r.V = Vh + (size_t)(b * 32 + hd * 2 + vh) * SEQ * 128;
    r.O = Oh + ((size_t)bhp * SEQ + (size_t)qb * 256) * 128; r.P0 = qb * 256;
    return r;
}
__device__ __forceinline__ void p_attn(const Ctx& C, const Ptrs& P) {
    unsigned char* ws = P.ws_(); const att::bf16* Qh = (const att::bf16*)(ws + WS_R + R_QH); const att::bf16* Kh = (const att::bf16*)(ws + WS_R + R_KH); const att::bf16* Vh = (const att::bf16*)(ws + WS_R + R_VH);
    att::bf16* Oh = (att::bf16*)(ws + WS_R + R_OH);
    extern __shared__ __attribute__((aligned(16))) char lds_sym[]; char* lds = lds_sym;
    constexpr int total = 128 * 8;
    int L = C.vcu; if (L >= total) return;
    int pass = 0;
    att::BlockRef<att::bf16, att::bf16> cur = attn_ref(Qh, Kh, Vh, Oh, L >> 3, L & 7);
    att::Seam<att::bf16> S;
    att::causal_swa_prime<att::bf16, att::bf16>(cur, SEQ, lds, S);
    for (;;) {
        const bool more_pass = pass == 0, more_item = L + C.G < total, last = !more_pass && !more_item;
        int passn = pass + 1, Ln = L;
        if (!more_pass) { passn = 0; Ln = more_item ? L + C.G : L; }
        const att::BlockRef<att::bf16, att::bf16> nxt = last ? cur : attn_ref(Qh, Kh, Vh, Oh, Ln >> 3, passn ? 15 - (Ln & 7) : (Ln & 7));
        att::causal_swa_block<att::bf16, att::bf16>(cur, nxt, SEQ, SEQ, lds, S);
        if (last) break;
        cur = nxt; pass = passn; L = Ln;
    }
    __syncthreads();
}

__device__ __forceinline__ void p_combine(const Ctx& C, const Ptrs& P) {
    unsigned char* ws = P.ws_(); const bfr* Oh = (const bfr*)(ws + WS_R + R_OH); bfr* AO = (bfr*)(ws + WS_XN); const float* sg = P.in_(18);
    float lam;
    { const float* q1 = P.in_(14); const float* k1 = P.in_(15); const float* q2 = P.in_(16); const float* k2 = P.in_(17); const int l = C.lane;
      const float d1 = wave_sum(q1[l] * k1[l] + q1[l + 64] * k1[l + 64]), d2 = wave_sum(q2[l] * k2[l] + q2[l + 64] * k2[l + 64]);
      lam = expf(d1) - expf(d2) + LAMBDA_INIT; }
    const size_t gt = (size_t)C.vcu * 512 + C.tid, GT = (size_t)C.G * 512;
    for (size_t idx0 = gt; idx0 < (size_t)NT * 512; idx0 += 4 * GT) {
        u4v a8[4], b8[4];
#pragma unroll
        for (int b4 = 0; b4 < 4; ++b4) { const size_t idx = idx0 + b4 * GT; const size_t t = idx >> 9, b = t >> 12, s = t & 4095; const int hd = (int)(idx >> 5) & 15, i = (int)idx & 31, vh = i >> 4, d = (8 * i) & 127;
            const size_t o0i = ((((b * 16 + hd) * 2 + 0) * 2 + vh) * SEQ + s) * 128 + d, o1i = ((((b * 16 + hd) * 2 + 1) * 2 + vh) * SEQ + s) * 128 + d;
            a8[b4] = *(const u4v*)(Oh + o0i); b8[b4] = *(const u4v*)(Oh + o1i); }
        const int i = (int)idx0 & 31;
        const f4v g0 = *(const f4v*)(sg + 8 * i), g1 = *(const f4v*)(sg + 8 * i + 4);
#pragma unroll
        for (int b4 = 0; b4 < 4; ++b4) { const size_t idx = idx0 + b4 * GT; const size_t t = idx >> 9; const int hd = (int)(idx >> 5) & 15;
            float o[8] = {bflo(a8[b4].x) - lam * bflo(b8[b4].x), bfhi(a8[b4].x) - lam * bfhi(b8[b4].x), bflo(a8[b4].y) - lam * bflo(b8[b4].y), bfhi(a8[b4].y) - lam * bfhi(b8[b4].y),
                          bflo(a8[b4].z) - lam * bflo(b8[b4].z), bfhi(a8[b4].z) - lam * bfhi(b8[b4].z), bflo(a8[b4].w) - lam * bflo(b8[b4].w), bfhi(a8[b4].w) - lam * bfhi(b8[b4].w)};
            float ss = 0.f;
#pragma unroll
            for (int k = 0; k < 8; ++k) ss += o[k] * o[k];
            ss += __shfl_xor(ss, 1); ss += __shfl_xor(ss, 2); ss += __shfl_xor(ss, 4); ss += __shfl_xor(ss, 8); ss += __shfl_xor(ss, 16);
            const float rn = __builtin_amdgcn_rsqf(ss * (1.f / 256.f) + EPS) * (1.f - LAMBDA_INIT);
#if F8_OUT1
            const float rs = rn * SO; float y[8] = {o[0] * rs * g0[0], o[1] * rs * g0[1], o[2] * rs * g0[2], o[3] * rs * g0[3], o[4] * rs * g1[0], o[5] * rs * g1[1], o[6] * rs * g1[2], o[7] * rs * g1[3]};
#pragma unroll
            for (int k = 0; k < 8; ++k) y[k] = fminf(fmaxf(y[k], -440.f), 440.f);
            u2v w; w.x = cvt4_fp8(y[0], y[1], y[2], y[3]); w.y = cvt4_fp8(y[4], y[5], y[6], y[7]);
            *(u2v*)(ws + WS_XN8 + t * DM + hd * 256 + 8 * i) = w; }
#else
            u4v w; w.x = cvtpk(o[0] * rn * g0[0], o[1] * rn * g0[1]); w.y = cvtpk(o[2] * rn * g0[2], o[3] * rn * g0[3]); w.z = cvtpk(o[4] * rn * g1[0], o[5] * rn * g1[1]); w.w = cvtpk(o[6] * rn * g1[2], o[7] * rn * g1[3]);
            *(u4v*)(AO + t * DM + hd * 256 + 8 * i) = w; }
#endif
    }
}
constexpr int NPH_LAYER = 13, NPHASE = 1 + 2 * NPH_LAYER;
#ifndef MK_PER_PHASE
#define MK_PER_PHASE 0
#endif

__global__ void __launch_bounds__(512, 2) trunk_fwd(KArgs KA) {
    extern __shared__ __attribute__((aligned(16))) unsigned char lds_raw[];
    Ctx C; C.lds = (LAS unsigned char*)lds_raw; C.tid = threadIdx.x; C.lane = C.tid & 63; C.wave = __builtin_amdgcn_readfirstlane(C.tid >> 6);
    C.G = gridDim.x; { const int bx = blockIdx.x; C.vcu = (C.G % 8 == 0) ? (bx % 8) * (C.G / 8) + bx / 8 : bx; }
    volatile LAS unsigned* MISC = (volatile LAS unsigned*)(C.lds + MISC_OFF);
    for (int u = C.tid; u < (LDS_BYTES - MISC_OFF) / 4; u += 512) MISC[u] = 0u;
    __syncthreads();
    Ptrs P; P.tbl = (LAS unsigned long long*)(C.lds + MISC_OFF + 128);
    if (C.tid < 28) P.tbl[C.tid] = ((const unsigned long long*)&KA)[C.tid];
    __syncthreads();
    unsigned* ctl = (unsigned*)(P.ws_() + WS_CTL);
    const int lo = KA.ph_lo, hi = KA.ph_hi;
    XcdBarrier bar; bar.bar = ctl + CW_BAR + KA.li * XCD_BAR_WORDS; bar.x = 0; bar.st = MISC + 8;
    if (hi - lo > 1) bar = xcd_barrier_post(ctl + CW_BAR + KA.li * XCD_BAR_WORDS, MISC + 8);
#define IN(k) (lo <= (k) && (k) < hi)
#define SEAM(k) do { if (IN(k) && IN((k) + 1)) xcd_barrier(bar); } while (0)
    unsigned char* ws = P.ws_();
    bfr* XN = (bfr*)(ws + WS_XN); bfr* BIG = (bfr*)(ws + WS_BIG);
    const int hb = (int)blockIdx.x;

    if (IN(0)) { p_convert(C, P); __syncthreads();
        p_norm_rows(C, P.in_(0), XN, F8_PROJ0 != 0 ? ws + WS_XN8 : nullptr); }
    SEAM(0);
    {
        constexpr int layer = 0;
        const int pb = 1 + layer * NPH_LAYER;
        if (layer == 1 && IN(pb + 0)) p_norm_rows(C, (const float*)P.out_(), XN, F8_KVQ != 0 ? ws + WS_XN8 : nullptr);
        if (layer == 1) SEAM(pb + 0);
        if (IN(pb + 1)) {
            const int N = layer == 0 ? 16384 : 12288;
            if (layer == 0 && F8_PROJ0 == 2) {
                { pg8::Gemm g{XN, (const bfr*)(ws + WS_WTIN), NT, 8192, DM}; pg8::StaticOrder S; S.init(NT, 8192, C.G, hb);
                  pg8::EpiBf16<0> E{BIG, N, nullptr, 0, 0, 1.f};
                  pg8::gemm_phase<pg8::EpiBf16<0>, pg8::StaticOrder, true, true>((PG8_LAS unsigned char*)C.lds, g, S, E); }
                __syncthreads();
                { pg8::Gemm g{(const bfr*)(ws + WS_XN8), (const bfr*)(ws + WS_WTIN + (size_t)8192 * DM * 2), NT, 8192, DM / 2}; pg8::StaticOrder S; S.init(NT, 8192, C.G, hb);
                  pg8::EpiBf16<0> E{BIG + 8192, N, nullptr, 8192, 0, 1.f / SU};
                  pg8::gemm_phase<pg8::EpiBf16<0>, pg8::StaticOrder, true, true, true>((PG8_LAS unsigned char*)C.lds, g, S, E); }
            } else if (layer == 0 && F8_PROJ0 == 4) {
                { pg8::Gemm g{(const bfr*)(ws + WS_XN8), (const bfr*)(ws + WS_WTIN), NT, 4096, DM / 2}; pg8::StaticOrder S; S.init(NT, 4096, C.G, hb);
                  pg8::EpiBf16<0> E{BIG, N, nullptr, 4096, 0, 1.f / SU};
                  pg8::gemm_phase<pg8::EpiBf16<0>, pg8::StaticOrder, true, true, true>((PG8_LAS unsigned char*)C.lds, g, S, E); }
                __syncthreads();
                { pg8::Gemm g{XN, (const bfr*)(ws + WS_WTIN + (size_t)4096 * DM), NT, 12288, DM}; pg8::StaticOrder S; S.init(NT, 12288, C.G, hb);
                  pg8::EpiBf16<0> E{BIG + 4096, N, nullptr, 0, 0, 1.f};
                  pg8::gemm_phase<pg8::EpiBf16<0>, pg8::StaticOrder, true, true>((PG8_LAS unsigned char*)C.lds, g, S, E); }
            } else if (layer == 0 && F8_PROJ0 == 3) {
                { pg8::Gemm g{(const bfr*)(ws + WS_XN8), (const bfr*)(ws + WS_WTIN), NT, 8192, DM / 2}; pg8::StaticOrder S; S.init(NT, 8192, C.G, hb);
                  pg8::EpiBf16<0> E{BIG, N, nullptr, 8192, 0, 1.f / SU};
                  pg8::gemm_phase<pg8::EpiBf16<0>, pg8::StaticOrder, true, true, true>((PG8_LAS unsigned char*)C.lds, g, S, E); }
                __syncthreads();
                { pg8::Gemm g{XN, (const bfr*)(ws + WS_WTIN + (size_t)8192 * DM), NT, 8192, DM}; pg8::StaticOrder S; S.init(NT, 8192, C.G, hb);
                  pg8::EpiBf16<0> E{BIG + 8192, N, nullptr, 0, 0, 1.f};
                  pg8::gemm_phase<pg8::EpiBf16<0>, pg8::StaticOrder, true, true>((PG8_LAS unsigned char*)C.lds, g, S, E); }
            } else if (layer == 0 && F8_PROJ0 == 1) {
                pg8::Gemm g{(const bfr*)(ws + WS_XN8), (const bfr*)(ws + WS_WTIN), NT, N, DM / 2}; pg8::StaticOrder S; S.init(NT, N, C.G, hb);
                pg8::EpiBf16<0> E{BIG, N, nullptr, N, 0, 1.f / SU};
                pg8::gemm_phase<pg8::EpiBf16<0>, pg8::StaticOrder, true, true, true>((PG8_LAS unsigned char*)C.lds, g, S, E);
            } else if (layer == 1 && F8_KVQ == 2) {
                pg8::Gemm g{(const bfr*)(ws + WS_XN8), (const bfr*)(ws + WS_WTKVQ), NT, N, DM / 2}; pg8::StaticOrder S; S.init(NT, N, C.G, hb);
                pg8::EpiBf16<0> E{BIG, N, nullptr, N, 0, 1.f / SU};
                pg8::gemm_phase<pg8::EpiBf16<0>, pg8::StaticOrder, true, true, true>((PG8_LAS unsigned char*)C.lds, g, S, E);
            } else if (layer == 1 && F8_KVQ) {
                { pg8::Gemm g{(const bfr*)(ws + WS_XN8), (const bfr*)(ws + WS_WTKVQ), NT, 8192, DM / 2}; pg8::StaticOrder S; S.init(NT, 8192, C.G, hb);
                  pg8::EpiBf16<0> E{BIG, N, nullptr, 8192, 0, 1.f / SU};
                  pg8::gemm_phase<pg8::EpiBf16<0>, pg8::StaticOrder, true, true, true>((PG8_LAS unsigned char*)C.lds, g, S, E); }
                __syncthreads();
                { pg8::Gemm g{XN, (const bfr*)(ws + WS_WTKVQ + (size_t)2 * DM * DM), NT, DM, DM}; pg8::StaticOrder S; S.init(NT, DM, C.G, hb);
                  pg8::EpiBf16<0> E{BIG + 8192, N, nullptr, 0, 0, 1.f};
                  pg8::gemm_phase<pg8::EpiBf16<0>, pg8::StaticOrder, true, true>((PG8_LAS unsigned char*)C.lds, g, S, E); }
            } else {
                pg8::Gemm g{XN, (const bfr*)(ws + (layer == 0 ? WS_WTIN : WS_WTKVQ)), NT, N, DM}; pg8::StaticOrder S; S.init(NT, N, C.G, hb);
                pg8::EpiBf16<0> E{BIG, N, nullptr, 0, 0, 1.f};
                pg8::gemm_phase<pg8::EpiBf16<0>, pg8::StaticOrder, true, true>((PG8_LAS unsigned char*)C.lds, g, S, E);
            }
            if (layer == 0) { __syncthreads(); p_bd(C, XN, (const bfr*)(ws + WS_WTBD), (float*)(ws + WS_BD)); }
        }
        SEAM(pb + 1);
        if (IN(pb + 2)) { if (layer == 1) p_headprep(C, P); }
        if (layer == 1) SEAM(pb + 2);
        if (IN(pb + 3)) { if (layer == 0) p_gdn_prep(C, P); else p_attn(C, P); }
        SEAM(pb + 3);
        if (IN(pb + 4)) { if (layer == 0) p_gdn_scan(C, P); else p_combine(C, P); }
        SEAM(pb + 4);
        if (IN(pb + 5)) { if (layer == 0) p_gdn_onorm(C, P); }
        if (layer == 0) SEAM(pb + 5);
        if (IN(pb + 6)) {
            if ((layer == 0 && F8_OUT0) || (layer == 1 && F8_OUT1)) {
                pg8::Gemm g{(const bfr*)(ws + WS_XN8), (const bfr*)(ws + (layer == 0 ? WS_WTOUT : WS_WTO)), NT, DM, DM / 2}; pg8::StaticOrder S; S.init(NT, DM, C.G, hb);
                pg8::EpiRes E{layer == 0 ? P.in_(0) : (const float*)P.out_(), P.out_(), DM, 1.f / (SO * SU)};
                pg8::gemm_phase<pg8::EpiRes, pg8::StaticOrder, true, true, true>((PG8_LAS unsigned char*)C.lds, g, S, E);
            } else {
                pg8::Gemm g{XN, (const bfr*)(ws + (layer == 0 ? WS_WTOUT : WS_WTO)), NT, DM, DM}; pg8::StaticOrder S; S.init(NT, DM, C.G, hb);
                pg8::EpiRes E{layer == 0 ? P.in_(0) : (const float*)P.out_(), P.out_(), DM, 1.f};
                pg8::gemm_phase<pg8::EpiRes, pg8::StaticOrder, true, true>((PG8_LAS unsigned char*)C.lds, g, S, E);
            }
        }
        SEAM(pb + 6);
        if (IN(pb + 7)) p_norm_rows(C, (const float*)P.out_(), XN, ws + WS_XN8);
        SEAM(pb + 7);
        if (IN(pb + 8)) {
            pg8::Gemm g{XN, (const bfr*)(ws + WS_WTQRY) + (size_t)layer * PQ * DM, NT, PQ, DM}; pg8::StaticOrder S; S.init(NT, PQ, C.G, hb);
            pg8::EpiBf16<0> E{(bfr*)(ws + WS_QRY), PQ, nullptr, 0, 0, 1.f};
            pg8::gemm_phase<pg8::EpiBf16<0>, pg8::StaticOrder, true, true>((PG8_LAS unsigned char*)C.lds, g, S, E);
        }
        SEAM(pb + 8);
        if (IN(pb + 9)) { p_sroute(C, P, layer); }
        SEAM(pb + 9); if (IN(pb + 9) && !IN(pb + 10) && IN(pb + 11)) xcd_barrier(bar);
        if (IN(pb + 11)) {
            pg8::Gemm g{(const bfr*)(ws + WS_XN8), (const bfr*)(ws + WS_U + (size_t)layer * PE * DM), NT, PE, DM / 2}; pg8::StaticOrder S; S.init(NT, PE, C.G, hb);
#ifdef G1_PROBE
            if (layer == 0) { pg8::StaticOrder S2; S2.init(NT, PE, C.G, hb); pg8::EpiGate8<G1_PROBE> E2{(bfr*)(ws + WS_G), ws + WS_A2, PE, 1.f / SU, SA};
                pg8::gemm_phase<pg8::EpiGate8<G1_PROBE>, pg8::StaticOrder, true, true, true>((PG8_LAS unsigned char*)C.lds, g, S2, E2); __syncthreads(); }
#endif
#if STAGGER_G1
            {
                const int sg = C.vcu & 7;
                if (sg) { const unsigned long long t0 = __builtin_amdgcn_s_memrealtime(); while (__builtin_amdgcn_s_memrealtime() - t0 < (unsigned long long)(sg * STAGGER_G1)) __builtin_amdgcn_s_sleep(4); }
            }
#endif
            pg8::EpiGate8C E{(bfr*)(ws + WS_G), ws + WS_A2, PE, 1.f / SU, SA};
            pg8::gemm_phase<pg8::EpiGate8C, pg8::StaticOrder, true, true, true>((PG8_LAS unsigned char*)C.lds, g, S, E);
        }
        SEAM(pb + 11);
        if (IN(pb + 12)) {
            pg8::Gemm g{(const bfr*)(ws + WS_A2), (const bfr*)(ws + WS_VT + (size_t)layer * DM * PE), NT, DM, PE / 2}; pg8::StaticOrder S; S.init(NT, DM, C.G, hb);
            pg8::EpiRes E{(const float*)P.out_(), P.out_(), DM, 1.f / (SA * SV)};
            pg8::gemm_phase<pg8::EpiRes, pg8::StaticOrder, true, true, true>((PG8_LAS unsigned char*)C.lds, g, S, E);
#ifdef G2_PROBE
            if (layer == 0) { __syncthreads(); pg8::StaticOrder S2; S2.init(NT, DM, C.G, hb); pg8::EpiRes E2{(const float*)P.out_(), P.out_(), DM, 0.f};
                pg8::gemm_phase<pg8::EpiRes, pg8::StaticOrder, true, true, true>((PG8_LAS unsigned char*)C.lds, g, S2, E2); }
#endif
        }
        SEAM(pb + 12);
    }
    {
        constexpr int layer = 1;
        const int pb = 1 + layer * NPH_LAYER;
        if (layer == 1 && IN(pb + 0)) p_norm_rows(C, (const float*)P.out_(), XN, F8_KVQ != 0 ? ws + WS_XN8 : nullptr);
        if (layer == 1) SEAM(pb + 0);
        if (IN(pb + 1)) {
            const int N = layer == 0 ? 16384 : 12288;
            if (layer == 0 && F8_PROJ0 == 2) {
                { pg8::Gemm g{XN, (const bfr*)(ws + WS_WTIN), NT, 8192, DM}; pg8::StaticOrder S; S.init(NT, 8192, C.G, hb);
                  pg8::EpiBf16<0> E{BIG, N, nullptr, 0, 0, 1.f};
                  pg8::gemm_phase<pg8::EpiBf16<0>, pg8::StaticOrder, true, true>((PG8_LAS unsigned char*)C.lds, g, S, E); }
                __syncthreads();
                { pg8::Gemm g{(const bfr*)(ws + WS_XN8), (const bfr*)(ws + WS_WTIN + (size_t)8192 * DM * 2), NT, 8192, DM / 2}; pg8::StaticOrder S; S.init(NT, 8192, C.G, hb);
                  pg8::EpiBf16<0> E{BIG + 8192, N, nullptr, 8192, 0, 1.f / SU};
                  pg8::gemm_phase<pg8::EpiBf16<0>, pg8::StaticOrder, true, true, true>((PG8_LAS unsigned char*)C.lds, g, S, E); }
            } else if (layer == 0 && F8_PROJ0 == 4) {
                { pg8::Gemm g{(const bfr*)(ws + WS_XN8), (const bfr*)(ws + WS_WTIN), NT, 4096, DM / 2}; pg8::StaticOrder S; S.init(NT, 4096, C.G, hb);
                  pg8::EpiBf16<0> E{BIG, N, nullptr, 4096, 0, 1.f / SU};
                  pg8::gemm_phase<pg8::EpiBf16<0>, pg8::StaticOrder, true, true, true>((PG8_LAS unsigned char*)C.lds, g, S, E); }
                __syncthreads();
                { pg8::Gemm g{XN, (const bfr*)(ws + WS_WTIN + (size_t)4096 * DM), NT, 12288, DM}; pg8::StaticOrder S; S.init(NT, 12288, C.G, hb);
                  pg8::EpiBf16<0> E{BIG + 4096, N, nullptr, 0, 0, 1.f};
                  pg8::gemm_phase<pg8::EpiBf16<0>, pg8::StaticOrder, true, true>((PG8_LAS unsigned char*)C.lds, g, S, E); }
            } else if (layer == 0 && F8_PROJ0 == 3) {
                { pg8::Gemm g{(const bfr*)(ws + WS_XN8), (const bfr*)(ws + WS_WTIN), NT, 8192, DM / 2}; pg8::StaticOrder S; S.init(NT, 8192, C.G, hb);
                  pg8::EpiBf16<0> E{BIG, N, nullptr, 8192, 0, 1.f / SU};
                  pg8::gemm_phase<pg8::EpiBf16<0>, pg8::StaticOrder, true, true, true>((PG8_LAS unsigned char*)C.lds, g, S, E); }
                __syncthreads();
                { pg8::Gemm g{XN, (const bfr*)(ws + WS_WTIN + (size_t)8192 * DM), NT, 8192, DM}; pg8::StaticOrder S; S.init(NT, 8192, C.G, hb);
                  pg8::EpiBf16<0> E{BIG + 8192, N, nullptr, 0, 0, 1.f};
                  pg8::gemm_phase<pg8::EpiBf16<0>, pg8::StaticOrder, true, true>((PG8_LAS unsigned char*)C.lds, g, S, E); }
            } else if (layer == 0 && F8_PROJ0 == 1) {
                pg8::Gemm g{(const bfr*)(ws + WS_XN8), (const bfr*)(ws + WS_WTIN), NT, N, DM / 2}; pg8::StaticOrder S; S.init(NT, N, C.G, hb);
                pg8::EpiBf16<0> E{BIG, N, nullptr, N, 0, 1.f / SU};
                pg8::gemm_phase<pg8::EpiBf16<0>, pg8::StaticOrder, true, true, true>((PG8_LAS unsigned char*)C.lds, g, S, E);
            } else if (layer == 1 && F8_KVQ == 2) {
                pg8::Gemm g{(const bfr*)(ws + WS_XN8), (const bfr*)(ws + WS_WTKVQ), NT, N, DM / 2}; pg8::StaticOrder S; S.init(NT, N, C.G, hb);
                pg8::EpiBf16<0> E{BIG, N, nullptr, N, 0, 1.f / SU};
                pg8::gemm_phase<pg8::EpiBf16<0>, pg8::StaticOrder, true, true, true>((PG8_LAS unsigned char*)C.lds, g, S, E);
            } else if (layer == 1 && F8_KVQ) {
                { pg8::Gemm g{(const bfr*)(ws + WS_XN8), (const bfr*)(ws + WS_WTKVQ), NT, 8192, DM / 2}; pg8::StaticOrder S; S.init(NT, 8192, C.G, hb);
                  pg8::EpiBf16<0> E{BIG, N, nullptr, 8192, 0, 1.f / SU};
                  pg8::gemm_phase<pg8::EpiBf16<0>, pg8::StaticOrder, true, true, true>((PG8_LAS unsigned char*)C.lds, g, S, E); }
                __syncthreads();
                { pg8::Gemm g{XN, (const bfr*)(ws + WS_WTKVQ + (size_t)2 * DM * DM), NT, DM, DM}; pg8::StaticOrder S; S.init(NT, DM, C.G, hb);
                  pg8::EpiBf16<0> E{BIG + 8192, N, nullptr, 0, 0, 1.f};
                  pg8::gemm_phase<pg8::EpiBf16<0>, pg8::StaticOrder, true, true>((PG8_LAS unsigned char*)C.lds, g, S, E); }
            } else {
                pg8::Gemm g{XN, (const bfr*)(ws + (layer == 0 ? WS_WTIN : WS_WTKVQ)), NT, N, DM}; pg8::StaticOrder S; S.init(NT, N, C.G, hb);
                pg8::EpiBf16<0> E{BIG, N, nullptr, 0, 0, 1.f};
                pg8::gemm_phase<pg8::EpiBf16<0>, pg8::StaticOrder, true, true>((PG8_LAS unsigned char*)C.lds, g, S, E);
            }
            if (layer == 0) { __syncthreads(); p_bd(C, XN, (const bfr*)(ws + WS_WTBD), (float*)(ws + WS_BD)); }
        }
        SEAM(pb + 1);
        if (IN(pb + 2)) { if (layer == 1) p_headprep(C, P); }
        if (layer == 1) SEAM(pb + 2);
        if (IN(pb + 3)) { if (layer == 0) p_gdn_prep(C, P); else p_attn(C, P); }
        SEAM(pb + 3);
        if (IN(pb + 4)) { if (layer == 0) p_gdn_scan(C, P); else p_combine(C, P); }
        SEAM(pb + 4);
        if (IN(pb + 5)) { if (layer == 0) p_gdn_onorm(C, P); }
        if (layer == 0) SEAM(pb + 5);
        if (IN(pb + 6)) {
            if ((layer == 0 && F8_OUT0) || (layer == 1 && F8_OUT1)) {
                pg8::Gemm g{(const bfr*)(ws + WS_XN8), (const bfr*)(ws + (layer == 0 ? WS_WTOUT : WS_WTO)), NT, DM, DM / 2}; pg8::StaticOrder S; S.init(NT, DM, C.G, hb);
                pg8::EpiRes E{layer == 0 ? P.in_(0) : (const float*)P.out_(), P.out_(), DM, 1.f / (SO * SU)};
                pg8::gemm_phase<pg8::EpiRes, pg8::StaticOrder, true, true, true>((PG8_LAS unsigned char*)C.lds, g, S, E);
            } else {
                pg8::Gemm g{XN, (const bfr*)(ws + (layer == 0 ? WS_WTOUT : WS_WTO)), NT, DM, DM}; pg8::StaticOrder S; S.init(NT, DM, C.G, hb);
                pg8::EpiRes E{layer == 0 ? P.in_(0) : (const float*)P.out_(), P.out_(), DM, 1.f};
                pg8::gemm_phase<pg8::EpiRes, pg8::StaticOrder, true, true>((PG8_LAS unsigned char*)C.lds, g, S, E);
            }
        }
        SEAM(pb + 6);
        if (IN(pb + 7)) p_norm_rows(C, (const float*)P.out_(), XN, ws + WS_XN8);
        SEAM(pb + 7);
        if (IN(pb + 8)) {
            pg8::Gemm g{XN, (const bfr*)(ws + WS_WTQRY) + (size_t)layer * PQ * DM, NT, PQ, DM}; pg8::StaticOrder S; S.init(NT, PQ, C.G, hb);
            pg8::EpiBf16<0> E{(bfr*)(ws + WS_QRY), PQ, nullptr, 0, 0, 1.f};
            pg8::gemm_phase<pg8::EpiBf16<0>, pg8::StaticOrder, true, true>((PG8_LAS unsigned char*)C.lds, g, S, E);
        }
        SEAM(pb + 8);
        if (IN(pb + 9)) { p_sroute(C, P, layer); }
        SEAM(pb + 9); if (IN(pb + 9) && !IN(pb + 10) && IN(pb + 11)) xcd_barrier(bar);
        if (IN(pb + 11)) {
            pg8::Gemm g{(const bfr*)(ws + WS_XN8), (const bfr*)(ws + WS_U + (size_t)layer * PE * DM), NT, PE, DM / 2}; pg8::StaticOrder S; S.init(NT, PE, C.G, hb);
#ifdef G1_PROBE
            if (layer == 0) { pg8::StaticOrder S2; S2.init(NT, PE, C.G, hb); pg8::EpiGate8<G1_PROBE> E2{(bfr*)(ws + WS_G), ws + WS_A2, PE, 1.f / SU, SA};
                pg8::gemm_phase<pg8::EpiGate8<G1_PROBE>, pg8::StaticOrder, true, true, true>((PG8_LAS unsigned char*)C.lds, g, S2, E2); __syncthreads(); }
#endif
#if STAGGER_G1
            {
                const int sg = C.vcu & 7;
                if (sg) { const unsigned long long t0 = __builtin_amdgcn_s_memrealtime(); while (__builtin_amdgcn_s_memrealtime() - t0 < (unsigned long long)(sg * STAGGER_G1)) __builtin_amdgcn_s_sleep(4); }
            }
#endif
            pg8::EpiGate8C E{(bfr*)(ws + WS_G), ws + WS_A2, PE, 1.f / SU, SA};
            pg8::gemm_phase<pg8::EpiGate8C, pg8::StaticOrder, true, true, true>((PG8_LAS unsigned char*)C.lds, g, S, E);
        }
        SEAM(pb + 11);
        if (IN(pb + 12)) {
            pg8::Gemm g{(const bfr*)(ws + WS_A2), (const bfr*)(ws + WS_VT + (size_t)layer * DM * PE), NT, DM, PE / 2}; pg8::StaticOrder S; S.init(NT, DM, C.G, hb);
            pg8::EpiRes E{(const float*)P.out_(), P.out_(), DM, 1.f / (SA * SV)};
            pg8::gemm_phase<pg8::EpiRes, pg8::StaticOrder, true, true, true>((PG8_LAS unsigned char*)C.lds, g, S, E);
#ifdef G2_PROBE
            if (layer == 0) { __syncthreads(); pg8::StaticOrder S2; S2.init(NT, DM, C.G, hb); pg8::EpiRes E2{(const float*)P.out_(), P.out_(), DM, 0.f};
                pg8::gemm_phase<pg8::EpiRes, pg8::StaticOrder, true, true, true>((PG8_LAS unsigned char*)C.lds, g, S2, E2); }
#endif
        }
        SEAM(pb + 12);
    }
#undef IN
#undef SEAM
}

extern "C" void kernel_launch(void* const* d_in, const int* in_sizes, int n_in, void* d_out, int out_size, void* d_ws, size_t ws_size, hipStream_t stream) {
    static int grid = 0;
    if (grid == 0) {
        if (n_in != 26 || out_size != NT * DM || ws_size < WS_END) { fprintf(stderr, "kernel_launch: unexpected problem (n_in %d, out %d, ws %zu < %zu)\n", n_in, out_size, ws_size, (size_t)WS_END); grid = -1; return; }
        int dev = 0, cus = 0;
        if (hipGetDevice(&dev) != hipSuccess || hipDeviceGetAttribute(&cus, hipDeviceAttributeMultiprocessorCount, dev) != hipSuccess || cus <= 0) { grid = -1; return; }
        if (hipFuncSetAttribute((const void*)trunk_fwd, hipFuncAttributeMaxDynamicSharedMemorySize, LDS_BYTES) != hipSuccess) { fprintf(stderr, "kernel_launch: hipFuncSetAttribute failed\n"); grid = -1; return; }
        int per_cu = 0;
        if (hipOccupancyMaxActiveBlocksPerMultiprocessor(&per_cu, (const void*)trunk_fwd, 512, LDS_BYTES) != hipSuccess || per_cu < 1) { fprintf(stderr, "kernel_launch: occupancy query says %d blocks per CU\n", per_cu); }
        (void)hipGetLastError();
        grid = cus;
    }
    if (grid < 0) return;
    (void)in_sizes;
    if (hipMemsetAsync((char*)d_ws + WS_CTL, 0, CTL_ZERO_BYTES, stream) != hipSuccess) return;
    KArgs p{};
    for (int i = 0; i < 26; ++i) p.in[i] = (const float*)d_in[i];
    p.out = (float*)d_out; p.ws = (unsigned char*)d_ws;
#if MK_PER_PHASE
    for (int ph = 0; ph < NPHASE; ++ph) {
        if (ph == 1 + 5 + NPH_LAYER || ph == 1 + 10 || ph == 1 + 10 + NPH_LAYER) continue;
        p.ph_lo = ph; p.ph_hi = ph + 1; p.li = 0; p.pad = 0;
        hipLaunchKernelGGL(trunk_fwd, dim3(grid), dim3(512), LDS_BYTES, stream, p);
    }
#else
    p.ph_lo = 0; p.ph_hi = NPHASE; p.li = 0; p.pad = 0;
    hipLaunchKernelGGL(trunk_fwd, dim3(grid), dim3(512), LDS_BYTES, stream, p);
#endif
}
```

```cpp
#include <hip/hip_runtime.h>
#include <hip/hip_bf16.h>
#include <cstdio>
#include <cstdint>

#define LAS __attribute__((address_space(3)))
#define GAS __attribute__((address_space(1)))
typedef unsigned short bfr;
typedef short s8v __attribute__((ext_vector_type(8)));
typedef float f4v __attribute__((ext_vector_type(4)));
typedef unsigned u4v __attribute__((ext_vector_type(4)));
typedef unsigned u2v __attribute__((ext_vector_type(2)));
typedef int i4v __attribute__((ext_vector_type(4)));

#ifndef F8_PROJ0
#define F8_PROJ0 3
#endif
#ifndef F8_KVQ
#define F8_KVQ 2
#endif
#ifndef F8_OUT0
#define F8_OUT0 1
#endif
#ifndef F8_OUT1
#define F8_OUT1 1
#endif
#ifndef F8_OUT
#define F8_OUT (F8_OUT0 || F8_OUT1)
#endif
#ifndef STAGGER_G1
#define STAGGER_G1 0
#endif
constexpr int NB = 2, SEQ = 4096, DM = 4096, NT = NB * SEQ;
constexpr int GH = 32, GD = 128, GIN = 16448, CH = 64, NCH = SEQ / CH;
constexpr int AH = 16, AD = 128, AV = 256;
constexpr int PH = 8, PK = 128, PE = 16384, PQ = 2048, PTOP = 16;
constexpr float EPS = 1e-6f;
constexpr float LAMBDA_INIT = 0.35550906759f;
constexpr float SU = 64.f, SA = 64.f, SV = 4.f, SO = 16.f;

constexpr size_t MiB = 1u << 20;
constexpr size_t WS_CTL   = 0;
constexpr size_t WS_WTIN  = 1 * MiB;
constexpr size_t WS_WTBD  = WS_WTIN + 128 * MiB;
constexpr size_t WS_WTOUT = WS_WTBD + 1 * MiB;
constexpr size_t WS_WTKVQ = WS_WTOUT + 32 * MiB;
constexpr size_t WS_WTO   = WS_WTKVQ + 96 * MiB;
constexpr size_t WS_WTQRY = WS_WTO + 32 * MiB;
constexpr size_t WS_WTKEY = WS_WTQRY + 32 * MiB;
constexpr size_t WS_U     = WS_WTKEY + 16 * MiB;
constexpr size_t WS_VT    = WS_U + 128 * MiB;
constexpr size_t WS_A2    = WS_VT + 128 * MiB;
constexpr size_t WS_XN8   = WS_A2 + 128 * MiB;
constexpr size_t WS_XN    = WS_XN8 + 32 * MiB;
constexpr size_t WS_BIG   = WS_XN + 64 * MiB;
constexpr size_t WS_R     = WS_BIG + 256 * MiB;
constexpr size_t WS_QRY   = WS_R + 352 * MiB;
constexpr size_t WS_SC    = WS_QRY + 32 * MiB;
constexpr size_t WS_BD    = WS_SC + 64 * MiB;
constexpr size_t WS_EG    = WS_BD + 2 * MiB;
constexpr size_t WS_G     = WS_EG + 1 * MiB;
constexpr size_t WS_END   = WS_G + 256 * MiB;
constexpr size_t R_W = 0, R_U = 64 * MiB, R_QG = 128 * MiB, R_KD = 192 * MiB, R_QK = 256 * MiB, R_O = 288 * MiB;
constexpr size_t R_QH = 0, R_KH = 64 * MiB, R_VH = 128 * MiB, R_OH = 192 * MiB;
static_assert(WS_END <= (size_t)1790 * MiB, "workspace map");

constexpr int CW_BAR = 4096;
constexpr size_t CTL_ZERO_BYTES = 1 * MiB;

constexpr int LDS_BYTES = 147456;
constexpr int MISC_OFF = 146944;

typedef float f2v_ __attribute__((ext_vector_type(2)));
typedef __bf16 b2v_ __attribute__((ext_vector_type(2)));
__device__ __forceinline__ unsigned cvtpk(float lo, float hi) { const b2v_ r = __builtin_convertvector((f2v_){lo, hi}, b2v_); return __builtin_bit_cast(unsigned, r); }
__device__ __forceinline__ unsigned cvt4_fp8(float a, float b, float c, float d) { int w = 0; w = __builtin_amdgcn_cvt_pk_fp8_f32(a, b, w, false); w = __builtin_amdgcn_cvt_pk_fp8_f32(c, d, w, true); return (unsigned)w; }
__device__ __forceinline__ float bflo(unsigned w) { return __uint_as_float(w << 16); }
__device__ __forceinline__ float bfhi(unsigned w) { return __uint_as_float(w & 0xffff0000u); }
__device__ __forceinline__ float bf1(bfr b) { return __uint_as_float(((unsigned)b) << 16); }
__device__ __forceinline__ bfr f2bf1(float f) { return (bfr)(cvtpk(f, 0.f) & 0xffffu); }
__device__ __forceinline__ float wave_sum(float v) {
#pragma unroll
    for (int o = 1; o < 64; o <<= 1) v += __shfl_xor(v, o);
    return v;
}
__device__ __forceinline__ f4v zero_acc() { f4v z = {0.f, 0.f, 0.f, 0.f}; asm volatile("" : "+v"(z)); return z; }
#define MFMA_SETTLE(acc) asm volatile("s_nop 7\n\ts_nop 7" : "+v"(acc))
#define LDS_WAIT() asm volatile("s_waitcnt lgkmcnt(0)" ::: "memory")
#define VM_WAIT() asm volatile("s_waitcnt vmcnt(0)" ::: "memory")
#define XB_TMO      128
#define XB_XCNT(j)  (256  + 64 * (j))
#define XB_XSUB(j)  (1280 + 64 * (j))
#define XB_XGEN(j)  (2304 + 64 * (j))
#define XB_TOP      3328
#define XB_TOPGEN   3392
#define XCD_BAR_WORDS 3456
#define XB_SPIN_CAP (1u << 18)

__device__ __forceinline__ unsigned xb_ld(unsigned* p)              { return __hip_atomic_load(p, __ATOMIC_RELAXED, __HIP_MEMORY_SCOPE_AGENT); }
__device__ __forceinline__ unsigned xb_add(unsigned* p, unsigned v) { return __hip_atomic_fetch_add(p, v, __ATOMIC_RELAXED, __HIP_MEMORY_SCOPE_AGENT); }
__device__ __forceinline__ unsigned xb_xcc_id() { return (unsigned)__builtin_amdgcn_s_getreg((3 << 11) | 20) & 0xFu; }
#define XB_SPIN(cond, bar) do { unsigned _sp = 0; while (cond) { __builtin_amdgcn_s_sleep(1); \
    if ((++_sp & 255u) == 0u) { if (xb_ld(&(bar)[XB_TMO])) break; if (_sp > XB_SPIN_CAP) { atomicAdd(&(bar)[XB_TMO], 1u); break; } } } } while (0)

struct XcdBarrier {
    unsigned* bar; unsigned x;
    volatile LAS unsigned* st;
};

__device__ __forceinline__ XcdBarrier xcd_barrier_post(unsigned* bar, volatile LAS unsigned* st) {
    XcdBarrier b; b.bar = bar; b.x = xb_xcc_id(); b.st = st;
    if (threadIdx.x == 0) (void)xb_add(&bar[XB_XCNT(b.x)], 1u);
    return b;
}
__device__ __forceinline__ void xcd_barrier_complete(unsigned* bar, unsigned x, unsigned& nloc, unsigned& nx) {
    const unsigned G = gridDim.x * gridDim.y * gridDim.z;
    unsigned sum, cnt, mine, sp = 0u;
    for (;;) {
        sum = 0u; cnt = 0u; mine = 0u;
#pragma unroll
        for (unsigned j = 0; j < 16; ++j) { const unsigned c = xb_ld(&bar[XB_XCNT(j)]); sum += c; cnt += (c > 0u) ? 1u : 0u; mine = (j == x) ? c : mine; }
        if (sum == G) break;
        __builtin_amdgcn_s_sleep(1);
        if ((++sp & 255u) == 0u) { if (xb_ld(&bar[XB_TMO])) break; if (sp > XB_SPIN_CAP) { atomicAdd(&bar[XB_TMO], 1u); break; } }
    }
    nloc = mine > 0u ? mine : 1u; nx = cnt > 0u ? cnt : 1u;
}

__device__ __forceinline__ void xcd_barrier(const XcdBarrier& b) {
    asm volatile("s_waitcnt vmcnt(0)" ::: "memory");
    __syncthreads();
    if (threadIdx.x == 0) {
        unsigned* bar = b.bar;
        __builtin_amdgcn_s_waitcnt(0);
        unsigned nloc = b.st[0], nx = b.st[1];
        if (nloc == 0u) { xcd_barrier_complete(bar, b.x, nloc, nx); b.st[0] = nloc; b.st[1] = nx; }
        const unsigned old = xb_add(&bar[XB_XSUB(b.x)], 1u);
        const unsigned gen = old / nloc;
        if (old + 1u == (gen + 1u) * nloc) {
            __builtin_amdgcn_fence(__ATOMIC_RELEASE, "agent");
            asm volatile("s_waitcnt vmcnt(0)" ::: "memory");
            const unsigned og = xb_add(&bar[XB_TOP], 1u);
            const unsigned tg = og / nx;
            if (og + 1u == (tg + 1u) * nx) xb_add(&bar[XB_TOPGEN], 1u);
            else XB_SPIN(xb_ld(&bar[XB_TOPGEN]) == tg, bar);
            __builtin_amdgcn_fence(__ATOMIC_ACQUIRE, "agent");
            xb_add(&bar[XB_XGEN(b.x)], 1u);
            asm volatile("s_waitcnt vmcnt(0)" ::: "memory");
        } else {
            XB_SPIN(xb_ld(&bar[XB_XGEN(b.x)]) == gen, bar);
            __builtin_amdgcn_fence(__ATOMIC_ACQUIRE, "agent");
            asm volatile("s_waitcnt vmcnt(0)" ::: "memory");
        }
    }
    __syncthreads();
}
namespace pg8 {
#define PG8_LAS __attribute__((address_space(3)))
typedef unsigned short bf16_t;
typedef short bf16x8 __attribute__((ext_vector_type(8)));
typedef float f32x4 __attribute__((ext_vector_type(4)));
typedef unsigned u32x4 __attribute__((ext_vector_type(4)));
typedef int i32x4 __attribute__((ext_vector_type(4)));
typedef int i32x8 __attribute__((ext_vector_type(8)));
typedef unsigned u32x2 __attribute__((ext_vector_type(2)));
constexpr int BM = 256, BK = 64, HALF = 128, HTB = HALF * BK * 2  , STAGE_BYTES = 8 * HTB, NXCD = 8, WGM = 8;

__host__ __device__ __forceinline__ int lds_byte(int r, int c) { const int st = (r >> 4) * 2 + (c >> 5), rr = r & 15, cc = c & 31, ob = rr * 64 + cc * 2; return st * 1024 + (ob ^ (((ob >> 9) & 1) << 5)); }
__host__ __device__ __forceinline__ void stage_rc(int b, int& R, int& C) { const int st = b / 1024, sb = b % 1024, swz = sb ^ (((sb >> 9) & 1) << 5); R = (st >> 1) * 16 + swz / 64; C = (st & 1) * 32 + (swz % 64) / 2; }
__host__ __device__ __forceinline__ int perm32(int rho) { const int n = rho >> 4, i = rho & 15; return 8 * (i >> 2) + 4 * n + (i & 3); }

struct Unit { int pm, pn; };
struct Gemm { const bf16_t* A; const bf16_t* Bt; int M, N, K; };

struct StaticOrder {
    int nM, nN, nwg, G, c;
    __host__ __device__ void init(int M, int N, int G_, int c_) { nM = M / BM; nN = N / BM; nwg = nM * nN; G = G_; c = c_; }
    __host__ __device__ bool next(int i, Unit& u) const {
        const long L = (long)i * G + c; if (L >= nwg) return false;
        int wgid = (int)L; { const int q = nwg / NXCD, r = nwg % NXCD, xcd = wgid % NXCD, off = wgid / NXCD; wgid = (xcd < r ? xcd * (q + 1) : r * (q + 1) + (xcd - r) * q) + off; }
        const int nig = WGM * nN, gid = wgid / nig, fm = gid * WGM, gsz = (nM - fm) < WGM ? (nM - fm) : WGM;
        u.pm = fm + ((wgid % nig) % gsz); u.pn = (wgid % nig) / gsz; return true;
    }
    __device__ __forceinline__ void a_ready(const Unit&) const {}
    __device__ __forceinline__ void done(const Unit&) const {}
};

__device__ __forceinline__ unsigned cvt_pk_bf16(float lo, float hi) { unsigned r; asm volatile("v_cvt_pk_bf16_f32 %0, %1, %2" : "=v"(r) : "v"(lo), "v"(hi)); return r; }
typedef float f32x2 __attribute__((ext_vector_type(2)));
__device__ __forceinline__ f32x2 gelu_pk(f32x2 v) {
    const f32x2 av = __builtin_elementwise_abs(v), d = av * 0.2316418882f + 1.0f;
    f32x2 t; t.x = __builtin_amdgcn_rcpf(d.x); t.y = __builtin_amdgcn_rcpf(d.y);
    f32x2 q = t * 0.5307027145f + (-0.7265760135f); q = q * t + 0.7107068705f; q = q * t + (-0.142248368f); q = q * t + 0.127414796f; q = q * t;
    const f32x2 s = (v * v) * (-0.72134752044f);
    f32x2 e; e.x = __builtin_amdgcn_exp2f(s.x); e.y = __builtin_amdgcn_exp2f(s.y);
    const f32x2 m = v * (q * e), r = v - m;
    f32x2 o; o.x = v.x < 0.f ? m.x : r.x; o.y = v.y < 0.f ? m.y : r.y; return o;
}

template <int ACT  > struct EpiBf16 {
    static constexpr bool PERM = true, AFTER_DRAIN = false; static_assert(ACT == 0 || ACT == 1, "EpiBf16: ACT is 0 (none) or 1 (gelu_pk)");
    bf16_t* O; int ldc; const float* bias; int split_cols; size_t split_stride; float scale0;
    __device__ __forceinline__ void operator()(const f32x4 (&acc)[2][2][4][2], const Unit& u, int wr, int wc, int fr, int fq) const {
        const int row0 = u.pm * BM + wr * 64 + fr; int colt = u.pn * BM; bf16_t* base = O;
        float sc = 1.f; if (split_cols) { const int t = colt / split_cols; base += (size_t)t * split_stride; colt -= t * split_cols; if (t == 0) sc = scale0; }
        const int col0 = colt + wc * 32 + 8 * fq, bcol0 = u.pn * BM + wc * 32 + 8 * fq;
        f32x4 bv[2][2];
#pragma unroll
        for (int bj = 0; bj < 2; ++bj)
#pragma unroll
            for (int n = 0; n < 2; ++n) bv[bj][n] = bias ? *(const f32x4*)(bias + bcol0 + bj * HALF + 4 * n) : (f32x4){0.f, 0.f, 0.f, 0.f};
#pragma unroll
        for (int ai = 0; ai < 2; ++ai)
#pragma unroll
            for (int m = 0; m < 4; ++m) { bf16_t* rowp = base + (size_t)(row0 + ai * HALF + m * 16) * ldc + col0;
#pragma unroll
                for (int bj = 0; bj < 2; ++bj) { f32x4 v0 = acc[ai][bj][m][0] + bv[bj][0], v1 = acc[ai][bj][m][1] + bv[bj][1];
                    if (ACT == 1) { f32x2 a = gelu_pk((f32x2){v0[0], v0[1]}), b = gelu_pk((f32x2){v0[2], v0[3]}), c = gelu_pk((f32x2){v1[0], v1[1]}), d = gelu_pk((f32x2){v1[2], v1[3]});
                        v0 = (f32x4){a.x, a.y, b.x, b.y}; v1 = (f32x4){c.x, c.y, d.x, d.y}; }
                    v0 = v0 * sc; v1 = v1 * sc; u32x4 w; w.x = cvt_pk_bf16(v0[0], v0[1]); w.y = cvt_pk_bf16(v0[2], v0[3]); w.z = cvt_pk_bf16(v1[0], v1[1]); w.w = cvt_pk_bf16(v1[2], v1[3]);
                    *(u32x4*)(rowp + bj * HALF) = w; } }
    }
};
struct EpiRes {
    static constexpr bool PERM = false, AFTER_DRAIN = false;
    const float* base; float* out; int ldc; float scale;
    __device__ __forceinline__ void operator()(const f32x4 (&acc)[2][2][4][2], const Unit& u, int wr, int wc, int fr, int fq) const {
        const int row0 = u.pm * BM + wr * 64 + fr, col0 = u.pn * BM + wc * 32 + 4 * fq;
#pragma unroll
        for (int ai = 0; ai < 2; ++ai)
#pragma unroll
            for (int m = 0; m < 4; ++m) { const size_t off = (size_t)(row0 + ai * HALF + m * 16) * ldc + col0;
                f32x4 bs[2][2];
#pragma unroll
                for (int bj = 0; bj < 2; ++bj)
#pragma unroll
                    for (int n = 0; n < 2; ++n) bs[bj][n] = *(const f32x4*)(base + off + bj * HALF + n * 16);
#pragma unroll
                for (int bj = 0; bj < 2; ++bj)
#pragma unroll
                    for (int n = 0; n < 2; ++n) *(f32x4*)(out + off + bj * HALF + n * 16) = bs[bj][n] + acc[ai][bj][m][n] * scale;
                asm volatile("" ::: "memory"); }
    }
};
struct EpiStF32 {
    static constexpr bool PERM = false, AFTER_DRAIN = false;
    float* C; int ldc;
    __device__ __forceinline__ void operator()(const f32x4 (&acc)[2][2][4][2], const Unit& u, int wr, int wc, int fr, int fq) const {
        const int row0 = u.pm * BM + wr * 64 + fr, col0 = u.pn * BM + wc * 32 + 4 * fq;
#pragma unroll
        for (int ai = 0; ai < 2; ++ai)
#pragma unroll
            for (int m = 0; m < 4; ++m) { float* rowp = C + (size_t)(row0 + ai * HALF + m * 16) * ldc + col0;
#pragma unroll
                for (int bj = 0; bj < 2; ++bj)
#pragma unroll
                    for (int n = 0; n < 2; ++n) *(f32x4*)(rowp + bj * HALF + n * 16) = acc[ai][bj][m][n]; }
    }
};
struct EpiGate {
    static constexpr bool PERM = true, AFTER_DRAIN = false;
    bf16_t* G; int ldc;
    __device__ __forceinline__ void operator()(const f32x4 (&acc)[2][2][4][2], const Unit& u, int wr, int wc, int fr, int fq) const {
        const int row0 = u.pm * BM + wr * 64 + fr, col0 = u.pn * BM + wc * 32 + 8 * fq;
#pragma unroll
        for (int ai = 0; ai < 2; ++ai)
#pragma unroll
            for (int m = 0; m < 4; ++m) { bf16_t* rowp = G + (size_t)(row0 + ai * HALF + m * 16) * ldc + col0;
                u32x4 g[2];
#pragma unroll
                for (int bj = 0; bj < 2; ++bj) g[bj] = *(const u32x4*)(rowp + bj * HALF);
#pragma unroll
                for (int bj = 0; bj < 2; ++bj) {
                    if ((g[bj].x | g[bj].y | g[bj].z | g[bj].w) != 0u) {
                        const f32x4 v0 = acc[ai][bj][m][0], v1 = acc[ai][bj][m][1];
                        const f32x2 a = gelu_pk((f32x2){v0[0], v0[1]}), b = gelu_pk((f32x2){v0[2], v0[3]}), c = gelu_pk((f32x2){v1[0], v1[1]}), d = gelu_pk((f32x2){v1[2], v1[3]});
                        u32x4 w;
                        w.x = cvt_pk_bf16(a.x * __uint_as_float(g[bj].x << 16), a.y * __uint_as_float(g[bj].x & 0xffff0000u));
                        w.y = cvt_pk_bf16(b.x * __uint_as_float(g[bj].y << 16), b.y * __uint_as_float(g[bj].y & 0xffff0000u));
                        w.z = cvt_pk_bf16(c.x * __uint_as_float(g[bj].z << 16), c.y * __uint_as_float(g[bj].z & 0xffff0000u));
                        w.w = cvt_pk_bf16(d.x * __uint_as_float(g[bj].w << 16), d.y * __uint_as_float(g[bj].w & 0xffff0000u));
                        *(u32x4*)(rowp + bj * HALF) = w;
                    }
                } }
    }
};
template <int MODE = 0>
struct EpiGate8 {
    static constexpr bool PERM = true, AFTER_DRAIN = false;
    bf16_t* G; unsigned char* A2; int ldc; float hscale, oscale;
    __device__ __forceinline__ void operator()(const f32x4 (&acc)[2][2][4][2], const Unit& u, int wr, int wc, int fr, int fq) const {
        const int row0 = u.pm * BM + wr * 64 + fr, col0 = u.pn * BM + wc * 32 + 8 * fq;
#pragma unroll
        for (int ai = 0; ai < 2; ++ai)
#pragma unroll
            for (int m = 0; m < 4; ++m) { const size_t ro = (size_t)(row0 + ai * HALF + m * 16) * ldc + col0;
                u32x4 g[2];
#pragma unroll
                for (int bj = 0; bj < 2; ++bj) g[bj] = (MODE == 2 || MODE == 3) ? (u32x4){0x3f803f80u, 0x3f803f80u, 0x3f803f80u, 0x3f803f80u} : *(const u32x4*)(G + ro + bj * HALF);
#pragma unroll
                for (int bj = 0; bj < 2; ++bj) {
                    u32x2 w = {0u, 0u};
                    if ((g[bj].x | g[bj].y | g[bj].z | g[bj].w) != 0u) {
                        const f32x4 v0 = acc[ai][bj][m][0] * hscale, v1 = acc[ai][bj][m][1] * hscale;
                        const f32x2 a = MODE == 3 ? (f32x2){v0[0], v0[1]} : gelu_pk((f32x2){v0[0], v0[1]}), b = MODE == 3 ? (f32x2){v0[2], v0[3]} : gelu_pk((f32x2){v0[2], v0[3]}), c = MODE == 3 ? (f32x2){v1[0], v1[1]} : gelu_pk((f32x2){v1[0], v1[1]}), d = MODE == 3 ? (f32x2){v1[2], v1[3]} : gelu_pk((f32x2){v1[2], v1[3]});
                        float y[8] = {a.x * __uint_as_float(g[bj].x << 16), a.y * __uint_as_float(g[bj].x & 0xffff0000u), b.x * __uint_as_float(g[bj].y << 16), b.y * __uint_as_float(g[bj].y & 0xffff0000u),
                                      c.x * __uint_as_float(g[bj].z << 16), c.y * __uint_as_float(g[bj].z & 0xffff0000u), d.x * __uint_as_float(g[bj].w << 16), d.y * __uint_as_float(g[bj].w & 0xffff0000u)};
#pragma unroll
                        for (int k = 0; k < 8; ++k) y[k] = fminf(fmaxf(y[k] * oscale, -440.f), 440.f);
                        int lo = 0, hi = 0;
                        lo = __builtin_amdgcn_cvt_pk_fp8_f32(y[0], y[1], lo, false); lo = __builtin_amdgcn_cvt_pk_fp8_f32(y[2], y[3], lo, true);
                        hi = __builtin_amdgcn_cvt_pk_fp8_f32(y[4], y[5], hi, false); hi = __builtin_amdgcn_cvt_pk_fp8_f32(y[6], y[7], hi, true);
                        w.x = (unsigned)lo; w.y = (unsigned)hi;
                        if (MODE == 0) *(u32x4*)(G + ro + bj * HALF) = (u32x4){0u, 0u, 0u, 0u};
                    }
                    *(u32x2*)(A2 + ro + bj * HALF) = w;
                } }
    }
};

struct EpiGate8C {
    static constexpr bool PERM = true, AFTER_DRAIN = false;
    static constexpr int REC_OFF = STAGE_BYTES, REC_WAVE = 1984, REC_DW = 8, CAP = REC_WAVE / (4 * REC_DW);
    unsigned char* G; unsigned char* A2; int ldc; float hscale, oscale;
    static __device__ __forceinline__ float gdec(unsigned w, int k) { const unsigned b = (w >> (8 * k)) & 255u; return b ? __builtin_amdgcn_exp2f(((float)b - 195.f) * 0.05f) : 0.f; }
    __device__ __forceinline__ void one(unsigned h0, unsigned h1, unsigned h2, unsigned h3, unsigned g0, unsigned g1, unsigned off) const {
        const f32x2 a = gelu_pk((f32x2){__uint_as_float(h0 << 16), __uint_as_float(h0 & 0xffff0000u)}), b = gelu_pk((f32x2){__uint_as_float(h1 << 16), __uint_as_float(h1 & 0xffff0000u)}),
                    c = gelu_pk((f32x2){__uint_as_float(h2 << 16), __uint_as_float(h2 & 0xffff0000u)}), d = gelu_pk((f32x2){__uint_as_float(h3 << 16), __uint_as_float(h3 & 0xffff0000u)});
        float y[8] = {a.x * gdec(g0, 0), a.y * gdec(g0, 1), b.x * gdec(g0, 2), b.y * gdec(g0, 3), c.x * gdec(g1, 0), c.y * gdec(g1, 1), d.x * gdec(g1, 2), d.y * gdec(g1, 3)};
#pragma unroll
        for (int k = 0; k < 8; ++k) y[k] = fminf(fmaxf(y[k] * oscale, -440.f), 440.f);
        int lo = 0, hi = 0;
        lo = __builtin_amdgcn_cvt_pk_fp8_f32(y[0], y[1], lo, false); lo = __builtin_amdgcn_cvt_pk_fp8_f32(y[2], y[3], lo, true);
        hi = __builtin_amdgcn_cvt_pk_fp8_f32(y[4], y[5], hi, false); hi = __builtin_amdgcn_cvt_pk_fp8_f32(y[6], y[7], hi, true);
        *(u32x2*)(A2 + off) = (u32x2){(unsigned)lo, (unsigned)hi};
        *(u32x2*)(G + off) = (u32x2){0u, 0u};
    }
    __device__ __forceinline__ void flush(PG8_LAS unsigned* rec, int cnt, int lane) const {
        asm volatile("s_waitcnt lgkmcnt(0)" ::: "memory");
        if (lane < cnt) { const PG8_LAS unsigned* r = rec + lane * REC_DW;
            const u32x4 hh = *(const PG8_LAS u32x4*)r; const u32x2 gg = *(const PG8_LAS u32x2*)(r + 4); const unsigned off = r[6];
            one(hh.x, hh.y, hh.z, hh.w, gg.x, gg.y, off); }
        asm volatile("s_waitcnt lgkmcnt(0)" ::: "memory");
    }
    __device__ __forceinline__ void operator()(const f32x4 (&acc)[2][2][4][2], const Unit& u, int wr, int wc, int fr, int fq) const {
        extern __shared__ __attribute__((aligned(16))) char pg8_lds_sym[];
        const int lane = fq * 16 + fr;
        PG8_LAS unsigned* rec = (PG8_LAS unsigned*)((PG8_LAS char*)pg8_lds_sym + REC_OFF + (wr * 4 + wc) * REC_WAVE);
        const int row0 = u.pm * BM + wr * 64 + fr, col0 = u.pn * BM + wc * 32 + 8 * fq;
        int cnt = 0;
#pragma unroll
        for (int ai = 0; ai < 2; ++ai) {
            u32x2 gall[4][2];
#pragma unroll
            for (int m = 0; m < 4; ++m) { const unsigned ro = (unsigned)(row0 + ai * HALF + m * 16) * (unsigned)ldc + (unsigned)col0;
#pragma unroll
                for (int bj = 0; bj < 2; ++bj) gall[m][bj] = *(const u32x2*)(G + ro + bj * HALF); }
            asm volatile("" ::: "memory");
#pragma unroll
            for (int m = 0; m < 4; ++m) { const unsigned ro = (unsigned)(row0 + ai * HALF + m * 16) * (unsigned)ldc + (unsigned)col0;
#pragma unroll
                for (int bj = 0; bj < 2; ++bj) { const u32x2 g = gall[m][bj];
                    const bool nz = (g.x | g.y) != 0u;
                    const unsigned long long bal = __builtin_amdgcn_ballot_w64(nz);
                    const int np = __builtin_popcountll(bal);
                    if (np > CAP) {
                        if (nz) { const f32x4 v0 = acc[ai][bj][m][0] * hscale, v1 = acc[ai][bj][m][1] * hscale;
                            one(cvt_pk_bf16(v0[0], v0[1]), cvt_pk_bf16(v0[2], v0[3]), cvt_pk_bf16(v1[0], v1[1]), cvt_pk_bf16(v1[2], v1[3]), g.x, g.y, ro + bj * HALF); }
                        else *(u32x2*)(A2 + ro + bj * HALF) = (u32x2){0u, 0u};
                        continue; }
                    if (cnt + np > CAP) { flush(rec, cnt, lane); cnt = 0; }
                    if (nz) { const int slot = cnt + (int)__builtin_amdgcn_mbcnt_hi((unsigned)(bal >> 32), __builtin_amdgcn_mbcnt_lo((unsigned)bal, 0u));
                        const f32x4 v0 = acc[ai][bj][m][0] * hscale, v1 = acc[ai][bj][m][1] * hscale;
                        PG8_LAS unsigned* r = rec + slot * REC_DW;
                        *(PG8_LAS u32x4*)r = (u32x4){cvt_pk_bf16(v0[0], v0[1]), cvt_pk_bf16(v0[2], v0[3]), cvt_pk_bf16(v1[0], v1[1]), cvt_pk_bf16(v1[2], v1[3])}; *(PG8_LAS u32x2*)(r + 4) = g; r[6] = ro + bj * HALF; }
                    else *(u32x2*)(A2 + ro + bj * HALF) = (u32x2){0u, 0u};
                    cnt += np;
                } }
        }
        flush(rec, cnt, lane);
    }
};
template <class Epi, class Sched, bool ALIGN_EPI = false, bool SP2 = false, bool F8 = false>
__device__ __forceinline__ void gemm_phase(PG8_LAS unsigned char* lds, const Gemm g, const Sched& S, const Epi& E) {
    const int tid = threadIdx.x, wid = __builtin_amdgcn_readfirstlane(tid >> 6), lane = tid & 63, wr = wid >> 2, wc = wid & 3, fr = lane & 15, fq = lane >> 4;
    const int K = g.K, nt = K / BK;
    unsigned voffA[2], voffB[2];
#pragma unroll
    for (int i = 0; i < 2; ++i) { int R, C; stage_rc(tid * 16 + i * 8192, R, C); const int Rb = Epi::PERM ? ((R & ~31) + perm32(R & 31)) : R;
        voffA[i] = (unsigned)(R * K + C) * 2u; voffB[i] = (unsigned)(Rb * K + C) * 2u; }
    const size_t kstep = (size_t)(BK * 2);
    const size_t hstep = (size_t)HALF * K * 2;
    const size_t tstep = 2 * hstep;
    const unsigned ldsw = (unsigned)wid * 1024u;
    const int aoff = lds_byte(wr * 64 + fr, fq * 8), boff = lds_byte(wc * 32 + fr, fq * 8);
#define PG8_SA(b, h) (((b) * 2 + (h)) * HTB)
#define PG8_SB(b, h) ((4 + (b) * 2 + (h)) * HTB)
#define PG8_STAGE(bufoff, gbase, voff) do { _Pragma("unroll") for (int _i = 0; _i < 2; ++_i) \
        __builtin_amdgcn_global_load_lds((const unsigned*)((const char*)(gbase) + (voff)[_i]), (PG8_LAS unsigned*)(lds + (bufoff) + ldsw + _i * 8192), 16, 0, 0); } while (0)
#define PG8_LDA(dst, b, h) do { if constexpr (F8) { _Pragma("unroll") for (int m = 0; m < 4; ++m) { const i32x4 lo_ = *(const PG8_LAS i32x4*)(lds + PG8_SA(b, h) + aoff + m * 2048), hi_ = *(const PG8_LAS i32x4*)(lds + PG8_SA(b, h) + aoff + m * 2048 + 1024); \
        dst##_8[m] = __builtin_shufflevector(lo_, hi_, 0, 1, 2, 3, 4, 5, 6, 7); } } else { _Pragma("unroll") for (int m = 0; m < 4; ++m) _Pragma("unroll") for (int k = 0; k < 2; ++k) dst[m][k] = *(const PG8_LAS bf16x8*)(lds + PG8_SA(b, h) + aoff + m * 2048 + k * 1024); } } while (0)
#define PG8_LDB(dst, b, h) do { if constexpr (F8) { _Pragma("unroll") for (int n = 0; n < 2; ++n) { const i32x4 lo_ = *(const PG8_LAS i32x4*)(lds + PG8_SB(b, h) + boff + n * 2048), hi_ = *(const PG8_LAS i32x4*)(lds + PG8_SB(b, h) + boff + n * 2048 + 1024); \
        dst##_8[n] = __builtin_shufflevector(lo_, hi_, 0, 1, 2, 3, 4, 5, 6, 7); } } else { _Pragma("unroll") for (int n = 0; n < 2; ++n) _Pragma("unroll") for (int k = 0; k < 2; ++k) dst[n][k] = *(const PG8_LAS bf16x8*)(lds + PG8_SB(b, h) + boff + n * 2048 + k * 1024); } } while (0)
#define PG8_MMA(ai, bj, At, Bt) do { __builtin_amdgcn_s_setprio(1); if constexpr (F8) { _Pragma("unroll") for (int m = 0; m < 4; ++m) _Pragma("unroll") for (int n = 0; n < 2; ++n) \
        asm volatile("v_mfma_f32_16x16x128_f8f6f4 %0, %1, %2, %0" : "+v"(acc[ai][bj][m][n]) : "v"(Bt##_8[n]), "v"(At##_8[m])); } \
    else { _Pragma("unroll") for (int m = 0; m < 4; ++m) _Pragma("unroll") for (int n = 0; n < 2; ++n) _Pragma("unroll") for (int k = 0; k < 2; ++k) \
        acc[ai][bj][m][n] = __builtin_amdgcn_mfma_f32_16x16x32_bf16(Bt[n][k], At[m][k], acc[ai][bj][m][n], 0, 0, 0); } __builtin_amdgcn_s_setprio(0); } while (0)
#define PG8_WAIT_V(n) asm volatile("s_waitcnt vmcnt(" #n ")" ::: "memory")
#define PG8_WAIT_L(n) asm volatile("s_waitcnt lgkmcnt(" #n ")" ::: "memory")
#define PG8_BAR __builtin_amdgcn_s_barrier()
#define PG8_SCHED __builtin_amdgcn_sched_barrier(0)
    Unit cur, nxt; int ui = 0;
    if (!S.next(0, cur)) return;
    f32x4 acc[2][2][4][2];
#pragma unroll
    for (int a = 0; a < 2; ++a)
#pragma unroll
        for (int b = 0; b < 2; ++b)
#pragma unroll
            for (int m = 0; m < 4; ++m)
#pragma unroll
                for (int n = 0; n < 2; ++n) acc[a][b][m][n] = (f32x4){0.f, 0.f, 0.f, 0.f};
    const int f8_scale_one = 0x7F7F7F7F;
    bf16x8 At[4][2], B0[2][2], B1[2][2]; i32x8 At_8[4], B0_8[2], B1_8[2];
    const char* cA = (const char*)g.A + (size_t)cur.pm * tstep; const char* cB = (const char*)g.Bt + (size_t)cur.pn * tstep;
    S.a_ready(cur);
    if constexpr (SP2) {
        PG8_STAGE(PG8_SB(0, 0), cB, voffB); PG8_STAGE(PG8_SB(0, 1), cB + hstep, voffB); PG8_STAGE(PG8_SA(0, 0), cA, voffA); PG8_STAGE(PG8_SA(0, 1), cA + hstep, voffA);
        if (wr == 1) PG8_BAR;
        PG8_WAIT_V(2); PG8_BAR;
        PG8_STAGE(PG8_SB(1, 0), cB + kstep, voffB); PG8_STAGE(PG8_SA(1, 0), cA + kstep, voffA); PG8_STAGE(PG8_SB(1, 1), cB + hstep + kstep, voffB);
        PG8_WAIT_V(6); PG8_BAR;
    } else {
        PG8_STAGE(PG8_SB(0, 0), cB, voffB); PG8_STAGE(PG8_SA(0, 0), cA, voffA); PG8_STAGE(PG8_SB(0, 1), cB + hstep, voffB); PG8_STAGE(PG8_SA(0, 1), cA + hstep, voffA);
        if (wr == 1) PG8_BAR;
        PG8_WAIT_V(4); PG8_BAR;
        PG8_STAGE(PG8_SB(1, 0), cB + kstep, voffB); PG8_STAGE(PG8_SA(1, 0), cA + kstep, voffA); PG8_STAGE(PG8_SB(1, 1), cB + hstep + kstep, voffB);
        PG8_WAIT_V(6); PG8_BAR;
    }
    for (;;) {
        const bool has_next = S.next(ui + 1, nxt);
        const char* nA = has_next ? (const char*)g.A + (size_t)nxt.pm * tstep : cA; const char* nB = has_next ? (const char*)g.Bt + (size_t)nxt.pn * tstep : cB;
        for (int t = 0; t < nt; t += 2) {
            const bool last = (t == nt - 2);
            const char* a1 = cA + (size_t)(t + 1) * kstep;
            const char* a2 = last ? nA : cA + (size_t)(t + 2) * kstep; const char* b2 = last ? nB : cB + (size_t)(t + 2) * kstep;
            const char* a3 = a2 + kstep; const char* b3 = b2 + kstep;
            if (last && has_next) S.a_ready(nxt);
            if constexpr (SP2) {
            PG8_LDB(B0, 0, 0); PG8_LDB(B1, 0, 1); PG8_SCHED; PG8_LDA(At, 0, 0); PG8_STAGE(PG8_SA(1, 1), a1 + hstep, voffA);
            PG8_WAIT_V(8); PG8_WAIT_L(0); PG8_BAR; PG8_MMA(0, 0, At, B0); PG8_MMA(0, 1, At, B1); PG8_BAR; PG8_SCHED;
            PG8_LDA(At, 0, 1); PG8_STAGE(PG8_SB(0, 0), b2, voffB); PG8_STAGE(PG8_SB(0, 1), b2 + hstep, voffB); PG8_STAGE(PG8_SA(0, 0), a2, voffA);
            PG8_WAIT_V(8); PG8_WAIT_L(0); PG8_BAR; PG8_MMA(1, 0, At, B0); PG8_MMA(1, 1, At, B1); PG8_BAR; PG8_SCHED;
            PG8_LDB(B0, 1, 0); PG8_LDB(B1, 1, 1); PG8_SCHED; PG8_LDA(At, 1, 0); PG8_STAGE(PG8_SA(0, 1), a2 + hstep, voffA);
            PG8_WAIT_V(8); PG8_WAIT_L(0); PG8_BAR; PG8_MMA(0, 0, At, B0); PG8_MMA(0, 1, At, B1); PG8_BAR; PG8_SCHED;
            PG8_LDA(At, 1, 1); PG8_STAGE(PG8_SB(1, 0), b3, voffB); PG8_STAGE(PG8_SB(1, 1), b3 + hstep, voffB); PG8_STAGE(PG8_SA(1, 0), a3, voffA);
            PG8_WAIT_V(8); PG8_WAIT_L(0); PG8_BAR; PG8_MMA(1, 0, At, B0); PG8_MMA(1, 1, At, B1); PG8_BAR; PG8_SCHED;
            } else {
            PG8_LDB(B0, 0, 0); PG8_SCHED; PG8_LDA(At, 0, 0); PG8_STAGE(PG8_SA(1, 1), a1 + hstep, voffA);
            PG8_WAIT_L(8); PG8_BAR; PG8_WAIT_L(0); PG8_MMA(0, 0, At, B0); PG8_BAR; PG8_SCHED;
            PG8_LDB(B1, 0, 1); PG8_STAGE(PG8_SB(0, 0), b2, voffB);
            PG8_BAR; PG8_WAIT_L(0); PG8_MMA(0, 1, At, B1); PG8_BAR;
            PG8_LDA(At, 0, 1); PG8_STAGE(PG8_SA(0, 0), a2, voffA);
            PG8_BAR; PG8_WAIT_L(0); PG8_MMA(1, 0, At, B0); PG8_BAR; PG8_SCHED;
            PG8_STAGE(PG8_SB(0, 1), b2 + hstep, voffB);
            PG8_WAIT_V(6); PG8_BAR; PG8_MMA(1, 1, At, B1); PG8_BAR;
            PG8_LDB(B0, 1, 0); PG8_SCHED; PG8_LDA(At, 1, 0); PG8_STAGE(PG8_SA(0, 1), a2 + hstep, voffA);
            PG8_WAIT_L(8); PG8_BAR; PG8_WAIT_L(0); PG8_MMA(0, 0, At, B0); PG8_BAR; PG8_SCHED;
            PG8_LDB(B1, 1, 1); PG8_STAGE(PG8_SB(1, 0), b3, voffB);
            PG8_BAR; PG8_WAIT_L(0); PG8_MMA(0, 1, At, B1); PG8_BAR;
            PG8_LDA(At, 1, 1); PG8_STAGE(PG8_SA(1, 0), a3, voffA);
            PG8_BAR; PG8_WAIT_L(0); PG8_MMA(1, 0, At, B0); PG8_BAR; PG8_SCHED;
            PG8_STAGE(PG8_SB(1, 1), b3 + hstep, voffB);
            PG8_WAIT_V(6); PG8_BAR; PG8_MMA(1, 1, At, B1); PG8_BAR;
            }
        }
        if constexpr (ALIGN_EPI) { if (wr == 0) PG8_BAR; }
        if constexpr (!Epi::AFTER_DRAIN) { E(acc, cur, wr, wc, fr, fq); S.done(cur); }
        if (!has_next) break;
#pragma unroll
        for (int a = 0; a < 2; ++a)
#pragma unroll
            for (int b = 0; b < 2; ++b)
#pragma unroll
                for (int m = 0; m < 4; ++m)
#pragma unroll
                    for (int n = 0; n < 2; ++n) acc[a][b][m][n] = (f32x4){0.f, 0.f, 0.f, 0.f};
        cur = nxt; cA = nA; cB = nB; ++ui;
        if constexpr (ALIGN_EPI) { if (wr == 1) PG8_BAR; }
    }
    PG8_WAIT_V(0);
    if constexpr (!ALIGN_EPI) { if (wr == 0) PG8_BAR; }
    PG8_BAR;
    if constexpr (Epi::AFTER_DRAIN) { E.fused(acc, cur, wr, wc, fr, fq, lds, wid, lane); S.done(cur); }
#undef PG8_SA
#undef PG8_SB
#undef PG8_STAGE
#undef PG8_LDA
#undef PG8_LDB
#undef PG8_MMA
#undef PG8_WAIT_V
#undef PG8_WAIT_L
#undef PG8_BAR
#undef PG8_SCHED
}
}
namespace att {
constexpr int D = 128;
#if F8_KVQ
constexpr int VSTR = 12288;
#else
constexpr int VSTR = 128;
#endif
constexpr int WINDOW = 4096;
constexpr float THR = 8.f;
constexpr bool WSKIP = false;
constexpr float SCALE = 0.08838834764831845f;
constexpr int NW = 8, QBLK = 32, KVBLK = 64, QB = NW * QBLK;
constexpr int SHM_V = KVBLK * D * 2, SHM_K = KVBLK * D * 2;
constexpr int LDS_BYTES = 2 * SHM_V + 2 * SHM_K + NW * 64 * 4;
using bf16 = __hip_bfloat16;
typedef short bf16x8 __attribute__((ext_vector_type(8)));
typedef short s16x4 __attribute__((ext_vector_type(4)));
typedef float f32x16 __attribute__((ext_vector_type(16)));
typedef float f32x4 __attribute__((ext_vector_type(4)));
typedef unsigned u32x4 __attribute__((ext_vector_type(4)));
template <class A, class Bt> struct same_t { static constexpr bool v = false; };
template <class A> struct same_t<A, A> { static constexpr bool v = true; };

#define KSWZ(row, colB) ((row) * 256 + ((colB) ^ (((row) & 7) << 4)))
#define SBAR() __builtin_amdgcn_sched_barrier(0)
__device__ __forceinline__ int v_st(int k, int c) { const int kk = (k & ~0xC) | ((k & 4) << 1) | ((k & 8) >> 1); return ((kk >> 3) * 4 + (c >> 5)) * 512 + ((kk & 7) * 32 + (c & 31)) * 2; }
__device__ __forceinline__ int v_rd_base(int lane) { return ((lane & 3) << 3) | (((lane >> 2) & 3) << 6) | (((lane >> 4) & 1) << 5) | (((lane >> 5) & 1) << 8); }
constexpr int v_rd_off(int d0, int ks, int half) { return d0 * 512 + ks * 4096 + half * 2048; }
__device__ __forceinline__ int crow(int r, int hi) { return (r & 3) + 8 * (r >> 2) + 4 * hi; }
__device__ __forceinline__ unsigned cvtpk(float lo, float hi) {
    unsigned r; asm volatile("v_cvt_pk_bf16_f32 %0, %1, %2" : "=v"(r) : "v"(lo), "v"(hi)); return r;
}
__device__ __forceinline__ bf16x8 pack8(f32x4 a, f32x4 b) {
    u32x4 w = {cvtpk(a[0], a[1]), cvtpk(a[2], a[3]), cvtpk(b[0], b[1]), cvtpk(b[2], b[3])};
    return *reinterpret_cast<bf16x8*>(&w);
}
template <class T> __device__ __forceinline__ bf16x8 load8(const T* p) {
    if constexpr (same_t<T, float>::v) { return pack8(*(const f32x4*)p, *(const f32x4*)(p + 4)); }
    else { return *reinterpret_cast<const bf16x8*>(p); }
}
__device__ __forceinline__ void mask_tile(f32x16& p0, f32x16& p1, int dq, unsigned W) {
    const float NEG = -__builtin_inff();
#pragma unroll
    for (int r = 0; r < 16; ++r) {
        const int c = (r & 3) + 8 * (r >> 2);
        if ((unsigned)(dq - c) >= W) p0[r] = NEG;
        if ((unsigned)(dq - c - 32) >= W) p1[r] = NEG;
    }
}
__device__ __forceinline__ void partialSM(f32x16& p0, f32x16& p1, float& m_reg, float& mn, float& alpha) {
    float pmax = p0[0]; for (int r = 1; r < 16; ++r) pmax = fmaxf(pmax, p0[r]); for (int r = 0; r < 16; ++r) pmax = fmaxf(pmax, p1[r]);
    { auto rr = __builtin_amdgcn_permlane32_swap(__float_as_uint(pmax), __float_as_uint(pmax), false, false);
      pmax = fmaxf(__uint_as_float(rr[0]), __uint_as_float(rr[1])); }
    constexpr float C2 = 1.4426950408889634f * SCALE;
    if (__builtin_expect(__all((pmax - m_reg) * SCALE <= THR), 1)) { mn = m_reg; alpha = 1.f; }
    else { mn = fmaxf(m_reg, pmax); alpha = __builtin_amdgcn_exp2f((m_reg - mn) * C2); m_reg = mn; }
    const float mnL = -mn * C2;
    for (int r = 0; r < 16; ++r) p0[r] = fmaf(p0[r], C2, mnL); for (int r = 0; r < 16; ++r) p1[r] = fmaf(p1[r], C2, mnL);
    for (int r = 0; r < 16; ++r) p0[r] = __builtin_amdgcn_exp2f(p0[r]);
}
__device__ __forceinline__ void finishSM(f32x16& p0, f32x16& p1, float alpha, float& l_reg, bf16x8& pa0, bf16x8& pa1, bf16x8& pa2, bf16x8& pa3) {
    for (int r = 0; r < 16; ++r) p1[r] = __builtin_amdgcn_exp2f(p1[r]);
    float ps = 0; for (int r = 0; r < 16; ++r) ps += p0[r]; for (int r = 0; r < 16; ++r) ps += p1[r];
    { auto rr = __builtin_amdgcn_permlane32_swap(__float_as_uint(ps), __float_as_uint(ps), false, false);
      ps = __uint_as_float(rr[0]) + __uint_as_float(rr[1]); }
    l_reg = l_reg * alpha + ps;
#define PK4(P, B_, OUT) do { unsigned a0 = cvtpk(P[B_+0], P[B_+1]), a1 = cvtpk(P[B_+2], P[B_+3]);                          \
        unsigned b0 = cvtpk(P[B_+4], P[B_+5]), b1 = cvtpk(P[B_+6], P[B_+7]);                                             \
        auto r0 = __builtin_amdgcn_permlane32_swap(a0, b0, false, false); auto r1 = __builtin_amdgcn_permlane32_swap(a1, b1, false, false); \
        u32x4 w = {r0[0], r1[0], r0[1], r1[1]}; OUT = *reinterpret_cast<bf16x8*>(&w); } while (0)
    PK4(p0, 0, pa0); PK4(p0, 8, pa1); PK4(p1, 0, pa2); PK4(p1, 8, pa3);
#undef PK4
}
template <int KB, bool SK>
__device__ __forceinline__ void qkt(f32x16& p0, f32x16& p1, const char* K_lds, int r32, int hi, const bf16x8* qr, bool act) {
    if (SK && !act) { const float NEG = -__builtin_inff();
#pragma unroll
        for (int r = 0; r < 16; ++r) { p0[r] = NEG; p1[r] = NEG; } return; }
    p0 = f32x16{}; p1 = f32x16{};
    const char* kb[4];
#pragma unroll
    for (int dd = 0; dd < 4; ++dd) kb[dd] = K_lds + KB * SHM_K + KSWZ(r32, (dd * 16 + hi * 8) * 2);
#pragma unroll
    for (int d0 = 0; d0 < 8; ++d0) { const char* a = kb[d0 & 3] + (d0 >> 2) * 128;
        bf16x8 b0 = *reinterpret_cast<const bf16x8*>(a);
        bf16x8 b1 = *reinterpret_cast<const bf16x8*>(a + 32 * 256);
        p0 = __builtin_amdgcn_mfma_f32_32x32x16_bf16(b0, qr[d0], p0, 0, 0, 0);
        p1 = __builtin_amdgcn_mfma_f32_32x32x16_bf16(b1, qr[d0], p1, 0, 0, 0); }
}
template <int VB, bool SK>
__device__ __forceinline__ void pv_tile(f32x16* o, int vb0, bf16x8 pa0, bf16x8 pa1, bf16x8 pa2, bf16x8 pa3, bool act) {
    if (SK && !act) return;
#define TRRD(dst, off) asm volatile("ds_read_b64_tr_b16 %0, %1 offset:%2" : "=&v"(dst) : "v"(vb0), "i"(off) : "memory")
#define PV_D0(d0) do { s16x4 l0, l1, l2, l3, h0, h1, h2, h3; constexpr int b_ = VB * SHM_V + v_rd_off(d0, 0, 0);     \
        TRRD(l0, b_); TRRD(h0, b_ + 2048); TRRD(l1, b_ + 4096); TRRD(h1, b_ + 6144); TRRD(l2, b_ + 8192); TRRD(h2, b_ + 10240); TRRD(l3, b_ + 12288); TRRD(h3, b_ + 14336); \
        asm volatile("s_waitcnt lgkmcnt(0)" ::: "memory"); SBAR();                 \
        o[d0] = __builtin_amdgcn_mfma_f32_32x32x16_bf16(pa0, (bf16x8){l0[0], l0[1], l0[2], l0[3], h0[0], h0[1], h0[2], h0[3]}, o[d0], 0, 0, 0);   \
        o[d0] = __builtin_amdgcn_mfma_f32_32x32x16_bf16(pa1, (bf16x8){l1[0], l1[1], l1[2], l1[3], h1[0], h1[1], h1[2], h1[3]}, o[d0], 0, 0, 0);   \
        o[d0] = __builtin_amdgcn_mfma_f32_32x32x16_bf16(pa2, (bf16x8){l2[0], l2[1], l2[2], l2[3], h2[0], h2[1], h2[2], h2[3]}, o[d0], 0, 0, 0);   \
        o[d0] = __builtin_amdgcn_mfma_f32_32x32x16_bf16(pa3, (bf16x8){l3[0], l3[1], l3[2], l3[3], h3[0], h3[1], h3[2], h3[3]}, o[d0], 0, 0, 0); } while (0)
    PV_D0(0); PV_D0(1); PV_D0(2); PV_D0(3);
#undef PV_D0
#undef TRRD
}

template <class TIn, class TOut> struct BlockRef { const TIn* Q; const TIn* K; const TIn* V; TOut* O; int P0; };
template <class TIn> struct Seam {
    bf16x8 qr[8];
    bf16x8 st_v0, st_v1, st_k0, st_k1; f32x4 sf0, sf1, sf2, sf3;
    f32x4 tq[16];
};
__device__ __forceinline__ int swa_jlo(int P0, int W) { const int lowk = P0 - W + 1; return lowk > 0 ? lowk / KVBLK : 0; }
#define ROW(p, k0, rr) ((p) + (size_t)((k0) + (rr)) * D + sc)
#define ROWV(p, k0, rr) ((p) + (size_t)((k0) + (rr)) * VSTR + sc)
#define VMW() asm volatile("s_waitcnt vmcnt(0)" ::: "memory")
#define VMWN(n) asm volatile("s_waitcnt vmcnt(%0)" :: "i"(n) : "memory")
#define SLOAD_H(Kp, Vp, k0) do { S.st_v0 = load8<TIn>(ROWV(Vp, k0, sr)); S.st_v1 = load8<TIn>(ROWV(Vp, k0, 32 + sr));              \
                         S.st_k0 = load8<TIn>(ROW(Kp, k0, sr)); S.st_k1 = load8<TIn>(ROW(Kp, k0, 32 + sr)); } while (0)
#define SWRITE_HK(bf) do { *(bf16x8*)(K_lds + (bf) * SHM_K + kws) = S.st_k0; *(bf16x8*)(K_lds + (bf) * SHM_K + kws + 32 * 256) = S.st_k1; } while (0)
#define SWRITE_HV(bf) do { *(bf16x8*)(V_lds + (bf) * SHM_V + vst0) = S.st_v0; *(bf16x8*)(V_lds + (bf) * SHM_V + vst1) = S.st_v1; } while (0)
#define SWRITE_H(bf) do { SWRITE_HV(bf); SWRITE_HK(bf); } while (0)
#define SLOAD_F(p, k0) do { S.sf0 = *(const f32x4*)ROW(p, k0, sr); S.sf1 = *(const f32x4*)(ROW(p, k0, sr) + 4);                \
                            S.sf2 = *(const f32x4*)ROW(p, k0, 32 + sr); S.sf3 = *(const f32x4*)(ROW(p, k0, 32 + sr) + 4); } while (0)
#define SWRITE_KF(bf) do { *(bf16x8*)(K_lds + (bf) * SHM_K + kws) = pack8(S.sf0, S.sf1); *(bf16x8*)(K_lds + (bf) * SHM_K + kws + 32 * 256) = pack8(S.sf2, S.sf3); } while (0)
#define SWRITE_VF(bf) do { *(bf16x8*)(V_lds + (bf) * SHM_V + vst0) = pack8(S.sf0, S.sf1); *(bf16x8*)(V_lds + (bf) * SHM_V + vst1) = pack8(S.sf2, S.sf3); } while (0)
template <class TIn, class TOut>
__device__ __forceinline__ void causal_swa_prime(const BlockRef<TIn, TOut>& cur, int W, char* lds, Seam<TIn>& S) {
    constexpr bool F32 = same_t<TIn, float>::v;
    const int tid = threadIdx.x, wid = __builtin_amdgcn_readfirstlane(tid >> 6), lane = tid & 63, r32 = lane & 31, hi = lane >> 5;
    const int sr = tid >> 4, sc = (tid & 15) * 8, kws = KSWZ(sr, sc * 2); char* K_lds = lds + 2 * SHM_V;
    const int kb0 = swa_jlo(cur.P0, W) * KVBLK;
    for (int d0 = 0; d0 < 8; ++d0) S.qr[d0] = load8<TIn>(cur.Q + (size_t)(wid * QBLK + r32) * D + d0 * 16 + hi * 8);
    if constexpr (F32) { SLOAD_F((const float*)cur.K, kb0); VMW(); SWRITE_KF(0); SBAR(); SLOAD_F((const float*)cur.V, kb0); }
    else { SLOAD_H(cur.K, cur.V, kb0); VMW(); SWRITE_HK(0); }
    __syncthreads();
}
template <class TIn, class TOut>
__device__ __forceinline__ void causal_swa_block(const BlockRef<TIn, TOut>& cur, const BlockRef<TIn, TOut>& nxt, int skv, int W, char* lds, Seam<TIn>& S) {
    constexpr bool F32 = same_t<TIn, float>::v;
    const int tid = threadIdx.x, wid = __builtin_amdgcn_readfirstlane(tid >> 6), lane = tid & 63, r32 = lane & 31, hi = lane >> 5;
    const int j_lo = swa_jlo(cur.P0, W);
    int j_hi = (cur.P0 + QB - 1) / KVBLK + 1; if (j_hi > skv / KVBLK) j_hi = skv / KVBLK;
    const int NT = j_hi - j_lo;
    const int kbn = swa_jlo(nxt.P0, W) * KVBLK;
    const int qlo = cur.P0 + wid * QBLK, qm = qlo + r32 - 4 * hi;
    char* V_lds = lds; char* K_lds = lds + 2 * SHM_V;
    float* ws = (float*)(lds + 2 * SHM_V + 2 * SHM_K) + wid * 64; float* li_l = ws, * al_l = ws + 32;
    float m_reg = -1e30f, l_reg = 0; f32x16 o[4] = {};
    const int sr = tid >> 4, sc = (tid & 15) * 8, vst0 = v_st(sr, sc), vst1 = v_st(32 + sr, sc), kws = KSWZ(sr, sc * 2);
    const int vb0 = (int)(uintptr_t)V_lds + v_rd_base(lane);
    const TIn* Kh = cur.K; const TIn* Vh = cur.V;
#define RESC(a) do { if (__any((a) < 1.f)) { if (hi == 0) al_l[r32] = (a); asm volatile("s_waitcnt lgkmcnt(0)" ::: "memory");              \
                     for (int d_ = 0; d_ < 4; ++d_) for (int r = 0; r < 16; ++r) o[d_][r] *= al_l[crow(r, hi)]; } } while (0)
#define KBASE(t) ((j_lo + (t)) * KVBLK)
#define ACT(t) (KBASE(t) <= qlo + QBLK - 1 && KBASE(t) + KVBLK - 1 >= qlo - W + 1)
#define MASKT(P0_, P1_, t) do { const int kb_ = KBASE(t); if ((!SK || ACT(t)) && (kb_ + KVBLK - 1 > qlo || kb_ <= qlo + QBLK - 1 - W)) mask_tile(P0_, P1_, qm - kb_, (unsigned)W); } while (0)
    constexpr int NQL = F32 ? 16 : 8;
    constexpr bool SK = WSKIP && !F32;
#define SEAM_K0() do { VMWN(NQL); if constexpr (F32) { SWRITE_KF(0); SBAR(); SLOAD_F((const float*)nxt.V, kbn); } else { SWRITE_HK(0); } SBAR(); } while (0)
    f32x16 pA0, pA1, pB0, pB1; float mnA, mnB, alA, alB; bf16x8 pa0, pa1, pa2, pa3;
    if constexpr (F32) { VMW(); SWRITE_VF(0); SBAR(); } else { SWRITE_HV(0); SBAR(); }
    if (NT > 1) { if constexpr (F32) SLOAD_F((const float*)Kh, KBASE(1)); else SLOAD_H(Kh, Vh, KBASE(1)); }
    SBAR(); qkt<0, SK>(pA0, pA1, K_lds, r32, hi, S.qr, ACT(0));
    if constexpr (F32) { if (NT > 1) { VMW(); SWRITE_KF(1); SBAR(); SLOAD_F((const float*)Vh, KBASE(1)); } }
    MASKT(pA0, pA1, 0); partialSM(pA0, pA1, m_reg, mnA, alA);
    if (NT > 1) { VMW(); if constexpr (F32) { SWRITE_VF(1); SBAR(); if (NT > 2) SLOAD_F((const float*)Kh, KBASE(2)); } else SWRITE_H(1); }
    __syncthreads();
#define HALF_STEP(PX0, PX1, mnX, alX, PY0, PY1, alY, t, KB, VB, SB) do {                                                      \
        SBAR(); qkt<KB, SK>(PX0, PX1, K_lds, r32, hi, S.qr, ACT(t));                                             \
        finishSM(PY0, PY1, alY, l_reg, pa0, pa1, pa2, pa3); SBAR();                                                           \
        if ((t) + 1 < NT) { if constexpr (F32) { VMW(); SWRITE_KF(SB); SBAR(); SLOAD_F((const float*)Vh, KBASE((t) + 1)); }  \
                            else { SLOAD_H(Kh, Vh, KBASE((t) + 1)); } SBAR(); }                                               \
        pv_tile<VB, SK>(o, vb0, pa0, pa1, pa2, pa3, ACT((t) - 1)); MASKT(PX0, PX1, (t)); partialSM(PX0, PX1, m_reg, mnX, alX);                                        \
        __syncthreads();                                                                                                      \
        if ((t) + 1 < NT) { VMW(); if constexpr (F32) { SWRITE_VF(SB); SBAR(); if ((t) + 2 < NT) SLOAD_F((const float*)Kh, KBASE((t) + 2)); } \
                            else { SWRITE_H(SB); } }                                                                          \
        RESC(alX); __syncthreads(); } while (0)
    for (int t = 1; t + 1 < NT; t += 2) {
        HALF_STEP(pB0, pB1, mnB, alB, pA0, pA1, alA, t, 1, 0, 0);
        HALF_STEP(pA0, pA1, mnA, alA, pB0, pB1, alB, t + 1, 0, 1, 1);
    }
    const bool even = (NT & 1) == 0;
    if (even) { SBAR(); qkt<1, SK>(pB0, pB1, K_lds, r32, hi, S.qr, ACT(NT - 1)); SBAR(); }
#define QROW(e) (nxt.Q + (size_t)(wid * QBLK + r32) * D + ((e) >> 1) * 16 + hi * 8 + ((e) & 1) * 4)
    if constexpr (F32) { SLOAD_F((const float*)nxt.K, kbn); SBAR();
#pragma unroll
        for (int e = 0; e < 8; ++e) S.tq[e] = *(const f32x4*)QROW(e); }
    else { SLOAD_H(nxt.K, nxt.V, kbn); SBAR();
#pragma unroll
        for (int d0 = 0; d0 < 8; ++d0) S.qr[d0] = load8<TIn>(nxt.Q + (size_t)(wid * QBLK + r32) * D + d0 * 16 + hi * 8); }
    SBAR();
    finishSM(pA0, pA1, alA, l_reg, pa0, pa1, pa2, pa3); SBAR();
    if constexpr (F32) {
#pragma unroll
        for (int e = 8; e < 16; ++e) S.tq[e] = *(const f32x4*)QROW(e); SBAR(); }
#undef QROW
    pv_tile<0, SK>(o, vb0, pa0, pa1, pa2, pa3, ACT(even ? NT - 2 : NT - 1));
    if (even) { MASKT(pB0, pB1, NT - 1); partialSM(pB0, pB1, m_reg, mnB, alB); __syncthreads(); RESC(alB);
        finishSM(pB0, pB1, alB, l_reg, pa0, pa1, pa2, pa3); SBAR(); pv_tile<1, SK>(o, vb0, pa0, pa1, pa2, pa3, ACT(NT - 1)); }
    SBAR(); SEAM_K0();
    if (hi == 0) li_l[r32] = l_reg; asm volatile("s_waitcnt lgkmcnt(0)" ::: "memory");
    float rli[16];
#pragma unroll
    for (int r = 0; r < 16; ++r) rli[r] = __builtin_amdgcn_rcpf(li_l[crow(r, hi)]);
    TOut* Ow = cur.O + (size_t)(wid * QBLK) * D;
#pragma unroll
    for (int r = 0; r < 16; ++r) { const int orow = crow(r, hi);
#pragma unroll
        for (int d0 = 0; d0 < 4; ++d0) { const float v = o[d0][r] * rli[r];
            if constexpr (same_t<TOut, float>::v) { Ow[(size_t)orow * D + d0 * 32 + r32] = v; }
            else { const float vn = __shfl_xor(v, 1);
                   if ((r32 & 1) == 0) *(unsigned*)(Ow + (size_t)orow * D + d0 * 32 + r32) = cvtpk(v, vn); } } }
    if constexpr (F32) {
#pragma unroll
        for (int d0 = 0; d0 < 8; ++d0) S.qr[d0] = pack8(S.tq[2 * d0], S.tq[2 * d0 + 1]); }
    __syncthreads();
#undef RESC
#undef KBASE
#undef ACT
#undef MASKT
#undef SEAM_K0
#undef HALF_STEP
}
#undef ROW
#undef ROWV
#undef VMW
#undef VMWN
#undef SLOAD_H
#undef SWRITE_HK
#undef SWRITE_HV
#undef SWRITE_H
#undef SLOAD_F
#undef SWRITE_KF
#undef SWRITE_VF
}
struct Ctx { LAS unsigned char* lds; int tid, lane, wave, vcu, G; };

__device__ __forceinline__ void tr_item(const float* __restrict__ src, size_t ldn, const float* __restrict__ gain, bfr* __restrict__ dst, int K,
                                        int k0, int nsrc0, int drow0, LAS float* scr, int lane) {
    const int r4 = lane >> 4, c4 = (lane & 15) * 4;
    f4v v[16];
#pragma unroll
    for (int i = 0; i < 16; ++i) v[i] = *(const f4v*)(src + (size_t)(k0 + 4 * i + r4) * ldn + nsrc0 + c4);
#pragma unroll
    for (int i = 0; i < 16; ++i) { const int k = 4 * i + r4; const float gk = gain ? gain[k0 + k] : 1.f;
        LAS float* s = scr + k * 65 + c4; s[0] = v[i][0] * gk; s[1] = v[i][1] * gk; s[2] = v[i][2] * gk; s[3] = v[i][3] * gk; }
    LDS_WAIT(); asm volatile("" ::: "memory");
    const int c = lane & 7;
#pragma unroll
    for (int jj = 0; jj < 8; ++jj) { const int n = (lane >> 3) + 8 * jj; const LAS float* s = scr + (8 * c) * 65 + n;
        u4v o; o.x = cvtpk(s[0 * 65], s[1 * 65]); o.y = cvtpk(s[2 * 65], s[3 * 65]); o.z = cvtpk(s[4 * 65], s[5 * 65]); o.w = cvtpk(s[6 * 65], s[7 * 65]);
        *(u4v*)(dst + (size_t)(drow0 + n) * K + k0 + 8 * c) = o; }
    LDS_WAIT(); asm volatile("" ::: "memory");
}
__device__ __forceinline__ void tr_item8(const float* __restrict__ src, size_t ldn, float sc, const float* __restrict__ gain, unsigned char* __restrict__ dst, int K, int k0, int nsrc0, int drow0, LAS float* scr, int lane) {
    const int r4 = lane >> 4, c4 = (lane & 15) * 4;
    f4v v[16];
#pragma unroll
    for (int i = 0; i < 16; ++i) v[i] = *(const f4v*)(src + (size_t)(k0 + 4 * i + r4) * ldn + nsrc0 + c4);
#pragma unroll
    for (int i = 0; i < 16; ++i) { const int k = 4 * i + r4; const float gk = gain ? gain[k0 + k] * sc : sc; LAS float* s = scr + k * 65 + c4; s[0] = v[i][0] * gk; s[1] = v[i][1] * gk; s[2] = v[i][2] * gk; s[3] = v[i][3] * gk; }
    LDS_WAIT(); asm volatile("" ::: "memory");
    const int c = lane & 3;
#pragma unroll
    for (int jj = 0; jj < 4; ++jj) { const int n = (lane >> 2) + 16 * jj; const LAS float* s = scr + (16 * c) * 65 + n;
        u4v o; o.x = cvt4_fp8(s[0 * 65], s[1 * 65], s[2 * 65], s[3 * 65]); o.y = cvt4_fp8(s[4 * 65], s[5 * 65], s[6 * 65], s[7 * 65]);
        o.z = cvt4_fp8(s[8 * 65], s[9 * 65], s[10 * 65], s[11 * 65]); o.w = cvt4_fp8(s[12 * 65], s[13 * 65], s[14 * 65], s[15 * 65]);
        *(u4v*)(dst + (size_t)(drow0 + n) * K + k0 + 16 * c) = o; }
    LDS_WAIT(); asm volatile("" ::: "memory");
}
__device__ __forceinline__ void tr_job8(const float* __restrict__ src, size_t ldn, float sc, const float* __restrict__ gain, unsigned char* __restrict__ dst, int K, int ncols, LAS float* scr, int lane, int gw, int NGW, int nsrc0 = 0) {
    const int nn = ncols / 64, ni = (K / 64) * nn;
    for (int it = gw; it < ni; it += NGW) { const int kb = it / nn, nb = it - kb * nn; tr_item8(src, ldn, sc, gain, dst, K, kb * 64, nsrc0 + nb * 64, nb * 64, scr, lane); }
}
__device__ __forceinline__ void tr_job(const float* __restrict__ src, size_t ldn, const float* __restrict__ gain, bfr* __restrict__ dst, int K, int ncols, int nsrc0, int drow0,
                                       LAS float* scr, int lane, int gw, int NGW) {
    const int nn = ncols / 64, ni = (K / 64) * nn;
    for (int it = gw; it < ni; it += NGW) { const int kb = it / nn, nb = it - kb * nn;
        tr_item(src, ldn, gain, dst, K, kb * 64, nsrc0 + nb * 64, drow0 + nb * 64, scr, lane); }
}
struct KArgs {
    const float* in[26]; float* out; unsigned char* ws; int ph_lo, ph_hi, li, pad;
};
struct Ptrs {
    LAS unsigned long long* tbl;
    __device__ __forceinline__ unsigned long long get(int k) const { const unsigned long long v = tbl[k];
        return ((unsigned long long)(unsigned)__builtin_amdgcn_readfirstlane((int)(unsigned)(v >> 32)) << 32) | (unsigned)__builtin_amdgcn_readfirstlane((int)(unsigned)v); }
    __device__ __forceinline__ const float* in_(int k) const { return (const float*)get(k); }
    __device__ __forceinline__ float* out_() const { return (float*)get(26); }
    __device__ __forceinline__ unsigned char* ws_() const { return (unsigned char*)get(27); }
};
__device__ __forceinline__ void p_convert(const Ctx& C, const Ptrs& P) {
    LAS float* scr = (LAS float*)(C.lds + C.wave * 16640);
    const int gw = C.vcu * 8 + C.wave, NGW = C.G * 8;
    unsigned char* ws = P.ws_();
#if F8_PROJ0 == 1
    tr_job8(P.in_(2), (size_t)GIN, SU, P.in_(1), ws + WS_WTIN, DM, 16384, scr, C.lane, gw, NGW);
#elif F8_PROJ0 == 2
    tr_job(P.in_(2), (size_t)GIN, P.in_(1), (bfr*)(ws + WS_WTIN), DM, 8192, 0, 0, scr, C.lane, gw, NGW);
    tr_job8(P.in_(2), (size_t)GIN, SU, P.in_(1), ws + WS_WTIN + (size_t)8192 * DM * 2, DM, 8192, scr, C.lane, gw, NGW, 8192);
#elif F8_PROJ0 == 3
    tr_job8(P.in_(2), (size_t)GIN, SU, P.in_(1), ws + WS_WTIN, DM, 8192, scr, C.lane, gw, NGW, 0);
    tr_job(P.in_(2), (size_t)GIN, P.in_(1), (bfr*)(ws + WS_WTIN + (size_t)8192 * DM), DM, 8192, 8192, 0, scr, C.lane, gw, NGW);
#else
    tr_job(P.in_(2), (size_t)GIN, P.in_(1), (bfr*)(ws + WS_WTIN), DM, 16384, 0, 0, scr, C.lane, gw, NGW);
#endif
    tr_job(P.in_(2), (size_t)GIN, P.in_(1), (bfr*)(ws + WS_WTBD), DM, 64, 16384, 0, scr, C.lane, gw, NGW);
#if F8_OUT0
    tr_job8(P.in_(7), (size_t)DM, SU, nullptr, ws + WS_WTOUT, DM, DM, scr, C.lane, gw, NGW, 0);
#else
    tr_job(P.in_(7), (size_t)DM, nullptr, (bfr*)(ws + WS_WTOUT), DM, DM, 0, 0, scr, C.lane, gw, NGW);
#endif
#if F8_KVQ
    tr_job8(P.in_(9), (size_t)8192, SU, P.in_(8), ws + WS_WTKVQ, DM, DM, scr, C.lane, gw, NGW, 0);
    tr_job8(P.in_(12), (size_t)DM, SU, P.in_(11), ws + WS_WTKVQ + (size_t)DM * DM, DM, DM, scr, C.lane, gw, NGW, 0);
#if F8_KVQ == 2
    tr_job8(P.in_(9), (size_t)8192, SU, P.in_(8), ws + WS_WTKVQ + (size_t)2 * DM * DM, DM, DM, scr, C.lane, gw, NGW, DM);
#else
    tr_job(P.in_(9), (size_t)8192, P.in_(8), (bfr*)(ws + WS_WTKVQ + (size_t)2 * DM * DM), DM, DM, DM, 0, scr, C.lane, gw, NGW);
#endif
#else
    tr_job(P.in_(9), (size_t)8192, P.in_(8), (bfr*)(ws + WS_WTKVQ), DM, 8192, 0, 0, scr, C.lane, gw, NGW);
    tr_job(P.in_(12), (size_t)DM, P.in_(11), (bfr*)(ws + WS_WTKVQ), DM, DM, 0, 8192, scr, C.lane, gw, NGW);
#endif
#if F8_OUT1
    tr_job8(P.in_(19), (size_t)DM, SU, nullptr, ws + WS_WTO, DM, DM, scr, C.lane, gw, NGW, 0);
#else
    tr_job(P.in_(19), (size_t)DM, nullptr, (bfr*)(ws + WS_WTO), DM, DM, 0, 0, scr, C.lane, gw, NGW);
#endif
    tr_job(P.in_(21), (size_t)PQ, P.in_(20), (bfr*)(ws + WS_WTQRY), DM, PQ, 0, 0, scr, C.lane, gw, NGW);
    tr_job(P.in_(21) + (size_t)DM * PQ, (size_t)PQ, P.in_(20) + DM, (bfr*)(ws + WS_WTQRY) + (size_t)PQ * DM, DM, PQ, 0, 0, scr, C.lane, gw, NGW);
    tr_job8(P.in_(25), (size_t)DM, SV, nullptr, ws + WS_VT, PE, DM, scr, C.lane, gw, NGW);
    tr_job8(P.in_(25) + (size_t)PE * DM, (size_t)DM, SV, nullptr, ws + WS_VT + (size_t)DM * PE, PE, DM, scr, C.lane, gw, NGW);
    {
        const size_t gt = (size_t)C.vcu * 512 + C.tid, GT = (size_t)C.G * 512;
        for (int l = 0; l < 2; ++l) {
            const float* src = P.in_(24) + (size_t)l * PE * DM; const float* gain = P.in_(20) + l * DM; unsigned char* dst = ws + WS_U + (size_t)l * PE * DM;
            for (size_t i = gt; i < (size_t)PE * DM / 16; i += GT) {
                const f4v a = *(const f4v*)(src + i * 16), b = *(const f4v*)(src + i * 16 + 4), c = *(const f4v*)(src + i * 16 + 8), d = *(const f4v*)(src + i * 16 + 12);
                const int dd = (int)((i * 16) & (DM - 1)); const f4v ga = *(const f4v*)(gain + dd) * SU, gb = *(const f4v*)(gain + dd + 4) * SU, gc = *(const f4v*)(gain + dd + 8) * SU, gd = *(const f4v*)(gain + dd + 12) * SU;
                u4v o; o.x = cvt4_fp8(a[0] * ga[0], a[1] * ga[1], a[2] * ga[2], a[3] * ga[3]); o.y = cvt4_fp8(b[0] * gb[0], b[1] * gb[1], b[2] * gb[2], b[3] * gb[3]);
                o.z = cvt4_fp8(c[0] * gc[0], c[1] * gc[1], c[2] * gc[2], c[3] * gc[3]); o.w = cvt4_fp8(d[0] * gd[0], d[1] * gd[1], d[2] * gd[2], d[3] * gd[3]);
                *(u4v*)(dst + i * 16) = o; }
        }
        for (int l = 0; l < 2; ++l) {
            bfr* dst = (bfr*)(ws + WS_WTKEY) + (size_t)l * PQ * PQ;
            for (size_t i = gt; i < (size_t)PQ * PQ / 8; i += GT) {
                const int row = (int)((i * 8) / PQ), col = (int)((i * 8) % PQ); u4v o = {0u, 0u, 0u, 0u};
                if ((row >> 7) == (col >> 7)) { const int blk = row >> 7, h = blk >> 1, half = blk & 1, n = row & 127, d = col & 127;
                    const float* src = (half ? P.in_(23) : P.in_(22)) + (((size_t)l * PH + h) * PK + n) * 128 + d;
                    const f4v a = *(const f4v*)src, b = *(const f4v*)(src + 4);
                    o.x = cvtpk(a[0], a[1]); o.y = cvtpk(a[2], a[3]); o.z = cvtpk(b[0], b[1]); o.w = cvtpk(b[2], b[3]); }
                *(u4v*)(dst + i * 8) = o; }
        }
    }
}

__device__ __forceinline__ void p_norm_rows(const Ctx& C, const float* __restrict__ src, bfr* __restrict__ dst, unsigned char* __restrict__ dst8) {
    const int gw = C.vcu * 8 + C.wave, NGW = C.G * 8;
    for (int row = gw; row < NT; row += NGW) {
        const f4v* p = (const f4v*)(src + (size_t)row * DM);
        f4v a[8], b[8]; float ss = 0.f;
#pragma unroll
        for (int j = 0; j < 8; ++j) { a[j] = p[j * 128 + 2 * C.lane]; b[j] = p[j * 128 + 2 * C.lane + 1]; }
#pragma unroll
        for (int j = 0; j < 8; ++j) ss += (a[j][0] * a[j][0] + a[j][1] * a[j][1]) + (a[j][2] * a[j][2] + a[j][3] * a[j][3]) + (b[j][0] * b[j][0] + b[j][1] * b[j][1]) + (b[j][2] * b[j][2] + b[j][3] * b[j][3]);
        const float r = __builtin_amdgcn_rsqf(wave_sum(ss) * (1.f / DM) + EPS);
        u4v* o = (u4v*)(dst + (size_t)row * DM);
#pragma unroll
        for (int j = 0; j < 8; ++j) { u4v w; w.x = cvtpk(a[j][0] * r, a[j][1] * r); w.y = cvtpk(a[j][2] * r, a[j][3] * r); w.z = cvtpk(b[j][0] * r, b[j][1] * r); w.w = cvtpk(b[j][2] * r, b[j][3] * r);
            if (dst) o[j * 64 + C.lane] = w;
            if (dst8) { u2v w8; w8.x = cvt4_fp8(a[j][0] * r, a[j][1] * r, a[j][2] * r, a[j][3] * r); w8.y = cvt4_fp8(b[j][0] * r, b[j][1] * r, b[j][2] * r, b[j][3] * r); ((u2v*)(dst8 + (size_t)row * DM))[j * 64 + C.lane] = w8; } }
    }
}

__device__ __forceinline__ void p_bd(const Ctx& C, const bfr* __restrict__ XN, const bfr* __restrict__ WB, float* __restrict__ BD) {
    LAS float* red = (LAS float*)C.lds;
    const int r = C.lane & 15, q = C.lane >> 4, rt = C.wave >> 2, kq = C.wave & 3;
    for (int blk = C.vcu; blk < NT / 32; blk += C.G) {
        const bfr* ap = XN + (size_t)(blk * 32 + rt * 16 + r) * DM + kq * 1024 + q * 8;
        const bfr* bp = WB + (size_t)r * DM + kq * 1024 + q * 8;
        f4v acc[4] = {zero_acc(), zero_acc(), zero_acc(), zero_acc()};
#pragma unroll 4
        for (int ks = 0; ks < 32; ++ks) {
            const s8v a = *(const s8v*)(ap + ks * 32);
#pragma unroll
            for (int nt = 0; nt < 4; ++nt) { const s8v b = *(const s8v*)(bp + (size_t)nt * 16 * DM + ks * 32); acc[nt] = __builtin_amdgcn_mfma_f32_16x16x32_bf16(a, b, acc[nt], 0, 0, 0); }
            MFMA_SETTLE(acc[0]); MFMA_SETTLE(acc[1]); MFMA_SETTLE(acc[2]); MFMA_SETTLE(acc[3]);
        }
        MFMA_SETTLE(acc[0]); MFMA_SETTLE(acc[1]); MFMA_SETTLE(acc[2]); MFMA_SETTLE(acc[3]);
#pragma unroll
        for (int nt = 0; nt < 4; ++nt)
#pragma unroll
            for (int i = 0; i < 4; ++i) red[C.wave * 1024 + (4 * q + i) * 64 + nt * 16 + r] = -acc[nt][i];
        __syncthreads();
#pragma unroll
        for (int i = 0; i < 4; ++i) { const int idx = C.tid * 4 + i, t2 = idx >> 10, rem = idx & 1023;
            const float s = -((red[(t2 * 4 + 0) * 1024 + rem] + red[(t2 * 4 + 1) * 1024 + rem]) + (red[(t2 * 4 + 2) * 1024 + rem] + red[(t2 * 4 + 3) * 1024 + rem]));
            BD[(size_t)(blk * 32 + t2 * 16 + (rem >> 6)) * 64 + (rem & 63)] = s; }
        __syncthreads();
    }
}
__device__ __forceinline__ int kq_off(int row, int chunk) { return row * 256 + ((chunk ^ (row & 7)) << 4); }
__device__ __forceinline__ int xt_off(int col, int chunk) { return col * 128 + ((chunk ^ (col & 7)) << 4); }
__device__ __forceinline__ void p_gdn_prep(const Ctx& C, const Ptrs& P) {
    unsigned char* ws = P.ws_();
    const bfr* PROJ = (const bfr*)(ws + WS_BIG); const float* BD = (const float*)(ws + WS_BD);
    const float* convw = P.in_(3); const float* alog = P.in_(4); const float* dtb = P.in_(5);
    bfr* Wg = (bfr*)(ws + WS_R + R_W); bfr* Ug = (bfr*)(ws + WS_R + R_U); bfr* QGg = (bfr*)(ws + WS_R + R_QG); bfr* KDg = (bfr*)(ws + WS_R + R_KD); bfr* QKg = (bfr*)(ws + WS_R + R_QK);
    float* EGg = (float*)(ws + WS_EG);
    LAS float* sCW = (LAS float*)(C.lds + 82944);
    for (int wq = C.vcu; wq < NB * GH * 4; wq += C.G) {
        const int bh = wq >> 2, cg = wq & 3, h = bh & 31, b = bh >> 5;
        for (int i = C.tid; i < 1536; i += 512) { const int part = i >> 9, tap = (i >> 7) & 3, ch = i & 127; sCW[i] = convw[tap * 12288 + part * 4096 + h * 128 + ch]; }
        __syncthreads();
        for (int it = 0; it < 8; ++it) {
            int tid = C.tid; asm volatile("" : "+v"(tid));
            const int hw = tid >> 8, lt = tid & 255, lane = tid & 63, lw = (tid >> 6) & 3;
            const int c = cg * 16 + it * 2 + hw, unit = bh * 64 + c, t0 = b * SEQ + c * CH;
            LAS unsigned char* hb = C.lds + hw * 41472;
            LAS unsigned char* sK = hb; LAS unsigned char* sQ = hb + 16384; LAS unsigned char* sX = hb;
            LAS unsigned char* sAM = hb + 32768; LAS float* sB = (LAS float*)(hb + 40960); LAS float* sG = (LAS float*)(hb + 41216);
            LAS float* scr = (LAS float*)(C.lds + 89088 + (tid >> 6) * 4352);
            LAS float* sAD = (LAS float*)(C.lds + 123904 + hw * 4096);
            if (lt < 64) {
                const int t = t0 + lt; const float braw = BD[(size_t)t * 64 + h], araw = BD[(size_t)t * 64 + 32 + h];
                const float beta = 1.f / (1.f + expf(-braw)); const float xx = araw + dtb[h]; const float sp = fmaxf(xx, 0.f) + log1pf(expf(-fabsf(xx)));
                float g = -expf(alog[h]) * sp;
#pragma unroll
                for (int o = 1; o < 64; o <<= 1) { const float y = __shfl_up(g, o); if (lane >= o) g += y; }
                sB[lt] = beta; sG[lt] = g;
            }
            __syncthreads();
            const int tk = lt >> 2, cs = lt & 3;
            const float beta = sB[tk], gc = sG[tk], gl = sG[63]; const float eg = expf(gc), ed = expf(gl - gc), bg = beta * eg;
            u4v kbg[4], vbt[4];
#pragma unroll
            for (int part = 0; part < 3; ++part) {
                float y[32];
#pragma unroll
                for (int i = 0; i < 32; ++i) y[i] = 0.f;
#pragma unroll
                for (int j = 0; j < 4; ++j) {
                    const int s = c * CH + tk - 3 + j;
                    if (s >= 0) {
                        const bfr* row = PROJ + (size_t)(b * SEQ + s) * 16384 + part * 4096 + h * 128 + cs * 32;
#pragma unroll
                        for (int q4 = 0; q4 < 4; ++q4) { const u4v x = *(const u4v*)(row + 8 * q4); const LAS float* wp = sCW + part * 512 + j * 128 + cs * 32 + 8 * q4;
                            const f4v w0 = *(const LAS f4v*)wp, w1 = *(const LAS f4v*)(wp + 4);
                            y[8 * q4 + 0] += bflo(x.x) * w0[0]; y[8 * q4 + 1] += bfhi(x.x) * w0[1]; y[8 * q4 + 2] += bflo(x.y) * w0[2]; y[8 * q4 + 3] += bfhi(x.y) * w0[3];
                            y[8 * q4 + 4] += bflo(x.z) * w1[0]; y[8 * q4 + 5] += bfhi(x.z) * w1[1]; y[8 * q4 + 6] += bflo(x.w) * w1[2]; y[8 * q4 + 7] += bfhi(x.w) * w1[3]; }
                    }
                }
                float ss = 0.f;
#pragma unroll
                for (int i = 0; i < 32; ++i) { y[i] = y[i] * __builtin_amdgcn_rcpf(1.f + __expf(-y[i])); ss += y[i] * y[i]; }
                if (part < 2) {
                    ss += __shfl_xor(ss, 1); ss += __shfl_xor(ss, 2);
                    const float rn = __builtin_amdgcn_rsqf(ss + EPS) * (part == 0 ? 0.08838834764831845f : 1.f); const float gs = part == 0 ? eg : ed;
                    LAS unsigned char* dstl = part == 0 ? sQ : sK; bfr* dstg = (part == 0 ? QGg : KDg) + (size_t)unit * 8192 + tk * 128 + cs * 32;
#pragma unroll
                    for (int q4 = 0; q4 < 4; ++q4) { float z[8];
#pragma unroll
                        for (int i = 0; i < 8; ++i) z[i] = y[8 * q4 + i] * rn;
                        u4v w; w.x = cvtpk(z[0], z[1]); w.y = cvtpk(z[2], z[3]); w.z = cvtpk(z[4], z[5]); w.w = cvtpk(z[6], z[7]);
                        *(LAS u4v*)(dstl + kq_off(tk, cs * 4 + q4)) = w;
                        u4v g; g.x = cvtpk(z[0] * gs, z[1] * gs); g.y = cvtpk(z[2] * gs, z[3] * gs); g.z = cvtpk(z[4] * gs, z[5] * gs); g.w = cvtpk(z[6] * gs, z[7] * gs);
                        *(u4v*)(dstg + 8 * q4) = g;
                        if (part == 1) { kbg[q4].x = cvtpk(z[0] * bg, z[1] * bg); kbg[q4].y = cvtpk(z[2] * bg, z[3] * bg); kbg[q4].z = cvtpk(z[4] * bg, z[5] * bg); kbg[q4].w = cvtpk(z[6] * bg, z[7] * bg); } }
                } else {
#pragma unroll
                    for (int q4 = 0; q4 < 4; ++q4) { vbt[q4].x = cvtpk(y[8 * q4] * beta, y[8 * q4 + 1] * beta); vbt[q4].y = cvtpk(y[8 * q4 + 2] * beta, y[8 * q4 + 3] * beta);
                        vbt[q4].z = cvtpk(y[8 * q4 + 4] * beta, y[8 * q4 + 5] * beta); vbt[q4].w = cvtpk(y[8 * q4 + 6] * beta, y[8 * q4 + 7] * beta); }
                }
            }
            __syncthreads();
            {
                const int r = lane & 15, q = lane >> 4, mt = lw;
                s8v ak[4], aq[4];
#pragma unroll
                for (int ks = 0; ks < 4; ++ks) { ak[ks] = *(const LAS s8v*)(sK + kq_off(16 * mt + r, 4 * ks + q)); aq[ks] = *(const LAS s8v*)(sQ + kq_off(16 * mt + r, 4 * ks + q)); }
                float gi[4], bi[4];
#pragma unroll
                for (int e = 0; e < 4; ++e) { gi[e] = sG[16 * mt + 4 * q + e]; bi[e] = sB[16 * mt + 4 * q + e]; }
                for (int nt = 0; nt < 4; ++nt) {
                    const int j = 16 * nt + r;
                    if (nt <= mt) {
                        f4v ck = zero_acc(), cq = zero_acc();
#pragma unroll
                        for (int ks = 0; ks < 4; ++ks) { const s8v bb = *(const LAS s8v*)(sK + kq_off(16 * nt + r, 4 * ks + q));
                            ck = __builtin_amdgcn_mfma_f32_16x16x32_bf16(ak[ks], bb, ck, 0, 0, 0); cq = __builtin_amdgcn_mfma_f32_16x16x32_bf16(aq[ks], bb, cq, 0, 0, 0); }
                        MFMA_SETTLE(ck); MFMA_SETTLE(cq);
                        const float gj = sG[j];
#pragma unroll
                        for (int e = 0; e < 4; ++e) { const int i = 16 * mt + 4 * q + e; const float dec = expf(fminf(gi[e] - gj, 0.f));
                            const float av = (i > j) ? bi[e] * ck[e] * dec : 0.f;
                            *(LAS bfr*)(sAM + xt_off(i, j >> 3) + (j & 7) * 2) = f2bf1(av);
                            if (nt == mt) sAD[mt * 256 + (4 * q + e) * 16 + r] = av;
                            QKg[(size_t)unit * 4096 + i * 64 + j] = f2bf1((i >= j) ? cq[e] * dec : 0.f); }
                    } else {
#pragma unroll
                        for (int e = 0; e < 4; ++e) QKg[(size_t)unit * 4096 + (16 * mt + 4 * q + e) * 64 + j] = (bfr)0;
                    }
                }
            }
            __syncthreads();
            {
                const int ro = ((tk >> 3)), rb = (tk & 7) * 2;
#pragma unroll
                for (int q4 = 0; q4 < 4; ++q4) {
                    const unsigned vv[4] = {vbt[q4].x, vbt[q4].y, vbt[q4].z, vbt[q4].w}, kk[4] = {kbg[q4].x, kbg[q4].y, kbg[q4].z, kbg[q4].w};
#pragma unroll
                    for (int i = 0; i < 8; ++i) { const int ch = cs * 32 + q4 * 8 + i;
                        *(LAS bfr*)(sX + xt_off(ch, ro) + rb) = (bfr)((i & 1) ? (vv[i >> 1] >> 16) : (vv[i >> 1] & 0xffffu));
                        *(LAS bfr*)(sX + xt_off(128 + ch, ro) + rb) = (bfr)((i & 1) ? (kk[i >> 1] >> 16) : (kk[i >> 1] & 0xffffu)); }
                }
            }
            __syncthreads();
            {
                const int r = lane & 15, q = lane >> 4;
                float x[64];
#pragma unroll
                for (int bk = 0; bk < 4; ++bk) {
                    float corr[16];
#pragma unroll
                    for (int i = 0; i < 16; ++i) corr[i] = 0.f;
                    if (bk > 0) {
                        f4v acc[4] = {zero_acc(), zero_acc(), zero_acc(), zero_acc()};
#pragma unroll
                        for (int ks = 0; ks < (16 * bk + 31) / 32; ++ks) {
                            s8v a = *(const LAS s8v*)(sAM + xt_off(16 * bk + r, 4 * ks + q));
                            if (32 * ks + 8 * q >= 16 * bk) a = (s8v){0, 0, 0, 0, 0, 0, 0, 0};
#pragma unroll
                            for (int nt = 0; nt < 4; ++nt) { const s8v bx = *(const LAS s8v*)(sX + xt_off(64 * lw + 16 * nt + r, 4 * ks + q)); acc[nt] = __builtin_amdgcn_mfma_f32_16x16x32_bf16(a, bx, acc[nt], 0, 0, 0); }
                        }
                        MFMA_SETTLE(acc[0]); MFMA_SETTLE(acc[1]); MFMA_SETTLE(acc[2]); MFMA_SETTLE(acc[3]);
#pragma unroll
                        for (int nt = 0; nt < 4; ++nt)
#pragma unroll
                            for (int e = 0; e < 4; ++e) scr[(16 * nt + r) * 17 + 4 * q + e] = -acc[nt][e];
                        LDS_WAIT(); asm volatile("" ::: "memory");
#pragma unroll
                        for (int i = 0; i < 16; ++i) corr[i] = scr[lane * 17 + i];
                    }
                    const u4v r0 = *(const LAS u4v*)(sX + xt_off(lt, 2 * bk)), r1 = *(const LAS u4v*)(sX + xt_off(lt, 2 * bk + 1));
                    const float rhs[16] = {bflo(r0.x), bfhi(r0.x), bflo(r0.y), bfhi(r0.y), bflo(r0.z), bfhi(r0.z), bflo(r0.w), bfhi(r0.w), bflo(r1.x), bfhi(r1.x), bflo(r1.y), bfhi(r1.y), bflo(r1.z), bfhi(r1.z), bflo(r1.w), bfhi(r1.w)};
                    float xb[16];
#pragma unroll
                    for (int i = 0; i < 16; ++i) {
                        float v = rhs[i] + corr[i];
                        const u4v a0 = *(const LAS u4v*)(sAM + xt_off(16 * bk + i, 2 * bk)), a1 = *(const LAS u4v*)(sAM + xt_off(16 * bk + i, 2 * bk + 1));
                        const float am[16] = {bflo(a0.x), bfhi(a0.x), bflo(a0.y), bfhi(a0.y), bflo(a0.z), bfhi(a0.z), bflo(a0.w), bfhi(a0.w), bflo(a1.x), bfhi(a1.x), bflo(a1.y), bfhi(a1.y), bflo(a1.z), bfhi(a1.z), bflo(a1.w), bfhi(a1.w)};
#pragma unroll
                        for (int j = 0; j < 16; ++j) if (j < i) v -= am[j] * xb[j];
                        xb[i] = v; x[16 * bk + i] = v;
                    }
                    u4v w0, w1; w0.x = cvtpk(xb[0], xb[1]); w0.y = cvtpk(xb[2], xb[3]); w0.z = cvtpk(xb[4], xb[5]); w0.w = cvtpk(xb[6], xb[7]);
                    w1.x = cvtpk(xb[8], xb[9]); w1.y = cvtpk(xb[10], xb[11]); w1.z = cvtpk(xb[12], xb[13]); w1.w = cvtpk(xb[14], xb[15]);
                    *(LAS u4v*)(sX + xt_off(lt, 2 * bk)) = w0; *(LAS u4v*)(sX + xt_off(lt, 2 * bk + 1)) = w1;
                    LDS_WAIT(); asm volatile("" ::: "memory");
                }
                bfr* dst = (lt < 128 ? Ug : Wg) + (size_t)unit * 8192 + (lt & 127);
#pragma unroll
                for (int i = 0; i < 64; ++i) dst[i * 128] = f2bf1(x[i]);
                if (lt == 0) EGg[unit] = expf(sG[63]);
            }
            __syncthreads();
        }
    }
}

__device__ __forceinline__ void p_gdn_scan(const Ctx& C, const Ptrs& P) {
    unsigned char* ws = P.ws_();
    const GAS bfr* Wg = (const GAS bfr*)(ws + WS_R + R_W); const GAS bfr* Ug = (const GAS bfr*)(ws + WS_R + R_U); const GAS bfr* QGg = (const GAS bfr*)(ws + WS_R + R_QG); const GAS bfr* KDg = (const GAS bfr*)(ws + WS_R + R_KD);
    const GAS bfr* QKg = (const GAS bfr*)(ws + WS_R + R_QK); GAS bfr* Og = (GAS bfr*)(ws + WS_R + R_O); const GAS float* EGg = (const GAS float*)(ws + WS_EG);
    const int tid = C.tid, lane = C.lane, wave = C.wave, r = lane & 15, q = lane >> 4, mt = wave & 3, nt = wave >> 2;
    LAS bfr* sST = (LAS bfr*)(C.lds + 131072); LAS bfr* sVN = (LAS bfr*)(C.lds + 139776);
#define SC_W(bb)  ((LAS bfr*)(C.lds + (bb) * 65536))
#define SC_QG(bb) ((LAS bfr*)(C.lds + (bb) * 65536 + 17408))
#define SC_KD(bb) ((LAS bfr*)(C.lds + (bb) * 65536 + 34816))
#define SC_QK(bb) ((LAS bfr*)(C.lds + (bb) * 65536 + 52224))
#define SC_U(bb)  ((LAS bfr*)(C.lds + (bb) * 65536 + 61440))
#define SC_LOAD(n) do { const size_t ub = (size_t)(bh * 64 + (n)) * 8192; \
        rW0 = *(const GAS u4v*)(Wg + ub + (size_t)tid * 8); rW1 = *(const GAS u4v*)(Wg + ub + (size_t)(tid + 512) * 8); \
        rQ0 = *(const GAS u4v*)(QGg + ub + (size_t)tid * 8); rQ1 = *(const GAS u4v*)(QGg + ub + (size_t)(tid + 512) * 8); \
        rK0 = *(const GAS u4v*)(KDg + ub + (size_t)tid * 8); rK1 = *(const GAS u4v*)(KDg + ub + (size_t)(tid + 512) * 8); \
        rQK = *(const GAS u4v*)(QKg + (size_t)(bh * 64 + (n)) * 4096 + (size_t)tid * 8); \
        if (tid < 256) rU = *(const GAS u4v*)(Ug + ub + (size_t)(tid >> 2) * 128 + es * 32 + (tid & 3) * 8); } while (0)
#define SC_WRITE(bb) do { const int c0 = tid, c1 = tid + 512; \
        *(LAS u4v*)(SC_W(bb) + (c0 >> 4) * 136 + (c0 & 15) * 8) = rW0; *(LAS u4v*)(SC_W(bb) + (c1 >> 4) * 136 + (c1 & 15) * 8) = rW1; \
        *(LAS u4v*)(SC_QG(bb) + (c0 >> 4) * 136 + (c0 & 15) * 8) = rQ0; *(LAS u4v*)(SC_QG(bb) + (c1 >> 4) * 136 + (c1 & 15) * 8) = rQ1; \
        *(LAS u4v*)(SC_KD(bb) + (c0 >> 4) * 136 + (c0 & 15) * 8) = rK0; *(LAS u4v*)(SC_KD(bb) + (c1 >> 4) * 136 + (c1 & 15) * 8) = rK1; \
        *(LAS u4v*)(SC_QK(bb) + (tid >> 3) * 72 + (tid & 7) * 8) = rQK; \
        if (tid < 256) *(LAS u4v*)(SC_U(bb) + (tid >> 2) * 32 + (tid & 3) * 8) = rU; } while (0)
    for (int task = C.vcu; task < NB * GH * 4; task += C.G) {
        const int bh = task >> 2, es = task & 3, h = bh & 31, b = bh >> 5;
        u4v rW0, rW1, rQ0, rQ1, rK0, rK1, rQK, rU = {0u, 0u, 0u, 0u};
        f4v S0 = {0.f, 0.f, 0.f, 0.f}, S1 = {0.f, 0.f, 0.f, 0.f};
        LAS float* sEG = (LAS float*)(C.lds + 144384);
        if (tid < 64) sEG[tid] = EGg[bh * 64 + tid];
        SC_LOAD(0); SC_WRITE(0); SC_LOAD(1);
        for (int n = 0; n < NCH; ++n) {
            const int bb = n & 1;
            {
                MFMA_SETTLE(S0); MFMA_SETTLE(S1);
                u2v w0, w1; w0.x = cvtpk(S0[0], S0[1]); w0.y = cvtpk(S0[2], S0[3]); w1.x = cvtpk(S1[0], S1[1]); w1.y = cvtpk(S1[2], S1[3]);
                *(LAS u2v*)(sST + (r) * 136 + 16 * wave + 4 * q) = w0; *(LAS u2v*)(sST + (16 + r) * 136 + 16 * wave + 4 * q) = w1;
            }
            __syncthreads();
            if (n + 1 < NCH) { if (bb) SC_WRITE(0); else SC_WRITE(1); if (n + 2 < NCH) SC_LOAD(n + 2); }
            f4v acc1 = zero_acc(), acc2 = zero_acc();
            const LAS bfr* pW = SC_W(bb) + (16 * mt + r) * 136 + 8 * q; const LAS bfr* pQ = SC_QG(bb) + (16 * mt + r) * 136 + 8 * q; const LAS bfr* pS = sST + (16 * nt + r) * 136 + 8 * q;
#pragma unroll
            for (int ks = 0; ks < 4; ++ks) { const s8v a1 = *(const LAS s8v*)(pW + 32 * ks), a2 = *(const LAS s8v*)(pQ + 32 * ks), bs = *(const LAS s8v*)(pS + 32 * ks);
                acc1 = __builtin_amdgcn_mfma_f32_16x16x32_bf16(a1, bs, acc1, 0, 0, 0); acc2 = __builtin_amdgcn_mfma_f32_16x16x32_bf16(a2, bs, acc2, 0, 0, 0); }
            MFMA_SETTLE(acc1);
            {
                const LAS bfr* pU = SC_U(bb) + (16 * mt + 4 * q) * 32 + 16 * nt + r;
                const float v0 = bf1(pU[0]) - acc1[0], v1 = bf1(pU[32]) - acc1[1], v2 = bf1(pU[64]) - acc1[2], v3 = bf1(pU[96]) - acc1[3];
                u2v w; w.x = cvtpk(v0, v1); w.y = cvtpk(v2, v3);
                *(LAS u2v*)(sVN + (16 * nt + r) * 72 + 16 * mt + 4 * q) = w;
            }
            __syncthreads();
            {
                const LAS bfr* pA = SC_QK(bb) + (16 * mt + r) * 72 + 8 * q; const LAS bfr* pV = sVN + (16 * nt + r) * 72 + 8 * q;
#pragma unroll
                for (int ks = 0; ks < 2; ++ks) { const s8v a = *(const LAS s8v*)(pA + 32 * ks), bv = *(const LAS s8v*)(pV + 32 * ks); acc2 = __builtin_amdgcn_mfma_f32_16x16x32_bf16(a, bv, acc2, 0, 0, 0); }
                MFMA_SETTLE(acc2);
                GAS bfr* po = Og + (size_t)(b * SEQ + n * CH + 16 * mt + 4 * q) * DM + h * 128 + es * 32 + 16 * nt + r;
                po[0] = f2bf1(acc2[0]); po[DM] = f2bf1(acc2[1]); po[2 * DM] = f2bf1(acc2[2]); po[3 * DM] = f2bf1(acc2[3]);
            }
            {
                const float eg = sEG[n];
                S0 *= eg; S1 *= eg;
                const LAS bfr* pK = SC_KD(bb) + (8 * q) * 136 + 16 * wave + r; const LAS bfr* pV0 = sVN + r * 72 + 8 * q; const LAS bfr* pV1 = sVN + (16 + r) * 72 + 8 * q;
#pragma unroll
                for (int ks = 0; ks < 2; ++ks) {
                    s8v a;
#pragma unroll
                    for (int i = 0; i < 8; ++i) a[i] = (short)pK[(32 * ks + i) * 136];
                    const s8v b0 = *(const LAS s8v*)(pV0 + 32 * ks), b1 = *(const LAS s8v*)(pV1 + 32 * ks);
                    S0 = __builtin_amdgcn_mfma_f32_16x16x32_bf16(a, b0, S0, 0, 0, 0); S1 = __builtin_amdgcn_mfma_f32_16x16x32_bf16(a, b1, S1, 0, 0, 0);
                }
            }
        }
        __syncthreads();
    }
#undef SC_W
#undef SC_QG
#undef SC_KD
#undef SC_QK
#undef SC_U
#undef SC_LOAD
#undef SC_WRITE
}

#define S2_OFF_QG 17408
#define S2_OFF_QK 34816
#define S2_OFF_KT 44032
#define S2_OFF_U  62464
#define S2_BUF    66560
__device__ __forceinline__ s8v s2_frag(const LAS bfr* rowp, int q) {
    const u2v lo = *(const LAS u2v*)(rowp + 4 * q), hi = *(const LAS u2v*)(rowp + 16 + 4 * q);
    const u4v w = {lo.x, lo.y, hi.x, hi.y}; return __builtin_bit_cast(s8v, w);
}
__device__ __forceinline__ s8v s2_fragx(const LAS bfr* rowp, int g0, int g1) {
    const u2v lo = *(const LAS u2v*)(rowp + 4 * g0), hi = *(const LAS u2v*)(rowp + 4 * g1);
    const u4v w = {lo.x, lo.y, hi.x, hi.y}; return __builtin_bit_cast(s8v, w);
}
__device__ __forceinline__ s8v s2_pack(const f4v& a, const f4v& b) { const u4v w = {cvtpk(a[0], a[1]), cvtpk(a[2], a[3]), cvtpk(b[0], b[1]), cvtpk(b[2], b[3])}; return __builtin_bit_cast(s8v, w); }
template <int MODE = 0>
__device__ __forceinline__ void p_gdn_scan2(const Ctx& C, const Ptrs& P) {
    unsigned char* ws = P.ws_();
    const GAS bfr* Wg = (const GAS bfr*)(ws + WS_R + R_W); const GAS bfr* Ug = (const GAS bfr*)(ws + WS_R + R_U); const GAS bfr* QGg = (const GAS bfr*)(ws + WS_R + R_QG); const GAS bfr* KDg = (const GAS bfr*)(ws + WS_R + R_KD);
    const GAS bfr* QKg = (const GAS bfr*)(ws + WS_R + R_QK); GAS bfr* Og = (GAS bfr*)(ws + (MODE ? WS_SC : WS_R + R_O)); const GAS float* EGg = (const GAS float*)(ws + WS_EG);
    const int tid = C.tid, lane = C.lane, wave = C.wave, r = lane & 15, q = lane >> 4;
    LAS float* sEG = (LAS float*)(C.lds + 2 * S2_BUF);
    for (int task = C.vcu; task < NB * GH * 4; task += C.G) {
        const int bh = task >> 2, es = task & 3, h = bh & 31, b = bh >> 5;
        if (tid < 64) sEG[tid] = EGg[bh * 64 + tid];
        if (wave >= 2) {
            const int lw = __builtin_amdgcn_readfirstlane((tid - 128) & ~63);
            __builtin_assume(lw >= 0 && lw <= 320);
            const GAS unsigned char* RB = (const GAS unsigned char*)(ws + WS_R);
            const unsigned l16 = lane * 16, lU = (lane >> 2) * 256 + (lane & 3) * 16 + es * 64;
            const unsigned lrow = (lane >> 4) * 272 + (lane & 15) * 16, lqk = (lane >> 3) * 144 + (lane & 7) * 16, lkt = (lane & 15) * 8 * 144 + (lane >> 4) * 2;
            const int lsw = (lane & 15) >> 1;
            u4v ra[10], rb[10];
#define S2_LOAD(R, n) do { const unsigned ua_ = (unsigned)(bh * 64 + ((MODE == 2 || MODE == 4) ? 0 : (n))) * 16384u; _Pragma("unroll") for (int k_ = 0; k_ < 10; ++k_) { const int c0_ = lw + 384 * k_; \
        if (c0_ < 1024) R[k_] = *(const GAS u4v*)(RB + (size_t)((unsigned)R_W + ua_ + c0_ * 16) + l16); \
        else if (c0_ < 2048) R[k_] = *(const GAS u4v*)(RB + (size_t)((unsigned)R_QG + ua_ + (c0_ - 1024) * 16) + l16); \
        else if (c0_ < 2560) R[k_] = *(const GAS u4v*)(RB + (size_t)((unsigned)R_QK + (ua_ >> 1) + (c0_ - 2048) * 16) + l16); \
        else if (c0_ < 2816) R[k_] = *(const GAS u4v*)(RB + (size_t)((unsigned)R_U + ua_ + ((c0_ - 2560) >> 2) * 256) + lU); \
        else R[k_] = *(const GAS u4v*)(RB + (size_t)((unsigned)R_KD + ua_ + (c0_ - 2816) * 16) + l16); } } while (0)
#define S2_WRITE(R, bb) do { LAS unsigned char* B_ = C.lds + (bb) * S2_BUF; _Pragma("unroll") for (int k_ = 0; k_ < 10; ++k_) { const int c0_ = lw + 384 * k_; \
        if (c0_ < 1024) *(LAS u4v*)(B_ + (c0_ >> 4) * 272 + lrow) = R[k_]; \
        else if (c0_ < 2048) *(LAS u4v*)(B_ + S2_OFF_QG + ((c0_ - 1024) >> 4) * 272 + lrow) = R[k_]; \
        else if (c0_ < 2560) *(LAS u4v*)(B_ + S2_OFF_QK + ((c0_ - 2048) >> 3) * 144 + lqk) = R[k_]; \
        else if (c0_ < 2816) *(LAS u4v*)(B_ + S2_OFF_U + (c0_ - 2560) * 16 + l16) = R[k_]; \
        else { const int g_ = (c0_ - 2816) >> 6; LAS bfr* kt_ = (LAS bfr*)(B_ + S2_OFF_KT + lkt + ((g_ ^ lsw) << 3)); const unsigned w_[4] = {R[k_].x, R[k_].y, R[k_].z, R[k_].w}; \
            _Pragma("unroll") for (int i_ = 0; i_ < 8; ++i_) kt_[i_ * 72] = (bfr)((i_ & 1) ? (w_[i_ >> 1] >> 16) : (w_[i_ >> 1] & 0xffffu)); } } } while (0)
            u4v rc[10];
            S2_LOAD(ra, 0); S2_WRITE(ra, 0);
            S2_LOAD(rb, 1); S2_LOAD(rc, 2); S2_LOAD(ra, 3);
            __syncthreads();
#define S2_STEP(R, bb, n_) { S2_WRITE(R, bb); S2_LOAD(R, (n_) + 4); __syncthreads(); }
            for (int n = 0; n < NCH - 4; n += 6) {
                S2_STEP(rb, 1, n) S2_STEP(rc, 0, n + 1) S2_STEP(ra, 1, n + 2) S2_STEP(rb, 0, n + 3) S2_STEP(rc, 1, n + 4) S2_STEP(ra, 0, n + 5)
            }
            static_assert((NCH - 4) % 6 == 0, "scan loader schedule");
            S2_WRITE(rb, 1); __syncthreads(); S2_WRITE(rc, 0); __syncthreads(); S2_WRITE(ra, 1); __syncthreads(); __syncthreads();
#undef S2_STEP
#undef S2_LOAD
#undef S2_WRITE
        } else {
            const int nt = wave;
            f4v S[8];
#pragma unroll
            for (int w = 0; w < 8; ++w) S[w] = zero_acc();
            __syncthreads();
            for (int n = 0; n < NCH; ++n) {
                if (MODE == 3 || MODE == 4) { __syncthreads(); continue; }
                const LAS unsigned char* B = C.lds + (n & 1) * S2_BUF;
                const LAS bfr* sW = (const LAS bfr*)B; const LAS bfr* sQG = (const LAS bfr*)(B + S2_OFF_QG); const LAS bfr* sQK = (const LAS bfr*)(B + S2_OFF_QK);
                const LAS bfr* sKT = (const LAS bfr*)(B + S2_OFF_KT); const LAS bfr* sU = (const LAS bfr*)(B + S2_OFF_U);
#define S2_STAGE() asm volatile("" ::: "memory")
#define S2_LOADQ(F, mt) do { _Pragma("unroll") for (int ks = 0; ks < 4; ++ks) { F[ks] = s2_frag(sW + (16 * (mt) + r) * 136 + 32 * ks, q); F[4 + ks] = s2_frag(sQG + (16 * (mt) + r) * 136 + 32 * ks, q); } } while (0)
#define S2_MMQ(F, mt) do { _Pragma("unroll") for (int ks = 0; ks < 4; ++ks) { a1[mt] = __builtin_amdgcn_mfma_f32_16x16x32_bf16(F[ks], Bs[ks], a1[mt], 0, 0, 0); \
        a2[mt] = __builtin_amdgcn_mfma_f32_16x16x32_bf16(F[4 + ks], Bs[ks], a2[mt], 0, 0, 0); } } while (0)
                s8v fA[8], fB[8];
                S2_LOADQ(fA, 0); S2_LOADQ(fB, 1);
                s8v Bs[4];
#pragma unroll
                for (int ks = 0; ks < 4; ++ks) Bs[ks] = s2_pack(S[2 * ks], S[2 * ks + 1]);
                f4v a1[4], a2[4];
#pragma unroll
                for (int mt = 0; mt < 4; ++mt) { a1[mt] = zero_acc(); a2[mt] = zero_acc(); }
                S2_STAGE();
                S2_MMQ(fA, 0); S2_STAGE(); S2_LOADQ(fA, 2); S2_STAGE();
                S2_MMQ(fB, 1); S2_STAGE(); S2_LOADQ(fB, 3);
                bfr ur[16]; s8v fa[8];
#pragma unroll
                for (int mt = 0; mt < 4; ++mt) { const LAS bfr* pU = sU + (16 * mt + 4 * q) * 32 + 16 * nt + r; ur[4 * mt] = pU[0]; ur[4 * mt + 1] = pU[32]; ur[4 * mt + 2] = pU[64]; ur[4 * mt + 3] = pU[96]; }
                S2_STAGE();
                S2_MMQ(fA, 2); S2_STAGE();
#pragma unroll
                for (int mt = 0; mt < 4; ++mt)
#pragma unroll
                    for (int k2 = 0; k2 < 2; ++k2) fa[2 * mt + k2] = s2_frag(sQK + (16 * mt + r) * 72 + 32 * k2, q);
                S2_STAGE();
                S2_MMQ(fB, 3); S2_STAGE();
#undef S2_LOADQ
#undef S2_MMQ
                s8v fk[16];
#pragma unroll
                for (int w = 0; w < 8; ++w)
#pragma unroll
                    for (int k2 = 0; k2 < 2; ++k2) fk[2 * w + k2] = s2_fragx(sKT + (16 * w + r) * 72 + 32 * k2, q ^ w, (4 + q) ^ w);
                const float eg = sEG[n];
                S2_STAGE();
                f4v vn[4];
#pragma unroll
                for (int mt = 0; mt < 4; ++mt) vn[mt] = (f4v){bf1(ur[4 * mt]) - a1[mt][0], bf1(ur[4 * mt + 1]) - a1[mt][1], bf1(ur[4 * mt + 2]) - a1[mt][2], bf1(ur[4 * mt + 3]) - a1[mt][3]};
                s8v Bv[2];
#pragma unroll
                for (int k2 = 0; k2 < 2; ++k2) Bv[k2] = s2_pack(vn[2 * k2], vn[2 * k2 + 1]);
#pragma unroll
                for (int k2 = 0; k2 < 2; ++k2)
#pragma unroll
                    for (int mt = 0; mt < 4; ++mt) a2[mt] = __builtin_amdgcn_mfma_f32_16x16x32_bf16(fa[2 * mt + k2], Bv[k2], a2[mt], 0, 0, 0);
#pragma unroll
                for (int w = 0; w < 8; ++w) S[w] *= eg;
#pragma unroll
                for (int k2 = 0; k2 < 2; ++k2)
#pragma unroll
                    for (int w = 0; w < 8; ++w) S[w] = __builtin_amdgcn_mfma_f32_16x16x32_bf16(fk[2 * w + k2], Bv[k2], S[w], 0, 0, 0);
#pragma unroll
                for (int mt = 0; mt < 4; ++mt) {
                    GAS bfr* po = Og + (size_t)(b * SEQ + n * CH + 16 * mt + 4 * q) * DM + h * 128 + es * 32 + 16 * nt + r;
                    po[0] = f2bf1(a2[mt][0]); po[DM] = f2bf1(a2[mt][1]); po[2 * DM] = f2bf1(a2[mt][2]); po[3 * DM] = f2bf1(a2[mt][3]); }
#undef S2_STAGE
                MFMA_SETTLE(S[7]);
                __syncthreads();
            }
        }
        __syncthreads();
    }
}
#undef S2_OFF_QG
#undef S2_OFF_QK
#undef S2_OFF_KT
#undef S2_OFF_U
#undef S2_BUF

__device__ __forceinline__ void p_gdn_onorm(const Ctx& C, const Ptrs& P) {
    unsigned char* ws = P.ws_(); const bfr* Og = (const bfr*)(ws + WS_R + R_O); const bfr* PROJ = (const bfr*)(ws + WS_BIG); bfr* AO = (bfr*)(ws + WS_XN); const float* og = P.in_(6);
    const size_t gt = (size_t)C.vcu * 512 + C.tid, GT = (size_t)C.G * 512;
    for (size_t idx0 = gt; idx0 < (size_t)NT * DM / 8; idx0 += 4 * GT) {
        u4v o8[4], z8[4];
#pragma unroll
        for (int b4 = 0; b4 < 4; ++b4) { const size_t idx = idx0 + b4 * GT; const size_t t = idx >> 9; const int hh = (int)(idx >> 4) & 31, i = (int)idx & 15;
            o8[b4] = *(const u4v*)(Og + t * DM + hh * 128 + 8 * i); z8[b4] = *(const u4v*)(PROJ + t * 16384 + 12288 + hh * 128 + 8 * i); }
        const int i = (int)idx0 & 15;
        const f4v g0 = *(const f4v*)(og + 8 * i), g1 = *(const f4v*)(og + 8 * i + 4); const float g[8] = {g0[0], g0[1], g0[2], g0[3], g1[0], g1[1], g1[2], g1[3]};
#pragma unroll
        for (int b4 = 0; b4 < 4; ++b4) { const size_t idx = idx0 + b4 * GT; const size_t t = idx >> 9; const int hh = (int)(idx >> 4) & 31;
            float o[8] = {bflo(o8[b4].x), bfhi(o8[b4].x), bflo(o8[b4].y), bfhi(o8[b4].y), bflo(o8[b4].z), bfhi(o8[b4].z), bflo(o8[b4].w), bfhi(o8[b4].w)};
            float z[8] = {bflo(z8[b4].x), bfhi(z8[b4].x), bflo(z8[b4].y), bfhi(z8[b4].y), bflo(z8[b4].z), bfhi(z8[b4].z), bflo(z8[b4].w), bfhi(z8[b4].w)};
            float ss = 0.f;
#pragma unroll
            for (int k = 0; k < 8; ++k) ss += o[k] * o[k];
            ss += __shfl_xor(ss, 1); ss += __shfl_xor(ss, 2); ss += __shfl_xor(ss, 4); ss += __shfl_xor(ss, 8);
            const float rn = __builtin_amdgcn_rsqf(ss * (1.f / 128.f) + EPS);
            float y[8];
#pragma unroll
            for (int k = 0; k < 8; ++k) y[k] = o[k] * rn * g[k] * (z[k] * __builtin_amdgcn_rcpf(1.f + __expf(-z[k])));
#if F8_OUT0
#pragma unroll
            for (int k = 0; k < 8; ++k) y[k] = fminf(fmaxf(y[k] * SO, -440.f), 440.f);
            u2v w; w.x = cvt4_fp8(y[0], y[1], y[2], y[3]); w.y = cvt4_fp8(y[4], y[5], y[6], y[7]);
            *(u2v*)(ws + WS_XN8 + t * DM + hh * 128 + 8 * i) = w; }
#else
            u4v w; w.x = cvtpk(y[0], y[1]); w.y = cvtpk(y[2], y[3]); w.z = cvtpk(y[4], y[5]); w.w = cvtpk(y[6], y[7]);
            *(u4v*)(AO + t * DM + hh * 128 + 8 * i) = w; }
#endif
    }
}
__device__ __forceinline__ unsigned mono_key(float x) { const unsigned u = __float_as_uint(x); return u ^ ((unsigned)((int)u >> 31) | 0x80000000u); }
#define KEY_INS(K, key) do { unsigned x_ = (key); _Pragma("unroll") for (int s_ = 0; s_ < 16; ++s_) { const unsigned hi_ = max(K[s_], x_); x_ = min(K[s_], x_); K[s_] = hi_; } } while (0)
__device__ __forceinline__ void p_route(const Ctx& C, const Ptrs& P) {
    unsigned char* ws = P.ws_(); const float* SC = (const float*)(ws + WS_SC); bfr* G = (bfr*)(ws + WS_G);
    LAS unsigned char* wl = C.lds + C.wave * 16384;
    LAS int* sE = (LAS int*)(wl); LAS float* sGt = (LAS float*)(wl + 2048); LAS float* sV1 = (LAS float*)(wl + 4096); LAS float* sV2 = (LAS float*)(wl + 8192); LAS int* sI = (LAS int*)(wl + 12288);
    const int lane = C.lane, gw = C.vcu * 8 + C.wave, NGW = C.G * 8;
    for (int wt = gw; wt < NT / 4; wt += NGW) {
        const int tl = lane >> 4, t = wt * 4 + tl;
        unsigned k1[16];
#pragma unroll
        for (int i = 0; i < 16; ++i) k1[i] = 0u;
        const float* base = SC + (size_t)t * PQ + (lane & 15) * 128;
        for (int e = 0; e < 128; e += 4) { const f4v x4 = *(const f4v*)(base + e);
            KEY_INS(k1, (mono_key(x4[0]) & ~127u) | (unsigned)(127 - e)); KEY_INS(k1, (mono_key(x4[1]) & ~127u) | (unsigned)(126 - e));
            KEY_INS(k1, (mono_key(x4[2]) & ~127u) | (unsigned)(125 - e)); KEY_INS(k1, (mono_key(x4[3]) & ~127u) | (unsigned)(124 - e)); }
        const bool h0 = (lane & 1) == 0;
        float v1[16], v2[16];
#pragma unroll
        for (int i = 0; i < 16; ++i) { const int id = 127 - (int)(k1[i] & 127u); const float vv = base[id];
            const float ov = __shfl_xor(vv, 1); const int oi = __shfl_xor(id, 1);
            v1[i] = h0 ? vv : ov; v2[i] = h0 ? ov : vv; const int ia = h0 ? id : oi, ib = h0 ? oi : id;
            sV1[i * 64 + lane] = v1[i]; sV2[i * 64 + lane] = v2[i]; sI[i * 64 + lane] = ia | (ib << 8); }
        unsigned k2[16];
#pragma unroll
        for (int i = 0; i < 16; ++i) k2[i] = 0u;
#pragma unroll
        for (int a = 0; a < 16; ++a)
#pragma unroll
            for (int b = 0; b < 16; ++b)
                if ((a + 1) * (b + 1) <= 16) KEY_INS(k2, (mono_key(v1[a] + v2[b]) & ~255u) | (unsigned)(255 - (a * 16 + b)));
        LDS_WAIT(); asm volatile("" ::: "memory");
        float ts[16]; int te[16]; float mx = -__builtin_inff();
#pragma unroll
        for (int i = 0; i < 16; ++i) { const int code = 255 - (int)(k2[i] & 255u), a = code >> 4, b = code & 15;
            ts[i] = sV1[a * 64 + lane] + sV2[b * 64 + lane]; te[i] = (sI[a * 64 + lane] & 0xff) * 128 + (sI[b * 64 + lane] >> 8); mx = fmaxf(mx, ts[i]); }
        float sum = 0.f;
#pragma unroll
        for (int i = 0; i < 16; ++i) { ts[i] = __expf(ts[i] - mx); sum += ts[i]; }
        const float inv = 1.f / sum;
        if (h0) { const int hb = ((lane >> 1) & 7) * 16;
#pragma unroll
            for (int i = 0; i < 16; ++i) { sE[tl * 128 + hb + i] = te[i]; sGt[tl * 128 + hb + i] = ts[i] * inv; } }
        LDS_WAIT(); asm volatile("" ::: "memory");
        for (int k = 0; k < 4; ++k) {
            const size_t tt = (size_t)wt * 4 + k; u4v* row = (u4v*)(G + tt * PE); const u4v z = {0u, 0u, 0u, 0u};
#pragma unroll 8
            for (int j = 0; j < 32; ++j) row[j * 64 + lane] = z;
            const int e0 = sE[k * 128 + lane], e1 = sE[k * 128 + 64 + lane]; float t0 = 0.f, t1 = 0.f; bool f0 = true, f1 = true;
            for (int j = 0; j < 128; j += 4) { const i4v ej = *(const LAS i4v*)(sE + k * 128 + j); const f4v gj = *(const LAS f4v*)(sGt + k * 128 + j);
                if (ej.x == e0) { t0 += gj[0]; if (j + 0 < lane) f0 = false; } if (ej.y == e0) { t0 += gj[1]; if (j + 1 < lane) f0 = false; }
                if (ej.z == e0) { t0 += gj[2]; if (j + 2 < lane) f0 = false; } if (ej.w == e0) { t0 += gj[3]; if (j + 3 < lane) f0 = false; }
                if (ej.x == e1) { t1 += gj[0]; if (j + 0 < lane + 64) f1 = false; } if (ej.y == e1) { t1 += gj[1]; if (j + 1 < lane + 64) f1 = false; }
                if (ej.z == e1) { t1 += gj[2]; if (j + 2 < lane + 64) f1 = false; } if (ej.w == e1) { t1 += gj[3]; if (j + 3 < lane + 64) f1 = false; } }
            VM_WAIT();
            if (f0) G[tt * PE + e0] = f2bf1(t0);
            if (f1) G[tt * PE + e1] = f2bf1(t1);
        }
        LDS_WAIT(); asm volatile("" ::: "memory");
    }
}

typedef _Float16 h2v __attribute__((ext_vector_type(2)));
__device__ __forceinline__ unsigned char gate_code(float g) { const float c = 195.f + 20.f * __log2f(g); return (unsigned char)(int)fminf(fmaxf(c + 0.5f, 1.f), 255.f); }
__device__ __forceinline__ void p_sroute(const Ctx& C, const Ptrs& P, int layer) {
    unsigned char* ws = P.ws_(); const bfr* QRY = (const bfr*)(ws + WS_QRY); const bfr* KEY = (const bfr*)(ws + WS_WTKEY) + (size_t)layer * PQ * PQ; unsigned char* G = ws + WS_G;
    const int lane = C.lane, wave = C.wave, r = lane & 15, q = lane >> 4;
    LAS unsigned char* wl = C.lds + wave * 16640;
    LAS _Float16* sS = (LAS _Float16*)wl;
    LAS float* sV1 = (LAS float*)(wl); LAS float* sV2 = (LAS float*)(wl + 4096); LAS int* sI = (LAS int*)(wl + 8192);
    LAS int* sE = (LAS int*)(C.lds); LAS float* sGt = (LAS float*)(C.lds + 16384);
    LAS unsigned* bm = (LAS unsigned*)(C.lds + 32768 + wave * 3200); LAS unsigned* cnt = bm + 512; LAS int* le = (LAS int*)(bm + 516); LAS float* lg = (LAS float*)(bm + 516 + 128);
    for (int blk = C.vcu; blk < NT / 32; blk += C.G) {
        const int t0 = blk * 32;
#pragma unroll
        for (int hf = 0; hf < 2; ++hf) {
            const int hh = wave * 2 + hf;
            s8v a[2][4];
#pragma unroll
            for (int mt = 0; mt < 2; ++mt)
#pragma unroll
                for (int ks = 0; ks < 4; ++ks) a[mt][ks] = *(const s8v*)(QRY + (size_t)(t0 + 16 * mt + r) * PQ + hh * 128 + 32 * ks + 8 * q);
#pragma unroll
            for (int nt = 0; nt < 8; ++nt) {
                s8v b[4];
#pragma unroll
                for (int ks = 0; ks < 4; ++ks) b[ks] = *(const s8v*)(KEY + (size_t)(hh * 128 + 16 * nt + r) * PQ + hh * 128 + 32 * ks + 8 * q);
                f4v c0 = zero_acc(), c1 = zero_acc();
#pragma unroll
                for (int ks = 0; ks < 4; ++ks) { c0 = __builtin_amdgcn_mfma_f32_16x16x32_bf16(a[0][ks], b[ks], c0, 0, 0, 0); c1 = __builtin_amdgcn_mfma_f32_16x16x32_bf16(a[1][ks], b[ks], c1, 0, 0, 0); MFMA_SETTLE(c0); MFMA_SETTLE(c1); }
                MFMA_SETTLE(c0); MFMA_SETTLE(c1);
#pragma unroll
                for (int e = 0; e < 4; ++e) { sS[(32 * hf + 4 * q + e) * 130 + 16 * nt + r] = (_Float16)c0[e]; sS[(32 * hf + 16 + 4 * q + e) * 130 + 16 * nt + r] = (_Float16)c1[e]; }
            }
        }
        LDS_WAIT(); asm volatile("" ::: "memory");
        unsigned k1[16];
#pragma unroll
        for (int i = 0; i < 16; ++i) k1[i] = 0u;
        const LAS h2v* lp = (const LAS h2v*)(sS + lane * 130);
        for (int e = 0; e < 128; e += 8) {
#pragma unroll
            for (int u = 0; u < 4; ++u) { const h2v x2 = lp[(e >> 1) + u];
                KEY_INS(k1, (mono_key((float)x2[0]) & ~127u) | (unsigned)(127 - e - 2 * u)); KEY_INS(k1, (mono_key((float)x2[1]) & ~127u) | (unsigned)(126 - e - 2 * u)); }
        }
        const bool h0 = lane < 32;
        float v1[16], v2[16]; int ids[16]; float vals[16];
#pragma unroll
        for (int i = 0; i < 16; ++i) { ids[i] = 127 - (int)(k1[i] & 127u); vals[i] = (float)sS[lane * 130 + ids[i]]; }
        LDS_WAIT(); asm volatile("" ::: "memory");
#pragma unroll
        for (int i = 0; i < 16; ++i) { const float ov = __shfl_xor(vals[i], 32); const int oi = __shfl_xor(ids[i], 32);
            v1[i] = h0 ? vals[i] : ov; v2[i] = h0 ? ov : vals[i]; const int ia = h0 ? ids[i] : oi, ib = h0 ? oi : ids[i];
            sV1[i * 64 + lane] = v1[i]; sV2[i * 64 + lane] = v2[i]; sI[i * 64 + lane] = ia | (ib << 8); }
        unsigned k2[16];
#pragma unroll
        for (int b = 0; b < 16; ++b) k2[b] = (mono_key(v1[0] + v2[b]) & ~255u) | (unsigned)(255 - b);
#pragma unroll
        for (int a = 1; a < 16; ++a)
#pragma unroll
            for (int b = 0; b < 16; ++b)
                if ((a + 1) * (b + 1) <= 16) KEY_INS(k2, (mono_key(v1[a] + v2[b]) & ~255u) | (unsigned)(255 - (a * 16 + b)));
        LDS_WAIT(); asm volatile("" ::: "memory");
        float ts[16]; int te[16]; float mx = -__builtin_inff();
#pragma unroll
        for (int i = 0; i < 16; ++i) { const int code = 255 - (int)(k2[i] & 255u), a = code >> 4, b = code & 15;
            ts[i] = sV1[a * 64 + lane] + sV2[b * 64 + lane]; te[i] = (sI[a * 64 + lane] & 0xff) * 128 + (sI[b * 64 + lane] >> 8); mx = fmaxf(mx, ts[i]); }
        float sum = 0.f;
#pragma unroll
        for (int i = 0; i < 16; ++i) { ts[i] = __expf(ts[i] - mx); sum += ts[i]; }
        const float inv = 1.f / sum;
        __syncthreads();
        if (h0) {
#pragma unroll
            for (int i = 0; i < 16; ++i) { sE[lane * 128 + wave * 16 + i] = te[i]; sGt[lane * 128 + wave * 16 + i] = ts[i] * inv; } }
        __syncthreads();
        for (int k = 0; k < 4; ++k) {
            const int tl = wave * 4 + k; const size_t tt = (size_t)t0 + tl;
            if (layer == 0) { u4v* row = (u4v*)(G + tt * PE); const u4v z = {0u, 0u, 0u, 0u};
#pragma unroll 8
                for (int j = 0; j < 16; ++j) row[j * 64 + lane] = z; }
            const int e0 = sE[tl * 128 + lane], e1 = sE[tl * 128 + 64 + lane]; float t0s = sGt[tl * 128 + lane], t1s = sGt[tl * 128 + 64 + lane];
#pragma unroll
            for (int j = 0; j < 8; ++j) bm[j * 64 + lane] = 0u;
            if (lane == 0) *cnt = 0u;
            LDS_WAIT(); asm volatile("" ::: "memory");
            const unsigned b0 = 1u << (e0 & 31), b1 = 1u << (e1 & 31);
            const bool d0 = (__hip_atomic_fetch_or(bm + (e0 >> 5), b0, __ATOMIC_RELAXED, __HIP_MEMORY_SCOPE_WORKGROUP) & b0) != 0u;
            const bool d1 = (__hip_atomic_fetch_or(bm + (e1 >> 5), b1, __ATOMIC_RELAXED, __HIP_MEMORY_SCOPE_WORKGROUP) & b1) != 0u;
            if (d0) { const unsigned sl = __hip_atomic_fetch_add(cnt, 1u, __ATOMIC_RELAXED, __HIP_MEMORY_SCOPE_WORKGROUP); le[sl] = e0; lg[sl] = t0s; }
            if (d1) { const unsigned sl = __hip_atomic_fetch_add(cnt, 1u, __ATOMIC_RELAXED, __HIP_MEMORY_SCOPE_WORKGROUP); le[sl] = e1; lg[sl] = t1s; }
            LDS_WAIT(); asm volatile("" ::: "memory");
            const int nd = (int)__builtin_amdgcn_readfirstlane((int)*cnt);
            for (int j = 0; j < nd; ++j) { const int ej = le[j]; const float gj = lg[j]; if (ej == e0 && !d0) t0s += gj; if (ej == e1 && !d1) t1s += gj; }
            const bool f0 = !d0, f1 = !d1;
            VM_WAIT();
            if (f0) G[tt * PE + e0] = gate_code(t0s);
            if (f1) G[tt * PE + e1] = gate_code(t1s);
        }
        __syncthreads();
    }
}

constexpr int KIND_V = F8_KVQ ? 2 : 1;
__device__ __forceinline__ void p_headprep(const Ctx& C, const Ptrs& P) {
    unsigned char* ws = P.ws_(); const bfr* KVQ = (const bfr*)(ws + WS_BIG); bfr* Qh = (bfr*)(ws + WS_R + R_QH); bfr* Kh = (bfr*)(ws + WS_R + R_KH); bfr* Vh = (bfr*)(ws + WS_R + R_VH);
    const float* kg = P.in_(10); const float* qg = P.in_(13);
    const size_t gt = (size_t)C.vcu * 512 + C.tid, GT = (size_t)C.G * 512;
    constexpr int NV16 = F8_KVQ ? 1024 : 1536;
    for (size_t idx0 = gt; idx0 < (size_t)NT * NV16; idx0 += 4 * GT) {
        u4v x8[4];
#pragma unroll
        for (int b4 = 0; b4 < 4; ++b4) { const size_t idx = idx0 + b4 * GT; const size_t t = idx / NV16; const int rem = (int)(idx - t * NV16), vec = rem >> 4, i = rem & 15;
            x8[b4] = *(const u4v*)(KVQ + t * 12288 + vec * 128 + 8 * i); }
#pragma unroll
        for (int b4 = 0; b4 < 4; ++b4) { const size_t idx = idx0 + b4 * GT; const size_t t = idx / NV16; const int rem = (int)(idx - t * NV16), vec = rem >> 4, i = rem & 15, kind = vec >> 5, sh = vec & 31;
            float x[8] = {bflo(x8[b4].x), bfhi(x8[b4].x), bflo(x8[b4].y), bfhi(x8[b4].y), bflo(x8[b4].z), bfhi(x8[b4].z), bflo(x8[b4].w), bfhi(x8[b4].w)};
            float ss = 0.f;
#pragma unroll
            for (int k = 0; k < 8; ++k) ss += x[k] * x[k];
            ss += __shfl_xor(ss, 1); ss += __shfl_xor(ss, 2); ss += __shfl_xor(ss, 4); ss += __shfl_xor(ss, 8);
            u4v w = x8[b4];
            if (kind != KIND_V) { const float rn = __builtin_amdgcn_rsqf(ss * (1.f / 128.f) + EPS); const float* gp = (kind == 0 ? kg : qg) + 8 * i; const f4v g0 = *(const f4v*)gp, g1 = *(const f4v*)(gp + 4);
                w.x = cvtpk(x[0] * rn * g0[0], x[1] * rn * g0[1]); w.y = cvtpk(x[2] * rn * g0[2], x[3] * rn * g0[3]); w.z = cvtpk(x[4] * rn * g1[0], x[5] * rn * g1[1]); w.w = cvtpk(x[6] * rn * g1[2], x[7] * rn * g1[3]); }
            const size_t b = t >> 12, s = t & 4095; bfr* dst = (kind == 0 ? Kh : (kind == KIND_V ? Vh : Qh)) + ((b * 32 + sh) * SEQ + s) * 128 + 8 * i;
            *(u4v*)dst = w; }
    }
}

__device__ __forceinline__ att::BlockRef<att::bf16, att::bf16> attn_ref(const att::bf16* Qh, const att::bf16* Kh, const att::bf16* Vh, att::bf16* Oh, int bhp, int qb) {
    const int b = bhp >> 6, hd = (bhp >> 2) & 15, c = (bhp >> 1) & 1, vh = bhp & 1;
    att::BlockRef<att::bf16, att::bf16> r;
    r.Q = Qh + ((size_t)(b * 32 + hd * 2 + c) * SEQ + (size_t)qb * 256) * 128; r.K = Kh + (size_t)(b * 32 + hd * 2 + c) * SEQ * 128; r.V = att::VSTR == 128 ? Vh + (size_t)(b * 32 + hd * 2 + vh) * SEQ * 128 : Vh + (size_t)b * SEQ * att::VSTR + 8192 + (hd * 2 + vh) * 128;
    r.O = Oh + ((size_t)bhp * SEQ + (size_t)qb * 256) * 128; r.P0 = qb * 256;
    return r;
}
__device__ __forceinline__ void p_attn(const Ctx& C, const Ptrs& P) {
    unsigned char* ws = P.ws_(); const att::bf16* Qh = (const att::bf16*)(ws + WS_R + R_QH); const att::bf16* Kh = (const att::bf16*)(ws + WS_R + R_KH); const att::bf16* Vh = (const att::bf16*)(att::VSTR == 128 ? ws + WS_R + R_VH : ws + WS_BIG);
    att::bf16* Oh = (att::bf16*)(ws + WS_R + R_OH);
    extern __shared__ __attribute__((aligned(16))) char lds_sym[]; char* lds = lds_sym;
    constexpr int total = 128 * 8;
    int L = C.vcu; if (L >= total) return;
    int pass = 0;
    att::BlockRef<att::bf16, att::bf16> cur = attn_ref(Qh, Kh, Vh, Oh, L >> 3, L & 7);
    att::Seam<att::bf16> S;
    att::causal_swa_prime<att::bf16, att::bf16>(cur, SEQ, lds, S);
    for (;;) {
        const bool more_pass = pass == 0, more_item = L + C.G < total, last = !more_pass && !more_item;
        int passn = pass + 1, Ln = L;
        if (!more_pass) { passn = 0; Ln = more_item ? L + C.G : L; }
        const att::BlockRef<att::bf16, att::bf16> nxt = last ? cur : attn_ref(Qh, Kh, Vh, Oh, Ln >> 3, passn ? 15 - (Ln & 7) : (Ln & 7));
        att::causal_swa_block<att::bf16, att::bf16>(cur, nxt, SEQ, SEQ, lds, S);
        if (last) break;
        cur = nxt; pass = passn; L = Ln;
    }
    __syncthreads();
}

__device__ __forceinline__ void p_combine(const Ctx& C, const Ptrs& P) {
    unsigned char* ws = P.ws_(); const bfr* Oh = (const bfr*)(ws + WS_R + R_OH); bfr* AO = (bfr*)(ws + WS_XN); const float* sg = P.in_(18);
    float lam;
    { const float* q1 = P.in_(14); const float* k1 = P.in_(15); const float* q2 = P.in_(16); const float* k2 = P.in_(17); const int l = C.lane;
      const float d1 = wave_sum(q1[l] * k1[l] + q1[l + 64] * k1[l + 64]), d2 = wave_sum(q2[l] * k2[l] + q2[l + 64] * k2[l + 64]);
      lam = expf(d1) - expf(d2) + LAMBDA_INIT; }
    const size_t gt = (size_t)C.vcu * 512 + C.tid, GT = (size_t)C.G * 512;
    for (size_t idx0 = gt; idx0 < (size_t)NT * 512; idx0 += 4 * GT) {
        u4v a8[4], b8[4];
#pragma unroll
        for (int b4 = 0; b4 < 4; ++b4) { const size_t idx = idx0 + b4 * GT; const size_t t = idx >> 9, b = t >> 12, s = t & 4095; const int hd = (int)(idx >> 5) & 15, i = (int)idx & 31, vh = i >> 4, d = (8 * i) & 127;
            const size_t o0i = ((((b * 16 + hd) * 2 + 0) * 2 + vh) * SEQ + s) * 128 + d, o1i = ((((b * 16 + hd) * 2 + 1) * 2 + vh) * SEQ + s) * 128 + d;
            a8[b4] = *(const u4v*)(Oh + o0i); b8[b4] = *(const u4v*)(Oh + o1i); }
        const int i = (int)idx0 & 31;
        const f4v g0 = *(const f4v*)(sg + 8 * i), g1 = *(const f4v*)(sg + 8 * i + 4);
#pragma unroll
        for (int b4 = 0; b4 < 4; ++b4) { const size_t idx = idx0 + b4 * GT; const size_t t = idx >> 9; const int hd = (int)(idx >> 5) & 15;
            float o[8] = {bflo(a8[b4].x) - lam * bflo(b8[b4].x), bfhi(a8[b4].x) - lam * bfhi(b8[b4].x), bflo(a8[b4].y) - lam * bflo(b8[b4].y), bfhi(a8[b4].y) - lam * bfhi(b8[b4].y),
                          bflo(a8[b4].z) - lam * bflo(b8[b4].z), bfhi(a8[b4].z) - lam * bfhi(b8[b4].z), bflo(a8[b4].w) - lam * bflo(b8[b4].w), bfhi(a8[b4].w) - lam * bfhi(b8[b4].w)};
            float ss = 0.f;
#pragma unroll
            for (int k = 0; k < 8; ++k) ss += o[k] * o[k];
            ss += __shfl_xor(ss, 1); ss += __shfl_xor(ss, 2); ss += __shfl_xor(ss, 4); ss += __shfl_xor(ss, 8); ss += __shfl_xor(ss, 16);
            const float rn = __builtin_amdgcn_rsqf(ss * (1.f / 256.f) + EPS) * (1.f - LAMBDA_INIT);
#if F8_OUT1
            const float rs = rn * SO; float y[8] = {o[0] * rs * g0[0], o[1] * rs * g0[1], o[2] * rs * g0[2], o[3] * rs * g0[3], o[4] * rs * g1[0], o[5] * rs * g1[1], o[6] * rs * g1[2], o[7] * rs * g1[3]};
#pragma unroll
            for (int k = 0; k < 8; ++k) y[k] = fminf(fmaxf(y[k], -440.f), 440.f);
            u2v w; w.x = cvt4_fp8(y[0], y[1], y[2], y[3]); w.y = cvt4_fp8(y[4], y[5], y[6], y[7]);
            *(u2v*)(ws + WS_XN8 + t * DM + hd * 256 + 8 * i) = w; }
#else
            u4v w; w.x = cvtpk(o[0] * rn * g0[0], o[1] * rn * g0[1]); w.y = cvtpk(o[2] * rn * g0[2], o[3] * rn * g0[3]); w.z = cvtpk(o[4] * rn * g1[0], o[5] * rn * g1[1]); w.w = cvtpk(o[6] * rn * g1[2], o[7] * rn * g1[3]);
            *(u4v*)(AO + t * DM + hd * 256 + 8 * i) = w; }
#endif
    }
}
constexpr int NPH_LAYER = 13, NPHASE = 1 + 2 * NPH_LAYER;
#ifndef MK_PER_PHASE
#define MK_PER_PHASE 0
#endif

__global__ void __launch_bounds__(512, 2) trunk_fwd(KArgs KA) {
    extern __shared__ __attribute__((aligned(16))) unsigned char lds_raw[];
    Ctx C; C.lds = (LAS unsigned char*)lds_raw; C.tid = threadIdx.x; C.lane = C.tid & 63; C.wave = __builtin_amdgcn_readfirstlane(C.tid >> 6);
    C.G = gridDim.x; { const int bx = blockIdx.x; C.vcu = (C.G % 8 == 0) ? (bx % 8) * (C.G / 8) + bx / 8 : bx; }
    volatile LAS unsigned* MISC = (volatile LAS unsigned*)(C.lds + MISC_OFF);
    for (int u = C.tid; u < (LDS_BYTES - MISC_OFF) / 4; u += 512) MISC[u] = 0u;
    __syncthreads();
    Ptrs P; P.tbl = (LAS unsigned long long*)(C.lds + MISC_OFF + 128);
    if (C.tid < 28) P.tbl[C.tid] = ((const unsigned long long*)&KA)[C.tid];
    __syncthreads();
    unsigned* ctl = (unsigned*)(P.ws_() + WS_CTL);
    const int lo = KA.ph_lo, hi = KA.ph_hi;
    XcdBarrier bar; bar.bar = ctl + CW_BAR + KA.li * XCD_BAR_WORDS; bar.x = 0; bar.st = MISC + 8;
    if (hi - lo > 1) bar = xcd_barrier_post(ctl + CW_BAR + KA.li * XCD_BAR_WORDS, MISC + 8);
#define IN(k) (lo <= (k) && (k) < hi)
#define SEAM(k) do { if (IN(k) && IN((k) + 1)) xcd_barrier(bar); } while (0)
    unsigned char* ws = P.ws_();
    bfr* XN = (bfr*)(ws + WS_XN); bfr* BIG = (bfr*)(ws + WS_BIG);
    const int hb = (int)blockIdx.x;

    if (IN(0)) { p_convert(C, P); __syncthreads();
        p_norm_rows(C, P.in_(0), XN, F8_PROJ0 != 0 ? ws + WS_XN8 : nullptr); }
    SEAM(0);
    {
        constexpr int layer = 0;
        const int pb = 1 + layer * NPH_LAYER;
        if (layer == 1 && IN(pb + 0)) p_norm_rows(C, (const float*)P.out_(), F8_KVQ == 2 ? nullptr : XN, F8_KVQ != 0 ? ws + WS_XN8 : nullptr);
        if (layer == 1) SEAM(pb + 0);
        if (IN(pb + 1)) {
            const int N = layer == 0 ? 16384 : 12288;
            if (layer == 0 && F8_PROJ0 == 2) {
                { pg8::Gemm g{XN, (const bfr*)(ws + WS_WTIN), NT, 8192, DM}; pg8::StaticOrder S; S.init(NT, 8192, C.G, hb);
                  pg8::EpiBf16<0> E{BIG, N, nullptr, 0, 0, 1.f};
                  pg8::gemm_phase<pg8::EpiBf16<0>, pg8::StaticOrder, true, true>((PG8_LAS unsigned char*)C.lds, g, S, E); }
                __syncthreads();
                { pg8::Gemm g{(const bfr*)(ws + WS_XN8), (const bfr*)(ws + WS_WTIN + (size_t)8192 * DM * 2), NT, 8192, DM / 2}; pg8::StaticOrder S; S.init(NT, 8192, C.G, hb);
                  pg8::EpiBf16<0> E{BIG + 8192, N, nullptr, 8192, 0, 1.f / SU};
                  pg8::gemm_phase<pg8::EpiBf16<0>, pg8::StaticOrder, true, true, true>((PG8_LAS unsigned char*)C.lds, g, S, E); }
            } else if (layer == 0 && F8_PROJ0 == 4) {
                { pg8::Gemm g{(const bfr*)(ws + WS_XN8), (const bfr*)(ws + WS_WTIN), NT, 4096, DM / 2}; pg8::StaticOrder S; S.init(NT, 4096, C.G, hb);
                  pg8::EpiBf16<0> E{BIG, N, nullptr, 4096, 0, 1.f / SU};
                  pg8::gemm_phase<pg8::EpiBf16<0>, pg8::StaticOrder, true, true, true>((PG8_LAS unsigned char*)C.lds, g, S, E); }
                __syncthreads();
                { pg8::Gemm g{XN, (const bfr*)(ws + WS_WTIN + (size_t)4096 * DM), NT, 12288, DM}; pg8::StaticOrder S; S.init(NT, 12288, C.G, hb);
                  pg8::EpiBf16<0> E{BIG + 4096, N, nullptr, 0, 0, 1.f};
                  pg8::gemm_phase<pg8::EpiBf16<0>, pg8::StaticOrder, true, true>((PG8_LAS unsigned char*)C.lds, g, S, E); }
            } else if (layer == 0 && F8_PROJ0 == 3) {
                { pg8::Gemm g{(const bfr*)(ws + WS_XN8), (const bfr*)(ws + WS_WTIN), NT, 8192, DM / 2}; pg8::StaticOrder S; S.init(NT, 8192, C.G, hb);
                  pg8::EpiBf16<0> E{BIG, N, nullptr, 8192, 0, 1.f / SU};
                  pg8::gemm_phase<pg8::EpiBf16<0>, pg8::StaticOrder, true, true, true>((PG8_LAS unsigned char*)C.lds, g, S, E); }
                __syncthreads();
                { pg8::Gemm g{XN, (const bfr*)(ws + WS_WTIN + (size_t)8192 * DM), NT, 8192, DM}; pg8::StaticOrder S; S.init(NT, 8192, C.G, hb);
                  pg8::EpiBf16<0> E{BIG + 8192, N, nullptr, 0, 0, 1.f};
                  pg8::gemm_phase<pg8::EpiBf16<0>, pg8::StaticOrder, true, true>((PG8_LAS unsigned char*)C.lds, g, S, E); }
            } else if (layer == 0 && F8_PROJ0 == 1) {
                pg8::Gemm g{(const bfr*)(ws + WS_XN8), (const bfr*)(ws + WS_WTIN), NT, N, DM / 2}; pg8::StaticOrder S; S.init(NT, N, C.G, hb);
                pg8::EpiBf16<0> E{BIG, N, nullptr, N, 0, 1.f / SU};
                pg8::gemm_phase<pg8::EpiBf16<0>, pg8::StaticOrder, true, true, true>((PG8_LAS unsigned char*)C.lds, g, S, E);
            } else if (layer == 1 && F8_KVQ == 2) {
                pg8::Gemm g{(const bfr*)(ws + WS_XN8), (const bfr*)(ws + WS_WTKVQ), NT, N, DM / 2}; pg8::StaticOrder S; S.init(NT, N, C.G, hb);
                pg8::EpiBf16<0> E{BIG, N, nullptr, N, 0, 1.f / SU};
                pg8::gemm_phase<pg8::EpiBf16<0>, pg8::StaticOrder, true, true, true>((PG8_LAS unsigned char*)C.lds, g, S, E);
            } else if (layer == 1 && F8_KVQ) {
                { pg8::Gemm g{(const bfr*)(ws + WS_XN8), (const bfr*)(ws + WS_WTKVQ), NT, 8192, DM / 2}; pg8::StaticOrder S; S.init(NT, 8192, C.G, hb);
                  pg8::EpiBf16<0> E{BIG, N, nullptr, 8192, 0, 1.f / SU};
                  pg8::gemm_phase<pg8::EpiBf16<0>, pg8::StaticOrder, true, true, true>((PG8_LAS unsigned char*)C.lds, g, S, E); }
                __syncthreads();
                { pg8::Gemm g{XN, (const bfr*)(ws + WS_WTKVQ + (size_t)2 * DM * DM), NT, DM, DM}; pg8::StaticOrder S; S.init(NT, DM, C.G, hb);
                  pg8::EpiBf16<0> E{BIG + 8192, N, nullptr, 0, 0, 1.f};
                  pg8::gemm_phase<pg8::EpiBf16<0>, pg8::StaticOrder, true, true>((PG8_LAS unsigned char*)C.lds, g, S, E); }
            } else {
                pg8::Gemm g{XN, (const bfr*)(ws + (layer == 0 ? WS_WTIN : WS_WTKVQ)), NT, N, DM}; pg8::StaticOrder S; S.init(NT, N, C.G, hb);
                pg8::EpiBf16<0> E{BIG, N, nullptr, 0, 0, 1.f};
                pg8::gemm_phase<pg8::EpiBf16<0>, pg8::StaticOrder, true, true>((PG8_LAS unsigned char*)C.lds, g, S, E);
            }
            if (layer == 0) { __syncthreads(); p_bd(C, XN, (const bfr*)(ws + WS_WTBD), (float*)(ws + WS_BD)); }
        }
        SEAM(pb + 1);
        if (IN(pb + 2)) { if (layer == 1) p_headprep(C, P); }
        if (layer == 1) SEAM(pb + 2);
        if (IN(pb + 3)) { if (layer == 0) p_gdn_prep(C, P); else p_attn(C, P); }
        SEAM(pb + 3);
        if (IN(pb + 4)) { if (layer == 0) p_gdn_scan(C, P); else p_combine(C, P); }
        SEAM(pb + 4);
        if (IN(pb + 5)) { if (layer == 0) p_gdn_onorm(C, P); }
        if (layer == 0) SEAM(pb + 5);
        if (IN(pb + 6)) {
            if ((layer == 0 && F8_OUT0) || (layer == 1 && F8_OUT1)) {
                pg8::Gemm g{(const bfr*)(ws + WS_XN8), (const bfr*)(ws + (layer == 0 ? WS_WTOUT : WS_WTO)), NT, DM, DM / 2}; pg8::StaticOrder S; S.init(NT, DM, C.G, hb);
                pg8::EpiRes E{layer == 0 ? P.in_(0) : (const float*)P.out_(), P.out_(), DM, 1.f / (SO * SU)};
                pg8::gemm_phase<pg8::EpiRes, pg8::StaticOrder, true, true, true>((PG8_LAS unsigned char*)C.lds, g, S, E);
            } else {
                pg8::Gemm g{XN, (const bfr*)(ws + (layer == 0 ? WS_WTOUT : WS_WTO)), NT, DM, DM}; pg8::StaticOrder S; S.init(NT, DM, C.G, hb);
                pg8::EpiRes E{layer == 0 ? P.in_(0) : (const float*)P.out_(), P.out_(), DM, 1.f};
                pg8::gemm_phase<pg8::EpiRes, pg8::StaticOrder, true, true>((PG8_LAS unsigned char*)C.lds, g, S, E);
            }
        }
        SEAM(pb + 6);
        if (IN(pb + 7)) p_norm_rows(C, (const float*)P.out_(), XN, ws + WS_XN8);
        SEAM(pb + 7);
        if (IN(pb + 8)) {
            pg8::Gemm g{XN, (const bfr*)(ws + WS_WTQRY) + (size_t)layer * PQ * DM, NT, PQ, DM}; pg8::StaticOrder S; S.init(NT, PQ, C.G, hb);
            pg8::EpiBf16<0> E{(bfr*)(ws + WS_QRY), PQ, nullptr, 0, 0, 1.f};
            pg8::gemm_phase<pg8::EpiBf16<0>, pg8::StaticOrder, true, true>((PG8_LAS unsigned char*)C.lds, g, S, E);
        }
        SEAM(pb + 8);
        if (IN(pb + 9)) { p_sroute(C, P, layer); }
        SEAM(pb + 9); if (IN(pb + 9) && !IN(pb + 10) && IN(pb + 11)) xcd_barrier(bar);
        if (IN(pb + 11)) {
            pg8::Gemm g{(const bfr*)(ws + WS_XN8), (const bfr*)(ws + WS_U + (size_t)layer * PE * DM), NT, PE, DM / 2}; pg8::StaticOrder S; S.init(NT, PE, C.G, hb);
#ifdef G1_PROBE
            if (layer == 0) { pg8::StaticOrder S2; S2.init(NT, PE, C.G, hb); pg8::EpiGate8<G1_PROBE> E2{(bfr*)(ws + WS_G), ws + WS_A2, PE, 1.f / SU, SA};
                pg8::gemm_phase<pg8::EpiGate8<G1_PROBE>, pg8::StaticOrder, true, true, true>((PG8_LAS unsigned char*)C.lds, g, S2, E2); __syncthreads(); }
#endif
#if STAGGER_G1
            {
                const int sg = C.vcu & 7;
                if (sg) { const unsigned long long t0 = __builtin_amdgcn_s_memrealtime(); while (__builtin_amdgcn_s_memrealtime() - t0 < (unsigned long long)(sg * STAGGER_G1)) __builtin_amdgcn_s_sleep(4); }
            }
#endif
            pg8::EpiGate8C E{ws + WS_G, ws + WS_A2, PE, 1.f / SU, SA};
            pg8::gemm_phase<pg8::EpiGate8C, pg8::StaticOrder, true, true, true>((PG8_LAS unsigned char*)C.lds, g, S, E);
        }
        SEAM(pb + 11);
        if (IN(pb + 12)) {
            pg8::Gemm g{(const bfr*)(ws + WS_A2), (const bfr*)(ws + WS_VT + (size_t)layer * DM * PE), NT, DM, PE / 2}; pg8::StaticOrder S; S.init(NT, DM, C.G, hb);
            pg8::EpiRes E{(const float*)P.out_(), P.out_(), DM, 1.f / (SA * SV)};
            pg8::gemm_phase<pg8::EpiRes, pg8::StaticOrder, true, true, true>((PG8_LAS unsigned char*)C.lds, g, S, E);
#ifdef G2_PROBE
            if (layer == 0) { __syncthreads(); pg8::StaticOrder S2; S2.init(NT, DM, C.G, hb); pg8::EpiRes E2{(const float*)P.out_(), P.out_(), DM, 0.f};
                pg8::gemm_phase<pg8::EpiRes, pg8::StaticOrder, true, true, true>((PG8_LAS unsigned char*)C.lds, g, S2, E2); }
#endif
        }
        SEAM(pb + 12);
    }
    {
        constexpr int layer = 1;
        const int pb = 1 + layer * NPH_LAYER;
        if (layer == 1 && IN(pb + 0)) p_norm_rows(C, (const float*)P.out_(), F8_KVQ == 2 ? nullptr : XN, F8_KVQ != 0 ? ws + WS_XN8 : nullptr);
        if (layer == 1) SEAM(pb + 0);
        if (IN(pb + 1)) {
            const int N = layer == 0 ? 16384 : 12288;
            if (layer == 0 && F8_PROJ0 == 2) {
                { pg8::Gemm g{XN, (const bfr*)(ws + WS_WTIN), NT, 8192, DM}; pg8::StaticOrder S; S.init(NT, 8192, C.G, hb);
                  pg8::EpiBf16<0> E{BIG, N, nullptr, 0, 0, 1.f};
                  pg8::gemm_phase<pg8::EpiBf16<0>, pg8::StaticOrder, true, true>((PG8_LAS unsigned char*)C.lds, g, S, E); }
                __syncthreads();
                { pg8::Gemm g{(const bfr*)(ws + WS_XN8), (const bfr*)(ws + WS_WTIN + (size_t)8192 * DM * 2), NT, 8192, DM / 2}; pg8::StaticOrder S; S.init(NT, 8192, C.G, hb);
                  pg8::EpiBf16<0> E{BIG + 8192, N, nullptr, 8192, 0, 1.f / SU};
                  pg8::gemm_phase<pg8::EpiBf16<0>, pg8::StaticOrder, true, true, true>((PG8_LAS unsigned char*)C.lds, g, S, E); }
            } else if (layer == 0 && F8_PROJ0 == 4) {
                { pg8::Gemm g{(const bfr*)(ws + WS_XN8), (const bfr*)(ws + WS_WTIN), NT, 4096, DM / 2}; pg8::StaticOrder S; S.init(NT, 4096, C.G, hb);
                  pg8::EpiBf16<0> E{BIG, N, nullptr, 4096, 0, 1.f / SU};
                  pg8::gemm_phase<pg8::EpiBf16<0>, pg8::StaticOrder, true, true, true>((PG8_LAS unsigned char*)C.lds, g, S, E); }
                __syncthreads();
                { pg8::Gemm g{XN, (const bfr*)(ws + WS_WTIN + (size_t)4096 * DM), NT, 12288, DM}; pg8::StaticOrder S; S.init(NT, 12288, C.G, hb);
                  pg8::EpiBf16<0> E{BIG + 4096, N, nullptr, 0, 0, 1.f};
                  pg8::gemm_phase<pg8::EpiBf16<0>, pg8::StaticOrder, true, true>((PG8_LAS unsigned char*)C.lds, g, S, E); }
            } else if (layer == 0 && F8_PROJ0 == 3) {
                { pg8::Gemm g{(const bfr*)(ws + WS_XN8), (const bfr*)(ws + WS_WTIN), NT, 8192, DM / 2}; pg8::StaticOrder S; S.init(NT, 8192, C.G, hb);
                  pg8::EpiBf16<0> E{BIG, N, nullptr, 8192, 0, 1.f / SU};
                  pg8::gemm_phase<pg8::EpiBf16<0>, pg8::StaticOrder, true, true, true>((PG8_LAS unsigned char*)C.lds, g, S, E); }
                __syncthreads();
                { pg8::Gemm g{XN, (const bfr*)(ws + WS_WTIN + (size_t)8192 * DM), NT, 8192, DM}; pg8::StaticOrder S; S.init(NT, 8192, C.G, hb);
                  pg8::EpiBf16<0> E{BIG + 8192, N, nullptr, 0, 0, 1.f};
                  pg8::gemm_phase<pg8::EpiBf16<0>, pg8::StaticOrder, true, true>((PG8_LAS unsigned char*)C.lds, g, S, E); }
            } else if (layer == 0 && F8_PROJ0 == 1) {
                pg8::Gemm g{(const bfr*)(ws + WS_XN8), (const bfr*)(ws + WS_WTIN), NT, N, DM / 2}; pg8::StaticOrder S; S.init(NT, N, C.G, hb);
                pg8::EpiBf16<0> E{BIG, N, nullptr, N, 0, 1.f / SU};
                pg8::gemm_phase<pg8::EpiBf16<0>, pg8::StaticOrder, true, true, true>((PG8_LAS unsigned char*)C.lds, g, S, E);
            } else if (layer == 1 && F8_KVQ == 2) {
                pg8::Gemm g{(const bfr*)(ws + WS_XN8), (const bfr*)(ws + WS_WTKVQ), NT, N, DM / 2}; pg8::StaticOrder S; S.init(NT, N, C.G, hb);
                pg8::EpiBf16<0> E{BIG, N, nullptr, N, 0, 1.f / SU};
                pg8::gemm_phase<pg8::EpiBf16<0>, pg8::StaticOrder, true, true, true>((PG8_LAS unsigned char*)C.lds, g, S, E);
            } else if (layer == 1 && F8_KVQ) {
                { pg8::Gemm g{(const bfr*)(ws + WS_XN8), (const bfr*)(ws + WS_WTKVQ), NT, 8192, DM / 2}; pg8::StaticOrder S; S.init(NT, 8192, C.G, hb);
                  pg8::EpiBf16<0> E{BIG, N, nullptr, 8192, 0, 1.f / SU};
                  pg8::gemm_phase<pg8::EpiBf16<0>, pg8::StaticOrder, true, true, true>((PG8_LAS unsigned char*)C.lds, g, S, E); }
                __syncthreads();
                { pg8::Gemm g{XN, (const bfr*)(ws + WS_WTKVQ + (size_t)2 * DM * DM), NT, DM, DM}; pg8::StaticOrder S; S.init(NT, DM, C.G, hb);
                  pg8::EpiBf16<0> E{BIG + 8192, N, nullptr, 0, 0, 1.f};
                  pg8::gemm_phase<pg8::EpiBf16<0>, pg8::StaticOrder, true, true>((PG8_LAS unsigned char*)C.lds, g, S, E); }
            } else {
                pg8::Gemm g{XN, (const bfr*)(ws + (layer == 0 ? WS_WTIN : WS_WTKVQ)), NT, N, DM}; pg8::StaticOrder S; S.init(NT, N, C.G, hb);
                pg8::EpiBf16<0> E{BIG, N, nullptr, 0, 0, 1.f};
                pg8::gemm_phase<pg8::EpiBf16<0>, pg8::StaticOrder, true, true>((PG8_LAS unsigned char*)C.lds, g, S, E);
            }
            if (layer == 0) { __syncthreads(); p_bd(C, XN, (const bfr*)(ws + WS_WTBD), (float*)(ws + WS_BD)); }
        }
        SEAM(pb + 1);
        if (IN(pb + 2)) { if (layer == 1) p_headprep(C, P); }
        if (layer == 1) SEAM(pb + 2);
        if (IN(pb + 3)) { if (layer == 0) p_gdn_prep(C, P); else p_attn(C, P); }
        SEAM(pb + 3);
        if (IN(pb + 4)) { if (layer == 0) p_gdn_scan(C, P); else p_combine(C, P); }
        SEAM(pb + 4);
        if (IN(pb + 5)) { if (layer == 0) p_gdn_onorm(C, P); }
        if (layer == 0) SEAM(pb + 5);
        if (IN(pb + 6)) {
            if ((layer == 0 && F8_OUT0) || (layer == 1 && F8_OUT1)) {
                pg8::Gemm g{(const bfr*)(ws + WS_XN8), (const bfr*)(ws + (layer == 0 ? WS_WTOUT : WS_WTO)), NT, DM, DM / 2}; pg8::StaticOrder S; S.init(NT, DM, C.G, hb);
                pg8::EpiRes E{layer == 0 ? P.in_(0) : (const float*)P.out_(), P.out_(), DM, 1.f / (SO * SU)};
                pg8::gemm_phase<pg8::EpiRes, pg8::StaticOrder, true, true, true>((PG8_LAS unsigned char*)C.lds, g, S, E);
            } else {
                pg8::Gemm g{XN, (const bfr*)(ws + (layer == 0 ? WS_WTOUT : WS_WTO)), NT, DM, DM}; pg8::StaticOrder S; S.init(NT, DM, C.G, hb);
                pg8::EpiRes E{layer == 0 ? P.in_(0) : (const float*)P.out_(), P.out_(), DM, 1.f};
                pg8::gemm_phase<pg8::EpiRes, pg8::StaticOrder, true, true>((PG8_LAS unsigned char*)C.lds, g, S, E);
            }
        }
        SEAM(pb + 6);
        if (IN(pb + 7)) p_norm_rows(C, (const float*)P.out_(), XN, ws + WS_XN8);
        SEAM(pb + 7);
        if (IN(pb + 8)) {
            pg8::Gemm g{XN, (const bfr*)(ws + WS_WTQRY) + (size_t)layer * PQ * DM, NT, PQ, DM}; pg8::StaticOrder S; S.init(NT, PQ, C.G, hb);
            pg8::EpiBf16<0> E{(bfr*)(ws + WS_QRY), PQ, nullptr, 0, 0, 1.f};
            pg8::gemm_phase<pg8::EpiBf16<0>, pg8::StaticOrder, true, true>((PG8_LAS unsigned char*)C.lds, g, S, E);
        }
        SEAM(pb + 8);
        if (IN(pb + 9)) { p_sroute(C, P, layer); }
        SEAM(pb + 9); if (IN(pb + 9) && !IN(pb + 10) && IN(pb + 11)) xcd_barrier(bar);
        if (IN(pb + 11)) {
            pg8::Gemm g{(const bfr*)(ws + WS_XN8), (const bfr*)(ws + WS_U + (size_t)layer * PE * DM), NT, PE, DM / 2}; pg8::StaticOrder S; S.init(NT, PE, C.G, hb);
#ifdef G1_PROBE
            if (layer == 0) { pg8::StaticOrder S2; S2.init(NT, PE, C.G, hb); pg8::EpiGate8<G1_PROBE> E2{(bfr*)(ws + WS_G), ws + WS_A2, PE, 1.f / SU, SA};
                pg8::gemm_phase<pg8::EpiGate8<G1_PROBE>, pg8::StaticOrder, true, true, true>((PG8_LAS unsigned char*)C.lds, g, S2, E2); __syncthreads(); }
#endif
#if STAGGER_G1
            {
                const int sg = C.vcu & 7;
                if (sg) { const unsigned long long t0 = __builtin_amdgcn_s_memrealtime(); while (__builtin_amdgcn_s_memrealtime() - t0 < (unsigned long long)(sg * STAGGER_G1)) __builtin_amdgcn_s_sleep(4); }
            }
#endif
            pg8::EpiGate8C E{ws + WS_G, ws + WS_A2, PE, 1.f / SU, SA};
            pg8::gemm_phase<pg8::EpiGate8C, pg8::StaticOrder, true, true, true>((PG8_LAS unsigned char*)C.lds, g, S, E);
        }
        SEAM(pb + 11);
        if (IN(pb + 12)) {
            pg8::Gemm g{(const bfr*)(ws + WS_A2), (const bfr*)(ws + WS_VT + (size_t)layer * DM * PE), NT, DM, PE / 2}; pg8::StaticOrder S; S.init(NT, DM, C.G, hb);
            pg8::EpiRes E{(const float*)P.out_(), P.out_(), DM, 1.f / (SA * SV)};
            pg8::gemm_phase<pg8::EpiRes, pg8::StaticOrder, true, true, true>((PG8_LAS unsigned char*)C.lds, g, S, E);
#ifdef G2_PROBE
            if (layer == 0) { __syncthreads(); pg8::StaticOrder S2; S2.init(NT, DM, C.G, hb); pg8::EpiRes E2{(const float*)P.out_(), P.out_(), DM, 0.f};
                pg8::gemm_phase<pg8::EpiRes, pg8::StaticOrder, true, true, true>((PG8_LAS unsigned char*)C.lds, g, S2, E2); }
#endif
        }
        SEAM(pb + 12);
    }
#undef IN
#undef SEAM
}

extern "C" void kernel_launch(void* const* d_in, const int* in_sizes, int n_in, void* d_out, int out_size, void* d_ws, size_t ws_size, hipStream_t stream) {
    static int grid = 0;
    if (grid == 0) {
        if (n_in != 26 || out_size != NT * DM || ws_size < WS_END) { fprintf(stderr, "kernel_launch: unexpected problem (n_in %d, out %d, ws %zu < %zu)\n", n_in, out_size, ws_size, (size_t)WS_END); grid = -1; return; }
        int dev = 0, cus = 0;
        if (hipGetDevice(&dev) != hipSuccess || hipDeviceGetAttribute(&cus, hipDeviceAttributeMultiprocessorCount, dev) != hipSuccess || cus <= 0) { grid = -1; return; }
        if (hipFuncSetAttribute((const void*)trunk_fwd, hipFuncAttributeMaxDynamicSharedMemorySize, LDS_BYTES) != hipSuccess) { fprintf(stderr, "kernel_launch: hipFuncSetAttribute failed\n"); grid = -1; return; }
        int per_cu = 0;
        if (hipOccupancyMaxActiveBlocksPerMultiprocessor(&per_cu, (const void*)trunk_fwd, 512, LDS_BYTES) != hipSuccess || per_cu < 1) { fprintf(stderr, "kernel_launch: occupancy query says %d blocks per CU\n", per_cu); }
        (void)hipGetLastError();
        grid = cus;
    }
    if (grid < 0) return;
    (void)in_sizes;
    if (hipMemsetAsync((char*)d_ws + WS_CTL, 0, CTL_ZERO_BYTES, stream) != hipSuccess) return;
    KArgs p{};
    for (int i = 0; i < 26; ++i) p.in[i] = (const float*)d_in[i];
    p.out = (float*)d_out; p.ws = (unsigned char*)d_ws;
#if MK_PER_PHASE
    for (int ph = 0; ph < NPHASE; ++ph) {
        if (ph == 1 + 5 + NPH_LAYER || ph == 1 + 10 || ph == 1 + 10 + NPH_LAYER) continue;
        p.ph_lo = ph; p.ph_hi = ph + 1; p.li = 0; p.pad = 0;
        hipLaunchKernelGGL(trunk_fwd, dim3(grid), dim3(512), LDS_BYTES, stream, p);
    }
#else
    p.ph_lo = 0; p.ph_hi = NPHASE; p.li = 0; p.pad = 0;
    hipLaunchKernelGGL(trunk_fwd, dim3(grid), dim3(512), LDS_BYTES, stream, p);
#endif
}
```

```cpp
#include <hip/hip_runtime.h>
#include <hip/hip_bf16.h>
#include <cstdio>
#include <cstdint>

#define LAS __attribute__((address_space(3)))
#define GAS __attribute__((address_space(1)))
typedef unsigned short bfr;
typedef short s8v __attribute__((ext_vector_type(8)));
typedef float f4v __attribute__((ext_vector_type(4)));
typedef unsigned u4v __attribute__((ext_vector_type(4)));
typedef unsigned u2v __attribute__((ext_vector_type(2)));
typedef int i4v __attribute__((ext_vector_type(4)));

#ifndef F8_PROJ0
#define F8_PROJ0 3
#endif
#ifndef F8_KVQ
#define F8_KVQ 2
#endif
#ifndef F8_OUT0
#define F8_OUT0 1
#endif
#ifndef F8_OUT1
#define F8_OUT1 1
#endif
#ifndef F8_OUT
#define F8_OUT (F8_OUT0 || F8_OUT1)
#endif
#ifndef STAGGER_G1
#define STAGGER_G1 0
#endif
constexpr int NB = 2, SEQ = 4096, DM = 4096, NT = NB * SEQ;
constexpr int GH = 32, GD = 128, GIN = 16448, CH = 64, NCH = SEQ / CH;
constexpr int AH = 16, AD = 128, AV = 256;
constexpr int PH = 8, PK = 128, PE = 16384, PQ = 2048, PTOP = 16;
constexpr float EPS = 1e-6f;
constexpr float LAMBDA_INIT = 0.35550906759f;
constexpr float SU = 64.f, SA = 64.f, SV = 4.f, SO = 16.f;

constexpr size_t MiB = 1u << 20;
constexpr size_t WS_CTL   = 0;
constexpr size_t WS_WTIN  = 1 * MiB;
constexpr size_t WS_WTBD  = WS_WTIN + 128 * MiB;
constexpr size_t WS_WTOUT = WS_WTBD + 1 * MiB;
constexpr size_t WS_WTKVQ = WS_WTOUT + 32 * MiB;
constexpr size_t WS_WTO   = WS_WTKVQ + 96 * MiB;
constexpr size_t WS_WTQRY = WS_WTO + 32 * MiB;
constexpr size_t WS_WTKEY = WS_WTQRY + 32 * MiB;
constexpr size_t WS_U     = WS_WTKEY + 16 * MiB;
constexpr size_t WS_VT    = WS_U + 128 * MiB;
constexpr size_t WS_A2    = WS_VT + 128 * MiB;
constexpr size_t WS_XN8   = WS_A2 + 128 * MiB;
constexpr size_t WS_XN    = WS_XN8 + 32 * MiB;
constexpr size_t WS_BIG   = WS_XN + 64 * MiB;
constexpr size_t WS_R     = WS_BIG + 256 * MiB;
constexpr size_t WS_QRY   = WS_R + 352 * MiB;
constexpr size_t WS_SC    = WS_QRY + 32 * MiB;
constexpr size_t WS_BD    = WS_SC + 64 * MiB;
constexpr size_t WS_EG    = WS_BD + 2 * MiB;
constexpr size_t WS_G     = WS_EG + 1 * MiB;
constexpr size_t WS_END   = WS_G + 256 * MiB;
constexpr size_t R_W = 0, R_U = 64 * MiB, R_QG = 128 * MiB, R_KD = 192 * MiB, R_QK = 256 * MiB, R_O = 288 * MiB;
constexpr size_t R_QH = 0, R_KH = 64 * MiB, R_VH = 128 * MiB, R_OH = 192 * MiB;
static_assert(WS_END <= (size_t)1790 * MiB, "workspace map");

constexpr int CW_BAR = 4096;
constexpr size_t CTL_ZERO_BYTES = 1 * MiB;

constexpr int LDS_BYTES = 147456;
constexpr int MISC_OFF = 146944;

typedef float f2v_ __attribute__((ext_vector_type(2)));
typedef __bf16 b2v_ __attribute__((ext_vector_type(2)));
__device__ __forceinline__ unsigned cvtpk(float lo, float hi) { const b2v_ r = __builtin_convertvector((f2v_){lo, hi}, b2v_); return __builtin_bit_cast(unsigned, r); }
__device__ __forceinline__ unsigned cvt4_fp8(float a, float b, float c, float d) { int w = 0; w = __builtin_amdgcn_cvt_pk_fp8_f32(a, b, w, false); w = __builtin_amdgcn_cvt_pk_fp8_f32(c, d, w, true); return (unsigned)w; }
__device__ __forceinline__ float bflo(unsigned w) { return __uint_as_float(w << 16); }
__device__ __forceinline__ float bfhi(unsigned w) { return __uint_as_float(w & 0xffff0000u); }
__device__ __forceinline__ float bf1(bfr b) { return __uint_as_float(((unsigned)b) << 16); }
__device__ __forceinline__ bfr f2bf1(float f) { return (bfr)(cvtpk(f, 0.f) & 0xffffu); }
__device__ __forceinline__ float wave_sum(float v) {
#pragma unroll
    for (int o = 1; o < 64; o <<= 1) v += __shfl_xor(v, o);
    return v;
}
__device__ __forceinline__ f4v zero_acc() { f4v z = {0.f, 0.f, 0.f, 0.f}; asm volatile("" : "+v"(z)); return z; }
#define MFMA_SETTLE(acc) asm volatile("s_nop 7\n\ts_nop 7" : "+v"(acc))
#define LDS_WAIT() asm volatile("s_waitcnt lgkmcnt(0)" ::: "memory")
#define VM_WAIT() asm volatile("s_waitcnt vmcnt(0)" ::: "memory")
#define XB_TMO      128
#define XB_XCNT(j)  (256  + 64 * (j))
#define XB_XSUB(j)  (1280 + 64 * (j))
#define XB_XGEN(j)  (2304 + 64 * (j))
#define XB_TOP      3328
#define XB_TOPGEN   3392
#define XCD_BAR_WORDS 3456
#define XB_SPIN_CAP (1u << 18)

__device__ __forceinline__ unsigned xb_ld(unsigned* p)              { return __hip_atomic_load(p, __ATOMIC_RELAXED, __HIP_MEMORY_SCOPE_AGENT); }
__device__ __forceinline__ unsigned xb_add(unsigned* p, unsigned v) { return __hip_atomic_fetch_add(p, v, __ATOMIC_RELAXED, __HIP_MEMORY_SCOPE_AGENT); }
__device__ __forceinline__ unsigned xb_xcc_id() { return (unsigned)__builtin_amdgcn_s_getreg((3 << 11) | 20) & 0xFu; }
#define XB_SPIN(cond, bar) do { unsigned _sp = 0; while (cond) { __builtin_amdgcn_s_sleep(1); \
    if ((++_sp & 255u) == 0u) { if (xb_ld(&(bar)[XB_TMO])) break; if (_sp > XB_SPIN_CAP) { atomicAdd(&(bar)[XB_TMO], 1u); break; } } } } while (0)

struct XcdBarrier {
    unsigned* bar; unsigned x;
    volatile LAS unsigned* st;
};

__device__ __forceinline__ XcdBarrier xcd_barrier_post(unsigned* bar, volatile LAS unsigned* st) {
    XcdBarrier b; b.bar = bar; b.x = xb_xcc_id(); b.st = st;
    if (threadIdx.x == 0) (void)xb_add(&bar[XB_XCNT(b.x)], 1u);
    return b;
}
__device__ __forceinline__ void xcd_barrier_complete(unsigned* bar, unsigned x, unsigned& nloc, unsigned& nx) {
    const unsigned G = gridDim.x * gridDim.y * gridDim.z;
    unsigned sum, cnt, mine, sp = 0u;
    for (;;) {
        sum = 0u; cnt = 0u; mine = 0u;
#pragma unroll
        for (unsigned j = 0; j < 16; ++j) { const unsigned c = xb_ld(&bar[XB_XCNT(j)]); sum += c; cnt += (c > 0u) ? 1u : 0u; mine = (j == x) ? c : mine; }
        if (sum == G) break;
        __builtin_amdgcn_s_sleep(1);
        if ((++sp & 255u) == 0u) { if (xb_ld(&bar[XB_TMO])) break; if (sp > XB_SPIN_CAP) { atomicAdd(&bar[XB_TMO], 1u); break; } }
    }
    nloc = mine > 0u ? mine : 1u; nx = cnt > 0u ? cnt : 1u;
}

__device__ __forceinline__ void xcd_barrier(const XcdBarrier& b) {
    asm volatile("s_waitcnt vmcnt(0)" ::: "memory");
    __syncthreads();
    if (threadIdx.x == 0) {
        unsigned* bar = b.bar;
        __builtin_amdgcn_s_waitcnt(0);
        unsigned nloc = b.st[0], nx = b.st[1];
        if (nloc == 0u) { xcd_barrier_complete(bar, b.x, nloc, nx); b.st[0] = nloc; b.st[1] = nx; }
        const unsigned old = xb_add(&bar[XB_XSUB(b.x)], 1u);
        const unsigned gen = old / nloc;
        if (old + 1u == (gen + 1u) * nloc) {
            __builtin_amdgcn_fence(__ATOMIC_RELEASE, "agent");
            asm volatile("s_waitcnt vmcnt(0)" ::: "memory");
            const unsigned og = xb_add(&bar[XB_TOP], 1u);
            const unsigned tg = og / nx;
            if (og + 1u == (tg + 1u) * nx) xb_add(&bar[XB_TOPGEN], 1u);
            else XB_SPIN(xb_ld(&bar[XB_TOPGEN]) == tg, bar);
            __builtin_amdgcn_fence(__ATOMIC_ACQUIRE, "agent");
            xb_add(&bar[XB_XGEN(b.x)], 1u);
            asm volatile("s_waitcnt vmcnt(0)" ::: "memory");
        } else {
            XB_SPIN(xb_ld(&bar[XB_XGEN(b.x)]) == gen, bar);
            __builtin_amdgcn_fence(__ATOMIC_ACQUIRE, "agent");
            asm volatile("s_waitcnt vmcnt(0)" ::: "memory");
        }
    }
    __syncthreads();
}
namespace pg8 {
#define PG8_LAS __attribute__((address_space(3)))
typedef unsigned short bf16_t;
typedef short bf16x8 __attribute__((ext_vector_type(8)));
typedef float f32x4 __attribute__((ext_vector_type(4)));
typedef unsigned u32x4 __attribute__((ext_vector_type(4)));
typedef int i32x4 __attribute__((ext_vector_type(4)));
typedef int i32x8 __attribute__((ext_vector_type(8)));
typedef unsigned u32x2 __attribute__((ext_vector_type(2)));
constexpr int BM = 256, BK = 64, HALF = 128, HTB = HALF * BK * 2  , STAGE_BYTES = 8 * HTB, NXCD = 8, WGM = 8;

__host__ __device__ __forceinline__ int lds_byte(int r, int c) { const int st = (r >> 4) * 2 + (c >> 5), rr = r & 15, cc = c & 31, ob = rr * 64 + cc * 2; return st * 1024 + (ob ^ (((ob >> 9) & 1) << 5)); }
__host__ __device__ __forceinline__ void stage_rc(int b, int& R, int& C) { const int st = b / 1024, sb = b % 1024, swz = sb ^ (((sb >> 9) & 1) << 5); R = (st >> 1) * 16 + swz / 64; C = (st & 1) * 32 + (swz % 64) / 2; }
__host__ __device__ __forceinline__ int perm32(int rho) { const int n = rho >> 4, i = rho & 15; return 8 * (i >> 2) + 4 * n + (i & 3); }

struct Unit { int pm, pn; };
struct Gemm { const bf16_t* A; const bf16_t* Bt; int M, N, K; };

struct StaticOrder {
    int nM, nN, nwg, G, c;
    __host__ __device__ void init(int M, int N, int G_, int c_) { nM = M / BM; nN = N / BM; nwg = nM * nN; G = G_; c = c_; }
    __host__ __device__ bool next(int i, Unit& u) const {
        const long L = (long)i * G + c; if (L >= nwg) return false;
        int wgid = (int)L; { const int q = nwg / NXCD, r = nwg % NXCD, xcd = wgid % NXCD, off = wgid / NXCD; wgid = (xcd < r ? xcd * (q + 1) : r * (q + 1) + (xcd - r) * q) + off; }
        const int nig = WGM * nN, gid = wgid / nig, fm = gid * WGM, gsz = (nM - fm) < WGM ? (nM - fm) : WGM;
        u.pm = fm + ((wgid % nig) % gsz); u.pn = (wgid % nig) / gsz; return true;
    }
    __device__ __forceinline__ void a_ready(const Unit&) const {}
    __device__ __forceinline__ void done(const Unit&) const {}
};

__device__ __forceinline__ unsigned cvt_pk_bf16(float lo, float hi) { unsigned r; asm volatile("v_cvt_pk_bf16_f32 %0, %1, %2" : "=v"(r) : "v"(lo), "v"(hi)); return r; }
typedef float f32x2 __attribute__((ext_vector_type(2)));
__device__ __forceinline__ f32x2 gelu_pk(f32x2 v) {
    const f32x2 av = __builtin_elementwise_abs(v), d = av * 0.2316418882f + 1.0f;
    f32x2 t; t.x = __builtin_amdgcn_rcpf(d.x); t.y = __builtin_amdgcn_rcpf(d.y);
    f32x2 q = t * 0.5307027145f + (-0.7265760135f); q = q * t + 0.7107068705f; q = q * t + (-0.142248368f); q = q * t + 0.127414796f; q = q * t;
    const f32x2 s = (v * v) * (-0.72134752044f);
    f32x2 e; e.x = __builtin_amdgcn_exp2f(s.x); e.y = __builtin_amdgcn_exp2f(s.y);
    const f32x2 m = v * (q * e), r = v - m;
    f32x2 o; o.x = v.x < 0.f ? m.x : r.x; o.y = v.y < 0.f ? m.y : r.y; return o;
}

template <int ACT  > struct EpiBf16 {
    static constexpr bool PERM = true, AFTER_DRAIN = false; static_assert(ACT == 0 || ACT == 1, "EpiBf16: ACT is 0 (none) or 1 (gelu_pk)");
    bf16_t* O; int ldc; const float* bias; int split_cols; size_t split_stride; float scale0;
    __device__ __forceinline__ void operator()(const f32x4 (&acc)[2][2][4][2], const Unit& u, int wr, int wc, int fr, int fq) const {
        const int row0 = u.pm * BM + wr * 64 + fr; int colt = u.pn * BM; bf16_t* base = O;
        float sc = 1.f; if (split_cols) { const int t = colt / split_cols; base += (size_t)t * split_stride; colt -= t * split_cols; if (t == 0) sc = scale0; }
        const int col0 = colt + wc * 32 + 8 * fq, bcol0 = u.pn * BM + wc * 32 + 8 * fq;
        f32x4 bv[2][2];
#pragma unroll
        for (int bj = 0; bj < 2; ++bj)
#pragma unroll
            for (int n = 0; n < 2; ++n) bv[bj][n] = bias ? *(const f32x4*)(bias + bcol0 + bj * HALF + 4 * n) : (f32x4){0.f, 0.f, 0.f, 0.f};
#pragma unroll
        for (int ai = 0; ai < 2; ++ai)
#pragma unroll
            for (int m = 0; m < 4; ++m) { bf16_t* rowp = base + (size_t)(row0 + ai * HALF + m * 16) * ldc + col0;
#pragma unroll
                for (int bj = 0; bj < 2; ++bj) { f32x4 v0 = acc[ai][bj][m][0] + bv[bj][0], v1 = acc[ai][bj][m][1] + bv[bj][1];
                    if (ACT == 1) { f32x2 a = gelu_pk((f32x2){v0[0], v0[1]}), b = gelu_pk((f32x2){v0[2], v0[3]}), c = gelu_pk((f32x2){v1[0], v1[1]}), d = gelu_pk((f32x2){v1[2], v1[3]});
                        v0 = (f32x4){a.x, a.y, b.x, b.y}; v1 = (f32x4){c.x, c.y, d.x, d.y}; }
                    v0 = v0 * sc; v1 = v1 * sc; u32x4 w; w.x = cvt_pk_bf16(v0[0], v0[1]); w.y = cvt_pk_bf16(v0[2], v0[3]); w.z = cvt_pk_bf16(v1[0], v1[1]); w.w = cvt_pk_bf16(v1[2], v1[3]);
                    *(u32x4*)(rowp + bj * HALF) = w; } }
    }
};
struct EpiRes {
    static constexpr bool PERM = false, AFTER_DRAIN = false;
    const float* base; float* out; int ldc; float scale;
    __device__ __forceinline__ void operator()(const f32x4 (&acc)[2][2][4][2], const Unit& u, int wr, int wc, int fr, int fq) const {
        const int row0 = u.pm * BM + wr * 64 + fr, col0 = u.pn * BM + wc * 32 + 4 * fq;
#pragma unroll
        for (int ai = 0; ai < 2; ++ai)
#pragma unroll
            for (int m = 0; m < 4; ++m) { const size_t off = (size_t)(row0 + ai * HALF + m * 16) * ldc + col0;
                f32x4 bs[2][2];
#pragma unroll
                for (int bj = 0; bj < 2; ++bj)
#pragma unroll
                    for (int n = 0; n < 2; ++n) bs[bj][n] = *(const f32x4*)(base + off + bj * HALF + n * 16);
#pragma unroll
                for (int bj = 0; bj < 2; ++bj)
#pragma unroll
                    for (int n = 0; n < 2; ++n) *(f32x4*)(out + off + bj * HALF + n * 16) = bs[bj][n] + acc[ai][bj][m][n] * scale;
                asm volatile("" ::: "memory"); }
    }
};
struct EpiStF32 {
    static constexpr bool PERM = false, AFTER_DRAIN = false;
    float* C; int ldc;
    __device__ __forceinline__ void operator()(const f32x4 (&acc)[2][2][4][2], const Unit& u, int wr, int wc, int fr, int fq) const {
        const int row0 = u.pm * BM + wr * 64 + fr, col0 = u.pn * BM + wc * 32 + 4 * fq;
#pragma unroll
        for (int ai = 0; ai < 2; ++ai)
#pragma unroll
            for (int m = 0; m < 4; ++m) { float* rowp = C + (size_t)(row0 + ai * HALF + m * 16) * ldc + col0;
#pragma unroll
                for (int bj = 0; bj < 2; ++bj)
#pragma unroll
                    for (int n = 0; n < 2; ++n) *(f32x4*)(rowp + bj * HALF + n * 16) = acc[ai][bj][m][n]; }
    }
};
struct EpiGate {
    static constexpr bool PERM = true, AFTER_DRAIN = false;
    bf16_t* G; int ldc;
    __device__ __forceinline__ void operator()(const f32x4 (&acc)[2][2][4][2], const Unit& u, int wr, int wc, int fr, int fq) const {
        const int row0 = u.pm * BM + wr * 64 + fr, col0 = u.pn * BM + wc * 32 + 8 * fq;
#pragma unroll
        for (int ai = 0; ai < 2; ++ai)
#pragma unroll
            for (int m = 0; m < 4; ++m) { bf16_t* rowp = G + (size_t)(row0 + ai * HALF + m * 16) * ldc + col0;
                u32x4 g[2];
#pragma unroll
                for (int bj = 0; bj < 2; ++bj) g[bj] = *(const u32x4*)(rowp + bj * HALF);
#pragma unroll
                for (int bj = 0; bj < 2; ++bj) {
                    if ((g[bj].x | g[bj].y | g[bj].z | g[bj].w) != 0u) {
                        const f32x4 v0 = acc[ai][bj][m][0], v1 = acc[ai][bj][m][1];
                        const f32x2 a = gelu_pk((f32x2){v0[0], v0[1]}), b = gelu_pk((f32x2){v0[2], v0[3]}), c = gelu_pk((f32x2){v1[0], v1[1]}), d = gelu_pk((f32x2){v1[2], v1[3]});
                        u32x4 w;
                        w.x = cvt_pk_bf16(a.x * __uint_as_float(g[bj].x << 16), a.y * __uint_as_float(g[bj].x & 0xffff0000u));
                        w.y = cvt_pk_bf16(b.x * __uint_as_float(g[bj].y << 16), b.y * __uint_as_float(g[bj].y & 0xffff0000u));
                        w.z = cvt_pk_bf16(c.x * __uint_as_float(g[bj].z << 16), c.y * __uint_as_float(g[bj].z & 0xffff0000u));
                        w.w = cvt_pk_bf16(d.x * __uint_as_float(g[bj].w << 16), d.y * __uint_as_float(g[bj].w & 0xffff0000u));
                        *(u32x4*)(rowp + bj * HALF) = w;
                    }
                } }
    }
};
template <int MODE = 0>
struct EpiGate8 {
    static constexpr bool PERM = true, AFTER_DRAIN = false;
    bf16_t* G; unsigned char* A2; int ldc; float hscale, oscale;
    __device__ __forceinline__ void operator()(const f32x4 (&acc)[2][2][4][2], const Unit& u, int wr, int wc, int fr, int fq) const {
        const int row0 = u.pm * BM + wr * 64 + fr, col0 = u.pn * BM + wc * 32 + 8 * fq;
#pragma unroll
        for (int ai = 0; ai < 2; ++ai)
#pragma unroll
            for (int m = 0; m < 4; ++m) { const size_t ro = (size_t)(row0 + ai * HALF + m * 16) * ldc + col0;
                u32x4 g[2];
#pragma unroll
                for (int bj = 0; bj < 2; ++bj) g[bj] = (MODE == 2 || MODE == 3) ? (u32x4){0x3f803f80u, 0x3f803f80u, 0x3f803f80u, 0x3f803f80u} : *(const u32x4*)(G + ro + bj * HALF);
#pragma unroll
                for (int bj = 0; bj < 2; ++bj) {
                    u32x2 w = {0u, 0u};
                    if ((g[bj].x | g[bj].y | g[bj].z | g[bj].w) != 0u) {
                        const f32x4 v0 = acc[ai][bj][m][0] * hscale, v1 = acc[ai][bj][m][1] * hscale;
                        const f32x2 a = MODE == 3 ? (f32x2){v0[0], v0[1]} : gelu_pk((f32x2){v0[0], v0[1]}), b = MODE == 3 ? (f32x2){v0[2], v0[3]} : gelu_pk((f32x2){v0[2], v0[3]}), c = MODE == 3 ? (f32x2){v1[0], v1[1]} : gelu_pk((f32x2){v1[0], v1[1]}), d = MODE == 3 ? (f32x2){v1[2], v1[3]} : gelu_pk((f32x2){v1[2], v1[3]});
                        float y[8] = {a.x * __uint_as_float(g[bj].x << 16), a.y * __uint_as_float(g[bj].x & 0xffff0000u), b.x * __uint_as_float(g[bj].y << 16), b.y * __uint_as_float(g[bj].y & 0xffff0000u),
                                      c.x * __uint_as_float(g[bj].z << 16), c.y * __uint_as_float(g[bj].z & 0xffff0000u), d.x * __uint_as_float(g[bj].w << 16), d.y * __uint_as_float(g[bj].w & 0xffff0000u)};
#pragma unroll
                        for (int k = 0; k < 8; ++k) y[k] = fminf(fmaxf(y[k] * oscale, -440.f), 440.f);
                        int lo = 0, hi = 0;
                        lo = __builtin_amdgcn_cvt_pk_fp8_f32(y[0], y[1], lo, false); lo = __builtin_amdgcn_cvt_pk_fp8_f32(y[2], y[3], lo, true);
                        hi = __builtin_amdgcn_cvt_pk_fp8_f32(y[4], y[5], hi, false); hi = __builtin_amdgcn_cvt_pk_fp8_f32(y[6], y[7], hi, true);
                        w.x = (unsigned)lo; w.y = (unsigned)hi;
                        if (MODE == 0) *(u32x4*)(G + ro + bj * HALF) = (u32x4){0u, 0u, 0u, 0u};
                    }
                    *(u32x2*)(A2 + ro + bj * HALF) = w;
                } }
    }
};

struct EpiGate8C {
    static constexpr bool PERM = true, AFTER_DRAIN = false;
    static constexpr int REC_OFF = STAGE_BYTES, REC_WAVE = 1984, REC_DW = 8, CAP = REC_WAVE / (4 * REC_DW);
    unsigned char* G; unsigned char* A2; int ldc; float hscale, oscale;
    static __device__ __forceinline__ float gdec(unsigned w, int k) { const unsigned b = (w >> (8 * k)) & 255u; return b ? __builtin_amdgcn_exp2f(((float)b - 195.f) * 0.05f) : 0.f; }
    __device__ __forceinline__ void one(unsigned h0, unsigned h1, unsigned h2, unsigned h3, unsigned g0, unsigned g1, unsigned off) const {
        const f32x2 a = gelu_pk((f32x2){__uint_as_float(h0 << 16), __uint_as_float(h0 & 0xffff0000u)}), b = gelu_pk((f32x2){__uint_as_float(h1 << 16), __uint_as_float(h1 & 0xffff0000u)}),
                    c = gelu_pk((f32x2){__uint_as_float(h2 << 16), __uint_as_float(h2 & 0xffff0000u)}), d = gelu_pk((f32x2){__uint_as_float(h3 << 16), __uint_as_float(h3 & 0xffff0000u)});
        float y[8] = {a.x * gdec(g0, 0), a.y * gdec(g0, 1), b.x * gdec(g0, 2), b.y * gdec(g0, 3), c.x * gdec(g1, 0), c.y * gdec(g1, 1), d.x * gdec(g1, 2), d.y * gdec(g1, 3)};
#pragma unroll
        for (int k = 0; k < 8; ++k) y[k] = fminf(fmaxf(y[k] * oscale, -440.f), 440.f);
        int lo = 0, hi = 0;
        lo = __builtin_amdgcn_cvt_pk_fp8_f32(y[0], y[1], lo, false); lo = __builtin_amdgcn_cvt_pk_fp8_f32(y[2], y[3], lo, true);
        hi = __builtin_amdgcn_cvt_pk_fp8_f32(y[4], y[5], hi, false); hi = __builtin_amdgcn_cvt_pk_fp8_f32(y[6], y[7], hi, true);
        *(u32x2*)(A2 + off) = (u32x2){(unsigned)lo, (unsigned)hi};
        *(u32x2*)(G + off) = (u32x2){0u, 0u};
    }
    __device__ __forceinline__ void flush(PG8_LAS unsigned* rec, int cnt, int lane) const {
        asm volatile("s_waitcnt lgkmcnt(0)" ::: "memory");
        if (lane < cnt) { const PG8_LAS unsigned* r = rec + lane * REC_DW;
            const u32x4 hh = *(const PG8_LAS u32x4*)r; const u32x2 gg = *(const PG8_LAS u32x2*)(r + 4); const unsigned off = r[6];
            one(hh.x, hh.y, hh.z, hh.w, gg.x, gg.y, off); }
        asm volatile("s_waitcnt lgkmcnt(0)" ::: "memory");
    }
    __device__ __forceinline__ void operator()(const f32x4 (&acc)[2][2][4][2], const Unit& u, int wr, int wc, int fr, int fq) const {
        extern __shared__ __attribute__((aligned(16))) char pg8_lds_sym[];
        const int lane = fq * 16 + fr;
        PG8_LAS unsigned* rec = (PG8_LAS unsigned*)((PG8_LAS char*)pg8_lds_sym + REC_OFF + (wr * 4 + wc) * REC_WAVE);
        const int row0 = u.pm * BM + wr * 64 + fr, col0 = u.pn * BM + wc * 32 + 8 * fq;
        int cnt = 0;
#pragma unroll
        for (int ai = 0; ai < 2; ++ai) {
            u32x2 gall[4][2];
#pragma unroll
            for (int m = 0; m < 4; ++m) { const unsigned ro = (unsigned)(row0 + ai * HALF + m * 16) * (unsigned)ldc + (unsigned)col0;
#pragma unroll
                for (int bj = 0; bj < 2; ++bj) gall[m][bj] = *(const u32x2*)(G + ro + bj * HALF); }
            asm volatile("" ::: "memory");
#pragma unroll
            for (int m = 0; m < 4; ++m) { const unsigned ro = (unsigned)(row0 + ai * HALF + m * 16) * (unsigned)ldc + (unsigned)col0;
#pragma unroll
                for (int bj = 0; bj < 2; ++bj) { const u32x2 g = gall[m][bj];
                    const bool nz = (g.x | g.y) != 0u;
                    const unsigned long long bal = __builtin_amdgcn_ballot_w64(nz);
                    const int np = __builtin_popcountll(bal);
                    if (np > CAP) {
                        if (nz) { const f32x4 v0 = acc[ai][bj][m][0] * hscale, v1 = acc[ai][bj][m][1] * hscale;
                            one(cvt_pk_bf16(v0[0], v0[1]), cvt_pk_bf16(v0[2], v0[3]), cvt_pk_bf16(v1[0], v1[1]), cvt_pk_bf16(v1[2], v1[3]), g.x, g.y, ro + bj * HALF); }
                        else *(u32x2*)(A2 + ro + bj * HALF) = (u32x2){0u, 0u};
                        continue; }
                    if (cnt + np > CAP) { flush(rec, cnt, lane); cnt = 0; }
                    if (nz) { const int slot = cnt + (int)__builtin_amdgcn_mbcnt_hi((unsigned)(bal >> 32), __builtin_amdgcn_mbcnt_lo((unsigned)bal, 0u));
                        const f32x4 v0 = acc[ai][bj][m][0] * hscale, v1 = acc[ai][bj][m][1] * hscale;
                        PG8_LAS unsigned* r = rec + slot * REC_DW;
                        *(PG8_LAS u32x4*)r = (u32x4){cvt_pk_bf16(v0[0], v0[1]), cvt_pk_bf16(v0[2], v0[3]), cvt_pk_bf16(v1[0], v1[1]), cvt_pk_bf16(v1[2], v1[3])}; *(PG8_LAS u32x2*)(r + 4) = g; r[6] = ro + bj * HALF; }
                    else *(u32x2*)(A2 + ro + bj * HALF) = (u32x2){0u, 0u};
                    cnt += np;
                } }
        }
        flush(rec, cnt, lane);
    }
};

struct EpiHead {
    static constexpr bool PERM = true, AFTER_DRAIN = false;
    static constexpr int RED_OFF = STAGE_BYTES;
    bf16_t* Kh; bf16_t* Qh; bf16_t* KVQ; const float* kg; const float* qg; float scale; int ldc;
    __device__ __forceinline__ void operator()(const f32x4 (&acc)[2][2][4][2], const Unit& u, int wr, int wc, int fr, int fq) const {
        extern __shared__ __attribute__((aligned(16))) char pg8_lds_sym[];
        const int colt = u.pn * BM, row0 = u.pm * BM + wr * 64 + fr, cw = wc * 32 + 8 * fq;
        if (colt >= 8192) {
#pragma unroll
            for (int ai = 0; ai < 2; ++ai)
#pragma unroll
                for (int m = 0; m < 4; ++m) { bf16_t* rowp = KVQ + (size_t)(row0 + ai * HALF + m * 16) * ldc + colt + cw;
#pragma unroll
                    for (int bj = 0; bj < 2; ++bj) { const f32x4 v0 = acc[ai][bj][m][0] * scale, v1 = acc[ai][bj][m][1] * scale;
                        u32x4 w; w.x = cvt_pk_bf16(v0[0], v0[1]); w.y = cvt_pk_bf16(v0[2], v0[3]); w.z = cvt_pk_bf16(v1[0], v1[1]); w.w = cvt_pk_bf16(v1[2], v1[3]);
                        *(u32x4*)(rowp + bj * HALF) = w; } }
            return; }
        PG8_LAS float* red = (PG8_LAS float*)((PG8_LAS char*)pg8_lds_sym + RED_OFF);
#pragma unroll
        for (int ai = 0; ai < 2; ++ai)
#pragma unroll
            for (int m = 0; m < 4; ++m)
#pragma unroll
                for (int bj = 0; bj < 2; ++bj) { const f32x4 v0 = acc[ai][bj][m][0] * scale, v1 = acc[ai][bj][m][1] * scale;
                    float s = (v0[0] * v0[0] + v0[1] * v0[1]) + (v0[2] * v0[2] + v0[3] * v0[3]) + (v1[0] * v1[0] + v1[1] * v1[1]) + (v1[2] * v1[2] + v1[3] * v1[3]);
                    s += __shfl_xor(s, 16); s += __shfl_xor(s, 32);
                    if (fq == 0) red[(((((wr * 4 + wc) * 2 + ai) * 4 + m) * 2 + bj) << 4) + fr] = s; }
        asm volatile("s_waitcnt lgkmcnt(0)\n\ts_barrier" ::: "memory");
        const bool isq = colt >= 4096; const float* gp = (isq ? qg : kg) + cw; const f32x4 g0 = *(const f32x4*)gp, g1 = *(const f32x4*)(gp + 4);
        bf16_t* dsth = isq ? Qh : Kh; const int head0 = ((isq ? colt - 4096 : colt) >> 7);
#pragma unroll
        for (int ai = 0; ai < 2; ++ai)
#pragma unroll
            for (int m = 0; m < 4; ++m) { const int t = row0 + ai * HALF + m * 16, b = t >> 12, sq = t & 4095;
#pragma unroll
                for (int bj = 0; bj < 2; ++bj) {
                    float tot = 0.f;
#pragma unroll
                    for (int w = 0; w < 4; ++w) tot += red[(((((wr * 4 + w) * 2 + ai) * 4 + m) * 2 + bj) << 4) + fr];
                    const float rn = __builtin_amdgcn_rsqf(tot * (1.f / 128.f) + EPS) * scale;
                    const f32x4 v0 = acc[ai][bj][m][0] * rn * g0, v1 = acc[ai][bj][m][1] * rn * g1;
                    u32x4 w8; w8.x = cvt_pk_bf16(v0[0], v0[1]); w8.y = cvt_pk_bf16(v0[2], v0[3]); w8.z = cvt_pk_bf16(v1[0], v1[1]); w8.w = cvt_pk_bf16(v1[2], v1[3]);
                    *(u32x4*)(dsth + ((size_t)(b * 32 + head0 + bj) * SEQ + sq) * 128 + cw) = w8; } }
    }
};
template <class Epi, class Sched, bool ALIGN_EPI = false, bool SP2 = false, bool F8 = false>
__device__ __forceinline__ void gemm_phase(PG8_LAS unsigned char* lds, const Gemm g, const Sched& S, const Epi& E) {
    const int tid = threadIdx.x, wid = __builtin_amdgcn_readfirstlane(tid >> 6), lane = tid & 63, wr = wid >> 2, wc = wid & 3, fr = lane & 15, fq = lane >> 4;
    const int K = g.K, nt = K / BK;
    unsigned voffA[2], voffB[2];
#pragma unroll
    for (int i = 0; i < 2; ++i) { int R, C; stage_rc(tid * 16 + i * 8192, R, C); const int Rb = Epi::PERM ? ((R & ~31) + perm32(R & 31)) : R;
        voffA[i] = (unsigned)(R * K + C) * 2u; voffB[i] = (unsigned)(Rb * K + C) * 2u; }
    const size_t kstep = (size_t)(BK * 2);
    const size_t hstep = (size_t)HALF * K * 2;
    const size_t tstep = 2 * hstep;
    const unsigned ldsw = (unsigned)wid * 1024u;
    const int aoff = lds_byte(wr * 64 + fr, fq * 8), boff = lds_byte(wc * 32 + fr, fq * 8);
#define PG8_SA(b, h) (((b) * 2 + (h)) * HTB)
#define PG8_SB(b, h) ((4 + (b) * 2 + (h)) * HTB)
#define PG8_STAGE(bufoff, gbase, voff) do { _Pragma("unroll") for (int _i = 0; _i < 2; ++_i) \
        __builtin_amdgcn_global_load_lds((const unsigned*)((const char*)(gbase) + (voff)[_i]), (PG8_LAS unsigned*)(lds + (bufoff) + ldsw + _i * 8192), 16, 0, 0); } while (0)
#define PG8_LDA(dst, b, h) do { if constexpr (F8) { _Pragma("unroll") for (int m = 0; m < 4; ++m) { const i32x4 lo_ = *(const PG8_LAS i32x4*)(lds + PG8_SA(b, h) + aoff + m * 2048), hi_ = *(const PG8_LAS i32x4*)(lds + PG8_SA(b, h) + aoff + m * 2048 + 1024); \
        dst##_8[m] = __builtin_shufflevector(lo_, hi_, 0, 1, 2, 3, 4, 5, 6, 7); } } else { _Pragma("unroll") for (int m = 0; m < 4; ++m) _Pragma("unroll") for (int k = 0; k < 2; ++k) dst[m][k] = *(const PG8_LAS bf16x8*)(lds + PG8_SA(b, h) + aoff + m * 2048 + k * 1024); } } while (0)
#define PG8_LDB(dst, b, h) do { if constexpr (F8) { _Pragma("unroll") for (int n = 0; n < 2; ++n) { const i32x4 lo_ = *(const PG8_LAS i32x4*)(lds + PG8_SB(b, h) + boff + n * 2048), hi_ = *(const PG8_LAS i32x4*)(lds + PG8_SB(b, h) + boff + n * 2048 + 1024); \
        dst##_8[n] = __builtin_shufflevector(lo_, hi_, 0, 1, 2, 3, 4, 5, 6, 7); } } else { _Pragma("unroll") for (int n = 0; n < 2; ++n) _Pragma("unroll") for (int k = 0; k < 2; ++k) dst[n][k] = *(const PG8_LAS bf16x8*)(lds + PG8_SB(b, h) + boff + n * 2048 + k * 1024); } } while (0)
#define PG8_MMA(ai, bj, At, Bt) do { __builtin_amdgcn_s_setprio(1); if constexpr (F8) { _Pragma("unroll") for (int m = 0; m < 4; ++m) _Pragma("unroll") for (int n = 0; n < 2; ++n) \
        asm volatile("v_mfma_f32_16x16x128_f8f6f4 %0, %1, %2, %0" : "+v"(acc[ai][bj][m][n]) : "v"(Bt##_8[n]), "v"(At##_8[m])); } \
    else { _Pragma("unroll") for (int m = 0; m < 4; ++m) _Pragma("unroll") for (int n = 0; n < 2; ++n) _Pragma("unroll") for (int k = 0; k < 2; ++k) \
        acc[ai][bj][m][n] = __builtin_amdgcn_mfma_f32_16x16x32_bf16(Bt[n][k], At[m][k], acc[ai][bj][m][n], 0, 0, 0); } __builtin_amdgcn_s_setprio(0); } while (0)
#define PG8_WAIT_V(n) asm volatile("s_waitcnt vmcnt(" #n ")" ::: "memory")
#define PG8_WAIT_L(n) asm volatile("s_waitcnt lgkmcnt(" #n ")" ::: "memory")
#define PG8_BAR __builtin_amdgcn_s_barrier()
#define PG8_SCHED __builtin_amdgcn_sched_barrier(0)
    Unit cur, nxt; int ui = 0;
    if (!S.next(0, cur)) return;
    f32x4 acc[2][2][4][2];
#pragma unroll
    for (int a = 0; a < 2; ++a)
#pragma unroll
        for (int b = 0; b < 2; ++b)
#pragma unroll
            for (int m = 0; m < 4; ++m)
#pragma unroll
                for (int n = 0; n < 2; ++n) acc[a][b][m][n] = (f32x4){0.f, 0.f, 0.f, 0.f};
    const int f8_scale_one = 0x7F7F7F7F;
    bf16x8 At[4][2], B0[2][2], B1[2][2]; i32x8 At_8[4], B0_8[2], B1_8[2];
    const char* cA = (const char*)g.A + (size_t)cur.pm * tstep; const char* cB = (const char*)g.Bt + (size_t)cur.pn * tstep;
    S.a_ready(cur);
    if constexpr (SP2) {
        PG8_STAGE(PG8_SB(0, 0), cB, voffB); PG8_STAGE(PG8_SB(0, 1), cB + hstep, voffB); PG8_STAGE(PG8_SA(0, 0), cA, voffA); PG8_STAGE(PG8_SA(0, 1), cA + hstep, voffA);
        if (wr == 1) PG8_BAR;
        PG8_WAIT_V(2); PG8_BAR;
        PG8_STAGE(PG8_SB(1, 0), cB + kstep, voffB); PG8_STAGE(PG8_SA(1, 0), cA + kstep, voffA); PG8_STAGE(PG8_SB(1, 1), cB + hstep + kstep, voffB);
        PG8_WAIT_V(6); PG8_BAR;
    } else {
        PG8_STAGE(PG8_SB(0, 0), cB, voffB); PG8_STAGE(PG8_SA(0, 0), cA, voffA); PG8_STAGE(PG8_SB(0, 1), cB + hstep, voffB); PG8_STAGE(PG8_SA(0, 1), cA + hstep, voffA);
        if (wr == 1) PG8_BAR;
        PG8_WAIT_V(4); PG8_BAR;
        PG8_STAGE(PG8_SB(1, 0), cB + kstep, voffB); PG8_STAGE(PG8_SA(1, 0), cA + kstep, voffA); PG8_STAGE(PG8_SB(1, 1), cB + hstep + kstep, voffB);
        PG8_WAIT_V(6); PG8_BAR;
    }
    for (;;) {
        const bool has_next = S.next(ui + 1, nxt);
        const char* nA = has_next ? (const char*)g.A + (size_t)nxt.pm * tstep : cA; const char* nB = has_next ? (const char*)g.Bt + (size_t)nxt.pn * tstep : cB;
        for (int t = 0; t < nt; t += 2) {
            const bool last = (t == nt - 2);
            const char* a1 = cA + (size_t)(t + 1) * kstep;
            const char* a2 = last ? nA : cA + (size_t)(t + 2) * kstep; const char* b2 = last ? nB : cB + (size_t)(t + 2) * kstep;
            const char* a3 = a2 + kstep; const char* b3 = b2 + kstep;
            if (last && has_next) S.a_ready(nxt);
            if constexpr (SP2) {
            PG8_LDB(B0, 0, 0); PG8_LDB(B1, 0, 1); PG8_SCHED; PG8_LDA(At, 0, 0); PG8_STAGE(PG8_SA(1, 1), a1 + hstep, voffA);
            PG8_WAIT_V(8); PG8_WAIT_L(0); PG8_BAR; PG8_MMA(0, 0, At, B0); PG8_MMA(0, 1, At, B1); PG8_BAR; PG8_SCHED;
            PG8_LDA(At, 0, 1); PG8_STAGE(PG8_SB(0, 0), b2, voffB); PG8_STAGE(PG8_SB(0, 1), b2 + hstep, voffB); PG8_STAGE(PG8_SA(0, 0), a2, voffA);
            PG8_WAIT_V(8); PG8_WAIT_L(0); PG8_BAR; PG8_MMA(1, 0, At, B0); PG8_MMA(1, 1, At, B1); PG8_BAR; PG8_SCHED;
            PG8_LDB(B0, 1, 0); PG8_LDB(B1, 1, 1); PG8_SCHED; PG8_LDA(At, 1, 0); PG8_STAGE(PG8_SA(0, 1), a2 + hstep, voffA);
            PG8_WAIT_V(8); PG8_WAIT_L(0); PG8_BAR; PG8_MMA(0, 0, At, B0); PG8_MMA(0, 1, At, B1); PG8_BAR; PG8_SCHED;
            PG8_LDA(At, 1, 1); PG8_STAGE(PG8_SB(1, 0), b3, voffB); PG8_STAGE(PG8_SB(1, 1), b3 + hstep, voffB); PG8_STAGE(PG8_SA(1, 0), a3, voffA);
            PG8_WAIT_V(8); PG8_WAIT_L(0); PG8_BAR; PG8_MMA(1, 0, At, B0); PG8_MMA(1, 1, At, B1); PG8_BAR; PG8_SCHED;
            } else {
            PG8_LDB(B0, 0, 0); PG8_SCHED; PG8_LDA(At, 0, 0); PG8_STAGE(PG8_SA(1, 1), a1 + hstep, voffA);
            PG8_WAIT_L(8); PG8_BAR; PG8_WAIT_L(0); PG8_MMA(0, 0, At, B0); PG8_BAR; PG8_SCHED;
            PG8_LDB(B1, 0, 1); PG8_STAGE(PG8_SB(0, 0), b2, voffB);
            PG8_BAR; PG8_WAIT_L(0); PG8_MMA(0, 1, At, B1); PG8_BAR;
            PG8_LDA(At, 0, 1); PG8_STAGE(PG8_SA(0, 0), a2, voffA);
            PG8_BAR; PG8_WAIT_L(0); PG8_MMA(1, 0, At, B0); PG8_BAR; PG8_SCHED;
            PG8_STAGE(PG8_SB(0, 1), b2 + hstep, voffB);
            PG8_WAIT_V(6); PG8_BAR; PG8_MMA(1, 1, At, B1); PG8_BAR;
            PG8_LDB(B0, 1, 0); PG8_SCHED; PG8_LDA(At, 1, 0); PG8_STAGE(PG8_SA(0, 1), a2 + hstep, voffA);
            PG8_WAIT_L(8); PG8_BAR; PG8_WAIT_L(0); PG8_MMA(0, 0, At, B0); PG8_BAR; PG8_SCHED;
            PG8_LDB(B1, 1, 1); PG8_STAGE(PG8_SB(1, 0), b3, voffB);
            PG8_BAR; PG8_WAIT_L(0); PG8_MMA(0, 1, At, B1); PG8_BAR;
            PG8_LDA(At, 1, 1); PG8_STAGE(PG8_SA(1, 0), a3, voffA);
            PG8_BAR; PG8_WAIT_L(0); PG8_MMA(1, 0, At, B0); PG8_BAR; PG8_SCHED;
            PG8_STAGE(PG8_SB(1, 1), b3 + hstep, voffB);
            PG8_WAIT_V(6); PG8_BAR; PG8_MMA(1, 1, At, B1); PG8_BAR;
            }
        }
        if constexpr (ALIGN_EPI) { if (wr == 0) PG8_BAR; }
        if constexpr (!Epi::AFTER_DRAIN) { E(acc, cur, wr, wc, fr, fq); S.done(cur); }
        if (!has_next) break;
#pragma unroll
        for (int a = 0; a < 2; ++a)
#pragma unroll
            for (int b = 0; b < 2; ++b)
#pragma unroll
                for (int m = 0; m < 4; ++m)
#pragma unroll
                    for (int n = 0; n < 2; ++n) acc[a][b][m][n] = (f32x4){0.f, 0.f, 0.f, 0.f};
        cur = nxt; cA = nA; cB = nB; ++ui;
        if constexpr (ALIGN_EPI) { if (wr == 1) PG8_BAR; }
    }
    PG8_WAIT_V(0);
    if constexpr (!ALIGN_EPI) { if (wr == 0) PG8_BAR; }
    PG8_BAR;
    if constexpr (Epi::AFTER_DRAIN) { E.fused(acc, cur, wr, wc, fr, fq, lds, wid, lane); S.done(cur); }
#undef PG8_SA
#undef PG8_SB
#undef PG8_STAGE
#undef PG8_LDA
#undef PG8_LDB
#undef PG8_MMA
#undef PG8_WAIT_V
#undef PG8_WAIT_L
#undef PG8_BAR
#undef PG8_SCHED
}
}
namespace att {
constexpr int D = 128;
#if F8_KVQ
constexpr int VSTR = 12288;
#else
constexpr int VSTR = 128;
#endif
constexpr int WINDOW = 4096;
constexpr float THR = 8.f;
constexpr bool WSKIP = false;
constexpr float SCALE = 0.08838834764831845f;
constexpr int NW = 8, QBLK = 32, KVBLK = 64, QB = NW * QBLK;
constexpr int SHM_V = KVBLK * D * 2, SHM_K = KVBLK * D * 2;
constexpr int LDS_BYTES = 2 * SHM_V + 2 * SHM_K + NW * 64 * 4;
using bf16 = __hip_bfloat16;
typedef short bf16x8 __attribute__((ext_vector_type(8)));
typedef short s16x4 __attribute__((ext_vector_type(4)));
typedef float f32x16 __attribute__((ext_vector_type(16)));
typedef float f32x4 __attribute__((ext_vector_type(4)));
typedef unsigned u32x4 __attribute__((ext_vector_type(4)));
template <class A, class Bt> struct same_t { static constexpr bool v = false; };
template <class A> struct same_t<A, A> { static constexpr bool v = true; };

#define KSWZ(row, colB) ((row) * 256 + ((colB) ^ (((row) & 7) << 4)))
#define SBAR() __builtin_amdgcn_sched_barrier(0)
__device__ __forceinline__ int v_st(int k, int c) { const int kk = (k & ~0xC) | ((k & 4) << 1) | ((k & 8) >> 1); return ((kk >> 3) * 4 + (c >> 5)) * 512 + ((kk & 7) * 32 + (c & 31)) * 2; }
__device__ __forceinline__ int v_rd_base(int lane) { return ((lane & 3) << 3) | (((lane >> 2) & 3) << 6) | (((lane >> 4) & 1) << 5) | (((lane >> 5) & 1) << 8); }
constexpr int v_rd_off(int d0, int ks, int half) { return d0 * 512 + ks * 4096 + half * 2048; }
__device__ __forceinline__ int crow(int r, int hi) { return (r & 3) + 8 * (r >> 2) + 4 * hi; }
__device__ __forceinline__ unsigned cvtpk(float lo, float hi) {
    unsigned r; asm volatile("v_cvt_pk_bf16_f32 %0, %1, %2" : "=v"(r) : "v"(lo), "v"(hi)); return r;
}
__device__ __forceinline__ bf16x8 pack8(f32x4 a, f32x4 b) {
    u32x4 w = {cvtpk(a[0], a[1]), cvtpk(a[2], a[3]), cvtpk(b[0], b[1]), cvtpk(b[2], b[3])};
    return *reinterpret_cast<bf16x8*>(&w);
}
template <class T> __device__ __forceinline__ bf16x8 load8(const T* p) {
    if constexpr (same_t<T, float>::v) { return pack8(*(const f32x4*)p, *(const f32x4*)(p + 4)); }
    else { return *reinterpret_cast<const bf16x8*>(p); }
}
__device__ __forceinline__ void mask_tile(f32x16& p0, f32x16& p1, int dq, unsigned W) {
    const float NEG = -__builtin_inff();
#pragma unroll
    for (int r = 0; r < 16; ++r) {
        const int c = (r & 3) + 8 * (r >> 2);
        if ((unsigned)(dq - c) >= W) p0[r] = NEG;
        if ((unsigned)(dq - c - 32) >= W) p1[r] = NEG;
    }
}
__device__ __forceinline__ void partialSM(f32x16& p0, f32x16& p1, float& m_reg, float& mn, float& alpha) {
    float pmax = p0[0]; for (int r = 1; r < 16; ++r) pmax = fmaxf(pmax, p0[r]); for (int r = 0; r < 16; ++r) pmax = fmaxf(pmax, p1[r]);
    { auto rr = __builtin_amdgcn_permlane32_swap(__float_as_uint(pmax), __float_as_uint(pmax), false, false);
      pmax = fmaxf(__uint_as_float(rr[0]), __uint_as_float(rr[1])); }
    constexpr float C2 = 1.4426950408889634f * SCALE;
    if (__builtin_expect(__all((pmax - m_reg) * SCALE <= THR), 1)) { mn = m_reg; alpha = 1.f; }
    else { mn = fmaxf(m_reg, pmax); alpha = __builtin_amdgcn_exp2f((m_reg - mn) * C2); m_reg = mn; }
    const float mnL = -mn * C2;
    for (int r = 0; r < 16; ++r) p0[r] = fmaf(p0[r], C2, mnL); for (int r = 0; r < 16; ++r) p1[r] = fmaf(p1[r], C2, mnL);
    for (int r = 0; r < 16; ++r) p0[r] = __builtin_amdgcn_exp2f(p0[r]);
}
__device__ __forceinline__ void finishSM(f32x16& p0, f32x16& p1, float alpha, float& l_reg, bf16x8& pa0, bf16x8& pa1, bf16x8& pa2, bf16x8& pa3) {
    for (int r = 0; r < 16; ++r) p1[r] = __builtin_amdgcn_exp2f(p1[r]);
    float ps = 0; for (int r = 0; r < 16; ++r) ps += p0[r]; for (int r = 0; r < 16; ++r) ps += p1[r];
    { auto rr = __builtin_amdgcn_permlane32_swap(__float_as_uint(ps), __float_as_uint(ps), false, false);
      ps = __uint_as_float(rr[0]) + __uint_as_float(rr[1]); }
    l_reg = l_reg * alpha + ps;
#define PK4(P, B_, OUT) do { unsigned a0 = cvtpk(P[B_+0], P[B_+1]), a1 = cvtpk(P[B_+2], P[B_+3]);                          \
        unsigned b0 = cvtpk(P[B_+4], P[B_+5]), b1 = cvtpk(P[B_+6], P[B_+7]);                                             \
        auto r0 = __builtin_amdgcn_permlane32_swap(a0, b0, false, false); auto r1 = __builtin_amdgcn_permlane32_swap(a1, b1, false, false); \
        u32x4 w = {r0[0], r1[0], r0[1], r1[1]}; OUT = *reinterpret_cast<bf16x8*>(&w); } while (0)
    PK4(p0, 0, pa0); PK4(p0, 8, pa1); PK4(p1, 0, pa2); PK4(p1, 8, pa3);
#undef PK4
}
template <int KB, bool SK>
__device__ __forceinline__ void qkt(f32x16& p0, f32x16& p1, const char* K_lds, int r32, int hi, const bf16x8* qr, bool act) {
    if (SK && !act) { const float NEG = -__builtin_inff();
#pragma unroll
        for (int r = 0; r < 16; ++r) { p0[r] = NEG; p1[r] = NEG; } return; }
    p0 = f32x16{}; p1 = f32x16{};
    const char* kb[4];
#pragma unroll
    for (int dd = 0; dd < 4; ++dd) kb[dd] = K_lds + KB * SHM_K + KSWZ(r32, (dd * 16 + hi * 8) * 2);
#pragma unroll
    for (int d0 = 0; d0 < 8; ++d0) { const char* a = kb[d0 & 3] + (d0 >> 2) * 128;
        bf16x8 b0 = *reinterpret_cast<const bf16x8*>(a);
        bf16x8 b1 = *reinterpret_cast<const bf16x8*>(a + 32 * 256);
        p0 = __builtin_amdgcn_mfma_f32_32x32x16_bf16(b0, qr[d0], p0, 0, 0, 0);
        p1 = __builtin_amdgcn_mfma_f32_32x32x16_bf16(b1, qr[d0], p1, 0, 0, 0); }
}
template <int VB, bool SK>
__device__ __forceinline__ void pv_tile(f32x16* o, int vb0, bf16x8 pa0, bf16x8 pa1, bf16x8 pa2, bf16x8 pa3, bool act) {
    if (SK && !act) return;
#define TRRD(dst, off) asm volatile("ds_read_b64_tr_b16 %0, %1 offset:%2" : "=&v"(dst) : "v"(vb0), "i"(off) : "memory")
#define PV_D0(d0) do { s16x4 l0, l1, l2, l3, h0, h1, h2, h3; constexpr int b_ = VB * SHM_V + v_rd_off(d0, 0, 0);     \
        TRRD(l0, b_); TRRD(h0, b_ + 2048); TRRD(l1, b_ + 4096); TRRD(h1, b_ + 6144); TRRD(l2, b_ + 8192); TRRD(h2, b_ + 10240); TRRD(l3, b_ + 12288); TRRD(h3, b_ + 14336); \
        asm volatile("s_waitcnt lgkmcnt(0)" ::: "memory"); SBAR();                 \
        o[d0] = __builtin_amdgcn_mfma_f32_32x32x16_bf16(pa0, (bf16x8){l0[0], l0[1], l0[2], l0[3], h0[0], h0[1], h0[2], h0[3]}, o[d0], 0, 0, 0);   \
        o[d0] = __builtin_amdgcn_mfma_f32_32x32x16_bf16(pa1, (bf16x8){l1[0], l1[1], l1[2], l1[3], h1[0], h1[1], h1[2], h1[3]}, o[d0], 0, 0, 0);   \
        o[d0] = __builtin_amdgcn_mfma_f32_32x32x16_bf16(pa2, (bf16x8){l2[0], l2[1], l2[2], l2[3], h2[0], h2[1], h2[2], h2[3]}, o[d0], 0, 0, 0);   \
        o[d0] = __builtin_amdgcn_mfma_f32_32x32x16_bf16(pa3, (bf16x8){l3[0], l3[1], l3[2], l3[3], h3[0], h3[1], h3[2], h3[3]}, o[d0], 0, 0, 0); } while (0)
    PV_D0(0); PV_D0(1); PV_D0(2); PV_D0(3);
#undef PV_D0
#undef TRRD
}

template <class TIn, class TOut> struct BlockRef { const TIn* Q; const TIn* K; const TIn* V; TOut* O; int P0; };
template <class TIn> struct Seam {
    bf16x8 qr[8];
    bf16x8 st_v0, st_v1, st_k0, st_k1; f32x4 sf0, sf1, sf2, sf3;
    f32x4 tq[16];
};
__device__ __forceinline__ int swa_jlo(int P0, int W) { const int lowk = P0 - W + 1; return lowk > 0 ? lowk / KVBLK : 0; }
#define ROW(p, k0, rr) ((p) + (size_t)((k0) + (rr)) * D + sc)
#define ROWV(p, k0, rr) ((p) + (size_t)((k0) + (rr)) * VSTR + sc)
#define VMW() asm volatile("s_waitcnt vmcnt(0)" ::: "memory")
#define VMWN(n) asm volatile("s_waitcnt vmcnt(%0)" :: "i"(n) : "memory")
#define SLOAD_H(Kp, Vp, k0) do { S.st_v0 = load8<TIn>(ROWV(Vp, k0, sr)); S.st_v1 = load8<TIn>(ROWV(Vp, k0, 32 + sr));              \
                         S.st_k0 = load8<TIn>(ROW(Kp, k0, sr)); S.st_k1 = load8<TIn>(ROW(Kp, k0, 32 + sr)); } while (0)
#define SWRITE_HK(bf) do { *(bf16x8*)(K_lds + (bf) * SHM_K + kws) = S.st_k0; *(bf16x8*)(K_lds + (bf) * SHM_K + kws + 32 * 256) = S.st_k1; } while (0)
#define SWRITE_HV(bf) do { *(bf16x8*)(V_lds + (bf) * SHM_V + vst0) = S.st_v0; *(bf16x8*)(V_lds + (bf) * SHM_V + vst1) = S.st_v1; } while (0)
#define SWRITE_H(bf) do { SWRITE_HV(bf); SWRITE_HK(bf); } while (0)
#define SLOAD_F(p, k0) do { S.sf0 = *(const f32x4*)ROW(p, k0, sr); S.sf1 = *(const f32x4*)(ROW(p, k0, sr) + 4);                \
                            S.sf2 = *(const f32x4*)ROW(p, k0, 32 + sr); S.sf3 = *(const f32x4*)(ROW(p, k0, 32 + sr) + 4); } while (0)
#define SWRITE_KF(bf) do { *(bf16x8*)(K_lds + (bf) * SHM_K + kws) = pack8(S.sf0, S.sf1); *(bf16x8*)(K_lds + (bf) * SHM_K + kws + 32 * 256) = pack8(S.sf2, S.sf3); } while (0)
#define SWRITE_VF(bf) do { *(bf16x8*)(V_lds + (bf) * SHM_V + vst0) = pack8(S.sf0, S.sf1); *(bf16x8*)(V_lds + (bf) * SHM_V + vst1) = pack8(S.sf2, S.sf3); } while (0)
template <class TIn, class TOut>
__device__ __forceinline__ void causal_swa_prime(const BlockRef<TIn, TOut>& cur, int W, char* lds, Seam<TIn>& S) {
    constexpr bool F32 = same_t<TIn, float>::v;
    const int tid = threadIdx.x, wid = __builtin_amdgcn_readfirstlane(tid >> 6), lane = tid & 63, r32 = lane & 31, hi = lane >> 5;
    const int sr = tid >> 4, sc = (tid & 15) * 8, kws = KSWZ(sr, sc * 2); char* K_lds = lds + 2 * SHM_V;
    const int kb0 = swa_jlo(cur.P0, W) * KVBLK;
    for (int d0 = 0; d0 < 8; ++d0) S.qr[d0] = load8<TIn>(cur.Q + (size_t)(wid * QBLK + r32) * D + d0 * 16 + hi * 8);
    if constexpr (F32) { SLOAD_F((const float*)cur.K, kb0); VMW(); SWRITE_KF(0); SBAR(); SLOAD_F((const float*)cur.V, kb0); }
    else { SLOAD_H(cur.K, cur.V, kb0); VMW(); SWRITE_HK(0); }
    __syncthreads();
}
template <class TIn, class TOut>
__device__ __forceinline__ void causal_swa_block(const BlockRef<TIn, TOut>& cur, const BlockRef<TIn, TOut>& nxt, int skv, int W, char* lds, Seam<TIn>& S) {
    constexpr bool F32 = same_t<TIn, float>::v;
    const int tid = threadIdx.x, wid = __builtin_amdgcn_readfirstlane(tid >> 6), lane = tid & 63, r32 = lane & 31, hi = lane >> 5;
    const int j_lo = swa_jlo(cur.P0, W);
    int j_hi = (cur.P0 + QB - 1) / KVBLK + 1; if (j_hi > skv / KVBLK) j_hi = skv / KVBLK;
    const int NT = j_hi - j_lo;
    const int kbn = swa_jlo(nxt.P0, W) * KVBLK;
    const int qlo = cur.P0 + wid * QBLK, qm = qlo + r32 - 4 * hi;
    char* V_lds = lds; char* K_lds = lds + 2 * SHM_V;
    float* ws = (float*)(lds + 2 * SHM_V + 2 * SHM_K) + wid * 64; float* li_l = ws, * al_l = ws + 32;
    float m_reg = -1e30f, l_reg = 0; f32x16 o[4] = {};
    const int sr = tid >> 4, sc = (tid & 15) * 8, vst0 = v_st(sr, sc), vst1 = v_st(32 + sr, sc), kws = KSWZ(sr, sc * 2);
    const int vb0 = (int)(uintptr_t)V_lds + v_rd_base(lane);
    const TIn* Kh = cur.K; const TIn* Vh = cur.V;
#define RESC(a) do { if (__any((a) < 1.f)) { if (hi == 0) al_l[r32] = (a); asm volatile("s_waitcnt lgkmcnt(0)" ::: "memory");              \
                     for (int d_ = 0; d_ < 4; ++d_) for (int r = 0; r < 16; ++r) o[d_][r] *= al_l[crow(r, hi)]; } } while (0)
#define KBASE(t) ((j_lo + (t)) * KVBLK)
#define ACT(t) (KBASE(t) <= qlo + QBLK - 1 && KBASE(t) + KVBLK - 1 >= qlo - W + 1)
#define MASKT(P0_, P1_, t) do { const int kb_ = KBASE(t); if ((!SK || ACT(t)) && (kb_ + KVBLK - 1 > qlo || kb_ <= qlo + QBLK - 1 - W)) mask_tile(P0_, P1_, qm - kb_, (unsigned)W); } while (0)
    constexpr int NQL = F32 ? 16 : 8;
    constexpr bool SK = WSKIP && !F32;
#define SEAM_K0() do { VMWN(NQL); if constexpr (F32) { SWRITE_KF(0); SBAR(); SLOAD_F((const float*)nxt.V, kbn); } else { SWRITE_HK(0); } SBAR(); } while (0)
    f32x16 pA0, pA1, pB0, pB1; float mnA, mnB, alA, alB; bf16x8 pa0, pa1, pa2, pa3;
    if constexpr (F32) { VMW(); SWRITE_VF(0); SBAR(); } else { SWRITE_HV(0); SBAR(); }
    if (NT > 1) { if constexpr (F32) SLOAD_F((const float*)Kh, KBASE(1)); else SLOAD_H(Kh, Vh, KBASE(1)); }
    SBAR(); qkt<0, SK>(pA0, pA1, K_lds, r32, hi, S.qr, ACT(0));
    if constexpr (F32) { if (NT > 1) { VMW(); SWRITE_KF(1); SBAR(); SLOAD_F((const float*)Vh, KBASE(1)); } }
    MASKT(pA0, pA1, 0); partialSM(pA0, pA1, m_reg, mnA, alA);
    if (NT > 1) { VMW(); if constexpr (F32) { SWRITE_VF(1); SBAR(); if (NT > 2) SLOAD_F((const float*)Kh, KBASE(2)); } else SWRITE_H(1); }
    __syncthreads();
#define HALF_STEP(PX0, PX1, mnX, alX, PY0, PY1, alY, t, KB, VB, SB) do {                                                      \
        SBAR(); qkt<KB, SK>(PX0, PX1, K_lds, r32, hi, S.qr, ACT(t));                                             \
        finishSM(PY0, PY1, alY, l_reg, pa0, pa1, pa2, pa3); SBAR();                                                           \
        if ((t) + 1 < NT) { if constexpr (F32) { VMW(); SWRITE_KF(SB); SBAR(); SLOAD_F((const float*)Vh, KBASE((t) + 1)); }  \
                            else { SLOAD_H(Kh, Vh, KBASE((t) + 1)); } SBAR(); }                                               \
        pv_tile<VB, SK>(o, vb0, pa0, pa1, pa2, pa3, ACT((t) - 1)); MASKT(PX0, PX1, (t)); partialSM(PX0, PX1, m_reg, mnX, alX);                                        \
        __syncthreads();                                                                                                      \
        if ((t) + 1 < NT) { VMW(); if constexpr (F32) { SWRITE_VF(SB); SBAR(); if ((t) + 2 < NT) SLOAD_F((const float*)Kh, KBASE((t) + 2)); } \
                            else { SWRITE_H(SB); } }                                                                          \
        RESC(alX); __syncthreads(); } while (0)
    for (int t = 1; t + 1 < NT; t += 2) {
        HALF_STEP(pB0, pB1, mnB, alB, pA0, pA1, alA, t, 1, 0, 0);
        HALF_STEP(pA0, pA1, mnA, alA, pB0, pB1, alB, t + 1, 0, 1, 1);
    }
    const bool even = (NT & 1) == 0;
    if (even) { SBAR(); qkt<1, SK>(pB0, pB1, K_lds, r32, hi, S.qr, ACT(NT - 1)); SBAR(); }
#define QROW(e) (nxt.Q + (size_t)(wid * QBLK + r32) * D + ((e) >> 1) * 16 + hi * 8 + ((e) & 1) * 4)
    if constexpr (F32) { SLOAD_F((const float*)nxt.K, kbn); SBAR();
#pragma unroll
        for (int e = 0; e < 8; ++e) S.tq[e] = *(const f32x4*)QROW(e); }
    else { SLOAD_H(nxt.K, nxt.V, kbn); SBAR();
#pragma unroll
        for (int d0 = 0; d0 < 8; ++d0) S.qr[d0] = load8<TIn>(nxt.Q + (size_t)(wid * QBLK + r32) * D + d0 * 16 + hi * 8); }
    SBAR();
    finishSM(pA0, pA1, alA, l_reg, pa0, pa1, pa2, pa3); SBAR();
    if constexpr (F32) {
#pragma unroll
        for (int e = 8; e < 16; ++e) S.tq[e] = *(const f32x4*)QROW(e); SBAR(); }
#undef QROW
    pv_tile<0, SK>(o, vb0, pa0, pa1, pa2, pa3, ACT(even ? NT - 2 : NT - 1));
    if (even) { MASKT(pB0, pB1, NT - 1); partialSM(pB0, pB1, m_reg, mnB, alB); __syncthreads(); RESC(alB);
        finishSM(pB0, pB1, alB, l_reg, pa0, pa1, pa2, pa3); SBAR(); pv_tile<1, SK>(o, vb0, pa0, pa1, pa2, pa3, ACT(NT - 1)); }
    SBAR(); SEAM_K0();
    if (hi == 0) li_l[r32] = l_reg; asm volatile("s_waitcnt lgkmcnt(0)" ::: "memory");
    float rli[16];
#pragma unroll
    for (int r = 0; r < 16; ++r) rli[r] = __builtin_amdgcn_rcpf(li_l[crow(r, hi)]);
    TOut* Ow = cur.O + (size_t)(wid * QBLK) * D;
#pragma unroll
    for (int r = 0; r < 16; ++r) { const int orow = crow(r, hi);
#pragma unroll
        for (int d0 = 0; d0 < 4; ++d0) { const float v = o[d0][r] * rli[r];
            if constexpr (same_t<TOut, float>::v) { Ow[(size_t)orow * D + d0 * 32 + r32] = v; }
            else { const float vn = __shfl_xor(v, 1);
                   if ((r32 & 1) == 0) *(unsigned*)(Ow + (size_t)orow * D + d0 * 32 + r32) = cvtpk(v, vn); } } }
    if constexpr (F32) {
#pragma unroll
        for (int d0 = 0; d0 < 8; ++d0) S.qr[d0] = pack8(S.tq[2 * d0], S.tq[2 * d0 + 1]); }
    __syncthreads();
#undef RESC
#undef KBASE
#undef ACT
#undef MASKT
#undef SEAM_K0
#undef HALF_STEP
}
#undef ROW
#undef ROWV
#undef VMW
#undef VMWN
#undef SLOAD_H
#undef SWRITE_HK
#undef SWRITE_HV
#undef SWRITE_H
#undef SLOAD_F
#undef SWRITE_KF
#undef SWRITE_VF
}
struct Ctx { LAS unsigned char* lds; int tid, lane, wave, vcu, G; };

__device__ __forceinline__ void tr_item(const float* __restrict__ src, size_t ldn, const float* __restrict__ gain, bfr* __restrict__ dst, int K,
                                        int k0, int nsrc0, int drow0, LAS float* scr, int lane) {
    const int r4 = lane >> 4, c4 = (lane & 15) * 4;
    f4v v[16];
#pragma unroll
    for (int i = 0; i < 16; ++i) v[i] = *(const f4v*)(src + (size_t)(k0 + 4 * i + r4) * ldn + nsrc0 + c4);
#pragma unroll
    for (int i = 0; i < 16; ++i) { const int k = 4 * i + r4; const float gk = gain ? gain[k0 + k] : 1.f;
        LAS float* s = scr + k * 65 + c4; s[0] = v[i][0] * gk; s[1] = v[i][1] * gk; s[2] = v[i][2] * gk; s[3] = v[i][3] * gk; }
    LDS_WAIT(); asm volatile("" ::: "memory");
    const int c = lane & 7;
#pragma unroll
    for (int jj = 0; jj < 8; ++jj) { const int n = (lane >> 3) + 8 * jj; const LAS float* s = scr + (8 * c) * 65 + n;
        u4v o; o.x = cvtpk(s[0 * 65], s[1 * 65]); o.y = cvtpk(s[2 * 65], s[3 * 65]); o.z = cvtpk(s[4 * 65], s[5 * 65]); o.w = cvtpk(s[6 * 65], s[7 * 65]);
        *(u4v*)(dst + (size_t)(drow0 + n) * K + k0 + 8 * c) = o; }
    LDS_WAIT(); asm volatile("" ::: "memory");
}
__device__ __forceinline__ void tr_item8(const float* __restrict__ src, size_t ldn, float sc, const float* __restrict__ gain, unsigned char* __restrict__ dst, int K, int k0, int nsrc0, int drow0, LAS float* scr, int lane) {
    const int r4 = lane >> 4, c4 = (lane & 15) * 4;
    f4v v[16];
#pragma unroll
    for (int i = 0; i < 16; ++i) v[i] = *(const f4v*)(src + (size_t)(k0 + 4 * i + r4) * ldn + nsrc0 + c4);
#pragma unroll
    for (int i = 0; i < 16; ++i) { const int k = 4 * i + r4; const float gk = gain ? gain[k0 + k] * sc : sc; LAS float* s = scr + k * 65 + c4; s[0] = v[i][0] * gk; s[1] = v[i][1] * gk; s[2] = v[i][2] * gk; s[3] = v[i][3] * gk; }
    LDS_WAIT(); asm volatile("" ::: "memory");
    const int c = lane & 3;
#pragma unroll
    for (int jj = 0; jj < 4; ++jj) { const int n = (lane >> 2) + 16 * jj; const LAS float* s = scr + (16 * c) * 65 + n;
        u4v o; o.x = cvt4_fp8(s[0 * 65], s[1 * 65], s[2 * 65], s[3 * 65]); o.y = cvt4_fp8(s[4 * 65], s[5 * 65], s[6 * 65], s[7 * 65]);
        o.z = cvt4_fp8(s[8 * 65], s[9 * 65], s[10 * 65], s[11 * 65]); o.w = cvt4_fp8(s[12 * 65], s[13 * 65], s[14 * 65], s[15 * 65]);
        *(u4v*)(dst + (size_t)(drow0 + n) * K + k0 + 16 * c) = o; }
    LDS_WAIT(); asm volatile("" ::: "memory");
}
__device__ __forceinline__ void tr_job8(const float* __restrict__ src, size_t ldn, float sc, const float* __restrict__ gain, unsigned char* __restrict__ dst, int K, int ncols, LAS float* scr, int lane, int gw, int NGW, int nsrc0 = 0) {
    const int nn = ncols / 64, ni = (K / 64) * nn;
    for (int it = gw; it < ni; it += NGW) { const int kb = it / nn, nb = it - kb * nn; tr_item8(src, ldn, sc, gain, dst, K, kb * 64, nsrc0 + nb * 64, nb * 64, scr, lane); }
}
__device__ __forceinline__ void tr_job(const float* __restrict__ src, size_t ldn, const float* __restrict__ gain, bfr* __restrict__ dst, int K, int ncols, int nsrc0, int drow0,
                                       LAS float* scr, int lane, int gw, int NGW) {
    const int nn = ncols / 64, ni = (K / 64) * nn;
    for (int it = gw; it < ni; it += NGW) { const int kb = it / nn, nb = it - kb * nn;
        tr_item(src, ldn, gain, dst, K, kb * 64, nsrc0 + nb * 64, drow0 + nb * 64, scr, lane); }
}
struct KArgs {
    const float* in[26]; float* out; unsigned char* ws; int ph_lo, ph_hi, li, pad;
};
struct Ptrs {
    LAS unsigned long long* tbl;
    __device__ __forceinline__ unsigned long long get(int k) const { const unsigned long long v = tbl[k];
        return ((unsigned long long)(unsigned)__builtin_amdgcn_readfirstlane((int)(unsigned)(v >> 32)) << 32) | (unsigned)__builtin_amdgcn_readfirstlane((int)(unsigned)v); }
    __device__ __forceinline__ const float* in_(int k) const { return (const float*)get(k); }
    __device__ __forceinline__ float* out_() const { return (float*)get(26); }
    __device__ __forceinline__ unsigned char* ws_() const { return (unsigned char*)get(27); }
};
__device__ __forceinline__ void p_convert(const Ctx& C, const Ptrs& P) {
    LAS float* scr = (LAS float*)(C.lds + C.wave * 16640);
    const int gw = C.vcu * 8 + C.wave, NGW = C.G * 8;
    unsigned char* ws = P.ws_();
#if F8_PROJ0 == 1
    tr_job8(P.in_(2), (size_t)GIN, SU, P.in_(1), ws + WS_WTIN, DM, 16384, scr, C.lane, gw, NGW);
#elif F8_PROJ0 == 2
    tr_job(P.in_(2), (size_t)GIN, P.in_(1), (bfr*)(ws + WS_WTIN), DM, 8192, 0, 0, scr, C.lane, gw, NGW);
    tr_job8(P.in_(2), (size_t)GIN, SU, P.in_(1), ws + WS_WTIN + (size_t)8192 * DM * 2, DM, 8192, scr, C.lane, gw, NGW, 8192);
#elif F8_PROJ0 == 5
    tr_job8(P.in_(2), (size_t)GIN, SU, P.in_(1), ws + WS_WTIN, DM, 8192, scr, C.lane, gw, NGW, 0);
    tr_job(P.in_(2), (size_t)GIN, P.in_(1), (bfr*)(ws + WS_WTIN + (size_t)32 * MiB), DM, 4096, 8192, 0, scr, C.lane, gw, NGW);
    tr_job8(P.in_(2), (size_t)GIN, SU, P.in_(1), ws + WS_WTIN + (size_t)64 * MiB, DM, 4096, scr, C.lane, gw, NGW, 12288);
#elif F8_PROJ0 == 6
    tr_job8(P.in_(2), (size_t)GIN, SU, P.in_(1), ws + WS_WTIN, DM, 12288, scr, C.lane, gw, NGW, 0);
    tr_job(P.in_(2), (size_t)GIN, P.in_(1), (bfr*)(ws + WS_WTIN + (size_t)48 * MiB), DM, 4096, 12288, 0, scr, C.lane, gw, NGW);
#elif F8_PROJ0 == 3
    tr_job8(P.in_(2), (size_t)GIN, SU, P.in_(1), ws + WS_WTIN, DM, 8192, scr, C.lane, gw, NGW, 0);
    tr_job(P.in_(2), (size_t)GIN, P.in_(1), (bfr*)(ws + WS_WTIN + (size_t)8192 * DM), DM, 8192, 8192, 0, scr, C.lane, gw, NGW);
#else
    tr_job(P.in_(2), (size_t)GIN, P.in_(1), (bfr*)(ws + WS_WTIN), DM, 16384, 0, 0, scr, C.lane, gw, NGW);
#endif
    tr_job(P.in_(2), (size_t)GIN, P.in_(1), (bfr*)(ws + WS_WTBD), DM, 64, 16384, 0, scr, C.lane, gw, NGW);
#if F8_OUT0
    tr_job8(P.in_(7), (size_t)DM, SU, nullptr, ws + WS_WTOUT, DM, DM, scr, C.lane, gw, NGW, 0);
#else
    tr_job(P.in_(7), (size_t)DM, nullptr, (bfr*)(ws + WS_WTOUT), DM, DM, 0, 0, scr, C.lane, gw, NGW);
#endif
#if F8_KVQ
    tr_job8(P.in_(9), (size_t)8192, SU, P.in_(8), ws + WS_WTKVQ, DM, DM, scr, C.lane, gw, NGW, 0);
    tr_job8(P.in_(12), (size_t)DM, SU, P.in_(11), ws + WS_WTKVQ + (size_t)DM * DM, DM, DM, scr, C.lane, gw, NGW, 0);
#if F8_KVQ == 2
    tr_job8(P.in_(9), (size_t)8192, SU, P.in_(8), ws + WS_WTKVQ + (size_t)2 * DM * DM, DM, DM, scr, C.lane, gw, NGW, DM);
#else
    tr_job(P.in_(9), (size_t)8192, P.in_(8), (bfr*)(ws + WS_WTKVQ + (size_t)2 * DM * DM), DM, DM, DM, 0, scr, C.lane, gw, NGW);
#endif
#else
    tr_job(P.in_(9), (size_t)8192, P.in_(8), (bfr*)(ws + WS_WTKVQ), DM, 8192, 0, 0, scr, C.lane, gw, NGW);
    tr_job(P.in_(12), (size_t)DM, P.in_(11), (bfr*)(ws + WS_WTKVQ), DM, DM, 0, 8192, scr, C.lane, gw, NGW);
#endif
#if F8_OUT1
    tr_job8(P.in_(19), (size_t)DM, SU, nullptr, ws + WS_WTO, DM, DM, scr, C.lane, gw, NGW, 0);
#else
    tr_job(P.in_(19), (size_t)DM, nullptr, (bfr*)(ws + WS_WTO), DM, DM, 0, 0, scr, C.lane, gw, NGW);
#endif
    tr_job(P.in_(21), (size_t)PQ, P.in_(20), (bfr*)(ws + WS_WTQRY), DM, PQ, 0, 0, scr, C.lane, gw, NGW);
    tr_job(P.in_(21) + (size_t)DM * PQ, (size_t)PQ, P.in_(20) + DM, (bfr*)(ws + WS_WTQRY) + (size_t)PQ * DM, DM, PQ, 0, 0, scr, C.lane, gw, NGW);
    tr_job8(P.in_(25), (size_t)DM, SV, nullptr, ws + WS_VT, PE, DM, scr, C.lane, gw, NGW);
    tr_job8(P.in_(25) + (size_t)PE * DM, (size_t)DM, SV, nullptr, ws + WS_VT + (size_t)DM * PE, PE, DM, scr, C.lane, gw, NGW);
    {
        const size_t gt = (size_t)C.vcu * 512 + C.tid, GT = (size_t)C.G * 512;
        for (int l = 0; l < 2; ++l) {
            const float* src = P.in_(24) + (size_t)l * PE * DM; const float* gain = P.in_(20) + l * DM; unsigned char* dst = ws + WS_U + (size_t)l * PE * DM;
            for (size_t i = gt; i < (size_t)PE * DM / 16; i += GT) {
                const f4v a = *(const f4v*)(src + i * 16), b = *(const f4v*)(src + i * 16 + 4), c = *(const f4v*)(src + i * 16 + 8), d = *(const f4v*)(src + i * 16 + 12);
                const int dd = (int)((i * 16) & (DM - 1)); const f4v ga = *(const f4v*)(gain + dd) * SU, gb = *(const f4v*)(gain + dd + 4) * SU, gc = *(const f4v*)(gain + dd + 8) * SU, gd = *(const f4v*)(gain + dd + 12) * SU;
                u4v o; o.x = cvt4_fp8(a[0] * ga[0], a[1] * ga[1], a[2] * ga[2], a[3] * ga[3]); o.y = cvt4_fp8(b[0] * gb[0], b[1] * gb[1], b[2] * gb[2], b[3] * gb[3]);
                o.z = cvt4_fp8(c[0] * gc[0], c[1] * gc[1], c[2] * gc[2], c[3] * gc[3]); o.w = cvt4_fp8(d[0] * gd[0], d[1] * gd[1], d[2] * gd[2], d[3] * gd[3]);
                *(u4v*)(dst + i * 16) = o; }
        }
        for (int l = 0; l < 2; ++l) {
            bfr* dst = (bfr*)(ws + WS_WTKEY) + (size_t)l * PQ * PQ;
            for (size_t i = gt; i < (size_t)PQ * PQ / 8; i += GT) {
                const int row = (int)((i * 8) / PQ), col = (int)((i * 8) % PQ); u4v o = {0u, 0u, 0u, 0u};
                if ((row >> 7) == (col >> 7)) { const int blk = row >> 7, h = blk >> 1, half = blk & 1, n = row & 127, d = col & 127;
                    const float* src = (half ? P.in_(23) : P.in_(22)) + (((size_t)l * PH + h) * PK + n) * 128 + d;
                    const f4v a = *(const f4v*)src, b = *(const f4v*)(src + 4);
                    o.x = cvtpk(a[0], a[1]); o.y = cvtpk(a[2], a[3]); o.z = cvtpk(b[0], b[1]); o.w = cvtpk(b[2], b[3]); }
                *(u4v*)(dst + i * 8) = o; }
        }
    }
}

__device__ __forceinline__ void p_norm_rows(const Ctx& C, const float* __restrict__ src, bfr* __restrict__ dst, unsigned char* __restrict__ dst8) {
    const int gw = C.vcu * 8 + C.wave, NGW = C.G * 8;
    for (int row = gw; row < NT; row += NGW) {
        const f4v* p = (const f4v*)(src + (size_t)row * DM);
        f4v a[8], b[8]; float ss = 0.f;
#pragma unroll
        for (int j = 0; j < 8; ++j) { a[j] = p[j * 128 + 2 * C.lane]; b[j] = p[j * 128 + 2 * C.lane + 1]; }
#pragma unroll
        for (int j = 0; j < 8; ++j) ss += (a[j][0] * a[j][0] + a[j][1] * a[j][1]) + (a[j][2] * a[j][2] + a[j][3] * a[j][3]) + (b[j][0] * b[j][0] + b[j][1] * b[j][1]) + (b[j][2] * b[j][2] + b[j][3] * b[j][3]);
        const float r = __builtin_amdgcn_rsqf(wave_sum(ss) * (1.f / DM) + EPS);
        u4v* o = (u4v*)(dst + (size_t)row * DM);
#pragma unroll
        for (int j = 0; j < 8; ++j) { u4v w; w.x = cvtpk(a[j][0] * r, a[j][1] * r); w.y = cvtpk(a[j][2] * r, a[j][3] * r); w.z = cvtpk(b[j][0] * r, b[j][1] * r); w.w = cvtpk(b[j][2] * r, b[j][3] * r);
            if (dst) o[j * 64 + C.lane] = w;
            if (dst8) { u2v w8; w8.x = cvt4_fp8(a[j][0] * r, a[j][1] * r, a[j][2] * r, a[j][3] * r); w8.y = cvt4_fp8(b[j][0] * r, b[j][1] * r, b[j][2] * r, b[j][3] * r); ((u2v*)(dst8 + (size_t)row * DM))[j * 64 + C.lane] = w8; } }
    }
}

__device__ __forceinline__ void p_bd(const Ctx& C, const bfr* __restrict__ XN, const bfr* __restrict__ WB, float* __restrict__ BD) {
    LAS float* red = (LAS float*)C.lds;
    const int r = C.lane & 15, q = C.lane >> 4, rt = C.wave >> 2, kq = C.wave & 3;
    for (int blk = C.vcu; blk < NT / 32; blk += C.G) {
        const bfr* ap = XN + (size_t)(blk * 32 + rt * 16 + r) * DM + kq * 1024 + q * 8;
        const bfr* bp = WB + (size_t)r * DM + kq * 1024 + q * 8;
        f4v acc[4] = {zero_acc(), zero_acc(), zero_acc(), zero_acc()};
#pragma unroll 4
        for (int ks = 0; ks < 32; ++ks) {
            const s8v a = *(const s8v*)(ap + ks * 32);
#pragma unroll
            for (int nt = 0; nt < 4; ++nt) { const s8v b = *(const s8v*)(bp + (size_t)nt * 16 * DM + ks * 32); acc[nt] = __builtin_amdgcn_mfma_f32_16x16x32_bf16(a, b, acc[nt], 0, 0, 0); }
            MFMA_SETTLE(acc[0]); MFMA_SETTLE(acc[1]); MFMA_SETTLE(acc[2]); MFMA_SETTLE(acc[3]);
        }
        MFMA_SETTLE(acc[0]); MFMA_SETTLE(acc[1]); MFMA_SETTLE(acc[2]); MFMA_SETTLE(acc[3]);
#pragma unroll
        for (int nt = 0; nt < 4; ++nt)
#pragma unroll
            for (int i = 0; i < 4; ++i) red[C.wave * 1024 + (4 * q + i) * 64 + nt * 16 + r] = -acc[nt][i];
        __syncthreads();
#pragma unroll
        for (int i = 0; i < 4; ++i) { const int idx = C.tid * 4 + i, t2 = idx >> 10, rem = idx & 1023;
            const float s = -((red[(t2 * 4 + 0) * 1024 + rem] + red[(t2 * 4 + 1) * 1024 + rem]) + (red[(t2 * 4 + 2) * 1024 + rem] + red[(t2 * 4 + 3) * 1024 + rem]));
            BD[(size_t)(blk * 32 + t2 * 16 + (rem >> 6)) * 64 + (rem & 63)] = s; }
        __syncthreads();
    }
}
__device__ __forceinline__ int kq_off(int row, int chunk) { return row * 256 + ((chunk ^ (row & 7)) << 4); }
__device__ __forceinline__ int xt_off(int col, int chunk) { return col * 128 + ((chunk ^ (col & 7)) << 4); }
__device__ __forceinline__ void p_gdn_prep(const Ctx& C, const Ptrs& P) {
    unsigned char* ws = P.ws_();
    const bfr* PROJ = (const bfr*)(ws + WS_BIG); const float* BD = (const float*)(ws + WS_BD);
    const float* convw = P.in_(3); const float* alog = P.in_(4); const float* dtb = P.in_(5);
    bfr* Wg = (bfr*)(ws + WS_R + R_W); bfr* Ug = (bfr*)(ws + WS_R + R_U); bfr* QGg = (bfr*)(ws + WS_R + R_QG); bfr* KDg = (bfr*)(ws + WS_R + R_KD); bfr* QKg = (bfr*)(ws + WS_R + R_QK);
    float* EGg = (float*)(ws + WS_EG);
    LAS float* sCW = (LAS float*)(C.lds + 82944);
    for (int wq = C.vcu; wq < NB * GH * 4; wq += C.G) {
        const int bh = wq >> 2, cg = wq & 3, h = bh & 31, b = bh >> 5;
        for (int i = C.tid; i < 1536; i += 512) { const int part = i >> 9, tap = (i >> 7) & 3, ch = i & 127; sCW[i] = convw[tap * 12288 + part * 4096 + h * 128 + ch]; }
        __syncthreads();
        for (int it = 0; it < 8; ++it) {
            int tid = C.tid; asm volatile("" : "+v"(tid));
            const int hw = tid >> 8, lt = tid & 255, lane = tid & 63, lw = (tid >> 6) & 3;
            const int c = cg * 16 + it * 2 + hw, unit = bh * 64 + c, t0 = b * SEQ + c * CH;
            LAS unsigned char* hb = C.lds + hw * 41472;
            LAS unsigned char* sK = hb; LAS unsigned char* sQ = hb + 16384; LAS unsigned char* sX = hb;
            LAS unsigned char* sAM = hb + 32768; LAS float* sB = (LAS float*)(hb + 40960); LAS float* sG = (LAS float*)(hb + 41216);
            LAS float* scr = (LAS float*)(C.lds + 89088 + (tid >> 6) * 4352);
            LAS float* sAD = (LAS float*)(C.lds + 123904 + hw * 4096);
            if (lt < 64) {
                const int t = t0 + lt; const float braw = BD[(size_t)t * 64 + h], araw = BD[(size_t)t * 64 + 32 + h];
                const float beta = 1.f / (1.f + expf(-braw)); const float xx = araw + dtb[h]; const float sp = fmaxf(xx, 0.f) + log1pf(expf(-fabsf(xx)));
                float g = -expf(alog[h]) * sp;
#pragma unroll
                for (int o = 1; o < 64; o <<= 1) { const float y = __shfl_up(g, o); if (lane >= o) g += y; }
                sB[lt] = beta; sG[lt] = g;
            }
            __syncthreads();
            const int tk = lt >> 2, cs = lt & 3;
            const float beta = sB[tk], gc = sG[tk], gl = sG[63]; const float eg = expf(gc), ed = expf(gl - gc), bg = beta * eg;
            u4v kbg[4], vbt[4];
#pragma unroll
            for (int part = 0; part < 3; ++part) {
                float y[32];
#pragma unroll
                for (int i = 0; i < 32; ++i) y[i] = 0.f;
#pragma unroll
                for (int j = 0; j < 4; ++j) {
                    const int s = c * CH + tk - 3 + j;
                    if (s >= 0) {
                        const bfr* row = PROJ + (size_t)(b * SEQ + s) * 16384 + part * 4096 + h * 128 + cs * 32;
#pragma unroll
                        for (int q4 = 0; q4 < 4; ++q4) { const u4v x = *(const u4v*)(row + 8 * q4); const LAS float* wp = sCW + part * 512 + j * 128 + cs * 32 + 8 * q4;
                            const f4v w0 = *(const LAS f4v*)wp, w1 = *(const LAS f4v*)(wp + 4);
                            y[8 * q4 + 0] += bflo(x.x) * w0[0]; y[8 * q4 + 1] += bfhi(x.x) * w0[1]; y[8 * q4 + 2] += bflo(x.y) * w0[2]; y[8 * q4 + 3] += bfhi(x.y) * w0[3];
                            y[8 * q4 + 4] += bflo(x.z) * w1[0]; y[8 * q4 + 5] += bfhi(x.z) * w1[1]; y[8 * q4 + 6] += bflo(x.w) * w1[2]; y[8 * q4 + 7] += bfhi(x.w) * w1[3]; }
                    }
                }
                float ss = 0.f;
#pragma unroll
                for (int i = 0; i < 32; ++i) { y[i] = y[i] * __builtin_amdgcn_rcpf(1.f + __expf(-y[i])); ss += y[i] * y[i]; }
                if (part < 2) {
                    ss += __shfl_xor(ss, 1); ss += __shfl_xor(ss, 2);
                    const float rn = __builtin_amdgcn_rsqf(ss + EPS) * (part == 0 ? 0.08838834764831845f : 1.f); const float gs = part == 0 ? eg : ed;
                    LAS unsigned char* dstl = part == 0 ? sQ : sK; bfr* dstg = (part == 0 ? QGg : KDg) + (size_t)unit * 8192 + tk * 128 + cs * 32;
#pragma unroll
                    for (int q4 = 0; q4 < 4; ++q4) { float z[8];
#pragma unroll
                        for (int i = 0; i < 8; ++i) z[i] = y[8 * q4 + i] * rn;
                        u4v w; w.x = cvtpk(z[0], z[1]); w.y = cvtpk(z[2], z[3]); w.z = cvtpk(z[4], z[5]); w.w = cvtpk(z[6], z[7]);
                        *(LAS u4v*)(dstl + kq_off(tk, cs * 4 + q4)) = w;
                        u4v g; g.x = cvtpk(z[0] * gs, z[1] * gs); g.y = cvtpk(z[2] * gs, z[3] * gs); g.z = cvtpk(z[4] * gs, z[5] * gs); g.w = cvtpk(z[6] * gs, z[7] * gs);
                        *(u4v*)(dstg + 8 * q4) = g;
                        if (part == 1) { kbg[q4].x = cvtpk(z[0] * bg, z[1] * bg); kbg[q4].y = cvtpk(z[2] * bg, z[3] * bg); kbg[q4].z = cvtpk(z[4] * bg, z[5] * bg); kbg[q4].w = cvtpk(z[6] * bg, z[7] * bg); } }
                } else {
#pragma unroll
                    for (int q4 = 0; q4 < 4; ++q4) { vbt[q4].x = cvtpk(y[8 * q4] * beta, y[8 * q4 + 1] * beta); vbt[q4].y = cvtpk(y[8 * q4 + 2] * beta, y[8 * q4 + 3] * beta);
                        vbt[q4].z = cvtpk(y[8 * q4 + 4] * beta, y[8 * q4 + 5] * beta); vbt[q4].w = cvtpk(y[8 * q4 + 6] * beta, y[8 * q4 + 7] * beta); }
                }
            }
            __syncthreads();
            {
                const int r = lane & 15, q = lane >> 4, mt = lw;
                s8v ak[4], aq[4];
#pragma unroll
                for (int ks = 0; ks < 4; ++ks) { ak[ks] = *(const LAS s8v*)(sK + kq_off(16 * mt + r, 4 * ks + q)); aq[ks] = *(const LAS s8v*)(sQ + kq_off(16 * mt + r, 4 * ks + q)); }
                float gi[4], bi[4];
#pragma unroll
                for (int e = 0; e < 4; ++e) { gi[e] = sG[16 * mt + 4 * q + e]; bi[e] = sB[16 * mt + 4 * q + e]; }
                for (int nt = 0; nt < 4; ++nt) {
                    const int j = 16 * nt + r;
                    if (nt <= mt) {
                        f4v ck = zero_acc(), cq = zero_acc();
#pragma unroll
                        for (int ks = 0; ks < 4; ++ks) { const s8v bb = *(const LAS s8v*)(sK + kq_off(16 * nt + r, 4 * ks + q));
                            ck = __builtin_amdgcn_mfma_f32_16x16x32_bf16(ak[ks], bb, ck, 0, 0, 0); cq = __builtin_amdgcn_mfma_f32_16x16x32_bf16(aq[ks], bb, cq, 0, 0, 0); }
                        MFMA_SETTLE(ck); MFMA_SETTLE(cq);
                        const float gj = sG[j];
#pragma unroll
                        for (int e = 0; e < 4; ++e) { const int i = 16 * mt + 4 * q + e; const float dec = expf(fminf(gi[e] - gj, 0.f));
                            const float av = (i > j) ? bi[e] * ck[e] * dec : 0.f;
                            *(LAS bfr*)(sAM + xt_off(i, j >> 3) + (j & 7) * 2) = f2bf1(av);
                            if (nt == mt) sAD[mt * 256 + (4 * q + e) * 16 + r] = av;
                            QKg[(size_t)unit * 4096 + i * 64 + j] = f2bf1((i >= j) ? cq[e] * dec : 0.f); }
                    } else {
#pragma unroll
                        for (int e = 0; e < 4; ++e) QKg[(size_t)unit * 4096 + (16 * mt + 4 * q + e) * 64 + j] = (bfr)0;
                    }
                }
            }
            __syncthreads();
            {
                const int ro = ((tk >> 3)), rb = (tk & 7) * 2;
#pragma unroll
                for (int q4 = 0; q4 < 4; ++q4) {
                    const unsigned vv[4] = {vbt[q4].x, vbt[q4].y, vbt[q4].z, vbt[q4].w}, kk[4] = {kbg[q4].x, kbg[q4].y, kbg[q4].z, kbg[q4].w};
#pragma unroll
                    for (int i = 0; i < 8; ++i) { const int ch = cs * 32 + q4 * 8 + i;
                        *(LAS bfr*)(sX + xt_off(ch, ro) + rb) = (bfr)((i & 1) ? (vv[i >> 1] >> 16) : (vv[i >> 1] & 0xffffu));
                        *(LAS bfr*)(sX + xt_off(128 + ch, ro) + rb) = (bfr)((i & 1) ? (kk[i >> 1] >> 16) : (kk[i >> 1] & 0xffffu)); }
                }
            }
            __syncthreads();
            {
                const int r = lane & 15, q = lane >> 4;
                float x[64];
#pragma unroll
                for (int bk = 0; bk < 4; ++bk) {
                    float corr[16];
#pragma unroll
                    for (int i = 0; i < 16; ++i) corr[i] = 0.f;
                    if (bk > 0) {
                        f4v acc[4] = {zero_acc(), zero_acc(), zero_acc(), zero_acc()};
#pragma unroll
                        for (int ks = 0; ks < (16 * bk + 31) / 32; ++ks) {
                            s8v a = *(const LAS s8v*)(sAM + xt_off(16 * bk + r, 4 * ks + q));
                            if (32 * ks + 8 * q >= 16 * bk) a = (s8v){0, 0, 0, 0, 0, 0, 0, 0};
#pragma unroll
                            for (int nt = 0; nt < 4; ++nt) { const s8v bx = *(const LAS s8v*)(sX + xt_off(64 * lw + 16 * nt + r, 4 * ks + q)); acc[nt] = __builtin_amdgcn_mfma_f32_16x16x32_bf16(a, bx, acc[nt], 0, 0, 0); }
                        }
                        MFMA_SETTLE(acc[0]); MFMA_SETTLE(acc[1]); MFMA_SETTLE(acc[2]); MFMA_SETTLE(acc[3]);
#pragma unroll
                        for (int nt = 0; nt < 4; ++nt)
#pragma unroll
                            for (int e = 0; e < 4; ++e) scr[(16 * nt + r) * 17 + 4 * q + e] = -acc[nt][e];
                        LDS_WAIT(); asm volatile("" ::: "memory");
#pragma unroll
                        for (int i = 0; i < 16; ++i) corr[i] = scr[lane * 17 + i];
                    }
                    const u4v r0 = *(const LAS u4v*)(sX + xt_off(lt, 2 * bk)), r1 = *(const LAS u4v*)(sX + xt_off(lt, 2 * bk + 1));
                    const float rhs[16] = {bflo(r0.x), bfhi(r0.x), bflo(r0.y), bfhi(r0.y), bflo(r0.z), bfhi(r0.z), bflo(r0.w), bfhi(r0.w), bflo(r1.x), bfhi(r1.x), bflo(r1.y), bfhi(r1.y), bflo(r1.z), bfhi(r1.z), bflo(r1.w), bfhi(r1.w)};
                    float xb[16];
#pragma unroll
                    for (int i = 0; i < 16; ++i) {
                        float v = rhs[i] + corr[i];
                        const u4v a0 = *(const LAS u4v*)(sAM + xt_off(16 * bk + i, 2 * bk)), a1 = *(const LAS u4v*)(sAM + xt_off(16 * bk + i, 2 * bk + 1));
                        const float am[16] = {bflo(a0.x), bfhi(a0.x), bflo(a0.y), bfhi(a0.y), bflo(a0.z), bfhi(a0.z), bflo(a0.w), bfhi(a0.w), bflo(a1.x), bfhi(a1.x), bflo(a1.y), bfhi(a1.y), bflo(a1.z), bfhi(a1.z), bflo(a1.w), bfhi(a1.w)};
#pragma unroll
                        for (int j = 0; j < 16; ++j) if (j < i) v -= am[j] * xb[j];
                        xb[i] = v; x[16 * bk + i] = v;
                    }
                    u4v w0, w1; w0.x = cvtpk(xb[0], xb[1]); w0.y = cvtpk(xb[2], xb[3]); w0.z = cvtpk(xb[4], xb[5]); w0.w = cvtpk(xb[6], xb[7]);
                    w1.x = cvtpk(xb[8], xb[9]); w1.y = cvtpk(xb[10], xb[11]); w1.z = cvtpk(xb[12], xb[13]); w1.w = cvtpk(xb[14], xb[15]);
                    *(LAS u4v*)(sX + xt_off(lt, 2 * bk)) = w0; *(LAS u4v*)(sX + xt_off(lt, 2 * bk + 1)) = w1;
                    LDS_WAIT(); asm volatile("" ::: "memory");
                }
                bfr* dst = (lt < 128 ? Ug : Wg) + (size_t)unit * 8192 + (lt & 127);
#pragma unroll
                for (int i = 0; i < 64; ++i) dst[i * 128] = f2bf1(x[i]);
                if (lt == 0) EGg[unit] = expf(sG[63]);
            }
            __syncthreads();
        }
    }
}

__device__ __forceinline__ void p_gdn_scan(const Ctx& C, const Ptrs& P) {
    unsigned char* ws = P.ws_();
    const GAS bfr* Wg = (const GAS bfr*)(ws + WS_R + R_W); const GAS bfr* Ug = (const GAS bfr*)(ws + WS_R + R_U); const GAS bfr* QGg = (const GAS bfr*)(ws + WS_R + R_QG); const GAS bfr* KDg = (const GAS bfr*)(ws + WS_R + R_KD);
    const GAS bfr* QKg = (const GAS bfr*)(ws + WS_R + R_QK); GAS bfr* Og = (GAS bfr*)(ws + WS_R + R_O); const GAS float* EGg = (const GAS float*)(ws + WS_EG);
    const int tid = C.tid, lane = C.lane, wave = C.wave, r = lane & 15, q = lane >> 4, mt = wave & 3, nt = wave >> 2;
    LAS bfr* sST = (LAS bfr*)(C.lds + 131072); LAS bfr* sVN = (LAS bfr*)(C.lds + 139776);
#define SC_W(bb)  ((LAS bfr*)(C.lds + (bb) * 65536))
#define SC_QG(bb) ((LAS bfr*)(C.lds + (bb) * 65536 + 17408))
#define SC_KD(bb) ((LAS bfr*)(C.lds + (bb) * 65536 + 34816))
#define SC_QK(bb) ((LAS bfr*)(C.lds + (bb) * 65536 + 52224))
#define SC_U(bb)  ((LAS bfr*)(C.lds + (bb) * 65536 + 61440))
#define SC_LOAD(n) do { const size_t ub = (size_t)(bh * 64 + (n)) * 8192; \
        rW0 = *(const GAS u4v*)(Wg + ub + (size_t)tid * 8); rW1 = *(const GAS u4v*)(Wg + ub + (size_t)(tid + 512) * 8); \
        rQ0 = *(const GAS u4v*)(QGg + ub + (size_t)tid * 8); rQ1 = *(const GAS u4v*)(QGg + ub + (size_t)(tid + 512) * 8); \
        rK0 = *(const GAS u4v*)(KDg + ub + (size_t)tid * 8); rK1 = *(const GAS u4v*)(KDg + ub + (size_t)(tid + 512) * 8); \
        rQK = *(const GAS u4v*)(QKg + (size_t)(bh * 64 + (n)) * 4096 + (size_t)tid * 8); \
        if (tid < 256) rU = *(const GAS u4v*)(Ug + ub + (size_t)(tid >> 2) * 128 + es * 32 + (tid & 3) * 8); } while (0)
#define SC_WRITE(bb) do { const int c0 = tid, c1 = tid + 512; \
        *(LAS u4v*)(SC_W(bb) + (c0 >> 4) * 136 + (c0 & 15) * 8) = rW0; *(LAS u4v*)(SC_W(bb) + (c1 >> 4) * 136 + (c1 & 15) * 8) = rW1; \
        *(LAS u4v*)(SC_QG(bb) + (c0 >> 4) * 136 + (c0 & 15) * 8) = rQ0; *(LAS u4v*)(SC_QG(bb) + (c1 >> 4) * 136 + (c1 & 15) * 8) = rQ1; \
        *(LAS u4v*)(SC_KD(bb) + (c0 >> 4) * 136 + (c0 & 15) * 8) = rK0; *(LAS u4v*)(SC_KD(bb) + (c1 >> 4) * 136 + (c1 & 15) * 8) = rK1; \
        *(LAS u4v*)(SC_QK(bb) + (tid >> 3) * 72 + (tid & 7) * 8) = rQK; \
        if (tid < 256) *(LAS u4v*)(SC_U(bb) + (tid >> 2) * 32 + (tid & 3) * 8) = rU; } while (0)
    for (int task = C.vcu; task < NB * GH * 4; task += C.G) {
        const int bh = task >> 2, es = task & 3, h = bh & 31, b = bh >> 5;
        u4v rW0, rW1, rQ0, rQ1, rK0, rK1, rQK, rU = {0u, 0u, 0u, 0u};
        f4v S0 = {0.f, 0.f, 0.f, 0.f}, S1 = {0.f, 0.f, 0.f, 0.f};
        LAS float* sEG = (LAS float*)(C.lds + 144384);
        if (tid < 64) sEG[tid] = EGg[bh * 64 + tid];
        SC_LOAD(0); SC_WRITE(0); SC_LOAD(1);
        for (int n = 0; n < NCH; ++n) {
            const int bb = n & 1;
            {
                MFMA_SETTLE(S0); MFMA_SETTLE(S1);
                u2v w0, w1; w0.x = cvtpk(S0[0], S0[1]); w0.y = cvtpk(S0[2], S0[3]); w1.x = cvtpk(S1[0], S1[1]); w1.y = cvtpk(S1[2], S1[3]);
                *(LAS u2v*)(sST + (r) * 136 + 16 * wave + 4 * q) = w0; *(LAS u2v*)(sST + (16 + r) * 136 + 16 * wave + 4 * q) = w1;
            }
            __syncthreads();
            if (n + 1 < NCH) { if (bb) SC_WRITE(0); else SC_WRITE(1); if (n + 2 < NCH) SC_LOAD(n + 2); }
            f4v acc1 = zero_acc(), acc2 = zero_acc();
            const LAS bfr* pW = SC_W(bb) + (16 * mt + r) * 136 + 8 * q; const LAS bfr* pQ = SC_QG(bb) + (16 * mt + r) * 136 + 8 * q; const LAS bfr* pS = sST + (16 * nt + r) * 136 + 8 * q;
#pragma unroll
            for (int ks = 0; ks < 4; ++ks) { const s8v a1 = *(const LAS s8v*)(pW + 32 * ks), a2 = *(const LAS s8v*)(pQ + 32 * ks), bs = *(const LAS s8v*)(pS + 32 * ks);
                acc1 = __builtin_amdgcn_mfma_f32_16x16x32_bf16(a1, bs, acc1, 0, 0, 0); acc2 = __builtin_amdgcn_mfma_f32_16x16x32_bf16(a2, bs, acc2, 0, 0, 0); }
            MFMA_SETTLE(acc1);
            {
                const LAS bfr* pU = SC_U(bb) + (16 * mt + 4 * q) * 32 + 16 * nt + r;
                const float v0 = bf1(pU[0]) - acc1[0], v1 = bf1(pU[32]) - acc1[1], v2 = bf1(pU[64]) - acc1[2], v3 = bf1(pU[96]) - acc1[3];
                u2v w; w.x = cvtpk(v0, v1); w.y = cvtpk(v2, v3);
                *(LAS u2v*)(sVN + (16 * nt + r) * 72 + 16 * mt + 4 * q) = w;
            }
            __syncthreads();
            {
                const LAS bfr* pA = SC_QK(bb) + (16 * mt + r) * 72 + 8 * q; const LAS bfr* pV = sVN + (16 * nt + r) * 72 + 8 * q;
#pragma unroll
                for (int ks = 0; ks < 2; ++ks) { const s8v a = *(const LAS s8v*)(pA + 32 * ks), bv = *(const LAS s8v*)(pV + 32 * ks); acc2 = __builtin_amdgcn_mfma_f32_16x16x32_bf16(a, bv, acc2, 0, 0, 0); }
                MFMA_SETTLE(acc2);
                GAS bfr* po = Og + (size_t)(b * SEQ + n * CH + 16 * mt + 4 * q) * DM + h * 128 + es * 32 + 16 * nt + r;
                po[0] = f2bf1(acc2[0]); po[DM] = f2bf1(acc2[1]); po[2 * DM] = f2bf1(acc2[2]); po[3 * DM] = f2bf1(acc2[3]);
            }
            {
                const float eg = sEG[n];
                S0 *= eg; S1 *= eg;
                const LAS bfr* pK = SC_KD(bb) + (8 * q) * 136 + 16 * wave + r; const LAS bfr* pV0 = sVN + r * 72 + 8 * q; const LAS bfr* pV1 = sVN + (16 + r) * 72 + 8 * q;
#pragma unroll
                for (int ks = 0; ks < 2; ++ks) {
                    s8v a;
#pragma unroll
                    for (int i = 0; i < 8; ++i) a[i] = (short)pK[(32 * ks + i) * 136];
                    const s8v b0 = *(const LAS s8v*)(pV0 + 32 * ks), b1 = *(const LAS s8v*)(pV1 + 32 * ks);
                    S0 = __builtin_amdgcn_mfma_f32_16x16x32_bf16(a, b0, S0, 0, 0, 0); S1 = __builtin_amdgcn_mfma_f32_16x16x32_bf16(a, b1, S1, 0, 0, 0);
                }
            }
        }
        __syncthreads();
    }
#undef SC_W
#undef SC_QG
#undef SC_KD
#undef SC_QK
#undef SC_U
#undef SC_LOAD
#undef SC_WRITE
}

#define S2_OFF_QG 17408
#define S2_OFF_QK 34816
#define S2_OFF_KT 44032
#define S2_OFF_U  62464
#define S2_BUF    66560
__device__ __forceinline__ s8v s2_frag(const LAS bfr* rowp, int q) {
    const u2v lo = *(const LAS u2v*)(rowp + 4 * q), hi = *(const LAS u2v*)(rowp + 16 + 4 * q);
    const u4v w = {lo.x, lo.y, hi.x, hi.y}; return __builtin_bit_cast(s8v, w);
}
__device__ __forceinline__ s8v s2_fragx(const LAS bfr* rowp, int g0, int g1) {
    const u2v lo = *(const LAS u2v*)(rowp + 4 * g0), hi = *(const LAS u2v*)(rowp + 4 * g1);
    const u4v w = {lo.x, lo.y, hi.x, hi.y}; return __builtin_bit_cast(s8v, w);
}
__device__ __forceinline__ s8v s2_pack(const f4v& a, const f4v& b) { const u4v w = {cvtpk(a[0], a[1]), cvtpk(a[2], a[3]), cvtpk(b[0], b[1]), cvtpk(b[2], b[3])}; return __builtin_bit_cast(s8v, w); }
template <int MODE = 0>
__device__ __forceinline__ void p_gdn_scan2(const Ctx& C, const Ptrs& P) {
    unsigned char* ws = P.ws_();
    const GAS bfr* Wg = (const GAS bfr*)(ws + WS_R + R_W); const GAS bfr* Ug = (const GAS bfr*)(ws + WS_R + R_U); const GAS bfr* QGg = (const GAS bfr*)(ws + WS_R + R_QG); const GAS bfr* KDg = (const GAS bfr*)(ws + WS_R + R_KD);
    const GAS bfr* QKg = (const GAS bfr*)(ws + WS_R + R_QK); GAS bfr* Og = (GAS bfr*)(ws + (MODE ? WS_SC : WS_R + R_O)); const GAS float* EGg = (const GAS float*)(ws + WS_EG);
    const int tid = C.tid, lane = C.lane, wave = C.wave, r = lane & 15, q = lane >> 4;
    LAS float* sEG = (LAS float*)(C.lds + 2 * S2_BUF);
    for (int task = C.vcu; task < NB * GH * 4; task += C.G) {
        const int bh = task >> 2, es = task & 3, h = bh & 31, b = bh >> 5;
        if (tid < 64) sEG[tid] = EGg[bh * 64 + tid];
        if (wave >= 2) {
            const int lw = __builtin_amdgcn_readfirstlane((tid - 128) & ~63);
            __builtin_assume(lw >= 0 && lw <= 320);
            const GAS unsigned char* RB = (const GAS unsigned char*)(ws + WS_R);
            const unsigned l16 = lane * 16, lU = (lane >> 2) * 256 + (lane & 3) * 16 + es * 64;
            const unsigned lrow = (lane >> 4) * 272 + (lane & 15) * 16, lqk = (lane >> 3) * 144 + (lane & 7) * 16, lkt = (lane & 15) * 8 * 144 + (lane >> 4) * 2;
            const int lsw = (lane & 15) >> 1;
            u4v ra[10], rb[10];
#define S2_LOAD(R, n) do { const unsigned ua_ = (unsigned)(bh * 64 + ((MODE == 2 || MODE == 4) ? 0 : (n))) * 16384u; _Pragma("unroll") for (int k_ = 0; k_ < 10; ++k_) { const int c0_ = lw + 384 * k_; \
        if (c0_ < 1024) R[k_] = *(const GAS u4v*)(RB + (size_t)((unsigned)R_W + ua_ + c0_ * 16) + l16); \
        else if (c0_ < 2048) R[k_] = *(const GAS u4v*)(RB + (size_t)((unsigned)R_QG + ua_ + (c0_ - 1024) * 16) + l16); \
        else if (c0_ < 2560) R[k_] = *(const GAS u4v*)(RB + (size_t)((unsigned)R_QK + (ua_ >> 1) + (c0_ - 2048) * 16) + l16); \
        else if (c0_ < 2816) R[k_] = *(const GAS u4v*)(RB + (size_t)((unsigned)R_U + ua_ + ((c0_ - 2560) >> 2) * 256) + lU); \
        else R[k_] = *(const GAS u4v*)(RB + (size_t)((unsigned)R_KD + ua_ + (c0_ - 2816) * 16) + l16); } } while (0)
#define S2_WRITE(R, bb) do { LAS unsigned char* B_ = C.lds + (bb) * S2_BUF; _Pragma("unroll") for (int k_ = 0; k_ < 10; ++k_) { const int c0_ = lw + 384 * k_; \
        if (c0_ < 1024) *(LAS u4v*)(B_ + (c0_ >> 4) * 272 + lrow) = R[k_]; \
        else if (c0_ < 2048) *(LAS u4v*)(B_ + S2_OFF_QG + ((c0_ - 1024) >> 4) * 272 + lrow) = R[k_]; \
        else if (c0_ < 2560) *(LAS u4v*)(B_ + S2_OFF_QK + ((c0_ - 2048) >> 3) * 144 + lqk) = R[k_]; \
        else if (c0_ < 2816) *(LAS u4v*)(B_ + S2_OFF_U + (c0_ - 2560) * 16 + l16) = R[k_]; \
        else { const int g_ = (c0_ - 2816) >> 6; LAS bfr* kt_ = (LAS bfr*)(B_ + S2_OFF_KT + lkt + ((g_ ^ lsw) << 3)); const unsigned w_[4] = {R[k_].x, R[k_].y, R[k_].z, R[k_].w}; \
            _Pragma("unroll") for (int i_ = 0; i_ < 8; ++i_) kt_[i_ * 72] = (bfr)((i_ & 1) ? (w_[i_ >> 1] >> 16) : (w_[i_ >> 1] & 0xffffu)); } } } while (0)
            u4v rc[10];
            S2_LOAD(ra, 0); S2_WRITE(ra, 0);
            S2_LOAD(rb, 1); S2_LOAD(rc, 2); S2_LOAD(ra, 3);
            __syncthreads();
#define S2_STEP(R, bb, n_) { S2_WRITE(R, bb); S2_LOAD(R, (n_) + 4); __syncthreads(); }
            for (int n = 0; n < NCH - 4; n += 6) {
                S2_STEP(rb, 1, n) S2_STEP(rc, 0, n + 1) S2_STEP(ra, 1, n + 2) S2_STEP(rb, 0, n + 3) S2_STEP(rc, 1, n + 4) S2_STEP(ra, 0, n + 5)
            }
            static_assert((NCH - 4) % 6 == 0, "scan loader schedule");
            S2_WRITE(rb, 1); __syncthreads(); S2_WRITE(rc, 0); __syncthreads(); S2_WRITE(ra, 1); __syncthreads(); __syncthreads();
#undef S2_STEP
#undef S2_LOAD
#undef S2_WRITE
        } else {
            const int nt = wave;
            f4v S[8];
#pragma unroll
            for (int w = 0; w < 8; ++w) S[w] = zero_acc();
            __syncthreads();
            for (int n = 0; n < NCH; ++n) {
                if (MODE == 3 || MODE == 4) { __syncthreads(); continue; }
                const LAS unsigned char* B = C.lds + (n & 1) * S2_BUF;
                const LAS bfr* sW = (const LAS bfr*)B; const LAS bfr* sQG = (const LAS bfr*)(B + S2_OFF_QG); const LAS bfr* sQK = (const LAS bfr*)(B + S2_OFF_QK);
                const LAS bfr* sKT = (const LAS bfr*)(B + S2_OFF_KT); const LAS bfr* sU = (const LAS bfr*)(B + S2_OFF_U);
#define S2_STAGE() asm volatile("" ::: "memory")
#define S2_LOADQ(F, mt) do { _Pragma("unroll") for (int ks = 0; ks < 4; ++ks) { F[ks] = s2_frag(sW + (16 * (mt) + r) * 136 + 32 * ks, q); F[4 + ks] = s2_frag(sQG + (16 * (mt) + r) * 136 + 32 * ks, q); } } while (0)
#define S2_MMQ(F, mt) do { _Pragma("unroll") for (int ks = 0; ks < 4; ++ks) { a1[mt] = __builtin_amdgcn_mfma_f32_16x16x32_bf16(F[ks], Bs[ks], a1[mt], 0, 0, 0); \
        a2[mt] = __builtin_amdgcn_mfma_f32_16x16x32_bf16(F[4 + ks], Bs[ks], a2[mt], 0, 0, 0); } } while (0)
                s8v fA[8], fB[8];
                S2_LOADQ(fA, 0); S2_LOADQ(fB, 1);
                s8v Bs[4];
#pragma unroll
                for (int ks = 0; ks < 4; ++ks) Bs[ks] = s2_pack(S[2 * ks], S[2 * ks + 1]);
                f4v a1[4], a2[4];
#pragma unroll
                for (int mt = 0; mt < 4; ++mt) { a1[mt] = zero_acc(); a2[mt] = zero_acc(); }
                S2_STAGE();
                S2_MMQ(fA, 0); S2_STAGE(); S2_LOADQ(fA, 2); S2_STAGE();
                S2_MMQ(fB, 1); S2_STAGE(); S2_LOADQ(fB, 3);
                bfr ur[16]; s8v fa[8];
#pragma unroll
                for (int mt = 0; mt < 4; ++mt) { const LAS bfr* pU = sU + (16 * mt + 4 * q) * 32 + 16 * nt + r; ur[4 * mt] = pU[0]; ur[4 * mt + 1] = pU[32]; ur[4 * mt + 2] = pU[64]; ur[4 * mt + 3] = pU[96]; }
                S2_STAGE();
                S2_MMQ(fA, 2); S2_STAGE();
#pragma unroll
                for (int mt = 0; mt < 4; ++mt)
#pragma unroll
                    for (int k2 = 0; k2 < 2; ++k2) fa[2 * mt + k2] = s2_frag(sQK + (16 * mt + r) * 72 + 32 * k2, q);
                S2_STAGE();
                S2_MMQ(fB, 3); S2_STAGE();
#undef S2_LOADQ
#undef S2_MMQ
                s8v fk[16];
#pragma unroll
                for (int w = 0; w < 8; ++w)
#pragma unroll
                    for (int k2 = 0; k2 < 2; ++k2) fk[2 * w + k2] = s2_fragx(sKT + (16 * w + r) * 72 + 32 * k2, q ^ w, (4 + q) ^ w);
                const float eg = sEG[n];
                S2_STAGE();
                f4v vn[4];
#pragma unroll
                for (int mt = 0; mt < 4; ++mt) vn[mt] = (f4v){bf1(ur[4 * mt]) - a1[mt][0], bf1(ur[4 * mt + 1]) - a1[mt][1], bf1(ur[4 * mt + 2]) - a1[mt][2], bf1(ur[4 * mt + 3]) - a1[mt][3]};
                s8v Bv[2];
#pragma unroll
                for (int k2 = 0; k2 < 2; ++k2) Bv[k2] = s2_pack(vn[2 * k2], vn[2 * k2 + 1]);
#pragma unroll
                for (int k2 = 0; k2 < 2; ++k2)
#pragma unroll
                    for (int mt = 0; mt < 4; ++mt) a2[mt] = __builtin_amdgcn_mfma_f32_16x16x32_bf16(fa[2 * mt + k2], Bv[k2], a2[mt], 0, 0, 0);
#pragma unroll
                for (int w = 0; w < 8; ++w) S[w] *= eg;
#pragma unroll
                for (int k2 = 0; k2 < 2; ++k2)
#pragma unroll
                    for (int w = 0; w < 8; ++w) S[w] = __builtin_amdgcn_mfma_f32_16x16x32_bf16(fk[2 * w + k2], Bv[k2], S[w], 0, 0, 0);
#pragma unroll
                for (int mt = 0; mt < 4; ++mt) {
                    GAS bfr* po = Og + (size_t)(b * SEQ + n * CH + 16 * mt + 4 * q) * DM + h * 128 + es * 32 + 16 * nt + r;
                    po[0] = f2bf1(a2[mt][0]); po[DM] = f2bf1(a2[mt][1]); po[2 * DM] = f2bf1(a2[mt][2]); po[3 * DM] = f2bf1(a2[mt][3]); }
#undef S2_STAGE
                MFMA_SETTLE(S[7]);
                __syncthreads();
            }
        }
        __syncthreads();
    }
}
#undef S2_OFF_QG
#undef S2_OFF_QK
#undef S2_OFF_KT
#undef S2_OFF_U
#undef S2_BUF

__device__ __forceinline__ void p_gdn_onorm(const Ctx& C, const Ptrs& P) {
    unsigned char* ws = P.ws_(); const bfr* Og = (const bfr*)(ws + WS_R + R_O); const bfr* PROJ = (const bfr*)(ws + WS_BIG); bfr* AO = (bfr*)(ws + WS_XN); const float* og = P.in_(6);
    const size_t gt = (size_t)C.vcu * 512 + C.tid, GT = (size_t)C.G * 512;
    for (size_t idx0 = gt; idx0 < (size_t)NT * DM / 8; idx0 += 4 * GT) {
        u4v o8[4], z8[4];
#pragma unroll
        for (int b4 = 0; b4 < 4; ++b4) { const size_t idx = idx0 + b4 * GT; const size_t t = idx >> 9; const int hh = (int)(idx >> 4) & 31, i = (int)idx & 15;
            o8[b4] = *(const u4v*)(Og + t * DM + hh * 128 + 8 * i); z8[b4] = *(const u4v*)(PROJ + t * 16384 + 12288 + hh * 128 + 8 * i); }
        const int i = (int)idx0 & 15;
        const f4v g0 = *(const f4v*)(og + 8 * i), g1 = *(const f4v*)(og + 8 * i + 4); const float g[8] = {g0[0], g0[1], g0[2], g0[3], g1[0], g1[1], g1[2], g1[3]};
#pragma unroll
        for (int b4 = 0; b4 < 4; ++b4) { const size_t idx = idx0 + b4 * GT; const size_t t = idx >> 9; const int hh = (int)(idx >> 4) & 31;
            float o[8] = {bflo(o8[b4].x), bfhi(o8[b4].x), bflo(o8[b4].y), bfhi(o8[b4].y), bflo(o8[b4].z), bfhi(o8[b4].z), bflo(o8[b4].w), bfhi(o8[b4].w)};
            float z[8] = {bflo(z8[b4].x), bfhi(z8[b4].x), bflo(z8[b4].y), bfhi(z8[b4].y), bflo(z8[b4].z), bfhi(z8[b4].z), bflo(z8[b4].w), bfhi(z8[b4].w)};
            float ss = 0.f;
#pragma unroll
            for (int k = 0; k < 8; ++k) ss += o[k] * o[k];
            ss += __shfl_xor(ss, 1); ss += __shfl_xor(ss, 2); ss += __shfl_xor(ss, 4); ss += __shfl_xor(ss, 8);
            const float rn = __builtin_amdgcn_rsqf(ss * (1.f / 128.f) + EPS);
            float y[8];
#pragma unroll
            for (int k = 0; k < 8; ++k) y[k] = o[k] * rn * g[k] * (z[k] * __builtin_amdgcn_rcpf(1.f + __expf(-z[k])));
#if F8_OUT0
#pragma unroll
            for (int k = 0; k < 8; ++k) y[k] = fminf(fmaxf(y[k] * SO, -440.f), 440.f);
            u2v w; w.x = cvt4_fp8(y[0], y[1], y[2], y[3]); w.y = cvt4_fp8(y[4], y[5], y[6], y[7]);
            *(u2v*)(ws + WS_XN8 + t * DM + hh * 128 + 8 * i) = w; }
#else
            u4v w; w.x = cvtpk(y[0], y[1]); w.y = cvtpk(y[2], y[3]); w.z = cvtpk(y[4], y[5]); w.w = cvtpk(y[6], y[7]);
            *(u4v*)(AO + t * DM + hh * 128 + 8 * i) = w; }
#endif
    }
}
__device__ __forceinline__ unsigned mono_key(float x) { const unsigned u = __float_as_uint(x); return u ^ ((unsigned)((int)u >> 31) | 0x80000000u); }
#define KEY_INS(K, key) do { unsigned x_ = (key); _Pragma("unroll") for (int s_ = 0; s_ < 16; ++s_) { const unsigned hi_ = max(K[s_], x_); x_ = min(K[s_], x_); K[s_] = hi_; } } while (0)
__device__ __forceinline__ void p_route(const Ctx& C, const Ptrs& P) {
    unsigned char* ws = P.ws_(); const float* SC = (const float*)(ws + WS_SC); bfr* G = (bfr*)(ws + WS_G);
    LAS unsigned char* wl = C.lds + C.wave * 16384;
    LAS int* sE = (LAS int*)(wl); LAS float* sGt = (LAS float*)(wl + 2048); LAS float* sV1 = (LAS float*)(wl + 4096); LAS float* sV2 = (LAS float*)(wl + 8192); LAS int* sI = (LAS int*)(wl + 12288);
    const int lane = C.lane, gw = C.vcu * 8 + C.wave, NGW = C.G * 8;
    for (int wt = gw; wt < NT / 4; wt += NGW) {
        const int tl = lane >> 4, t = wt * 4 + tl;
        unsigned k1[16];
#pragma unroll
        for (int i = 0; i < 16; ++i) k1[i] = 0u;
        const float* base = SC + (size_t)t * PQ + (lane & 15) * 128;
        for (int e = 0; e < 128; e += 4) { const f4v x4 = *(const f4v*)(base + e);
            KEY_INS(k1, (mono_key(x4[0]) & ~127u) | (unsigned)(127 - e)); KEY_INS(k1, (mono_key(x4[1]) & ~127u) | (unsigned)(126 - e));
            KEY_INS(k1, (mono_key(x4[2]) & ~127u) | (unsigned)(125 - e)); KEY_INS(k1, (mono_key(x4[3]) & ~127u) | (unsigned)(124 - e)); }
        const bool h0 = (lane & 1) == 0;
        float v1[16], v2[16];
#pragma unroll
        for (int i = 0; i < 16; ++i) { const int id = 127 - (int)(k1[i] & 127u); const float vv = base[id];
            const float ov = __shfl_xor(vv, 1); const int oi = __shfl_xor(id, 1);
            v1[i] = h0 ? vv : ov; v2[i] = h0 ? ov : vv; const int ia = h0 ? id : oi, ib = h0 ? oi : id;
            sV1[i * 64 + lane] = v1[i]; sV2[i * 64 + lane] = v2[i]; sI[i * 64 + lane] = ia | (ib << 8); }
        unsigned k2[16];
#pragma unroll
        for (int i = 0; i < 16; ++i) k2[i] = 0u;
#pragma unroll
        for (int a = 0; a < 16; ++a)
#pragma unroll
            for (int b = 0; b < 16; ++b)
                if ((a + 1) * (b + 1) <= 16) KEY_INS(k2, (mono_key(v1[a] + v2[b]) & ~255u) | (unsigned)(255 - (a * 16 + b)));
        LDS_WAIT(); asm volatile("" ::: "memory");
        float ts[16]; int te[16]; float mx = -__builtin_inff();
#pragma unroll
        for (int i = 0; i < 16; ++i) { const int code = 255 - (int)(k2[i] & 255u), a = code >> 4, b = code & 15;
            ts[i] = sV1[a * 64 + lane] + sV2[b * 64 + lane]; te[i] = (sI[a * 64 + lane] & 0xff) * 128 + (sI[b * 64 + lane] >> 8); mx = fmaxf(mx, ts[i]); }
        float sum = 0.f;
#pragma unroll
        for (int i = 0; i < 16; ++i) { ts[i] = __expf(ts[i] - mx); sum += ts[i]; }
        const float inv = 1.f / sum;
        if (h0) { const int hb = ((lane >> 1) & 7) * 16;
#pragma unroll
            for (int i = 0; i < 16; ++i) { sE[tl * 128 + hb + i] = te[i]; sGt[tl * 128 + hb + i] = ts[i] * inv; } }
        LDS_WAIT(); asm volatile("" ::: "memory");
        for (int k = 0; k < 4; ++k) {
            const size_t tt = (size_t)wt * 4 + k; u4v* row = (u4v*)(G + tt * PE); const u4v z = {0u, 0u, 0u, 0u};
#pragma unroll 8
            for (int j = 0; j < 32; ++j) row[j * 64 + lane] = z;
            const int e0 = sE[k * 128 + lane], e1 = sE[k * 128 + 64 + lane]; float t0 = 0.f, t1 = 0.f; bool f0 = true, f1 = true;
            for (int j = 0; j < 128; j += 4) { const i4v ej = *(const LAS i4v*)(sE + k * 128 + j); const f4v gj = *(const LAS f4v*)(sGt + k * 128 + j);
                if (ej.x == e0) { t0 += gj[0]; if (j + 0 < lane) f0 = false; } if (ej.y == e0) { t0 += gj[1]; if (j + 1 < lane) f0 = false; }
                if (ej.z == e0) { t0 += gj[2]; if (j + 2 < lane) f0 = false; } if (ej.w == e0) { t0 += gj[3]; if (j + 3 < lane) f0 = false; }
                if (ej.x == e1) { t1 += gj[0]; if (j + 0 < lane + 64) f1 = false; } if (ej.y == e1) { t1 += gj[1]; if (j + 1 < lane + 64) f1 = false; }
                if (ej.z == e1) { t1 += gj[2]; if (j + 2 < lane + 64) f1 = false; } if (ej.w == e1) { t1 += gj[3]; if (j + 3 < lane + 64) f1 = false; } }
            VM_WAIT();
            if (f0) G[tt * PE + e0] = f2bf1(t0);
            if (f1) G[tt * PE + e1] = f2bf1(t1);
        }
        LDS_WAIT(); asm volatile("" ::: "memory");
    }
}

typedef _Float16 h2v __attribute__((ext_vector_type(2)));
__device__ __forceinline__ unsigned char gate_code(float g) { const float c = 195.f + 20.f * __log2f(g); return (unsigned char)(int)fminf(fmaxf(c + 0.5f, 1.f), 255.f); }
__device__ __forceinline__ void p_sroute(const Ctx& C, const Ptrs& P, int layer) {
    unsigned char* ws = P.ws_(); const bfr* QRY = (const bfr*)(ws + WS_QRY); const bfr* KEY = (const bfr*)(ws + WS_WTKEY) + (size_t)layer * PQ * PQ; unsigned char* G = ws + WS_G;
    const int lane = C.lane, wave = C.wave, r = lane & 15, q = lane >> 4;
    LAS unsigned char* wl = C.lds + wave * 16640;
    LAS _Float16* sS = (LAS _Float16*)wl;
    LAS float* sV1 = (LAS float*)(wl); LAS float* sV2 = (LAS float*)(wl + 4096); LAS int* sI = (LAS int*)(wl + 8192);
    LAS int* sE = (LAS int*)(C.lds); LAS float* sGt = (LAS float*)(C.lds + 16384);
    LAS unsigned* bm = (LAS unsigned*)(C.lds + 32768 + wave * 3200); LAS unsigned* cnt = bm + 512; LAS int* le = (LAS int*)(bm + 516); LAS float* lg = (LAS float*)(bm + 516 + 128);
    for (int blk = C.vcu; blk < NT / 32; blk += C.G) {
        const int t0 = blk * 32;
#pragma unroll
        for (int hf = 0; hf < 2; ++hf) {
            const int hh = wave * 2 + hf;
            s8v a[2][4];
#pragma unroll
            for (int mt = 0; mt < 2; ++mt)
#pragma unroll
                for (int ks = 0; ks < 4; ++ks) a[mt][ks] = *(const s8v*)(QRY + (size_t)(t0 + 16 * mt + r) * PQ + hh * 128 + 32 * ks + 8 * q);
#pragma unroll
            for (int nt = 0; nt < 8; ++nt) {
                s8v b[4];
#pragma unroll
                for (int ks = 0; ks < 4; ++ks) b[ks] = *(const s8v*)(KEY + (size_t)(hh * 128 + 16 * nt + r) * PQ + hh * 128 + 32 * ks + 8 * q);
                f4v c0 = zero_acc(), c1 = zero_acc();
#pragma unroll
                for (int ks = 0; ks < 4; ++ks) { c0 = __builtin_amdgcn_mfma_f32_16x16x32_bf16(a[0][ks], b[ks], c0, 0, 0, 0); c1 = __builtin_amdgcn_mfma_f32_16x16x32_bf16(a[1][ks], b[ks], c1, 0, 0, 0); MFMA_SETTLE(c0); MFMA_SETTLE(c1); }
                MFMA_SETTLE(c0); MFMA_SETTLE(c1);
#pragma unroll
                for (int e = 0; e < 4; ++e) { sS[(32 * hf + 4 * q + e) * 130 + 16 * nt + r] = (_Float16)c0[e]; sS[(32 * hf + 16 + 4 * q + e) * 130 + 16 * nt + r] = (_Float16)c1[e]; }
            }
        }
        LDS_WAIT(); asm volatile("" ::: "memory");
        unsigned k1[16];
#pragma unroll
        for (int i = 0; i < 16; ++i) k1[i] = 0u;
        const LAS h2v* lp = (const LAS h2v*)(sS + lane * 130);
        for (int e = 0; e < 128; e += 8) {
#pragma unroll
            for (int u = 0; u < 4; ++u) { const h2v x2 = lp[(e >> 1) + u];
                KEY_INS(k1, (mono_key((float)x2[0]) & ~127u) | (unsigned)(127 - e - 2 * u)); KEY_INS(k1, (mono_key((float)x2[1]) & ~127u) | (unsigned)(126 - e - 2 * u)); }
        }
        const bool h0 = lane < 32;
        float v1[16], v2[16]; int ids[16]; float vals[16];
#pragma unroll
        for (int i = 0; i < 16; ++i) { ids[i] = 127 - (int)(k1[i] & 127u); vals[i] = (float)sS[lane * 130 + ids[i]]; }
        LDS_WAIT(); asm volatile("" ::: "memory");
#pragma unroll
        for (int i = 0; i < 16; ++i) { const float ov = __shfl_xor(vals[i], 32); const int oi = __shfl_xor(ids[i], 32);
            v1[i] = h0 ? vals[i] : ov; v2[i] = h0 ? ov : vals[i]; const int ia = h0 ? ids[i] : oi, ib = h0 ? oi : ids[i];
            sV1[i * 64 + lane] = v1[i]; sV2[i * 64 + lane] = v2[i]; sI[i * 64 + lane] = ia | (ib << 8); }
        unsigned k2[16];
#pragma unroll
        for (int b = 0; b < 16; ++b) k2[b] = (mono_key(v1[0] + v2[b]) & ~255u) | (unsigned)(255 - b);
#pragma unroll
        for (int a = 1; a < 16; ++a)
#pragma unroll
            for (int b = 0; b < 16; ++b)
                if ((a + 1) * (b + 1) <= 16) KEY_INS(k2, (mono_key(v1[a] + v2[b]) & ~255u) | (unsigned)(255 - (a * 16 + b)));
        LDS_WAIT(); asm volatile("" ::: "memory");
        float ts[16]; int te[16]; float mx = -__builtin_inff();
#pragma unroll
        for (int i = 0; i < 16; ++i) { const int code = 255 - (int)(k2[i] & 255u), a = code >> 4, b = code & 15;
            ts[i] = sV1[a * 64 + lane] + sV2[b * 64 + lane]; te[i] = (sI[a * 64 + lane] & 0xff) * 128 + (sI[b * 64 + lane] >> 8); mx = fmaxf(mx, ts[i]); }
        float sum = 0.f;
#pragma unroll
        for (int i = 0; i < 16; ++i) { ts[i] = __expf(ts[i] - mx); sum += ts[i]; }
        const float inv = 1.f / sum;
        __syncthreads();
        if (h0) {
#pragma unroll
            for (int i = 0; i < 16; ++i) { sE[lane * 128 + wave * 16 + i] = te[i]; sGt[lane * 128 + wave * 16 + i] = ts[i] * inv; } }
        __syncthreads();
        for (int k = 0; k < 4; ++k) {
            const int tl = wave * 4 + k; const size_t tt = (size_t)t0 + tl;
            if (layer == 0) { u4v* row = (u4v*)(G + tt * PE); const u4v z = {0u, 0u, 0u, 0u};
#pragma unroll 8
                for (int j = 0; j < 16; ++j) row[j * 64 + lane] = z; }
            const int e0 = sE[tl * 128 + lane], e1 = sE[tl * 128 + 64 + lane]; float t0s = sGt[tl * 128 + lane], t1s = sGt[tl * 128 + 64 + lane];
#pragma unroll
            for (int j = 0; j < 8; ++j) bm[j * 64 + lane] = 0u;
            if (lane == 0) *cnt = 0u;
            LDS_WAIT(); asm volatile("" ::: "memory");
            const unsigned b0 = 1u << (e0 & 31), b1 = 1u << (e1 & 31);
            const bool d0 = (__hip_atomic_fetch_or(bm + (e0 >> 5), b0, __ATOMIC_RELAXED, __HIP_MEMORY_SCOPE_WORKGROUP) & b0) != 0u;
            const bool d1 = (__hip_atomic_fetch_or(bm + (e1 >> 5), b1, __ATOMIC_RELAXED, __HIP_MEMORY_SCOPE_WORKGROUP) & b1) != 0u;
            if (d0) { const unsigned sl = __hip_atomic_fetch_add(cnt, 1u, __ATOMIC_RELAXED, __HIP_MEMORY_SCOPE_WORKGROUP); le[sl] = e0; lg[sl] = t0s; }
            if (d1) { const unsigned sl = __hip_atomic_fetch_add(cnt, 1u, __ATOMIC_RELAXED, __HIP_MEMORY_SCOPE_WORKGROUP); le[sl] = e1; lg[sl] = t1s; }
            LDS_WAIT(); asm volatile("" ::: "memory");
            const int nd = (int)__builtin_amdgcn_readfirstlane((int)*cnt);
            for (int j = 0; j < nd; ++j) { const int ej = le[j]; const float gj = lg[j]; if (ej == e0 && !d0) t0s += gj; if (ej == e1 && !d1) t1s += gj; }
            const bool f0 = !d0, f1 = !d1;
            VM_WAIT();
            if (f0) G[tt * PE + e0] = gate_code(t0s);
            if (f1) G[tt * PE + e1] = gate_code(t1s);
        }
        __syncthreads();
    }
}

constexpr int KIND_V = F8_KVQ ? 2 : 1;
__device__ __forceinline__ void p_headprep(const Ctx& C, const Ptrs& P) {
    unsigned char* ws = P.ws_(); const bfr* KVQ = (const bfr*)(ws + WS_BIG); bfr* Qh = (bfr*)(ws + WS_R + R_QH); bfr* Kh = (bfr*)(ws + WS_R + R_KH); bfr* Vh = (bfr*)(ws + WS_R + R_VH);
    const float* kg = P.in_(10); const float* qg = P.in_(13);
    const size_t gt = (size_t)C.vcu * 512 + C.tid, GT = (size_t)C.G * 512;
    constexpr int NV16 = F8_KVQ ? 1024 : 1536;
    for (size_t idx0 = gt; idx0 < (size_t)NT * NV16; idx0 += 4 * GT) {
        u4v x8[4];
#pragma unroll
        for (int b4 = 0; b4 < 4; ++b4) { const size_t idx = idx0 + b4 * GT; const size_t t = idx / NV16; const int rem = (int)(idx - t * NV16), vec = rem >> 4, i = rem & 15;
            x8[b4] = *(const u4v*)(KVQ + t * 12288 + vec * 128 + 8 * i); }
#pragma unroll
        for (int b4 = 0; b4 < 4; ++b4) { const size_t idx = idx0 + b4 * GT; const size_t t = idx / NV16; const int rem = (int)(idx - t * NV16), vec = rem >> 4, i = rem & 15, kind = vec >> 5, sh = vec & 31;
            float x[8] = {bflo(x8[b4].x), bfhi(x8[b4].x), bflo(x8[b4].y), bfhi(x8[b4].y), bflo(x8[b4].z), bfhi(x8[b4].z), bflo(x8[b4].w), bfhi(x8[b4].w)};
            float ss = 0.f;
#pragma unroll
            for (int k = 0; k < 8; ++k) ss += x[k] * x[k];
            ss += __shfl_xor(ss, 1); ss += __shfl_xor(ss, 2); ss += __shfl_xor(ss, 4); ss += __shfl_xor(ss, 8);
            u4v w = x8[b4];
            if (kind != KIND_V) { const float rn = __builtin_amdgcn_rsqf(ss * (1.f / 128.f) + EPS); const float* gp = (kind == 0 ? kg : qg) + 8 * i; const f4v g0 = *(const f4v*)gp, g1 = *(const f4v*)(gp + 4);
                w.x = cvtpk(x[0] * rn * g0[0], x[1] * rn * g0[1]); w.y = cvtpk(x[2] * rn * g0[2], x[3] * rn * g0[3]); w.z = cvtpk(x[4] * rn * g1[0], x[5] * rn * g1[1]); w.w = cvtpk(x[6] * rn * g1[2], x[7] * rn * g1[3]); }
            const size_t b = t >> 12, s = t & 4095; bfr* dst = (kind == 0 ? Kh : (kind == KIND_V ? Vh : Qh)) + ((b * 32 + sh) * SEQ + s) * 128 + 8 * i;
            *(u4v*)dst = w; }
    }
}

__device__ __forceinline__ att::BlockRef<att::bf16, att::bf16> attn_ref(const att::bf16* Qh, const att::bf16* Kh, const att::bf16* Vh, att::bf16* Oh, int bhp, int qb) {
    const int b = bhp >> 6, hd = (bhp >> 2) & 15, c = (bhp >> 1) & 1, vh = bhp & 1;
    att::BlockRef<att::bf16, att::bf16> r;
    r.Q = Qh + ((size_t)(b * 32 + hd * 2 + c) * SEQ + (size_t)qb * 256) * 128; r.K = Kh + (size_t)(b * 32 + hd * 2 + c) * SEQ * 128; r.V = att::VSTR == 128 ? Vh + (size_t)(b * 32 + hd * 2 + vh) * SEQ * 128 : Vh + (size_t)b * SEQ * att::VSTR + 8192 + (hd * 2 + vh) * 128;
    r.O = Oh + ((size_t)bhp * SEQ + (size_t)qb * 256) * 128; r.P0 = qb * 256;
    return r;
}
__device__ __forceinline__ void p_attn(const Ctx& C, const Ptrs& P) {
    unsigned char* ws = P.ws_(); const att::bf16* Qh = (const att::bf16*)(ws + WS_R + R_QH); const att::bf16* Kh = (const att::bf16*)(ws + WS_R + R_KH); const att::bf16* Vh = (const att::bf16*)(att::VSTR == 128 ? ws + WS_R + R_VH : ws + WS_BIG);
    att::bf16* Oh = (att::bf16*)(ws + WS_R + R_OH);
    extern __shared__ __attribute__((aligned(16))) char lds_sym[]; char* lds = lds_sym;
    constexpr int total = 128 * 8;
    int L = C.vcu; if (L >= total) return;
    int pass = 0;
    att::BlockRef<att::bf16, att::bf16> cur = attn_ref(Qh, Kh, Vh, Oh, L >> 3, L & 7);
    att::Seam<att::bf16> S;
    att::causal_swa_prime<att::bf16, att::bf16>(cur, SEQ, lds, S);
    for (;;) {
        const bool more_pass = pass == 0, more_item = L + C.G < total, last = !more_pass && !more_item;
        int passn = pass + 1, Ln = L;
        if (!more_pass) { passn = 0; Ln = more_item ? L + C.G : L; }
        const att::BlockRef<att::bf16, att::bf16> nxt = last ? cur : attn_ref(Qh, Kh, Vh, Oh, Ln >> 3, passn ? 15 - (Ln & 7) : (Ln & 7));
        att::causal_swa_block<att::bf16, att::bf16>(cur, nxt, SEQ, SEQ, lds, S);
        if (last) break;
        cur = nxt; pass = passn; L = Ln;
    }
    __syncthreads();
}

__device__ __forceinline__ void p_combine(const Ctx& C, const Ptrs& P) {
    unsigned char* ws = P.ws_(); const bfr* Oh = (const bfr*)(ws + WS_R + R_OH); bfr* AO = (bfr*)(ws + WS_XN); const float* sg = P.in_(18);
    float lam;
    { const float* q1 = P.in_(14); const float* k1 = P.in_(15); const float* q2 = P.in_(16); const float* k2 = P.in_(17); const int l = C.lane;
      const float d1 = wave_sum(q1[l] * k1[l] + q1[l + 64] * k1[l + 64]), d2 = wave_sum(q2[l] * k2[l] + q2[l + 64] * k2[l + 64]);
      lam = expf(d1) - expf(d2) + LAMBDA_INIT; }
    const size_t gt = (size_t)C.vcu * 512 + C.tid, GT = (size_t)C.G * 512;
    for (size_t idx0 = gt; idx0 < (size_t)NT * 512; idx0 += 4 * GT) {
        u4v a8[4], b8[4];
#pragma unroll
        for (int b4 = 0; b4 < 4; ++b4) { const size_t idx = idx0 + b4 * GT; const size_t t = idx >> 9, b = t >> 12, s = t & 4095; const int hd = (int)(idx >> 5) & 15, i = (int)idx & 31, vh = i >> 4, d = (8 * i) & 127;
            const size_t o0i = ((((b * 16 + hd) * 2 + 0) * 2 + vh) * SEQ + s) * 128 + d, o1i = ((((b * 16 + hd) * 2 + 1) * 2 + vh) * SEQ + s) * 128 + d;
            a8[b4] = *(const u4v*)(Oh + o0i); b8[b4] = *(const u4v*)(Oh + o1i); }
        const int i = (int)idx0 & 31;
        const f4v g0 = *(const f4v*)(sg + 8 * i), g1 = *(const f4v*)(sg + 8 * i + 4);
#pragma unroll
        for (int b4 = 0; b4 < 4; ++b4) { const size_t idx = idx0 + b4 * GT; const size_t t = idx >> 9; const int hd = (int)(idx >> 5) & 15;
            float o[8] = {bflo(a8[b4].x) - lam * bflo(b8[b4].x), bfhi(a8[b4].x) - lam * bfhi(b8[b4].x), bflo(a8[b4].y) - lam * bflo(b8[b4].y), bfhi(a8[b4].y) - lam * bfhi(b8[b4].y),
                          bflo(a8[b4].z) - lam * bflo(b8[b4].z), bfhi(a8[b4].z) - lam * bfhi(b8[b4].z), bflo(a8[b4].w) - lam * bflo(b8[b4].w), bfhi(a8[b4].w) - lam * bfhi(b8[b4].w)};
            float ss = 0.f;
#pragma unroll
            for (int k = 0; k < 8; ++k) ss += o[k] * o[k];
            ss += __shfl_xor(ss, 1); ss += __shfl_xor(ss, 2); ss += __shfl_xor(ss, 4); ss += __shfl_xor(ss, 8); ss += __shfl_xor(ss, 16);
            const float rn = __builtin_amdgcn_rsqf(ss * (1.f / 256.f) + EPS) * (1.f - LAMBDA_INIT);
#if F8_OUT1
            const float rs = rn * SO; float y[8] = {o[0] * rs * g0[0], o[1] * rs * g0[1], o[2] * rs * g0[2], o[3] * rs * g0[3], o[4] * rs * g1[0], o[5] * rs * g1[1], o[6] * rs * g1[2], o[7] * rs * g1[3]};
#pragma unroll
            for (int k = 0; k < 8; ++k) y[k] = fminf(fmaxf(y[k], -440.f), 440.f);
            u2v w; w.x = cvt4_fp8(y[0], y[1], y[2], y[3]); w.y = cvt4_fp8(y[4], y[5], y[6], y[7]);
            *(u2v*)(ws + WS_XN8 + t * DM + hd * 256 + 8 * i) = w; }
#else
            u4v w; w.x = cvtpk(o[0] * rn * g0[0], o[1] * rn * g0[1]); w.y = cvtpk(o[2] * rn * g0[2], o[3] * rn * g0[3]); w.z = cvtpk(o[4] * rn * g1[0], o[5] * rn * g1[1]); w.w = cvtpk(o[6] * rn * g1[2], o[7] * rn * g1[3]);
            *(u4v*)(AO + t * DM + hd * 256 + 8 * i) = w; }
#endif
    }
}
constexpr int NPH_LAYER = 13, NPHASE = 1 + 2 * NPH_LAYER;
#ifndef MK_PER_PHASE
#define MK_PER_PHASE 0
#endif

__global__ void __launch_bounds__(512, 2) trunk_fwd(KArgs KA) {
    extern __shared__ __attribute__((aligned(16))) unsigned char lds_raw[];
    Ctx C; C.lds = (LAS unsigned char*)lds_raw; C.tid = threadIdx.x; C.lane = C.tid & 63; C.wave = __builtin_amdgcn_readfirstlane(C.tid >> 6);
    C.G = gridDim.x; { const int bx = blockIdx.x; C.vcu = (C.G % 8 == 0) ? (bx % 8) * (C.G / 8) + bx / 8 : bx; }
    volatile LAS unsigned* MISC = (volatile LAS unsigned*)(C.lds + MISC_OFF);
    for (int u = C.tid; u < (LDS_BYTES - MISC_OFF) / 4; u += 512) MISC[u] = 0u;
    __syncthreads();
    Ptrs P; P.tbl = (LAS unsigned long long*)(C.lds + MISC_OFF + 128);
    if (C.tid < 28) P.tbl[C.tid] = ((const unsigned long long*)&KA)[C.tid];
    __syncthreads();
    unsigned* ctl = (unsigned*)(P.ws_() + WS_CTL);
    const int lo = KA.ph_lo, hi = KA.ph_hi;
    XcdBarrier bar; bar.bar = ctl + CW_BAR + KA.li * XCD_BAR_WORDS; bar.x = 0; bar.st = MISC + 8;
    if (hi - lo > 1) bar = xcd_barrier_post(ctl + CW_BAR + KA.li * XCD_BAR_WORDS, MISC + 8);
#define IN(k) (lo <= (k) && (k) < hi)
#define SEAM(k) do { if (IN(k) && IN((k) + 1)) xcd_barrier(bar); } while (0)
    unsigned char* ws = P.ws_();
    bfr* XN = (bfr*)(ws + WS_XN); bfr* BIG = (bfr*)(ws + WS_BIG);
    const int hb = (int)blockIdx.x;

    if (IN(0)) { p_convert(C, P); __syncthreads();
        p_norm_rows(C, P.in_(0), XN, F8_PROJ0 != 0 ? ws + WS_XN8 : nullptr); }
    SEAM(0);
    {
        constexpr int layer = 0;
        const int pb = 1 + layer * NPH_LAYER;
        if (layer == 1 && IN(pb + 0)) p_norm_rows(C, (const float*)P.out_(), F8_KVQ == 2 ? nullptr : XN, F8_KVQ != 0 ? ws + WS_XN8 : nullptr);
        if (layer == 1) SEAM(pb + 0);
        if (IN(pb + 1)) {
            const int N = layer == 0 ? 16384 : 12288;
            if (layer == 0 && F8_PROJ0 == 2) {
                { pg8::Gemm g{XN, (const bfr*)(ws + WS_WTIN), NT, 8192, DM}; pg8::StaticOrder S; S.init(NT, 8192, C.G, hb);
                  pg8::EpiBf16<0> E{BIG, N, nullptr, 0, 0, 1.f};
                  pg8::gemm_phase<pg8::EpiBf16<0>, pg8::StaticOrder, true, true>((PG8_LAS unsigned char*)C.lds, g, S, E); }
                __syncthreads();
                { pg8::Gemm g{(const bfr*)(ws + WS_XN8), (const bfr*)(ws + WS_WTIN + (size_t)8192 * DM * 2), NT, 8192, DM / 2}; pg8::StaticOrder S; S.init(NT, 8192, C.G, hb);
                  pg8::EpiBf16<0> E{BIG + 8192, N, nullptr, 8192, 0, 1.f / SU};
                  pg8::gemm_phase<pg8::EpiBf16<0>, pg8::StaticOrder, true, true, true>((PG8_LAS unsigned char*)C.lds, g, S, E); }
            } else if (layer == 0 && F8_PROJ0 == 5) {
                { pg8::Gemm g{(const bfr*)(ws + WS_XN8), (const bfr*)(ws + WS_WTIN), NT, 8192, DM / 2}; pg8::StaticOrder S; S.init(NT, 8192, C.G, hb);
                  pg8::EpiBf16<0> E{BIG, N, nullptr, 8192, 0, 1.f / SU};
                  pg8::gemm_phase<pg8::EpiBf16<0>, pg8::StaticOrder, true, true, true>((PG8_LAS unsigned char*)C.lds, g, S, E); }
                __syncthreads();
                { pg8::Gemm g{XN, (const bfr*)(ws + WS_WTIN + (size_t)32 * MiB), NT, 4096, DM}; pg8::StaticOrder S; S.init(NT, 4096, C.G, hb);
                  pg8::EpiBf16<0> E{BIG + 8192, N, nullptr, 0, 0, 1.f};
                  pg8::gemm_phase<pg8::EpiBf16<0>, pg8::StaticOrder, true, true>((PG8_LAS unsigned char*)C.lds, g, S, E); }
                __syncthreads();
                { pg8::Gemm g{(const bfr*)(ws + WS_XN8), (const bfr*)(ws + WS_WTIN + (size_t)64 * MiB), NT, 4096, DM / 2}; pg8::StaticOrder S; S.init(NT, 4096, C.G, hb);
                  pg8::EpiBf16<0> E{BIG + 12288, N, nullptr, 4096, 0, 1.f / SU};
                  pg8::gemm_phase<pg8::EpiBf16<0>, pg8::StaticOrder, true, true, true>((PG8_LAS unsigned char*)C.lds, g, S, E); }
            } else if (layer == 0 && F8_PROJ0 == 6) {
                { pg8::Gemm g{(const bfr*)(ws + WS_XN8), (const bfr*)(ws + WS_WTIN), NT, 12288, DM / 2}; pg8::StaticOrder S; S.init(NT, 12288, C.G, hb);
                  pg8::EpiBf16<0> E{BIG, N, nullptr, 12288, 0, 1.f / SU};
                  pg8::gemm_phase<pg8::EpiBf16<0>, pg8::StaticOrder, true, true, true>((PG8_LAS unsigned char*)C.lds, g, S, E); }
                __syncthreads();
                { pg8::Gemm g{XN, (const bfr*)(ws + WS_WTIN + (size_t)48 * MiB), NT, 4096, DM}; pg8::StaticOrder S; S.init(NT, 4096, C.G, hb);
                  pg8::EpiBf16<0> E{BIG + 12288, N, nullptr, 0, 0, 1.f};
                  pg8::gemm_phase<pg8::EpiBf16<0>, pg8::StaticOrder, true, true>((PG8_LAS unsigned char*)C.lds, g, S, E); }
            } else if (layer == 0 && F8_PROJ0 == 4) {
                { pg8::Gemm g{(const bfr*)(ws + WS_XN8), (const bfr*)(ws + WS_WTIN), NT, 4096, DM / 2}; pg8::StaticOrder S; S.init(NT, 4096, C.G, hb);
                  pg8::EpiBf16<0> E{BIG, N, nullptr, 4096, 0, 1.f / SU};
                  pg8::gemm_phase<pg8::EpiBf16<0>, pg8::StaticOrder, true, true, true>((PG8_LAS unsigned char*)C.lds, g, S, E); }
                __syncthreads();
                { pg8::Gemm g{XN, (const bfr*)(ws + WS_WTIN + (size_t)4096 * DM), NT, 12288, DM}; pg8::StaticOrder S; S.init(NT, 12288, C.G, hb);
                  pg8::EpiBf16<0> E{BIG + 4096, N, nullptr, 0, 0, 1.f};
                  pg8::gemm_phase<pg8::EpiBf16<0>, pg8::StaticOrder, true, true>((PG8_LAS unsigned char*)C.lds, g, S, E); }
            } else if (layer == 0 && F8_PROJ0 == 3) {
                { pg8::Gemm g{(const bfr*)(ws + WS_XN8), (const bfr*)(ws + WS_WTIN), NT, 8192, DM / 2}; pg8::StaticOrder S; S.init(NT, 8192, C.G, hb);
                  pg8::EpiBf16<0> E{BIG, N, nullptr, 8192, 0, 1.f / SU};
                  pg8::gemm_phase<pg8::EpiBf16<0>, pg8::StaticOrder, true, true, true>((PG8_LAS unsigned char*)C.lds, g, S, E); }
                __syncthreads();
                { pg8::Gemm g{XN, (const bfr*)(ws + WS_WTIN + (size_t)8192 * DM), NT, 8192, DM}; pg8::StaticOrder S; S.init(NT, 8192, C.G, hb);
                  pg8::EpiBf16<0> E{BIG + 8192, N, nullptr, 0, 0, 1.f};
                  pg8::gemm_phase<pg8::EpiBf16<0>, pg8::StaticOrder, true, true>((PG8_LAS unsigned char*)C.lds, g, S, E); }
            } else if (layer == 0 && F8_PROJ0 == 1) {
                pg8::Gemm g{(const bfr*)(ws + WS_XN8), (const bfr*)(ws + WS_WTIN), NT, N, DM / 2}; pg8::StaticOrder S; S.init(NT, N, C.G, hb);
                pg8::EpiBf16<0> E{BIG, N, nullptr, N, 0, 1.f / SU};
                pg8::gemm_phase<pg8::EpiBf16<0>, pg8::StaticOrder, true, true, true>((PG8_LAS unsigned char*)C.lds, g, S, E);
            } else if (layer == 1 && F8_KVQ == 2) {
                pg8::Gemm g{(const bfr*)(ws + WS_XN8), (const bfr*)(ws + WS_WTKVQ), NT, N, DM / 2}; pg8::StaticOrder S; S.init(NT, N, C.G, hb);
                pg8::EpiHead E{(bfr*)(ws + WS_R + R_KH), (bfr*)(ws + WS_R + R_QH), BIG, P.in_(10), P.in_(13), 1.f / SU, N};
                pg8::gemm_phase<pg8::EpiHead, pg8::StaticOrder, true, true, true>((PG8_LAS unsigned char*)C.lds, g, S, E);
            } else if (layer == 1 && F8_KVQ) {
                { pg8::Gemm g{(const bfr*)(ws + WS_XN8), (const bfr*)(ws + WS_WTKVQ), NT, 8192, DM / 2}; pg8::StaticOrder S; S.init(NT, 8192, C.G, hb);
                  pg8::EpiBf16<0> E{BIG, N, nullptr, 8192, 0, 1.f / SU};
                  pg8::gemm_phase<pg8::EpiBf16<0>, pg8::StaticOrder, true, true, true>((PG8_LAS unsigned char*)C.lds, g, S, E); }
                __syncthreads();
                { pg8::Gemm g{XN, (const bfr*)(ws + WS_WTKVQ + (size_t)2 * DM * DM), NT, DM, DM}; pg8::StaticOrder S; S.init(NT, DM, C.G, hb);
                  pg8::EpiBf16<0> E{BIG + 8192, N, nullptr, 0, 0, 1.f};
                  pg8::gemm_phase<pg8::EpiBf16<0>, pg8::StaticOrder, true, true>((PG8_LAS unsigned char*)C.lds, g, S, E); }
            } else {
                pg8::Gemm g{XN, (const bfr*)(ws + (layer == 0 ? WS_WTIN : WS_WTKVQ)), NT, N, DM}; pg8::StaticOrder S; S.init(NT, N, C.G, hb);
                pg8::EpiBf16<0> E{BIG, N, nullptr, 0, 0, 1.f};
                pg8::gemm_phase<pg8::EpiBf16<0>, pg8::StaticOrder, true, true>((PG8_LAS unsigned char*)C.lds, g, S, E);
            }
            if (layer == 0) { __syncthreads(); p_bd(C, XN, (const bfr*)(ws + WS_WTBD), (float*)(ws + WS_BD));
#ifdef BD_PROBE
                __syncthreads(); p_bd(C, XN, (const bfr*)(ws + WS_WTBD), (float*)(ws + WS_BD));
#endif
            }
        }
        SEAM(pb + 1);
        if (IN(pb + 2)) { if (layer == 1 && F8_KVQ != 2) p_headprep(C, P); }
        if (layer == 1 && F8_KVQ != 2) SEAM(pb + 2);
        if (IN(pb + 3)) { if (layer == 0) p_gdn_prep(C, P); else p_attn(C, P); }
        SEAM(pb + 3);
        if (IN(pb + 4)) { if (layer == 0) p_gdn_scan(C, P); else p_combine(C, P); }
        SEAM(pb + 4);
        if (IN(pb + 5)) { if (layer == 0) p_gdn_onorm(C, P); }
        if (layer == 0) SEAM(pb + 5);
        if (IN(pb + 6)) {
            if ((layer == 0 && F8_OUT0) || (layer == 1 && F8_OUT1)) {
                pg8::Gemm g{(const bfr*)(ws + WS_XN8), (const bfr*)(ws + (layer == 0 ? WS_WTOUT : WS_WTO)), NT, DM, DM / 2}; pg8::StaticOrder S; S.init(NT, DM, C.G, hb);
                pg8::EpiRes E{layer == 0 ? P.in_(0) : (const float*)P.out_(), P.out_(), DM, 1.f / (SO * SU)};
                pg8::gemm_phase<pg8::EpiRes, pg8::StaticOrder, true, true, true>((PG8_LAS unsigned char*)C.lds, g, S, E);
            } else {
                pg8::Gemm g{XN, (const bfr*)(ws + (layer == 0 ? WS_WTOUT : WS_WTO)), NT, DM, DM}; pg8::StaticOrder S; S.init(NT, DM, C.G, hb);
                pg8::EpiRes E{layer == 0 ? P.in_(0) : (const float*)P.out_(), P.out_(), DM, 1.f};
                pg8::gemm_phase<pg8::EpiRes, pg8::StaticOrder, true, true>((PG8_LAS unsigned char*)C.lds, g, S, E);
            }
        }
        SEAM(pb + 6);
        if (IN(pb + 7)) p_norm_rows(C, (const float*)P.out_(), XN, ws + WS_XN8);
        SEAM(pb + 7);
        if (IN(pb + 8)) {
            pg8::Gemm g{XN, (const bfr*)(ws + WS_WTQRY) + (size_t)layer * PQ * DM, NT, PQ, DM}; pg8::StaticOrder S; S.init(NT, PQ, C.G, hb);
            pg8::EpiBf16<0> E{(bfr*)(ws + WS_QRY), PQ, nullptr, 0, 0, 1.f};
            pg8::gemm_phase<pg8::EpiBf16<0>, pg8::StaticOrder, true, true>((PG8_LAS unsigned char*)C.lds, g, S, E);
        }
        SEAM(pb + 8);
        if (IN(pb + 9)) { p_sroute(C, P, layer); }
        SEAM(pb + 9); if (IN(pb + 9) && !IN(pb + 10) && IN(pb + 11)) xcd_barrier(bar);
        if (IN(pb + 11)) {
            pg8::Gemm g{(const bfr*)(ws + WS_XN8), (const bfr*)(ws + WS_U + (size_t)layer * PE * DM), NT, PE, DM / 2}; pg8::StaticOrder S; S.init(NT, PE, C.G, hb);
#ifdef G1_PROBE
            if (layer == 0) { pg8::StaticOrder S2; S2.init(NT, PE, C.G, hb); pg8::EpiGate8<G1_PROBE> E2{(bfr*)(ws + WS_G), ws + WS_A2, PE, 1.f / SU, SA};
                pg8::gemm_phase<pg8::EpiGate8<G1_PROBE>, pg8::StaticOrder, true, true, true>((PG8_LAS unsigned char*)C.lds, g, S2, E2); __syncthreads(); }
#endif
#if STAGGER_G1
            {
                const int sg = C.vcu & 7;
                if (sg) { const unsigned long long t0 = __builtin_amdgcn_s_memrealtime(); while (__builtin_amdgcn_s_memrealtime() - t0 < (unsigned long long)(sg * STAGGER_G1)) __builtin_amdgcn_s_sleep(4); }
            }
#endif
            pg8::EpiGate8C E{ws + WS_G, ws + WS_A2, PE, 1.f / SU, SA};
            pg8::gemm_phase<pg8::EpiGate8C, pg8::StaticOrder, true, true, true>((PG8_LAS unsigned char*)C.lds, g, S, E);
        }
        SEAM(pb + 11);
        if (IN(pb + 12)) {
            pg8::Gemm g{(const bfr*)(ws + WS_A2), (const bfr*)(ws + WS_VT + (size_t)layer * DM * PE), NT, DM, PE / 2}; pg8::StaticOrder S; S.init(NT, DM, C.G, hb);
            pg8::EpiRes E{(const float*)P.out_(), P.out_(), DM, 1.f / (SA * SV)};
            pg8::gemm_phase<pg8::EpiRes, pg8::StaticOrder, true, true, true>((PG8_LAS unsigned char*)C.lds, g, S, E);
#ifdef G2_PROBE
            if (layer == 0) { __syncthreads(); pg8::StaticOrder S2; S2.init(NT, DM, C.G, hb); pg8::EpiRes E2{(const float*)P.out_(), P.out_(), DM, 0.f};
                pg8::gemm_phase<pg8::EpiRes, pg8::StaticOrder, true, true, true>((PG8_LAS unsigned char*)C.lds, g, S2, E2); }
#endif
        }
        SEAM(pb + 12);
    }
    {
        constexpr int layer = 1;
        const int pb = 1 + layer * NPH_LAYER;
        if (layer == 1 && IN(pb + 0)) p_norm_rows(C, (const float*)P.out_(), F8_KVQ == 2 ? nullptr : XN, F8_KVQ != 0 ? ws + WS_XN8 : nullptr);
        if (layer == 1) SEAM(pb + 0);
        if (IN(pb + 1)) {
            const int N = layer == 0 ? 16384 : 12288;
            if (layer == 0 && F8_PROJ0 == 2) {
                { pg8::Gemm g{XN, (const bfr*)(ws + WS_WTIN), NT, 8192, DM}; pg8::StaticOrder S; S.init(NT, 8192, C.G, hb);
                  pg8::EpiBf16<0> E{BIG, N, nullptr, 0, 0, 1.f};
                  pg8::gemm_phase<pg8::EpiBf16<0>, pg8::StaticOrder, true, true>((PG8_LAS unsigned char*)C.lds, g, S, E); }
                __syncthreads();
                { pg8::Gemm g{(const bfr*)(ws + WS_XN8), (const bfr*)(ws + WS_WTIN + (size_t)8192 * DM * 2), NT, 8192, DM / 2}; pg8::StaticOrder S; S.init(NT, 8192, C.G, hb);
                  pg8::EpiBf16<0> E{BIG + 8192, N, nullptr, 8192, 0, 1.f / SU};
                  pg8::gemm_phase<pg8::EpiBf16<0>, pg8::StaticOrder, true, true, true>((PG8_LAS unsigned char*)C.lds, g, S, E); }
            } else if (layer == 0 && F8_PROJ0 == 5) {
                { pg8::Gemm g{(const bfr*)(ws + WS_XN8), (const bfr*)(ws + WS_WTIN), NT, 8192, DM / 2}; pg8::StaticOrder S; S.init(NT, 8192, C.G, hb);
                  pg8::EpiBf16<0> E{BIG, N, nullptr, 8192, 0, 1.f / SU};
                  pg8::gemm_phase<pg8::EpiBf16<0>, pg8::StaticOrder, true, true, true>((PG8_LAS unsigned char*)C.lds, g, S, E); }
                __syncthreads();
                { pg8::Gemm g{XN, (const bfr*)(ws + WS_WTIN + (size_t)32 * MiB), NT, 4096, DM}; pg8::StaticOrder S; S.init(NT, 4096, C.G, hb);
                  pg8::EpiBf16<0> E{BIG + 8192, N, nullptr, 0, 0, 1.f};
                  pg8::gemm_phase<pg8::EpiBf16<0>, pg8::StaticOrder, true, true>((PG8_LAS unsigned char*)C.lds, g, S, E); }
                __syncthreads();
                { pg8::Gemm g{(const bfr*)(ws + WS_XN8), (const bfr*)(ws + WS_WTIN + (size_t)64 * MiB), NT, 4096, DM / 2}; pg8::StaticOrder S; S.init(NT, 4096, C.G, hb);
                  pg8::EpiBf16<0> E{BIG + 12288, N, nullptr, 4096, 0, 1.f / SU};
                  pg8::gemm_phase<pg8::EpiBf16<0>, pg8::StaticOrder, true, true, true>((PG8_LAS unsigned char*)C.lds, g, S, E); }
            } else if (layer == 0 && F8_PROJ0 == 6) {
                { pg8::Gemm g{(const bfr*)(ws + WS_XN8), (const bfr*)(ws + WS_WTIN), NT, 12288, DM / 2}; pg8::StaticOrder S; S.init(NT, 12288, C.G, hb);
                  pg8::EpiBf16<0> E{BIG, N, nullptr, 12288, 0, 1.f / SU};
                  pg8::gemm_phase<pg8::EpiBf16<0>, pg8::StaticOrder, true, true, true>((PG8_LAS unsigned char*)C.lds, g, S, E); }
                __syncthreads();
                { pg8::Gemm g{XN, (const bfr*)(ws + WS_WTIN + (size_t)48 * MiB), NT, 4096, DM}; pg8::StaticOrder S; S.init(NT, 4096, C.G, hb);
                  pg8::EpiBf16<0> E{BIG + 12288, N, nullptr, 0, 0, 1.f};
                  pg8::gemm_phase<pg8::EpiBf16<0>, pg8::StaticOrder, true, true>((PG8_LAS unsigned char*)C.lds, g, S, E); }
            } else if (layer == 0 && F8_PROJ0 == 4) {
                { pg8::Gemm g{(const bfr*)(ws + WS_XN8), (const bfr*)(ws + WS_WTIN), NT, 4096, DM / 2}; pg8::StaticOrder S; S.init(NT, 4096, C.G, hb);
                  pg8::EpiBf16<0> E{BIG, N, nullptr, 4096, 0, 1.f / SU};
                  pg8::gemm_phase<pg8::EpiBf16<0>, pg8::StaticOrder, true, true, true>((PG8_LAS unsigned char*)C.lds, g, S, E); }
                __syncthreads();
                { pg8::Gemm g{XN, (const bfr*)(ws + WS_WTIN + (size_t)4096 * DM), NT, 12288, DM}; pg8::StaticOrder S; S.init(NT, 12288, C.G, hb);
                  pg8::EpiBf16<0> E{BIG + 4096, N, nullptr, 0, 0, 1.f};
                  pg8::gemm_phase<pg8::EpiBf16<0>, pg8::StaticOrder, true, true>((PG8_LAS unsigned char*)C.lds, g, S, E); }
            } else if (layer == 0 && F8_PROJ0 == 3) {
                { pg8::Gemm g{(const bfr*)(ws + WS_XN8), (const bfr*)(ws + WS_WTIN), NT, 8192, DM / 2}; pg8::StaticOrder S; S.init(NT, 8192, C.G, hb);
                  pg8::EpiBf16<0> E{BIG, N, nullptr, 8192, 0, 1.f / SU};
                  pg8::gemm_phase<pg8::EpiBf16<0>, pg8::StaticOrder, true, true, true>((PG8_LAS unsigned char*)C.lds, g, S, E); }
                __syncthreads();
                { pg8::Gemm g{XN, (const bfr*)(ws + WS_WTIN + (size_t)8192 * DM), NT, 8192, DM}; pg8::StaticOrder S; S.init(NT, 8192, C.G, hb);
                  pg8::EpiBf16<0> E{BIG + 8192, N, nullptr, 0, 0, 1.f};
                  pg8::gemm_phase<pg8::EpiBf16<0>, pg8::StaticOrder, true, true>((PG8_LAS unsigned char*)C.lds, g, S, E); }
            } else if (layer == 0 && F8_PROJ0 == 1) {
                pg8::Gemm g{(const bfr*)(ws + WS_XN8), (const bfr*)(ws + WS_WTIN), NT, N, DM / 2}; pg8::StaticOrder S; S.init(NT, N, C.G, hb);
                pg8::EpiBf16<0> E{BIG, N, nullptr, N, 0, 1.f / SU};
                pg8::gemm_phase<pg8::EpiBf16<0>, pg8::StaticOrder, true, true, true>((PG8_LAS unsigned char*)C.lds, g, S, E);
            } else if (layer == 1 && F8_KVQ == 2) {
                pg8::Gemm g{(const bfr*)(ws + WS_XN8), (const bfr*)(ws + WS_WTKVQ), NT, N, DM / 2}; pg8::StaticOrder S; S.init(NT, N, C.G, hb);
                pg8::EpiHead E{(bfr*)(ws + WS_R + R_KH), (bfr*)(ws + WS_R + R_QH), BIG, P.in_(10), P.in_(13), 1.f / SU, N};
                pg8::gemm_phase<pg8::EpiHead, pg8::StaticOrder, true, true, true>((PG8_LAS unsigned char*)C.lds, g, S, E);
            } else if (layer == 1 && F8_KVQ) {
                { pg8::Gemm g{(const bfr*)(ws + WS_XN8), (const bfr*)(ws + WS_WTKVQ), NT, 8192, DM / 2}; pg8::StaticOrder S; S.init(NT, 8192, C.G, hb);
                  pg8::EpiBf16<0> E{BIG, N, nullptr, 8192, 0, 1.f / SU};
                  pg8::gemm_phase<pg8::EpiBf16<0>, pg8::StaticOrder, true, true, true>((PG8_LAS unsigned char*)C.lds, g, S, E); }
                __syncthreads();
                { pg8::Gemm g{XN, (const bfr*)(ws + WS_WTKVQ + (size_t)2 * DM * DM), NT, DM, DM}; pg8::StaticOrder S; S.init(NT, DM, C.G, hb);
                  pg8::EpiBf16<0> E{BIG + 8192, N, nullptr, 0, 0, 1.f};
                  pg8::gemm_phase<pg8::EpiBf16<0>, pg8::StaticOrder, true, true>((PG8_LAS unsigned char*)C.lds, g, S, E); }
            } else {
                pg8::Gemm g{XN, (const bfr*)(ws + (layer == 0 ? WS_WTIN : WS_WTKVQ)), NT, N, DM}; pg8::StaticOrder S; S.init(NT, N, C.G, hb);
                pg8::EpiBf16<0> E{BIG, N, nullptr, 0, 0, 1.f};
                pg8::gemm_phase<pg8::EpiBf16<0>, pg8::StaticOrder, true, true>((PG8_LAS unsigned char*)C.lds, g, S, E);
            }
            if (layer == 0) { __syncthreads(); p_bd(C, XN, (const bfr*)(ws + WS_WTBD), (float*)(ws + WS_BD));
#ifdef BD_PROBE
                __syncthreads(); p_bd(C, XN, (const bfr*)(ws + WS_WTBD), (float*)(ws + WS_BD));
#endif
            }
        }
        SEAM(pb + 1);
        if (IN(pb + 2)) { if (layer == 1 && F8_KVQ != 2) p_headprep(C, P); }
        if (layer == 1 && F8_KVQ != 2) SEAM(pb + 2);
        if (IN(pb + 3)) { if (layer == 0) p_gdn_prep(C, P); else p_attn(C, P); }
        SEAM(pb + 3);
        if (IN(pb + 4)) { if (layer == 0) p_gdn_scan(C, P); else p_combine(C, P); }
        SEAM(pb + 4);
        if (IN(pb + 5)) { if (layer == 0) p_gdn_onorm(C, P); }
        if (layer == 0) SEAM(pb + 5);
        if (IN(pb + 6)) {
            if ((layer == 0 && F8_OUT0) || (layer == 1 && F8_OUT1)) {
                pg8::Gemm g{(const bfr*)(ws + WS_XN8), (const bfr*)(ws + (layer == 0 ? WS_WTOUT : WS_WTO)), NT, DM, DM / 2}; pg8::StaticOrder S; S.init(NT, DM, C.G, hb);
                pg8::EpiRes E{layer == 0 ? P.in_(0) : (const float*)P.out_(), P.out_(), DM, 1.f / (SO * SU)};
                pg8::gemm_phase<pg8::EpiRes, pg8::StaticOrder, true, true, true>((PG8_LAS unsigned char*)C.lds, g, S, E);
            } else {
                pg8::Gemm g{XN, (const bfr*)(ws + (layer == 0 ? WS_WTOUT : WS_WTO)), NT, DM, DM}; pg8::StaticOrder S; S.init(NT, DM, C.G, hb);
                pg8::EpiRes E{layer == 0 ? P.in_(0) : (const float*)P.out_(), P.out_(), DM, 1.f};
                pg8::gemm_phase<pg8::EpiRes, pg8::StaticOrder, true, true>((PG8_LAS unsigned char*)C.lds, g, S, E);
            }
        }
        SEAM(pb + 6);
        if (IN(pb + 7)) p_norm_rows(C, (const float*)P.out_(), XN, ws + WS_XN8);
        SEAM(pb + 7);
        if (IN(pb + 8)) {
            pg8::Gemm g{XN, (const bfr*)(ws + WS_WTQRY) + (size_t)layer * PQ * DM, NT, PQ, DM}; pg8::StaticOrder S; S.init(NT, PQ, C.G, hb);
            pg8::EpiBf16<0> E{(bfr*)(ws + WS_QRY), PQ, nullptr, 0, 0, 1.f};
            pg8::gemm_phase<pg8::EpiBf16<0>, pg8::StaticOrder, true, true>((PG8_LAS unsigned char*)C.lds, g, S, E);
        }
        SEAM(pb + 8);
        if (IN(pb + 9)) { p_sroute(C, P, layer); }
        SEAM(pb + 9); if (IN(pb + 9) && !IN(pb + 10) && IN(pb + 11)) xcd_barrier(bar);
        if (IN(pb + 11)) {
            pg8::Gemm g{(const bfr*)(ws + WS_XN8), (const bfr*)(ws + WS_U + (size_t)layer * PE * DM), NT, PE, DM / 2}; pg8::StaticOrder S; S.init(NT, PE, C.G, hb);
#ifdef G1_PROBE
            if (layer == 0) { pg8::StaticOrder S2; S2.init(NT, PE, C.G, hb); pg8::EpiGate8<G1_PROBE> E2{(bfr*)(ws + WS_G), ws + WS_A2, PE, 1.f / SU, SA};
                pg8::gemm_phase<pg8::EpiGate8<G1_PROBE>, pg8::StaticOrder, true, true, true>((PG8_LAS unsigned char*)C.lds, g, S2, E2); __syncthreads(); }
#endif
#if STAGGER_G1
            {
                const int sg = C.vcu & 7;
                if (sg) { const unsigned long long t0 = __builtin_amdgcn_s_memrealtime(); while (__builtin_amdgcn_s_memrealtime() - t0 < (unsigned long long)(sg * STAGGER_G1)) __builtin_amdgcn_s_sleep(4); }
            }
#endif
            pg8::EpiGate8C E{ws + WS_G, ws + WS_A2, PE, 1.f / SU, SA};
            pg8::gemm_phase<pg8::EpiGate8C, pg8::StaticOrder, true, true, true>((PG8_LAS unsigned char*)C.lds, g, S, E);
        }
        SEAM(pb + 11);
        if (IN(pb + 12)) {
            pg8::Gemm g{(const bfr*)(ws + WS_A2), (const bfr*)(ws + WS_VT + (size_t)layer * DM * PE), NT, DM, PE / 2}; pg8::StaticOrder S; S.init(NT, DM, C.G, hb);
            pg8::EpiRes E{(const float*)P.out_(), P.out_(), DM, 1.f / (SA * SV)};
            pg8::gemm_phase<pg8::EpiRes, pg8::StaticOrder, true, true, true>((PG8_LAS unsigned char*)C.lds, g, S, E);
#ifdef G2_PROBE
            if (layer == 0) { __syncthreads(); pg8::StaticOrder S2; S2.init(NT, DM, C.G, hb); pg8::EpiRes E2{(const float*)P.out_(), P.out_(), DM, 0.f};
                pg8::gemm_phase<pg8::EpiRes, pg8::StaticOrder, true, true, true>((PG8_LAS unsigned char*)C.lds, g, S2, E2); }
#endif
        }
        SEAM(pb + 12);
    }
#undef IN
#undef SEAM
}

extern "C" void kernel_launch(void* const* d_in, const int* in_sizes, int n_in, void* d_out, int out_size, void* d_ws, size_t ws_size, hipStream_t stream) {
    static int grid = 0;
    if (grid == 0) {
        if (n_in != 26 || out_size != NT * DM || ws_size < WS_END) { fprintf(stderr, "kernel_launch: unexpected problem (n_in %d, out %d, ws %zu < %zu)\n", n_in, out_size, ws_size, (size_t)WS_END); grid = -1; return; }
        int dev = 0, cus = 0;
        if (hipGetDevice(&dev) != hipSuccess || hipDeviceGetAttribute(&cus, hipDeviceAttributeMultiprocessorCount, dev) != hipSuccess || cus <= 0) { grid = -1; return; }
        if (hipFuncSetAttribute((const void*)trunk_fwd, hipFuncAttributeMaxDynamicSharedMemorySize, LDS_BYTES) != hipSuccess) { fprintf(stderr, "kernel_launch: hipFuncSetAttribute failed\n"); grid = -1; return; }
        int per_cu = 0;
        if (hipOccupancyMaxActiveBlocksPerMultiprocessor(&per_cu, (const void*)trunk_fwd, 512, LDS_BYTES) != hipSuccess || per_cu < 1) { fprintf(stderr, "kernel_launch: occupancy query says %d blocks per CU\n", per_cu); }
        (void)hipGetLastError();
        grid = cus;
    }
    if (grid < 0) return;
    (void)in_sizes;
    if (hipMemsetAsync((char*)d_ws + WS_CTL, 0, CTL_ZERO_BYTES, stream) != hipSuccess) return;
    KArgs p{};
    for (int i = 0; i < 26; ++i) p.in[i] = (const float*)d_in[i];
    p.out = (float*)d_out; p.ws = (unsigned char*)d_ws;
#if MK_PER_PHASE
    for (int ph = 0; ph < NPHASE; ++ph) {
        if (ph == 1 + 5 + NPH_LAYER || ph == 1 + 10 || ph == 1 + 10 + NPH_LAYER) continue;
        p.ph_lo = ph; p.ph_hi = ph + 1; p.li = 0; p.pad = 0;
        hipLaunchKernelGGL(trunk_fwd, dim3(grid), dim3(512), LDS_BYTES, stream, p);
    }
#else
    p.ph_lo = 0; p.ph_hi = NPHASE; p.li = 0; p.pad = 0;
    hipLaunchKernelGGL(trunk_fwd, dim3(grid), dim3(512), LDS_BYTES, stream, p);
#endif
}
```

```cpp
#include <hip/hip_runtime.h>
#include <hip/hip_bf16.h>
#include <cstdio>
#include <cstdint>

#define LAS __attribute__((address_space(3)))
#define GAS __attribute__((address_space(1)))
typedef unsigned short bfr;
typedef short s8v __attribute__((ext_vector_type(8)));
typedef float f4v __attribute__((ext_vector_type(4)));
typedef unsigned u4v __attribute__((ext_vector_type(4)));
typedef unsigned u2v __attribute__((ext_vector_type(2)));
typedef int i4v __attribute__((ext_vector_type(4)));

#ifndef F8_PROJ0
#define F8_PROJ0 3
#endif
#ifndef F8_KVQ
#define F8_KVQ 2
#endif
#ifndef F8_OUT0
#define F8_OUT0 1
#endif
#ifndef F8_OUT1
#define F8_OUT1 1
#endif
#ifndef F8_OUT
#define F8_OUT (F8_OUT0 || F8_OUT1)
#endif
#ifndef STAGGER_G1
#define STAGGER_G1 0
#endif
#ifndef NPREP
#define NPREP 20
#endif
constexpr int NB = 2, SEQ = 4096, DM = 4096, NT = NB * SEQ;
constexpr int GH = 32, GD = 128, GIN = 16448, CH = 64, NCH = SEQ / CH;
constexpr int AH = 16, AD = 128, AV = 256;
constexpr int PH = 8, PK = 128, PE = 16384, PQ = 2048, PTOP = 16;
constexpr float EPS = 1e-6f;
constexpr float LAMBDA_INIT = 0.35550906759f;
constexpr float SU = 64.f, SA = 64.f, SV = 4.f, SO = 16.f;

constexpr size_t MiB = 1u << 20;
constexpr size_t WS_CTL   = 0;
constexpr size_t WS_WTIN  = 1 * MiB;
constexpr size_t WS_WTBD  = WS_WTIN + 128 * MiB;
constexpr size_t WS_WTOUT = WS_WTBD + 1 * MiB;
constexpr size_t WS_WTKVQ = WS_WTOUT + 32 * MiB;
constexpr size_t WS_WTO   = WS_WTKVQ + 96 * MiB;
constexpr size_t WS_WTQRY = WS_WTO + 32 * MiB;
constexpr size_t WS_WTKEY = WS_WTQRY + 32 * MiB;
constexpr size_t WS_U     = WS_WTKEY + 16 * MiB;
constexpr size_t WS_VT    = WS_U + 128 * MiB;
constexpr size_t WS_A2    = WS_VT + 128 * MiB;
constexpr size_t WS_XN8   = WS_A2 + 128 * MiB;
constexpr size_t WS_XN    = WS_XN8 + 32 * MiB;
constexpr size_t WS_BIG   = WS_XN + 64 * MiB;
constexpr size_t WS_R     = WS_BIG + 256 * MiB;
constexpr size_t WS_QRY   = WS_R + 352 * MiB;
constexpr size_t WS_SC    = WS_QRY + 32 * MiB;
constexpr size_t WS_BD    = WS_SC + 64 * MiB;
constexpr size_t WS_EG    = WS_BD + 2 * MiB;
constexpr size_t WS_G     = WS_EG + 1 * MiB;
constexpr size_t WS_END   = WS_G + 256 * MiB;
constexpr size_t R_W = 0, R_U = 64 * MiB, R_QG = 128 * MiB, R_KD = 192 * MiB, R_QK = 256 * MiB, R_O = 288 * MiB;
constexpr size_t R_QH = 0, R_KH = 64 * MiB, R_VH = 128 * MiB, R_OH = 192 * MiB;
static_assert(WS_END <= (size_t)1790 * MiB, "workspace map");

constexpr int CW_BAR = 4096;
constexpr size_t CTL_ZERO_BYTES = 1 * MiB;

constexpr int LDS_BYTES = 147456;
constexpr int MISC_OFF = 146944;

typedef float f2v_ __attribute__((ext_vector_type(2)));
typedef __bf16 b2v_ __attribute__((ext_vector_type(2)));
__device__ __forceinline__ unsigned cvtpk(float lo, float hi) { const b2v_ r = __builtin_convertvector((f2v_){lo, hi}, b2v_); return __builtin_bit_cast(unsigned, r); }
__device__ __forceinline__ unsigned cvt4_fp8(float a, float b, float c, float d) { int w = 0; w = __builtin_amdgcn_cvt_pk_fp8_f32(a, b, w, false); w = __builtin_amdgcn_cvt_pk_fp8_f32(c, d, w, true); return (unsigned)w; }
__device__ __forceinline__ float bflo(unsigned w) { return __uint_as_float(w << 16); }
__device__ __forceinline__ float bfhi(unsigned w) { return __uint_as_float(w & 0xffff0000u); }
__device__ __forceinline__ float bf1(bfr b) { return __uint_as_float(((unsigned)b) << 16); }
__device__ __forceinline__ bfr f2bf1(float f) { return (bfr)(cvtpk(f, 0.f) & 0xffffu); }
__device__ __forceinline__ float wave_sum(float v) {
#pragma unroll
    for (int o = 1; o < 64; o <<= 1) v += __shfl_xor(v, o);
    return v;
}
__device__ __forceinline__ f4v zero_acc() { f4v z = {0.f, 0.f, 0.f, 0.f}; asm volatile("" : "+v"(z)); return z; }
#define MFMA_SETTLE(acc) asm volatile("s_nop 7\n\ts_nop 7" : "+v"(acc))
#define LDS_WAIT() asm volatile("s_waitcnt lgkmcnt(0)" ::: "memory")
#define VM_WAIT() asm volatile("s_waitcnt vmcnt(0)" ::: "memory")
#define XB_TMO      128
#define XB_XCNT(j)  (256  + 64 * (j))
#define XB_XSUB(j)  (1280 + 64 * (j))
#define XB_XGEN(j)  (2304 + 64 * (j))
#define XB_TOP      3328
#define XB_TOPGEN   3392
#define XCD_BAR_WORDS 3456
#define XB_SPIN_CAP (1u << 18)

__device__ __forceinline__ unsigned xb_ld(unsigned* p)              { return __hip_atomic_load(p, __ATOMIC_RELAXED, __HIP_MEMORY_SCOPE_AGENT); }
__device__ __forceinline__ unsigned xb_add(unsigned* p, unsigned v) { return __hip_atomic_fetch_add(p, v, __ATOMIC_RELAXED, __HIP_MEMORY_SCOPE_AGENT); }
__device__ __forceinline__ unsigned xb_xcc_id() { return (unsigned)__builtin_amdgcn_s_getreg((3 << 11) | 20) & 0xFu; }
#define XB_SPIN(cond, bar) do { unsigned _sp = 0; while (cond) { __builtin_amdgcn_s_sleep(1); \
    if ((++_sp & 255u) == 0u) { if (xb_ld(&(bar)[XB_TMO])) break; if (_sp > XB_SPIN_CAP) { atomicAdd(&(bar)[XB_TMO], 1u); break; } } } } while (0)

struct XcdBarrier {
    unsigned* bar; unsigned x;
    volatile LAS unsigned* st;
};

__device__ __forceinline__ XcdBarrier xcd_barrier_post(unsigned* bar, volatile LAS unsigned* st) {
    XcdBarrier b; b.bar = bar; b.x = xb_xcc_id(); b.st = st;
    if (threadIdx.x == 0) (void)xb_add(&bar[XB_XCNT(b.x)], 1u);
    return b;
}
__device__ __forceinline__ void xcd_barrier_complete(unsigned* bar, unsigned x, unsigned& nloc, unsigned& nx) {
    const unsigned G = gridDim.x * gridDim.y * gridDim.z;
    unsigned sum, cnt, mine, sp = 0u;
    for (;;) {
        sum = 0u; cnt = 0u; mine = 0u;
#pragma unroll
        for (unsigned j = 0; j < 16; ++j) { const unsigned c = xb_ld(&bar[XB_XCNT(j)]); sum += c; cnt += (c > 0u) ? 1u : 0u; mine = (j == x) ? c : mine; }
        if (sum == G) break;
        __builtin_amdgcn_s_sleep(1);
        if ((++sp & 255u) == 0u) { if (xb_ld(&bar[XB_TMO])) break; if (sp > XB_SPIN_CAP) { atomicAdd(&bar[XB_TMO], 1u); break; } }
    }
    nloc = mine > 0u ? mine : 1u; nx = cnt > 0u ? cnt : 1u;
}

__device__ __forceinline__ void xcd_barrier(const XcdBarrier& b) {
    asm volatile("s_waitcnt vmcnt(0)" ::: "memory");
    __syncthreads();
    if (threadIdx.x == 0) {
        unsigned* bar = b.bar;
        __builtin_amdgcn_s_waitcnt(0);
        unsigned nloc = b.st[0], nx = b.st[1];
        if (nloc == 0u) { xcd_barrier_complete(bar, b.x, nloc, nx); b.st[0] = nloc; b.st[1] = nx; }
        const unsigned old = xb_add(&bar[XB_XSUB(b.x)], 1u);
        const unsigned gen = old / nloc;
        if (old + 1u == (gen + 1u) * nloc) {
            __builtin_amdgcn_fence(__ATOMIC_RELEASE, "agent");
            asm volatile("s_waitcnt vmcnt(0)" ::: "memory");
            const unsigned og = xb_add(&bar[XB_TOP], 1u);
            const unsigned tg = og / nx;
            if (og + 1u == (tg + 1u) * nx) xb_add(&bar[XB_TOPGEN], 1u);
            else XB_SPIN(xb_ld(&bar[XB_TOPGEN]) == tg, bar);
            __builtin_amdgcn_fence(__ATOMIC_ACQUIRE, "agent");
            xb_add(&bar[XB_XGEN(b.x)], 1u);
            asm volatile("s_waitcnt vmcnt(0)" ::: "memory");
        } else {
            XB_SPIN(xb_ld(&bar[XB_XGEN(b.x)]) == gen, bar);
            __builtin_amdgcn_fence(__ATOMIC_ACQUIRE, "agent");
            asm volatile("s_waitcnt vmcnt(0)" ::: "memory");
        }
    }
    __syncthreads();
}
namespace pg8 {
#define PG8_LAS __attribute__((address_space(3)))
typedef unsigned short bf16_t;
typedef short bf16x8 __attribute__((ext_vector_type(8)));
typedef float f32x4 __attribute__((ext_vector_type(4)));
typedef unsigned u32x4 __attribute__((ext_vector_type(4)));
typedef int i32x4 __attribute__((ext_vector_type(4)));
typedef int i32x8 __attribute__((ext_vector_type(8)));
typedef unsigned u32x2 __attribute__((ext_vector_type(2)));
constexpr int BM = 256, BK = 64, HALF = 128, HTB = HALF * BK * 2  , STAGE_BYTES = 8 * HTB, NXCD = 8, WGM = 8;

__host__ __device__ __forceinline__ int lds_byte(int r, int c) { const int st = (r >> 4) * 2 + (c >> 5), rr = r & 15, cc = c & 31, ob = rr * 64 + cc * 2; return st * 1024 + (ob ^ (((ob >> 9) & 1) << 5)); }
__host__ __device__ __forceinline__ void stage_rc(int b, int& R, int& C) { const int st = b / 1024, sb = b % 1024, swz = sb ^ (((sb >> 9) & 1) << 5); R = (st >> 1) * 16 + swz / 64; C = (st & 1) * 32 + (swz % 64) / 2; }
__host__ __device__ __forceinline__ int perm32(int rho) { const int n = rho >> 4, i = rho & 15; return 8 * (i >> 2) + 4 * n + (i & 3); }

struct Unit { int pm, pn; };
struct Gemm { const bf16_t* A; const bf16_t* Bt; int M, N, K; };

struct StaticOrder {
    int nM, nN, nwg, G, c;
    __host__ __device__ void init(int M, int N, int G_, int c_) { nM = M / BM; nN = N / BM; nwg = nM * nN; G = G_; c = c_; }
    __host__ __device__ bool next(int i, Unit& u) const {
        const long L = (long)i * G + c; if (L >= nwg) return false;
        int wgid = (int)L; { const int q = nwg / NXCD, r = nwg % NXCD, xcd = wgid % NXCD, off = wgid / NXCD; wgid = (xcd < r ? xcd * (q + 1) : r * (q + 1) + (xcd - r) * q) + off; }
        const int nig = WGM * nN, gid = wgid / nig, fm = gid * WGM, gsz = (nM - fm) < WGM ? (nM - fm) : WGM;
        u.pm = fm + ((wgid % nig) % gsz); u.pn = (wgid % nig) / gsz; return true;
    }
    __device__ __forceinline__ void a_ready(const Unit&) const {}
    __device__ __forceinline__ void done(const Unit&) const {}
};

__device__ __forceinline__ unsigned cvt_pk_bf16(float lo, float hi) { unsigned r; asm volatile("v_cvt_pk_bf16_f32 %0, %1, %2" : "=v"(r) : "v"(lo), "v"(hi)); return r; }
typedef float f32x2 __attribute__((ext_vector_type(2)));
__device__ __forceinline__ f32x2 gelu_pk(f32x2 v) {
    const f32x2 av = __builtin_elementwise_abs(v), d = av * 0.2316418882f + 1.0f;
    f32x2 t; t.x = __builtin_amdgcn_rcpf(d.x); t.y = __builtin_amdgcn_rcpf(d.y);
    f32x2 q = t * 0.5307027145f + (-0.7265760135f); q = q * t + 0.7107068705f; q = q * t + (-0.142248368f); q = q * t + 0.127414796f; q = q * t;
    const f32x2 s = (v * v) * (-0.72134752044f);
    f32x2 e; e.x = __builtin_amdgcn_exp2f(s.x); e.y = __builtin_amdgcn_exp2f(s.y);
    const f32x2 m = v * (q * e), r = v - m;
    f32x2 o; o.x = v.x < 0.f ? m.x : r.x; o.y = v.y < 0.f ? m.y : r.y; return o;
}

template <int ACT  > struct EpiBf16 {
    static constexpr bool PERM = true, AFTER_DRAIN = false; static_assert(ACT == 0 || ACT == 1, "EpiBf16: ACT is 0 (none) or 1 (gelu_pk)");
    bf16_t* O; int ldc; const float* bias; int split_cols; size_t split_stride; float scale0;
    __device__ __forceinline__ void operator()(const f32x4 (&acc)[2][2][4][2], const Unit& u, int wr, int wc, int fr, int fq) const {
        const int row0 = u.pm * BM + wr * 64 + fr; int colt = u.pn * BM; bf16_t* base = O;
        float sc = 1.f; if (split_cols) { const int t = colt / split_cols; base += (size_t)t * split_stride; colt -= t * split_cols; if (t == 0) sc = scale0; }
        const int col0 = colt + wc * 32 + 8 * fq, bcol0 = u.pn * BM + wc * 32 + 8 * fq;
        f32x4 bv[2][2];
#pragma unroll
        for (int bj = 0; bj < 2; ++bj)
#pragma unroll
            for (int n = 0; n < 2; ++n) bv[bj][n] = bias ? *(const f32x4*)(bias + bcol0 + bj * HALF + 4 * n) : (f32x4){0.f, 0.f, 0.f, 0.f};
#pragma unroll
        for (int ai = 0; ai < 2; ++ai)
#pragma unroll
            for (int m = 0; m < 4; ++m) { bf16_t* rowp = base + (size_t)(row0 + ai * HALF + m * 16) * ldc + col0;
#pragma unroll
                for (int bj = 0; bj < 2; ++bj) { f32x4 v0 = acc[ai][bj][m][0] + bv[bj][0], v1 = acc[ai][bj][m][1] + bv[bj][1];
                    if (ACT == 1) { f32x2 a = gelu_pk((f32x2){v0[0], v0[1]}), b = gelu_pk((f32x2){v0[2], v0[3]}), c = gelu_pk((f32x2){v1[0], v1[1]}), d = gelu_pk((f32x2){v1[2], v1[3]});
                        v0 = (f32x4){a.x, a.y, b.x, b.y}; v1 = (f32x4){c.x, c.y, d.x, d.y}; }
                    v0 = v0 * sc; v1 = v1 * sc; u32x4 w; w.x = cvt_pk_bf16(v0[0], v0[1]); w.y = cvt_pk_bf16(v0[2], v0[3]); w.z = cvt_pk_bf16(v1[0], v1[1]); w.w = cvt_pk_bf16(v1[2], v1[3]);
                    *(u32x4*)(rowp + bj * HALF) = w; } }
    }
};
struct EpiRes {
    static constexpr bool PERM = false, AFTER_DRAIN = false;
    const float* base; float* out; int ldc; float scale;
    __device__ __forceinline__ void operator()(const f32x4 (&acc)[2][2][4][2], const Unit& u, int wr, int wc, int fr, int fq) const {
        const int row0 = u.pm * BM + wr * 64 + fr, col0 = u.pn * BM + wc * 32 + 4 * fq;
#pragma unroll
        for (int ai = 0; ai < 2; ++ai)
#pragma unroll
            for (int m = 0; m < 4; ++m) { const size_t off = (size_t)(row0 + ai * HALF + m * 16) * ldc + col0;
                f32x4 bs[2][2];
#pragma unroll
                for (int bj = 0; bj < 2; ++bj)
#pragma unroll
                    for (int n = 0; n < 2; ++n) bs[bj][n] = *(const f32x4*)(base + off + bj * HALF + n * 16);
#pragma unroll
                for (int bj = 0; bj < 2; ++bj)
#pragma unroll
                    for (int n = 0; n < 2; ++n) *(f32x4*)(out + off + bj * HALF + n * 16) = bs[bj][n] + acc[ai][bj][m][n] * scale;
                asm volatile("" ::: "memory"); }
    }
};
struct EpiStF32 {
    static constexpr bool PERM = false, AFTER_DRAIN = false;
    float* C; int ldc;
    __device__ __forceinline__ void operator()(const f32x4 (&acc)[2][2][4][2], const Unit& u, int wr, int wc, int fr, int fq) const {
        const int row0 = u.pm * BM + wr * 64 + fr, col0 = u.pn * BM + wc * 32 + 4 * fq;
#pragma unroll
        for (int ai = 0; ai < 2; ++ai)
#pragma unroll
            for (int m = 0; m < 4; ++m) { float* rowp = C + (size_t)(row0 + ai * HALF + m * 16) * ldc + col0;
#pragma unroll
                for (int bj = 0; bj < 2; ++bj)
#pragma unroll
                    for (int n = 0; n < 2; ++n) *(f32x4*)(rowp + bj * HALF + n * 16) = acc[ai][bj][m][n]; }
    }
};
struct EpiGate {
    static constexpr bool PERM = true, AFTER_DRAIN = false;
    bf16_t* G; int ldc;
    __device__ __forceinline__ void operator()(const f32x4 (&acc)[2][2][4][2], const Unit& u, int wr, int wc, int fr, int fq) const {
        const int row0 = u.pm * BM + wr * 64 + fr, col0 = u.pn * BM + wc * 32 + 8 * fq;
#pragma unroll
        for (int ai = 0; ai < 2; ++ai)
#pragma unroll
            for (int m = 0; m < 4; ++m) { bf16_t* rowp = G + (size_t)(row0 + ai * HALF + m * 16) * ldc + col0;
                u32x4 g[2];
#pragma unroll
                for (int bj = 0; bj < 2; ++bj) g[bj] = *(const u32x4*)(rowp + bj * HALF);
#pragma unroll
                for (int bj = 0; bj < 2; ++bj) {
                    if ((g[bj].x | g[bj].y | g[bj].z | g[bj].w) != 0u) {
                        const f32x4 v0 = acc[ai][bj][m][0], v1 = acc[ai][bj][m][1];
                        const f32x2 a = gelu_pk((f32x2){v0[0], v0[1]}), b = gelu_pk((f32x2){v0[2], v0[3]}), c = gelu_pk((f32x2){v1[0], v1[1]}), d = gelu_pk((f32x2){v1[2], v1[3]});
                        u32x4 w;
                        w.x = cvt_pk_bf16(a.x * __uint_as_float(g[bj].x << 16), a.y * __uint_as_float(g[bj].x & 0xffff0000u));
                        w.y = cvt_pk_bf16(b.x * __uint_as_float(g[bj].y << 16), b.y * __uint_as_float(g[bj].y & 0xffff0000u));
                        w.z = cvt_pk_bf16(c.x * __uint_as_float(g[bj].z << 16), c.y * __uint_as_float(g[bj].z & 0xffff0000u));
                        w.w = cvt_pk_bf16(d.x * __uint_as_float(g[bj].w << 16), d.y * __uint_as_float(g[bj].w & 0xffff0000u));
                        *(u32x4*)(rowp + bj * HALF) = w;
                    }
                } }
    }
};
template <int MODE = 0>
struct EpiGate8 {
    static constexpr bool PERM = true, AFTER_DRAIN = false;
    bf16_t* G; unsigned char* A2; int ldc; float hscale, oscale;
    __device__ __forceinline__ void operator()(const f32x4 (&acc)[2][2][4][2], const Unit& u, int wr, int wc, int fr, int fq) const {
        const int row0 = u.pm * BM + wr * 64 + fr, col0 = u.pn * BM + wc * 32 + 8 * fq;
#pragma unroll
        for (int ai = 0; ai < 2; ++ai)
#pragma unroll
            for (int m = 0; m < 4; ++m) { const size_t ro = (size_t)(row0 + ai * HALF + m * 16) * ldc + col0;
                u32x4 g[2];
#pragma unroll
                for (int bj = 0; bj < 2; ++bj) g[bj] = (MODE == 2 || MODE == 3) ? (u32x4){0x3f803f80u, 0x3f803f80u, 0x3f803f80u, 0x3f803f80u} : *(const u32x4*)(G + ro + bj * HALF);
#pragma unroll
                for (int bj = 0; bj < 2; ++bj) {
                    u32x2 w = {0u, 0u};
                    if ((g[bj].x | g[bj].y | g[bj].z | g[bj].w) != 0u) {
                        const f32x4 v0 = acc[ai][bj][m][0] * hscale, v1 = acc[ai][bj][m][1] * hscale;
                        const f32x2 a = MODE == 3 ? (f32x2){v0[0], v0[1]} : gelu_pk((f32x2){v0[0], v0[1]}), b = MODE == 3 ? (f32x2){v0[2], v0[3]} : gelu_pk((f32x2){v0[2], v0[3]}), c = MODE == 3 ? (f32x2){v1[0], v1[1]} : gelu_pk((f32x2){v1[0], v1[1]}), d = MODE == 3 ? (f32x2){v1[2], v1[3]} : gelu_pk((f32x2){v1[2], v1[3]});
                        float y[8] = {a.x * __uint_as_float(g[bj].x << 16), a.y * __uint_as_float(g[bj].x & 0xffff0000u), b.x * __uint_as_float(g[bj].y << 16), b.y * __uint_as_float(g[bj].y & 0xffff0000u),
                                      c.x * __uint_as_float(g[bj].z << 16), c.y * __uint_as_float(g[bj].z & 0xffff0000u), d.x * __uint_as_float(g[bj].w << 16), d.y * __uint_as_float(g[bj].w & 0xffff0000u)};
#pragma unroll
                        for (int k = 0; k < 8; ++k) y[k] = fminf(fmaxf(y[k] * oscale, -440.f), 440.f);
                        int lo = 0, hi = 0;
                        lo = __builtin_amdgcn_cvt_pk_fp8_f32(y[0], y[1], lo, false); lo = __builtin_amdgcn_cvt_pk_fp8_f32(y[2], y[3], lo, true);
                        hi = __builtin_amdgcn_cvt_pk_fp8_f32(y[4], y[5], hi, false); hi = __builtin_amdgcn_cvt_pk_fp8_f32(y[6], y[7], hi, true);
                        w.x = (unsigned)lo; w.y = (unsigned)hi;
                        if (MODE == 0) *(u32x4*)(G + ro + bj * HALF) = (u32x4){0u, 0u, 0u, 0u};
                    }
                    *(u32x2*)(A2 + ro + bj * HALF) = w;
                } }
    }
};

struct EpiGate8C {
    static constexpr bool PERM = true, AFTER_DRAIN = false;
    static constexpr int REC_OFF = STAGE_BYTES, REC_WAVE = 1984, REC_DW = 8, CAP = REC_WAVE / (4 * REC_DW);
    unsigned char* G; unsigned char* A2; int ldc; float hscale, oscale;
    static __device__ __forceinline__ float gdec(unsigned w, int k) { const unsigned b = (w >> (8 * k)) & 255u; return b ? __builtin_amdgcn_exp2f(((float)b - 195.f) * 0.05f) : 0.f; }
    __device__ __forceinline__ void one(unsigned h0, unsigned h1, unsigned h2, unsigned h3, unsigned g0, unsigned g1, unsigned off) const {
        const f32x2 a = gelu_pk((f32x2){__uint_as_float(h0 << 16), __uint_as_float(h0 & 0xffff0000u)}), b = gelu_pk((f32x2){__uint_as_float(h1 << 16), __uint_as_float(h1 & 0xffff0000u)}),
                    c = gelu_pk((f32x2){__uint_as_float(h2 << 16), __uint_as_float(h2 & 0xffff0000u)}), d = gelu_pk((f32x2){__uint_as_float(h3 << 16), __uint_as_float(h3 & 0xffff0000u)});
        float y[8] = {a.x * gdec(g0, 0), a.y * gdec(g0, 1), b.x * gdec(g0, 2), b.y * gdec(g0, 3), c.x * gdec(g1, 0), c.y * gdec(g1, 1), d.x * gdec(g1, 2), d.y * gdec(g1, 3)};
#pragma unroll
        for (int k = 0; k < 8; ++k) y[k] = fminf(fmaxf(y[k] * oscale, -440.f), 440.f);
        int lo = 0, hi = 0;
        lo = __builtin_amdgcn_cvt_pk_fp8_f32(y[0], y[1], lo, false); lo = __builtin_amdgcn_cvt_pk_fp8_f32(y[2], y[3], lo, true);
        hi = __builtin_amdgcn_cvt_pk_fp8_f32(y[4], y[5], hi, false); hi = __builtin_amdgcn_cvt_pk_fp8_f32(y[6], y[7], hi, true);
        *(u32x2*)(A2 + off) = (u32x2){(unsigned)lo, (unsigned)hi};
        *(u32x2*)(G + off) = (u32x2){0u, 0u};
    }
    __device__ __forceinline__ void flush(PG8_LAS unsigned* rec, int cnt, int lane) const {
        asm volatile("s_waitcnt lgkmcnt(0)" ::: "memory");
        if (lane < cnt) { const PG8_LAS unsigned* r = rec + lane * REC_DW;
            const u32x4 hh = *(const PG8_LAS u32x4*)r; const u32x2 gg = *(const PG8_LAS u32x2*)(r + 4); const unsigned off = r[6];
            one(hh.x, hh.y, hh.z, hh.w, gg.x, gg.y, off); }
        asm volatile("s_waitcnt lgkmcnt(0)" ::: "memory");
    }
    __device__ __forceinline__ void operator()(const f32x4 (&acc)[2][2][4][2], const Unit& u, int wr, int wc, int fr, int fq) const {
        extern __shared__ __attribute__((aligned(16))) char pg8_lds_sym[];
        const int lane = fq * 16 + fr;
        PG8_LAS unsigned* rec = (PG8_LAS unsigned*)((PG8_LAS char*)pg8_lds_sym + REC_OFF + (wr * 4 + wc) * REC_WAVE);
        const int row0 = u.pm * BM + wr * 64 + fr, col0 = u.pn * BM + wc * 32 + 8 * fq;
        int cnt = 0;
#pragma unroll
        for (int ai = 0; ai < 2; ++ai) {
            u32x2 gall[4][2];
#pragma unroll
            for (int m = 0; m < 4; ++m) { const unsigned ro = (unsigned)(row0 + ai * HALF + m * 16) * (unsigned)ldc + (unsigned)col0;
#pragma unroll
                for (int bj = 0; bj < 2; ++bj) gall[m][bj] = *(const u32x2*)(G + ro + bj * HALF); }
            asm volatile("" ::: "memory");
#pragma unroll
            for (int m = 0; m < 4; ++m) { const unsigned ro = (unsigned)(row0 + ai * HALF + m * 16) * (unsigned)ldc + (unsigned)col0;
#pragma unroll
                for (int bj = 0; bj < 2; ++bj) { const u32x2 g = gall[m][bj];
                    const bool nz = (g.x | g.y) != 0u;
                    const unsigned long long bal = __builtin_amdgcn_ballot_w64(nz);
                    const int np = __builtin_popcountll(bal);
                    if (np > CAP) {
                        if (nz) { const f32x4 v0 = acc[ai][bj][m][0] * hscale, v1 = acc[ai][bj][m][1] * hscale;
                            one(cvt_pk_bf16(v0[0], v0[1]), cvt_pk_bf16(v0[2], v0[3]), cvt_pk_bf16(v1[0], v1[1]), cvt_pk_bf16(v1[2], v1[3]), g.x, g.y, ro + bj * HALF); }
                        else *(u32x2*)(A2 + ro + bj * HALF) = (u32x2){0u, 0u};
                        continue; }
                    if (cnt + np > CAP) { flush(rec, cnt, lane); cnt = 0; }
                    if (nz) { const int slot = cnt + (int)__builtin_amdgcn_mbcnt_hi((unsigned)(bal >> 32), __builtin_amdgcn_mbcnt_lo((unsigned)bal, 0u));
                        const f32x4 v0 = acc[ai][bj][m][0] * hscale, v1 = acc[ai][bj][m][1] * hscale;
                        PG8_LAS unsigned* r = rec + slot * REC_DW;
                        *(PG8_LAS u32x4*)r = (u32x4){cvt_pk_bf16(v0[0], v0[1]), cvt_pk_bf16(v0[2], v0[3]), cvt_pk_bf16(v1[0], v1[1]), cvt_pk_bf16(v1[2], v1[3])}; *(PG8_LAS u32x2*)(r + 4) = g; r[6] = ro + bj * HALF; }
                    else *(u32x2*)(A2 + ro + bj * HALF) = (u32x2){0u, 0u};
                    cnt += np;
                } }
        }
        flush(rec, cnt, lane);
    }
};

struct EpiHead {
    static constexpr bool PERM = true, AFTER_DRAIN = false;
    static constexpr int RED_OFF = STAGE_BYTES;
    bf16_t* Kh; bf16_t* Qh; bf16_t* Vh; const float* kg; const float* qg; float scale;
    __device__ __forceinline__ void operator()(const f32x4 (&acc)[2][2][4][2], const Unit& u, int wr, int wc, int fr, int fq) const {
        extern __shared__ __attribute__((aligned(16))) char pg8_lds_sym[];
        const int colt = u.pn * BM, row0 = u.pm * BM + wr * 64 + fr, cw = wc * 32 + 8 * fq;
        if (colt >= 8192) {
            const int head0 = (colt - 8192) >> 7;
#pragma unroll
            for (int ai = 0; ai < 2; ++ai)
#pragma unroll
                for (int m = 0; m < 4; ++m) { const int t = row0 + ai * HALF + m * 16, b = t >> 12, sq = t & 4095;
#pragma unroll
                    for (int bj = 0; bj < 2; ++bj) { const f32x4 v0 = acc[ai][bj][m][0] * scale, v1 = acc[ai][bj][m][1] * scale;
                        u32x4 w; w.x = cvt_pk_bf16(v0[0], v0[1]); w.y = cvt_pk_bf16(v0[2], v0[3]); w.z = cvt_pk_bf16(v1[0], v1[1]); w.w = cvt_pk_bf16(v1[2], v1[3]);
                        *(u32x4*)(Vh + ((size_t)(b * 32 + head0 + bj) * SEQ + sq) * 128 + cw) = w; } }
            return; }
        PG8_LAS float* red = (PG8_LAS float*)((PG8_LAS char*)pg8_lds_sym + RED_OFF);
#pragma unroll
        for (int ai = 0; ai < 2; ++ai)
#pragma unroll
            for (int m = 0; m < 4; ++m)
#pragma unroll
                for (int bj = 0; bj < 2; ++bj) { const f32x4 v0 = acc[ai][bj][m][0] * scale, v1 = acc[ai][bj][m][1] * scale;
                    float s = (v0[0] * v0[0] + v0[1] * v0[1]) + (v0[2] * v0[2] + v0[3] * v0[3]) + (v1[0] * v1[0] + v1[1] * v1[1]) + (v1[2] * v1[2] + v1[3] * v1[3]);
                    s += __shfl_xor(s, 16); s += __shfl_xor(s, 32);
                    if (fq == 0) red[(((((wr * 4 + wc) * 2 + ai) * 4 + m) * 2 + bj) << 4) + fr] = s; }
        asm volatile("s_waitcnt lgkmcnt(0)\n\ts_barrier" ::: "memory");
        const bool isq = colt >= 4096; const float* gp = (isq ? qg : kg) + cw; const f32x4 g0 = *(const f32x4*)gp, g1 = *(const f32x4*)(gp + 4);
        bf16_t* dsth = isq ? Qh : Kh; const int head0 = ((isq ? colt - 4096 : colt) >> 7);
#pragma unroll
        for (int ai = 0; ai < 2; ++ai)
#pragma unroll
            for (int m = 0; m < 4; ++m) { const int t = row0 + ai * HALF + m * 16, b = t >> 12, sq = t & 4095;
#pragma unroll
                for (int bj = 0; bj < 2; ++bj) {
                    float tot = 0.f;
#pragma unroll
                    for (int w = 0; w < 4; ++w) tot += red[(((((wr * 4 + w) * 2 + ai) * 4 + m) * 2 + bj) << 4) + fr];
                    const float rn = __builtin_amdgcn_rsqf(tot * (1.f / 128.f) + EPS) * scale;
                    const f32x4 v0 = acc[ai][bj][m][0] * rn * g0, v1 = acc[ai][bj][m][1] * rn * g1;
                    u32x4 w8; w8.x = cvt_pk_bf16(v0[0], v0[1]); w8.y = cvt_pk_bf16(v0[2], v0[3]); w8.z = cvt_pk_bf16(v1[0], v1[1]); w8.w = cvt_pk_bf16(v1[2], v1[3]);
                    *(u32x4*)(dsth + ((size_t)(b * 32 + head0 + bj) * SEQ + sq) * 128 + cw) = w8; } }
    }
};
template <class Epi, class Sched, bool ALIGN_EPI = false, bool SP2 = false, bool F8 = false>
__device__ __forceinline__ void gemm_phase(PG8_LAS unsigned char* lds, const Gemm g, const Sched& S, const Epi& E) {
    const int tid = threadIdx.x, wid = __builtin_amdgcn_readfirstlane(tid >> 6), lane = tid & 63, wr = wid >> 2, wc = wid & 3, fr = lane & 15, fq = lane >> 4;
    const int K = g.K, nt = K / BK;
    unsigned voffA[2], voffB[2];
#pragma unroll
    for (int i = 0; i < 2; ++i) { int R, C; stage_rc(tid * 16 + i * 8192, R, C); const int Rb = Epi::PERM ? ((R & ~31) + perm32(R & 31)) : R;
        voffA[i] = (unsigned)(R * K + C) * 2u; voffB[i] = (unsigned)(Rb * K + C) * 2u; }
    const size_t kstep = (size_t)(BK * 2);
    const size_t hstep = (size_t)HALF * K * 2;
    const size_t tstep = 2 * hstep;
    const unsigned ldsw = (unsigned)wid * 1024u;
    const int aoff = lds_byte(wr * 64 + fr, fq * 8), boff = lds_byte(wc * 32 + fr, fq * 8);
#define PG8_SA(b, h) (((b) * 2 + (h)) * HTB)
#define PG8_SB(b, h) ((4 + (b) * 2 + (h)) * HTB)
#define PG8_STAGE(bufoff, gbase, voff) do { _Pragma("unroll") for (int _i = 0; _i < 2; ++_i) \
        __builtin_amdgcn_global_load_lds((const unsigned*)((const char*)(gbase) + (voff)[_i]), (PG8_LAS unsigned*)(lds + (bufoff) + ldsw + _i * 8192), 16, 0, 0); } while (0)
#define PG8_LDA(dst, b, h) do { if constexpr (F8) { _Pragma("unroll") for (int m = 0; m < 4; ++m) { const i32x4 lo_ = *(const PG8_LAS i32x4*)(lds + PG8_SA(b, h) + aoff + m * 2048), hi_ = *(const PG8_LAS i32x4*)(lds + PG8_SA(b, h) + aoff + m * 2048 + 1024); \
        dst##_8[m] = __builtin_shufflevector(lo_, hi_, 0, 1, 2, 3, 4, 5, 6, 7); } } else { _Pragma("unroll") for (int m = 0; m < 4; ++m) _Pragma("unroll") for (int k = 0; k < 2; ++k) dst[m][k] = *(const PG8_LAS bf16x8*)(lds + PG8_SA(b, h) + aoff + m * 2048 + k * 1024); } } while (0)
#define PG8_LDB(dst, b, h) do { if constexpr (F8) { _Pragma("unroll") for (int n = 0; n < 2; ++n) { const i32x4 lo_ = *(const PG8_LAS i32x4*)(lds + PG8_SB(b, h) + boff + n * 2048), hi_ = *(const PG8_LAS i32x4*)(lds + PG8_SB(b, h) + boff + n * 2048 + 1024); \
        dst##_8[n] = __builtin_shufflevector(lo_, hi_, 0, 1, 2, 3, 4, 5, 6, 7); } } else { _Pragma("unroll") for (int n = 0; n < 2; ++n) _Pragma("unroll") for (int k = 0; k < 2; ++k) dst[n][k] = *(const PG8_LAS bf16x8*)(lds + PG8_SB(b, h) + boff + n * 2048 + k * 1024); } } while (0)
#define PG8_MMA(ai, bj, At, Bt) do { __builtin_amdgcn_s_setprio(1); if constexpr (F8) { _Pragma("unroll") for (int m = 0; m < 4; ++m) _Pragma("unroll") for (int n = 0; n < 2; ++n) \
        asm volatile("v_mfma_f32_16x16x128_f8f6f4 %0, %1, %2, %0" : "+v"(acc[ai][bj][m][n]) : "v"(Bt##_8[n]), "v"(At##_8[m])); } \
    else { _Pragma("unroll") for (int m = 0; m < 4; ++m) _Pragma("unroll") for (int n = 0; n < 2; ++n) _Pragma("unroll") for (int k = 0; k < 2; ++k) \
        acc[ai][bj][m][n] = __builtin_amdgcn_mfma_f32_16x16x32_bf16(Bt[n][k], At[m][k], acc[ai][bj][m][n], 0, 0, 0); } __builtin_amdgcn_s_setprio(0); } while (0)
#define PG8_WAIT_V(n) asm volatile("s_waitcnt vmcnt(" #n ")" ::: "memory")
#define PG8_WAIT_L(n) asm volatile("s_waitcnt lgkmcnt(" #n ")" ::: "memory")
#define PG8_BAR __builtin_amdgcn_s_barrier()
#define PG8_SCHED __builtin_amdgcn_sched_barrier(0)
    Unit cur, nxt; int ui = 0;
    if (!S.next(0, cur)) return;
    f32x4 acc[2][2][4][2];
#pragma unroll
    for (int a = 0; a < 2; ++a)
#pragma unroll
        for (int b = 0; b < 2; ++b)
#pragma unroll
            for (int m = 0; m < 4; ++m)
#pragma unroll
                for (int n = 0; n < 2; ++n) acc[a][b][m][n] = (f32x4){0.f, 0.f, 0.f, 0.f};
    const int f8_scale_one = 0x7F7F7F7F;
    bf16x8 At[4][2], B0[2][2], B1[2][2]; i32x8 At_8[4], B0_8[2], B1_8[2];
    const char* cA = (const char*)g.A + (size_t)cur.pm * tstep; const char* cB = (const char*)g.Bt + (size_t)cur.pn * tstep;
    S.a_ready(cur);
    if constexpr (SP2) {
        PG8_STAGE(PG8_SB(0, 0), cB, voffB); PG8_STAGE(PG8_SB(0, 1), cB + hstep, voffB); PG8_STAGE(PG8_SA(0, 0), cA, voffA); PG8_STAGE(PG8_SA(0, 1), cA + hstep, voffA);
        if (wr == 1) PG8_BAR;
        PG8_WAIT_V(2); PG8_BAR;
        PG8_STAGE(PG8_SB(1, 0), cB + kstep, voffB); PG8_STAGE(PG8_SA(1, 0), cA + kstep, voffA); PG8_STAGE(PG8_SB(1, 1), cB + hstep + kstep, voffB);
        PG8_WAIT_V(6); PG8_BAR;
    } else {
        PG8_STAGE(PG8_SB(0, 0), cB, voffB); PG8_STAGE(PG8_SA(0, 0), cA, voffA); PG8_STAGE(PG8_SB(0, 1), cB + hstep, voffB); PG8_STAGE(PG8_SA(0, 1), cA + hstep, voffA);
        if (wr == 1) PG8_BAR;
        PG8_WAIT_V(4); PG8_BAR;
        PG8_STAGE(PG8_SB(1, 0), cB + kstep, voffB); PG8_STAGE(PG8_SA(1, 0), cA + kstep, voffA); PG8_STAGE(PG8_SB(1, 1), cB + hstep + kstep, voffB);
        PG8_WAIT_V(6); PG8_BAR;
    }
    for (;;) {
        const bool has_next = S.next(ui + 1, nxt);
        const char* nA = has_next ? (const char*)g.A + (size_t)nxt.pm * tstep : cA; const char* nB = has_next ? (const char*)g.Bt + (size_t)nxt.pn * tstep : cB;
        for (int t = 0; t < nt; t += 2) {
            const bool last = (t == nt - 2);
            const char* a1 = cA + (size_t)(t + 1) * kstep;
            const char* a2 = last ? nA : cA + (size_t)(t + 2) * kstep; const char* b2 = last ? nB : cB + (size_t)(t + 2) * kstep;
            const char* a3 = a2 + kstep; const char* b3 = b2 + kstep;
            if (last && has_next) S.a_ready(nxt);
            if constexpr (SP2) {
            PG8_LDB(B0, 0, 0); PG8_LDB(B1, 0, 1); PG8_SCHED; PG8_LDA(At, 0, 0); PG8_STAGE(PG8_SA(1, 1), a1 + hstep, voffA);
            PG8_WAIT_V(8); PG8_WAIT_L(0); PG8_BAR; PG8_MMA(0, 0, At, B0); PG8_MMA(0, 1, At, B1); PG8_BAR; PG8_SCHED;
            PG8_LDA(At, 0, 1); PG8_STAGE(PG8_SB(0, 0), b2, voffB); PG8_STAGE(PG8_SB(0, 1), b2 + hstep, voffB); PG8_STAGE(PG8_SA(0, 0), a2, voffA);
            PG8_WAIT_V(8); PG8_WAIT_L(0); PG8_BAR; PG8_MMA(1, 0, At, B0); PG8_MMA(1, 1, At, B1); PG8_BAR; PG8_SCHED;
            PG8_LDB(B0, 1, 0); PG8_LDB(B1, 1, 1); PG8_SCHED; PG8_LDA(At, 1, 0); PG8_STAGE(PG8_SA(0, 1), a2 + hstep, voffA);
            PG8_WAIT_V(8); PG8_WAIT_L(0); PG8_BAR; PG8_MMA(0, 0, At, B0); PG8_MMA(0, 1, At, B1); PG8_BAR; PG8_SCHED;
            PG8_LDA(At, 1, 1); PG8_STAGE(PG8_SB(1, 0), b3, voffB); PG8_STAGE(PG8_SB(1, 1), b3 + hstep, voffB); PG8_STAGE(PG8_SA(1, 0), a3, voffA);
            PG8_WAIT_V(8); PG8_WAIT_L(0); PG8_BAR; PG8_MMA(1, 0, At, B0); PG8_MMA(1, 1, At, B1); PG8_BAR; PG8_SCHED;
            } else {
            PG8_LDB(B0, 0, 0); PG8_SCHED; PG8_LDA(At, 0, 0); PG8_STAGE(PG8_SA(1, 1), a1 + hstep, voffA);
            PG8_WAIT_L(8); PG8_BAR; PG8_WAIT_L(0); PG8_MMA(0, 0, At, B0); PG8_BAR; PG8_SCHED;
            PG8_LDB(B1, 0, 1); PG8_STAGE(PG8_SB(0, 0), b2, voffB);
            PG8_BAR; PG8_WAIT_L(0); PG8_MMA(0, 1, At, B1); PG8_BAR;
            PG8_LDA(At, 0, 1); PG8_STAGE(PG8_SA(0, 0), a2, voffA);
            PG8_BAR; PG8_WAIT_L(0); PG8_MMA(1, 0, At, B0); PG8_BAR; PG8_SCHED;
            PG8_STAGE(PG8_SB(0, 1), b2 + hstep, voffB);
            PG8_WAIT_V(6); PG8_BAR; PG8_MMA(1, 1, At, B1); PG8_BAR;
            PG8_LDB(B0, 1, 0); PG8_SCHED; PG8_LDA(At, 1, 0); PG8_STAGE(PG8_SA(0, 1), a2 + hstep, voffA);
            PG8_WAIT_L(8); PG8_BAR; PG8_WAIT_L(0); PG8_MMA(0, 0, At, B0); PG8_BAR; PG8_SCHED;
            PG8_LDB(B1, 1, 1); PG8_STAGE(PG8_SB(1, 0), b3, voffB);
            PG8_BAR; PG8_WAIT_L(0); PG8_MMA(0, 1, At, B1); PG8_BAR;
            PG8_LDA(At, 1, 1); PG8_STAGE(PG8_SA(1, 0), a3, voffA);
            PG8_BAR; PG8_WAIT_L(0); PG8_MMA(1, 0, At, B0); PG8_BAR; PG8_SCHED;
            PG8_STAGE(PG8_SB(1, 1), b3 + hstep, voffB);
            PG8_WAIT_V(6); PG8_BAR; PG8_MMA(1, 1, At, B1); PG8_BAR;
            }
        }
        if constexpr (ALIGN_EPI) { if (wr == 0) PG8_BAR; }
        if constexpr (!Epi::AFTER_DRAIN) { E(acc, cur, wr, wc, fr, fq); S.done(cur); }
        if (!has_next) break;
#pragma unroll
        for (int a = 0; a < 2; ++a)
#pragma unroll
            for (int b = 0; b < 2; ++b)
#pragma unroll
                for (int m = 0; m < 4; ++m)
#pragma unroll
                    for (int n = 0; n < 2; ++n) acc[a][b][m][n] = (f32x4){0.f, 0.f, 0.f, 0.f};
        cur = nxt; cA = nA; cB = nB; ++ui;
        if constexpr (ALIGN_EPI) { if (wr == 1) PG8_BAR; }
    }
    PG8_WAIT_V(0);
    if constexpr (!ALIGN_EPI) { if (wr == 0) PG8_BAR; }
    PG8_BAR;
    if constexpr (Epi::AFTER_DRAIN) { E.fused(acc, cur, wr, wc, fr, fq, lds, wid, lane); S.done(cur); }
#undef PG8_SA
#undef PG8_SB
#undef PG8_STAGE
#undef PG8_LDA
#undef PG8_LDB
#undef PG8_MMA
#undef PG8_WAIT_V
#undef PG8_WAIT_L
#undef PG8_BAR
#undef PG8_SCHED
}
}
namespace att {
constexpr int D = 128;
#if F8_KVQ == 1
constexpr int VSTR = 12288;
#else
constexpr int VSTR = 128;
#endif
constexpr int WINDOW = 4096;
constexpr float THR = 8.f;
constexpr bool WSKIP = false;
constexpr float SCALE = 0.08838834764831845f;
constexpr int NW = 8, QBLK = 32, KVBLK = 64, QB = NW * QBLK;
constexpr int SHM_V = KVBLK * D * 2, SHM_K = KVBLK * D * 2;
constexpr int LDS_BYTES = 2 * SHM_V + 2 * SHM_K + NW * 64 * 4;
using bf16 = __hip_bfloat16;
typedef short bf16x8 __attribute__((ext_vector_type(8)));
typedef short s16x4 __attribute__((ext_vector_type(4)));
typedef float f32x16 __attribute__((ext_vector_type(16)));
typedef float f32x4 __attribute__((ext_vector_type(4)));
typedef unsigned u32x4 __attribute__((ext_vector_type(4)));
template <class A, class Bt> struct same_t { static constexpr bool v = false; };
template <class A> struct same_t<A, A> { static constexpr bool v = true; };

#define KSWZ(row, colB) ((row) * 256 + ((colB) ^ (((row) & 7) << 4)))
#define SBAR() __builtin_amdgcn_sched_barrier(0)
__device__ __forceinline__ int v_st(int k, int c) { const int kk = (k & ~0xC) | ((k & 4) << 1) | ((k & 8) >> 1); return ((kk >> 3) * 4 + (c >> 5)) * 512 + ((kk & 7) * 32 + (c & 31)) * 2; }
__device__ __forceinline__ int v_rd_base(int lane) { return ((lane & 3) << 3) | (((lane >> 2) & 3) << 6) | (((lane >> 4) & 1) << 5) | (((lane >> 5) & 1) << 8); }
constexpr int v_rd_off(int d0, int ks, int half) { return d0 * 512 + ks * 4096 + half * 2048; }
__device__ __forceinline__ int crow(int r, int hi) { return (r & 3) + 8 * (r >> 2) + 4 * hi; }
__device__ __forceinline__ unsigned cvtpk(float lo, float hi) {
    unsigned r; asm volatile("v_cvt_pk_bf16_f32 %0, %1, %2" : "=v"(r) : "v"(lo), "v"(hi)); return r;
}
__device__ __forceinline__ bf16x8 pack8(f32x4 a, f32x4 b) {
    u32x4 w = {cvtpk(a[0], a[1]), cvtpk(a[2], a[3]), cvtpk(b[0], b[1]), cvtpk(b[2], b[3])};
    return *reinterpret_cast<bf16x8*>(&w);
}
template <class T> __device__ __forceinline__ bf16x8 load8(const T* p) {
    if constexpr (same_t<T, float>::v) { return pack8(*(const f32x4*)p, *(const f32x4*)(p + 4)); }
    else { return *reinterpret_cast<const bf16x8*>(p); }
}
__device__ __forceinline__ void mask_tile(f32x16& p0, f32x16& p1, int dq, unsigned W) {
    const float NEG = -__builtin_inff();
#pragma unroll
    for (int r = 0; r < 16; ++r) {
        const int c = (r & 3) + 8 * (r >> 2);
        if ((unsigned)(dq - c) >= W) p0[r] = NEG;
        if ((unsigned)(dq - c - 32) >= W) p1[r] = NEG;
    }
}
__device__ __forceinline__ void partialSM(f32x16& p0, f32x16& p1, float& m_reg, float& mn, float& alpha) {
    float pmax = p0[0]; for (int r = 1; r < 16; ++r) pmax = fmaxf(pmax, p0[r]); for (int r = 0; r < 16; ++r) pmax = fmaxf(pmax, p1[r]);
    { auto rr = __builtin_amdgcn_permlane32_swap(__float_as_uint(pmax), __float_as_uint(pmax), false, false);
      pmax = fmaxf(__uint_as_float(rr[0]), __uint_as_float(rr[1])); }
    constexpr float C2 = 1.4426950408889634f * SCALE;
    if (__builtin_expect(__all((pmax - m_reg) * SCALE <= THR), 1)) { mn = m_reg; alpha = 1.f; }
    else { mn = fmaxf(m_reg, pmax); alpha = __builtin_amdgcn_exp2f((m_reg - mn) * C2); m_reg = mn; }
    const float mnL = -mn * C2;
    for (int r = 0; r < 16; ++r) p0[r] = fmaf(p0[r], C2, mnL); for (int r = 0; r < 16; ++r) p1[r] = fmaf(p1[r], C2, mnL);
    for (int r = 0; r < 16; ++r) p0[r] = __builtin_amdgcn_exp2f(p0[r]);
}
__device__ __forceinline__ void finishSM(f32x16& p0, f32x16& p1, float alpha, float& l_reg, bf16x8& pa0, bf16x8& pa1, bf16x8& pa2, bf16x8& pa3) {
    for (int r = 0; r < 16; ++r) p1[r] = __builtin_amdgcn_exp2f(p1[r]);
    float ps = 0; for (int r = 0; r < 16; ++r) ps += p0[r]; for (int r = 0; r < 16; ++r) ps += p1[r];
    { auto rr = __builtin_amdgcn_permlane32_swap(__float_as_uint(ps), __float_as_uint(ps), false, false);
      ps = __uint_as_float(rr[0]) + __uint_as_float(rr[1]); }
    l_reg = l_reg * alpha + ps;
#define PK4(P, B_, OUT) do { unsigned a0 = cvtpk(P[B_+0], P[B_+1]), a1 = cvtpk(P[B_+2], P[B_+3]);                          \
        unsigned b0 = cvtpk(P[B_+4], P[B_+5]), b1 = cvtpk(P[B_+6], P[B_+7]);                                             \
        auto r0 = __builtin_amdgcn_permlane32_swap(a0, b0, false, false); auto r1 = __builtin_amdgcn_permlane32_swap(a1, b1, false, false); \
        u32x4 w = {r0[0], r1[0], r0[1], r1[1]}; OUT = *reinterpret_cast<bf16x8*>(&w); } while (0)
    PK4(p0, 0, pa0); PK4(p0, 8, pa1); PK4(p1, 0, pa2); PK4(p1, 8, pa3);
#undef PK4
}
template <int KB, bool SK>
__device__ __forceinline__ void qkt(f32x16& p0, f32x16& p1, const char* K_lds, int r32, int hi, const bf16x8* qr, bool act) {
    if (SK && !act) { const float NEG = -__builtin_inff();
#pragma unroll
        for (int r = 0; r < 16; ++r) { p0[r] = NEG; p1[r] = NEG; } return; }
    p0 = f32x16{}; p1 = f32x16{};
    const char* kb[4];
#pragma unroll
    for (int dd = 0; dd < 4; ++dd) kb[dd] = K_lds + KB * SHM_K + KSWZ(r32, (dd * 16 + hi * 8) * 2);
#pragma unroll
    for (int d0 = 0; d0 < 8; ++d0) { const char* a = kb[d0 & 3] + (d0 >> 2) * 128;
        bf16x8 b0 = *reinterpret_cast<const bf16x8*>(a);
        bf16x8 b1 = *reinterpret_cast<const bf16x8*>(a + 32 * 256);
        p0 = __builtin_amdgcn_mfma_f32_32x32x16_bf16(b0, qr[d0], p0, 0, 0, 0);
        p1 = __builtin_amdgcn_mfma_f32_32x32x16_bf16(b1, qr[d0], p1, 0, 0, 0); }
}
template <int VB, bool SK>
__device__ __forceinline__ void pv_tile(f32x16* o, int vb0, bf16x8 pa0, bf16x8 pa1, bf16x8 pa2, bf16x8 pa3, bool act) {
    if (SK && !act) return;
#define TRRD(dst, off) asm volatile("ds_read_b64_tr_b16 %0, %1 offset:%2" : "=&v"(dst) : "v"(vb0), "i"(off) : "memory")
#define PV_D0(d0) do { s16x4 l0, l1, l2, l3, h0, h1, h2, h3; constexpr int b_ = VB * SHM_V + v_rd_off(d0, 0, 0);     \
        TRRD(l0, b_); TRRD(h0, b_ + 2048); TRRD(l1, b_ + 4096); TRRD(h1, b_ + 6144); TRRD(l2, b_ + 8192); TRRD(h2, b_ + 10240); TRRD(l3, b_ + 12288); TRRD(h3, b_ + 14336); \
        asm volatile("s_waitcnt lgkmcnt(0)" ::: "memory"); SBAR();                 \
        o[d0] = __builtin_amdgcn_mfma_f32_32x32x16_bf16(pa0, (bf16x8){l0[0], l0[1], l0[2], l0[3], h0[0], h0[1], h0[2], h0[3]}, o[d0], 0, 0, 0);   \
        o[d0] = __builtin_amdgcn_mfma_f32_32x32x16_bf16(pa1, (bf16x8){l1[0], l1[1], l1[2], l1[3], h1[0], h1[1], h1[2], h1[3]}, o[d0], 0, 0, 0);   \
        o[d0] = __builtin_amdgcn_mfma_f32_32x32x16_bf16(pa2, (bf16x8){l2[0], l2[1], l2[2], l2[3], h2[0], h2[1], h2[2], h2[3]}, o[d0], 0, 0, 0);   \
        o[d0] = __builtin_amdgcn_mfma_f32_32x32x16_bf16(pa3, (bf16x8){l3[0], l3[1], l3[2], l3[3], h3[0], h3[1], h3[2], h3[3]}, o[d0], 0, 0, 0); } while (0)
    PV_D0(0); PV_D0(1); PV_D0(2); PV_D0(3);
#undef PV_D0
#undef TRRD
}

template <class TIn, class TOut> struct BlockRef { const TIn* Q; const TIn* K; const TIn* V; TOut* O; int P0; };
template <class TIn> struct Seam {
    bf16x8 qr[8];
    bf16x8 st_v0, st_v1, st_k0, st_k1; f32x4 sf0, sf1, sf2, sf3;
    f32x4 tq[16];
};
__device__ __forceinline__ int swa_jlo(int P0, int W) { const int lowk = P0 - W + 1; return lowk > 0 ? lowk / KVBLK : 0; }
#define ROW(p, k0, rr) ((p) + (size_t)((k0) + (rr)) * D + sc)
#define ROWV(p, k0, rr) ((p) + (size_t)((k0) + (rr)) * VSTR + sc)
#define VMW() asm volatile("s_waitcnt vmcnt(0)" ::: "memory")
#define VMWN(n) asm volatile("s_waitcnt vmcnt(%0)" :: "i"(n) : "memory")
#define SLOAD_H(Kp, Vp, k0) do { S.st_v0 = load8<TIn>(ROWV(Vp, k0, sr)); S.st_v1 = load8<TIn>(ROWV(Vp, k0, 32 + sr));              \
                         S.st_k0 = load8<TIn>(ROW(Kp, k0, sr)); S.st_k1 = load8<TIn>(ROW(Kp, k0, 32 + sr)); } while (0)
#define SWRITE_HK(bf) do { *(bf16x8*)(K_lds + (bf) * SHM_K + kws) = S.st_k0; *(bf16x8*)(K_lds + (bf) * SHM_K + kws + 32 * 256) = S.st_k1; } while (0)
#define SWRITE_HV(bf) do { *(bf16x8*)(V_lds + (bf) * SHM_V + vst0) = S.st_v0; *(bf16x8*)(V_lds + (bf) * SHM_V + vst1) = S.st_v1; } while (0)
#define SWRITE_H(bf) do { SWRITE_HV(bf); SWRITE_HK(bf); } while (0)
#define SLOAD_F(p, k0) do { S.sf0 = *(const f32x4*)ROW(p, k0, sr); S.sf1 = *(const f32x4*)(ROW(p, k0, sr) + 4);                \
                            S.sf2 = *(const f32x4*)ROW(p, k0, 32 + sr); S.sf3 = *(const f32x4*)(ROW(p, k0, 32 + sr) + 4); } while (0)
#define SWRITE_KF(bf) do { *(bf16x8*)(K_lds + (bf) * SHM_K + kws) = pack8(S.sf0, S.sf1); *(bf16x8*)(K_lds + (bf) * SHM_K + kws + 32 * 256) = pack8(S.sf2, S.sf3); } while (0)
#define SWRITE_VF(bf) do { *(bf16x8*)(V_lds + (bf) * SHM_V + vst0) = pack8(S.sf0, S.sf1); *(bf16x8*)(V_lds + (bf) * SHM_V + vst1) = pack8(S.sf2, S.sf3); } while (0)
template <class TIn, class TOut>
__device__ __forceinline__ void causal_swa_prime(const BlockRef<TIn, TOut>& cur, int W, char* lds, Seam<TIn>& S) {
    constexpr bool F32 = same_t<TIn, float>::v;
    const int tid = threadIdx.x, wid = __builtin_amdgcn_readfirstlane(tid >> 6), lane = tid & 63, r32 = lane & 31, hi = lane >> 5;
    const int sr = tid >> 4, sc = (tid & 15) * 8, kws = KSWZ(sr, sc * 2); char* K_lds = lds + 2 * SHM_V;
    const int kb0 = swa_jlo(cur.P0, W) * KVBLK;
    for (int d0 = 0; d0 < 8; ++d0) S.qr[d0] = load8<TIn>(cur.Q + (size_t)(wid * QBLK + r32) * D + d0 * 16 + hi * 8);
    if constexpr (F32) { SLOAD_F((const float*)cur.K, kb0); VMW(); SWRITE_KF(0); SBAR(); SLOAD_F((const float*)cur.V, kb0); }
    else { SLOAD_H(cur.K, cur.V, kb0); VMW(); SWRITE_HK(0); }
    __syncthreads();
}
template <class TIn, class TOut>
__device__ __forceinline__ void causal_swa_block(const BlockRef<TIn, TOut>& cur, const BlockRef<TIn, TOut>& nxt, int skv, int W, char* lds, Seam<TIn>& S) {
    constexpr bool F32 = same_t<TIn, float>::v;
    const int tid = threadIdx.x, wid = __builtin_amdgcn_readfirstlane(tid >> 6), lane = tid & 63, r32 = lane & 31, hi = lane >> 5;
    const int j_lo = swa_jlo(cur.P0, W);
    int j_hi = (cur.P0 + QB - 1) / KVBLK + 1; if (j_hi > skv / KVBLK) j_hi = skv / KVBLK;
    const int NT = j_hi - j_lo;
    const int kbn = swa_jlo(nxt.P0, W) * KVBLK;
    const int qlo = cur.P0 + wid * QBLK, qm = qlo + r32 - 4 * hi;
    char* V_lds = lds; char* K_lds = lds + 2 * SHM_V;
    float* ws = (float*)(lds + 2 * SHM_V + 2 * SHM_K) + wid * 64; float* li_l = ws, * al_l = ws + 32;
    float m_reg = -1e30f, l_reg = 0; f32x16 o[4] = {};
    const int sr = tid >> 4, sc = (tid & 15) * 8, vst0 = v_st(sr, sc), vst1 = v_st(32 + sr, sc), kws = KSWZ(sr, sc * 2);
    const int vb0 = (int)(uintptr_t)V_lds + v_rd_base(lane);
    const TIn* Kh = cur.K; const TIn* Vh = cur.V;
#define RESC(a) do { if (__any((a) < 1.f)) { if (hi == 0) al_l[r32] = (a); asm volatile("s_waitcnt lgkmcnt(0)" ::: "memory");              \
                     for (int d_ = 0; d_ < 4; ++d_) for (int r = 0; r < 16; ++r) o[d_][r] *= al_l[crow(r, hi)]; } } while (0)
#define KBASE(t) ((j_lo + (t)) * KVBLK)
#define ACT(t) (KBASE(t) <= qlo + QBLK - 1 && KBASE(t) + KVBLK - 1 >= qlo - W + 1)
#define MASKT(P0_, P1_, t) do { const int kb_ = KBASE(t); if ((!SK || ACT(t)) && (kb_ + KVBLK - 1 > qlo || kb_ <= qlo + QBLK - 1 - W)) mask_tile(P0_, P1_, qm - kb_, (unsigned)W); } while (0)
    constexpr int NQL = F32 ? 16 : 8;
    constexpr bool SK = WSKIP && !F32;
#define SEAM_K0() do { VMWN(NQL); if constexpr (F32) { SWRITE_KF(0); SBAR(); SLOAD_F((const float*)nxt.V, kbn); } else { SWRITE_HK(0); } SBAR(); } while (0)
    f32x16 pA0, pA1, pB0, pB1; float mnA, mnB, alA, alB; bf16x8 pa0, pa1, pa2, pa3;
    if constexpr (F32) { VMW(); SWRITE_VF(0); SBAR(); } else { SWRITE_HV(0); SBAR(); }
    if (NT > 1) { if constexpr (F32) SLOAD_F((const float*)Kh, KBASE(1)); else SLOAD_H(Kh, Vh, KBASE(1)); }
    SBAR(); qkt<0, SK>(pA0, pA1, K_lds, r32, hi, S.qr, ACT(0));
    if constexpr (F32) { if (NT > 1) { VMW(); SWRITE_KF(1); SBAR(); SLOAD_F((const float*)Vh, KBASE(1)); } }
    MASKT(pA0, pA1, 0); partialSM(pA0, pA1, m_reg, mnA, alA);
    if (NT > 1) { VMW(); if constexpr (F32) { SWRITE_VF(1); SBAR(); if (NT > 2) SLOAD_F((const float*)Kh, KBASE(2)); } else SWRITE_H(1); }
    __syncthreads();
#define HALF_STEP(PX0, PX1, mnX, alX, PY0, PY1, alY, t, KB, VB, SB) do {                                                      \
        SBAR(); qkt<KB, SK>(PX0, PX1, K_lds, r32, hi, S.qr, ACT(t));                                             \
        finishSM(PY0, PY1, alY, l_reg, pa0, pa1, pa2, pa3); SBAR();                                                           \
        if ((t) + 1 < NT) { if constexpr (F32) { VMW(); SWRITE_KF(SB); SBAR(); SLOAD_F((const float*)Vh, KBASE((t) + 1)); }  \
                            else { SLOAD_H(Kh, Vh, KBASE((t) + 1)); } SBAR(); }                                               \
        pv_tile<VB, SK>(o, vb0, pa0, pa1, pa2, pa3, ACT((t) - 1)); MASKT(PX0, PX1, (t)); partialSM(PX0, PX1, m_reg, mnX, alX);                                        \
        __syncthreads();                                                                                                      \
        if ((t) + 1 < NT) { VMW(); if constexpr (F32) { SWRITE_VF(SB); SBAR(); if ((t) + 2 < NT) SLOAD_F((const float*)Kh, KBASE((t) + 2)); } \
                            else { SWRITE_H(SB); } }                                                                          \
        RESC(alX); __syncthreads(); } while (0)
    for (int t = 1; t + 1 < NT; t += 2) {
        HALF_STEP(pB0, pB1, mnB, alB, pA0, pA1, alA, t, 1, 0, 0);
        HALF_STEP(pA0, pA1, mnA, alA, pB0, pB1, alB, t + 1, 0, 1, 1);
    }
    const bool even = (NT & 1) == 0;
    if (even) { SBAR(); qkt<1, SK>(pB0, pB1, K_lds, r32, hi, S.qr, ACT(NT - 1)); SBAR(); }
#define QROW(e) (nxt.Q + (size_t)(wid * QBLK + r32) * D + ((e) >> 1) * 16 + hi * 8 + ((e) & 1) * 4)
    if constexpr (F32) { SLOAD_F((const float*)nxt.K, kbn); SBAR();
#pragma unroll
        for (int e = 0; e < 8; ++e) S.tq[e] = *(const f32x4*)QROW(e); }
    else { SLOAD_H(nxt.K, nxt.V, kbn); SBAR();
#pragma unroll
        for (int d0 = 0; d0 < 8; ++d0) S.qr[d0] = load8<TIn>(nxt.Q + (size_t)(wid * QBLK + r32) * D + d0 * 16 + hi * 8); }
    SBAR();
    finishSM(pA0, pA1, alA, l_reg, pa0, pa1, pa2, pa3); SBAR();
    if constexpr (F32) {
#pragma unroll
        for (int e = 8; e < 16; ++e) S.tq[e] = *(const f32x4*)QROW(e); SBAR(); }
#undef QROW
    pv_tile<0, SK>(o, vb0, pa0, pa1, pa2, pa3, ACT(even ? NT - 2 : NT - 1));
    if (even) { MASKT(pB0, pB1, NT - 1); partialSM(pB0, pB1, m_reg, mnB, alB); __syncthreads(); RESC(alB);
        finishSM(pB0, pB1, alB, l_reg, pa0, pa1, pa2, pa3); SBAR(); pv_tile<1, SK>(o, vb0, pa0, pa1, pa2, pa3, ACT(NT - 1)); }
    SBAR(); SEAM_K0();
    if (hi == 0) li_l[r32] = l_reg; asm volatile("s_waitcnt lgkmcnt(0)" ::: "memory");
    float rli[16];
#pragma unroll
    for (int r = 0; r < 16; ++r) rli[r] = __builtin_amdgcn_rcpf(li_l[crow(r, hi)]);
    TOut* Ow = cur.O + (size_t)(wid * QBLK) * D;
#pragma unroll
    for (int r = 0; r < 16; ++r) { const int orow = crow(r, hi);
#pragma unroll
        for (int d0 = 0; d0 < 4; ++d0) { const float v = o[d0][r] * rli[r];
            if constexpr (same_t<TOut, float>::v) { Ow[(size_t)orow * D + d0 * 32 + r32] = v; }
            else { const float vn = __shfl_xor(v, 1);
                   if ((r32 & 1) == 0) *(unsigned*)(Ow + (size_t)orow * D + d0 * 32 + r32) = cvtpk(v, vn); } } }
    if constexpr (F32) {
#pragma unroll
        for (int d0 = 0; d0 < 8; ++d0) S.qr[d0] = pack8(S.tq[2 * d0], S.tq[2 * d0 + 1]); }
    __syncthreads();
#undef RESC
#undef KBASE
#undef ACT
#undef MASKT
#undef SEAM_K0
#undef HALF_STEP
}
#undef ROW
#undef ROWV
#undef VMW
#undef VMWN
#undef SLOAD_H
#undef SWRITE_HK
#undef SWRITE_HV
#undef SWRITE_H
#undef SLOAD_F
#undef SWRITE_KF
#undef SWRITE_VF
}
struct Ctx { LAS unsigned char* lds; int tid, lane, wave, vcu, G; };

__device__ __forceinline__ void tr_load(f4v (&v)[16], float (&gk)[16], const float* __restrict__ src, size_t ldn, const float* __restrict__ gain, int k0, int nsrc0, int lane) {
    const int r4 = lane >> 4, c4 = (lane & 15) * 4;
#pragma unroll
    for (int i = 0; i < 16; ++i) v[i] = *(const f4v*)(src + (size_t)(k0 + 4 * i + r4) * ldn + nsrc0 + c4);
#pragma unroll
    for (int i = 0; i < 16; ++i) gk[i] = gain ? gain[k0 + 4 * i + r4] : 1.f;
}
__device__ __forceinline__ void tr_item(const f4v (&v)[16], const float (&gv)[16], bfr* __restrict__ dst, int K,
                                        int k0, int drow0, LAS float* scr, int lane) {
    const int r4 = lane >> 4, c4 = (lane & 15) * 4;
#pragma unroll
    for (int i = 0; i < 16; ++i) { const int k = 4 * i + r4; const float gk = gv[i];
        LAS float* s = scr + k * 65 + c4; s[0] = v[i][0] * gk; s[1] = v[i][1] * gk; s[2] = v[i][2] * gk; s[3] = v[i][3] * gk; }
    LDS_WAIT(); asm volatile("" ::: "memory");
    const int c = lane & 7;
#pragma unroll
    for (int jj = 0; jj < 8; ++jj) { const int n = (lane >> 3) + 8 * jj; const LAS float* s = scr + (8 * c) * 65 + n;
        u4v o; o.x = cvtpk(s[0 * 65], s[1 * 65]); o.y = cvtpk(s[2 * 65], s[3 * 65]); o.z = cvtpk(s[4 * 65], s[5 * 65]); o.w = cvtpk(s[6 * 65], s[7 * 65]);
        *(u4v*)(dst + (size_t)(drow0 + n) * K + k0 + 8 * c) = o; }
    LDS_WAIT(); asm volatile("" ::: "memory");
}
__device__ __forceinline__ void tr_item8(const f4v (&v)[16], float sc, const float (&gv)[16], unsigned char* __restrict__ dst, int K, int k0, int drow0, LAS float* scr, int lane) {
    const int r4 = lane >> 4, c4 = (lane & 15) * 4;
#pragma unroll
    for (int i = 0; i < 16; ++i) { const int k = 4 * i + r4; const float gk = gv[i] * sc; LAS float* s = scr + k * 65 + c4; s[0] = v[i][0] * gk; s[1] = v[i][1] * gk; s[2] = v[i][2] * gk; s[3] = v[i][3] * gk; }
    LDS_WAIT(); asm volatile("" ::: "memory");
    const int c = lane & 3;
#pragma unroll
    for (int jj = 0; jj < 4; ++jj) { const int n = (lane >> 2) + 16 * jj; const LAS float* s = scr + (16 * c) * 65 + n;
        u4v o; o.x = cvt4_fp8(s[0 * 65], s[1 * 65], s[2 * 65], s[3 * 65]); o.y = cvt4_fp8(s[4 * 65], s[5 * 65], s[6 * 65], s[7 * 65]);
        o.z = cvt4_fp8(s[8 * 65], s[9 * 65], s[10 * 65], s[11 * 65]); o.w = cvt4_fp8(s[12 * 65], s[13 * 65], s[14 * 65], s[15 * 65]);
        *(u4v*)(dst + (size_t)(drow0 + n) * K + k0 + 16 * c) = o; }
    LDS_WAIT(); asm volatile("" ::: "memory");
}
__device__ __forceinline__ void tr_job8(const float* __restrict__ src, size_t ldn, float sc, const float* __restrict__ gain, unsigned char* __restrict__ dst, int K, int ncols, LAS float* scr, int lane, int gw, int NGW, int nsrc0 = 0) {
    const int nn = ncols / 64, ni = (K / 64) * nn;
    float ga[16], gb[16];
    f4v va[16], vb[16];
#define TRJ_LOAD(V, G_, it_) do { const int kb_ = (it_) / nn, nb_ = (it_) - kb_ * nn; tr_load(V, G_, src, ldn, gain, kb_ * 64, nsrc0 + nb_ * 64, lane); } while (0)
#define TRJ_ITEM(V, G_, it_) do { const int kb_ = (it_) / nn, nb_ = (it_) - kb_ * nn; tr_item8(V, sc, G_, dst, K, kb_ * 64, nb_ * 64, scr, lane); } while (0)
    int it = gw;
    if (it < ni) {
        TRJ_LOAD(va, ga, it);
        while (it + 2 * NGW < ni) {
            TRJ_LOAD(vb, gb, it + NGW); TRJ_ITEM(va, ga, it); TRJ_LOAD(va, ga, it + 2 * NGW); TRJ_ITEM(vb, gb, it + NGW); it += 2 * NGW; }
        if (it + NGW < ni) { TRJ_LOAD(vb, gb, it + NGW); TRJ_ITEM(va, ga, it); TRJ_ITEM(vb, gb, it + NGW); } else TRJ_ITEM(va, ga, it);
    }
#undef TRJ_LOAD
#undef TRJ_ITEM
}
__device__ __forceinline__ void tr_job(const float* __restrict__ src, size_t ldn, const float* __restrict__ gain, bfr* __restrict__ dst, int K, int ncols, int nsrc0, int drow0,
                                       LAS float* scr, int lane, int gw, int NGW) {
    const int nn = ncols / 64, ni = (K / 64) * nn;
    float ga[16], gb[16];
    f4v va[16], vb[16];
#define TRJ_LOAD(V, G_, it_) do { const int kb_ = (it_) / nn, nb_ = (it_) - kb_ * nn; tr_load(V, G_, src, ldn, gain, kb_ * 64, nsrc0 + nb_ * 64, lane); } while (0)
#define TRJ_ITEM(V, G_, it_) do { const int kb_ = (it_) / nn, nb_ = (it_) - kb_ * nn; tr_item(V, G_, dst, K, kb_ * 64, drow0 + nb_ * 64, scr, lane); } while (0)
    int it = gw;
    if (it < ni) {
        TRJ_LOAD(va, ga, it);
        while (it + 2 * NGW < ni) {
            TRJ_LOAD(vb, gb, it + NGW); TRJ_ITEM(va, ga, it); TRJ_LOAD(va, ga, it + 2 * NGW); TRJ_ITEM(vb, gb, it + NGW); it += 2 * NGW; }
        if (it + NGW < ni) { TRJ_LOAD(vb, gb, it + NGW); TRJ_ITEM(va, ga, it); TRJ_ITEM(vb, gb, it + NGW); } else TRJ_ITEM(va, ga, it);
    }
#undef TRJ_LOAD
#undef TRJ_ITEM
}
struct KArgs {
    const float* in[26]; float* out; unsigned char* ws; int ph_lo, ph_hi, li, pad;
};
struct Ptrs {
    LAS unsigned long long* tbl;
    __device__ __forceinline__ unsigned long long get(int k) const { const unsigned long long v = tbl[k];
        return ((unsigned long long)(unsigned)__builtin_amdgcn_readfirstlane((int)(unsigned)(v >> 32)) << 32) | (unsigned)__builtin_amdgcn_readfirstlane((int)(unsigned)v); }
    __device__ __forceinline__ const float* in_(int k) const { return (const float*)get(k); }
    __device__ __forceinline__ float* out_() const { return (float*)get(26); }
    __device__ __forceinline__ unsigned char* ws_() const { return (unsigned char*)get(27); }
};
__device__ __forceinline__ void p_convert(const Ctx& C, const Ptrs& P, const int part, const int vc, const int nc) {
    LAS float* scr = (LAS float*)(C.lds + C.wave * 16640);
    const int gw = vc * 8 + C.wave, NGW = nc * 8;
    unsigned char* ws = P.ws_();
    if (part == 0) {
#if F8_PROJ0 == 1
    tr_job8(P.in_(2), (size_t)GIN, SU, P.in_(1), ws + WS_WTIN, DM, 16384, scr, C.lane, gw, NGW);
#elif F8_PROJ0 == 2
    tr_job(P.in_(2), (size_t)GIN, P.in_(1), (bfr*)(ws + WS_WTIN), DM, 8192, 0, 0, scr, C.lane, gw, NGW);
    tr_job8(P.in_(2), (size_t)GIN, SU, P.in_(1), ws + WS_WTIN + (size_t)8192 * DM * 2, DM, 8192, scr, C.lane, gw, NGW, 8192);
#elif F8_PROJ0 == 5
    tr_job8(P.in_(2), (size_t)GIN, SU, P.in_(1), ws + WS_WTIN, DM, 8192, scr, C.lane, gw, NGW, 0);
    tr_job(P.in_(2), (size_t)GIN, P.in_(1), (bfr*)(ws + WS_WTIN + (size_t)32 * MiB), DM, 4096, 8192, 0, scr, C.lane, gw, NGW);
    tr_job8(P.in_(2), (size_t)GIN, SU, P.in_(1), ws + WS_WTIN + (size_t)64 * MiB, DM, 4096, scr, C.lane, gw, NGW, 12288);
#elif F8_PROJ0 == 6
    tr_job8(P.in_(2), (size_t)GIN, SU, P.in_(1), ws + WS_WTIN, DM, 12288, scr, C.lane, gw, NGW, 0);
    tr_job(P.in_(2), (size_t)GIN, P.in_(1), (bfr*)(ws + WS_WTIN + (size_t)48 * MiB), DM, 4096, 12288, 0, scr, C.lane, gw, NGW);
#elif F8_PROJ0 == 3
    tr_job8(P.in_(2), (size_t)GIN, SU, P.in_(1), ws + WS_WTIN, DM, 8192, scr, C.lane, gw, NGW, 0);
    tr_job(P.in_(2), (size_t)GIN, P.in_(1), (bfr*)(ws + WS_WTIN + (size_t)8192 * DM), DM, 8192, 8192, 0, scr, C.lane, gw, NGW);
#else
    tr_job(P.in_(2), (size_t)GIN, P.in_(1), (bfr*)(ws + WS_WTIN), DM, 16384, 0, 0, scr, C.lane, gw, NGW);
#endif
    tr_job(P.in_(2), (size_t)GIN, P.in_(1), (bfr*)(ws + WS_WTBD), DM, 64, 16384, 0, scr, C.lane, gw, NGW);
#if F8_OUT0
    tr_job8(P.in_(7), (size_t)DM, SU, nullptr, ws + WS_WTOUT, DM, DM, scr, C.lane, gw, NGW, 0);
#else
    tr_job(P.in_(7), (size_t)DM, nullptr, (bfr*)(ws + WS_WTOUT), DM, DM, 0, 0, scr, C.lane, gw, NGW);
#endif
    } else {
#if F8_KVQ
    tr_job8(P.in_(9), (size_t)8192, SU, P.in_(8), ws + WS_WTKVQ, DM, DM, scr, C.lane, gw, NGW, 0);
    tr_job8(P.in_(12), (size_t)DM, SU, P.in_(11), ws + WS_WTKVQ + (size_t)DM * DM, DM, DM, scr, C.lane, gw, NGW, 0);
#if F8_KVQ == 2
    tr_job8(P.in_(9), (size_t)8192, SU, P.in_(8), ws + WS_WTKVQ + (size_t)2 * DM * DM, DM, DM, scr, C.lane, gw, NGW, DM);
#else
    tr_job(P.in_(9), (size_t)8192, P.in_(8), (bfr*)(ws + WS_WTKVQ + (size_t)2 * DM * DM), DM, DM, DM, 0, scr, C.lane, gw, NGW);
#endif
#else
    tr_job(P.in_(9), (size_t)8192, P.in_(8), (bfr*)(ws + WS_WTKVQ), DM, 8192, 0, 0, scr, C.lane, gw, NGW);
    tr_job(P.in_(12), (size_t)DM, P.in_(11), (bfr*)(ws + WS_WTKVQ), DM, DM, 0, 8192, scr, C.lane, gw, NGW);
#endif
#if F8_OUT1
    tr_job8(P.in_(19), (size_t)DM, SU, nullptr, ws + WS_WTO, DM, DM, scr, C.lane, gw, NGW, 0);
#else
    tr_job(P.in_(19), (size_t)DM, nullptr, (bfr*)(ws + WS_WTO), DM, DM, 0, 0, scr, C.lane, gw, NGW);
#endif
    }
    tr_job(P.in_(21) + (size_t)part * DM * PQ, (size_t)PQ, P.in_(20) + part * DM, (bfr*)(ws + WS_WTQRY) + (size_t)part * PQ * DM, DM, PQ, 0, 0, scr, C.lane, gw, NGW);
    tr_job8(P.in_(25) + (size_t)part * PE * DM, (size_t)DM, SV, nullptr, ws + WS_VT + (size_t)part * DM * PE, PE, DM, scr, C.lane, gw, NGW);
    {
        const size_t gt = (size_t)vc * 512 + C.tid, GT = (size_t)nc * 512;
        for (int l = part; l <= part; ++l) {
            const float* src = P.in_(24) + (size_t)l * PE * DM; const float* gain = P.in_(20) + l * DM; unsigned char* dst = ws + WS_U + (size_t)l * PE * DM;
            constexpr size_t NIT = (size_t)PE * DM / 16; size_t i0 = gt;
            for (; i0 + 3 * GT < NIT; i0 += 4 * GT) {
                f4v x[4][4];
#pragma unroll
                for (int u = 0; u < 4; ++u) { const size_t i = i0 + (size_t)u * GT;
#pragma unroll
                    for (int j = 0; j < 4; ++j) x[u][j] = *(const f4v*)(src + i * 16 + 4 * j); }
#pragma unroll
                for (int u = 0; u < 4; ++u) { const size_t i = i0 + (size_t)u * GT; const int dd = (int)((i * 16) & (DM - 1));
                    u4v o; unsigned w[4];
#pragma unroll
                    for (int j = 0; j < 4; ++j) { const f4v g = *(const f4v*)(gain + dd + 4 * j) * SU; w[j] = cvt4_fp8(x[u][j][0] * g[0], x[u][j][1] * g[1], x[u][j][2] * g[2], x[u][j][3] * g[3]); }
                    o.x = w[0]; o.y = w[1]; o.z = w[2]; o.w = w[3];
                    *(u4v*)(dst + i * 16) = o; }
            }
            for (; i0 < NIT; i0 += GT) {
                const size_t i = i0; const int dd = (int)((i * 16) & (DM - 1)); u4v o; unsigned w[4];
#pragma unroll
                for (int j = 0; j < 4; ++j) { const f4v xx = *(const f4v*)(src + i * 16 + 4 * j); const f4v g = *(const f4v*)(gain + dd + 4 * j) * SU; w[j] = cvt4_fp8(xx[0] * g[0], xx[1] * g[1], xx[2] * g[2], xx[3] * g[3]); }
                o.x = w[0]; o.y = w[1]; o.z = w[2]; o.w = w[3];
                *(u4v*)(dst + i * 16) = o; }
        }
        for (int l = part; l <= part; ++l) {
            bfr* dst = (bfr*)(ws + WS_WTKEY) + (size_t)l * PQ * PQ;
            for (size_t i = gt; i < (size_t)PQ * PQ / 8; i += GT) {
                const int row = (int)((i * 8) / PQ), col = (int)((i * 8) % PQ); u4v o = {0u, 0u, 0u, 0u};
                if ((row >> 7) == (col >> 7)) { const int blk = row >> 7, h = blk >> 1, half = blk & 1, n = row & 127, d = col & 127;
                    const float* src = (half ? P.in_(23) : P.in_(22)) + (((size_t)l * PH + h) * PK + n) * 128 + d;
                    const f4v a = *(const f4v*)src, b = *(const f4v*)(src + 4);
                    o.x = cvtpk(a[0], a[1]); o.y = cvtpk(a[2], a[3]); o.z = cvtpk(b[0], b[1]); o.w = cvtpk(b[2], b[3]); }
                *(u4v*)(dst + i * 8) = o; }
        }
    }
}

__device__ __forceinline__ void p_norm_rows(const Ctx& C, const float* __restrict__ src, bfr* __restrict__ dst, unsigned char* __restrict__ dst8) {
    const int gw = C.vcu * 8 + C.wave, NGW = C.G * 8;
    for (int row = gw; row < NT; row += NGW) {
        const f4v* p = (const f4v*)(src + (size_t)row * DM);
        f4v a[8], b[8]; float ss = 0.f;
#pragma unroll
        for (int j = 0; j < 8; ++j) { a[j] = p[j * 128 + 2 * C.lane]; b[j] = p[j * 128 + 2 * C.lane + 1]; }
#pragma unroll
        for (int j = 0; j < 8; ++j) ss += (a[j][0] * a[j][0] + a[j][1] * a[j][1]) + (a[j][2] * a[j][2] + a[j][3] * a[j][3]) + (b[j][0] * b[j][0] + b[j][1] * b[j][1]) + (b[j][2] * b[j][2] + b[j][3] * b[j][3]);
        const float r = __builtin_amdgcn_rsqf(wave_sum(ss) * (1.f / DM) + EPS);
        u4v* o = (u4v*)(dst + (size_t)row * DM);
#pragma unroll
        for (int j = 0; j < 8; ++j) { u4v w; w.x = cvtpk(a[j][0] * r, a[j][1] * r); w.y = cvtpk(a[j][2] * r, a[j][3] * r); w.z = cvtpk(b[j][0] * r, b[j][1] * r); w.w = cvtpk(b[j][2] * r, b[j][3] * r);
            if (dst) o[j * 64 + C.lane] = w;
            if (dst8) { u2v w8; w8.x = cvt4_fp8(a[j][0] * r, a[j][1] * r, a[j][2] * r, a[j][3] * r); w8.y = cvt4_fp8(b[j][0] * r, b[j][1] * r, b[j][2] * r, b[j][3] * r); ((u2v*)(dst8 + (size_t)row * DM))[j * 64 + C.lane] = w8; } }
    }
}

__device__ __forceinline__ void p_bd(const Ctx& C, const bfr* __restrict__ XN, const bfr* __restrict__ WB, float* __restrict__ BD) {
    LAS float* red = (LAS float*)C.lds;
    const int r = C.lane & 15, q = C.lane >> 4, rt = C.wave >> 2, kq = C.wave & 3;
    for (int blk = C.vcu; blk < NT / 32; blk += C.G) {
        const bfr* ap = XN + (size_t)(blk * 32 + rt * 16 + r) * DM + kq * 1024 + q * 8;
        const bfr* bp = WB + (size_t)r * DM + kq * 1024 + q * 8;
        f4v acc[4] = {zero_acc(), zero_acc(), zero_acc(), zero_acc()};
#pragma unroll 4
        for (int ks = 0; ks < 32; ++ks) {
            const s8v a = *(const s8v*)(ap + ks * 32);
#pragma unroll
            for (int nt = 0; nt < 4; ++nt) { const s8v b = *(const s8v*)(bp + (size_t)nt * 16 * DM + ks * 32); acc[nt] = __builtin_amdgcn_mfma_f32_16x16x32_bf16(a, b, acc[nt], 0, 0, 0); }
            MFMA_SETTLE(acc[0]); MFMA_SETTLE(acc[1]); MFMA_SETTLE(acc[2]); MFMA_SETTLE(acc[3]);
        }
        MFMA_SETTLE(acc[0]); MFMA_SETTLE(acc[1]); MFMA_SETTLE(acc[2]); MFMA_SETTLE(acc[3]);
#pragma unroll
        for (int nt = 0; nt < 4; ++nt)
#pragma unroll
            for (int i = 0; i < 4; ++i) red[C.wave * 1024 + (4 * q + i) * 64 + nt * 16 + r] = -acc[nt][i];
        __syncthreads();
#pragma unroll
        for (int i = 0; i < 4; ++i) { const int idx = C.tid * 4 + i, t2 = idx >> 10, rem = idx & 1023;
            const float s = -((red[(t2 * 4 + 0) * 1024 + rem] + red[(t2 * 4 + 1) * 1024 + rem]) + (red[(t2 * 4 + 2) * 1024 + rem] + red[(t2 * 4 + 3) * 1024 + rem]));
            BD[(size_t)(blk * 32 + t2 * 16 + (rem >> 6)) * 64 + (rem & 63)] = s; }
        __syncthreads();
    }
}
__device__ __forceinline__ int kq_off(int row, int chunk) { return row * 256 + ((chunk ^ (row & 7)) << 4); }
__device__ __forceinline__ int xt_off(int col, int chunk) { return col * 128 + ((chunk ^ (col & 7)) << 4); }
__device__ __forceinline__ void p_gdn_prep(const Ctx& C, const Ptrs& P, int vp, int np) {
    unsigned char* ws = P.ws_();
    const bfr* PROJ = (const bfr*)(ws + WS_BIG); const float* BD = (const float*)(ws + WS_BD);
    const float* convw = P.in_(3); const float* alog = P.in_(4); const float* dtb = P.in_(5);
    bfr* Wg = (bfr*)(ws + WS_R + R_W); bfr* Ug = (bfr*)(ws + WS_R + R_U); bfr* QGg = (bfr*)(ws + WS_R + R_QG); bfr* KDg = (bfr*)(ws + WS_R + R_KD); bfr* QKg = (bfr*)(ws + WS_R + R_QK);
    float* EGg = (float*)(ws + WS_EG);
    LAS float* sCW = (LAS float*)(C.lds + 82944);
    for (int tk = vp; tk < NB * GH * 32; tk += np) {
        const int wq = tk >> 3, it = tk & 7;
        const int bh = wq >> 2, cg = wq & 3, h = bh & 31, b = bh >> 5;
        for (int i = C.tid; i < 1536; i += 512) { const int part = i >> 9, tap = (i >> 7) & 3, ch = i & 127; sCW[i] = convw[tap * 12288 + part * 4096 + h * 128 + ch]; }
        __syncthreads();
        {
            int tid = C.tid; asm volatile("" : "+v"(tid));
            const int hw = tid >> 8, lt = tid & 255, lane = tid & 63, lw = (tid >> 6) & 3;
            const int c = cg * 16 + it * 2 + hw, unit = bh * 64 + c, t0 = b * SEQ + c * CH;
            LAS unsigned char* hb = C.lds + hw * 41472;
            LAS unsigned char* sK = hb; LAS unsigned char* sQ = hb + 16384; LAS unsigned char* sX = hb;
            LAS unsigned char* sAM = hb + 32768; LAS float* sB = (LAS float*)(hb + 40960); LAS float* sG = (LAS float*)(hb + 41216);
            LAS float* scr = (LAS float*)(C.lds + 89088 + (tid >> 6) * 4352);
            LAS float* sAD = (LAS float*)(C.lds + 123904 + hw * 4096);
            if (lt < 64) {
                const int t = t0 + lt; const float braw = BD[(size_t)t * 64 + h], araw = BD[(size_t)t * 64 + 32 + h];
                const float beta = 1.f / (1.f + expf(-braw)); const float xx = araw + dtb[h]; const float sp = fmaxf(xx, 0.f) + log1pf(expf(-fabsf(xx)));
                float g = -expf(alog[h]) * sp;
#pragma unroll
                for (int o = 1; o < 64; o <<= 1) { const float y = __shfl_up(g, o); if (lane >= o) g += y; }
                sB[lt] = beta; sG[lt] = g;
            }
            __syncthreads();
            const int tk = lt >> 2, cs = lt & 3;
            const float beta = sB[tk], gc = sG[tk], gl = sG[63]; const float eg = expf(gc), ed = expf(gl - gc), bg = beta * eg;
            u4v kbg[4], vbt[4];
#pragma unroll
            for (int part = 0; part < 3; ++part) {
                float y[32];
#pragma unroll
                for (int i = 0; i < 32; ++i) y[i] = 0.f;
#pragma unroll
                for (int j = 0; j < 4; ++j) {
                    const int s = c * CH + tk - 3 + j;
                    if (s >= 0) {
                        const bfr* row = PROJ + (size_t)(b * SEQ + s) * 16384 + part * 4096 + h * 128 + cs * 32;
#pragma unroll
                        for (int q4 = 0; q4 < 4; ++q4) { const u4v x = *(const u4v*)(row + 8 * q4); const LAS float* wp = sCW + part * 512 + j * 128 + cs * 32 + 8 * q4;
                            const f4v w0 = *(const LAS f4v*)wp, w1 = *(const LAS f4v*)(wp + 4);
                            y[8 * q4 + 0] += bflo(x.x) * w0[0]; y[8 * q4 + 1] += bfhi(x.x) * w0[1]; y[8 * q4 + 2] += bflo(x.y) * w0[2]; y[8 * q4 + 3] += bfhi(x.y) * w0[3];
                            y[8 * q4 + 4] += bflo(x.z) * w1[0]; y[8 * q4 + 5] += bfhi(x.z) * w1[1]; y[8 * q4 + 6] += bflo(x.w) * w1[2]; y[8 * q4 + 7] += bfhi(x.w) * w1[3]; }
                    }
                }
                float ss = 0.f;
#pragma unroll
                for (int i = 0; i < 32; ++i) { y[i] = y[i] * __builtin_amdgcn_rcpf(1.f + __expf(-y[i])); ss += y[i] * y[i]; }
                if (part < 2) {
                    ss += __shfl_xor(ss, 1); ss += __shfl_xor(ss, 2);
                    const float rn = __builtin_amdgcn_rsqf(ss + EPS) * (part == 0 ? 0.08838834764831845f : 1.f); const float gs = part == 0 ? eg : ed;
                    LAS unsigned char* dstl = part == 0 ? sQ : sK; bfr* dstg = (part == 0 ? QGg : KDg) + (size_t)unit * 8192 + tk * 128 + cs * 32;
#pragma unroll
                    for (int q4 = 0; q4 < 4; ++q4) { float z[8];
#pragma unroll
                        for (int i = 0; i < 8; ++i) z[i] = y[8 * q4 + i] * rn;
                        u4v w; w.x = cvtpk(z[0], z[1]); w.y = cvtpk(z[2], z[3]); w.z = cvtpk(z[4], z[5]); w.w = cvtpk(z[6], z[7]);
                        *(LAS u4v*)(dstl + kq_off(tk, cs * 4 + q4)) = w;
                        u4v g; g.x = cvtpk(z[0] * gs, z[1] * gs); g.y = cvtpk(z[2] * gs, z[3] * gs); g.z = cvtpk(z[4] * gs, z[5] * gs); g.w = cvtpk(z[6] * gs, z[7] * gs);
                        *(u4v*)(dstg + 8 * q4) = g;
                        if (part == 1) { kbg[q4].x = cvtpk(z[0] * bg, z[1] * bg); kbg[q4].y = cvtpk(z[2] * bg, z[3] * bg); kbg[q4].z = cvtpk(z[4] * bg, z[5] * bg); kbg[q4].w = cvtpk(z[6] * bg, z[7] * bg); } }
                } else {
#pragma unroll
                    for (int q4 = 0; q4 < 4; ++q4) { vbt[q4].x = cvtpk(y[8 * q4] * beta, y[8 * q4 + 1] * beta); vbt[q4].y = cvtpk(y[8 * q4 + 2] * beta, y[8 * q4 + 3] * beta);
                        vbt[q4].z = cvtpk(y[8 * q4 + 4] * beta, y[8 * q4 + 5] * beta); vbt[q4].w = cvtpk(y[8 * q4 + 6] * beta, y[8 * q4 + 7] * beta); }
                }
            }
            __syncthreads();
            {
                const int r = lane & 15, q = lane >> 4, mt = lw;
                s8v ak[4], aq[4];
#pragma unroll
                for (int ks = 0; ks < 4; ++ks) { ak[ks] = *(const LAS s8v*)(sK + kq_off(16 * mt + r, 4 * ks + q)); aq[ks] = *(const LAS s8v*)(sQ + kq_off(16 * mt + r, 4 * ks + q)); }
                float gi[4], bi[4];
#pragma unroll
                for (int e = 0; e < 4; ++e) { gi[e] = sG[16 * mt + 4 * q + e]; bi[e] = sB[16 * mt + 4 * q + e]; }
                for (int nt = 0; nt < 4; ++nt) {
                    const int j = 16 * nt + r;
                    if (nt <= mt) {
                        f4v ck = zero_acc(), cq = zero_acc();
#pragma unroll
                        for (int ks = 0; ks < 4; ++ks) { const s8v bb = *(const LAS s8v*)(sK + kq_off(16 * nt + r, 4 * ks + q));
                            ck = __builtin_amdgcn_mfma_f32_16x16x32_bf16(ak[ks], bb, ck, 0, 0, 0); cq = __builtin_amdgcn_mfma_f32_16x16x32_bf16(aq[ks], bb, cq, 0, 0, 0); }
                        MFMA_SETTLE(ck); MFMA_SETTLE(cq);
                        const float gj = sG[j];
#pragma unroll
                        for (int e = 0; e < 4; ++e) { const int i = 16 * mt + 4 * q + e; const float dec = expf(fminf(gi[e] - gj, 0.f));
                            const float av = (i > j) ? bi[e] * ck[e] * dec : 0.f;
                            *(LAS bfr*)(sAM + xt_off(i, j >> 3) + (j & 7) * 2) = f2bf1(av);
                            if (nt == mt) sAD[mt * 256 + (4 * q + e) * 16 + r] = av;
                            QKg[(size_t)unit * 4096 + i * 64 + j] = f2bf1((i >= j) ? cq[e] * dec : 0.f); }
                    } else {
#pragma unroll
                        for (int e = 0; e < 4; ++e) QKg[(size_t)unit * 4096 + (16 * mt + 4 * q + e) * 64 + j] = (bfr)0;
                    }
                }
            }
            __syncthreads();
            {
                const int ro = ((tk >> 3)), rb = (tk & 7) * 2;
#pragma unroll
                for (int q4 = 0; q4 < 4; ++q4) {
                    const unsigned vv[4] = {vbt[q4].x, vbt[q4].y, vbt[q4].z, vbt[q4].w}, kk[4] = {kbg[q4].x, kbg[q4].y, kbg[q4].z, kbg[q4].w};
#pragma unroll
                    for (int i = 0; i < 8; ++i) { const int ch = cs * 32 + q4 * 8 + i;
                        *(LAS bfr*)(sX + xt_off(ch, ro) + rb) = (bfr)((i & 1) ? (vv[i >> 1] >> 16) : (vv[i >> 1] & 0xffffu));
                        *(LAS bfr*)(sX + xt_off(128 + ch, ro) + rb) = (bfr)((i & 1) ? (kk[i >> 1] >> 16) : (kk[i >> 1] & 0xffffu)); }
                }
            }
            __syncthreads();
            {
                const int r = lane & 15, q = lane >> 4;
                float x[64];
#pragma unroll
                for (int bk = 0; bk < 4; ++bk) {
                    float corr[16];
#pragma unroll
                    for (int i = 0; i < 16; ++i) corr[i] = 0.f;
                    if (bk > 0) {
                        f4v acc[4] = {zero_acc(), zero_acc(), zero_acc(), zero_acc()};
#pragma unroll
                        for (int ks = 0; ks < (16 * bk + 31) / 32; ++ks) {
                            s8v a = *(const LAS s8v*)(sAM + xt_off(16 * bk + r, 4 * ks + q));
                            if (32 * ks + 8 * q >= 16 * bk) a = (s8v){0, 0, 0, 0, 0, 0, 0, 0};
#pragma unroll
                            for (int nt = 0; nt < 4; ++nt) { const s8v bx = *(const LAS s8v*)(sX + xt_off(64 * lw + 16 * nt + r, 4 * ks + q)); acc[nt] = __builtin_amdgcn_mfma_f32_16x16x32_bf16(a, bx, acc[nt], 0, 0, 0); }
                        }
                        MFMA_SETTLE(acc[0]); MFMA_SETTLE(acc[1]); MFMA_SETTLE(acc[2]); MFMA_SETTLE(acc[3]);
#pragma unroll
                        for (int nt = 0; nt < 4; ++nt)
#pragma unroll
                            for (int e = 0; e < 4; ++e) scr[(16 * nt + r) * 17 + 4 * q + e] = -acc[nt][e];
                        LDS_WAIT(); asm volatile("" ::: "memory");
#pragma unroll
                        for (int i = 0; i < 16; ++i) corr[i] = scr[lane * 17 + i];
                    }
                    const u4v r0 = *(const LAS u4v*)(sX + xt_off(lt, 2 * bk)), r1 = *(const LAS u4v*)(sX + xt_off(lt, 2 * bk + 1));
                    const float rhs[16] = {bflo(r0.x), bfhi(r0.x), bflo(r0.y), bfhi(r0.y), bflo(r0.z), bfhi(r0.z), bflo(r0.w), bfhi(r0.w), bflo(r1.x), bfhi(r1.x), bflo(r1.y), bfhi(r1.y), bflo(r1.z), bfhi(r1.z), bflo(r1.w), bfhi(r1.w)};
                    float xb[16];
#pragma unroll
                    for (int i = 0; i < 16; ++i) {
                        float v = rhs[i] + corr[i];
                        const u4v a0 = *(const LAS u4v*)(sAM + xt_off(16 * bk + i, 2 * bk)), a1 = *(const LAS u4v*)(sAM + xt_off(16 * bk + i, 2 * bk + 1));
                        const float am[16] = {bflo(a0.x), bfhi(a0.x), bflo(a0.y), bfhi(a0.y), bflo(a0.z), bfhi(a0.z), bflo(a0.w), bfhi(a0.w), bflo(a1.x), bfhi(a1.x), bflo(a1.y), bfhi(a1.y), bflo(a1.z), bfhi(a1.z), bflo(a1.w), bfhi(a1.w)};
#pragma unroll
                        for (int j = 0; j < 16; ++j) if (j < i) v -= am[j] * xb[j];
                        xb[i] = v; x[16 * bk + i] = v;
                    }
                    u4v w0, w1; w0.x = cvtpk(xb[0], xb[1]); w0.y = cvtpk(xb[2], xb[3]); w0.z = cvtpk(xb[4], xb[5]); w0.w = cvtpk(xb[6], xb[7]);
                    w1.x = cvtpk(xb[8], xb[9]); w1.y = cvtpk(xb[10], xb[11]); w1.z = cvtpk(xb[12], xb[13]); w1.w = cvtpk(xb[14], xb[15]);
                    *(LAS u4v*)(sX + xt_off(lt, 2 * bk)) = w0; *(LAS u4v*)(sX + xt_off(lt, 2 * bk + 1)) = w1;
                    LDS_WAIT(); asm volatile("" ::: "memory");
                }
                bfr* dst = (lt < 128 ? Ug : Wg) + (size_t)unit * 8192 + (lt & 127);
#pragma unroll
                for (int i = 0; i < 64; ++i) dst[i * 128] = f2bf1(x[i]);
                if (lt == 0) EGg[unit] = expf(sG[63]);
            }
            __syncthreads();
        }
    }
}

__device__ __forceinline__ void p_gdn_scan(const Ctx& C, const Ptrs& P) {
    unsigned char* ws = P.ws_();
    const GAS bfr* Wg = (const GAS bfr*)(ws + WS_R + R_W); const GAS bfr* Ug = (const GAS bfr*)(ws + WS_R + R_U); const GAS bfr* QGg = (const GAS bfr*)(ws + WS_R + R_QG); const GAS bfr* KDg = (const GAS bfr*)(ws + WS_R + R_KD);
    const GAS bfr* QKg = (const GAS bfr*)(ws + WS_R + R_QK); GAS bfr* Og = (GAS bfr*)(ws + WS_R + R_O); const GAS float* EGg = (const GAS float*)(ws + WS_EG);
    const int tid = C.tid, lane = C.lane, wave = C.wave, r = lane & 15, q = lane >> 4, mt = wave & 3, nt = wave >> 2;
    LAS bfr* sST = (LAS bfr*)(C.lds + 131072); LAS bfr* sVN = (LAS bfr*)(C.lds + 139776);
#define SC_W(bb)  ((LAS bfr*)(C.lds + (bb) * 65536))
#define SC_QG(bb) ((LAS bfr*)(C.lds + (bb) * 65536 + 17408))
#define SC_KD(bb) ((LAS bfr*)(C.lds + (bb) * 65536 + 34816))
#define SC_QK(bb) ((LAS bfr*)(C.lds + (bb) * 65536 + 52224))
#define SC_U(bb)  ((LAS bfr*)(C.lds + (bb) * 65536 + 61440))
#define SC_LOAD(n) do { const size_t ub = (size_t)(bh * 64 + (n)) * 8192; \
        rW0 = *(const GAS u4v*)(Wg + ub + (size_t)tid * 8); rW1 = *(const GAS u4v*)(Wg + ub + (size_t)(tid + 512) * 8); \
        rQ0 = *(const GAS u4v*)(QGg + ub + (size_t)tid * 8); rQ1 = *(const GAS u4v*)(QGg + ub + (size_t)(tid + 512) * 8); \
        rK0 = *(const GAS u4v*)(KDg + ub + (size_t)tid * 8); rK1 = *(const GAS u4v*)(KDg + ub + (size_t)(tid + 512) * 8); \
        rQK = *(const GAS u4v*)(QKg + (size_t)(bh * 64 + (n)) * 4096 + (size_t)tid * 8); \
        if (tid < 256) rU = *(const GAS u4v*)(Ug + ub + (size_t)(tid >> 2) * 128 + es * 32 + (tid & 3) * 8); } while (0)
#define SC_WRITE(bb) do { const int c0 = tid, c1 = tid + 512; \
        *(LAS u4v*)(SC_W(bb) + (c0 >> 4) * 136 + (c0 & 15) * 8) = rW0; *(LAS u4v*)(SC_W(bb) + (c1 >> 4) * 136 + (c1 & 15) * 8) = rW1; \
        *(LAS u4v*)(SC_QG(bb) + (c0 >> 4) * 136 + (c0 & 15) * 8) = rQ0; *(LAS u4v*)(SC_QG(bb) + (c1 >> 4) * 136 + (c1 & 15) * 8) = rQ1; \
        *(LAS u4v*)(SC_KD(bb) + (c0 >> 4) * 136 + (c0 & 15) * 8) = rK0; *(LAS u4v*)(SC_KD(bb) + (c1 >> 4) * 136 + (c1 & 15) * 8) = rK1; \
        *(LAS u4v*)(SC_QK(bb) + (tid >> 3) * 72 + (tid & 7) * 8) = rQK; \
        if (tid < 256) *(LAS u4v*)(SC_U(bb) + (tid >> 2) * 32 + (tid & 3) * 8) = rU; } while (0)
    for (int task = C.vcu; task < NB * GH * 4; task += C.G) {
        const int bh = task >> 2, es = task & 3, h = bh & 31, b = bh >> 5;
        u4v rW0, rW1, rQ0, rQ1, rK0, rK1, rQK, rU = {0u, 0u, 0u, 0u};
        f4v S0 = {0.f, 0.f, 0.f, 0.f}, S1 = {0.f, 0.f, 0.f, 0.f};
        LAS float* sEG = (LAS float*)(C.lds + 144384);
        if (tid < 64) sEG[tid] = EGg[bh * 64 + tid];
        SC_LOAD(0); SC_WRITE(0); SC_LOAD(1);
        for (int n = 0; n < NCH; ++n) {
            const int bb = n & 1;
            {
                MFMA_SETTLE(S0); MFMA_SETTLE(S1);
                u2v w0, w1; w0.x = cvtpk(S0[0], S0[1]); w0.y = cvtpk(S0[2], S0[3]); w1.x = cvtpk(S1[0], S1[1]); w1.y = cvtpk(S1[2], S1[3]);
                *(LAS u2v*)(sST + (r) * 136 + 16 * wave + 4 * q) = w0; *(LAS u2v*)(sST + (16 + r) * 136 + 16 * wave + 4 * q) = w1;
            }
            __syncthreads();
            if (n + 1 < NCH) { if (bb) SC_WRITE(0); else SC_WRITE(1); if (n + 2 < NCH) SC_LOAD(n + 2); }
            f4v acc1 = zero_acc(), acc2 = zero_acc();
            const LAS bfr* pW = SC_W(bb) + (16 * mt + r) * 136 + 8 * q; const LAS bfr* pQ = SC_QG(bb) + (16 * mt + r) * 136 + 8 * q; const LAS bfr* pS = sST + (16 * nt + r) * 136 + 8 * q;
#pragma unroll
            for (int ks = 0; ks < 4; ++ks) { const s8v a1 = *(const LAS s8v*)(pW + 32 * ks), a2 = *(const LAS s8v*)(pQ + 32 * ks), bs = *(const LAS s8v*)(pS + 32 * ks);
                acc1 = __builtin_amdgcn_mfma_f32_16x16x32_bf16(a1, bs, acc1, 0, 0, 0); acc2 = __builtin_amdgcn_mfma_f32_16x16x32_bf16(a2, bs, acc2, 0, 0, 0); }
            MFMA_SETTLE(acc1);
            {
                const LAS bfr* pU = SC_U(bb) + (16 * mt + 4 * q) * 32 + 16 * nt + r;
                const float v0 = bf1(pU[0]) - acc1[0], v1 = bf1(pU[32]) - acc1[1], v2 = bf1(pU[64]) - acc1[2], v3 = bf1(pU[96]) - acc1[3];
                u2v w; w.x = cvtpk(v0, v1); w.y = cvtpk(v2, v3);
                *(LAS u2v*)(sVN + (16 * nt + r) * 72 + 16 * mt + 4 * q) = w;
            }
            __syncthreads();
            {
                const LAS bfr* pA = SC_QK(bb) + (16 * mt + r) * 72 + 8 * q; const LAS bfr* pV = sVN + (16 * nt + r) * 72 + 8 * q;
#pragma unroll
                for (int ks = 0; ks < 2; ++ks) { const s8v a = *(const LAS s8v*)(pA + 32 * ks), bv = *(const LAS s8v*)(pV + 32 * ks); acc2 = __builtin_amdgcn_mfma_f32_16x16x32_bf16(a, bv, acc2, 0, 0, 0); }
                MFMA_SETTLE(acc2);
                GAS bfr* po = Og + (size_t)(b * SEQ + n * CH + 16 * mt + 4 * q) * DM + h * 128 + es * 32 + 16 * nt + r;
                po[0] = f2bf1(acc2[0]); po[DM] = f2bf1(acc2[1]); po[2 * DM] = f2bf1(acc2[2]); po[3 * DM] = f2bf1(acc2[3]);
            }
            {
                const float eg = sEG[n];
                S0 *= eg; S1 *= eg;
                const LAS bfr* pK = SC_KD(bb) + (8 * q) * 136 + 16 * wave + r; const LAS bfr* pV0 = sVN + r * 72 + 8 * q; const LAS bfr* pV1 = sVN + (16 + r) * 72 + 8 * q;
#pragma unroll
                for (int ks = 0; ks < 2; ++ks) {
                    s8v a;
#pragma unroll
                    for (int i = 0; i < 8; ++i) a[i] = (short)pK[(32 * ks + i) * 136];
                    const s8v b0 = *(const LAS s8v*)(pV0 + 32 * ks), b1 = *(const LAS s8v*)(pV1 + 32 * ks);
                    S0 = __builtin_amdgcn_mfma_f32_16x16x32_bf16(a, b0, S0, 0, 0, 0); S1 = __builtin_amdgcn_mfma_f32_16x16x32_bf16(a, b1, S1, 0, 0, 0);
                }
            }
        }
        __syncthreads();
    }
#undef SC_W
#undef SC_QG
#undef SC_KD
#undef SC_QK
#undef SC_U
#undef SC_LOAD
#undef SC_WRITE
}

#define S2_OFF_QG 17408
#define S2_OFF_QK 34816
#define S2_OFF_KT 44032
#define S2_OFF_U  62464
#define S2_BUF    66560
__device__ __forceinline__ s8v s2_frag(const LAS bfr* rowp, int q) {
    const u2v lo = *(const LAS u2v*)(rowp + 4 * q), hi = *(const LAS u2v*)(rowp + 16 + 4 * q);
    const u4v w = {lo.x, lo.y, hi.x, hi.y}; return __builtin_bit_cast(s8v, w);
}
__device__ __forceinline__ s8v s2_fragx(const LAS bfr* rowp, int g0, int g1) {
    const u2v lo = *(const LAS u2v*)(rowp + 4 * g0), hi = *(const LAS u2v*)(rowp + 4 * g1);
    const u4v w = {lo.x, lo.y, hi.x, hi.y}; return __builtin_bit_cast(s8v, w);
}
__device__ __forceinline__ s8v s2_pack(const f4v& a, const f4v& b) { const u4v w = {cvtpk(a[0], a[1]), cvtpk(a[2], a[3]), cvtpk(b[0], b[1]), cvtpk(b[2], b[3])}; return __builtin_bit_cast(s8v, w); }
template <int MODE = 0>
__device__ __forceinline__ void p_gdn_scan2(const Ctx& C, const Ptrs& P) {
    unsigned char* ws = P.ws_();
    const GAS bfr* Wg = (const GAS bfr*)(ws + WS_R + R_W); const GAS bfr* Ug = (const GAS bfr*)(ws + WS_R + R_U); const GAS bfr* QGg = (const GAS bfr*)(ws + WS_R + R_QG); const GAS bfr* KDg = (const GAS bfr*)(ws + WS_R + R_KD);
    const GAS bfr* QKg = (const GAS bfr*)(ws + WS_R + R_QK); GAS bfr* Og = (GAS bfr*)(ws + (MODE ? WS_SC : WS_R + R_O)); const GAS float* EGg = (const GAS float*)(ws + WS_EG);
    const int tid = C.tid, lane = C.lane, wave = C.wave, r = lane & 15, q = lane >> 4;
    LAS float* sEG = (LAS float*)(C.lds + 2 * S2_BUF);
    for (int task = C.vcu; task < NB * GH * 4; task += C.G) {
        const int bh = task >> 2, es = task & 3, h = bh & 31, b = bh >> 5;
        if (tid < 64) sEG[tid] = EGg[bh * 64 + tid];
        if (wave >= 2) {
            const int lw = __builtin_amdgcn_readfirstlane((tid - 128) & ~63);
            __builtin_assume(lw >= 0 && lw <= 320);
            const GAS unsigned char* RB = (const GAS unsigned char*)(ws + WS_R);
            const unsigned l16 = lane * 16, lU = (lane >> 2) * 256 + (lane & 3) * 16 + es * 64;
            const unsigned lrow = (lane >> 4) * 272 + (lane & 15) * 16, lqk = (lane >> 3) * 144 + (lane & 7) * 16, lkt = (lane & 15) * 8 * 144 + (lane >> 4) * 2;
            const int lsw = (lane & 15) >> 1;
            u4v ra[10], rb[10];
#define S2_LOAD(R, n) do { const unsigned ua_ = (unsigned)(bh * 64 + ((MODE == 2 || MODE == 4) ? 0 : (n))) * 16384u; _Pragma("unroll") for (int k_ = 0; k_ < 10; ++k_) { const int c0_ = lw + 384 * k_; \
        if (c0_ < 1024) R[k_] = *(const GAS u4v*)(RB + (size_t)((unsigned)R_W + ua_ + c0_ * 16) + l16); \
        else if (c0_ < 2048) R[k_] = *(const GAS u4v*)(RB + (size_t)((unsigned)R_QG + ua_ + (c0_ - 1024) * 16) + l16); \
        else if (c0_ < 2560) R[k_] = *(const GAS u4v*)(RB + (size_t)((unsigned)R_QK + (ua_ >> 1) + (c0_ - 2048) * 16) + l16); \
        else if (c0_ < 2816) R[k_] = *(const GAS u4v*)(RB + (size_t)((unsigned)R_U + ua_ + ((c0_ - 2560) >> 2) * 256) + lU); \
        else R[k_] = *(const GAS u4v*)(RB + (size_t)((unsigned)R_KD + ua_ + (c0_ - 2816) * 16) + l16); } } while (0)
#define S2_WRITE(R, bb) do { LAS unsigned char* B_ = C.lds + (bb) * S2_BUF; _Pragma("unroll") for (int k_ = 0; k_ < 10; ++k_) { const int c0_ = lw + 384 * k_; \
        if (c0_ < 1024) *(LAS u4v*)(B_ + (c0_ >> 4) * 272 + lrow) = R[k_]; \
        else if (c0_ < 2048) *(LAS u4v*)(B_ + S2_OFF_QG + ((c0_ - 1024) >> 4) * 272 + lrow) = R[k_]; \
        else if (c0_ < 2560) *(LAS u4v*)(B_ + S2_OFF_QK + ((c0_ - 2048) >> 3) * 144 + lqk) = R[k_]; \
        else if (c0_ < 2816) *(LAS u4v*)(B_ + S2_OFF_U + (c0_ - 2560) * 16 + l16) = R[k_]; \
        else { const int g_ = (c0_ - 2816) >> 6; LAS bfr* kt_ = (LAS bfr*)(B_ + S2_OFF_KT + lkt + ((g_ ^ lsw) << 3)); const unsigned w_[4] = {R[k_].x, R[k_].y, R[k_].z, R[k_].w}; \
            _Pragma("unroll") for (int i_ = 0; i_ < 8; ++i_) kt_[i_ * 72] = (bfr)((i_ & 1) ? (w_[i_ >> 1] >> 16) : (w_[i_ >> 1] & 0xffffu)); } } } while (0)
            u4v rc[10];
            S2_LOAD(ra, 0); S2_WRITE(ra, 0);
            S2_LOAD(rb, 1); S2_LOAD(rc, 2); S2_LOAD(ra, 3);
            __syncthreads();
#define S2_STEP(R, bb, n_) { S2_WRITE(R, bb); S2_LOAD(R, (n_) + 4); __syncthreads(); }
            for (int n = 0; n < NCH - 4; n += 6) {
                S2_STEP(rb, 1, n) S2_STEP(rc, 0, n + 1) S2_STEP(ra, 1, n + 2) S2_STEP(rb, 0, n + 3) S2_STEP(rc, 1, n + 4) S2_STEP(ra, 0, n + 5)
            }
            static_assert((NCH - 4) % 6 == 0, "scan loader schedule");
            S2_WRITE(rb, 1); __syncthreads(); S2_WRITE(rc, 0); __syncthreads(); S2_WRITE(ra, 1); __syncthreads(); __syncthreads();
#undef S2_STEP
#undef S2_LOAD
#undef S2_WRITE
        } else {
            const int nt = wave;
            f4v S[8];
#pragma unroll
            for (int w = 0; w < 8; ++w) S[w] = zero_acc();
            __syncthreads();
            for (int n = 0; n < NCH; ++n) {
                if (MODE == 3 || MODE == 4) { __syncthreads(); continue; }
                const LAS unsigned char* B = C.lds + (n & 1) * S2_BUF;
                const LAS bfr* sW = (const LAS bfr*)B; const LAS bfr* sQG = (const LAS bfr*)(B + S2_OFF_QG); const LAS bfr* sQK = (const LAS bfr*)(B + S2_OFF_QK);
                const LAS bfr* sKT = (const LAS bfr*)(B + S2_OFF_KT); const LAS bfr* sU = (const LAS bfr*)(B + S2_OFF_U);
#define S2_STAGE() asm volatile("" ::: "memory")
#define S2_LOADQ(F, mt) do { _Pragma("unroll") for (int ks = 0; ks < 4; ++ks) { F[ks] = s2_frag(sW + (16 * (mt) + r) * 136 + 32 * ks, q); F[4 + ks] = s2_frag(sQG + (16 * (mt) + r) * 136 + 32 * ks, q); } } while (0)
#define S2_MMQ(F, mt) do { _Pragma("unroll") for (int ks = 0; ks < 4; ++ks) { a1[mt] = __builtin_amdgcn_mfma_f32_16x16x32_bf16(F[ks], Bs[ks], a1[mt], 0, 0, 0); \
        a2[mt] = __builtin_amdgcn_mfma_f32_16x16x32_bf16(F[4 + ks], Bs[ks], a2[mt], 0, 0, 0); } } while (0)
                s8v fA[8], fB[8];
                S2_LOADQ(fA, 0); S2_LOADQ(fB, 1);
                s8v Bs[4];
#pragma unroll
                for (int ks = 0; ks < 4; ++ks) Bs[ks] = s2_pack(S[2 * ks], S[2 * ks + 1]);
                f4v a1[4], a2[4];
#pragma unroll
                for (int mt = 0; mt < 4; ++mt) { a1[mt] = zero_acc(); a2[mt] = zero_acc(); }
                S2_STAGE();
                S2_MMQ(fA, 0); S2_STAGE(); S2_LOADQ(fA, 2); S2_STAGE();
                S2_MMQ(fB, 1); S2_STAGE(); S2_LOADQ(fB, 3);
                bfr ur[16]; s8v fa[8];
#pragma unroll
                for (int mt = 0; mt < 4; ++mt) { const LAS bfr* pU = sU + (16 * mt + 4 * q) * 32 + 16 * nt + r; ur[4 * mt] = pU[0]; ur[4 * mt + 1] = pU[32]; ur[4 * mt + 2] = pU[64]; ur[4 * mt + 3] = pU[96]; }
                S2_STAGE();
                S2_MMQ(fA, 2); S2_STAGE();
#pragma unroll
                for (int mt = 0; mt < 4; ++mt)
#pragma unroll
                    for (int k2 = 0; k2 < 2; ++k2) fa[2 * mt + k2] = s2_frag(sQK + (16 * mt + r) * 72 + 32 * k2, q);
                S2_STAGE();
                S2_MMQ(fB, 3); S2_STAGE();
#undef S2_LOADQ
#undef S2_MMQ
                s8v fk[16];
#pragma unroll
                for (int w = 0; w < 8; ++w)
#pragma unroll
                    for (int k2 = 0; k2 < 2; ++k2) fk[2 * w + k2] = s2_fragx(sKT + (16 * w + r) * 72 + 32 * k2, q ^ w, (4 + q) ^ w);
                const float eg = sEG[n];
                S2_STAGE();
                f4v vn[4];
#pragma unroll
                for (int mt = 0; mt < 4; ++mt) vn[mt] = (f4v){bf1(ur[4 * mt]) - a1[mt][0], bf1(ur[4 * mt + 1]) - a1[mt][1], bf1(ur[4 * mt + 2]) - a1[mt][2], bf1(ur[4 * mt + 3]) - a1[mt][3]};
                s8v Bv[2];
#pragma unroll
                for (int k2 = 0; k2 < 2; ++k2) Bv[k2] = s2_pack(vn[2 * k2], vn[2 * k2 + 1]);
#pragma unroll
                for (int k2 = 0; k2 < 2; ++k2)
#pragma unroll
                    for (int mt = 0; mt < 4; ++mt) a2[mt] = __builtin_amdgcn_mfma_f32_16x16x32_bf16(fa[2 * mt + k2], Bv[k2], a2[mt], 0, 0, 0);
#pragma unroll
                for (int w = 0; w < 8; ++w) S[w] *= eg;
#pragma unroll
                for (int k2 = 0; k2 < 2; ++k2)
#pragma unroll
                    for (int w = 0; w < 8; ++w) S[w] = __builtin_amdgcn_mfma_f32_16x16x32_bf16(fk[2 * w + k2], Bv[k2], S[w], 0, 0, 0);
#pragma unroll
                for (int mt = 0; mt < 4; ++mt) {
                    GAS bfr* po = Og + (size_t)(b * SEQ + n * CH + 16 * mt + 4 * q) * DM + h * 128 + es * 32 + 16 * nt + r;
                    po[0] = f2bf1(a2[mt][0]); po[DM] = f2bf1(a2[mt][1]); po[2 * DM] = f2bf1(a2[mt][2]); po[3 * DM] = f2bf1(a2[mt][3]); }
#undef S2_STAGE
                MFMA_SETTLE(S[7]);
                __syncthreads();
            }
        }
        __syncthreads();
    }
}
#undef S2_OFF_QG
#undef S2_OFF_QK
#undef S2_OFF_KT
#undef S2_OFF_U
#undef S2_BUF

__device__ __forceinline__ void p_gdn_onorm(const Ctx& C, const Ptrs& P) {
    unsigned char* ws = P.ws_(); const bfr* Og = (const bfr*)(ws + WS_R + R_O); const bfr* PROJ = (const bfr*)(ws + WS_BIG); bfr* AO = (bfr*)(ws + WS_XN); const float* og = P.in_(6);
    const size_t gt = (size_t)C.vcu * 512 + C.tid, GT = (size_t)C.G * 512;
    for (size_t idx0 = gt; idx0 < (size_t)NT * DM / 8; idx0 += 4 * GT) {
        u4v o8[4], z8[4];
#pragma unroll
        for (int b4 = 0; b4 < 4; ++b4) { const size_t idx = idx0 + b4 * GT; const size_t t = idx >> 9; const int hh = (int)(idx >> 4) & 31, i = (int)idx & 15;
            o8[b4] = *(const u4v*)(Og + t * DM + hh * 128 + 8 * i); z8[b4] = *(const u4v*)(PROJ + t * 16384 + 12288 + hh * 128 + 8 * i); }
        const int i = (int)idx0 & 15;
        const f4v g0 = *(const f4v*)(og + 8 * i), g1 = *(const f4v*)(og + 8 * i + 4); const float g[8] = {g0[0], g0[1], g0[2], g0[3], g1[0], g1[1], g1[2], g1[3]};
#pragma unroll
        for (int b4 = 0; b4 < 4; ++b4) { const size_t idx = idx0 + b4 * GT; const size_t t = idx >> 9; const int hh = (int)(idx >> 4) & 31;
            float o[8] = {bflo(o8[b4].x), bfhi(o8[b4].x), bflo(o8[b4].y), bfhi(o8[b4].y), bflo(o8[b4].z), bfhi(o8[b4].z), bflo(o8[b4].w), bfhi(o8[b4].w)};
            float z[8] = {bflo(z8[b4].x), bfhi(z8[b4].x), bflo(z8[b4].y), bfhi(z8[b4].y), bflo(z8[b4].z), bfhi(z8[b4].z), bflo(z8[b4].w), bfhi(z8[b4].w)};
            float ss = 0.f;
#pragma unroll
            for (int k = 0; k < 8; ++k) ss += o[k] * o[k];
            ss += __shfl_xor(ss, 1); ss += __shfl_xor(ss, 2); ss += __shfl_xor(ss, 4); ss += __shfl_xor(ss, 8);
            const float rn = __builtin_amdgcn_rsqf(ss * (1.f / 128.f) + EPS);
            float y[8];
#pragma unroll
            for (int k = 0; k < 8; ++k) y[k] = o[k] * rn * g[k] * (z[k] * __builtin_amdgcn_rcpf(1.f + __expf(-z[k])));
#if F8_OUT0
#pragma unroll
            for (int k = 0; k < 8; ++k) y[k] = fminf(fmaxf(y[k] * SO, -440.f), 440.f);
            u2v w; w.x = cvt4_fp8(y[0], y[1], y[2], y[3]); w.y = cvt4_fp8(y[4], y[5], y[6], y[7]);
            *(u2v*)(ws + WS_XN8 + t * DM + hh * 128 + 8 * i) = w; }
#else
            u4v w; w.x = cvtpk(y[0], y[1]); w.y = cvtpk(y[2], y[3]); w.z = cvtpk(y[4], y[5]); w.w = cvtpk(y[6], y[7]);
            *(u4v*)(AO + t * DM + hh * 128 + 8 * i) = w; }
#endif
    }
}
__device__ __forceinline__ unsigned mono_key(float x) { const unsigned u = __float_as_uint(x); return u ^ ((unsigned)((int)u >> 31) | 0x80000000u); }
#define KEY_INS(K, key) do { unsigned x_ = (key); _Pragma("unroll") for (int s_ = 0; s_ < 16; ++s_) { const unsigned hi_ = max(K[s_], x_); x_ = min(K[s_], x_); K[s_] = hi_; } } while (0)
__device__ __forceinline__ void p_route(const Ctx& C, const Ptrs& P) {
    unsigned char* ws = P.ws_(); const float* SC = (const float*)(ws + WS_SC); bfr* G = (bfr*)(ws + WS_G);
    LAS unsigned char* wl = C.lds + C.wave * 16384;
    LAS int* sE = (LAS int*)(wl); LAS float* sGt = (LAS float*)(wl + 2048); LAS float* sV1 = (LAS float*)(wl + 4096); LAS float* sV2 = (LAS float*)(wl + 8192); LAS int* sI = (LAS int*)(wl + 12288);
    const int lane = C.lane, gw = C.vcu * 8 + C.wave, NGW = C.G * 8;
    for (int wt = gw; wt < NT / 4; wt += NGW) {
        const int tl = lane >> 4, t = wt * 4 + tl;
        unsigned k1[16];
#pragma unroll
        for (int i = 0; i < 16; ++i) k1[i] = 0u;
        const float* base = SC + (size_t)t * PQ + (lane & 15) * 128;
        for (int e = 0; e < 128; e += 4) { const f4v x4 = *(const f4v*)(base + e);
            KEY_INS(k1, (mono_key(x4[0]) & ~127u) | (unsigned)(127 - e)); KEY_INS(k1, (mono_key(x4[1]) & ~127u) | (unsigned)(126 - e));
            KEY_INS(k1, (mono_key(x4[2]) & ~127u) | (unsigned)(125 - e)); KEY_INS(k1, (mono_key(x4[3]) & ~127u) | (unsigned)(124 - e)); }
        const bool h0 = (lane & 1) == 0;
        float v1[16], v2[16];
#pragma unroll
        for (int i = 0; i < 16; ++i) { const int id = 127 - (int)(k1[i] & 127u); const float vv = base[id];
            const float ov = __shfl_xor(vv, 1); const int oi = __shfl_xor(id, 1);
            v1[i] = h0 ? vv : ov; v2[i] = h0 ? ov : vv; const int ia = h0 ? id : oi, ib = h0 ? oi : id;
            sV1[i * 64 + lane] = v1[i]; sV2[i * 64 + lane] = v2[i]; sI[i * 64 + lane] = ia | (ib << 8); }
        unsigned k2[16];
#pragma unroll
        for (int i = 0; i < 16; ++i) k2[i] = 0u;
#pragma unroll
        for (int a = 0; a < 16; ++a)
#pragma unroll
            for (int b = 0; b < 16; ++b)
                if ((a + 1) * (b + 1) <= 16) KEY_INS(k2, (mono_key(v1[a] + v2[b]) & ~255u) | (unsigned)(255 - (a * 16 + b)));
        LDS_WAIT(); asm volatile("" ::: "memory");
        float ts[16]; int te[16]; float mx = -__builtin_inff();
#pragma unroll
        for (int i = 0; i < 16; ++i) { const int code = 255 - (int)(k2[i] & 255u), a = code >> 4, b = code & 15;
            ts[i] = sV1[a * 64 + lane] + sV2[b * 64 + lane]; te[i] = (sI[a * 64 + lane] & 0xff) * 128 + (sI[b * 64 + lane] >> 8); mx = fmaxf(mx, ts[i]); }
        float sum = 0.f;
#pragma unroll
        for (int i = 0; i < 16; ++i) { ts[i] = __expf(ts[i] - mx); sum += ts[i]; }
        const float inv = 1.f / sum;
        if (h0) { const int hb = ((lane >> 1) & 7) * 16;
#pragma unroll
            for (int i = 0; i < 16; ++i) { sE[tl * 128 + hb + i] = te[i]; sGt[tl * 128 + hb + i] = ts[i] * inv; } }
        LDS_WAIT(); asm volatile("" ::: "memory");
        for (int k = 0; k < 4; ++k) {
            const size_t tt = (size_t)wt * 4 + k; u4v* row = (u4v*)(G + tt * PE); const u4v z = {0u, 0u, 0u, 0u};
#pragma unroll 8
            for (int j = 0; j < 32; ++j) row[j * 64 + lane] = z;
            const int e0 = sE[k * 128 + lane], e1 = sE[k * 128 + 64 + lane]; float t0 = 0.f, t1 = 0.f; bool f0 = true, f1 = true;
            for (int j = 0; j < 128; j += 4) { const i4v ej = *(const LAS i4v*)(sE + k * 128 + j); const f4v gj = *(const LAS f4v*)(sGt + k * 128 + j);
                if (ej.x == e0) { t0 += gj[0]; if (j + 0 < lane) f0 = false; } if (ej.y == e0) { t0 += gj[1]; if (j + 1 < lane) f0 = false; }
                if (ej.z == e0) { t0 += gj[2]; if (j + 2 < lane) f0 = false; } if (ej.w == e0) { t0 += gj[3]; if (j + 3 < lane) f0 = false; }
                if (ej.x == e1) { t1 += gj[0]; if (j + 0 < lane + 64) f1 = false; } if (ej.y == e1) { t1 += gj[1]; if (j + 1 < lane + 64) f1 = false; }
                if (ej.z == e1) { t1 += gj[2]; if (j + 2 < lane + 64) f1 = false; } if (ej.w == e1) { t1 += gj[3]; if (j + 3 < lane + 64) f1 = false; } }
            VM_WAIT();
            if (f0) G[tt * PE + e0] = f2bf1(t0);
            if (f1) G[tt * PE + e1] = f2bf1(t1);
        }
        LDS_WAIT(); asm volatile("" ::: "memory");
    }
}

typedef _Float16 h2v __attribute__((ext_vector_type(2)));
__device__ __forceinline__ unsigned char gate_code(float g) { const float c = 195.f + 20.f * __log2f(g); return (unsigned char)(int)fminf(fmaxf(c + 0.5f, 1.f), 255.f); }
__device__ __forceinline__ void p_sroute(const Ctx& C, const Ptrs& P, int layer) {
    unsigned char* ws = P.ws_(); const bfr* QRY = (const bfr*)(ws + WS_QRY); const bfr* KEY = (const bfr*)(ws + WS_WTKEY) + (size_t)layer * PQ * PQ; unsigned char* G = ws + WS_G;
    const int lane = C.lane, wave = C.wave, r = lane & 15, q = lane >> 4;
    LAS unsigned char* wl = C.lds + wave * 16640;
    LAS _Float16* sS = (LAS _Float16*)wl;
    LAS float* sV1 = (LAS float*)(wl); LAS float* sV2 = (LAS float*)(wl + 4096); LAS int* sI = (LAS int*)(wl + 8192);
    LAS int* sE = (LAS int*)(C.lds); LAS float* sGt = (LAS float*)(C.lds + 16384);
    LAS unsigned* bm = (LAS unsigned*)(C.lds + 32768 + wave * 3200); LAS unsigned* cnt = bm + 512; LAS int* le = (LAS int*)(bm + 516); LAS float* lg = (LAS float*)(bm + 516 + 128);
    for (int blk = C.vcu; blk < NT / 32; blk += C.G) {
        const int t0 = blk * 32;
#pragma unroll
        for (int hf = 0; hf < 2; ++hf) {
            const int hh = wave * 2 + hf;
            s8v a[2][4];
#pragma unroll
            for (int mt = 0; mt < 2; ++mt)
#pragma unroll
                for (int ks = 0; ks < 4; ++ks) a[mt][ks] = *(const s8v*)(QRY + (size_t)(t0 + 16 * mt + r) * PQ + hh * 128 + 32 * ks + 8 * q);
#pragma unroll
            for (int nt = 0; nt < 8; ++nt) {
                s8v b[4];
#pragma unroll
                for (int ks = 0; ks < 4; ++ks) b[ks] = *(const s8v*)(KEY + (size_t)(hh * 128 + 16 * nt + r) * PQ + hh * 128 + 32 * ks + 8 * q);
                f4v c0 = zero_acc(), c1 = zero_acc();
#pragma unroll
                for (int ks = 0; ks < 4; ++ks) { c0 = __builtin_amdgcn_mfma_f32_16x16x32_bf16(a[0][ks], b[ks], c0, 0, 0, 0); c1 = __builtin_amdgcn_mfma_f32_16x16x32_bf16(a[1][ks], b[ks], c1, 0, 0, 0); MFMA_SETTLE(c0); MFMA_SETTLE(c1); }
                MFMA_SETTLE(c0); MFMA_SETTLE(c1);
#pragma unroll
                for (int e = 0; e < 4; ++e) { sS[(32 * hf + 4 * q + e) * 130 + 16 * nt + r] = (_Float16)c0[e]; sS[(32 * hf + 16 + 4 * q + e) * 130 + 16 * nt + r] = (_Float16)c1[e]; }
            }
        }
        LDS_WAIT(); asm volatile("" ::: "memory");
        unsigned k1[16];
#pragma unroll
        for (int i = 0; i < 16; ++i) k1[i] = 0u;
        const LAS h2v* lp = (const LAS h2v*)(sS + lane * 130);
        for (int e = 0; e < 128; e += 8) {
#pragma unroll
            for (int u = 0; u < 4; ++u) { const h2v x2 = lp[(e >> 1) + u];
                KEY_INS(k1, (mono_key((float)x2[0]) & ~127u) | (unsigned)(127 - e - 2 * u)); KEY_INS(k1, (mono_key((float)x2[1]) & ~127u) | (unsigned)(126 - e - 2 * u)); }
        }
        const bool h0 = lane < 32;
        float v1[16], v2[16]; int ids[16]; float vals[16];
#pragma unroll
        for (int i = 0; i < 16; ++i) { ids[i] = 127 - (int)(k1[i] & 127u); vals[i] = (float)sS[lane * 130 + ids[i]]; }
        LDS_WAIT(); asm volatile("" ::: "memory");
#pragma unroll
        for (int i = 0; i < 16; ++i) { const float ov = __shfl_xor(vals[i], 32); const int oi = __shfl_xor(ids[i], 32);
            v1[i] = h0 ? vals[i] : ov; v2[i] = h0 ? ov : vals[i]; const int ia = h0 ? ids[i] : oi, ib = h0 ? oi : ids[i];
            sV1[i * 64 + lane] = v1[i]; sV2[i * 64 + lane] = v2[i]; sI[i * 64 + lane] = ia | (ib << 8); }
        unsigned k2[16];
#pragma unroll
        for (int b = 0; b < 16; ++b) k2[b] = (mono_key(v1[0] + v2[b]) & ~255u) | (unsigned)(255 - b);
#pragma unroll
        for (int a = 1; a < 16; ++a)
#pragma unroll
            for (int b = 0; b < 16; ++b)
                if ((a + 1) * (b + 1) <= 16) KEY_INS(k2, (mono_key(v1[a] + v2[b]) & ~255u) | (unsigned)(255 - (a * 16 + b)));
        LDS_WAIT(); asm volatile("" ::: "memory");
        float ts[16]; int te[16]; float mx = -__builtin_inff();
#pragma unroll
        for (int i = 0; i < 16; ++i) { const int code = 255 - (int)(k2[i] & 255u), a = code >> 4, b = code & 15;
            ts[i] = sV1[a * 64 + lane] + sV2[b * 64 + lane]; te[i] = (sI[a * 64 + lane] & 0xff) * 128 + (sI[b * 64 + lane] >> 8); mx = fmaxf(mx, ts[i]); }
        float sum = 0.f;
#pragma unroll
        for (int i = 0; i < 16; ++i) { ts[i] = __expf(ts[i] - mx); sum += ts[i]; }
        const float inv = 1.f / sum;
        __syncthreads();
        if (h0) {
#pragma unroll
            for (int i = 0; i < 16; ++i) { sE[lane * 128 + wave * 16 + i] = te[i]; sGt[lane * 128 + wave * 16 + i] = ts[i] * inv; } }
        __syncthreads();
        for (int k = 0; k < 4; ++k) {
            const int tl = wave * 4 + k; const size_t tt = (size_t)t0 + tl;
            if (layer == 0) { u4v* row = (u4v*)(G + tt * PE); const u4v z = {0u, 0u, 0u, 0u};
#pragma unroll 8
                for (int j = 0; j < 16; ++j) row[j * 64 + lane] = z; }
            const int e0 = sE[tl * 128 + lane], e1 = sE[tl * 128 + 64 + lane]; float t0s = sGt[tl * 128 + lane], t1s = sGt[tl * 128 + 64 + lane];
#pragma unroll
            for (int j = 0; j < 8; ++j) bm[j * 64 + lane] = 0u;
            if (lane == 0) *cnt = 0u;
            LDS_WAIT(); asm volatile("" ::: "memory");
            const unsigned b0 = 1u << (e0 & 31), b1 = 1u << (e1 & 31);
            const bool d0 = (__hip_atomic_fetch_or(bm + (e0 >> 5), b0, __ATOMIC_RELAXED, __HIP_MEMORY_SCOPE_WORKGROUP) & b0) != 0u;
            const bool d1 = (__hip_atomic_fetch_or(bm + (e1 >> 5), b1, __ATOMIC_RELAXED, __HIP_MEMORY_SCOPE_WORKGROUP) & b1) != 0u;
            if (d0) { const unsigned sl = __hip_atomic_fetch_add(cnt, 1u, __ATOMIC_RELAXED, __HIP_MEMORY_SCOPE_WORKGROUP); le[sl] = e0; lg[sl] = t0s; }
            if (d1) { const unsigned sl = __hip_atomic_fetch_add(cnt, 1u, __ATOMIC_RELAXED, __HIP_MEMORY_SCOPE_WORKGROUP); le[sl] = e1; lg[sl] = t1s; }
            LDS_WAIT(); asm volatile("" ::: "memory");
            const int nd = (int)__builtin_amdgcn_readfirstlane((int)*cnt);
            for (int j = 0; j < nd; ++j) { const int ej = le[j]; const float gj = lg[j]; if (ej == e0 && !d0) t0s += gj; if (ej == e1 && !d1) t1s += gj; }
            const bool f0 = !d0, f1 = !d1;
            VM_WAIT();
            if (f0) G[tt * PE + e0] = gate_code(t0s);
            if (f1) G[tt * PE + e1] = gate_code(t1s);
        }
        __syncthreads();
    }
}

constexpr int KIND_V = F8_KVQ ? 2 : 1;
__device__ __forceinline__ void p_headprep(const Ctx& C, const Ptrs& P) {
    unsigned char* ws = P.ws_(); const bfr* KVQ = (const bfr*)(ws + WS_BIG); bfr* Qh = (bfr*)(ws + WS_R + R_QH); bfr* Kh = (bfr*)(ws + WS_R + R_KH); bfr* Vh = (bfr*)(ws + WS_R + R_VH);
    const float* kg = P.in_(10); const float* qg = P.in_(13);
    const size_t gt = (size_t)C.vcu * 512 + C.tid, GT = (size_t)C.G * 512;
    constexpr int NV16 = F8_KVQ ? 1024 : 1536;
    for (size_t idx0 = gt; idx0 < (size_t)NT * NV16; idx0 += 4 * GT) {
        u4v x8[4];
#pragma unroll
        for (int b4 = 0; b4 < 4; ++b4) { const size_t idx = idx0 + b4 * GT; const size_t t = idx / NV16; const int rem = (int)(idx - t * NV16), vec = rem >> 4, i = rem & 15;
            x8[b4] = *(const u4v*)(KVQ + t * 12288 + vec * 128 + 8 * i); }
#pragma unroll
        for (int b4 = 0; b4 < 4; ++b4) { const size_t idx = idx0 + b4 * GT; const size_t t = idx / NV16; const int rem = (int)(idx - t * NV16), vec = rem >> 4, i = rem & 15, kind = vec >> 5, sh = vec & 31;
            float x[8] = {bflo(x8[b4].x), bfhi(x8[b4].x), bflo(x8[b4].y), bfhi(x8[b4].y), bflo(x8[b4].z), bfhi(x8[b4].z), bflo(x8[b4].w), bfhi(x8[b4].w)};
            float ss = 0.f;
#pragma unroll
            for (int k = 0; k < 8; ++k) ss += x[k] * x[k];
            ss += __shfl_xor(ss, 1); ss += __shfl_xor(ss, 2); ss += __shfl_xor(ss, 4); ss += __shfl_xor(ss, 8);
            u4v w = x8[b4];
            if (kind != KIND_V) { const float rn = __builtin_amdgcn_rsqf(ss * (1.f / 128.f) + EPS); const float* gp = (kind == 0 ? kg : qg) + 8 * i; const f4v g0 = *(const f4v*)gp, g1 = *(const f4v*)(gp + 4);
                w.x = cvtpk(x[0] * rn * g0[0], x[1] * rn * g0[1]); w.y = cvtpk(x[2] * rn * g0[2], x[3] * rn * g0[3]); w.z = cvtpk(x[4] * rn * g1[0], x[5] * rn * g1[1]); w.w = cvtpk(x[6] * rn * g1[2], x[7] * rn * g1[3]); }
            const size_t b = t >> 12, s = t & 4095; bfr* dst = (kind == 0 ? Kh : (kind == KIND_V ? Vh : Qh)) + ((b * 32 + sh) * SEQ + s) * 128 + 8 * i;
            *(u4v*)dst = w; }
    }
}

__device__ __forceinline__ att::BlockRef<att::bf16, att::bf16> attn_ref(const att::bf16* Qh, const att::bf16* Kh, const att::bf16* Vh, att::bf16* Oh, int bhp, int qb) {
    const int b = bhp >> 6, hd = (bhp >> 2) & 15, c = (bhp >> 1) & 1, vh = bhp & 1;
    att::BlockRef<att::bf16, att::bf16> r;
    r.Q = Qh + ((size_t)(b * 32 + hd * 2 + c) * SEQ + (size_t)qb * 256) * 128; r.K = Kh + (size_t)(b * 32 + hd * 2 + c) * SEQ * 128; r.V = att::VSTR == 128 ? Vh + (size_t)(b * 32 + hd * 2 + vh) * SEQ * 128 : Vh + (size_t)b * SEQ * att::VSTR + 8192 + (hd * 2 + vh) * 128;
    r.O = Oh + ((size_t)bhp * SEQ + (size_t)qb * 256) * 128; r.P0 = qb * 256;
    return r;
}
__device__ __forceinline__ void p_attn(const Ctx& C, const Ptrs& P) {
    unsigned char* ws = P.ws_(); const att::bf16* Qh = (const att::bf16*)(ws + WS_R + R_QH); const att::bf16* Kh = (const att::bf16*)(ws + WS_R + R_KH); const att::bf16* Vh = (const att::bf16*)(att::VSTR == 128 ? ws + WS_R + R_VH : ws + WS_BIG);
    att::bf16* Oh = (att::bf16*)(ws + WS_R + R_OH);
    extern __shared__ __attribute__((aligned(16))) char lds_sym[]; char* lds = lds_sym;
    constexpr int total = 128 * 8;
    int L = C.vcu; if (L >= total) return;
    int pass = 0;
    att::BlockRef<att::bf16, att::bf16> cur = attn_ref(Qh, Kh, Vh, Oh, L >> 3, L & 7);
    att::Seam<att::bf16> S;
    att::causal_swa_prime<att::bf16, att::bf16>(cur, SEQ, lds, S);
    for (;;) {
        const bool more_pass = pass == 0, more_item = L + C.G < total, last = !more_pass && !more_item;
        int passn = pass + 1, Ln = L;
        if (!more_pass) { passn = 0; Ln = more_item ? L + C.G : L; }
        const att::BlockRef<att::bf16, att::bf16> nxt = last ? cur : attn_ref(Qh, Kh, Vh, Oh, Ln >> 3, passn ? 15 - (Ln & 7) : (Ln & 7));
        att::causal_swa_block<att::bf16, att::bf16>(cur, nxt, SEQ, SEQ, lds, S);
        if (last) break;
        cur = nxt; pass = passn; L = Ln;
    }
    __syncthreads();
}

__device__ __forceinline__ void p_combine(const Ctx& C, const Ptrs& P) {
    unsigned char* ws = P.ws_(); const bfr* Oh = (const bfr*)(ws + WS_R + R_OH); bfr* AO = (bfr*)(ws + WS_XN); const float* sg = P.in_(18);
    float lam;
    { const float* q1 = P.in_(14); const float* k1 = P.in_(15); const float* q2 = P.in_(16); const float* k2 = P.in_(17); const int l = C.lane;
      const float d1 = wave_sum(q1[l] * k1[l] + q1[l + 64] * k1[l + 64]), d2 = wave_sum(q2[l] * k2[l] + q2[l + 64] * k2[l + 64]);
      lam = expf(d1) - expf(d2) + LAMBDA_INIT; }
    const size_t gt = (size_t)C.vcu * 512 + C.tid, GT = (size_t)C.G * 512;
    for (size_t idx0 = gt; idx0 < (size_t)NT * 512; idx0 += 4 * GT) {
        u4v a8[4], b8[4];
#pragma unroll
        for (int b4 = 0; b4 < 4; ++b4) { const size_t idx = idx0 + b4 * GT; const size_t t = idx >> 9, b = t >> 12, s = t & 4095; const int hd = (int)(idx >> 5) & 15, i = (int)idx & 31, vh = i >> 4, d = (8 * i) & 127;
            const size_t o0i = ((((b * 16 + hd) * 2 + 0) * 2 + vh) * SEQ + s) * 128 + d, o1i = ((((b * 16 + hd) * 2 + 1) * 2 + vh) * SEQ + s) * 128 + d;
            a8[b4] = *(const u4v*)(Oh + o0i); b8[b4] = *(const u4v*)(Oh + o1i); }
        const int i = (int)idx0 & 31;
        const f4v g0 = *(const f4v*)(sg + 8 * i), g1 = *(const f4v*)(sg + 8 * i + 4);
#pragma unroll
        for (int b4 = 0; b4 < 4; ++b4) { const size_t idx = idx0 + b4 * GT; const size_t t = idx >> 9; const int hd = (int)(idx >> 5) & 15;
            float o[8] = {bflo(a8[b4].x) - lam * bflo(b8[b4].x), bfhi(a8[b4].x) - lam * bfhi(b8[b4].x), bflo(a8[b4].y) - lam * bflo(b8[b4].y), bfhi(a8[b4].y) - lam * bfhi(b8[b4].y),
                          bflo(a8[b4].z) - lam * bflo(b8[b4].z), bfhi(a8[b4].z) - lam * bfhi(b8[b4].z), bflo(a8[b4].w) - lam * bflo(b8[b4].w), bfhi(a8[b4].w) - lam * bfhi(b8[b4].w)};
            float ss = 0.f;
#pragma unroll
            for (int k = 0; k < 8; ++k) ss += o[k] * o[k];
            ss += __shfl_xor(ss, 1); ss += __shfl_xor(ss, 2); ss += __shfl_xor(ss, 4); ss += __shfl_xor(ss, 8); ss += __shfl_xor(ss, 16);
            const float rn = __builtin_amdgcn_rsqf(ss * (1.f / 256.f) + EPS) * (1.f - LAMBDA_INIT);
#if F8_OUT1
            const float rs = rn * SO; float y[8] = {o[0] * rs * g0[0], o[1] * rs * g0[1], o[2] * rs * g0[2], o[3] * rs * g0[3], o[4] * rs * g1[0], o[5] * rs * g1[1], o[6] * rs * g1[2], o[7] * rs * g1[3]};
#pragma unroll
            for (int k = 0; k < 8; ++k) y[k] = fminf(fmaxf(y[k], -440.f), 440.f);
            u2v w; w.x = cvt4_fp8(y[0], y[1], y[2], y[3]); w.y = cvt4_fp8(y[4], y[5], y[6], y[7]);
            *(u2v*)(ws + WS_XN8 + t * DM + hd * 256 + 8 * i) = w; }
#else
            u4v w; w.x = cvtpk(o[0] * rn * g0[0], o[1] * rn * g0[1]); w.y = cvtpk(o[2] * rn * g0[2], o[3] * rn * g0[3]); w.z = cvtpk(o[4] * rn * g1[0], o[5] * rn * g1[1]); w.w = cvtpk(o[6] * rn * g1[2], o[7] * rn * g1[3]);
            *(u4v*)(AO + t * DM + hd * 256 + 8 * i) = w; }
#endif
    }
}
constexpr int NPH_LAYER = 13, NPHASE = 1 + 2 * NPH_LAYER;
#ifndef MK_PER_PHASE
#define MK_PER_PHASE 0
#endif

__global__ void __launch_bounds__(512, 2) trunk_fwd(KArgs KA) {
    extern __shared__ __attribute__((aligned(16))) unsigned char lds_raw[];
    Ctx C; C.lds = (LAS unsigned char*)lds_raw; C.tid = threadIdx.x; C.lane = C.tid & 63; C.wave = __builtin_amdgcn_readfirstlane(C.tid >> 6);
    C.G = gridDim.x; { const int bx = blockIdx.x; C.vcu = (C.G % 8 == 0) ? (bx % 8) * (C.G / 8) + bx / 8 : bx; }
    volatile LAS unsigned* MISC = (volatile LAS unsigned*)(C.lds + MISC_OFF);
    for (int u = C.tid; u < (LDS_BYTES - MISC_OFF) / 4; u += 512) MISC[u] = 0u;
    __syncthreads();
    Ptrs P; P.tbl = (LAS unsigned long long*)(C.lds + MISC_OFF + 128);
    if (C.tid < 28) P.tbl[C.tid] = ((const unsigned long long*)&KA)[C.tid];
    __syncthreads();
    unsigned* ctl = (unsigned*)(P.ws_() + WS_CTL);
    const int lo = KA.ph_lo, hi = KA.ph_hi;
    XcdBarrier bar; bar.bar = ctl + CW_BAR + KA.li * XCD_BAR_WORDS; bar.x = 0; bar.st = MISC + 8;
    if (hi - lo > 1) bar = xcd_barrier_post(ctl + CW_BAR + KA.li * XCD_BAR_WORDS, MISC + 8);
#define IN(k) (lo <= (k) && (k) < hi)
#define SEAM(k) do { if (IN(k) && IN((k) + 1)) xcd_barrier(bar); } while (0)
    unsigned char* ws = P.ws_();
    bfr* XN = (bfr*)(ws + WS_XN); bfr* BIG = (bfr*)(ws + WS_BIG);
    const int hb = (int)blockIdx.x;

    if (IN(0)) { p_convert(C, P, 0, C.vcu, C.G); __syncthreads();
#if NPREP >= 32
        p_convert(C, P, 1, C.vcu, C.G); __syncthreads();
#endif
        p_norm_rows(C, P.in_(0), XN, F8_PROJ0 != 0 ? ws + WS_XN8 : nullptr); }
    SEAM(0);
    {
        constexpr int layer = 0;
        const int pb = 1 + layer * NPH_LAYER;
        if (layer == 1 && IN(pb + 0)) p_norm_rows(C, (const float*)P.out_(), F8_KVQ == 2 ? nullptr : XN, F8_KVQ != 0 ? ws + WS_XN8 : nullptr);
        if (layer == 1) SEAM(pb + 0);
        if (IN(pb + 1)) {
            const int N = layer == 0 ? 16384 : 12288;
            if (layer == 0 && F8_PROJ0 == 2) {
                { pg8::Gemm g{XN, (const bfr*)(ws + WS_WTIN), NT, 8192, DM}; pg8::StaticOrder S; S.init(NT, 8192, C.G, hb);
                  pg8::EpiBf16<0> E{BIG, N, nullptr, 0, 0, 1.f};
                  pg8::gemm_phase<pg8::EpiBf16<0>, pg8::StaticOrder, true, true>((PG8_LAS unsigned char*)C.lds, g, S, E); }
                __syncthreads();
                { pg8::Gemm g{(const bfr*)(ws + WS_XN8), (const bfr*)(ws + WS_WTIN + (size_t)8192 * DM * 2), NT, 8192, DM / 2}; pg8::StaticOrder S; S.init(NT, 8192, C.G, hb);
                  pg8::EpiBf16<0> E{BIG + 8192, N, nullptr, 8192, 0, 1.f / SU};
                  pg8::gemm_phase<pg8::EpiBf16<0>, pg8::StaticOrder, true, true, true>((PG8_LAS unsigned char*)C.lds, g, S, E); }
            } else if (layer == 0 && F8_PROJ0 == 5) {
                { pg8::Gemm g{(const bfr*)(ws + WS_XN8), (const bfr*)(ws + WS_WTIN), NT, 8192, DM / 2}; pg8::StaticOrder S; S.init(NT, 8192, C.G, hb);
                  pg8::EpiBf16<0> E{BIG, N, nullptr, 8192, 0, 1.f / SU};
                  pg8::gemm_phase<pg8::EpiBf16<0>, pg8::StaticOrder, true, true, true>((PG8_LAS unsigned char*)C.lds, g, S, E); }
                __syncthreads();
                { pg8::Gemm g{XN, (const bfr*)(ws + WS_WTIN + (size_t)32 * MiB), NT, 4096, DM}; pg8::StaticOrder S; S.init(NT, 4096, C.G, hb);
                  pg8::EpiBf16<0> E{BIG + 8192, N, nullptr, 0, 0, 1.f};
                  pg8::gemm_phase<pg8::EpiBf16<0>, pg8::StaticOrder, true, true>((PG8_LAS unsigned char*)C.lds, g, S, E); }
                __syncthreads();
                { pg8::Gemm g{(const bfr*)(ws + WS_XN8), (const bfr*)(ws + WS_WTIN + (size_t)64 * MiB), NT, 4096, DM / 2}; pg8::StaticOrder S; S.init(NT, 4096, C.G, hb);
                  pg8::EpiBf16<0> E{BIG + 12288, N, nullptr, 4096, 0, 1.f / SU};
                  pg8::gemm_phase<pg8::EpiBf16<0>, pg8::StaticOrder, true, true, true>((PG8_LAS unsigned char*)C.lds, g, S, E); }
            } else if (layer == 0 && F8_PROJ0 == 6) {
                { pg8::Gemm g{(const bfr*)(ws + WS_XN8), (const bfr*)(ws + WS_WTIN), NT, 12288, DM / 2}; pg8::StaticOrder S; S.init(NT, 12288, C.G, hb);
                  pg8::EpiBf16<0> E{BIG, N, nullptr, 12288, 0, 1.f / SU};
                  pg8::gemm_phase<pg8::EpiBf16<0>, pg8::StaticOrder, true, true, true>((PG8_LAS unsigned char*)C.lds, g, S, E); }
                __syncthreads();
                { pg8::Gemm g{XN, (const bfr*)(ws + WS_WTIN + (size_t)48 * MiB), NT, 4096, DM}; pg8::StaticOrder S; S.init(NT, 4096, C.G, hb);
                  pg8::EpiBf16<0> E{BIG + 12288, N, nullptr, 0, 0, 1.f};
                  pg8::gemm_phase<pg8::EpiBf16<0>, pg8::StaticOrder, true, true>((PG8_LAS unsigned char*)C.lds, g, S, E); }
            } else if (layer == 0 && F8_PROJ0 == 4) {
                { pg8::Gemm g{(const bfr*)(ws + WS_XN8), (const bfr*)(ws + WS_WTIN), NT, 4096, DM / 2}; pg8::StaticOrder S; S.init(NT, 4096, C.G, hb);
                  pg8::EpiBf16<0> E{BIG, N, nullptr, 4096, 0, 1.f / SU};
                  pg8::gemm_phase<pg8::EpiBf16<0>, pg8::StaticOrder, true, true, true>((PG8_LAS unsigned char*)C.lds, g, S, E); }
                __syncthreads();
                { pg8::Gemm g{XN, (const bfr*)(ws + WS_WTIN + (size_t)4096 * DM), NT, 12288, DM}; pg8::StaticOrder S; S.init(NT, 12288, C.G, hb);
                  pg8::EpiBf16<0> E{BIG + 4096, N, nullptr, 0, 0, 1.f};
                  pg8::gemm_phase<pg8::EpiBf16<0>, pg8::StaticOrder, true, true>((PG8_LAS unsigned char*)C.lds, g, S, E); }
            } else if (layer == 0 && F8_PROJ0 == 3) {
                { pg8::Gemm g{(const bfr*)(ws + WS_XN8), (const bfr*)(ws + WS_WTIN), NT, 8192, DM / 2}; pg8::StaticOrder S; S.init(NT, 8192, C.G, hb);
                  pg8::EpiBf16<0> E{BIG, N, nullptr, 8192, 0, 1.f / SU};
                  pg8::gemm_phase<pg8::EpiBf16<0>, pg8::StaticOrder, true, true, true>((PG8_LAS unsigned char*)C.lds, g, S, E); }
                __syncthreads();
                { pg8::Gemm g{XN, (const bfr*)(ws + WS_WTIN + (size_t)8192 * DM), NT, 8192, DM}; pg8::StaticOrder S; S.init(NT, 8192, C.G, hb);
                  pg8::EpiBf16<0> E{BIG + 8192, N, nullptr, 0, 0, 1.f};
                  pg8::gemm_phase<pg8::EpiBf16<0>, pg8::StaticOrder, true, true>((PG8_LAS unsigned char*)C.lds, g, S, E); }
            } else if (layer == 0 && F8_PROJ0 == 1) {
                pg8::Gemm g{(const bfr*)(ws + WS_XN8), (const bfr*)(ws + WS_WTIN), NT, N, DM / 2}; pg8::StaticOrder S; S.init(NT, N, C.G, hb);
                pg8::EpiBf16<0> E{BIG, N, nullptr, N, 0, 1.f / SU};
                pg8::gemm_phase<pg8::EpiBf16<0>, pg8::StaticOrder, true, true, true>((PG8_LAS unsigned char*)C.lds, g, S, E);
            } else if (layer == 1 && F8_KVQ == 2) {
                pg8::Gemm g{(const bfr*)(ws + WS_XN8), (const bfr*)(ws + WS_WTKVQ), NT, N, DM / 2}; pg8::StaticOrder S; S.init(NT, N, C.G, hb);
                pg8::EpiHead E{(bfr*)(ws + WS_R + R_KH), (bfr*)(ws + WS_R + R_QH), (bfr*)(ws + WS_R + R_VH), P.in_(10), P.in_(13), 1.f / SU};
                pg8::gemm_phase<pg8::EpiHead, pg8::StaticOrder, true, true, true>((PG8_LAS unsigned char*)C.lds, g, S, E);
            } else if (layer == 1 && F8_KVQ) {
                { pg8::Gemm g{(const bfr*)(ws + WS_XN8), (const bfr*)(ws + WS_WTKVQ), NT, 8192, DM / 2}; pg8::StaticOrder S; S.init(NT, 8192, C.G, hb);
                  pg8::EpiBf16<0> E{BIG, N, nullptr, 8192, 0, 1.f / SU};
                  pg8::gemm_phase<pg8::EpiBf16<0>, pg8::StaticOrder, true, true, true>((PG8_LAS unsigned char*)C.lds, g, S, E); }
                __syncthreads();
                { pg8::Gemm g{XN, (const bfr*)(ws + WS_WTKVQ + (size_t)2 * DM * DM), NT, DM, DM}; pg8::StaticOrder S; S.init(NT, DM, C.G, hb);
                  pg8::EpiBf16<0> E{BIG + 8192, N, nullptr, 0, 0, 1.f};
                  pg8::gemm_phase<pg8::EpiBf16<0>, pg8::StaticOrder, true, true>((PG8_LAS unsigned char*)C.lds, g, S, E); }
            } else {
                pg8::Gemm g{XN, (const bfr*)(ws + (layer == 0 ? WS_WTIN : WS_WTKVQ)), NT, N, DM}; pg8::StaticOrder S; S.init(NT, N, C.G, hb);
                pg8::EpiBf16<0> E{BIG, N, nullptr, 0, 0, 1.f};
                pg8::gemm_phase<pg8::EpiBf16<0>, pg8::StaticOrder, true, true>((PG8_LAS unsigned char*)C.lds, g, S, E);
            }
            if (layer == 0) { __syncthreads(); p_bd(C, XN, (const bfr*)(ws + WS_WTBD), (float*)(ws + WS_BD));
#ifdef BD_PROBE
                __syncthreads(); p_bd(C, XN, (const bfr*)(ws + WS_WTBD), (float*)(ws + WS_BD));
#endif
            }
        }
        SEAM(pb + 1);
        if (IN(pb + 2)) { if (layer == 1 && F8_KVQ != 2) p_headprep(C, P); }
        if (layer == 1 && F8_KVQ != 2) SEAM(pb + 2);
        if (IN(pb + 3)) { if (layer == 0) {
                if (NPREP >= 32) p_gdn_prep(C, P, C.vcu, C.G);
                else if (C.G == 256) { const int cidx = C.vcu & 31, xcd = C.vcu >> 5;
                    if (cidx < NPREP) p_gdn_prep(C, P, xcd * NPREP + cidx, 8 * NPREP); else p_convert(C, P, 1, xcd * (32 - NPREP) + (cidx - NPREP), 8 * (32 - NPREP)); }
                else { p_convert(C, P, 1, C.vcu, C.G); __syncthreads(); p_gdn_prep(C, P, C.vcu, C.G); }
            } else p_attn(C, P); }
        SEAM(pb + 3);
        if (IN(pb + 4)) { if (layer == 0) p_gdn_scan(C, P); else p_combine(C, P); }
        SEAM(pb + 4);
        if (IN(pb + 5)) { if (layer == 0) p_gdn_onorm(C, P); }
        if (layer == 0) SEAM(pb + 5);
        if (IN(pb + 6)) {
            if ((layer == 0 && F8_OUT0) || (layer == 1 && F8_OUT1)) {
                pg8::Gemm g{(const bfr*)(ws + WS_XN8), (const bfr*)(ws + (layer == 0 ? WS_WTOUT : WS_WTO)), NT, DM, DM / 2}; pg8::StaticOrder S; S.init(NT, DM, C.G, hb);
                pg8::EpiRes E{layer == 0 ? P.in_(0) : (const float*)P.out_(), P.out_(), DM, 1.f / (SO * SU)};
                pg8::gemm_phase<pg8::EpiRes, pg8::StaticOrder, true, true, true>((PG8_LAS unsigned char*)C.lds, g, S, E);
            } else {
                pg8::Gemm g{XN, (const bfr*)(ws + (layer == 0 ? WS_WTOUT : WS_WTO)), NT, DM, DM}; pg8::StaticOrder S; S.init(NT, DM, C.G, hb);
                pg8::EpiRes E{layer == 0 ? P.in_(0) : (const float*)P.out_(), P.out_(), DM, 1.f};
                pg8::gemm_phase<pg8::EpiRes, pg8::StaticOrder, true, true>((PG8_LAS unsigned char*)C.lds, g, S, E);
            }
        }
        SEAM(pb + 6);
        if (IN(pb + 7)) p_norm_rows(C, (const float*)P.out_(), XN, ws + WS_XN8);
        SEAM(pb + 7);
        if (IN(pb + 8)) {
            pg8::Gemm g{XN, (const bfr*)(ws + WS_WTQRY) + (size_t)layer * PQ * DM, NT, PQ, DM}; pg8::StaticOrder S; S.init(NT, PQ, C.G, hb);
            pg8::EpiBf16<0> E{(bfr*)(ws + WS_QRY), PQ, nullptr, 0, 0, 1.f};
            pg8::gemm_phase<pg8::EpiBf16<0>, pg8::StaticOrder, true, true>((PG8_LAS unsigned char*)C.lds, g, S, E);
        }
        SEAM(pb + 8);
        if (IN(pb + 9)) { p_sroute(C, P, layer); }
        SEAM(pb + 9); if (IN(pb + 9) && !IN(pb + 10) && IN(pb + 11)) xcd_barrier(bar);
        if (IN(pb + 11)) {
            pg8::Gemm g{(const bfr*)(ws + WS_XN8), (const bfr*)(ws + WS_U + (size_t)layer * PE * DM), NT, PE, DM / 2}; pg8::StaticOrder S; S.init(NT, PE, C.G, hb);
#ifdef G1_PROBE
            if (layer == 0) { pg8::StaticOrder S2; S2.init(NT, PE, C.G, hb); pg8::EpiGate8<G1_PROBE> E2{(bfr*)(ws + WS_G), ws + WS_A2, PE, 1.f / SU, SA};
                pg8::gemm_phase<pg8::EpiGate8<G1_PROBE>, pg8::StaticOrder, true, true, true>((PG8_LAS unsigned char*)C.lds, g, S2, E2); __syncthreads(); }
#endif
#if STAGGER_G1
            {
                const int sg = C.vcu & 7;
                if (sg) { const unsigned long long t0 = __builtin_amdgcn_s_memrealtime(); while (__builtin_amdgcn_s_memrealtime() - t0 < (unsigned long long)(sg * STAGGER_G1)) __builtin_amdgcn_s_sleep(4); }
            }
#endif
            pg8::EpiGate8C E{ws + WS_G, ws + WS_A2, PE, 1.f / SU, SA};
            pg8::gemm_phase<pg8::EpiGate8C, pg8::StaticOrder, true, true, true>((PG8_LAS unsigned char*)C.lds, g, S, E);
        }
        SEAM(pb + 11);
        if (IN(pb + 12)) {
            pg8::Gemm g{(const bfr*)(ws + WS_A2), (const bfr*)(ws + WS_VT + (size_t)layer * DM * PE), NT, DM, PE / 2}; pg8::StaticOrder S; S.init(NT, DM, C.G, hb);
            pg8::EpiRes E{(const float*)P.out_(), P.out_(), DM, 1.f / (SA * SV)};
            pg8::gemm_phase<pg8::EpiRes, pg8::StaticOrder, true, true, true>((PG8_LAS unsigned char*)C.lds, g, S, E);
#ifdef G2_PROBE
            if (layer == 0) { __syncthreads(); pg8::StaticOrder S2; S2.init(NT, DM, C.G, hb); pg8::EpiRes E2{(const float*)P.out_(), P.out_(), DM, 0.f};
                pg8::gemm_phase<pg8::EpiRes, pg8::StaticOrder, true, true, true>((PG8_LAS unsigned char*)C.lds, g, S2, E2); }
#endif
        }
        SEAM(pb + 12);
    }
    {
        constexpr int layer = 1;
        const int pb = 1 + layer * NPH_LAYER;
        if (layer == 1 && IN(pb + 0)) p_norm_rows(C, (const float*)P.out_(), F8_KVQ == 2 ? nullptr : XN, F8_KVQ != 0 ? ws + WS_XN8 : nullptr);
        if (layer == 1) SEAM(pb + 0);
        if (IN(pb + 1)) {
            const int N = layer == 0 ? 16384 : 12288;
            if (layer == 0 && F8_PROJ0 == 2) {
                { pg8::Gemm g{XN, (const bfr*)(ws + WS_WTIN), NT, 8192, DM}; pg8::StaticOrder S; S.init(NT, 8192, C.G, hb);
                  pg8::EpiBf16<0> E{BIG, N, nullptr, 0, 0, 1.f};
                  pg8::gemm_phase<pg8::EpiBf16<0>, pg8::StaticOrder, true, true>((PG8_LAS unsigned char*)C.lds, g, S, E); }
                __syncthreads();
                { pg8::Gemm g{(const bfr*)(ws + WS_XN8), (const bfr*)(ws + WS_WTIN + (size_t)8192 * DM * 2), NT, 8192, DM / 2}; pg8::StaticOrder S; S.init(NT, 8192, C.G, hb);
                  pg8::EpiBf16<0> E{BIG + 8192, N, nullptr, 8192, 0, 1.f / SU};
                  pg8::gemm_phase<pg8::EpiBf16<0>, pg8::StaticOrder, true, true, true>((PG8_LAS unsigned char*)C.lds, g, S, E); }
            } else if (layer == 0 && F8_PROJ0 == 5) {
                { pg8::Gemm g{(const bfr*)(ws + WS_XN8), (const bfr*)(ws + WS_WTIN), NT, 8192, DM / 2}; pg8::StaticOrder S; S.init(NT, 8192, C.G, hb);
                  pg8::EpiBf16<0> E{BIG, N, nullptr, 8192, 0, 1.f / SU};
                  pg8::gemm_phase<pg8::EpiBf16<0>, pg8::StaticOrder, true, true, true>((PG8_LAS unsigned char*)C.lds, g, S, E); }
                __syncthreads();
                { pg8::Gemm g{XN, (const bfr*)(ws + WS_WTIN + (size_t)32 * MiB), NT, 4096, DM}; pg8::StaticOrder S; S.init(NT, 4096, C.G, hb);
                  pg8::EpiBf16<0> E{BIG + 8192, N, nullptr, 0, 0, 1.f};
                  pg8::gemm_phase<pg8::EpiBf16<0>, pg8::StaticOrder, true, true>((PG8_LAS unsigned char*)C.lds, g, S, E); }
                __syncthreads();
                { pg8::Gemm g{(const bfr*)(ws + WS_XN8), (const bfr*)(ws + WS_WTIN + (size_t)64 * MiB), NT, 4096, DM / 2}; pg8::StaticOrder S; S.init(NT, 4096, C.G, hb);
                  pg8::EpiBf16<0> E{BIG + 12288, N, nullptr, 4096, 0, 1.f / SU};
                  pg8::gemm_phase<pg8::EpiBf16<0>, pg8::StaticOrder, true, true, true>((PG8_LAS unsigned char*)C.lds, g, S, E); }
            } else if (layer == 0 && F8_PROJ0 == 6) {
                { pg8::Gemm g{(const bfr*)(ws + WS_XN8), (const bfr*)(ws + WS_WTIN), NT, 12288, DM / 2}; pg8::StaticOrder S; S.init(NT, 12288, C.G, hb);
                  pg8::EpiBf16<0> E{BIG, N, nullptr, 12288, 0, 1.f / SU};
                  pg8::gemm_phase<pg8::EpiBf16<0>, pg8::StaticOrder, true, true, true>((PG8_LAS unsigned char*)C.lds, g, S, E); }
                __syncthreads();
                { pg8::Gemm g{XN, (const bfr*)(ws + WS_WTIN + (size_t)48 * MiB), NT, 4096, DM}; pg8::StaticOrder S; S.init(NT, 4096, C.G, hb);
                  pg8::EpiBf16<0> E{BIG + 12288, N, nullptr, 0, 0, 1.f};
                  pg8::gemm_phase<pg8::EpiBf16<0>, pg8::StaticOrder, true, true>((PG8_LAS unsigned char*)C.lds, g, S, E); }
            } else if (layer == 0 && F8_PROJ0 == 4) {
                { pg8::Gemm g{(const bfr*)(ws + WS_XN8), (const bfr*)(ws + WS_WTIN), NT, 4096, DM / 2}; pg8::StaticOrder S; S.init(NT, 4096, C.G, hb);
                  pg8::EpiBf16<0> E{BIG, N, nullptr, 4096, 0, 1.f / SU};
                  pg8::gemm_phase<pg8::EpiBf16<0>, pg8::StaticOrder, true, true, true>((PG8_LAS unsigned char*)C.lds, g, S, E); }
                __syncthreads();
                { pg8::Gemm g{XN, (const bfr*)(ws + WS_WTIN + (size_t)4096 * DM), NT, 12288, DM}; pg8::StaticOrder S; S.init(NT, 12288, C.G, hb);
                  pg8::EpiBf16<0> E{BIG + 4096, N, nullptr, 0, 0, 1.f};
                  pg8::gemm_phase<pg8::EpiBf16<0>, pg8::StaticOrder, true, true>((PG8_LAS unsigned char*)C.lds, g, S, E); }
            } else if (layer == 0 && F8_PROJ0 == 3) {
                { pg8::Gemm g{(const bfr*)(ws + WS_XN8), (const bfr*)(ws + WS_WTIN), NT, 8192, DM / 2}; pg8::StaticOrder S; S.init(NT, 8192, C.G, hb);
                  pg8::EpiBf16<0> E{BIG, N, nullptr, 8192, 0, 1.f / SU};
                  pg8::gemm_phase<pg8::EpiBf16<0>, pg8::StaticOrder, true, true, true>((PG8_LAS unsigned char*)C.lds, g, S, E); }
                __syncthreads();
                { pg8::Gemm g{XN, (const bfr*)(ws + WS_WTIN + (size_t)8192 * DM), NT, 8192, DM}; pg8::StaticOrder S; S.init(NT, 8192, C.G, hb);
                  pg8::EpiBf16<0> E{BIG + 8192, N, nullptr, 0, 0, 1.f};
                  pg8::gemm_phase<pg8::EpiBf16<0>, pg8::StaticOrder, true, true>((PG8_LAS unsigned char*)C.lds, g, S, E); }
            } else if (layer == 0 && F8_PROJ0 == 1) {
                pg8::Gemm g{(const bfr*)(ws + WS_XN8), (const bfr*)(ws + WS_WTIN), NT, N, DM / 2}; pg8::StaticOrder S; S.init(NT, N, C.G, hb);
                pg8::EpiBf16<0> E{BIG, N, nullptr, N, 0, 1.f / SU};
                pg8::gemm_phase<pg8::EpiBf16<0>, pg8::StaticOrder, true, true, true>((PG8_LAS unsigned char*)C.lds, g, S, E);
            } else if (layer == 1 && F8_KVQ == 2) {
                pg8::Gemm g{(const bfr*)(ws + WS_XN8), (const bfr*)(ws + WS_WTKVQ), NT, N, DM / 2}; pg8::StaticOrder S; S.init(NT, N, C.G, hb);
                pg8::EpiHead E{(bfr*)(ws + WS_R + R_KH), (bfr*)(ws + WS_R + R_QH), (bfr*)(ws + WS_R + R_VH), P.in_(10), P.in_(13), 1.f / SU};
                pg8::gemm_phase<pg8::EpiHead, pg8::StaticOrder, true, true, true>((PG8_LAS unsigned char*)C.lds, g, S, E);
            } else if (layer == 1 && F8_KVQ) {
                { pg8::Gemm g{(const bfr*)(ws + WS_XN8), (const bfr*)(ws + WS_WTKVQ), NT, 8192, DM / 2}; pg8::StaticOrder S; S.init(NT, 8192, C.G, hb);
                  pg8::EpiBf16<0> E{BIG, N, nullptr, 8192, 0, 1.f / SU};
                  pg8::gemm_phase<pg8::EpiBf16<0>, pg8::StaticOrder, true, true, true>((PG8_LAS unsigned char*)C.lds, g, S, E); }
                __syncthreads();
                { pg8::Gemm g{XN, (const bfr*)(ws + WS_WTKVQ + (size_t)2 * DM * DM), NT, DM, DM}; pg8::StaticOrder S; S.init(NT, DM, C.G, hb);
                  pg8::EpiBf16<0> E{BIG + 8192, N, nullptr, 0, 0, 1.f};
                  pg8::gemm_phase<pg8::EpiBf16<0>, pg8::StaticOrder, true, true>((PG8_LAS unsigned char*)C.lds, g, S, E); }
            } else {
                pg8::Gemm g{XN, (const bfr*)(ws + (layer == 0 ? WS_WTIN : WS_WTKVQ)), NT, N, DM}; pg8::StaticOrder S; S.init(NT, N, C.G, hb);
                pg8::EpiBf16<0> E{BIG, N, nullptr, 0, 0, 1.f};
                pg8::gemm_phase<pg8::EpiBf16<0>, pg8::StaticOrder, true, true>((PG8_LAS unsigned char*)C.lds, g, S, E);
            }
            if (layer == 0) { __syncthreads(); p_bd(C, XN, (const bfr*)(ws + WS_WTBD), (float*)(ws + WS_BD));
#ifdef BD_PROBE
                __syncthreads(); p_bd(C, XN, (const bfr*)(ws + WS_WTBD), (float*)(ws + WS_BD));
#endif
            }
        }
        SEAM(pb + 1);
        if (IN(pb + 2)) { if (layer == 1 && F8_KVQ != 2) p_headprep(C, P); }
        if (layer == 1 && F8_KVQ != 2) SEAM(pb + 2);
        if (IN(pb + 3)) { if (layer == 0) {
                if (NPREP >= 32) p_gdn_prep(C, P, C.vcu, C.G);
                else if (C.G == 256) { const int cidx = C.vcu & 31, xcd = C.vcu >> 5;
                    if (cidx < NPREP) p_gdn_prep(C, P, xcd * NPREP + cidx, 8 * NPREP); else p_convert(C, P, 1, xcd * (32 - NPREP) + (cidx - NPREP), 8 * (32 - NPREP)); }
                else { p_convert(C, P, 1, C.vcu, C.G); __syncthreads(); p_gdn_prep(C, P, C.vcu, C.G); }
            } else p_attn(C, P); }
        SEAM(pb + 3);
        if (IN(pb + 4)) { if (layer == 0) p_gdn_scan(C, P); else p_combine(C, P); }
        SEAM(pb + 4);
        if (IN(pb + 5)) { if (layer == 0) p_gdn_onorm(C, P); }
        if (layer == 0) SEAM(pb + 5);
        if (IN(pb + 6)) {
            if ((layer == 0 && F8_OUT0) || (layer == 1 && F8_OUT1)) {
                pg8::Gemm g{(const bfr*)(ws + WS_XN8), (const bfr*)(ws + (layer == 0 ? WS_WTOUT : WS_WTO)), NT, DM, DM / 2}; pg8::StaticOrder S; S.init(NT, DM, C.G, hb);
                pg8::EpiRes E{layer == 0 ? P.in_(0) : (const float*)P.out_(), P.out_(), DM, 1.f / (SO * SU)};
                pg8::gemm_phase<pg8::EpiRes, pg8::StaticOrder, true, true, true>((PG8_LAS unsigned char*)C.lds, g, S, E);
            } else {
                pg8::Gemm g{XN, (const bfr*)(ws + (layer == 0 ? WS_WTOUT : WS_WTO)), NT, DM, DM}; pg8::StaticOrder S; S.init(NT, DM, C.G, hb);
                pg8::EpiRes E{layer == 0 ? P.in_(0) : (const float*)P.out_(), P.out_(), DM, 1.f};
                pg8::gemm_phase<pg8::EpiRes, pg8::StaticOrder, true, true>((PG8_LAS unsigned char*)C.lds, g, S, E);
            }
        }
        SEAM(pb + 6);
        if (IN(pb + 7)) p_norm_rows(C, (const float*)P.out_(), XN, ws + WS_XN8);
        SEAM(pb + 7);
        if (IN(pb + 8)) {
            pg8::Gemm g{XN, (const bfr*)(ws + WS_WTQRY) + (size_t)layer * PQ * DM, NT, PQ, DM}; pg8::StaticOrder S; S.init(NT, PQ, C.G, hb);
            pg8::EpiBf16<0> E{(bfr*)(ws + WS_QRY), PQ, nullptr, 0, 0, 1.f};
            pg8::gemm_phase<pg8::EpiBf16<0>, pg8::StaticOrder, true, true>((PG8_LAS unsigned char*)C.lds, g, S, E);
        }
        SEAM(pb + 8);
        if (IN(pb + 9)) { p_sroute(C, P, layer); }
        SEAM(pb + 9); if (IN(pb + 9) && !IN(pb + 10) && IN(pb + 11)) xcd_barrier(bar);
        if (IN(pb + 11)) {
            pg8::Gemm g{(const bfr*)(ws + WS_XN8), (const bfr*)(ws + WS_U + (size_t)layer * PE * DM), NT, PE, DM / 2}; pg8::StaticOrder S; S.init(NT, PE, C.G, hb);
#ifdef G1_PROBE
            if (layer == 0) { pg8::StaticOrder S2; S2.init(NT, PE, C.G, hb); pg8::EpiGate8<G1_PROBE> E2{(bfr*)(ws + WS_G), ws + WS_A2, PE, 1.f / SU, SA};
                pg8::gemm_phase<pg8::EpiGate8<G1_PROBE>, pg8::StaticOrder, true, true, true>((PG8_LAS unsigned char*)C.lds, g, S2, E2); __syncthreads(); }
#endif
#if STAGGER_G1
            {
                const int sg = C.vcu & 7;
                if (sg) { const unsigned long long t0 = __builtin_amdgcn_s_memrealtime(); while (__builtin_amdgcn_s_memrealtime() - t0 < (unsigned long long)(sg * STAGGER_G1)) __builtin_amdgcn_s_sleep(4); }
            }
#endif
            pg8::EpiGate8C E{ws + WS_G, ws + WS_A2, PE, 1.f / SU, SA};
            pg8::gemm_phase<pg8::EpiGate8C, pg8::StaticOrder, true, true, true>((PG8_LAS unsigned char*)C.lds, g, S, E);
        }
        SEAM(pb + 11);
        if (IN(pb + 12)) {
            pg8::Gemm g{(const bfr*)(ws + WS_A2), (const bfr*)(ws + WS_VT + (size_t)layer * DM * PE), NT, DM, PE / 2}; pg8::StaticOrder S; S.init(NT, DM, C.G, hb);
            pg8::EpiRes E{(const float*)P.out_(), P.out_(), DM, 1.f / (SA * SV)};
            pg8::gemm_phase<pg8::EpiRes, pg8::StaticOrder, true, true, true>((PG8_LAS unsigned char*)C.lds, g, S, E);
#ifdef G2_PROBE
            if (layer == 0) { __syncthreads(); pg8::StaticOrder S2; S2.init(NT, DM, C.G, hb); pg8::EpiRes E2{(const float*)P.out_(), P.out_(), DM, 0.f};
                pg8::gemm_phase<pg8::EpiRes, pg8::StaticOrder, true, true, true>((PG8_LAS unsigned char*)C.lds, g, S2, E2); }
#endif
        }
        SEAM(pb + 12);
    }
#undef IN
#undef SEAM
}

extern "C" void kernel_launch(void* const* d_in, const int* in_sizes, int n_in, void* d_out, int out_size, void* d_ws, size_t ws_size, hipStream_t stream) {
    static int grid = 0;
    if (grid == 0) {
        if (n_in != 26 || out_size != NT * DM || ws_size < WS_END) { fprintf(stderr, "kernel_launch: unexpected problem (n_in %d, out %d, ws %zu < %zu)\n", n_in, out_size, ws_size, (size_t)WS_END); grid = -1; return; }
        int dev = 0, cus = 0;
        if (hipGetDevice(&dev) != hipSuccess || hipDeviceGetAttribute(&cus, hipDeviceAttributeMultiprocessorCount, dev) != hipSuccess || cus <= 0) { grid = -1; return; }
        if (hipFuncSetAttribute((const void*)trunk_fwd, hipFuncAttributeMaxDynamicSharedMemorySize, LDS_BYTES) != hipSuccess) { fprintf(stderr, "kernel_launch: hipFuncSetAttribute failed\n"); grid = -1; return; }
        int per_cu = 0;
        if (hipOccupancyMaxActiveBlocksPerMultiprocessor(&per_cu, (const void*)trunk_fwd, 512, LDS_BYTES) != hipSuccess || per_cu < 1) { fprintf(stderr, "kernel_launch: occupancy query says %d blocks per CU\n", per_cu); }
        (void)hipGetLastError();
        grid = cus;
    }
    if (grid < 0) return;
    (void)in_sizes;
    if (hipMemsetAsync((char*)d_ws + WS_CTL, 0, CTL_ZERO_BYTES, stream) != hipSuccess) return;
    KArgs p{};
    for (int i = 0; i < 26; ++i) p.in[i] = (const float*)d_in[i];
    p.out = (float*)d_out; p.ws = (unsigned char*)d_ws;
#if MK_PER_PHASE
    for (int ph = 0; ph < NPHASE; ++ph) {
        if (ph == 1 + 5 + NPH_LAYER || ph == 1 + 10 || ph == 1 + 10 + NPH_LAYER) continue;
        p.ph_lo = ph; p.ph_hi = ph + 1; p.li = 0; p.pad = 0;
        hipLaunchKernelGGL(trunk_fwd, dim3(grid), dim3(512), LDS_BYTES, stream, p);
    }
#else
    p.ph_lo = 0; p.ph_hi = NPHASE; p.li = 0; p.pad = 0;
    hipLaunchKernelGGL(trunk_fwd, dim3(grid), dim3(512), LDS_BYTES, stream, p);
#endif
}
```

```cpp
#include <hip/hip_runtime.h>
#include <hip/hip_bf16.h>
#include <cstdio>
#include <cstdint>

#define LAS __attribute__((address_space(3)))
#define GAS __attribute__((address_space(1)))
typedef unsigned short bfr;
typedef short s8v __attribute__((ext_vector_type(8)));
typedef float f4v __attribute__((ext_vector_type(4)));
typedef unsigned u4v __attribute__((ext_vector_type(4)));
typedef unsigned u2v __attribute__((ext_vector_type(2)));
typedef int i4v __attribute__((ext_vector_type(4)));

#ifndef F8_PROJ0
#define F8_PROJ0 3
#endif
#ifndef F8_KVQ
#define F8_KVQ 2
#endif
#ifndef F8_OUT0
#define F8_OUT0 1
#endif
#ifndef F8_OUT1
#define F8_OUT1 1
#endif
#ifndef F8_OUT
#define F8_OUT (F8_OUT0 || F8_OUT1)
#endif
#ifndef STAGGER_G1
#define STAGGER_G1 0
#endif
#ifndef NPREP
#define NPREP 20
#endif
constexpr int NB = 2, SEQ = 4096, DM = 4096, NT = NB * SEQ;
constexpr int GH = 32, GD = 128, GIN = 16448, CH = 64, NCH = SEQ / CH;
constexpr int AH = 16, AD = 128, AV = 256;
constexpr int PH = 8, PK = 128, PE = 16384, PQ = 2048, PTOP = 16;
constexpr float EPS = 1e-6f;
constexpr float LAMBDA_INIT = 0.35550906759f;
constexpr float SU = 64.f, SA = 64.f, SV = 4.f, SO = 16.f;

constexpr size_t MiB = 1u << 20;
constexpr size_t WS_CTL   = 0;
constexpr size_t WS_WTIN  = 1 * MiB;
constexpr size_t WS_WTBD  = WS_WTIN + 128 * MiB;
constexpr size_t WS_WTOUT = WS_WTBD + 1 * MiB;
constexpr size_t WS_WTKVQ = WS_WTOUT + 32 * MiB;
constexpr size_t WS_WTO   = WS_WTKVQ + 96 * MiB;
constexpr size_t WS_WTQRY = WS_WTO + 32 * MiB;
constexpr size_t WS_WTKEY = WS_WTQRY + 32 * MiB;
constexpr size_t WS_U     = WS_WTKEY + 16 * MiB;
constexpr size_t WS_VT    = WS_U + 128 * MiB;
constexpr size_t WS_A2    = WS_VT + 128 * MiB;
constexpr size_t WS_XN8   = WS_A2 + 128 * MiB;
constexpr size_t WS_XN    = WS_XN8 + 32 * MiB;
constexpr size_t WS_BIG   = WS_XN + 64 * MiB;
constexpr size_t WS_R     = WS_BIG + 256 * MiB;
constexpr size_t WS_QRY   = WS_R + 352 * MiB;
constexpr size_t WS_SC    = WS_QRY + 32 * MiB;
constexpr size_t WS_BD    = WS_SC + 64 * MiB;
constexpr size_t WS_EG    = WS_BD + 2 * MiB;
constexpr size_t WS_G     = WS_EG + 1 * MiB;
constexpr size_t WS_END   = WS_G + 256 * MiB;
constexpr size_t R_W = 0, R_U = 64 * MiB, R_QG = 128 * MiB, R_KD = 192 * MiB, R_QK = 256 * MiB, R_O = 288 * MiB;
constexpr size_t R_QH = 0, R_KH = 64 * MiB, R_VH = 128 * MiB, R_OH = 192 * MiB;
static_assert(WS_END <= (size_t)1790 * MiB, "workspace map");

constexpr int CW_BAR = 4096;
constexpr size_t CTL_ZERO_BYTES = 1 * MiB;

constexpr int LDS_BYTES = 147456;
constexpr int MISC_OFF = 146944;

typedef float f2v_ __attribute__((ext_vector_type(2)));
typedef __bf16 b2v_ __attribute__((ext_vector_type(2)));
__device__ __forceinline__ unsigned cvtpk(float lo, float hi) { const b2v_ r = __builtin_convertvector((f2v_){lo, hi}, b2v_); return __builtin_bit_cast(unsigned, r); }
__device__ __forceinline__ unsigned cvt4_fp8(float a, float b, float c, float d) { int w = 0; w = __builtin_amdgcn_cvt_pk_fp8_f32(a, b, w, false); w = __builtin_amdgcn_cvt_pk_fp8_f32(c, d, w, true); return (unsigned)w; }
__device__ __forceinline__ float bflo(unsigned w) { return __uint_as_float(w << 16); }
__device__ __forceinline__ float bfhi(unsigned w) { return __uint_as_float(w & 0xffff0000u); }
__device__ __forceinline__ float bf1(bfr b) { return __uint_as_float(((unsigned)b) << 16); }
__device__ __forceinline__ bfr f2bf1(float f) { return (bfr)(cvtpk(f, 0.f) & 0xffffu); }
__device__ __forceinline__ float wave_sum(float v) {
#pragma unroll
    for (int o = 1; o < 64; o <<= 1) v += __shfl_xor(v, o);
    return v;
}
__device__ __forceinline__ f4v zero_acc() { f4v z = {0.f, 0.f, 0.f, 0.f}; asm volatile("" : "+v"(z)); return z; }
#define MFMA_SETTLE(acc) asm volatile("s_nop 7\n\ts_nop 7" : "+v"(acc))
#define LDS_WAIT() asm volatile("s_waitcnt lgkmcnt(0)" ::: "memory")
#define VM_WAIT() asm volatile("s_waitcnt vmcnt(0)" ::: "memory")
#define XB_TMO      128
#define XB_XCNT(j)  (256  + 64 * (j))
#define XB_XSUB(j)  (1280 + 64 * (j))
#define XB_XGEN(j)  (2304 + 64 * (j))
#define XB_TOP      3328
#define XB_TOPGEN   3392
#define XCD_BAR_WORDS 3456
#define XB_SPIN_CAP (1u << 18)

__device__ __forceinline__ unsigned xb_ld(unsigned* p)              { return __hip_atomic_load(p, __ATOMIC_RELAXED, __HIP_MEMORY_SCOPE_AGENT); }
__device__ __forceinline__ unsigned xb_add(unsigned* p, unsigned v) { return __hip_atomic_fetch_add(p, v, __ATOMIC_RELAXED, __HIP_MEMORY_SCOPE_AGENT); }
__device__ __forceinline__ unsigned xb_xcc_id() { return (unsigned)__builtin_amdgcn_s_getreg((3 << 11) | 20) & 0xFu; }
#define XB_SPIN(cond, bar) do { unsigned _sp = 0; while (cond) { __builtin_amdgcn_s_sleep(1); \
    if ((++_sp & 255u) == 0u) { if (xb_ld(&(bar)[XB_TMO])) break; if (_sp > XB_SPIN_CAP) { atomicAdd(&(bar)[XB_TMO], 1u); break; } } } } while (0)

struct XcdBarrier {
    unsigned* bar; unsigned x;
    volatile LAS unsigned* st;
};

__device__ __forceinline__ XcdBarrier xcd_barrier_post(unsigned* bar, volatile LAS unsigned* st) {
    XcdBarrier b; b.bar = bar; b.x = xb_xcc_id(); b.st = st;
    if (threadIdx.x == 0) (void)xb_add(&bar[XB_XCNT(b.x)], 1u);
    return b;
}
__device__ __forceinline__ void xcd_barrier_complete(unsigned* bar, unsigned x, unsigned& nloc, unsigned& nx) {
    const unsigned G = gridDim.x * gridDim.y * gridDim.z;
    unsigned sum, cnt, mine, sp = 0u;
    for (;;) {
        sum = 0u; cnt = 0u; mine = 0u;
#pragma unroll
        for (unsigned j = 0; j < 16; ++j) { const unsigned c = xb_ld(&bar[XB_XCNT(j)]); sum += c; cnt += (c > 0u) ? 1u : 0u; mine = (j == x) ? c : mine; }
        if (sum == G) break;
        __builtin_amdgcn_s_sleep(1);
        if ((++sp & 255u) == 0u) { if (xb_ld(&bar[XB_TMO])) break; if (sp > XB_SPIN_CAP) { atomicAdd(&bar[XB_TMO], 1u); break; } }
    }
    nloc = mine > 0u ? mine : 1u; nx = cnt > 0u ? cnt : 1u;
}

__device__ __forceinline__ void xcd_barrier(const XcdBarrier& b) {
    asm volatile("s_waitcnt vmcnt(0)" ::: "memory");
    __syncthreads();
    if (threadIdx.x == 0) {
        unsigned* bar = b.bar;
        __builtin_amdgcn_s_waitcnt(0);
        unsigned nloc = b.st[0], nx = b.st[1];
        if (nloc == 0u) { xcd_barrier_complete(bar, b.x, nloc, nx); b.st[0] = nloc; b.st[1] = nx; }
        const unsigned old = xb_add(&bar[XB_XSUB(b.x)], 1u);
        const unsigned gen = old / nloc;
        if (old + 1u == (gen + 1u) * nloc) {
            __builtin_amdgcn_fence(__ATOMIC_RELEASE, "agent");
            asm volatile("s_waitcnt vmcnt(0)" ::: "memory");
            const unsigned og = xb_add(&bar[XB_TOP], 1u);
            const unsigned tg = og / nx;
            if (og + 1u == (tg + 1u) * nx) xb_add(&bar[XB_TOPGEN], 1u);
            else XB_SPIN(xb_ld(&bar[XB_TOPGEN]) == tg, bar);
            __builtin_amdgcn_fence(__ATOMIC_ACQUIRE, "agent");
            xb_add(&bar[XB_XGEN(b.x)], 1u);
            asm volatile("s_waitcnt vmcnt(0)" ::: "memory");
        } else {
            XB_SPIN(xb_ld(&bar[XB_XGEN(b.x)]) == gen, bar);
            __builtin_amdgcn_fence(__ATOMIC_ACQUIRE, "agent");
            asm volatile("s_waitcnt vmcnt(0)" ::: "memory");
        }
    }
    __syncthreads();
}
namespace pg8 {
#define PG8_LAS __attribute__((address_space(3)))
typedef unsigned short bf16_t;
typedef short bf16x8 __attribute__((ext_vector_type(8)));
typedef float f32x4 __attribute__((ext_vector_type(4)));
typedef unsigned u32x4 __attribute__((ext_vector_type(4)));
typedef int i32x4 __attribute__((ext_vector_type(4)));
typedef int i32x8 __attribute__((ext_vector_type(8)));
typedef unsigned u32x2 __attribute__((ext_vector_type(2)));
constexpr int BM = 256, BK = 64, HALF = 128, HTB = HALF * BK * 2  , STAGE_BYTES = 8 * HTB, NXCD = 8, WGM = 8;

__host__ __device__ __forceinline__ int lds_byte(int r, int c) { const int st = (r >> 4) * 2 + (c >> 5), rr = r & 15, cc = c & 31, ob = rr * 64 + cc * 2; return st * 1024 + (ob ^ (((ob >> 9) & 1) << 5)); }
__host__ __device__ __forceinline__ void stage_rc(int b, int& R, int& C) { const int st = b / 1024, sb = b % 1024, swz = sb ^ (((sb >> 9) & 1) << 5); R = (st >> 1) * 16 + swz / 64; C = (st & 1) * 32 + (swz % 64) / 2; }
__host__ __device__ __forceinline__ int perm32(int rho) { const int n = rho >> 4, i = rho & 15; return 8 * (i >> 2) + 4 * n + (i & 3); }

struct Unit { int pm, pn; };
struct Gemm { const bf16_t* A; const bf16_t* Bt; int M, N, K; };

struct StaticOrder {
    int nM, nN, nwg, G, c;
    __host__ __device__ void init(int M, int N, int G_, int c_) { nM = M / BM; nN = N / BM; nwg = nM * nN; G = G_; c = c_; }
    __host__ __device__ bool next(int i, Unit& u) const {
        const long L = (long)i * G + c; if (L >= nwg) return false;
        int wgid = (int)L; { const int q = nwg / NXCD, r = nwg % NXCD, xcd = wgid % NXCD, off = wgid / NXCD; wgid = (xcd < r ? xcd * (q + 1) : r * (q + 1) + (xcd - r) * q) + off; }
        const int nig = WGM * nN, gid = wgid / nig, fm = gid * WGM, gsz = (nM - fm) < WGM ? (nM - fm) : WGM;
        u.pm = fm + ((wgid % nig) % gsz); u.pn = (wgid % nig) / gsz; return true;
    }
    __device__ __forceinline__ void a_ready(const Unit&) const {}
    __device__ __forceinline__ void done(const Unit&) const {}
};

__device__ __forceinline__ unsigned cvt_pk_bf16(float lo, float hi) { unsigned r; asm volatile("v_cvt_pk_bf16_f32 %0, %1, %2" : "=v"(r) : "v"(lo), "v"(hi)); return r; }
typedef float f32x2 __attribute__((ext_vector_type(2)));
__device__ __forceinline__ f32x2 gelu_pk(f32x2 v) {
    const f32x2 av = __builtin_elementwise_abs(v), d = av * 0.2316418882f + 1.0f;
    f32x2 t; t.x = __builtin_amdgcn_rcpf(d.x); t.y = __builtin_amdgcn_rcpf(d.y);
    f32x2 q = t * 0.5307027145f + (-0.7265760135f); q = q * t + 0.7107068705f; q = q * t + (-0.142248368f); q = q * t + 0.127414796f; q = q * t;
    const f32x2 s = (v * v) * (-0.72134752044f);
    f32x2 e; e.x = __builtin_amdgcn_exp2f(s.x); e.y = __builtin_amdgcn_exp2f(s.y);
    const f32x2 m = v * (q * e), r = v - m;
    f32x2 o; o.x = v.x < 0.f ? m.x : r.x; o.y = v.y < 0.f ? m.y : r.y; return o;
}

template <int ACT  > struct EpiBf16 {
    static constexpr bool PERM = true, AFTER_DRAIN = false; static_assert(ACT == 0 || ACT == 1, "EpiBf16: ACT is 0 (none) or 1 (gelu_pk)");
    bf16_t* O; int ldc; const float* bias; int split_cols; size_t split_stride; float scale0;
    __device__ __forceinline__ void operator()(const f32x4 (&acc)[2][2][4][2], const Unit& u, int wr, int wc, int fr, int fq) const {
        const int row0 = u.pm * BM + wr * 64 + fr; int colt = u.pn * BM; bf16_t* base = O;
        float sc = 1.f; if (split_cols) { const int t = colt / split_cols; base += (size_t)t * split_stride; colt -= t * split_cols; if (t == 0) sc = scale0; }
        const int col0 = colt + wc * 32 + 8 * fq, bcol0 = u.pn * BM + wc * 32 + 8 * fq;
        f32x4 bv[2][2];
#pragma unroll
        for (int bj = 0; bj < 2; ++bj)
#pragma unroll
            for (int n = 0; n < 2; ++n) bv[bj][n] = bias ? *(const f32x4*)(bias + bcol0 + bj * HALF + 4 * n) : (f32x4){0.f, 0.f, 0.f, 0.f};
#pragma unroll
        for (int ai = 0; ai < 2; ++ai)
#pragma unroll
            for (int m = 0; m < 4; ++m) { bf16_t* rowp = base + (size_t)(row0 + ai * HALF + m * 16) * ldc + col0;
#pragma unroll
                for (int bj = 0; bj < 2; ++bj) { f32x4 v0 = acc[ai][bj][m][0] + bv[bj][0], v1 = acc[ai][bj][m][1] + bv[bj][1];
                    if (ACT == 1) { f32x2 a = gelu_pk((f32x2){v0[0], v0[1]}), b = gelu_pk((f32x2){v0[2], v0[3]}), c = gelu_pk((f32x2){v1[0], v1[1]}), d = gelu_pk((f32x2){v1[2], v1[3]});
                        v0 = (f32x4){a.x, a.y, b.x, b.y}; v1 = (f32x4){c.x, c.y, d.x, d.y}; }
                    v0 = v0 * sc; v1 = v1 * sc; u32x4 w; w.x = cvt_pk_bf16(v0[0], v0[1]); w.y = cvt_pk_bf16(v0[2], v0[3]); w.z = cvt_pk_bf16(v1[0], v1[1]); w.w = cvt_pk_bf16(v1[2], v1[3]);
                    *(u32x4*)(rowp + bj * HALF) = w; } }
    }
};
struct EpiRes {
    static constexpr bool PERM = false, AFTER_DRAIN = false;
    const float* base; float* out; int ldc; float scale;
    __device__ __forceinline__ void operator()(const f32x4 (&acc)[2][2][4][2], const Unit& u, int wr, int wc, int fr, int fq) const {
        const int row0 = u.pm * BM + wr * 64 + fr, col0 = u.pn * BM + wc * 32 + 4 * fq;
#pragma unroll
        for (int ai = 0; ai < 2; ++ai)
#pragma unroll
            for (int m = 0; m < 4; ++m) { const size_t off = (size_t)(row0 + ai * HALF + m * 16) * ldc + col0;
                f32x4 bs[2][2];
#pragma unroll
                for (int bj = 0; bj < 2; ++bj)
#pragma unroll
                    for (int n = 0; n < 2; ++n) bs[bj][n] = *(const f32x4*)(base + off + bj * HALF + n * 16);
#pragma unroll
                for (int bj = 0; bj < 2; ++bj)
#pragma unroll
                    for (int n = 0; n < 2; ++n) *(f32x4*)(out + off + bj * HALF + n * 16) = bs[bj][n] + acc[ai][bj][m][n] * scale;
                asm volatile("" ::: "memory"); }
    }
};
struct EpiStF32 {
    static constexpr bool PERM = false, AFTER_DRAIN = false;
    float* C; int ldc;
    __device__ __forceinline__ void operator()(const f32x4 (&acc)[2][2][4][2], const Unit& u, int wr, int wc, int fr, int fq) const {
        const int row0 = u.pm * BM + wr * 64 + fr, col0 = u.pn * BM + wc * 32 + 4 * fq;
#pragma unroll
        for (int ai = 0; ai < 2; ++ai)
#pragma unroll
            for (int m = 0; m < 4; ++m) { float* rowp = C + (size_t)(row0 + ai * HALF + m * 16) * ldc + col0;
#pragma unroll
                for (int bj = 0; bj < 2; ++bj)
#pragma unroll
                    for (int n = 0; n < 2; ++n) *(f32x4*)(rowp + bj * HALF + n * 16) = acc[ai][bj][m][n]; }
    }
};
struct EpiGate {
    static constexpr bool PERM = true, AFTER_DRAIN = false;
    bf16_t* G; int ldc;
    __device__ __forceinline__ void operator()(const f32x4 (&acc)[2][2][4][2], const Unit& u, int wr, int wc, int fr, int fq) const {
        const int row0 = u.pm * BM + wr * 64 + fr, col0 = u.pn * BM + wc * 32 + 8 * fq;
#pragma unroll
        for (int ai = 0; ai < 2; ++ai)
#pragma unroll
            for (int m = 0; m < 4; ++m) { bf16_t* rowp = G + (size_t)(row0 + ai * HALF + m * 16) * ldc + col0;
                u32x4 g[2];
#pragma unroll
                for (int bj = 0; bj < 2; ++bj) g[bj] = *(const u32x4*)(rowp + bj * HALF);
#pragma unroll
                for (int bj = 0; bj < 2; ++bj) {
                    if ((g[bj].x | g[bj].y | g[bj].z | g[bj].w) != 0u) {
                        const f32x4 v0 = acc[ai][bj][m][0], v1 = acc[ai][bj][m][1];
                        const f32x2 a = gelu_pk((f32x2){v0[0], v0[1]}), b = gelu_pk((f32x2){v0[2], v0[3]}), c = gelu_pk((f32x2){v1[0], v1[1]}), d = gelu_pk((f32x2){v1[2], v1[3]});
                        u32x4 w;
                        w.x = cvt_pk_bf16(a.x * __uint_as_float(g[bj].x << 16), a.y * __uint_as_float(g[bj].x & 0xffff0000u));
                        w.y = cvt_pk_bf16(b.x * __uint_as_float(g[bj].y << 16), b.y * __uint_as_float(g[bj].y & 0xffff0000u));
                        w.z = cvt_pk_bf16(c.x * __uint_as_float(g[bj].z << 16), c.y * __uint_as_float(g[bj].z & 0xffff0000u));
                        w.w = cvt_pk_bf16(d.x * __uint_as_float(g[bj].w << 16), d.y * __uint_as_float(g[bj].w & 0xffff0000u));
                        *(u32x4*)(rowp + bj * HALF) = w;
                    }
                } }
    }
};
template <int MODE = 0>
struct EpiGate8 {
    static constexpr bool PERM = true, AFTER_DRAIN = false;
    bf16_t* G; unsigned char* A2; int ldc; float hscale, oscale;
    __device__ __forceinline__ void operator()(const f32x4 (&acc)[2][2][4][2], const Unit& u, int wr, int wc, int fr, int fq) const {
        const int row0 = u.pm * BM + wr * 64 + fr, col0 = u.pn * BM + wc * 32 + 8 * fq;
#pragma unroll
        for (int ai = 0; ai < 2; ++ai)
#pragma unroll
            for (int m = 0; m < 4; ++m) { const size_t ro = (size_t)(row0 + ai * HALF + m * 16) * ldc + col0;
                u32x4 g[2];
#pragma unroll
                for (int bj = 0; bj < 2; ++bj) g[bj] = (MODE == 2 || MODE == 3) ? (u32x4){0x3f803f80u, 0x3f803f80u, 0x3f803f80u, 0x3f803f80u} : *(const u32x4*)(G + ro + bj * HALF);
#pragma unroll
                for (int bj = 0; bj < 2; ++bj) {
                    u32x2 w = {0u, 0u};
                    if ((g[bj].x | g[bj].y | g[bj].z | g[bj].w) != 0u) {
                        const f32x4 v0 = acc[ai][bj][m][0] * hscale, v1 = acc[ai][bj][m][1] * hscale;
                        const f32x2 a = MODE == 3 ? (f32x2){v0[0], v0[1]} : gelu_pk((f32x2){v0[0], v0[1]}), b = MODE == 3 ? (f32x2){v0[2], v0[3]} : gelu_pk((f32x2){v0[2], v0[3]}), c = MODE == 3 ? (f32x2){v1[0], v1[1]} : gelu_pk((f32x2){v1[0], v1[1]}), d = MODE == 3 ? (f32x2){v1[2], v1[3]} : gelu_pk((f32x2){v1[2], v1[3]});
                        float y[8] = {a.x * __uint_as_float(g[bj].x << 16), a.y * __uint_as_float(g[bj].x & 0xffff0000u), b.x * __uint_as_float(g[bj].y << 16), b.y * __uint_as_float(g[bj].y & 0xffff0000u),
                                      c.x * __uint_as_float(g[bj].z << 16), c.y * __uint_as_float(g[bj].z & 0xffff0000u), d.x * __uint_as_float(g[bj].w << 16), d.y * __uint_as_float(g[bj].w & 0xffff0000u)};
#pragma unroll
                        for (int k = 0; k < 8; ++k) y[k] = fminf(fmaxf(y[k] * oscale, -440.f), 440.f);
                        int lo = 0, hi = 0;
                        lo = __builtin_amdgcn_cvt_pk_fp8_f32(y[0], y[1], lo, false); lo = __builtin_amdgcn_cvt_pk_fp8_f32(y[2], y[3], lo, true);
                        hi = __builtin_amdgcn_cvt_pk_fp8_f32(y[4], y[5], hi, false); hi = __builtin_amdgcn_cvt_pk_fp8_f32(y[6], y[7], hi, true);
                        w.x = (unsigned)lo; w.y = (unsigned)hi;
                        if (MODE == 0) *(u32x4*)(G + ro + bj * HALF) = (u32x4){0u, 0u, 0u, 0u};
                    }
                    *(u32x2*)(A2 + ro + bj * HALF) = w;
                } }
    }
};

struct EpiGate8C {
    static constexpr bool PERM = true, AFTER_DRAIN = false;
    static constexpr int REC_OFF = STAGE_BYTES, REC_WAVE = 1984, REC_DW = 8, CAP = REC_WAVE / (4 * REC_DW);
    unsigned char* G; unsigned char* A2; int ldc; float hscale, oscale;
    static __device__ __forceinline__ float gdec(unsigned w, int k) { const unsigned b = (w >> (8 * k)) & 255u; return b ? __builtin_amdgcn_exp2f(((float)b - 195.f) * 0.05f) : 0.f; }
    __device__ __forceinline__ void one(unsigned h0, unsigned h1, unsigned h2, unsigned h3, unsigned g0, unsigned g1, unsigned off) const {
        const f32x2 a = gelu_pk((f32x2){__uint_as_float(h0 << 16), __uint_as_float(h0 & 0xffff0000u)}), b = gelu_pk((f32x2){__uint_as_float(h1 << 16), __uint_as_float(h1 & 0xffff0000u)}),
                    c = gelu_pk((f32x2){__uint_as_float(h2 << 16), __uint_as_float(h2 & 0xffff0000u)}), d = gelu_pk((f32x2){__uint_as_float(h3 << 16), __uint_as_float(h3 & 0xffff0000u)});
        float y[8] = {a.x * gdec(g0, 0), a.y * gdec(g0, 1), b.x * gdec(g0, 2), b.y * gdec(g0, 3), c.x * gdec(g1, 0), c.y * gdec(g1, 1), d.x * gdec(g1, 2), d.y * gdec(g1, 3)};
#pragma unroll
        for (int k = 0; k < 8; ++k) y[k] = fminf(fmaxf(y[k] * oscale, -440.f), 440.f);
        int lo = 0, hi = 0;
        lo = __builtin_amdgcn_cvt_pk_fp8_f32(y[0], y[1], lo, false); lo = __builtin_amdgcn_cvt_pk_fp8_f32(y[2], y[3], lo, true);
        hi = __builtin_amdgcn_cvt_pk_fp8_f32(y[4], y[5], hi, false); hi = __builtin_amdgcn_cvt_pk_fp8_f32(y[6], y[7], hi, true);
        *(u32x2*)(A2 + off) = (u32x2){(unsigned)lo, (unsigned)hi};
        *(u32x2*)(G + off) = (u32x2){0u, 0u};
    }
    __device__ __forceinline__ void flush(PG8_LAS unsigned* rec, int cnt, int lane) const {
        asm volatile("s_waitcnt lgkmcnt(0)" ::: "memory");
        if (lane < cnt) { const PG8_LAS unsigned* r = rec + lane * REC_DW;
            const u32x4 hh = *(const PG8_LAS u32x4*)r; const u32x2 gg = *(const PG8_LAS u32x2*)(r + 4); const unsigned off = r[6];
            one(hh.x, hh.y, hh.z, hh.w, gg.x, gg.y, off); }
        asm volatile("s_waitcnt lgkmcnt(0)" ::: "memory");
    }
    __device__ __forceinline__ void operator()(const f32x4 (&acc)[2][2][4][2], const Unit& u, int wr, int wc, int fr, int fq) const {
        extern __shared__ __attribute__((aligned(16))) char pg8_lds_sym[];
        const int lane = fq * 16 + fr;
        PG8_LAS unsigned* rec = (PG8_LAS unsigned*)((PG8_LAS char*)pg8_lds_sym + REC_OFF + (wr * 4 + wc) * REC_WAVE);
        const int row0 = u.pm * BM + wr * 64 + fr, col0 = u.pn * BM + wc * 32 + 8 * fq;
        int cnt = 0;
#pragma unroll
        for (int ai = 0; ai < 2; ++ai) {
            u32x2 gall[4][2];
#pragma unroll
            for (int m = 0; m < 4; ++m) { const unsigned ro = (unsigned)(row0 + ai * HALF + m * 16) * (unsigned)ldc + (unsigned)col0;
#pragma unroll
                for (int bj = 0; bj < 2; ++bj) gall[m][bj] = *(const u32x2*)(G + ro + bj * HALF); }
            asm volatile("" ::: "memory");
#pragma unroll
            for (int m = 0; m < 4; ++m) { const unsigned ro = (unsigned)(row0 + ai * HALF + m * 16) * (unsigned)ldc + (unsigned)col0;
#pragma unroll
                for (int bj = 0; bj < 2; ++bj) { const u32x2 g = gall[m][bj];
                    const bool nz = (g.x | g.y) != 0u;
                    const unsigned long long bal = __builtin_amdgcn_ballot_w64(nz);
                    const int np = __builtin_popcountll(bal);
                    if (np > CAP) {
                        if (nz) { const f32x4 v0 = acc[ai][bj][m][0] * hscale, v1 = acc[ai][bj][m][1] * hscale;
                            one(cvt_pk_bf16(v0[0], v0[1]), cvt_pk_bf16(v0[2], v0[3]), cvt_pk_bf16(v1[0], v1[1]), cvt_pk_bf16(v1[2], v1[3]), g.x, g.y, ro + bj * HALF); }
                        else *(u32x2*)(A2 + ro + bj * HALF) = (u32x2){0u, 0u};
                        continue; }
                    if (cnt + np > CAP) { flush(rec, cnt, lane); cnt = 0; }
                    if (nz) { const int slot = cnt + (int)__builtin_amdgcn_mbcnt_hi((unsigned)(bal >> 32), __builtin_amdgcn_mbcnt_lo((unsigned)bal, 0u));
                        const f32x4 v0 = acc[ai][bj][m][0] * hscale, v1 = acc[ai][bj][m][1] * hscale;
                        PG8_LAS unsigned* r = rec + slot * REC_DW;
                        *(PG8_LAS u32x4*)r = (u32x4){cvt_pk_bf16(v0[0], v0[1]), cvt_pk_bf16(v0[2], v0[3]), cvt_pk_bf16(v1[0], v1[1]), cvt_pk_bf16(v1[2], v1[3])}; *(PG8_LAS u32x2*)(r + 4) = g; r[6] = ro + bj * HALF; }
                    else *(u32x2*)(A2 + ro + bj * HALF) = (u32x2){0u, 0u};
                    cnt += np;
                } }
        }
        flush(rec, cnt, lane);
    }
};

struct EpiHead {
    static constexpr bool PERM = true, AFTER_DRAIN = false;
    static constexpr int RED_OFF = STAGE_BYTES;
    bf16_t* Kh; bf16_t* Qh; bf16_t* Vh; const float* kg; const float* qg; float scale;
    __device__ __forceinline__ void operator()(const f32x4 (&acc)[2][2][4][2], const Unit& u, int wr, int wc, int fr, int fq) const {
        extern __shared__ __attribute__((aligned(16))) char pg8_lds_sym[];
        const int colt = u.pn * BM, row0 = u.pm * BM + wr * 64 + fr, cw = wc * 32 + 8 * fq;
        if (colt >= 8192) {
            const int head0 = (colt - 8192) >> 7;
#pragma unroll
            for (int ai = 0; ai < 2; ++ai)
#pragma unroll
                for (int m = 0; m < 4; ++m) { const int t = row0 + ai * HALF + m * 16, b = t >> 12, sq = t & 4095;
#pragma unroll
                    for (int bj = 0; bj < 2; ++bj) { const f32x4 v0 = acc[ai][bj][m][0] * scale, v1 = acc[ai][bj][m][1] * scale;
                        u32x4 w; w.x = cvt_pk_bf16(v0[0], v0[1]); w.y = cvt_pk_bf16(v0[2], v0[3]); w.z = cvt_pk_bf16(v1[0], v1[1]); w.w = cvt_pk_bf16(v1[2], v1[3]);
                        *(u32x4*)(Vh + ((size_t)(b * 32 + head0 + bj) * SEQ + sq) * 128 + cw) = w; } }
            return; }
        PG8_LAS float* red = (PG8_LAS float*)((PG8_LAS char*)pg8_lds_sym + RED_OFF);
#pragma unroll
        for (int ai = 0; ai < 2; ++ai)
#pragma unroll
            for (int m = 0; m < 4; ++m)
#pragma unroll
                for (int bj = 0; bj < 2; ++bj) { const f32x4 v0 = acc[ai][bj][m][0] * scale, v1 = acc[ai][bj][m][1] * scale;
                    float s = (v0[0] * v0[0] + v0[1] * v0[1]) + (v0[2] * v0[2] + v0[3] * v0[3]) + (v1[0] * v1[0] + v1[1] * v1[1]) + (v1[2] * v1[2] + v1[3] * v1[3]);
                    s += __shfl_xor(s, 16); s += __shfl_xor(s, 32);
                    if (fq == 0) red[(((((wr * 4 + wc) * 2 + ai) * 4 + m) * 2 + bj) << 4) + fr] = s; }
        asm volatile("s_waitcnt lgkmcnt(0)\n\ts_barrier" ::: "memory");
        const bool isq = colt >= 4096; const float* gp = (isq ? qg : kg) + cw; const f32x4 g0 = *(const f32x4*)gp, g1 = *(const f32x4*)(gp + 4);
        bf16_t* dsth = isq ? Qh : Kh; const int head0 = ((isq ? colt - 4096 : colt) >> 7);
#pragma unroll
        for (int ai = 0; ai < 2; ++ai)
#pragma unroll
            for (int m = 0; m < 4; ++m) { const int t = row0 + ai * HALF + m * 16, b = t >> 12, sq = t & 4095;
#pragma unroll
                for (int bj = 0; bj < 2; ++bj) {
                    float tot = 0.f;
#pragma unroll
                    for (int w = 0; w < 4; ++w) tot += red[(((((wr * 4 + w) * 2 + ai) * 4 + m) * 2 + bj) << 4) + fr];
                    const float rn = __builtin_amdgcn_rsqf(tot * (1.f / 128.f) + EPS) * scale;
                    const f32x4 v0 = acc[ai][bj][m][0] * rn * g0, v1 = acc[ai][bj][m][1] * rn * g1;
                    u32x4 w8; w8.x = cvt_pk_bf16(v0[0], v0[1]); w8.y = cvt_pk_bf16(v0[2], v0[3]); w8.z = cvt_pk_bf16(v1[0], v1[1]); w8.w = cvt_pk_bf16(v1[2], v1[3]);
                    *(u32x4*)(dsth + ((size_t)(b * 32 + head0 + bj) * SEQ + sq) * 128 + cw) = w8; } }
    }
};

template <bool IB, bool OB> struct EpiResB {
    static constexpr bool PERM = true, AFTER_DRAIN = false;
    const void* base; void* out; int ldc; float scale;
    __device__ __forceinline__ void operator()(const f32x4 (&acc)[2][2][4][2], const Unit& u, int wr, int wc, int fr, int fq) const {
        const int row0 = u.pm * BM + wr * 64 + fr, col0 = u.pn * BM + wc * 32 + 8 * fq;
#pragma unroll
        for (int ai = 0; ai < 2; ++ai)
#pragma unroll
            for (int m = 0; m < 4; ++m) { const size_t off = (size_t)(row0 + ai * HALF + m * 16) * ldc + col0;
                f32x4 b0[2], b1[2];
#pragma unroll
                for (int bj = 0; bj < 2; ++bj) {
                    if (IB) { const u32x4 r = *(const u32x4*)((const bf16_t*)base + off + bj * HALF);
                        b0[bj] = (f32x4){__uint_as_float(r.x << 16), __uint_as_float(r.x & 0xffff0000u), __uint_as_float(r.y << 16), __uint_as_float(r.y & 0xffff0000u)};
                        b1[bj] = (f32x4){__uint_as_float(r.z << 16), __uint_as_float(r.z & 0xffff0000u), __uint_as_float(r.w << 16), __uint_as_float(r.w & 0xffff0000u)}; }
                    else { b0[bj] = *(const f32x4*)((const float*)base + off + bj * HALF); b1[bj] = *(const f32x4*)((const float*)base + off + bj * HALF + 4); } }
#pragma unroll
                for (int bj = 0; bj < 2; ++bj) { const f32x4 v0 = b0[bj] + acc[ai][bj][m][0] * scale, v1 = b1[bj] + acc[ai][bj][m][1] * scale;
                    if (OB) { u32x4 w; w.x = cvt_pk_bf16(v0[0], v0[1]); w.y = cvt_pk_bf16(v0[2], v0[3]); w.z = cvt_pk_bf16(v1[0], v1[1]); w.w = cvt_pk_bf16(v1[2], v1[3]);
                        *(u32x4*)((bf16_t*)out + off + bj * HALF) = w; }
                    else { *(f32x4*)((float*)out + off + bj * HALF) = v0; *(f32x4*)((float*)out + off + bj * HALF + 4) = v1; } }
                asm volatile("" ::: "memory"); }
    }
};
template <class Epi, class Sched, bool ALIGN_EPI = false, bool SP2 = false, bool F8 = false>
__device__ __forceinline__ void gemm_phase(PG8_LAS unsigned char* lds, const Gemm g, const Sched& S, const Epi& E) {
    const int tid = threadIdx.x, wid = __builtin_amdgcn_readfirstlane(tid >> 6), lane = tid & 63, wr = wid >> 2, wc = wid & 3, fr = lane & 15, fq = lane >> 4;
    const int K = g.K, nt = K / BK;
    unsigned voffA[2], voffB[2];
#pragma unroll
    for (int i = 0; i < 2; ++i) { int R, C; stage_rc(tid * 16 + i * 8192, R, C); const int Rb = Epi::PERM ? ((R & ~31) + perm32(R & 31)) : R;
        voffA[i] = (unsigned)(R * K + C) * 2u; voffB[i] = (unsigned)(Rb * K + C) * 2u; }
    const size_t kstep = (size_t)(BK * 2);
    const size_t hstep = (size_t)HALF * K * 2;
    const size_t tstep = 2 * hstep;
    const unsigned ldsw = (unsigned)wid * 1024u;
    const int aoff = lds_byte(wr * 64 + fr, fq * 8), boff = lds_byte(wc * 32 + fr, fq * 8);
#define PG8_SA(b, h) (((b) * 2 + (h)) * HTB)
#define PG8_SB(b, h) ((4 + (b) * 2 + (h)) * HTB)
#define PG8_STAGE(bufoff, gbase, voff) do { _Pragma("unroll") for (int _i = 0; _i < 2; ++_i) \
        __builtin_amdgcn_global_load_lds((const unsigned*)((const char*)(gbase) + (voff)[_i]), (PG8_LAS unsigned*)(lds + (bufoff) + ldsw + _i * 8192), 16, 0, 0); } while (0)
#define PG8_LDA(dst, b, h) do { if constexpr (F8) { _Pragma("unroll") for (int m = 0; m < 4; ++m) { const i32x4 lo_ = *(const PG8_LAS i32x4*)(lds + PG8_SA(b, h) + aoff + m * 2048), hi_ = *(const PG8_LAS i32x4*)(lds + PG8_SA(b, h) + aoff + m * 2048 + 1024); \
        dst##_8[m] = __builtin_shufflevector(lo_, hi_, 0, 1, 2, 3, 4, 5, 6, 7); } } else { _Pragma("unroll") for (int m = 0; m < 4; ++m) _Pragma("unroll") for (int k = 0; k < 2; ++k) dst[m][k] = *(const PG8_LAS bf16x8*)(lds + PG8_SA(b, h) + aoff + m * 2048 + k * 1024); } } while (0)
#define PG8_LDB(dst, b, h) do { if constexpr (F8) { _Pragma("unroll") for (int n = 0; n < 2; ++n) { const i32x4 lo_ = *(const PG8_LAS i32x4*)(lds + PG8_SB(b, h) + boff + n * 2048), hi_ = *(const PG8_LAS i32x4*)(lds + PG8_SB(b, h) + boff + n * 2048 + 1024); \
        dst##_8[n] = __builtin_shufflevector(lo_, hi_, 0, 1, 2, 3, 4, 5, 6, 7); } } else { _Pragma("unroll") for (int n = 0; n < 2; ++n) _Pragma("unroll") for (int k = 0; k < 2; ++k) dst[n][k] = *(const PG8_LAS bf16x8*)(lds + PG8_SB(b, h) + boff + n * 2048 + k * 1024); } } while (0)
#define PG8_MMA(ai, bj, At, Bt) do { __builtin_amdgcn_s_setprio(1); if constexpr (F8) { _Pragma("unroll") for (int m = 0; m < 4; ++m) _Pragma("unroll") for (int n = 0; n < 2; ++n) \
        asm volatile("v_mfma_f32_16x16x128_f8f6f4 %0, %1, %2, %0" : "+v"(acc[ai][bj][m][n]) : "v"(Bt##_8[n]), "v"(At##_8[m])); } \
    else { _Pragma("unroll") for (int m = 0; m < 4; ++m) _Pragma("unroll") for (int n = 0; n < 2; ++n) _Pragma("unroll") for (int k = 0; k < 2; ++k) \
        acc[ai][bj][m][n] = __builtin_amdgcn_mfma_f32_16x16x32_bf16(Bt[n][k], At[m][k], acc[ai][bj][m][n], 0, 0, 0); } __builtin_amdgcn_s_setprio(0); } while (0)
#define PG8_WAIT_V(n) asm volatile("s_waitcnt vmcnt(" #n ")" ::: "memory")
#define PG8_WAIT_L(n) asm volatile("s_waitcnt lgkmcnt(" #n ")" ::: "memory")
#define PG8_BAR __builtin_amdgcn_s_barrier()
#define PG8_SCHED __builtin_amdgcn_sched_barrier(0)
    Unit cur, nxt; int ui = 0;
    if (!S.next(0, cur)) return;
    f32x4 acc[2][2][4][2];
#pragma unroll
    for (int a = 0; a < 2; ++a)
#pragma unroll
        for (int b = 0; b < 2; ++b)
#pragma unroll
            for (int m = 0; m < 4; ++m)
#pragma unroll
                for (int n = 0; n < 2; ++n) acc[a][b][m][n] = (f32x4){0.f, 0.f, 0.f, 0.f};
    const int f8_scale_one = 0x7F7F7F7F;
    bf16x8 At[4][2], B0[2][2], B1[2][2]; i32x8 At_8[4], B0_8[2], B1_8[2];
    const char* cA = (const char*)g.A + (size_t)cur.pm * tstep; const char* cB = (const char*)g.Bt + (size_t)cur.pn * tstep;
    S.a_ready(cur);
    if constexpr (SP2) {
        PG8_STAGE(PG8_SB(0, 0), cB, voffB); PG8_STAGE(PG8_SB(0, 1), cB + hstep, voffB); PG8_STAGE(PG8_SA(0, 0), cA, voffA); PG8_STAGE(PG8_SA(0, 1), cA + hstep, voffA);
        if (wr == 1) PG8_BAR;
        PG8_WAIT_V(2); PG8_BAR;
        PG8_STAGE(PG8_SB(1, 0), cB + kstep, voffB); PG8_STAGE(PG8_SA(1, 0), cA + kstep, voffA); PG8_STAGE(PG8_SB(1, 1), cB + hstep + kstep, voffB);
        PG8_WAIT_V(6); PG8_BAR;
    } else {
        PG8_STAGE(PG8_SB(0, 0), cB, voffB); PG8_STAGE(PG8_SA(0, 0), cA, voffA); PG8_STAGE(PG8_SB(0, 1), cB + hstep, voffB); PG8_STAGE(PG8_SA(0, 1), cA + hstep, voffA);
        if (wr == 1) PG8_BAR;
        PG8_WAIT_V(4); PG8_BAR;
        PG8_STAGE(PG8_SB(1, 0), cB + kstep, voffB); PG8_STAGE(PG8_SA(1, 0), cA + kstep, voffA); PG8_STAGE(PG8_SB(1, 1), cB + hstep + kstep, voffB);
        PG8_WAIT_V(6); PG8_BAR;
    }
    for (;;) {
        const bool has_next = S.next(ui + 1, nxt);
        const char* nA = has_next ? (const char*)g.A + (size_t)nxt.pm * tstep : cA; const char* nB = has_next ? (const char*)g.Bt + (size_t)nxt.pn * tstep : cB;
        for (int t = 0; t < nt; t += 2) {
            const bool last = (t == nt - 2);
            const char* a1 = cA + (size_t)(t + 1) * kstep;
            const char* a2 = last ? nA : cA + (size_t)(t + 2) * kstep; const char* b2 = last ? nB : cB + (size_t)(t + 2) * kstep;
            const char* a3 = a2 + kstep; const char* b3 = b2 + kstep;
            if (last && has_next) S.a_ready(nxt);
            if constexpr (SP2) {
            PG8_LDB(B0, 0, 0); PG8_LDB(B1, 0, 1); PG8_SCHED; PG8_LDA(At, 0, 0); PG8_STAGE(PG8_SA(1, 1), a1 + hstep, voffA);
            PG8_WAIT_V(8); PG8_WAIT_L(0); PG8_BAR; PG8_MMA(0, 0, At, B0); PG8_MMA(0, 1, At, B1); PG8_BAR; PG8_SCHED;
            PG8_LDA(At, 0, 1); PG8_STAGE(PG8_SB(0, 0), b2, voffB); PG8_STAGE(PG8_SB(0, 1), b2 + hstep, voffB); PG8_STAGE(PG8_SA(0, 0), a2, voffA);
            PG8_WAIT_V(8); PG8_WAIT_L(0); PG8_BAR; PG8_MMA(1, 0, At, B0); PG8_MMA(1, 1, At, B1); PG8_BAR; PG8_SCHED;
            PG8_LDB(B0, 1, 0); PG8_LDB(B1, 1, 1); PG8_SCHED; PG8_LDA(At, 1, 0); PG8_STAGE(PG8_SA(0, 1), a2 + hstep, voffA);
            PG8_WAIT_V(8); PG8_WAIT_L(0); PG8_BAR; PG8_MMA(0, 0, At, B0); PG8_MMA(0, 1, At, B1); PG8_BAR; PG8_SCHED;
            PG8_LDA(At, 1, 1); PG8_STAGE(PG8_SB(1, 0), b3, voffB); PG8_STAGE(PG8_SB(1, 1), b3 + hstep, voffB); PG8_STAGE(PG8_SA(1, 0), a3, voffA);
            PG8_WAIT_V(8); PG8_WAIT_L(0); PG8_BAR; PG8_MMA(1, 0, At, B0); PG8_MMA(1, 1, At, B1); PG8_BAR; PG8_SCHED;
            } else {
            PG8_LDB(B0, 0, 0); PG8_SCHED; PG8_LDA(At, 0, 0); PG8_STAGE(PG8_SA(1, 1), a1 + hstep, voffA);
            PG8_WAIT_L(8); PG8_BAR; PG8_WAIT_L(0); PG8_MMA(0, 0, At, B0); PG8_BAR; PG8_SCHED;
            PG8_LDB(B1, 0, 1); PG8_STAGE(PG8_SB(0, 0), b2, voffB);
            PG8_BAR; PG8_WAIT_L(0); PG8_MMA(0, 1, At, B1); PG8_BAR;
            PG8_LDA(At, 0, 1); PG8_STAGE(PG8_SA(0, 0), a2, voffA);
            PG8_BAR; PG8_WAIT_L(0); PG8_MMA(1, 0, At, B0); PG8_BAR; PG8_SCHED;
            PG8_STAGE(PG8_SB(0, 1), b2 + hstep, voffB);
            PG8_WAIT_V(6); PG8_BAR; PG8_MMA(1, 1, At, B1); PG8_BAR;
            PG8_LDB(B0, 1, 0); PG8_SCHED; PG8_LDA(At, 1, 0); PG8_STAGE(PG8_SA(0, 1), a2 + hstep, voffA);
            PG8_WAIT_L(8); PG8_BAR; PG8_WAIT_L(0); PG8_MMA(0, 0, At, B0); PG8_BAR; PG8_SCHED;
            PG8_LDB(B1, 1, 1); PG8_STAGE(PG8_SB(1, 0), b3, voffB);
            PG8_BAR; PG8_WAIT_L(0); PG8_MMA(0, 1, At, B1); PG8_BAR;
            PG8_LDA(At, 1, 1); PG8_STAGE(PG8_SA(1, 0), a3, voffA);
            PG8_BAR; PG8_WAIT_L(0); PG8_MMA(1, 0, At, B0); PG8_BAR; PG8_SCHED;
            PG8_STAGE(PG8_SB(1, 1), b3 + hstep, voffB);
            PG8_WAIT_V(6); PG8_BAR; PG8_MMA(1, 1, At, B1); PG8_BAR;
            }
        }
        if constexpr (ALIGN_EPI) { if (wr == 0) PG8_BAR; }
        if constexpr (!Epi::AFTER_DRAIN) { E(acc, cur, wr, wc, fr, fq); S.done(cur); }
        if (!has_next) break;
#pragma unroll
        for (int a = 0; a < 2; ++a)
#pragma unroll
            for (int b = 0; b < 2; ++b)
#pragma unroll
                for (int m = 0; m < 4; ++m)
#pragma unroll
                    for (int n = 0; n < 2; ++n) acc[a][b][m][n] = (f32x4){0.f, 0.f, 0.f, 0.f};
        cur = nxt; cA = nA; cB = nB; ++ui;
        if constexpr (ALIGN_EPI) { if (wr == 1) PG8_BAR; }
    }
    PG8_WAIT_V(0);
    if constexpr (!ALIGN_EPI) { if (wr == 0) PG8_BAR; }
    PG8_BAR;
    if constexpr (Epi::AFTER_DRAIN) { E.fused(acc, cur, wr, wc, fr, fq, lds, wid, lane); S.done(cur); }
#undef PG8_SA
#undef PG8_SB
#undef PG8_STAGE
#undef PG8_LDA
#undef PG8_LDB
#undef PG8_MMA
#undef PG8_WAIT_V
#undef PG8_WAIT_L
#undef PG8_BAR
#undef PG8_SCHED
}
}
namespace att {
constexpr int D = 128;
#if F8_KVQ == 1
constexpr int VSTR = 12288;
#else
constexpr int VSTR = 128;
#endif
constexpr int WINDOW = 4096;
constexpr float THR = 8.f;
constexpr bool WSKIP = false;
constexpr float SCALE = 0.08838834764831845f;
constexpr int NW = 8, QBLK = 32, KVBLK = 64, QB = NW * QBLK;
constexpr int SHM_V = KVBLK * D * 2, SHM_K = KVBLK * D * 2;
constexpr int LDS_BYTES = 2 * SHM_V + 2 * SHM_K + NW * 64 * 4;
using bf16 = __hip_bfloat16;
typedef short bf16x8 __attribute__((ext_vector_type(8)));
typedef short s16x4 __attribute__((ext_vector_type(4)));
typedef float f32x16 __attribute__((ext_vector_type(16)));
typedef float f32x4 __attribute__((ext_vector_type(4)));
typedef unsigned u32x4 __attribute__((ext_vector_type(4)));
template <class A, class Bt> struct same_t { static constexpr bool v = false; };
template <class A> struct same_t<A, A> { static constexpr bool v = true; };

#define KSWZ(row, colB) ((row) * 256 + ((colB) ^ (((row) & 7) << 4)))
#define SBAR() __builtin_amdgcn_sched_barrier(0)
__device__ __forceinline__ int v_st(int k, int c) { const int kk = (k & ~0xC) | ((k & 4) << 1) | ((k & 8) >> 1); return ((kk >> 3) * 4 + (c >> 5)) * 512 + ((kk & 7) * 32 + (c & 31)) * 2; }
__device__ __forceinline__ int v_rd_base(int lane) { return ((lane & 3) << 3) | (((lane >> 2) & 3) << 6) | (((lane >> 4) & 1) << 5) | (((lane >> 5) & 1) << 8); }
constexpr int v_rd_off(int d0, int ks, int half) { return d0 * 512 + ks * 4096 + half * 2048; }
__device__ __forceinline__ int crow(int r, int hi) { return (r & 3) + 8 * (r >> 2) + 4 * hi; }
__device__ __forceinline__ unsigned cvtpk(float lo, float hi) {
    unsigned r; asm volatile("v_cvt_pk_bf16_f32 %0, %1, %2" : "=v"(r) : "v"(lo), "v"(hi)); return r;
}
__device__ __forceinline__ bf16x8 pack8(f32x4 a, f32x4 b) {
    u32x4 w = {cvtpk(a[0], a[1]), cvtpk(a[2], a[3]), cvtpk(b[0], b[1]), cvtpk(b[2], b[3])};
    return *reinterpret_cast<bf16x8*>(&w);
}
template <class T> __device__ __forceinline__ bf16x8 load8(const T* p) {
    if constexpr (same_t<T, float>::v) { return pack8(*(const f32x4*)p, *(const f32x4*)(p + 4)); }
    else { return *reinterpret_cast<const bf16x8*>(p); }
}
__device__ __forceinline__ void mask_tile(f32x16& p0, f32x16& p1, int dq, unsigned W) {
    const float NEG = -__builtin_inff();
#pragma unroll
    for (int r = 0; r < 16; ++r) {
        const int c = (r & 3) + 8 * (r >> 2);
        if ((unsigned)(dq - c) >= W) p0[r] = NEG;
        if ((unsigned)(dq - c - 32) >= W) p1[r] = NEG;
    }
}
__device__ __forceinline__ void partialSM(f32x16& p0, f32x16& p1, float& m_reg, float& mn, float& alpha) {
    float pmax = p0[0]; for (int r = 1; r < 16; ++r) pmax = fmaxf(pmax, p0[r]); for (int r = 0; r < 16; ++r) pmax = fmaxf(pmax, p1[r]);
    { auto rr = __builtin_amdgcn_permlane32_swap(__float_as_uint(pmax), __float_as_uint(pmax), false, false);
      pmax = fmaxf(__uint_as_float(rr[0]), __uint_as_float(rr[1])); }
    constexpr float C2 = 1.4426950408889634f * SCALE;
    if (__builtin_expect(__all((pmax - m_reg) * SCALE <= THR), 1)) { mn = m_reg; alpha = 1.f; }
    else { mn = fmaxf(m_reg, pmax); alpha = __builtin_amdgcn_exp2f((m_reg - mn) * C2); m_reg = mn; }
    const float mnL = -mn * C2;
    for (int r = 0; r < 16; ++r) p0[r] = fmaf(p0[r], C2, mnL); for (int r = 0; r < 16; ++r) p1[r] = fmaf(p1[r], C2, mnL);
    for (int r = 0; r < 16; ++r) p0[r] = __builtin_amdgcn_exp2f(p0[r]);
}
__device__ __forceinline__ void finishSM(f32x16& p0, f32x16& p1, float alpha, float& l_reg, bf16x8& pa0, bf16x8& pa1, bf16x8& pa2, bf16x8& pa3) {
    for (int r = 0; r < 16; ++r) p1[r] = __builtin_amdgcn_exp2f(p1[r]);
    float ps = 0; for (int r = 0; r < 16; ++r) ps += p0[r]; for (int r = 0; r < 16; ++r) ps += p1[r];
    { auto rr = __builtin_amdgcn_permlane32_swap(__float_as_uint(ps), __float_as_uint(ps), false, false);
      ps = __uint_as_float(rr[0]) + __uint_as_float(rr[1]); }
    l_reg = l_reg * alpha + ps;
#define PK4(P, B_, OUT) do { unsigned a0 = cvtpk(P[B_+0], P[B_+1]), a1 = cvtpk(P[B_+2], P[B_+3]);                          \
        unsigned b0 = cvtpk(P[B_+4], P[B_+5]), b1 = cvtpk(P[B_+6], P[B_+7]);                                             \
        auto r0 = __builtin_amdgcn_permlane32_swap(a0, b0, false, false); auto r1 = __builtin_amdgcn_permlane32_swap(a1, b1, false, false); \
        u32x4 w = {r0[0], r1[0], r0[1], r1[1]}; OUT = *reinterpret_cast<bf16x8*>(&w); } while (0)
    PK4(p0, 0, pa0); PK4(p0, 8, pa1); PK4(p1, 0, pa2); PK4(p1, 8, pa3);
#undef PK4
}
template <int KB, bool SK>
__device__ __forceinline__ void qkt(f32x16& p0, f32x16& p1, const char* K_lds, int r32, int hi, const bf16x8* qr, bool act) {
    if (SK && !act) { const float NEG = -__builtin_inff();
#pragma unroll
        for (int r = 0; r < 16; ++r) { p0[r] = NEG; p1[r] = NEG; } return; }
    p0 = f32x16{}; p1 = f32x16{};
    const char* kb[4];
#pragma unroll
    for (int dd = 0; dd < 4; ++dd) kb[dd] = K_lds + KB * SHM_K + KSWZ(r32, (dd * 16 + hi * 8) * 2);
#pragma unroll
    for (int d0 = 0; d0 < 8; ++d0) { const char* a = kb[d0 & 3] + (d0 >> 2) * 128;
        bf16x8 b0 = *reinterpret_cast<const bf16x8*>(a);
        bf16x8 b1 = *reinterpret_cast<const bf16x8*>(a + 32 * 256);
        p0 = __builtin_amdgcn_mfma_f32_32x32x16_bf16(b0, qr[d0], p0, 0, 0, 0);
        p1 = __builtin_amdgcn_mfma_f32_32x32x16_bf16(b1, qr[d0], p1, 0, 0, 0); }
}
template <int VB, bool SK>
__device__ __forceinline__ void pv_tile(f32x16* o, int vb0, bf16x8 pa0, bf16x8 pa1, bf16x8 pa2, bf16x8 pa3, bool act) {
    if (SK && !act) return;
#define TRRD(dst, off) asm volatile("ds_read_b64_tr_b16 %0, %1 offset:%2" : "=&v"(dst) : "v"(vb0), "i"(off) : "memory")
#define PV_D0(d0) do { s16x4 l0, l1, l2, l3, h0, h1, h2, h3; constexpr int b_ = VB * SHM_V + v_rd_off(d0, 0, 0);     \
        TRRD(l0, b_); TRRD(h0, b_ + 2048); TRRD(l1, b_ + 4096); TRRD(h1, b_ + 6144); TRRD(l2, b_ + 8192); TRRD(h2, b_ + 10240); TRRD(l3, b_ + 12288); TRRD(h3, b_ + 14336); \
        asm volatile("s_waitcnt lgkmcnt(0)" ::: "memory"); SBAR();                 \
        o[d0] = __builtin_amdgcn_mfma_f32_32x32x16_bf16(pa0, (bf16x8){l0[0], l0[1], l0[2], l0[3], h0[0], h0[1], h0[2], h0[3]}, o[d0], 0, 0, 0);   \
        o[d0] = __builtin_amdgcn_mfma_f32_32x32x16_bf16(pa1, (bf16x8){l1[0], l1[1], l1[2], l1[3], h1[0], h1[1], h1[2], h1[3]}, o[d0], 0, 0, 0);   \
        o[d0] = __builtin_amdgcn_mfma_f32_32x32x16_bf16(pa2, (bf16x8){l2[0], l2[1], l2[2], l2[3], h2[0], h2[1], h2[2], h2[3]}, o[d0], 0, 0, 0);   \
        o[d0] = __builtin_amdgcn_mfma_f32_32x32x16_bf16(pa3, (bf16x8){l3[0], l3[1], l3[2], l3[3], h3[0], h3[1], h3[2], h3[3]}, o[d0], 0, 0, 0); } while (0)
    PV_D0(0); PV_D0(1); PV_D0(2); PV_D0(3);
#undef PV_D0
#undef TRRD
}

template <class TIn, class TOut> struct BlockRef { const TIn* Q; const TIn* K; const TIn* V; TOut* O; int P0; };
template <class TIn> struct Seam {
    bf16x8 qr[8];
    bf16x8 st_v0, st_v1, st_k0, st_k1; f32x4 sf0, sf1, sf2, sf3;
    f32x4 tq[16];
};
__device__ __forceinline__ int swa_jlo(int P0, int W) { const int lowk = P0 - W + 1; return lowk > 0 ? lowk / KVBLK : 0; }
#define ROW(p, k0, rr) ((p) + (size_t)((k0) + (rr)) * D + sc)
#define ROWV(p, k0, rr) ((p) + (size_t)((k0) + (rr)) * VSTR + sc)
#define VMW() asm volatile("s_waitcnt vmcnt(0)" ::: "memory")
#define VMWN(n) asm volatile("s_waitcnt vmcnt(%0)" :: "i"(n) : "memory")
#define SLOAD_H(Kp, Vp, k0) do { S.st_v0 = load8<TIn>(ROWV(Vp, k0, sr)); S.st_v1 = load8<TIn>(ROWV(Vp, k0, 32 + sr));              \
                         S.st_k0 = load8<TIn>(ROW(Kp, k0, sr)); S.st_k1 = load8<TIn>(ROW(Kp, k0, 32 + sr)); } while (0)
#define SWRITE_HK(bf) do { *(bf16x8*)(K_lds + (bf) * SHM_K + kws) = S.st_k0; *(bf16x8*)(K_lds + (bf) * SHM_K + kws + 32 * 256) = S.st_k1; } while (0)
#define SWRITE_HV(bf) do { *(bf16x8*)(V_lds + (bf) * SHM_V + vst0) = S.st_v0; *(bf16x8*)(V_lds + (bf) * SHM_V + vst1) = S.st_v1; } while (0)
#define SWRITE_H(bf) do { SWRITE_HV(bf); SWRITE_HK(bf); } while (0)
#define SLOAD_F(p, k0) do { S.sf0 = *(const f32x4*)ROW(p, k0, sr); S.sf1 = *(const f32x4*)(ROW(p, k0, sr) + 4);                \
                            S.sf2 = *(const f32x4*)ROW(p, k0, 32 + sr); S.sf3 = *(const f32x4*)(ROW(p, k0, 32 + sr) + 4); } while (0)
#define SWRITE_KF(bf) do { *(bf16x8*)(K_lds + (bf) * SHM_K + kws) = pack8(S.sf0, S.sf1); *(bf16x8*)(K_lds + (bf) * SHM_K + kws + 32 * 256) = pack8(S.sf2, S.sf3); } while (0)
#define SWRITE_VF(bf) do { *(bf16x8*)(V_lds + (bf) * SHM_V + vst0) = pack8(S.sf0, S.sf1); *(bf16x8*)(V_lds + (bf) * SHM_V + vst1) = pack8(S.sf2, S.sf3); } while (0)
template <class TIn, class TOut>
__device__ __forceinline__ void causal_swa_prime(const BlockRef<TIn, TOut>& cur, int W, char* lds, Seam<TIn>& S) {
    constexpr bool F32 = same_t<TIn, float>::v;
    const int tid = threadIdx.x, wid = __builtin_amdgcn_readfirstlane(tid >> 6), lane = tid & 63, r32 = lane & 31, hi = lane >> 5;
    const int sr = tid >> 4, sc = (tid & 15) * 8, kws = KSWZ(sr, sc * 2); char* K_lds = lds + 2 * SHM_V;
    const int kb0 = swa_jlo(cur.P0, W) * KVBLK;
    for (int d0 = 0; d0 < 8; ++d0) S.qr[d0] = load8<TIn>(cur.Q + (size_t)(wid * QBLK + r32) * D + d0 * 16 + hi * 8);
    if constexpr (F32) { SLOAD_F((const float*)cur.K, kb0); VMW(); SWRITE_KF(0); SBAR(); SLOAD_F((const float*)cur.V, kb0); }
    else { SLOAD_H(cur.K, cur.V, kb0); VMW(); SWRITE_HK(0); }
    __syncthreads();
}
template <class TIn, class TOut>
__device__ __forceinline__ void causal_swa_block(const BlockRef<TIn, TOut>& cur, const BlockRef<TIn, TOut>& nxt, int skv, int W, char* lds, Seam<TIn>& S) {
    constexpr bool F32 = same_t<TIn, float>::v;
    const int tid = threadIdx.x, wid = __builtin_amdgcn_readfirstlane(tid >> 6), lane = tid & 63, r32 = lane & 31, hi = lane >> 5;
    const int j_lo = swa_jlo(cur.P0, W);
    int j_hi = (cur.P0 + QB - 1) / KVBLK + 1; if (j_hi > skv / KVBLK) j_hi = skv / KVBLK;
    const int NT = j_hi - j_lo;
    const int kbn = swa_jlo(nxt.P0, W) * KVBLK;
    const int qlo = cur.P0 + wid * QBLK, qm = qlo + r32 - 4 * hi;
    char* V_lds = lds; char* K_lds = lds + 2 * SHM_V;
    float* ws = (float*)(lds + 2 * SHM_V + 2 * SHM_K) + wid * 64; float* li_l = ws, * al_l = ws + 32;
    float m_reg = -1e30f, l_reg = 0; f32x16 o[4] = {};
    const int sr = tid >> 4, sc = (tid & 15) * 8, vst0 = v_st(sr, sc), vst1 = v_st(32 + sr, sc), kws = KSWZ(sr, sc * 2);
    const int vb0 = (int)(uintptr_t)V_lds + v_rd_base(lane);
    const TIn* Kh = cur.K; const TIn* Vh = cur.V;
#define RESC(a) do { if (__any((a) < 1.f)) { if (hi == 0) al_l[r32] = (a); asm volatile("s_waitcnt lgkmcnt(0)" ::: "memory");              \
                     for (int d_ = 0; d_ < 4; ++d_) for (int r = 0; r < 16; ++r) o[d_][r] *= al_l[crow(r, hi)]; } } while (0)
#define KBASE(t) ((j_lo + (t)) * KVBLK)
#define ACT(t) (KBASE(t) <= qlo + QBLK - 1 && KBASE(t) + KVBLK - 1 >= qlo - W + 1)
#define MASKT(P0_, P1_, t) do { const int kb_ = KBASE(t); if ((!SK || ACT(t)) && (kb_ + KVBLK - 1 > qlo || kb_ <= qlo + QBLK - 1 - W)) mask_tile(P0_, P1_, qm - kb_, (unsigned)W); } while (0)
    constexpr int NQL = F32 ? 16 : 8;
    constexpr bool SK = WSKIP && !F32;
#define SEAM_K0() do { VMWN(NQL); if constexpr (F32) { SWRITE_KF(0); SBAR(); SLOAD_F((const float*)nxt.V, kbn); } else { SWRITE_HK(0); } SBAR(); } while (0)
    f32x16 pA0, pA1, pB0, pB1; float mnA, mnB, alA, alB; bf16x8 pa0, pa1, pa2, pa3;
    if constexpr (F32) { VMW(); SWRITE_VF(0); SBAR(); } else { SWRITE_HV(0); SBAR(); }
    if (NT > 1) { if constexpr (F32) SLOAD_F((const float*)Kh, KBASE(1)); else SLOAD_H(Kh, Vh, KBASE(1)); }
    SBAR(); qkt<0, SK>(pA0, pA1, K_lds, r32, hi, S.qr, ACT(0));
    if constexpr (F32) { if (NT > 1) { VMW(); SWRITE_KF(1); SBAR(); SLOAD_F((const float*)Vh, KBASE(1)); } }
    MASKT(pA0, pA1, 0); partialSM(pA0, pA1, m_reg, mnA, alA);
    if (NT > 1) { VMW(); if constexpr (F32) { SWRITE_VF(1); SBAR(); if (NT > 2) SLOAD_F((const float*)Kh, KBASE(2)); } else SWRITE_H(1); }
    __syncthreads();
#define HALF_STEP(PX0, PX1, mnX, alX, PY0, PY1, alY, t, KB, VB, SB) do {                                                      \
        SBAR(); qkt<KB, SK>(PX0, PX1, K_lds, r32, hi, S.qr, ACT(t));                                             \
        finishSM(PY0, PY1, alY, l_reg, pa0, pa1, pa2, pa3); SBAR();                                                           \
        if ((t) + 1 < NT) { if constexpr (F32) { VMW(); SWRITE_KF(SB); SBAR(); SLOAD_F((const float*)Vh, KBASE((t) + 1)); }  \
                            else { SLOAD_H(Kh, Vh, KBASE((t) + 1)); } SBAR(); }                                               \
        pv_tile<VB, SK>(o, vb0, pa0, pa1, pa2, pa3, ACT((t) - 1)); MASKT(PX0, PX1, (t)); partialSM(PX0, PX1, m_reg, mnX, alX);                                        \
        __syncthreads();                                                                                                      \
        if ((t) + 1 < NT) { VMW(); if constexpr (F32) { SWRITE_VF(SB); SBAR(); if ((t) + 2 < NT) SLOAD_F((const float*)Kh, KBASE((t) + 2)); } \
                            else { SWRITE_H(SB); } }                                                                          \
        RESC(alX); __syncthreads(); } while (0)
    for (int t = 1; t + 1 < NT; t += 2) {
        HALF_STEP(pB0, pB1, mnB, alB, pA0, pA1, alA, t, 1, 0, 0);
        HALF_STEP(pA0, pA1, mnA, alA, pB0, pB1, alB, t + 1, 0, 1, 1);
    }
    const bool even = (NT & 1) == 0;
    if (even) { SBAR(); qkt<1, SK>(pB0, pB1, K_lds, r32, hi, S.qr, ACT(NT - 1)); SBAR(); }
#define QROW(e) (nxt.Q + (size_t)(wid * QBLK + r32) * D + ((e) >> 1) * 16 + hi * 8 + ((e) & 1) * 4)
    if constexpr (F32) { SLOAD_F((const float*)nxt.K, kbn); SBAR();
#pragma unroll
        for (int e = 0; e < 8; ++e) S.tq[e] = *(const f32x4*)QROW(e); }
    else { SLOAD_H(nxt.K, nxt.V, kbn); SBAR();
#pragma unroll
        for (int d0 = 0; d0 < 8; ++d0) S.qr[d0] = load8<TIn>(nxt.Q + (size_t)(wid * QBLK + r32) * D + d0 * 16 + hi * 8); }
    SBAR();
    finishSM(pA0, pA1, alA, l_reg, pa0, pa1, pa2, pa3); SBAR();
    if constexpr (F32) {
#pragma unroll
        for (int e = 8; e < 16; ++e) S.tq[e] = *(const f32x4*)QROW(e); SBAR(); }
#undef QROW
    pv_tile<0, SK>(o, vb0, pa0, pa1, pa2, pa3, ACT(even ? NT - 2 : NT - 1));
    if (even) { MASKT(pB0, pB1, NT - 1); partialSM(pB0, pB1, m_reg, mnB, alB); __syncthreads(); RESC(alB);
        finishSM(pB0, pB1, alB, l_reg, pa0, pa1, pa2, pa3); SBAR(); pv_tile<1, SK>(o, vb0, pa0, pa1, pa2, pa3, ACT(NT - 1)); }
    SBAR(); SEAM_K0();
    if (hi == 0) li_l[r32] = l_reg; asm volatile("s_waitcnt lgkmcnt(0)" ::: "memory");
    float rli[16];
#pragma unroll
    for (int r = 0; r < 16; ++r) rli[r] = __builtin_amdgcn_rcpf(li_l[crow(r, hi)]);
    TOut* Ow = cur.O + (size_t)(wid * QBLK) * D;
#pragma unroll
    for (int r = 0; r < 16; ++r) { const int orow = crow(r, hi);
#pragma unroll
        for (int d0 = 0; d0 < 4; ++d0) { const float v = o[d0][r] * rli[r];
            if constexpr (same_t<TOut, float>::v) { Ow[(size_t)orow * D + d0 * 32 + r32] = v; }
            else { const float vn = __shfl_xor(v, 1);
                   if ((r32 & 1) == 0) *(unsigned*)(Ow + (size_t)orow * D + d0 * 32 + r32) = cvtpk(v, vn); } } }
    if constexpr (F32) {
#pragma unroll
        for (int d0 = 0; d0 < 8; ++d0) S.qr[d0] = pack8(S.tq[2 * d0], S.tq[2 * d0 + 1]); }
    __syncthreads();
#undef RESC
#undef KBASE
#undef ACT
#undef MASKT
#undef SEAM_K0
#undef HALF_STEP
}
#undef ROW
#undef ROWV
#undef VMW
#undef VMWN
#undef SLOAD_H
#undef SWRITE_HK
#undef SWRITE_HV
#undef SWRITE_H
#undef SLOAD_F
#undef SWRITE_KF
#undef SWRITE_VF
}
struct Ctx { LAS unsigned char* lds; int tid, lane, wave, vcu, G; };

__device__ __forceinline__ void tr_load(f4v (&v)[16], float (&gk)[16], const float* __restrict__ src, size_t ldn, const float* __restrict__ gain, int k0, int nsrc0, int lane) {
    const int r4 = lane >> 4, c4 = (lane & 15) * 4;
#pragma unroll
    for (int i = 0; i < 16; ++i) v[i] = *(const f4v*)(src + (size_t)(k0 + 4 * i + r4) * ldn + nsrc0 + c4);
#pragma unroll
    for (int i = 0; i < 16; ++i) gk[i] = gain ? gain[k0 + 4 * i + r4] : 1.f;
}
__device__ __forceinline__ void tr_item(const f4v (&v)[16], const float (&gv)[16], bfr* __restrict__ dst, int K,
                                        int k0, int drow0, LAS float* scr, int lane) {
    const int r4 = lane >> 4, c4 = (lane & 15) * 4;
#pragma unroll
    for (int i = 0; i < 16; ++i) { const int k = 4 * i + r4; const float gk = gv[i];
        LAS float* s = scr + k * 65 + c4; s[0] = v[i][0] * gk; s[1] = v[i][1] * gk; s[2] = v[i][2] * gk; s[3] = v[i][3] * gk; }
    LDS_WAIT(); asm volatile("" ::: "memory");
    const int c = lane & 7;
#pragma unroll
    for (int jj = 0; jj < 8; ++jj) { const int n = (lane >> 3) + 8 * jj; const LAS float* s = scr + (8 * c) * 65 + n;
        u4v o; o.x = cvtpk(s[0 * 65], s[1 * 65]); o.y = cvtpk(s[2 * 65], s[3 * 65]); o.z = cvtpk(s[4 * 65], s[5 * 65]); o.w = cvtpk(s[6 * 65], s[7 * 65]);
        *(u4v*)(dst + (size_t)(drow0 + n) * K + k0 + 8 * c) = o; }
    LDS_WAIT(); asm volatile("" ::: "memory");
}
__device__ __forceinline__ void tr_item8(const f4v (&v)[16], float sc, const float (&gv)[16], unsigned char* __restrict__ dst, int K, int k0, int drow0, LAS float* scr, int lane) {
    const int r4 = lane >> 4, c4 = (lane & 15) * 4;
#pragma unroll
    for (int i = 0; i < 16; ++i) { const int k = 4 * i + r4; const float gk = gv[i] * sc; LAS float* s = scr + k * 65 + c4; s[0] = v[i][0] * gk; s[1] = v[i][1] * gk; s[2] = v[i][2] * gk; s[3] = v[i][3] * gk; }
    LDS_WAIT(); asm volatile("" ::: "memory");
    const int c = lane & 3;
#pragma unroll
    for (int jj = 0; jj < 4; ++jj) { const int n = (lane >> 2) + 16 * jj; const LAS float* s = scr + (16 * c) * 65 + n;
        u4v o; o.x = cvt4_fp8(s[0 * 65], s[1 * 65], s[2 * 65], s[3 * 65]); o.y = cvt4_fp8(s[4 * 65], s[5 * 65], s[6 * 65], s[7 * 65]);
        o.z = cvt4_fp8(s[8 * 65], s[9 * 65], s[10 * 65], s[11 * 65]); o.w = cvt4_fp8(s[12 * 65], s[13 * 65], s[14 * 65], s[15 * 65]);
        *(u4v*)(dst + (size_t)(drow0 + n) * K + k0 + 16 * c) = o; }
    LDS_WAIT(); asm volatile("" ::: "memory");
}
__device__ __forceinline__ void tr_job8(const float* __restrict__ src, size_t ldn, float sc, const float* __restrict__ gain, unsigned char* __restrict__ dst, int K, int ncols, LAS float* scr, int lane, int gw, int NGW, int nsrc0 = 0) {
    const int nn = ncols / 64, ni = (K / 64) * nn;
    float ga[16], gb[16];
    f4v va[16], vb[16];
#define TRJ_LOAD(V, G_, it_) do { const int kb_ = (it_) / nn, nb_ = (it_) - kb_ * nn; tr_load(V, G_, src, ldn, gain, kb_ * 64, nsrc0 + nb_ * 64, lane); } while (0)
#define TRJ_ITEM(V, G_, it_) do { const int kb_ = (it_) / nn, nb_ = (it_) - kb_ * nn; tr_item8(V, sc, G_, dst, K, kb_ * 64, nb_ * 64, scr, lane); } while (0)
    int it = gw;
    if (it < ni) {
        TRJ_LOAD(va, ga, it);
        while (it + 2 * NGW < ni) {
            TRJ_LOAD(vb, gb, it + NGW); TRJ_ITEM(va, ga, it); TRJ_LOAD(va, ga, it + 2 * NGW); TRJ_ITEM(vb, gb, it + NGW); it += 2 * NGW; }
        if (it + NGW < ni) { TRJ_LOAD(vb, gb, it + NGW); TRJ_ITEM(va, ga, it); TRJ_ITEM(vb, gb, it + NGW); } else TRJ_ITEM(va, ga, it);
    }
#undef TRJ_LOAD
#undef TRJ_ITEM
}
__device__ __forceinline__ void tr_job(const float* __restrict__ src, size_t ldn, const float* __restrict__ gain, bfr* __restrict__ dst, int K, int ncols, int nsrc0, int drow0,
                                       LAS float* scr, int lane, int gw, int NGW) {
    const int nn = ncols / 64, ni = (K / 64) * nn;
    float ga[16], gb[16];
    f4v va[16], vb[16];
#define TRJ_LOAD(V, G_, it_) do { const int kb_ = (it_) / nn, nb_ = (it_) - kb_ * nn; tr_load(V, G_, src, ldn, gain, kb_ * 64, nsrc0 + nb_ * 64, lane); } while (0)
#define TRJ_ITEM(V, G_, it_) do { const int kb_ = (it_) / nn, nb_ = (it_) - kb_ * nn; tr_item(V, G_, dst, K, kb_ * 64, drow0 + nb_ * 64, scr, lane); } while (0)
    int it = gw;
    if (it < ni) {
        TRJ_LOAD(va, ga, it);
        while (it + 2 * NGW < ni) {
            TRJ_LOAD(vb, gb, it + NGW); TRJ_ITEM(va, ga, it); TRJ_LOAD(va, ga, it + 2 * NGW); TRJ_ITEM(vb, gb, it + NGW); it += 2 * NGW; }
        if (it + NGW < ni) { TRJ_LOAD(vb, gb, it + NGW); TRJ_ITEM(va, ga, it); TRJ_ITEM(vb, gb, it + NGW); } else TRJ_ITEM(va, ga, it);
    }
#undef TRJ_LOAD
#undef TRJ_ITEM
}
struct KArgs {
    const float* in[26]; float* out; unsigned char* ws; int ph_lo, ph_hi, li, pad;
};
struct Ptrs {
    LAS unsigned long long* tbl;
    __device__ __forceinline__ unsigned long long get(int k) const { const unsigned long long v = tbl[k];
        return ((unsigned long long)(unsigned)__builtin_amdgcn_readfirstlane((int)(unsigned)(v >> 32)) << 32) | (unsigned)__builtin_amdgcn_readfirstlane((int)(unsigned)v); }
    __device__ __forceinline__ const float* in_(int k) const { return (const float*)get(k); }
    __device__ __forceinline__ float* out_() const { return (float*)get(26); }
    __device__ __forceinline__ unsigned char* ws_() const { return (unsigned char*)get(27); }
};
__device__ __forceinline__ void p_convert(const Ctx& C, const Ptrs& P, const int part, const int vc, const int nc) {
    LAS float* scr = (LAS float*)(C.lds + C.wave * 16640);
    const int gw = vc * 8 + C.wave, NGW = nc * 8;
    unsigned char* ws = P.ws_();
    if (part == 0) {
#if F8_PROJ0 == 1
    tr_job8(P.in_(2), (size_t)GIN, SU, P.in_(1), ws + WS_WTIN, DM, 16384, scr, C.lane, gw, NGW);
#elif F8_PROJ0 == 2
    tr_job(P.in_(2), (size_t)GIN, P.in_(1), (bfr*)(ws + WS_WTIN), DM, 8192, 0, 0, scr, C.lane, gw, NGW);
    tr_job8(P.in_(2), (size_t)GIN, SU, P.in_(1), ws + WS_WTIN + (size_t)8192 * DM * 2, DM, 8192, scr, C.lane, gw, NGW, 8192);
#elif F8_PROJ0 == 5
    tr_job8(P.in_(2), (size_t)GIN, SU, P.in_(1), ws + WS_WTIN, DM, 8192, scr, C.lane, gw, NGW, 0);
    tr_job(P.in_(2), (size_t)GIN, P.in_(1), (bfr*)(ws + WS_WTIN + (size_t)32 * MiB), DM, 4096, 8192, 0, scr, C.lane, gw, NGW);
    tr_job8(P.in_(2), (size_t)GIN, SU, P.in_(1), ws + WS_WTIN + (size_t)64 * MiB, DM, 4096, scr, C.lane, gw, NGW, 12288);
#elif F8_PROJ0 == 6
    tr_job8(P.in_(2), (size_t)GIN, SU, P.in_(1), ws + WS_WTIN, DM, 12288, scr, C.lane, gw, NGW, 0);
    tr_job(P.in_(2), (size_t)GIN, P.in_(1), (bfr*)(ws + WS_WTIN + (size_t)48 * MiB), DM, 4096, 12288, 0, scr, C.lane, gw, NGW);
#elif F8_PROJ0 == 3
    tr_job8(P.in_(2), (size_t)GIN, SU, P.in_(1), ws + WS_WTIN, DM, 8192, scr, C.lane, gw, NGW, 0);
    tr_job(P.in_(2), (size_t)GIN, P.in_(1), (bfr*)(ws + WS_WTIN + (size_t)8192 * DM), DM, 8192, 8192, 0, scr, C.lane, gw, NGW);
#else
    tr_job(P.in_(2), (size_t)GIN, P.in_(1), (bfr*)(ws + WS_WTIN), DM, 16384, 0, 0, scr, C.lane, gw, NGW);
#endif
    tr_job(P.in_(2), (size_t)GIN, P.in_(1), (bfr*)(ws + WS_WTBD), DM, 64, 16384, 0, scr, C.lane, gw, NGW);
#if F8_OUT0
    tr_job8(P.in_(7), (size_t)DM, SU, nullptr, ws + WS_WTOUT, DM, DM, scr, C.lane, gw, NGW, 0);
#else
    tr_job(P.in_(7), (size_t)DM, nullptr, (bfr*)(ws + WS_WTOUT), DM, DM, 0, 0, scr, C.lane, gw, NGW);
#endif
    } else {
#if F8_KVQ
    tr_job8(P.in_(9), (size_t)8192, SU, P.in_(8), ws + WS_WTKVQ, DM, DM, scr, C.lane, gw, NGW, 0);
    tr_job8(P.in_(12), (size_t)DM, SU, P.in_(11), ws + WS_WTKVQ + (size_t)DM * DM, DM, DM, scr, C.lane, gw, NGW, 0);
#if F8_KVQ == 2
    tr_job8(P.in_(9), (size_t)8192, SU, P.in_(8), ws + WS_WTKVQ + (size_t)2 * DM * DM, DM, DM, scr, C.lane, gw, NGW, DM);
#else
    tr_job(P.in_(9), (size_t)8192, P.in_(8), (bfr*)(ws + WS_WTKVQ + (size_t)2 * DM * DM), DM, DM, DM, 0, scr, C.lane, gw, NGW);
#endif
#else
    tr_job(P.in_(9), (size_t)8192, P.in_(8), (bfr*)(ws + WS_WTKVQ), DM, 8192, 0, 0, scr, C.lane, gw, NGW);
    tr_job(P.in_(12), (size_t)DM, P.in_(11), (bfr*)(ws + WS_WTKVQ), DM, DM, 0, 8192, scr, C.lane, gw, NGW);
#endif
#if F8_OUT1
    tr_job8(P.in_(19), (size_t)DM, SU, nullptr, ws + WS_WTO, DM, DM, scr, C.lane, gw, NGW, 0);
#else
    tr_job(P.in_(19), (size_t)DM, nullptr, (bfr*)(ws + WS_WTO), DM, DM, 0, 0, scr, C.lane, gw, NGW);
#endif
    }
    tr_job(P.in_(21) + (size_t)part * DM * PQ, (size_t)PQ, P.in_(20) + part * DM, (bfr*)(ws + WS_WTQRY) + (size_t)part * PQ * DM, DM, PQ, 0, 0, scr, C.lane, gw, NGW);
    tr_job8(P.in_(25) + (size_t)part * PE * DM, (size_t)DM, SV, nullptr, ws + WS_VT + (size_t)part * DM * PE, PE, DM, scr, C.lane, gw, NGW);
    {
        const size_t gt = (size_t)vc * 512 + C.tid, GT = (size_t)nc * 512;
        for (int l = part; l <= part; ++l) {
            const float* src = P.in_(24) + (size_t)l * PE * DM; const float* gain = P.in_(20) + l * DM; unsigned char* dst = ws + WS_U + (size_t)l * PE * DM;
            constexpr size_t NIT = (size_t)PE * DM / 16; size_t i0 = gt;
            for (; i0 + 3 * GT < NIT; i0 += 4 * GT) {
                f4v x[4][4];
#pragma unroll
                for (int u = 0; u < 4; ++u) { const size_t i = i0 + (size_t)u * GT;
#pragma unroll
                    for (int j = 0; j < 4; ++j) x[u][j] = *(const f4v*)(src + i * 16 + 4 * j); }
#pragma unroll
                for (int u = 0; u < 4; ++u) { const size_t i = i0 + (size_t)u * GT; const int dd = (int)((i * 16) & (DM - 1));
                    u4v o; unsigned w[4];
#pragma unroll
                    for (int j = 0; j < 4; ++j) { const f4v g = *(const f4v*)(gain + dd + 4 * j) * SU; w[j] = cvt4_fp8(x[u][j][0] * g[0], x[u][j][1] * g[1], x[u][j][2] * g[2], x[u][j][3] * g[3]); }
                    o.x = w[0]; o.y = w[1]; o.z = w[2]; o.w = w[3];
                    *(u4v*)(dst + i * 16) = o; }
            }
            for (; i0 < NIT; i0 += GT) {
                const size_t i = i0; const int dd = (int)((i * 16) & (DM - 1)); u4v o; unsigned w[4];
#pragma unroll
                for (int j = 0; j < 4; ++j) { const f4v xx = *(const f4v*)(src + i * 16 + 4 * j); const f4v g = *(const f4v*)(gain + dd + 4 * j) * SU; w[j] = cvt4_fp8(xx[0] * g[0], xx[1] * g[1], xx[2] * g[2], xx[3] * g[3]); }
                o.x = w[0]; o.y = w[1]; o.z = w[2]; o.w = w[3];
                *(u4v*)(dst + i * 16) = o; }
        }
        for (int l = part; l <= part; ++l) {
            bfr* dst = (bfr*)(ws + WS_WTKEY) + (size_t)l * PQ * PQ;
            for (size_t i = gt; i < (size_t)PQ * PQ / 8; i += GT) {
                const int row = (int)((i * 8) / PQ), col = (int)((i * 8) % PQ); u4v o = {0u, 0u, 0u, 0u};
                if ((row >> 7) == (col >> 7)) { const int blk = row >> 7, h = blk >> 1, half = blk & 1, n = row & 127, d = col & 127;
                    const float* src = (half ? P.in_(23) : P.in_(22)) + (((size_t)l * PH + h) * PK + n) * 128 + d;
                    const f4v a = *(const f4v*)src, b = *(const f4v*)(src + 4);
                    o.x = cvtpk(a[0], a[1]); o.y = cvtpk(a[2], a[3]); o.z = cvtpk(b[0], b[1]); o.w = cvtpk(b[2], b[3]); }
                *(u4v*)(dst + i * 8) = o; }
        }
    }
}

template <bool SB = false>
__device__ __forceinline__ void p_norm_rows(const Ctx& C, const void* __restrict__ srcv, bfr* __restrict__ dst, unsigned char* __restrict__ dst8) {
    const int gw = C.vcu * 8 + C.wave, NGW = C.G * 8;
    for (int row = gw; row < NT; row += NGW) {
        f4v a[8], b[8]; float ss = 0.f;
        if (SB) { const u4v* p = (const u4v*)((const bfr*)srcv + (size_t)row * DM); u4v raw[8];
#pragma unroll
            for (int j = 0; j < 8; ++j) raw[j] = p[j * 64 + C.lane];
#pragma unroll
            for (int j = 0; j < 8; ++j) { a[j] = (f4v){bflo(raw[j].x), bfhi(raw[j].x), bflo(raw[j].y), bfhi(raw[j].y)}; b[j] = (f4v){bflo(raw[j].z), bfhi(raw[j].z), bflo(raw[j].w), bfhi(raw[j].w)}; } }
        else { const f4v* p = (const f4v*)((const float*)srcv + (size_t)row * DM);
#pragma unroll
            for (int j = 0; j < 8; ++j) { a[j] = p[j * 128 + 2 * C.lane]; b[j] = p[j * 128 + 2 * C.lane + 1]; } }
#pragma unroll
        for (int j = 0; j < 8; ++j) ss += (a[j][0] * a[j][0] + a[j][1] * a[j][1]) + (a[j][2] * a[j][2] + a[j][3] * a[j][3]) + (b[j][0] * b[j][0] + b[j][1] * b[j][1]) + (b[j][2] * b[j][2] + b[j][3] * b[j][3]);
        const float r = __builtin_amdgcn_rsqf(wave_sum(ss) * (1.f / DM) + EPS);
        u4v* o = (u4v*)(dst + (size_t)row * DM);
#pragma unroll
        for (int j = 0; j < 8; ++j) { u4v w; w.x = cvtpk(a[j][0] * r, a[j][1] * r); w.y = cvtpk(a[j][2] * r, a[j][3] * r); w.z = cvtpk(b[j][0] * r, b[j][1] * r); w.w = cvtpk(b[j][2] * r, b[j][3] * r);
            if (dst) o[j * 64 + C.lane] = w;
            if (dst8) { u2v w8; w8.x = cvt4_fp8(a[j][0] * r, a[j][1] * r, a[j][2] * r, a[j][3] * r); w8.y = cvt4_fp8(b[j][0] * r, b[j][1] * r, b[j][2] * r, b[j][3] * r); ((u2v*)(dst8 + (size_t)row * DM))[j * 64 + C.lane] = w8; } }
    }
}

__device__ __forceinline__ void p_bd(const Ctx& C, const bfr* __restrict__ XN, const bfr* __restrict__ WB, float* __restrict__ BD) {
    LAS float* red = (LAS float*)C.lds;
    const int r = C.lane & 15, q = C.lane >> 4, rt = C.wave >> 2, kq = C.wave & 3;
    for (int blk = C.vcu; blk < NT / 32; blk += C.G) {
        const bfr* ap = XN + (size_t)(blk * 32 + rt * 16 + r) * DM + kq * 1024 + q * 8;
        const bfr* bp = WB + (size_t)r * DM + kq * 1024 + q * 8;
        f4v acc[4] = {zero_acc(), zero_acc(), zero_acc(), zero_acc()};
#pragma unroll 4
        for (int ks = 0; ks < 32; ++ks) {
            const s8v a = *(const s8v*)(ap + ks * 32);
#pragma unroll
            for (int nt = 0; nt < 4; ++nt) { const s8v b = *(const s8v*)(bp + (size_t)nt * 16 * DM + ks * 32); acc[nt] = __builtin_amdgcn_mfma_f32_16x16x32_bf16(a, b, acc[nt], 0, 0, 0); }
            MFMA_SETTLE(acc[0]); MFMA_SETTLE(acc[1]); MFMA_SETTLE(acc[2]); MFMA_SETTLE(acc[3]);
        }
        MFMA_SETTLE(acc[0]); MFMA_SETTLE(acc[1]); MFMA_SETTLE(acc[2]); MFMA_SETTLE(acc[3]);
#pragma unroll
        for (int nt = 0; nt < 4; ++nt)
#pragma unroll
            for (int i = 0; i < 4; ++i) red[C.wave * 1024 + (4 * q + i) * 64 + nt * 16 + r] = -acc[nt][i];
        __syncthreads();
#pragma unroll
        for (int i = 0; i < 4; ++i) { const int idx = C.tid * 4 + i, t2 = idx >> 10, rem = idx & 1023;
            const float s = -((red[(t2 * 4 + 0) * 1024 + rem] + red[(t2 * 4 + 1) * 1024 + rem]) + (red[(t2 * 4 + 2) * 1024 + rem] + red[(t2 * 4 + 3) * 1024 + rem]));
            BD[(size_t)(blk * 32 + t2 * 16 + (rem >> 6)) * 64 + (rem & 63)] = s; }
        __syncthreads();
    }
}
__device__ __forceinline__ int kq_off(int row, int chunk) { return row * 256 + ((chunk ^ (row & 7)) << 4); }
__device__ __forceinline__ int xt_off(int col, int chunk) { return col * 128 + ((chunk ^ (col & 7)) << 4); }
__device__ __forceinline__ void p_gdn_prep(const Ctx& C, const Ptrs& P, int vp, int np) {
    unsigned char* ws = P.ws_();
    const bfr* PROJ = (const bfr*)(ws + WS_BIG); const float* BD = (const float*)(ws + WS_BD);
    const float* convw = P.in_(3); const float* alog = P.in_(4); const float* dtb = P.in_(5);
    bfr* Wg = (bfr*)(ws + WS_R + R_W); bfr* Ug = (bfr*)(ws + WS_R + R_U); bfr* QGg = (bfr*)(ws + WS_R + R_QG); bfr* KDg = (bfr*)(ws + WS_R + R_KD); bfr* QKg = (bfr*)(ws + WS_R + R_QK);
    float* EGg = (float*)(ws + WS_EG);
    LAS float* sCW = (LAS float*)(C.lds + 82944);
    for (int tk = vp; tk < NB * GH * 32; tk += np) {
        const int wq = tk >> 3, it = tk & 7;
        const int bh = wq >> 2, cg = wq & 3, h = bh & 31, b = bh >> 5;
        for (int i = C.tid; i < 1536; i += 512) { const int part = i >> 9, tap = (i >> 7) & 3, ch = i & 127; sCW[i] = convw[tap * 12288 + part * 4096 + h * 128 + ch]; }
        __syncthreads();
        {
            int tid = C.tid; asm volatile("" : "+v"(tid));
            const int hw = tid >> 8, lt = tid & 255, lane = tid & 63, lw = (tid >> 6) & 3;
            const int c = cg * 16 + it * 2 + hw, unit = bh * 64 + c, t0 = b * SEQ + c * CH;
            LAS unsigned char* hb = C.lds + hw * 41472;
            LAS unsigned char* sK = hb; LAS unsigned char* sQ = hb + 16384; LAS unsigned char* sX = hb;
            LAS unsigned char* sAM = hb + 32768; LAS float* sB = (LAS float*)(hb + 40960); LAS float* sG = (LAS float*)(hb + 41216);
            LAS float* scr = (LAS float*)(C.lds + 89088 + (tid >> 6) * 4352);
            LAS float* sAD = (LAS float*)(C.lds + 123904 + hw * 4096);
            if (lt < 64) {
                const int t = t0 + lt; const float braw = BD[(size_t)t * 64 + h], araw = BD[(size_t)t * 64 + 32 + h];
                const float beta = 1.f / (1.f + expf(-braw)); const float xx = araw + dtb[h]; const float sp = fmaxf(xx, 0.f) + log1pf(expf(-fabsf(xx)));
                float g = -expf(alog[h]) * sp;
#pragma unroll
                for (int o = 1; o < 64; o <<= 1) { const float y = __shfl_up(g, o); if (lane >= o) g += y; }
                sB[lt] = beta; sG[lt] = g;
            }
            __syncthreads();
            const int tk = lt >> 2, cs = lt & 3;
            const float beta = sB[tk], gc = sG[tk], gl = sG[63]; const float eg = expf(gc), ed = expf(gl - gc), bg = beta * eg;
            u4v kbg[4], vbt[4];
#pragma unroll
            for (int part = 0; part < 3; ++part) {
                float y[32];
#pragma unroll
                for (int i = 0; i < 32; ++i) y[i] = 0.f;
#pragma unroll
                for (int j = 0; j < 4; ++j) {
                    const int s = c * CH + tk - 3 + j;
                    if (s >= 0) {
                        const bfr* row = PROJ + (size_t)(b * SEQ + s) * 16384 + part * 4096 + h * 128 + cs * 32;
#pragma unroll
                        for (int q4 = 0; q4 < 4; ++q4) { const u4v x = *(const u4v*)(row + 8 * q4); const LAS float* wp = sCW + part * 512 + j * 128 + cs * 32 + 8 * q4;
                            const f4v w0 = *(const LAS f4v*)wp, w1 = *(const LAS f4v*)(wp + 4);
                            y[8 * q4 + 0] += bflo(x.x) * w0[0]; y[8 * q4 + 1] += bfhi(x.x) * w0[1]; y[8 * q4 + 2] += bflo(x.y) * w0[2]; y[8 * q4 + 3] += bfhi(x.y) * w0[3];
                            y[8 * q4 + 4] += bflo(x.z) * w1[0]; y[8 * q4 + 5] += bfhi(x.z) * w1[1]; y[8 * q4 + 6] += bflo(x.w) * w1[2]; y[8 * q4 + 7] += bfhi(x.w) * w1[3]; }
                    }
                }
                float ss = 0.f;
#pragma unroll
                for (int i = 0; i < 32; ++i) { y[i] = y[i] * __builtin_amdgcn_rcpf(1.f + __expf(-y[i])); ss += y[i] * y[i]; }
                if (part < 2) {
                    ss += __shfl_xor(ss, 1); ss += __shfl_xor(ss, 2);
                    const float rn = __builtin_amdgcn_rsqf(ss + EPS) * (part == 0 ? 0.08838834764831845f : 1.f); const float gs = part == 0 ? eg : ed;
                    LAS unsigned char* dstl = part == 0 ? sQ : sK; bfr* dstg = (part == 0 ? QGg : KDg) + (size_t)unit * 8192 + tk * 128 + cs * 32;
#pragma unroll
                    for (int q4 = 0; q4 < 4; ++q4) { float z[8];
#pragma unroll
                        for (int i = 0; i < 8; ++i) z[i] = y[8 * q4 + i] * rn;
                        u4v w; w.x = cvtpk(z[0], z[1]); w.y = cvtpk(z[2], z[3]); w.z = cvtpk(z[4], z[5]); w.w = cvtpk(z[6], z[7]);
                        *(LAS u4v*)(dstl + kq_off(tk, cs * 4 + q4)) = w;
                        u4v g; g.x = cvtpk(z[0] * gs, z[1] * gs); g.y = cvtpk(z[2] * gs, z[3] * gs); g.z = cvtpk(z[4] * gs, z[5] * gs); g.w = cvtpk(z[6] * gs, z[7] * gs);
                        *(u4v*)(dstg + 8 * q4) = g;
                        if (part == 1) { kbg[q4].x = cvtpk(z[0] * bg, z[1] * bg); kbg[q4].y = cvtpk(z[2] * bg, z[3] * bg); kbg[q4].z = cvtpk(z[4] * bg, z[5] * bg); kbg[q4].w = cvtpk(z[6] * bg, z[7] * bg); } }
                } else {
#pragma unroll
                    for (int q4 = 0; q4 < 4; ++q4) { vbt[q4].x = cvtpk(y[8 * q4] * beta, y[8 * q4 + 1] * beta); vbt[q4].y = cvtpk(y[8 * q4 + 2] * beta, y[8 * q4 + 3] * beta);
                        vbt[q4].z = cvtpk(y[8 * q4 + 4] * beta, y[8 * q4 + 5] * beta); vbt[q4].w = cvtpk(y[8 * q4 + 6] * beta, y[8 * q4 + 7] * beta); }
                }
            }
            __syncthreads();
            {
                const int r = lane & 15, q = lane >> 4, mt = lw;
                s8v ak[4], aq[4];
#pragma unroll
                for (int ks = 0; ks < 4; ++ks) { ak[ks] = *(const LAS s8v*)(sK + kq_off(16 * mt + r, 4 * ks + q)); aq[ks] = *(const LAS s8v*)(sQ + kq_off(16 * mt + r, 4 * ks + q)); }
                float gi[4], bi[4];
#pragma unroll
                for (int e = 0; e < 4; ++e) { gi[e] = sG[16 * mt + 4 * q + e]; bi[e] = sB[16 * mt + 4 * q + e]; }
                for (int nt = 0; nt < 4; ++nt) {
                    const int j = 16 * nt + r;
                    if (nt <= mt) {
                        f4v ck = zero_acc(), cq = zero_acc();
#pragma unroll
                        for (int ks = 0; ks < 4; ++ks) { const s8v bb = *(const LAS s8v*)(sK + kq_off(16 * nt + r, 4 * ks + q));
                            ck = __builtin_amdgcn_mfma_f32_16x16x32_bf16(ak[ks], bb, ck, 0, 0, 0); cq = __builtin_amdgcn_mfma_f32_16x16x32_bf16(aq[ks], bb, cq, 0, 0, 0); }
                        MFMA_SETTLE(ck); MFMA_SETTLE(cq);
                        const float gj = sG[j];
#pragma unroll
                        for (int e = 0; e < 4; ++e) { const int i = 16 * mt + 4 * q + e; const float dec = expf(fminf(gi[e] - gj, 0.f));
                            const float av = (i > j) ? bi[e] * ck[e] * dec : 0.f;
                            *(LAS bfr*)(sAM + xt_off(i, j >> 3) + (j & 7) * 2) = f2bf1(av);
                            if (nt == mt) sAD[mt * 256 + (4 * q + e) * 16 + r] = av;
                            QKg[(size_t)unit * 4096 + i * 64 + j] = f2bf1((i >= j) ? cq[e] * dec : 0.f); }
                    } else {
#pragma unroll
                        for (int e = 0; e < 4; ++e) QKg[(size_t)unit * 4096 + (16 * mt + 4 * q + e) * 64 + j] = (bfr)0;
                    }
                }
            }
            __syncthreads();
            {
                const int ro = ((tk >> 3)), rb = (tk & 7) * 2;
#pragma unroll
                for (int q4 = 0; q4 < 4; ++q4) {
                    const unsigned vv[4] = {vbt[q4].x, vbt[q4].y, vbt[q4].z, vbt[q4].w}, kk[4] = {kbg[q4].x, kbg[q4].y, kbg[q4].z, kbg[q4].w};
#pragma unroll
                    for (int i = 0; i < 8; ++i) { const int ch = cs * 32 + q4 * 8 + i;
                        *(LAS bfr*)(sX + xt_off(ch, ro) + rb) = (bfr)((i & 1) ? (vv[i >> 1] >> 16) : (vv[i >> 1] & 0xffffu));
                        *(LAS bfr*)(sX + xt_off(128 + ch, ro) + rb) = (bfr)((i & 1) ? (kk[i >> 1] >> 16) : (kk[i >> 1] & 0xffffu)); }
                }
            }
            __syncthreads();
            {
                const int r = lane & 15, q = lane >> 4;
                float x[64];
#pragma unroll
                for (int bk = 0; bk < 4; ++bk) {
                    float corr[16];
#pragma unroll
                    for (int i = 0; i < 16; ++i) corr[i] = 0.f;
                    if (bk > 0) {
                        f4v acc[4] = {zero_acc(), zero_acc(), zero_acc(), zero_acc()};
#pragma unroll
                        for (int ks = 0; ks < (16 * bk + 31) / 32; ++ks) {
                            s8v a = *(const LAS s8v*)(sAM + xt_off(16 * bk + r, 4 * ks + q));
                            if (32 * ks + 8 * q >= 16 * bk) a = (s8v){0, 0, 0, 0, 0, 0, 0, 0};
#pragma unroll
                            for (int nt = 0; nt < 4; ++nt) { const s8v bx = *(const LAS s8v*)(sX + xt_off(64 * lw + 16 * nt + r, 4 * ks + q)); acc[nt] = __builtin_amdgcn_mfma_f32_16x16x32_bf16(a, bx, acc[nt], 0, 0, 0); }
                        }
                        MFMA_SETTLE(acc[0]); MFMA_SETTLE(acc[1]); MFMA_SETTLE(acc[2]); MFMA_SETTLE(acc[3]);
#pragma unroll
                        for (int nt = 0; nt < 4; ++nt)
#pragma unroll
                            for (int e = 0; e < 4; ++e) scr[(16 * nt + r) * 17 + 4 * q + e] = -acc[nt][e];
                        LDS_WAIT(); asm volatile("" ::: "memory");
#pragma unroll
                        for (int i = 0; i < 16; ++i) corr[i] = scr[lane * 17 + i];
                    }
                    const u4v r0 = *(const LAS u4v*)(sX + xt_off(lt, 2 * bk)), r1 = *(const LAS u4v*)(sX + xt_off(lt, 2 * bk + 1));
                    const float rhs[16] = {bflo(r0.x), bfhi(r0.x), bflo(r0.y), bfhi(r0.y), bflo(r0.z), bfhi(r0.z), bflo(r0.w), bfhi(r0.w), bflo(r1.x), bfhi(r1.x), bflo(r1.y), bfhi(r1.y), bflo(r1.z), bfhi(r1.z), bflo(r1.w), bfhi(r1.w)};
                    float xb[16];
#pragma unroll
                    for (int i = 0; i < 16; ++i) {
                        float v = rhs[i] + corr[i];
                        const u4v a0 = *(const LAS u4v*)(sAM + xt_off(16 * bk + i, 2 * bk)), a1 = *(const LAS u4v*)(sAM + xt_off(16 * bk + i, 2 * bk + 1));
                        const float am[16] = {bflo(a0.x), bfhi(a0.x), bflo(a0.y), bfhi(a0.y), bflo(a0.z), bfhi(a0.z), bflo(a0.w), bfhi(a0.w), bflo(a1.x), bfhi(a1.x), bflo(a1.y), bfhi(a1.y), bflo(a1.z), bfhi(a1.z), bflo(a1.w), bfhi(a1.w)};
#pragma unroll
                        for (int j = 0; j < 16; ++j) if (j < i) v -= am[j] * xb[j];
                        xb[i] = v; x[16 * bk + i] = v;
                    }
                    u4v w0, w1; w0.x = cvtpk(xb[0], xb[1]); w0.y = cvtpk(xb[2], xb[3]); w0.z = cvtpk(xb[4], xb[5]); w0.w = cvtpk(xb[6], xb[7]);
                    w1.x = cvtpk(xb[8], xb[9]); w1.y = cvtpk(xb[10], xb[11]); w1.z = cvtpk(xb[12], xb[13]); w1.w = cvtpk(xb[14], xb[15]);
                    *(LAS u4v*)(sX + xt_off(lt, 2 * bk)) = w0; *(LAS u4v*)(sX + xt_off(lt, 2 * bk + 1)) = w1;
                    LDS_WAIT(); asm volatile("" ::: "memory");
                }
                bfr* dst = (lt < 128 ? Ug : Wg) + (size_t)unit * 8192 + (lt & 127);
#pragma unroll
                for (int i = 0; i < 64; ++i) dst[i * 128] = f2bf1(x[i]);
                if (lt == 0) EGg[unit] = expf(sG[63]);
            }
            __syncthreads();
        }
    }
}

__device__ __forceinline__ void p_gdn_scan(const Ctx& C, const Ptrs& P) {
    unsigned char* ws = P.ws_();
    const GAS bfr* Wg = (const GAS bfr*)(ws + WS_R + R_W); const GAS bfr* Ug = (const GAS bfr*)(ws + WS_R + R_U); const GAS bfr* QGg = (const GAS bfr*)(ws + WS_R + R_QG); const GAS bfr* KDg = (const GAS bfr*)(ws + WS_R + R_KD);
    const GAS bfr* QKg = (const GAS bfr*)(ws + WS_R + R_QK); GAS bfr* Og = (GAS bfr*)(ws + WS_R + R_O); const GAS float* EGg = (const GAS float*)(ws + WS_EG);
    const int tid = C.tid, lane = C.lane, wave = C.wave, r = lane & 15, q = lane >> 4, mt = wave & 3, nt = wave >> 2;
    LAS bfr* sST = (LAS bfr*)(C.lds + 131072); LAS bfr* sVN = (LAS bfr*)(C.lds + 139776);
#define SC_W(bb)  ((LAS bfr*)(C.lds + (bb) * 65536))
#define SC_QG(bb) ((LAS bfr*)(C.lds + (bb) * 65536 + 17408))
#define SC_KD(bb) ((LAS bfr*)(C.lds + (bb) * 65536 + 34816))
#define SC_QK(bb) ((LAS bfr*)(C.lds + (bb) * 65536 + 52224))
#define SC_U(bb)  ((LAS bfr*)(C.lds + (bb) * 65536 + 61440))
#define SC_LOAD(n) do { const size_t ub = (size_t)(bh * 64 + (n)) * 8192; \
        rW0 = *(const GAS u4v*)(Wg + ub + (size_t)tid * 8); rW1 = *(const GAS u4v*)(Wg + ub + (size_t)(tid + 512) * 8); \
        rQ0 = *(const GAS u4v*)(QGg + ub + (size_t)tid * 8); rQ1 = *(const GAS u4v*)(QGg + ub + (size_t)(tid + 512) * 8); \
        rK0 = *(const GAS u4v*)(KDg + ub + (size_t)tid * 8); rK1 = *(const GAS u4v*)(KDg + ub + (size_t)(tid + 512) * 8); \
        rQK = *(const GAS u4v*)(QKg + (size_t)(bh * 64 + (n)) * 4096 + (size_t)tid * 8); \
        if (tid < 256) rU = *(const GAS u4v*)(Ug + ub + (size_t)(tid >> 2) * 128 + es * 32 + (tid & 3) * 8); } while (0)
#define SC_WRITE(bb) do { const int c0 = tid, c1 = tid + 512; \
        *(LAS u4v*)(SC_W(bb) + (c0 >> 4) * 136 + (c0 & 15) * 8) = rW0; *(LAS u4v*)(SC_W(bb) + (c1 >> 4) * 136 + (c1 & 15) * 8) = rW1; \
        *(LAS u4v*)(SC_QG(bb) + (c0 >> 4) * 136 + (c0 & 15) * 8) = rQ0; *(LAS u4v*)(SC_QG(bb) + (c1 >> 4) * 136 + (c1 & 15) * 8) = rQ1; \
        *(LAS u4v*)(SC_KD(bb) + (c0 >> 4) * 136 + (c0 & 15) * 8) = rK0; *(LAS u4v*)(SC_KD(bb) + (c1 >> 4) * 136 + (c1 & 15) * 8) = rK1; \
        *(LAS u4v*)(SC_QK(bb) + (tid >> 3) * 72 + (tid & 7) * 8) = rQK; \
        if (tid < 256) *(LAS u4v*)(SC_U(bb) + (tid >> 2) * 32 + (tid & 3) * 8) = rU; } while (0)
    for (int task = C.vcu; task < NB * GH * 4; task += C.G) {
        const int bh = task >> 2, es = task & 3, h = bh & 31, b = bh >> 5;
        u4v rW0, rW1, rQ0, rQ1, rK0, rK1, rQK, rU = {0u, 0u, 0u, 0u};
        f4v S0 = {0.f, 0.f, 0.f, 0.f}, S1 = {0.f, 0.f, 0.f, 0.f};
        LAS float* sEG = (LAS float*)(C.lds + 144384);
        if (tid < 64) sEG[tid] = EGg[bh * 64 + tid];
        SC_LOAD(0); SC_WRITE(0); SC_LOAD(1);
        for (int n = 0; n < NCH; ++n) {
            const int bb = n & 1;
            {
                MFMA_SETTLE(S0); MFMA_SETTLE(S1);
                u2v w0, w1; w0.x = cvtpk(S0[0], S0[1]); w0.y = cvtpk(S0[2], S0[3]); w1.x = cvtpk(S1[0], S1[1]); w1.y = cvtpk(S1[2], S1[3]);
                *(LAS u2v*)(sST + (r) * 136 + 16 * wave + 4 * q) = w0; *(LAS u2v*)(sST + (16 + r) * 136 + 16 * wave + 4 * q) = w1;
            }
            __syncthreads();
            if (n + 1 < NCH) { if (bb) SC_WRITE(0); else SC_WRITE(1); if (n + 2 < NCH) SC_LOAD(n + 2); }
            f4v acc1 = zero_acc(), acc2 = zero_acc();
            const LAS bfr* pW = SC_W(bb) + (16 * mt + r) * 136 + 8 * q; const LAS bfr* pQ = SC_QG(bb) + (16 * mt + r) * 136 + 8 * q; const LAS bfr* pS = sST + (16 * nt + r) * 136 + 8 * q;
#pragma unroll
            for (int ks = 0; ks < 4; ++ks) { const s8v a1 = *(const LAS s8v*)(pW + 32 * ks), a2 = *(const LAS s8v*)(pQ + 32 * ks), bs = *(const LAS s8v*)(pS + 32 * ks);
                acc1 = __builtin_amdgcn_mfma_f32_16x16x32_bf16(a1, bs, acc1, 0, 0, 0); acc2 = __builtin_amdgcn_mfma_f32_16x16x32_bf16(a2, bs, acc2, 0, 0, 0); }
            MFMA_SETTLE(acc1);
            {
                const LAS bfr* pU = SC_U(bb) + (16 * mt + 4 * q) * 32 + 16 * nt + r;
                const float v0 = bf1(pU[0]) - acc1[0], v1 = bf1(pU[32]) - acc1[1], v2 = bf1(pU[64]) - acc1[2], v3 = bf1(pU[96]) - acc1[3];
                u2v w; w.x = cvtpk(v0, v1); w.y = cvtpk(v2, v3);
                *(LAS u2v*)(sVN + (16 * nt + r) * 72 + 16 * mt + 4 * q) = w;
            }
            __syncthreads();
            {
                const LAS bfr* pA = SC_QK(bb) + (16 * mt + r) * 72 + 8 * q; const LAS bfr* pV = sVN + (16 * nt + r) * 72 + 8 * q;
#pragma unroll
                for (int ks = 0; ks < 2; ++ks) { const s8v a = *(const LAS s8v*)(pA + 32 * ks), bv = *(const LAS s8v*)(pV + 32 * ks); acc2 = __builtin_amdgcn_mfma_f32_16x16x32_bf16(a, bv, acc2, 0, 0, 0); }
                MFMA_SETTLE(acc2);
                GAS bfr* po = Og + (size_t)(b * SEQ + n * CH + 16 * mt + 4 * q) * DM + h * 128 + es * 32 + 16 * nt + r;
                po[0] = f2bf1(acc2[0]); po[DM] = f2bf1(acc2[1]); po[2 * DM] = f2bf1(acc2[2]); po[3 * DM] = f2bf1(acc2[3]);
            }
            {
                const float eg = sEG[n];
                S0 *= eg; S1 *= eg;
                const LAS bfr* pK = SC_KD(bb) + (8 * q) * 136 + 16 * wave + r; const LAS bfr* pV0 = sVN + r * 72 + 8 * q; const LAS bfr* pV1 = sVN + (16 + r) * 72 + 8 * q;
#pragma unroll
                for (int ks = 0; ks < 2; ++ks) {
                    s8v a;
#pragma unroll
                    for (int i = 0; i < 8; ++i) a[i] = (short)pK[(32 * ks + i) * 136];
                    const s8v b0 = *(const LAS s8v*)(pV0 + 32 * ks), b1 = *(const LAS s8v*)(pV1 + 32 * ks);
                    S0 = __builtin_amdgcn_mfma_f32_16x16x32_bf16(a, b0, S0, 0, 0, 0); S1 = __builtin_amdgcn_mfma_f32_16x16x32_bf16(a, b1, S1, 0, 0, 0);
                }
            }
        }
        __syncthreads();
    }
#undef SC_W
#undef SC_QG
#undef SC_KD
#undef SC_QK
#undef SC_U
#undef SC_LOAD
#undef SC_WRITE
}

#define S2_OFF_QG 17408
#define S2_OFF_QK 34816
#define S2_OFF_KT 44032
#define S2_OFF_U  62464
#define S2_BUF    66560
__device__ __forceinline__ s8v s2_frag(const LAS bfr* rowp, int q) {
    const u2v lo = *(const LAS u2v*)(rowp + 4 * q), hi = *(const LAS u2v*)(rowp + 16 + 4 * q);
    const u4v w = {lo.x, lo.y, hi.x, hi.y}; return __builtin_bit_cast(s8v, w);
}
__device__ __forceinline__ s8v s2_fragx(const LAS bfr* rowp, int g0, int g1) {
    const u2v lo = *(const LAS u2v*)(rowp + 4 * g0), hi = *(const LAS u2v*)(rowp + 4 * g1);
    const u4v w = {lo.x, lo.y, hi.x, hi.y}; return __builtin_bit_cast(s8v, w);
}
__device__ __forceinline__ s8v s2_pack(const f4v& a, const f4v& b) { const u4v w = {cvtpk(a[0], a[1]), cvtpk(a[2], a[3]), cvtpk(b[0], b[1]), cvtpk(b[2], b[3])}; return __builtin_bit_cast(s8v, w); }
template <int MODE = 0>
__device__ __forceinline__ void p_gdn_scan2(const Ctx& C, const Ptrs& P) {
    unsigned char* ws = P.ws_();
    const GAS bfr* Wg = (const GAS bfr*)(ws + WS_R + R_W); const GAS bfr* Ug = (const GAS bfr*)(ws + WS_R + R_U); const GAS bfr* QGg = (const GAS bfr*)(ws + WS_R + R_QG); const GAS bfr* KDg = (const GAS bfr*)(ws + WS_R + R_KD);
    const GAS bfr* QKg = (const GAS bfr*)(ws + WS_R + R_QK); GAS bfr* Og = (GAS bfr*)(ws + (MODE ? WS_SC : WS_R + R_O)); const GAS float* EGg = (const GAS float*)(ws + WS_EG);
    const int tid = C.tid, lane = C.lane, wave = C.wave, r = lane & 15, q = lane >> 4;
    LAS float* sEG = (LAS float*)(C.lds + 2 * S2_BUF);
    for (int task = C.vcu; task < NB * GH * 4; task += C.G) {
        const int bh = task >> 2, es = task & 3, h = bh & 31, b = bh >> 5;
        if (tid < 64) sEG[tid] = EGg[bh * 64 + tid];
        if (wave >= 2) {
            const int lw = __builtin_amdgcn_readfirstlane((tid - 128) & ~63);
            __builtin_assume(lw >= 0 && lw <= 320);
            const GAS unsigned char* RB = (const GAS unsigned char*)(ws + WS_R);
            const unsigned l16 = lane * 16, lU = (lane >> 2) * 256 + (lane & 3) * 16 + es * 64;
            const unsigned lrow = (lane >> 4) * 272 + (lane & 15) * 16, lqk = (lane >> 3) * 144 + (lane & 7) * 16, lkt = (lane & 15) * 8 * 144 + (lane >> 4) * 2;
            const int lsw = (lane & 15) >> 1;
            u4v ra[10], rb[10];
#define S2_LOAD(R, n) do { const unsigned ua_ = (unsigned)(bh * 64 + ((MODE == 2 || MODE == 4) ? 0 : (n))) * 16384u; _Pragma("unroll") for (int k_ = 0; k_ < 10; ++k_) { const int c0_ = lw + 384 * k_; \
        if (c0_ < 1024) R[k_] = *(const GAS u4v*)(RB + (size_t)((unsigned)R_W + ua_ + c0_ * 16) + l16); \
        else if (c0_ < 2048) R[k_] = *(const GAS u4v*)(RB + (size_t)((unsigned)R_QG + ua_ + (c0_ - 1024) * 16) + l16); \
        else if (c0_ < 2560) R[k_] = *(const GAS u4v*)(RB + (size_t)((unsigned)R_QK + (ua_ >> 1) + (c0_ - 2048) * 16) + l16); \
        else if (c0_ < 2816) R[k_] = *(const GAS u4v*)(RB + (size_t)((unsigned)R_U + ua_ + ((c0_ - 2560) >> 2) * 256) + lU); \
        else R[k_] = *(const GAS u4v*)(RB + (size_t)((unsigned)R_KD + ua_ + (c0_ - 2816) * 16) + l16); } } while (0)
#define S2_WRITE(R, bb) do { LAS unsigned char* B_ = C.lds + (bb) * S2_BUF; _Pragma("unroll") for (int k_ = 0; k_ < 10; ++k_) { const int c0_ = lw + 384 * k_; \
        if (c0_ < 1024) *(LAS u4v*)(B_ + (c0_ >> 4) * 272 + lrow) = R[k_]; \
        else if (c0_ < 2048) *(LAS u4v*)(B_ + S2_OFF_QG + ((c0_ - 1024) >> 4) * 272 + lrow) = R[k_]; \
        else if (c0_ < 2560) *(LAS u4v*)(B_ + S2_OFF_QK + ((c0_ - 2048) >> 3) * 144 + lqk) = R[k_]; \
        else if (c0_ < 2816) *(LAS u4v*)(B_ + S2_OFF_U + (c0_ - 2560) * 16 + l16) = R[k_]; \
        else { const int g_ = (c0_ - 2816) >> 6; LAS bfr* kt_ = (LAS bfr*)(B_ + S2_OFF_KT + lkt + ((g_ ^ lsw) << 3)); const unsigned w_[4] = {R[k_].x, R[k_].y, R[k_].z, R[k_].w}; \
            _Pragma("unroll") for (int i_ = 0; i_ < 8; ++i_) kt_[i_ * 72] = (bfr)((i_ & 1) ? (w_[i_ >> 1] >> 16) : (w_[i_ >> 1] & 0xffffu)); } } } while (0)
            u4v rc[10];
            S2_LOAD(ra, 0); S2_WRITE(ra, 0);
            S2_LOAD(rb, 1); S2_LOAD(rc, 2); S2_LOAD(ra, 3);
            __syncthreads();
#define S2_STEP(R, bb, n_) { S2_WRITE(R, bb); S2_LOAD(R, (n_) + 4); __syncthreads(); }
            for (int n = 0; n < NCH - 4; n += 6) {
                S2_STEP(rb, 1, n) S2_STEP(rc, 0, n + 1) S2_STEP(ra, 1, n + 2) S2_STEP(rb, 0, n + 3) S2_STEP(rc, 1, n + 4) S2_STEP(ra, 0, n + 5)
            }
            static_assert((NCH - 4) % 6 == 0, "scan loader schedule");
            S2_WRITE(rb, 1); __syncthreads(); S2_WRITE(rc, 0); __syncthreads(); S2_WRITE(ra, 1); __syncthreads(); __syncthreads();
#undef S2_STEP
#undef S2_LOAD
#undef S2_WRITE
        } else {
            const int nt = wave;
            f4v S[8];
#pragma unroll
            for (int w = 0; w < 8; ++w) S[w] = zero_acc();
            __syncthreads();
            for (int n = 0; n < NCH; ++n) {
                if (MODE == 3 || MODE == 4) { __syncthreads(); continue; }
                const LAS unsigned char* B = C.lds + (n & 1) * S2_BUF;
                const LAS bfr* sW = (const LAS bfr*)B; const LAS bfr* sQG = (const LAS bfr*)(B + S2_OFF_QG); const LAS bfr* sQK = (const LAS bfr*)(B + S2_OFF_QK);
                const LAS bfr* sKT = (const LAS bfr*)(B + S2_OFF_KT); const LAS bfr* sU = (const LAS bfr*)(B + S2_OFF_U);
#define S2_STAGE() asm volatile("" ::: "memory")
#define S2_LOADQ(F, mt) do { _Pragma("unroll") for (int ks = 0; ks < 4; ++ks) { F[ks] = s2_frag(sW + (16 * (mt) + r) * 136 + 32 * ks, q); F[4 + ks] = s2_frag(sQG + (16 * (mt) + r) * 136 + 32 * ks, q); } } while (0)
#define S2_MMQ(F, mt) do { _Pragma("unroll") for (int ks = 0; ks < 4; ++ks) { a1[mt] = __builtin_amdgcn_mfma_f32_16x16x32_bf16(F[ks], Bs[ks], a1[mt], 0, 0, 0); \
        a2[mt] = __builtin_amdgcn_mfma_f32_16x16x32_bf16(F[4 + ks], Bs[ks], a2[mt], 0, 0, 0); } } while (0)
                s8v fA[8], fB[8];
                S2_LOADQ(fA, 0); S2_LOADQ(fB, 1);
                s8v Bs[4];
#pragma unroll
                for (int ks = 0; ks < 4; ++ks) Bs[ks] = s2_pack(S[2 * ks], S[2 * ks + 1]);
                f4v a1[4], a2[4];
#pragma unroll
                for (int mt = 0; mt < 4; ++mt) { a1[mt] = zero_acc(); a2[mt] = zero_acc(); }
                S2_STAGE();
                S2_MMQ(fA, 0); S2_STAGE(); S2_LOADQ(fA, 2); S2_STAGE();
                S2_MMQ(fB, 1); S2_STAGE(); S2_LOADQ(fB, 3);
                bfr ur[16]; s8v fa[8];
#pragma unroll
                for (int mt = 0; mt < 4; ++mt) { const LAS bfr* pU = sU + (16 * mt + 4 * q) * 32 + 16 * nt + r; ur[4 * mt] = pU[0]; ur[4 * mt + 1] = pU[32]; ur[4 * mt + 2] = pU[64]; ur[4 * mt + 3] = pU[96]; }
                S2_STAGE();
                S2_MMQ(fA, 2); S2_STAGE();
#pragma unroll
                for (int mt = 0; mt < 4; ++mt)
#pragma unroll
                    for (int k2 = 0; k2 < 2; ++k2) fa[2 * mt + k2] = s2_frag(sQK + (16 * mt + r) * 72 + 32 * k2, q);
                S2_STAGE();
                S2_MMQ(fB, 3); S2_STAGE();
#undef S2_LOADQ
#undef S2_MMQ
                s8v fk[16];
#pragma unroll
                for (int w = 0; w < 8; ++w)
#pragma unroll
                    for (int k2 = 0; k2 < 2; ++k2) fk[2 * w + k2] = s2_fragx(sKT + (16 * w + r) * 72 + 32 * k2, q ^ w, (4 + q) ^ w);
                const float eg = sEG[n];
                S2_STAGE();
                f4v vn[4];
#pragma unroll
                for (int mt = 0; mt < 4; ++mt) vn[mt] = (f4v){bf1(ur[4 * mt]) - a1[mt][0], bf1(ur[4 * mt + 1]) - a1[mt][1], bf1(ur[4 * mt + 2]) - a1[mt][2], bf1(ur[4 * mt + 3]) - a1[mt][3]};
                s8v Bv[2];
#pragma unroll
                for (int k2 = 0; k2 < 2; ++k2) Bv[k2] = s2_pack(vn[2 * k2], vn[2 * k2 + 1]);
#pragma unroll
                for (int k2 = 0; k2 < 2; ++k2)
#pragma unroll
                    for (int mt = 0; mt < 4; ++mt) a2[mt] = __builtin_amdgcn_mfma_f32_16x16x32_bf16(fa[2 * mt + k2], Bv[k2], a2[mt], 0, 0, 0);
#pragma unroll
                for (int w = 0; w < 8; ++w) S[w] *= eg;
#pragma unroll
                for (int k2 = 0; k2 < 2; ++k2)
#pragma unroll
                    for (int w = 0; w < 8; ++w) S[w] = __builtin_amdgcn_mfma_f32_16x16x32_bf16(fk[2 * w + k2], Bv[k2], S[w], 0, 0, 0);
#pragma unroll
                for (int mt = 0; mt < 4; ++mt) {
                    GAS bfr* po = Og + (size_t)(b * SEQ + n * CH + 16 * mt + 4 * q) * DM + h * 128 + es * 32 + 16 * nt + r;
                    po[0] = f2bf1(a2[mt][0]); po[DM] = f2bf1(a2[mt][1]); po[2 * DM] = f2bf1(a2[mt][2]); po[3 * DM] = f2bf1(a2[mt][3]); }
#undef S2_STAGE
                MFMA_SETTLE(S[7]);
                __syncthreads();
            }
        }
        __syncthreads();
    }
}
#undef S2_OFF_QG
#undef S2_OFF_QK
#undef S2_OFF_KT
#undef S2_OFF_U
#undef S2_BUF

__device__ __forceinline__ void p_gdn_onorm(const Ctx& C, const Ptrs& P) {
    unsigned char* ws = P.ws_(); const bfr* Og = (const bfr*)(ws + WS_R + R_O); const bfr* PROJ = (const bfr*)(ws + WS_BIG); bfr* AO = (bfr*)(ws + WS_XN); const float* og = P.in_(6);
    const size_t gt = (size_t)C.vcu * 512 + C.tid, GT = (size_t)C.G * 512;
    for (size_t idx0 = gt; idx0 < (size_t)NT * DM / 8; idx0 += 4 * GT) {
        u4v o8[4], z8[4];
#pragma unroll
        for (int b4 = 0; b4 < 4; ++b4) { const size_t idx = idx0 + b4 * GT; const size_t t = idx >> 9; const int hh = (int)(idx >> 4) & 31, i = (int)idx & 15;
            o8[b4] = *(const u4v*)(Og + t * DM + hh * 128 + 8 * i); z8[b4] = *(const u4v*)(PROJ + t * 16384 + 12288 + hh * 128 + 8 * i); }
        const int i = (int)idx0 & 15;
        const f4v g0 = *(const f4v*)(og + 8 * i), g1 = *(const f4v*)(og + 8 * i + 4); const float g[8] = {g0[0], g0[1], g0[2], g0[3], g1[0], g1[1], g1[2], g1[3]};
#pragma unroll
        for (int b4 = 0; b4 < 4; ++b4) { const size_t idx = idx0 + b4 * GT; const size_t t = idx >> 9; const int hh = (int)(idx >> 4) & 31;
            float o[8] = {bflo(o8[b4].x), bfhi(o8[b4].x), bflo(o8[b4].y), bfhi(o8[b4].y), bflo(o8[b4].z), bfhi(o8[b4].z), bflo(o8[b4].w), bfhi(o8[b4].w)};
            float z[8] = {bflo(z8[b4].x), bfhi(z8[b4].x), bflo(z8[b4].y), bfhi(z8[b4].y), bflo(z8[b4].z), bfhi(z8[b4].z), bflo(z8[b4].w), bfhi(z8[b4].w)};
            float ss = 0.f;
#pragma unroll
            for (int k = 0; k < 8; ++k) ss += o[k] * o[k];
            ss += __shfl_xor(ss, 1); ss += __shfl_xor(ss, 2); ss += __shfl_xor(ss, 4); ss += __shfl_xor(ss, 8);
            const float rn = __builtin_amdgcn_rsqf(ss * (1.f / 128.f) + EPS);
            float y[8];
#pragma unroll
            for (int k = 0; k < 8; ++k) y[k] = o[k] * rn * g[k] * (z[k] * __builtin_amdgcn_rcpf(1.f + __expf(-z[k])));
#if F8_OUT0
#pragma unroll
            for (int k = 0; k < 8; ++k) y[k] = fminf(fmaxf(y[k] * SO, -440.f), 440.f);
            u2v w; w.x = cvt4_fp8(y[0], y[1], y[2], y[3]); w.y = cvt4_fp8(y[4], y[5], y[6], y[7]);
            *(u2v*)(ws + WS_XN8 + t * DM + hh * 128 + 8 * i) = w; }
#else
            u4v w; w.x = cvtpk(y[0], y[1]); w.y = cvtpk(y[2], y[3]); w.z = cvtpk(y[4], y[5]); w.w = cvtpk(y[6], y[7]);
            *(u4v*)(AO + t * DM + hh * 128 + 8 * i) = w; }
#endif
    }
}
__device__ __forceinline__ unsigned mono_key(float x) { const unsigned u = __float_as_uint(x); return u ^ ((unsigned)((int)u >> 31) | 0x80000000u); }
#define KEY_INS(K, key) do { unsigned x_ = (key); _Pragma("unroll") for (int s_ = 0; s_ < 16; ++s_) { const unsigned hi_ = max(K[s_], x_); x_ = min(K[s_], x_); K[s_] = hi_; } } while (0)
__device__ __forceinline__ void p_route(const Ctx& C, const Ptrs& P) {
    unsigned char* ws = P.ws_(); const float* SC = (const float*)(ws + WS_SC); bfr* G = (bfr*)(ws + WS_G);
    LAS unsigned char* wl = C.lds + C.wave * 16384;
    LAS int* sE = (LAS int*)(wl); LAS float* sGt = (LAS float*)(wl + 2048); LAS float* sV1 = (LAS float*)(wl + 4096); LAS float* sV2 = (LAS float*)(wl + 8192); LAS int* sI = (LAS int*)(wl + 12288);
    const int lane = C.lane, gw = C.vcu * 8 + C.wave, NGW = C.G * 8;
    for (int wt = gw; wt < NT / 4; wt += NGW) {
        const int tl = lane >> 4, t = wt * 4 + tl;
        unsigned k1[16];
#pragma unroll
        for (int i = 0; i < 16; ++i) k1[i] = 0u;
        const float* base = SC + (size_t)t * PQ + (lane & 15) * 128;
        for (int e = 0; e < 128; e += 4) { const f4v x4 = *(const f4v*)(base + e);
            KEY_INS(k1, (mono_key(x4[0]) & ~127u) | (unsigned)(127 - e)); KEY_INS(k1, (mono_key(x4[1]) & ~127u) | (unsigned)(126 - e));
            KEY_INS(k1, (mono_key(x4[2]) & ~127u) | (unsigned)(125 - e)); KEY_INS(k1, (mono_key(x4[3]) & ~127u) | (unsigned)(124 - e)); }
        const bool h0 = (lane & 1) == 0;
        float v1[16], v2[16];
#pragma unroll
        for (int i = 0; i < 16; ++i) { const int id = 127 - (int)(k1[i] & 127u); const float vv = base[id];
            const float ov = __shfl_xor(vv, 1); const int oi = __shfl_xor(id, 1);
            v1[i] = h0 ? vv : ov; v2[i] = h0 ? ov : vv; const int ia = h0 ? id : oi, ib = h0 ? oi : id;
            sV1[i * 64 + lane] = v1[i]; sV2[i * 64 + lane] = v2[i]; sI[i * 64 + lane] = ia | (ib << 8); }
        unsigned k2[16];
#pragma unroll
        for (int i = 0; i < 16; ++i) k2[i] = 0u;
#pragma unroll
        for (int a = 0; a < 16; ++a)
#pragma unroll
            for (int b = 0; b < 16; ++b)
                if ((a + 1) * (b + 1) <= 16) KEY_INS(k2, (mono_key(v1[a] + v2[b]) & ~255u) | (unsigned)(255 - (a * 16 + b)));
        LDS_WAIT(); asm volatile("" ::: "memory");
        float ts[16]; int te[16]; float mx = -__builtin_inff();
#pragma unroll
        for (int i = 0; i < 16; ++i) { const int code = 255 - (int)(k2[i] & 255u), a = code >> 4, b = code & 15;
            ts[i] = sV1[a * 64 + lane] + sV2[b * 64 + lane]; te[i] = (sI[a * 64 + lane] & 0xff) * 128 + (sI[b * 64 + lane] >> 8); mx = fmaxf(mx, ts[i]); }
        float sum = 0.f;
#pragma unroll
        for (int i = 0; i < 16; ++i) { ts[i] = __expf(ts[i] - mx); sum += ts[i]; }
        const float inv = 1.f / sum;
        if (h0) { const int hb = ((lane >> 1) & 7) * 16;
#pragma unroll
            for (int i = 0; i < 16; ++i) { sE[tl * 128 + hb + i] = te[i]; sGt[tl * 128 + hb + i] = ts[i] * inv; } }
        LDS_WAIT(); asm volatile("" ::: "memory");
        for (int k = 0; k < 4; ++k) {
            const size_t tt = (size_t)wt * 4 + k; u4v* row = (u4v*)(G + tt * PE); const u4v z = {0u, 0u, 0u, 0u};
#pragma unroll 8
            for (int j = 0; j < 32; ++j) row[j * 64 + lane] = z;
            const int e0 = sE[k * 128 + lane], e1 = sE[k * 128 + 64 + lane]; float t0 = 0.f, t1 = 0.f; bool f0 = true, f1 = true;
            for (int j = 0; j < 128; j += 4) { const i4v ej = *(const LAS i4v*)(sE + k * 128 + j); const f4v gj = *(const LAS f4v*)(sGt + k * 128 + j);
                if (ej.x == e0) { t0 += gj[0]; if (j + 0 < lane) f0 = false; } if (ej.y == e0) { t0 += gj[1]; if (j + 1 < lane) f0 = false; }
                if (ej.z == e0) { t0 += gj[2]; if (j + 2 < lane) f0 = false; } if (ej.w == e0) { t0 += gj[3]; if (j + 3 < lane) f0 = false; }
                if (ej.x == e1) { t1 += gj[0]; if (j + 0 < lane + 64) f1 = false; } if (ej.y == e1) { t1 += gj[1]; if (j + 1 < lane + 64) f1 = false; }
                if (ej.z == e1) { t1 += gj[2]; if (j + 2 < lane + 64) f1 = false; } if (ej.w == e1) { t1 += gj[3]; if (j + 3 < lane + 64) f1 = false; } }
            VM_WAIT();
            if (f0) G[tt * PE + e0] = f2bf1(t0);
            if (f1) G[tt * PE + e1] = f2bf1(t1);
        }
        LDS_WAIT(); asm volatile("" ::: "memory");
    }
}

typedef _Float16 h2v __attribute__((ext_vector_type(2)));
__device__ __forceinline__ unsigned char gate_code(float g) { const float c = 195.f + 20.f * __log2f(g); return (unsigned char)(int)fminf(fmaxf(c + 0.5f, 1.f), 255.f); }
__device__ __forceinline__ void p_sroute(const Ctx& C, const Ptrs& P, int layer) {
    unsigned char* ws = P.ws_(); const bfr* QRY = (const bfr*)(ws + WS_QRY); const bfr* KEY = (const bfr*)(ws + WS_WTKEY) + (size_t)layer * PQ * PQ; unsigned char* G = ws + WS_G;
    const int lane = C.lane, wave = C.wave, r = lane & 15, q = lane >> 4;
    LAS unsigned char* wl = C.lds + wave * 16640;
    LAS _Float16* sS = (LAS _Float16*)wl;
    LAS float* sV1 = (LAS float*)(wl); LAS float* sV2 = (LAS float*)(wl + 4096); LAS int* sI = (LAS int*)(wl + 8192);
    LAS int* sE = (LAS int*)(C.lds); LAS float* sGt = (LAS float*)(C.lds + 16384);
    LAS unsigned* bm = (LAS unsigned*)(C.lds + 32768 + wave * 3200); LAS unsigned* cnt = bm + 512; LAS int* le = (LAS int*)(bm + 516); LAS float* lg = (LAS float*)(bm + 516 + 128);
    for (int blk = C.vcu; blk < NT / 32; blk += C.G) {
        const int t0 = blk * 32;
#pragma unroll
        for (int hf = 0; hf < 2; ++hf) {
            const int hh = wave * 2 + hf;
            s8v a[2][4];
#pragma unroll
            for (int mt = 0; mt < 2; ++mt)
#pragma unroll
                for (int ks = 0; ks < 4; ++ks) a[mt][ks] = *(const s8v*)(QRY + (size_t)(t0 + 16 * mt + r) * PQ + hh * 128 + 32 * ks + 8 * q);
#pragma unroll
            for (int nt = 0; nt < 8; ++nt) {
                s8v b[4];
#pragma unroll
                for (int ks = 0; ks < 4; ++ks) b[ks] = *(const s8v*)(KEY + (size_t)(hh * 128 + 16 * nt + r) * PQ + hh * 128 + 32 * ks + 8 * q);
                f4v c0 = zero_acc(), c1 = zero_acc();
#pragma unroll
                for (int ks = 0; ks < 4; ++ks) { c0 = __builtin_amdgcn_mfma_f32_16x16x32_bf16(a[0][ks], b[ks], c0, 0, 0, 0); c1 = __builtin_amdgcn_mfma_f32_16x16x32_bf16(a[1][ks], b[ks], c1, 0, 0, 0); MFMA_SETTLE(c0); MFMA_SETTLE(c1); }
                MFMA_SETTLE(c0); MFMA_SETTLE(c1);
#pragma unroll
                for (int e = 0; e < 4; ++e) { sS[(32 * hf + 4 * q + e) * 130 + 16 * nt + r] = (_Float16)c0[e]; sS[(32 * hf + 16 + 4 * q + e) * 130 + 16 * nt + r] = (_Float16)c1[e]; }
            }
        }
        LDS_WAIT(); asm volatile("" ::: "memory");
        unsigned k1[16];
#pragma unroll
        for (int i = 0; i < 16; ++i) k1[i] = 0u;
        const LAS h2v* lp = (const LAS h2v*)(sS + lane * 130);
        for (int e = 0; e < 128; e += 8) {
#pragma unroll
            for (int u = 0; u < 4; ++u) { const h2v x2 = lp[(e >> 1) + u];
                KEY_INS(k1, (mono_key((float)x2[0]) & ~127u) | (unsigned)(127 - e - 2 * u)); KEY_INS(k1, (mono_key((float)x2[1]) & ~127u) | (unsigned)(126 - e - 2 * u)); }
        }
        const bool h0 = lane < 32;
        float v1[16], v2[16]; int ids[16]; float vals[16];
#pragma unroll
        for (int i = 0; i < 16; ++i) { ids[i] = 127 - (int)(k1[i] & 127u); vals[i] = (float)sS[lane * 130 + ids[i]]; }
        LDS_WAIT(); asm volatile("" ::: "memory");
#pragma unroll
        for (int i = 0; i < 16; ++i) { const float ov = __shfl_xor(vals[i], 32); const int oi = __shfl_xor(ids[i], 32);
            v1[i] = h0 ? vals[i] : ov; v2[i] = h0 ? ov : vals[i]; const int ia = h0 ? ids[i] : oi, ib = h0 ? oi : ids[i];
            sV1[i * 64 + lane] = v1[i]; sV2[i * 64 + lane] = v2[i]; sI[i * 64 + lane] = ia | (ib << 8); }
        unsigned k2[16];
#pragma unroll
        for (int b = 0; b < 16; ++b) k2[b] = (mono_key(v1[0] + v2[b]) & ~255u) | (unsigned)(255 - b);
#pragma unroll
        for (int a = 1; a < 16; ++a)
#pragma unroll
            for (int b = 0; b < 16; ++b)
                if ((a + 1) * (b + 1) <= 16) KEY_INS(k2, (mono_key(v1[a] + v2[b]) & ~255u) | (unsigned)(255 - (a * 16 + b)));
        LDS_WAIT(); asm volatile("" ::: "memory");
        float ts[16]; int te[16]; float mx = -__builtin_inff();
#pragma unroll
        for (int i = 0; i < 16; ++i) { const int code = 255 - (int)(k2[i] & 255u), a = code >> 4, b = code & 15;
            ts[i] = sV1[a * 64 + lane] + sV2[b * 64 + lane]; te[i] = (sI[a * 64 + lane] & 0xff) * 128 + (sI[b * 64 + lane] >> 8); mx = fmaxf(mx, ts[i]); }
        float sum = 0.f;
#pragma unroll
        for (int i = 0; i < 16; ++i) { ts[i] = __expf(ts[i] - mx); sum += ts[i]; }
        const float inv = 1.f / sum;
        __syncthreads();
        if (h0) {
#pragma unroll
            for (int i = 0; i < 16; ++i) { sE[lane * 128 + wave * 16 + i] = te[i]; sGt[lane * 128 + wave * 16 + i] = ts[i] * inv; } }
        __syncthreads();
        for (int k = 0; k < 4; ++k) {
            const int tl = wave * 4 + k; const size_t tt = (size_t)t0 + tl;
            if (layer == 0) { u4v* row = (u4v*)(G + tt * PE); const u4v z = {0u, 0u, 0u, 0u};
#pragma unroll 8
                for (int j = 0; j < 16; ++j) row[j * 64 + lane] = z; }
            const int e0 = sE[tl * 128 + lane], e1 = sE[tl * 128 + 64 + lane]; float t0s = sGt[tl * 128 + lane], t1s = sGt[tl * 128 + 64 + lane];
#pragma unroll
            for (int j = 0; j < 8; ++j) bm[j * 64 + lane] = 0u;
            if (lane == 0) *cnt = 0u;
            LDS_WAIT(); asm volatile("" ::: "memory");
            const unsigned b0 = 1u << (e0 & 31), b1 = 1u << (e1 & 31);
            const bool d0 = (__hip_atomic_fetch_or(bm + (e0 >> 5), b0, __ATOMIC_RELAXED, __HIP_MEMORY_SCOPE_WORKGROUP) & b0) != 0u;
            const bool d1 = (__hip_atomic_fetch_or(bm + (e1 >> 5), b1, __ATOMIC_RELAXED, __HIP_MEMORY_SCOPE_WORKGROUP) & b1) != 0u;
            if (d0) { const unsigned sl = __hip_atomic_fetch_add(cnt, 1u, __ATOMIC_RELAXED, __HIP_MEMORY_SCOPE_WORKGROUP); le[sl] = e0; lg[sl] = t0s; }
            if (d1) { const unsigned sl = __hip_atomic_fetch_add(cnt, 1u, __ATOMIC_RELAXED, __HIP_MEMORY_SCOPE_WORKGROUP); le[sl] = e1; lg[sl] = t1s; }
            LDS_WAIT(); asm volatile("" ::: "memory");
            const int nd = (int)__builtin_amdgcn_readfirstlane((int)*cnt);
            for (int j = 0; j < nd; ++j) { const int ej = le[j]; const float gj = lg[j]; if (ej == e0 && !d0) t0s += gj; if (ej == e1 && !d1) t1s += gj; }
            const bool f0 = !d0, f1 = !d1;
            VM_WAIT();
            if (f0) G[tt * PE + e0] = gate_code(t0s);
            if (f1) G[tt * PE + e1] = gate_code(t1s);
        }
        __syncthreads();
    }
}

constexpr int KIND_V = F8_KVQ ? 2 : 1;
__device__ __forceinline__ void p_headprep(const Ctx& C, const Ptrs& P) {
    unsigned char* ws = P.ws_(); const bfr* KVQ = (const bfr*)(ws + WS_BIG); bfr* Qh = (bfr*)(ws + WS_R + R_QH); bfr* Kh = (bfr*)(ws + WS_R + R_KH); bfr* Vh = (bfr*)(ws + WS_R + R_VH);
    const float* kg = P.in_(10); const float* qg = P.in_(13);
    const size_t gt = (size_t)C.vcu * 512 + C.tid, GT = (size_t)C.G * 512;
    constexpr int NV16 = F8_KVQ ? 1024 : 1536;
    for (size_t idx0 = gt; idx0 < (size_t)NT * NV16; idx0 += 4 * GT) {
        u4v x8[4];
#pragma unroll
        for (int b4 = 0; b4 < 4; ++b4) { const size_t idx = idx0 + b4 * GT; const size_t t = idx / NV16; const int rem = (int)(idx - t * NV16), vec = rem >> 4, i = rem & 15;
            x8[b4] = *(const u4v*)(KVQ + t * 12288 + vec * 128 + 8 * i); }
#pragma unroll
        for (int b4 = 0; b4 < 4; ++b4) { const size_t idx = idx0 + b4 * GT; const size_t t = idx / NV16; const int rem = (int)(idx - t * NV16), vec = rem >> 4, i = rem & 15, kind = vec >> 5, sh = vec & 31;
            float x[8] = {bflo(x8[b4].x), bfhi(x8[b4].x), bflo(x8[b4].y), bfhi(x8[b4].y), bflo(x8[b4].z), bfhi(x8[b4].z), bflo(x8[b4].w), bfhi(x8[b4].w)};
            float ss = 0.f;
#pragma unroll
            for (int k = 0; k < 8; ++k) ss += x[k] * x[k];
            ss += __shfl_xor(ss, 1); ss += __shfl_xor(ss, 2); ss += __shfl_xor(ss, 4); ss += __shfl_xor(ss, 8);
            u4v w = x8[b4];
            if (kind != KIND_V) { const float rn = __builtin_amdgcn_rsqf(ss * (1.f / 128.f) + EPS); const float* gp = (kind == 0 ? kg : qg) + 8 * i; const f4v g0 = *(const f4v*)gp, g1 = *(const f4v*)(gp + 4);
                w.x = cvtpk(x[0] * rn * g0[0], x[1] * rn * g0[1]); w.y = cvtpk(x[2] * rn * g0[2], x[3] * rn * g0[3]); w.z = cvtpk(x[4] * rn * g1[0], x[5] * rn * g1[1]); w.w = cvtpk(x[6] * rn * g1[2], x[7] * rn * g1[3]); }
            const size_t b = t >> 12, s = t & 4095; bfr* dst = (kind == 0 ? Kh : (kind == KIND_V ? Vh : Qh)) + ((b * 32 + sh) * SEQ + s) * 128 + 8 * i;
            *(u4v*)dst = w; }
    }
}

__device__ __forceinline__ att::BlockRef<att::bf16, att::bf16> attn_ref(const att::bf16* Qh, const att::bf16* Kh, const att::bf16* Vh, att::bf16* Oh, int bhp, int qb) {
    const int b = bhp >> 6, hd = (bhp >> 2) & 15, c = (bhp >> 1) & 1, vh = bhp & 1;
    att::BlockRef<att::bf16, att::bf16> r;
    r.Q = Qh + ((size_t)(b * 32 + hd * 2 + c) * SEQ + (size_t)qb * 256) * 128; r.K = Kh + (size_t)(b * 32 + hd * 2 + c) * SEQ * 128; r.V = att::VSTR == 128 ? Vh + (size_t)(b * 32 + hd * 2 + vh) * SEQ * 128 : Vh + (size_t)b * SEQ * att::VSTR + 8192 + (hd * 2 + vh) * 128;
    r.O = Oh + ((size_t)bhp * SEQ + (size_t)qb * 256) * 128; r.P0 = qb * 256;
    return r;
}
__device__ __forceinline__ void p_attn(const Ctx& C, const Ptrs& P) {
    unsigned char* ws = P.ws_(); const att::bf16* Qh = (const att::bf16*)(ws + WS_R + R_QH); const att::bf16* Kh = (const att::bf16*)(ws + WS_R + R_KH); const att::bf16* Vh = (const att::bf16*)(att::VSTR == 128 ? ws + WS_R + R_VH : ws + WS_BIG);
    att::bf16* Oh = (att::bf16*)(ws + WS_R + R_OH);
    extern __shared__ __attribute__((aligned(16))) char lds_sym[]; char* lds = lds_sym;
    constexpr int total = 128 * 8;
    int L = C.vcu; if (L >= total) return;
    int pass = 0;
    att::BlockRef<att::bf16, att::bf16> cur = attn_ref(Qh, Kh, Vh, Oh, L >> 3, L & 7);
    att::Seam<att::bf16> S;
    att::causal_swa_prime<att::bf16, att::bf16>(cur, SEQ, lds, S);
    for (;;) {
        const bool more_pass = pass == 0, more_item = L + C.G < total, last = !more_pass && !more_item;
        int passn = pass + 1, Ln = L;
        if (!more_pass) { passn = 0; Ln = more_item ? L + C.G : L; }
        const att::BlockRef<att::bf16, att::bf16> nxt = last ? cur : attn_ref(Qh, Kh, Vh, Oh, Ln >> 3, passn ? 15 - (Ln & 7) : (Ln & 7));
        att::causal_swa_block<att::bf16, att::bf16>(cur, nxt, SEQ, SEQ, lds, S);
        if (last) break;
        cur = nxt; pass = passn; L = Ln;
    }
    __syncthreads();
}

__device__ __forceinline__ void p_combine(const Ctx& C, const Ptrs& P) {
    unsigned char* ws = P.ws_(); const bfr* Oh = (const bfr*)(ws + WS_R + R_OH); bfr* AO = (bfr*)(ws + WS_XN); const float* sg = P.in_(18);
    float lam;
    { const float* q1 = P.in_(14); const float* k1 = P.in_(15); const float* q2 = P.in_(16); const float* k2 = P.in_(17); const int l = C.lane;
      const float d1 = wave_sum(q1[l] * k1[l] + q1[l + 64] * k1[l + 64]), d2 = wave_sum(q2[l] * k2[l] + q2[l + 64] * k2[l + 64]);
      lam = expf(d1) - expf(d2) + LAMBDA_INIT; }
    const size_t gt = (size_t)C.vcu * 512 + C.tid, GT = (size_t)C.G * 512;
    for (size_t idx0 = gt; idx0 < (size_t)NT * 512; idx0 += 4 * GT) {
        u4v a8[4], b8[4];
#pragma unroll
        for (int b4 = 0; b4 < 4; ++b4) { const size_t idx = idx0 + b4 * GT; const size_t t = idx >> 9, b = t >> 12, s = t & 4095; const int hd = (int)(idx >> 5) & 15, i = (int)idx & 31, vh = i >> 4, d = (8 * i) & 127;
            const size_t o0i = ((((b * 16 + hd) * 2 + 0) * 2 + vh) * SEQ + s) * 128 + d, o1i = ((((b * 16 + hd) * 2 + 1) * 2 + vh) * SEQ + s) * 128 + d;
            a8[b4] = *(const u4v*)(Oh + o0i); b8[b4] = *(const u4v*)(Oh + o1i); }
        const int i = (int)idx0 & 31;
        const f4v g0 = *(const f4v*)(sg + 8 * i), g1 = *(const f4v*)(sg + 8 * i + 4);
#pragma unroll
        for (int b4 = 0; b4 < 4; ++b4) { const size_t idx = idx0 + b4 * GT; const size_t t = idx >> 9; const int hd = (int)(idx >> 5) & 15;
            float o[8] = {bflo(a8[b4].x) - lam * bflo(b8[b4].x), bfhi(a8[b4].x) - lam * bfhi(b8[b4].x), bflo(a8[b4].y) - lam * bflo(b8[b4].y), bfhi(a8[b4].y) - lam * bfhi(b8[b4].y),
                          bflo(a8[b4].z) - lam * bflo(b8[b4].z), bfhi(a8[b4].z) - lam * bfhi(b8[b4].z), bflo(a8[b4].w) - lam * bflo(b8[b4].w), bfhi(a8[b4].w) - lam * bfhi(b8[b4].w)};
            float ss = 0.f;
#pragma unroll
            for (int k = 0; k < 8; ++k) ss += o[k] * o[k];
            ss += __shfl_xor(ss, 1); ss += __shfl_xor(ss, 2); ss += __shfl_xor(ss, 4); ss += __shfl_xor(ss, 8); ss += __shfl_xor(ss, 16);
            const float rn = __builtin_amdgcn_rsqf(ss * (1.f / 256.f) + EPS) * (1.f - LAMBDA_INIT);
#if F8_OUT1
            const float rs = rn * SO; float y[8] = {o[0] * rs * g0[0], o[1] * rs * g0[1], o[2] * rs * g0[2], o[3] * rs * g0[3], o[4] * rs * g1[0], o[5] * rs * g1[1], o[6] * rs * g1[2], o[7] * rs * g1[3]};
#pragma unroll
            for (int k = 0; k < 8; ++k) y[k] = fminf(fmaxf(y[k], -440.f), 440.f);
            u2v w; w.x = cvt4_fp8(y[0], y[1], y[2], y[3]); w.y = cvt4_fp8(y[4], y[5], y[6], y[7]);
            *(u2v*)(ws + WS_XN8 + t * DM + hd * 256 + 8 * i) = w; }
#else
            u4v w; w.x = cvtpk(o[0] * rn * g0[0], o[1] * rn * g0[1]); w.y = cvtpk(o[2] * rn * g0[2], o[3] * rn * g0[3]); w.z = cvtpk(o[4] * rn * g1[0], o[5] * rn * g1[1]); w.w = cvtpk(o[6] * rn * g1[2], o[7] * rn * g1[3]);
            *(u4v*)(AO + t * DM + hd * 256 + 8 * i) = w; }
#endif
    }
}
constexpr int NPH_LAYER = 13, NPHASE = 1 + 2 * NPH_LAYER;
#ifndef MK_PER_PHASE
#define MK_PER_PHASE 0
#endif

__global__ void __launch_bounds__(512, 2) trunk_fwd(KArgs KA) {
    extern __shared__ __attribute__((aligned(16))) unsigned char lds_raw[];
    Ctx C; C.lds = (LAS unsigned char*)lds_raw; C.tid = threadIdx.x; C.lane = C.tid & 63; C.wave = __builtin_amdgcn_readfirstlane(C.tid >> 6);
    C.G = gridDim.x; { const int bx = blockIdx.x; C.vcu = (C.G % 8 == 0) ? (bx % 8) * (C.G / 8) + bx / 8 : bx; }
    volatile LAS unsigned* MISC = (volatile LAS unsigned*)(C.lds + MISC_OFF);
    for (int u = C.tid; u < (LDS_BYTES - MISC_OFF) / 4; u += 512) MISC[u] = 0u;
    __syncthreads();
    Ptrs P; P.tbl = (LAS unsigned long long*)(C.lds + MISC_OFF + 128);
    if (C.tid < 28) P.tbl[C.tid] = ((const unsigned long long*)&KA)[C.tid];
    __syncthreads();
    unsigned* ctl = (unsigned*)(P.ws_() + WS_CTL);
    const int lo = KA.ph_lo, hi = KA.ph_hi;
    XcdBarrier bar; bar.bar = ctl + CW_BAR + KA.li * XCD_BAR_WORDS; bar.x = 0; bar.st = MISC + 8;
    if (hi - lo > 1) bar = xcd_barrier_post(ctl + CW_BAR + KA.li * XCD_BAR_WORDS, MISC + 8);
#define IN(k) (lo <= (k) && (k) < hi)
#define SEAM(k) do { if (IN(k) && IN((k) + 1)) xcd_barrier(bar); } while (0)
    unsigned char* ws = P.ws_();
    bfr* XN = (bfr*)(ws + WS_XN); bfr* BIG = (bfr*)(ws + WS_BIG);
    const int hb = (int)blockIdx.x;

    if (IN(0)) { p_convert(C, P, 0, C.vcu, C.G); __syncthreads();
#if NPREP >= 32
        p_convert(C, P, 1, C.vcu, C.G); __syncthreads();
#endif
        p_norm_rows(C, P.in_(0), XN, F8_PROJ0 != 0 ? ws + WS_XN8 : nullptr); }
    SEAM(0);
    {
        constexpr int layer = 0;
        const int pb = 1 + layer * NPH_LAYER;
        if (layer == 1 && IN(pb + 0)) p_norm_rows<true>(C, ws + WS_SC, F8_KVQ == 2 ? nullptr : XN, F8_KVQ != 0 ? ws + WS_XN8 : nullptr);
        if (layer == 1) SEAM(pb + 0);
        if (IN(pb + 1)) {
            const int N = layer == 0 ? 16384 : 12288;
            if (layer == 0 && F8_PROJ0 == 2) {
                { pg8::Gemm g{XN, (const bfr*)(ws + WS_WTIN), NT, 8192, DM}; pg8::StaticOrder S; S.init(NT, 8192, C.G, hb);
                  pg8::EpiBf16<0> E{BIG, N, nullptr, 0, 0, 1.f};
                  pg8::gemm_phase<pg8::EpiBf16<0>, pg8::StaticOrder, true, true>((PG8_LAS unsigned char*)C.lds, g, S, E); }
                __syncthreads();
                { pg8::Gemm g{(const bfr*)(ws + WS_XN8), (const bfr*)(ws + WS_WTIN + (size_t)8192 * DM * 2), NT, 8192, DM / 2}; pg8::StaticOrder S; S.init(NT, 8192, C.G, hb);
                  pg8::EpiBf16<0> E{BIG + 8192, N, nullptr, 8192, 0, 1.f / SU};
                  pg8::gemm_phase<pg8::EpiBf16<0>, pg8::StaticOrder, true, true, true>((PG8_LAS unsigned char*)C.lds, g, S, E); }
            } else if (layer == 0 && F8_PROJ0 == 5) {
                { pg8::Gemm g{(const bfr*)(ws + WS_XN8), (const bfr*)(ws + WS_WTIN), NT, 8192, DM / 2}; pg8::StaticOrder S; S.init(NT, 8192, C.G, hb);
                  pg8::EpiBf16<0> E{BIG, N, nullptr, 8192, 0, 1.f / SU};
                  pg8::gemm_phase<pg8::EpiBf16<0>, pg8::StaticOrder, true, true, true>((PG8_LAS unsigned char*)C.lds, g, S, E); }
                __syncthreads();
                { pg8::Gemm g{XN, (const bfr*)(ws + WS_WTIN + (size_t)32 * MiB), NT, 4096, DM}; pg8::StaticOrder S; S.init(NT, 4096, C.G, hb);
                  pg8::EpiBf16<0> E{BIG + 8192, N, nullptr, 0, 0, 1.f};
                  pg8::gemm_phase<pg8::EpiBf16<0>, pg8::StaticOrder, true, true>((PG8_LAS unsigned char*)C.lds, g, S, E); }
                __syncthreads();
                { pg8::Gemm g{(const bfr*)(ws + WS_XN8), (const bfr*)(ws + WS_WTIN + (size_t)64 * MiB), NT, 4096, DM / 2}; pg8::StaticOrder S; S.init(NT, 4096, C.G, hb);
                  pg8::EpiBf16<0> E{BIG + 12288, N, nullptr, 4096, 0, 1.f / SU};
                  pg8::gemm_phase<pg8::EpiBf16<0>, pg8::StaticOrder, true, true, true>((PG8_LAS unsigned char*)C.lds, g, S, E); }
            } else if (layer == 0 && F8_PROJ0 == 6) {
                { pg8::Gemm g{(const bfr*)(ws + WS_XN8), (const bfr*)(ws + WS_WTIN), NT, 12288, DM / 2}; pg8::StaticOrder S; S.init(NT, 12288, C.G, hb);
                  pg8::EpiBf16<0> E{BIG, N, nullptr, 12288, 0, 1.f / SU};
                  pg8::gemm_phase<pg8::EpiBf16<0>, pg8::StaticOrder, true, true, true>((PG8_LAS unsigned char*)C.lds, g, S, E); }
                __syncthreads();
                { pg8::Gemm g{XN, (const bfr*)(ws + WS_WTIN + (size_t)48 * MiB), NT, 4096, DM}; pg8::StaticOrder S; S.init(NT, 4096, C.G, hb);
                  pg8::EpiBf16<0> E{BIG + 12288, N, nullptr, 0, 0, 1.f};
                  pg8::gemm_phase<pg8::EpiBf16<0>, pg8::StaticOrder, true, true>((PG8_LAS unsigned char*)C.lds, g, S, E); }
            } else if (layer == 0 && F8_PROJ0 == 4) {
                { pg8::Gemm g{(const bfr*)(ws + WS_XN8), (const bfr*)(ws + WS_WTIN), NT, 4096, DM / 2}; pg8::StaticOrder S; S.init(NT, 4096, C.G, hb);
                  pg8::EpiBf16<0> E{BIG, N, nullptr, 4096, 0, 1.f / SU};
                  pg8::gemm_phase<pg8::EpiBf16<0>, pg8::StaticOrder, true, true, true>((PG8_LAS unsigned char*)C.lds, g, S, E); }
                __syncthreads();
                { pg8::Gemm g{XN, (const bfr*)(ws + WS_WTIN + (size_t)4096 * DM), NT, 12288, DM}; pg8::StaticOrder S; S.init(NT, 12288, C.G, hb);
                  pg8::EpiBf16<0> E{BIG + 4096, N, nullptr, 0, 0, 1.f};
                  pg8::gemm_phase<pg8::EpiBf16<0>, pg8::StaticOrder, true, true>((PG8_LAS unsigned char*)C.lds, g, S, E); }
            } else if (layer == 0 && F8_PROJ0 == 3) {
                { pg8::Gemm g{(const bfr*)(ws + WS_XN8), (const bfr*)(ws + WS_WTIN), NT, 8192, DM / 2}; pg8::StaticOrder S; S.init(NT, 8192, C.G, hb);
                  pg8::EpiBf16<0> E{BIG, N, nullptr, 8192, 0, 1.f / SU};
                  pg8::gemm_phase<pg8::EpiBf16<0>, pg8::StaticOrder, true, true, true>((PG8_LAS unsigned char*)C.lds, g, S, E); }
                __syncthreads();
                { pg8::Gemm g{XN, (const bfr*)(ws + WS_WTIN + (size_t)8192 * DM), NT, 8192, DM}; pg8::StaticOrder S; S.init(NT, 8192, C.G, hb);
                  pg8::EpiBf16<0> E{BIG + 8192, N, nullptr, 0, 0, 1.f};
                  pg8::gemm_phase<pg8::EpiBf16<0>, pg8::StaticOrder, true, true>((PG8_LAS unsigned char*)C.lds, g, S, E); }
            } else if (layer == 0 && F8_PROJ0 == 1) {
                pg8::Gemm g{(const bfr*)(ws + WS_XN8), (const bfr*)(ws + WS_WTIN), NT, N, DM / 2}; pg8::StaticOrder S; S.init(NT, N, C.G, hb);
                pg8::EpiBf16<0> E{BIG, N, nullptr, N, 0, 1.f / SU};
                pg8::gemm_phase<pg8::EpiBf16<0>, pg8::StaticOrder, true, true, true>((PG8_LAS unsigned char*)C.lds, g, S, E);
            } else if (layer == 1 && F8_KVQ == 2) {
                pg8::Gemm g{(const bfr*)(ws + WS_XN8), (const bfr*)(ws + WS_WTKVQ), NT, N, DM / 2}; pg8::StaticOrder S; S.init(NT, N, C.G, hb);
                pg8::EpiHead E{(bfr*)(ws + WS_R + R_KH), (bfr*)(ws + WS_R + R_QH), (bfr*)(ws + WS_R + R_VH), P.in_(10), P.in_(13), 1.f / SU};
                pg8::gemm_phase<pg8::EpiHead, pg8::StaticOrder, true, true, true>((PG8_LAS unsigned char*)C.lds, g, S, E);
            } else if (layer == 1 && F8_KVQ) {
                { pg8::Gemm g{(const bfr*)(ws + WS_XN8), (const bfr*)(ws + WS_WTKVQ), NT, 8192, DM / 2}; pg8::StaticOrder S; S.init(NT, 8192, C.G, hb);
                  pg8::EpiBf16<0> E{BIG, N, nullptr, 8192, 0, 1.f / SU};
                  pg8::gemm_phase<pg8::EpiBf16<0>, pg8::StaticOrder, true, true, true>((PG8_LAS unsigned char*)C.lds, g, S, E); }
                __syncthreads();
                { pg8::Gemm g{XN, (const bfr*)(ws + WS_WTKVQ + (size_t)2 * DM * DM), NT, DM, DM}; pg8::StaticOrder S; S.init(NT, DM, C.G, hb);
                  pg8::EpiBf16<0> E{BIG + 8192, N, nullptr, 0, 0, 1.f};
                  pg8::gemm_phase<pg8::EpiBf16<0>, pg8::StaticOrder, true, true>((PG8_LAS unsigned char*)C.lds, g, S, E); }
            } else {
                pg8::Gemm g{XN, (const bfr*)(ws + (layer == 0 ? WS_WTIN : WS_WTKVQ)), NT, N, DM}; pg8::StaticOrder S; S.init(NT, N, C.G, hb);
                pg8::EpiBf16<0> E{BIG, N, nullptr, 0, 0, 1.f};
                pg8::gemm_phase<pg8::EpiBf16<0>, pg8::StaticOrder, true, true>((PG8_LAS unsigned char*)C.lds, g, S, E);
            }
            if (layer == 0) { __syncthreads(); p_bd(C, XN, (const bfr*)(ws + WS_WTBD), (float*)(ws + WS_BD));
#ifdef BD_PROBE
                __syncthreads(); p_bd(C, XN, (const bfr*)(ws + WS_WTBD), (float*)(ws + WS_BD));
#endif
            }
        }
        SEAM(pb + 1);
        if (IN(pb + 2)) { if (layer == 1 && F8_KVQ != 2) p_headprep(C, P); }
        if (layer == 1 && F8_KVQ != 2) SEAM(pb + 2);
        if (IN(pb + 3)) { if (layer == 0) {
                if (NPREP >= 32) p_gdn_prep(C, P, C.vcu, C.G);
                else if (C.G == 256) { const int cidx = C.vcu & 31, xcd = C.vcu >> 5;
                    if (cidx < NPREP) p_gdn_prep(C, P, xcd * NPREP + cidx, 8 * NPREP); else p_convert(C, P, 1, xcd * (32 - NPREP) + (cidx - NPREP), 8 * (32 - NPREP)); }
                else { p_convert(C, P, 1, C.vcu, C.G); __syncthreads(); p_gdn_prep(C, P, C.vcu, C.G); }
            } else p_attn(C, P); }
        SEAM(pb + 3);
        if (IN(pb + 4)) { if (layer == 0) p_gdn_scan(C, P); else p_combine(C, P); }
        SEAM(pb + 4);
        if (IN(pb + 5)) { if (layer == 0) p_gdn_onorm(C, P); }
        if (layer == 0) SEAM(pb + 5);
        if (IN(pb + 6)) {
            if ((layer == 0 && F8_OUT0) || (layer == 1 && F8_OUT1)) {
                pg8::Gemm g{(const bfr*)(ws + WS_XN8), (const bfr*)(ws + (layer == 0 ? WS_WTOUT : WS_WTO)), NT, DM, DM / 2}; pg8::StaticOrder S; S.init(NT, DM, C.G, hb);
                if (layer == 0) { pg8::EpiResB<false, true> E{P.in_(0), ws + WS_SC, DM, 1.f / (SO * SU)};
                    pg8::gemm_phase<pg8::EpiResB<false, true>, pg8::StaticOrder, true, true, true>((PG8_LAS unsigned char*)C.lds, g, S, E); }
                else { pg8::EpiResB<true, true> E{ws + WS_SC, ws + WS_SC, DM, 1.f / (SO * SU)};
                    pg8::gemm_phase<pg8::EpiResB<true, true>, pg8::StaticOrder, true, true, true>((PG8_LAS unsigned char*)C.lds, g, S, E); }
            } else {
                pg8::Gemm g{XN, (const bfr*)(ws + (layer == 0 ? WS_WTOUT : WS_WTO)), NT, DM, DM}; pg8::StaticOrder S; S.init(NT, DM, C.G, hb);
                pg8::EpiRes E{layer == 0 ? P.in_(0) : (const float*)P.out_(), P.out_(), DM, 1.f};
                pg8::gemm_phase<pg8::EpiRes, pg8::StaticOrder, true, true>((PG8_LAS unsigned char*)C.lds, g, S, E);
            }
        }
        SEAM(pb + 6);
        if (IN(pb + 7)) p_norm_rows<true>(C, ws + WS_SC, XN, ws + WS_XN8);
        SEAM(pb + 7);
        if (IN(pb + 8)) {
            pg8::Gemm g{XN, (const bfr*)(ws + WS_WTQRY) + (size_t)layer * PQ * DM, NT, PQ, DM}; pg8::StaticOrder S; S.init(NT, PQ, C.G, hb);
            pg8::EpiBf16<0> E{(bfr*)(ws + WS_QRY), PQ, nullptr, 0, 0, 1.f};
            pg8::gemm_phase<pg8::EpiBf16<0>, pg8::StaticOrder, true, true>((PG8_LAS unsigned char*)C.lds, g, S, E);
        }
        SEAM(pb + 8);
        if (IN(pb + 9)) { p_sroute(C, P, layer); }
        SEAM(pb + 9); if (IN(pb + 9) && !IN(pb + 10) && IN(pb + 11)) xcd_barrier(bar);
        if (IN(pb + 11)) {
            pg8::Gemm g{(const bfr*)(ws + WS_XN8), (const bfr*)(ws + WS_U + (size_t)layer * PE * DM), NT, PE, DM / 2}; pg8::StaticOrder S; S.init(NT, PE, C.G, hb);
#ifdef G1_PROBE
            if (layer == 0) { pg8::StaticOrder S2; S2.init(NT, PE, C.G, hb); pg8::EpiGate8<G1_PROBE> E2{(bfr*)(ws + WS_G), ws + WS_A2, PE, 1.f / SU, SA};
                pg8::gemm_phase<pg8::EpiGate8<G1_PROBE>, pg8::StaticOrder, true, true, true>((PG8_LAS unsigned char*)C.lds, g, S2, E2); __syncthreads(); }
#endif
#if STAGGER_G1
            {
                const int sg = C.vcu & 7;
                if (sg) { const unsigned long long t0 = __builtin_amdgcn_s_memrealtime(); while (__builtin_amdgcn_s_memrealtime() - t0 < (unsigned long long)(sg * STAGGER_G1)) __builtin_amdgcn_s_sleep(4); }
            }
#endif
            pg8::EpiGate8C E{ws + WS_G, ws + WS_A2, PE, 1.f / SU, SA};
            pg8::gemm_phase<pg8::EpiGate8C, pg8::StaticOrder, true, true, true>((PG8_LAS unsigned char*)C.lds, g, S, E);
        }
        SEAM(pb + 11);
        if (IN(pb + 12)) {
            pg8::Gemm g{(const bfr*)(ws + WS_A2), (const bfr*)(ws + WS_VT + (size_t)layer * DM * PE), NT, DM, PE / 2}; pg8::StaticOrder S; S.init(NT, DM, C.G, hb);
            if (layer == 0) { pg8::EpiResB<true, true> E{ws + WS_SC, ws + WS_SC, DM, 1.f / (SA * SV)};
                pg8::gemm_phase<pg8::EpiResB<true, true>, pg8::StaticOrder, true, true, true>((PG8_LAS unsigned char*)C.lds, g, S, E); }
            else { pg8::EpiResB<true, false> E{ws + WS_SC, P.out_(), DM, 1.f / (SA * SV)};
                pg8::gemm_phase<pg8::EpiResB<true, false>, pg8::StaticOrder, true, true, true>((PG8_LAS unsigned char*)C.lds, g, S, E); }
#ifdef G2_PROBE
            if (layer == 0) { __syncthreads(); pg8::StaticOrder S2; S2.init(NT, DM, C.G, hb); pg8::EpiRes E2{(const float*)P.out_(), P.out_(), DM, 0.f};
                pg8::gemm_phase<pg8::EpiRes, pg8::StaticOrder, true, true, true>((PG8_LAS unsigned char*)C.lds, g, S2, E2); }
#endif
        }
        SEAM(pb + 12);
    }
    {
        constexpr int layer = 1;
        const int pb = 1 + layer * NPH_LAYER;
        if (layer == 1 && IN(pb + 0)) p_norm_rows<true>(C, ws + WS_SC, F8_KVQ == 2 ? nullptr : XN, F8_KVQ != 0 ? ws + WS_XN8 : nullptr);
        if (layer == 1) SEAM(pb + 0);
        if (IN(pb + 1)) {
            const int N = layer == 0 ? 16384 : 12288;
            if (layer == 0 && F8_PROJ0 == 2) {
                { pg8::Gemm g{XN, (const bfr*)(ws + WS_WTIN), NT, 8192, DM}; pg8::StaticOrder S; S.init(NT, 8192, C.G, hb);
                  pg8::EpiBf16<0> E{BIG, N, nullptr, 0, 0, 1.f};
                  pg8::gemm_phase<pg8::EpiBf16<0>, pg8::StaticOrder, true, true>((PG8_LAS unsigned char*)C.lds, g, S, E); }
                __syncthreads();
                { pg8::Gemm g{(const bfr*)(ws + WS_XN8), (const bfr*)(ws + WS_WTIN + (size_t)8192 * DM * 2), NT, 8192, DM / 2}; pg8::StaticOrder S; S.init(NT, 8192, C.G, hb);
                  pg8::EpiBf16<0> E{BIG + 8192, N, nullptr, 8192, 0, 1.f / SU};
                  pg8::gemm_phase<pg8::EpiBf16<0>, pg8::StaticOrder, true, true, true>((PG8_LAS unsigned char*)C.lds, g, S, E); }
            } else if (layer == 0 && F8_PROJ0 == 5) {
                { pg8::Gemm g{(const bfr*)(ws + WS_XN8), (const bfr*)(ws + WS_WTIN), NT, 8192, DM / 2}; pg8::StaticOrder S; S.init(NT, 8192, C.G, hb);
                  pg8::EpiBf16<0> E{BIG, N, nullptr, 8192, 0, 1.f / SU};
                  pg8::gemm_phase<pg8::EpiBf16<0>, pg8::StaticOrder, true, true, true>((PG8_LAS unsigned char*)C.lds, g, S, E); }
                __syncthreads();
                { pg8::Gemm g{XN, (const bfr*)(ws + WS_WTIN + (size_t)32 * MiB), NT, 4096, DM}; pg8::StaticOrder S; S.init(NT, 4096, C.G, hb);
                  pg8::EpiBf16<0> E{BIG + 8192, N, nullptr, 0, 0, 1.f};
                  pg8::gemm_phase<pg8::EpiBf16<0>, pg8::StaticOrder, true, true>((PG8_LAS unsigned char*)C.lds, g, S, E); }
                __syncthreads();
                { pg8::Gemm g{(const bfr*)(ws + WS_XN8), (const bfr*)(ws + WS_WTIN + (size_t)64 * MiB), NT, 4096, DM / 2}; pg8::StaticOrder S; S.init(NT, 4096, C.G, hb);
                  pg8::EpiBf16<0> E{BIG + 12288, N, nullptr, 4096, 0, 1.f / SU};
                  pg8::gemm_phase<pg8::EpiBf16<0>, pg8::StaticOrder, true, true, true>((PG8_LAS unsigned char*)C.lds, g, S, E); }
            } else if (layer == 0 && F8_PROJ0 == 6) {
                { pg8::Gemm g{(const bfr*)(ws + WS_XN8), (const bfr*)(ws + WS_WTIN), NT, 12288, DM / 2}; pg8::StaticOrder S; S.init(NT, 12288, C.G, hb);
                  pg8::EpiBf16<0> E{BIG, N, nullptr, 12288, 0, 1.f / SU};
                  pg8::gemm_phase<pg8::EpiBf16<0>, pg8::StaticOrder, true, true, true>((PG8_LAS unsigned char*)C.lds, g, S, E); }
                __syncthreads();
                { pg8::Gemm g{XN, (const bfr*)(ws + WS_WTIN + (size_t)48 * MiB), NT, 4096, DM}; pg8::StaticOrder S; S.init(NT, 4096, C.G, hb);
                  pg8::EpiBf16<0> E{BIG + 12288, N, nullptr, 0, 0, 1.f};
                  pg8::gemm_phase<pg8::EpiBf16<0>, pg8::StaticOrder, true, true>((PG8_LAS unsigned char*)C.lds, g, S, E); }
            } else if (layer == 0 && F8_PROJ0 == 4) {
                { pg8::Gemm g{(const bfr*)(ws + WS_XN8), (const bfr*)(ws + WS_WTIN), NT, 4096, DM / 2}; pg8::StaticOrder S; S.init(NT, 4096, C.G, hb);
                  pg8::EpiBf16<0> E{BIG, N, nullptr, 4096, 0, 1.f / SU};
                  pg8::gemm_phase<pg8::EpiBf16<0>, pg8::StaticOrder, true, true, true>((PG8_LAS unsigned char*)C.lds, g, S, E); }
                __syncthreads();
                { pg8::Gemm g{XN, (const bfr*)(ws + WS_WTIN + (size_t)4096 * DM), NT, 12288, DM}; pg8::StaticOrder S; S.init(NT, 12288, C.G, hb);
                  pg8::EpiBf16<0> E{BIG + 4096, N, nullptr, 0, 0, 1.f};
                  pg8::gemm_phase<pg8::EpiBf16<0>, pg8::StaticOrder, true, true>((PG8_LAS unsigned char*)C.lds, g, S, E); }
            } else if (layer == 0 && F8_PROJ0 == 3) {
                { pg8::Gemm g{(const bfr*)(ws + WS_XN8), (const bfr*)(ws + WS_WTIN), NT, 8192, DM / 2}; pg8::StaticOrder S; S.init(NT, 8192, C.G, hb);
                  pg8::EpiBf16<0> E{BIG, N, nullptr, 8192, 0, 1.f / SU};
                  pg8::gemm_phase<pg8::EpiBf16<0>, pg8::StaticOrder, true, true, true>((PG8_LAS unsigned char*)C.lds, g, S, E); }
                __syncthreads();
                { pg8::Gemm g{XN, (const bfr*)(ws + WS_WTIN + (size_t)8192 * DM), NT, 8192, DM}; pg8::StaticOrder S; S.init(NT, 8192, C.G, hb);
                  pg8::EpiBf16<0> E{BIG + 8192, N, nullptr, 0, 0, 1.f};
                  pg8::gemm_phase<pg8::EpiBf16<0>, pg8::StaticOrder, true, true>((PG8_LAS unsigned char*)C.lds, g, S, E); }
            } else if (layer == 0 && F8_PROJ0 == 1) {
                pg8::Gemm g{(const bfr*)(ws + WS_XN8), (const bfr*)(ws + WS_WTIN), NT, N, DM / 2}; pg8::StaticOrder S; S.init(NT, N, C.G, hb);
                pg8::EpiBf16<0> E{BIG, N, nullptr, N, 0, 1.f / SU};
                pg8::gemm_phase<pg8::EpiBf16<0>, pg8::StaticOrder, true, true, true>((PG8_LAS unsigned char*)C.lds, g, S, E);
            } else if (layer == 1 && F8_KVQ == 2) {
                pg8::Gemm g{(const bfr*)(ws + WS_XN8), (const bfr*)(ws + WS_WTKVQ), NT, N, DM / 2}; pg8::StaticOrder S; S.init(NT, N, C.G, hb);
                pg8::EpiHead E{(bfr*)(ws + WS_R + R_KH), (bfr*)(ws + WS_R + R_QH), (bfr*)(ws + WS_R + R_VH), P.in_(10), P.in_(13), 1.f / SU};
                pg8::gemm_phase<pg8::EpiHead, pg8::StaticOrder, true, true, true>((PG8_LAS unsigned char*)C.lds, g, S, E);
            } else if (layer == 1 && F8_KVQ) {
                { pg8::Gemm g{(const bfr*)(ws + WS_XN8), (const bfr*)(ws + WS_WTKVQ), NT, 8192, DM / 2}; pg8::StaticOrder S; S.init(NT, 8192, C.G, hb);
                  pg8::EpiBf16<0> E{BIG, N, nullptr, 8192, 0, 1.f / SU};
                  pg8::gemm_phase<pg8::EpiBf16<0>, pg8::StaticOrder, true, true, true>((PG8_LAS unsigned char*)C.lds, g, S, E); }
                __syncthreads();
                { pg8::Gemm g{XN, (const bfr*)(ws + WS_WTKVQ + (size_t)2 * DM * DM), NT, DM, DM}; pg8::StaticOrder S; S.init(NT, DM, C.G, hb);
                  pg8::EpiBf16<0> E{BIG + 8192, N, nullptr, 0, 0, 1.f};
                  pg8::gemm_phase<pg8::EpiBf16<0>, pg8::StaticOrder, true, true>((PG8_LAS unsigned char*)C.lds, g, S, E); }
            } else {
                pg8::Gemm g{XN, (const bfr*)(ws + (layer == 0 ? WS_WTIN : WS_WTKVQ)), NT, N, DM}; pg8::StaticOrder S; S.init(NT, N, C.G, hb);
                pg8::EpiBf16<0> E{BIG, N, nullptr, 0, 0, 1.f};
                pg8::gemm_phase<pg8::EpiBf16<0>, pg8::StaticOrder, true, true>((PG8_LAS unsigned char*)C.lds, g, S, E);
            }
            if (layer == 0) { __syncthreads(); p_bd(C, XN, (const bfr*)(ws + WS_WTBD), (float*)(ws + WS_BD));
#ifdef BD_PROBE
                __syncthreads(); p_bd(C, XN, (const bfr*)(ws + WS_WTBD), (float*)(ws + WS_BD));
#endif
            }
        }
        SEAM(pb + 1);
        if (IN(pb + 2)) { if (layer == 1 && F8_KVQ != 2) p_headprep(C, P); }
        if (layer == 1 && F8_KVQ != 2) SEAM(pb + 2);
        if (IN(pb + 3)) { if (layer == 0) {
                if (NPREP >= 32) p_gdn_prep(C, P, C.vcu, C.G);
                else if (C.G == 256) { const int cidx = C.vcu & 31, xcd = C.vcu >> 5;
                    if (cidx < NPREP) p_gdn_prep(C, P, xcd * NPREP + cidx, 8 * NPREP); else p_convert(C, P, 1, xcd * (32 - NPREP) + (cidx - NPREP), 8 * (32 - NPREP)); }
                else { p_convert(C, P, 1, C.vcu, C.G); __syncthreads(); p_gdn_prep(C, P, C.vcu, C.G); }
            } else p_attn(C, P); }
        SEAM(pb + 3);
        if (IN(pb + 4)) { if (layer == 0) p_gdn_scan(C, P); else p_combine(C, P); }
        SEAM(pb + 4);
        if (IN(pb + 5)) { if (layer == 0) p_gdn_onorm(C, P); }
        if (layer == 0) SEAM(pb + 5);
        if (IN(pb + 6)) {
            if ((layer == 0 && F8_OUT0) || (layer == 1 && F8_OUT1)) {
                pg8::Gemm g{(const bfr*)(ws + WS_XN8), (const bfr*)(ws + (layer == 0 ? WS_WTOUT : WS_WTO)), NT, DM, DM / 2}; pg8::StaticOrder S; S.init(NT, DM, C.G, hb);
                if (layer == 0) { pg8::EpiResB<false, true> E{P.in_(0), ws + WS_SC, DM, 1.f / (SO * SU)};
                    pg8::gemm_phase<pg8::EpiResB<false, true>, pg8::StaticOrder, true, true, true>((PG8_LAS unsigned char*)C.lds, g, S, E); }
                else { pg8::EpiResB<true, true> E{ws + WS_SC, ws + WS_SC, DM, 1.f / (SO * SU)};
                    pg8::gemm_phase<pg8::EpiResB<true, true>, pg8::StaticOrder, true, true, true>((PG8_LAS unsigned char*)C.lds, g, S, E); }
            } else {
                pg8::Gemm g{XN, (const bfr*)(ws + (layer == 0 ? WS_WTOUT : WS_WTO)), NT, DM, DM}; pg8::StaticOrder S; S.init(NT, DM, C.G, hb);
                pg8::EpiRes E{layer == 0 ? P.in_(0) : (const float*)P.out_(), P.out_(), DM, 1.f};
                pg8::gemm_phase<pg8::EpiRes, pg8::StaticOrder, true, true>((PG8_LAS unsigned char*)C.lds, g, S, E);
            }
        }
        SEAM(pb + 6);
        if (IN(pb + 7)) p_norm_rows<true>(C, ws + WS_SC, XN, ws + WS_XN8);
        SEAM(pb + 7);
        if (IN(pb + 8)) {
            pg8::Gemm g{XN, (const bfr*)(ws + WS_WTQRY) + (size_t)layer * PQ * DM, NT, PQ, DM}; pg8::StaticOrder S; S.init(NT, PQ, C.G, hb);
            pg8::EpiBf16<0> E{(bfr*)(ws + WS_QRY), PQ, nullptr, 0, 0, 1.f};
            pg8::gemm_phase<pg8::EpiBf16<0>, pg8::StaticOrder, true, true>((PG8_LAS unsigned char*)C.lds, g, S, E);
        }
        SEAM(pb + 8);
        if (IN(pb + 9)) { p_sroute(C, P, layer); }
        SEAM(pb + 9); if (IN(pb + 9) && !IN(pb + 10) && IN(pb + 11)) xcd_barrier(bar);
        if (IN(pb + 11)) {
            pg8::Gemm g{(const bfr*)(ws + WS_XN8), (const bfr*)(ws + WS_U + (size_t)layer * PE * DM), NT, PE, DM / 2}; pg8::StaticOrder S; S.init(NT, PE, C.G, hb);
#ifdef G1_PROBE
            if (layer == 0) { pg8::StaticOrder S2; S2.init(NT, PE, C.G, hb); pg8::EpiGate8<G1_PROBE> E2{(bfr*)(ws + WS_G), ws + WS_A2, PE, 1.f / SU, SA};
                pg8::gemm_phase<pg8::EpiGate8<G1_PROBE>, pg8::StaticOrder, true, true, true>((PG8_LAS unsigned char*)C.lds, g, S2, E2); __syncthreads(); }
#endif
#if STAGGER_G1
            {
                const int sg = C.vcu & 7;
                if (sg) { const unsigned long long t0 = __builtin_amdgcn_s_memrealtime(); while (__builtin_amdgcn_s_memrealtime() - t0 < (unsigned long long)(sg * STAGGER_G1)) __builtin_amdgcn_s_sleep(4); }
            }
#endif
            pg8::EpiGate8C E{ws + WS_G, ws + WS_A2, PE, 1.f / SU, SA};
            pg8::gemm_phase<pg8::EpiGate8C, pg8::StaticOrder, true, true, true>((PG8_LAS unsigned char*)C.lds, g, S, E);
        }
        SEAM(pb + 11);
        if (IN(pb + 12)) {
            pg8::Gemm g{(const bfr*)(ws + WS_A2), (const bfr*)(ws + WS_VT + (size_t)layer * DM * PE), NT, DM, PE / 2}; pg8::StaticOrder S; S.init(NT, DM, C.G, hb);
            if (layer == 0) { pg8::EpiResB<true, true> E{ws + WS_SC, ws + WS_SC, DM, 1.f / (SA * SV)};
                pg8::gemm_phase<pg8::EpiResB<true, true>, pg8::StaticOrder, true, true, true>((PG8_LAS unsigned char*)C.lds, g, S, E); }
            else { pg8::EpiResB<true, false> E{ws + WS_SC, P.out_(), DM, 1.f / (SA * SV)};
                pg8::gemm_phase<pg8::EpiResB<true, false>, pg8::StaticOrder, true, true, true>((PG8_LAS unsigned char*)C.lds, g, S, E); }
#ifdef G2_PROBE
            if (layer == 0) { __syncthreads(); pg8::StaticOrder S2; S2.init(NT, DM, C.G, hb); pg8::EpiRes E2{(const float*)P.out_(), P.out_(), DM, 0.f};
                pg8::gemm_phase<pg8::EpiRes, pg8::StaticOrder, true, true, true>((PG8_LAS unsigned char*)C.lds, g, S2, E2); }
#endif
        }
        SEAM(pb + 12);
    }
#undef IN
#undef SEAM
}

extern "C" void kernel_launch(void* const* d_in, const int* in_sizes, int n_in, void* d_out, int out_size, void* d_ws, size_t ws_size, hipStream_t stream) {
    static int grid = 0;
    if (grid == 0) {
        if (n_in != 26 || out_size != NT * DM || ws_size < WS_END) { fprintf(stderr, "kernel_launch: unexpected problem (n_in %d, out %d, ws %zu < %zu)\n", n_in, out_size, ws_size, (size_t)WS_END); grid = -1; return; }
        int dev = 0, cus = 0;
        if (hipGetDevice(&dev) != hipSuccess || hipDeviceGetAttribute(&cus, hipDeviceAttributeMultiprocessorCount, dev) != hipSuccess || cus <= 0) { grid = -1; return; }
        if (hipFuncSetAttribute((const void*)trunk_fwd, hipFuncAttributeMaxDynamicSharedMemorySize, LDS_BYTES) != hipSuccess) { fprintf(stderr, "kernel_launch: hipFuncSetAttribute failed\n"); grid = -1; return; }
        int per_cu = 0;
        if (hipOccupancyMaxActiveBlocksPerMultiprocessor(&per_cu, (const void*)trunk_fwd, 512, LDS_BYTES) != hipSuccess || per_cu < 1) { fprintf(stderr, "kernel_launch: occupancy query says %d blocks per CU\n", per_cu); }
        (void)hipGetLastError();
        grid = cus;
    }
    if (grid < 0) return;
    (void)in_sizes;
    if (hipMemsetAsync((char*)d_ws + WS_CTL, 0, CTL_ZERO_BYTES, stream) != hipSuccess) return;
    KArgs p{};
    for (int i = 0; i < 26; ++i) p.in[i] = (const float*)d_in[i];
    p.out = (float*)d_out; p.ws = (unsigned char*)d_ws;
#if MK_PER_PHASE
    for (int ph = 0; ph < NPHASE; ++ph) {
        if (ph == 1 + 5 + NPH_LAYER || ph == 1 + 10 || ph == 1 + 10 + NPH_LAYER) continue;
        p.ph_lo = ph; p.ph_hi = ph + 1; p.li = 0; p.pad = 0;
        hipLaunchKernelGGL(trunk_fwd, dim3(grid), dim3(512), LDS_BYTES, stream, p);
    }
#else
    p.ph_lo = 0; p.ph_hi = NPHASE; p.li = 0; p.pad = 0;
    hipLaunchKernelGGL(trunk_fwd, dim3(grid), dim3(512), LDS_BYTES, stream, p);
#endif
}
```

```cpp
#include <hip/hip_runtime.h>
#include <hip/hip_bf16.h>
#include <cstdio>
#include <cstdint>

#define LAS __attribute__((address_space(3)))
#define GAS __attribute__((address_space(1)))
typedef unsigned short bfr;
typedef short s8v __attribute__((ext_vector_type(8)));
typedef float f4v __attribute__((ext_vector_type(4)));
typedef unsigned u4v __attribute__((ext_vector_type(4)));
typedef unsigned u2v __attribute__((ext_vector_type(2)));
typedef int i4v __attribute__((ext_vector_type(4)));

#ifndef F8_PROJ0
#define F8_PROJ0 3
#endif
#ifndef F8_KVQ
#define F8_KVQ 2
#endif
#ifndef F8_OUT0
#define F8_OUT0 1
#endif
#ifndef F8_OUT1
#define F8_OUT1 1
#endif
#ifndef F8_OUT
#define F8_OUT (F8_OUT0 || F8_OUT1)
#endif
#ifndef STAGGER_G1
#define STAGGER_G1 0
#endif
#ifndef NPREP
#define NPREP 20
#endif
constexpr int NB = 2, SEQ = 4096, DM = 4096, NT = NB * SEQ;
constexpr int GH = 32, GD = 128, GIN = 16448, CH = 64, NCH = SEQ / CH;
constexpr int AH = 16, AD = 128, AV = 256;
constexpr int PH = 8, PK = 128, PE = 16384, PQ = 2048, PTOP = 16;
constexpr float EPS = 1e-6f;
constexpr float LAMBDA_INIT = 0.35550906759f;
constexpr float SU = 64.f, SA = 64.f, SV = 4.f, SO = 16.f;

constexpr size_t MiB = 1u << 20;
constexpr size_t WS_CTL   = 0;
constexpr size_t WS_WTIN  = 1 * MiB;
constexpr size_t WS_WTBD  = WS_WTIN + 128 * MiB;
constexpr size_t WS_WTOUT = WS_WTBD + 1 * MiB;
constexpr size_t WS_WTKVQ = WS_WTOUT + 32 * MiB;
constexpr size_t WS_WTO   = WS_WTKVQ + 96 * MiB;
constexpr size_t WS_WTQRY = WS_WTO + 32 * MiB;
constexpr size_t WS_WTKEY = WS_WTQRY + 32 * MiB;
constexpr size_t WS_U     = WS_WTKEY + 16 * MiB;
constexpr size_t WS_VT    = WS_U + 128 * MiB;
constexpr size_t WS_A2    = WS_VT + 128 * MiB;
constexpr size_t WS_XN8   = WS_A2 + 128 * MiB;
constexpr size_t WS_XN    = WS_XN8 + 32 * MiB;
constexpr size_t WS_BIG   = WS_XN + 64 * MiB;
constexpr size_t WS_R     = WS_BIG + 256 * MiB;
constexpr size_t WS_QRY   = WS_R + 352 * MiB;
constexpr size_t WS_SC    = WS_QRY + 32 * MiB;
constexpr size_t WS_BD    = WS_SC + 64 * MiB;
constexpr size_t WS_EG    = WS_BD + 2 * MiB;
constexpr size_t WS_G     = WS_EG + 1 * MiB;
constexpr size_t WS_END   = WS_G + 256 * MiB;
constexpr size_t R_W = 0, R_U = 64 * MiB, R_QG = 128 * MiB, R_KD = 192 * MiB, R_QK = 256 * MiB, R_O = 288 * MiB;
constexpr size_t R_QH = 0, R_KH = 64 * MiB, R_VH = 128 * MiB, R_OH = 192 * MiB;
static_assert(WS_END <= (size_t)1790 * MiB, "workspace map");

constexpr int CW_BAR = 4096;
constexpr size_t CTL_ZERO_BYTES = 1 * MiB;

constexpr int LDS_BYTES = 147456;
constexpr int MISC_OFF = 146944;

typedef float f2v_ __attribute__((ext_vector_type(2)));
typedef __bf16 b2v_ __attribute__((ext_vector_type(2)));
__device__ __forceinline__ unsigned cvtpk(float lo, float hi) { const b2v_ r = __builtin_convertvector((f2v_){lo, hi}, b2v_); return __builtin_bit_cast(unsigned, r); }
__device__ __forceinline__ unsigned cvt4_fp8(float a, float b, float c, float d) { int w = 0; w = __builtin_amdgcn_cvt_pk_fp8_f32(a, b, w, false); w = __builtin_amdgcn_cvt_pk_fp8_f32(c, d, w, true); return (unsigned)w; }
__device__ __forceinline__ float bflo(unsigned w) { return __uint_as_float(w << 16); }
__device__ __forceinline__ float bfhi(unsigned w) { return __uint_as_float(w & 0xffff0000u); }
__device__ __forceinline__ float bf1(bfr b) { return __uint_as_float(((unsigned)b) << 16); }
__device__ __forceinline__ bfr f2bf1(float f) { return (bfr)(cvtpk(f, 0.f) & 0xffffu); }
__device__ __forceinline__ float wave_sum(float v) {
#pragma unroll
    for (int o = 1; o < 64; o <<= 1) v += __shfl_xor(v, o);
    return v;
}
__device__ __forceinline__ f4v zero_acc() { f4v z = {0.f, 0.f, 0.f, 0.f}; asm volatile("" : "+v"(z)); return z; }
#define MFMA_SETTLE(acc) asm volatile("s_nop 7\n\ts_nop 7" : "+v"(acc))
#define LDS_WAIT() asm volatile("s_waitcnt lgkmcnt(0)" ::: "memory")
#define VM_WAIT() asm volatile("s_waitcnt vmcnt(0)" ::: "memory")
#define XB_TMO      128
#define XB_XCNT(j)  (256  + 64 * (j))
#define XB_XSUB(j)  (1280 + 64 * (j))
#define XB_XGEN(j)  (2304 + 64 * (j))
#define XB_TOP      3328
#define XB_TOPGEN   3392
#define XCD_BAR_WORDS 3456
#define XB_SPIN_CAP (1u << 18)

__device__ __forceinline__ unsigned xb_ld(unsigned* p)              { return __hip_atomic_load(p, __ATOMIC_RELAXED, __HIP_MEMORY_SCOPE_AGENT); }
__device__ __forceinline__ unsigned xb_add(unsigned* p, unsigned v) { return __hip_atomic_fetch_add(p, v, __ATOMIC_RELAXED, __HIP_MEMORY_SCOPE_AGENT); }
__device__ __forceinline__ unsigned xb_xcc_id() { return (unsigned)__builtin_amdgcn_s_getreg((3 << 11) | 20) & 0xFu; }
#define XB_SPIN(cond, bar) do { unsigned _sp = 0; while (cond) { __builtin_amdgcn_s_sleep(1); \
    if ((++_sp & 255u) == 0u) { if (xb_ld(&(bar)[XB_TMO])) break; if (_sp > XB_SPIN_CAP) { atomicAdd(&(bar)[XB_TMO], 1u); break; } } } } while (0)

struct XcdBarrier {
    unsigned* bar; unsigned x;
    volatile LAS unsigned* st;
};

__device__ __forceinline__ XcdBarrier xcd_barrier_post(unsigned* bar, volatile LAS unsigned* st) {
    XcdBarrier b; b.bar = bar; b.x = xb_xcc_id(); b.st = st;
    if (threadIdx.x == 0) (void)xb_add(&bar[XB_XCNT(b.x)], 1u);
    return b;
}
__device__ __forceinline__ void xcd_barrier_complete(unsigned* bar, unsigned x, unsigned& nloc, unsigned& nx) {
    const unsigned G = gridDim.x * gridDim.y * gridDim.z;
    unsigned sum, cnt, mine, sp = 0u;
    for (;;) {
        sum = 0u; cnt = 0u; mine = 0u;
#pragma unroll
        for (unsigned j = 0; j < 16; ++j) { const unsigned c = xb_ld(&bar[XB_XCNT(j)]); sum += c; cnt += (c > 0u) ? 1u : 0u; mine = (j == x) ? c : mine; }
        if (sum == G) break;
        __builtin_amdgcn_s_sleep(1);
        if ((++sp & 255u) == 0u) { if (xb_ld(&bar[XB_TMO])) break; if (sp > XB_SPIN_CAP) { atomicAdd(&bar[XB_TMO], 1u); break; } }
    }
    nloc = mine > 0u ? mine : 1u; nx = cnt > 0u ? cnt : 1u;
}

__device__ __forceinline__ void xcd_barrier(const XcdBarrier& b) {
    asm volatile("s_waitcnt vmcnt(0)" ::: "memory");
    __syncthreads();
    if (threadIdx.x == 0) {
        unsigned* bar = b.bar;
        __builtin_amdgcn_s_waitcnt(0);
        unsigned nloc = b.st[0], nx = b.st[1];
        if (nloc == 0u) { xcd_barrier_complete(bar, b.x, nloc, nx); b.st[0] = nloc; b.st[1] = nx; }
        const unsigned old = xb_add(&bar[XB_XSUB(b.x)], 1u);
        const unsigned gen = old / nloc;
        if (old + 1u == (gen + 1u) * nloc) {
            __builtin_amdgcn_fence(__ATOMIC_RELEASE, "agent");
            asm volatile("s_waitcnt vmcnt(0)" ::: "memory");
            const unsigned og = xb_add(&bar[XB_TOP], 1u);
            const unsigned tg = og / nx;
            if (og + 1u == (tg + 1u) * nx) xb_add(&bar[XB_TOPGEN], 1u);
            else XB_SPIN(xb_ld(&bar[XB_TOPGEN]) == tg, bar);
            __builtin_amdgcn_fence(__ATOMIC_ACQUIRE, "agent");
            xb_add(&bar[XB_XGEN(b.x)], 1u);
            asm volatile("s_waitcnt vmcnt(0)" ::: "memory");
        } else {
            XB_SPIN(xb_ld(&bar[XB_XGEN(b.x)]) == gen, bar);
            __builtin_amdgcn_fence(__ATOMIC_ACQUIRE, "agent");
            asm volatile("s_waitcnt vmcnt(0)" ::: "memory");
        }
    }
    __syncthreads();
}
namespace pg8 {
#define PG8_LAS __attribute__((address_space(3)))
typedef unsigned short bf16_t;
typedef short bf16x8 __attribute__((ext_vector_type(8)));
typedef float f32x4 __attribute__((ext_vector_type(4)));
typedef unsigned u32x4 __attribute__((ext_vector_type(4)));
typedef int i32x4 __attribute__((ext_vector_type(4)));
typedef int i32x8 __attribute__((ext_vector_type(8)));
typedef unsigned u32x2 __attribute__((ext_vector_type(2)));
constexpr int BM = 256, BK = 64, HALF = 128, HTB = HALF * BK * 2  , STAGE_BYTES = 8 * HTB, NXCD = 8, WGM = 8;

__host__ __device__ __forceinline__ int lds_byte(int r, int c) { const int st = (r >> 4) * 2 + (c >> 5), rr = r & 15, cc = c & 31, ob = rr * 64 + cc * 2; return st * 1024 + (ob ^ (((ob >> 9) & 1) << 5)); }
__host__ __device__ __forceinline__ void stage_rc(int b, int& R, int& C) { const int st = b / 1024, sb = b % 1024, swz = sb ^ (((sb >> 9) & 1) << 5); R = (st >> 1) * 16 + swz / 64; C = (st & 1) * 32 + (swz % 64) / 2; }
__host__ __device__ __forceinline__ int perm32(int rho) { const int n = rho >> 4, i = rho & 15; return 8 * (i >> 2) + 4 * n + (i & 3); }

struct Unit { int pm, pn; };
struct Gemm { const bf16_t* A; const bf16_t* Bt; int M, N, K; };

struct StaticOrder {
    int nM, nN, nwg, G, c;
    __host__ __device__ void init(int M, int N, int G_, int c_) { nM = M / BM; nN = N / BM; nwg = nM * nN; G = G_; c = c_; }
    __host__ __device__ bool next(int i, Unit& u) const {
        const long L = (long)i * G + c; if (L >= nwg) return false;
        int wgid = (int)L; { const int q = nwg / NXCD, r = nwg % NXCD, xcd = wgid % NXCD, off = wgid / NXCD; wgid = (xcd < r ? xcd * (q + 1) : r * (q + 1) + (xcd - r) * q) + off; }
        const int nig = WGM * nN, gid = wgid / nig, fm = gid * WGM, gsz = (nM - fm) < WGM ? (nM - fm) : WGM;
        u.pm = fm + ((wgid % nig) % gsz); u.pn = (wgid % nig) / gsz; return true;
    }
    __device__ __forceinline__ void a_ready(const Unit&) const {}
    __device__ __forceinline__ void done(const Unit&) const {}
};

__device__ __forceinline__ unsigned cvt_pk_bf16(float lo, float hi) { unsigned r; asm volatile("v_cvt_pk_bf16_f32 %0, %1, %2" : "=v"(r) : "v"(lo), "v"(hi)); return r; }
typedef float f32x2 __attribute__((ext_vector_type(2)));
__device__ __forceinline__ f32x2 gelu_pk(f32x2 v) {
    const f32x2 av = __builtin_elementwise_abs(v), d = av * 0.2316418882f + 1.0f;
    f32x2 t; t.x = __builtin_amdgcn_rcpf(d.x); t.y = __builtin_amdgcn_rcpf(d.y);
    f32x2 q = t * 0.5307027145f + (-0.7265760135f); q = q * t + 0.7107068705f; q = q * t + (-0.142248368f); q = q * t + 0.127414796f; q = q * t;
    const f32x2 s = (v * v) * (-0.72134752044f);
    f32x2 e; e.x = __builtin_amdgcn_exp2f(s.x); e.y = __builtin_amdgcn_exp2f(s.y);
    const f32x2 m = v * (q * e), r = v - m;
    f32x2 o; o.x = v.x < 0.f ? m.x : r.x; o.y = v.y < 0.f ? m.y : r.y; return o;
}

template <int ACT  > struct EpiBf16 {
    static constexpr bool PERM = true, AFTER_DRAIN = false; static_assert(ACT == 0 || ACT == 1, "EpiBf16: ACT is 0 (none) or 1 (gelu_pk)");
    bf16_t* O; int ldc; const float* bias; int split_cols; size_t split_stride; float scale0;
    __device__ __forceinline__ void operator()(const f32x4 (&acc)[2][2][4][2], const Unit& u, int wr, int wc, int fr, int fq) const {
        const int row0 = u.pm * BM + wr * 64 + fr; int colt = u.pn * BM; bf16_t* base = O;
        float sc = 1.f; if (split_cols) { const int t = colt / split_cols; base += (size_t)t * split_stride; colt -= t * split_cols; if (t == 0) sc = scale0; }
        const int col0 = colt + wc * 32 + 8 * fq, bcol0 = u.pn * BM + wc * 32 + 8 * fq;
        f32x4 bv[2][2];
#pragma unroll
        for (int bj = 0; bj < 2; ++bj)
#pragma unroll
            for (int n = 0; n < 2; ++n) bv[bj][n] = bias ? *(const f32x4*)(bias + bcol0 + bj * HALF + 4 * n) : (f32x4){0.f, 0.f, 0.f, 0.f};
#pragma unroll
        for (int ai = 0; ai < 2; ++ai)
#pragma unroll
            for (int m = 0; m < 4; ++m) { bf16_t* rowp = base + (size_t)(row0 + ai * HALF + m * 16) * ldc + col0;
#pragma unroll
                for (int bj = 0; bj < 2; ++bj) { f32x4 v0 = acc[ai][bj][m][0] + bv[bj][0], v1 = acc[ai][bj][m][1] + bv[bj][1];
                    if (ACT == 1) { f32x2 a = gelu_pk((f32x2){v0[0], v0[1]}), b = gelu_pk((f32x2){v0[2], v0[3]}), c = gelu_pk((f32x2){v1[0], v1[1]}), d = gelu_pk((f32x2){v1[2], v1[3]});
                        v0 = (f32x4){a.x, a.y, b.x, b.y}; v1 = (f32x4){c.x, c.y, d.x, d.y}; }
                    v0 = v0 * sc; v1 = v1 * sc; u32x4 w; w.x = cvt_pk_bf16(v0[0], v0[1]); w.y = cvt_pk_bf16(v0[2], v0[3]); w.z = cvt_pk_bf16(v1[0], v1[1]); w.w = cvt_pk_bf16(v1[2], v1[3]);
                    *(u32x4*)(rowp + bj * HALF) = w; } }
    }
};
struct EpiRes {
    static constexpr bool PERM = false, AFTER_DRAIN = false;
    const float* base; float* out; int ldc; float scale;
    __device__ __forceinline__ void operator()(const f32x4 (&acc)[2][2][4][2], const Unit& u, int wr, int wc, int fr, int fq) const {
        const int row0 = u.pm * BM + wr * 64 + fr, col0 = u.pn * BM + wc * 32 + 4 * fq;
#pragma unroll
        for (int ai = 0; ai < 2; ++ai)
#pragma unroll
            for (int m = 0; m < 4; ++m) { const size_t off = (size_t)(row0 + ai * HALF + m * 16) * ldc + col0;
                f32x4 bs[2][2];
#pragma unroll
                for (int bj = 0; bj < 2; ++bj)
#pragma unroll
                    for (int n = 0; n < 2; ++n) bs[bj][n] = *(const f32x4*)(base + off + bj * HALF + n * 16);
#pragma unroll
                for (int bj = 0; bj < 2; ++bj)
#pragma unroll
                    for (int n = 0; n < 2; ++n) *(f32x4*)(out + off + bj * HALF + n * 16) = bs[bj][n] + acc[ai][bj][m][n] * scale;
                asm volatile("" ::: "memory"); }
    }
};
struct EpiStF32 {
    static constexpr bool PERM = false, AFTER_DRAIN = false;
    float* C; int ldc;
    __device__ __forceinline__ void operator()(const f32x4 (&acc)[2][2][4][2], const Unit& u, int wr, int wc, int fr, int fq) const {
        const int row0 = u.pm * BM + wr * 64 + fr, col0 = u.pn * BM + wc * 32 + 4 * fq;
#pragma unroll
        for (int ai = 0; ai < 2; ++ai)
#pragma unroll
            for (int m = 0; m < 4; ++m) { float* rowp = C + (size_t)(row0 + ai * HALF + m * 16) * ldc + col0;
#pragma unroll
                for (int bj = 0; bj < 2; ++bj)
#pragma unroll
                    for (int n = 0; n < 2; ++n) *(f32x4*)(rowp + bj * HALF + n * 16) = acc[ai][bj][m][n]; }
    }
};
struct EpiGate {
    static constexpr bool PERM = true, AFTER_DRAIN = false;
    bf16_t* G; int ldc;
    __device__ __forceinline__ void operator()(const f32x4 (&acc)[2][2][4][2], const Unit& u, int wr, int wc, int fr, int fq) const {
        const int row0 = u.pm * BM + wr * 64 + fr, col0 = u.pn * BM + wc * 32 + 8 * fq;
#pragma unroll
        for (int ai = 0; ai < 2; ++ai)
#pragma unroll
            for (int m = 0; m < 4; ++m) { bf16_t* rowp = G + (size_t)(row0 + ai * HALF + m * 16) * ldc + col0;
                u32x4 g[2];
#pragma unroll
                for (int bj = 0; bj < 2; ++bj) g[bj] = *(const u32x4*)(rowp + bj * HALF);
#pragma unroll
                for (int bj = 0; bj < 2; ++bj) {
                    if ((g[bj].x | g[bj].y | g[bj].z | g[bj].w) != 0u) {
                        const f32x4 v0 = acc[ai][bj][m][0], v1 = acc[ai][bj][m][1];
                        const f32x2 a = gelu_pk((f32x2){v0[0], v0[1]}), b = gelu_pk((f32x2){v0[2], v0[3]}), c = gelu_pk((f32x2){v1[0], v1[1]}), d = gelu_pk((f32x2){v1[2], v1[3]});
                        u32x4 w;
                        w.x = cvt_pk_bf16(a.x * __uint_as_float(g[bj].x << 16), a.y * __uint_as_float(g[bj].x & 0xffff0000u));
                        w.y = cvt_pk_bf16(b.x * __uint_as_float(g[bj].y << 16), b.y * __uint_as_float(g[bj].y & 0xffff0000u));
                        w.z = cvt_pk_bf16(c.x * __uint_as_float(g[bj].z << 16), c.y * __uint_as_float(g[bj].z & 0xffff0000u));
                        w.w = cvt_pk_bf16(d.x * __uint_as_float(g[bj].w << 16), d.y * __uint_as_float(g[bj].w & 0xffff0000u));
                        *(u32x4*)(rowp + bj * HALF) = w;
                    }
                } }
    }
};
template <int MODE = 0>
struct EpiGate8 {
    static constexpr bool PERM = true, AFTER_DRAIN = false;
    bf16_t* G; unsigned char* A2; int ldc; float hscale, oscale;
    __device__ __forceinline__ void operator()(const f32x4 (&acc)[2][2][4][2], const Unit& u, int wr, int wc, int fr, int fq) const {
        const int row0 = u.pm * BM + wr * 64 + fr, col0 = u.pn * BM + wc * 32 + 8 * fq;
#pragma unroll
        for (int ai = 0; ai < 2; ++ai)
#pragma unroll
            for (int m = 0; m < 4; ++m) { const size_t ro = (size_t)(row0 + ai * HALF + m * 16) * ldc + col0;
                u32x4 g[2];
#pragma unroll
                for (int bj = 0; bj < 2; ++bj) g[bj] = (MODE == 2 || MODE == 3) ? (u32x4){0x3f803f80u, 0x3f803f80u, 0x3f803f80u, 0x3f803f80u} : *(const u32x4*)(G + ro + bj * HALF);
#pragma unroll
                for (int bj = 0; bj < 2; ++bj) {
                    u32x2 w = {0u, 0u};
                    if ((g[bj].x | g[bj].y | g[bj].z | g[bj].w) != 0u) {
                        const f32x4 v0 = acc[ai][bj][m][0] * hscale, v1 = acc[ai][bj][m][1] * hscale;
                        const f32x2 a = MODE == 3 ? (f32x2){v0[0], v0[1]} : gelu_pk((f32x2){v0[0], v0[1]}), b = MODE == 3 ? (f32x2){v0[2], v0[3]} : gelu_pk((f32x2){v0[2], v0[3]}), c = MODE == 3 ? (f32x2){v1[0], v1[1]} : gelu_pk((f32x2){v1[0], v1[1]}), d = MODE == 3 ? (f32x2){v1[2], v1[3]} : gelu_pk((f32x2){v1[2], v1[3]});
                        float y[8] = {a.x * __uint_as_float(g[bj].x << 16), a.y * __uint_as_float(g[bj].x & 0xffff0000u), b.x * __uint_as_float(g[bj].y << 16), b.y * __uint_as_float(g[bj].y & 0xffff0000u),
                                      c.x * __uint_as_float(g[bj].z << 16), c.y * __uint_as_float(g[bj].z & 0xffff0000u), d.x * __uint_as_float(g[bj].w << 16), d.y * __uint_as_float(g[bj].w & 0xffff0000u)};
#pragma unroll
                        for (int k = 0; k < 8; ++k) y[k] = fminf(fmaxf(y[k] * oscale, -440.f), 440.f);
                        int lo = 0, hi = 0;
                        lo = __builtin_amdgcn_cvt_pk_fp8_f32(y[0], y[1], lo, false); lo = __builtin_amdgcn_cvt_pk_fp8_f32(y[2], y[3], lo, true);
                        hi = __builtin_amdgcn_cvt_pk_fp8_f32(y[4], y[5], hi, false); hi = __builtin_amdgcn_cvt_pk_fp8_f32(y[6], y[7], hi, true);
                        w.x = (unsigned)lo; w.y = (unsigned)hi;
                        if (MODE == 0) *(u32x4*)(G + ro + bj * HALF) = (u32x4){0u, 0u, 0u, 0u};
                    }
                    *(u32x2*)(A2 + ro + bj * HALF) = w;
                } }
    }
};

struct EpiGate8C {
    static constexpr bool PERM = true, AFTER_DRAIN = false;
    static constexpr int REC_OFF = STAGE_BYTES, REC_WAVE = 1984, REC_DW = 8, CAP = REC_WAVE / (4 * REC_DW);
    unsigned char* G; unsigned char* A2; int ldc; float hscale, oscale;
    static __device__ __forceinline__ float gdec(unsigned w, int k) { const unsigned b = (w >> (8 * k)) & 255u; return b ? __builtin_amdgcn_exp2f(((float)b - 195.f) * 0.05f) : 0.f; }
    __device__ __forceinline__ void one(unsigned h0, unsigned h1, unsigned h2, unsigned h3, unsigned g0, unsigned g1, unsigned off) const {
        const f32x2 a = gelu_pk((f32x2){__uint_as_float(h0 << 16), __uint_as_float(h0 & 0xffff0000u)}), b = gelu_pk((f32x2){__uint_as_float(h1 << 16), __uint_as_float(h1 & 0xffff0000u)}),
                    c = gelu_pk((f32x2){__uint_as_float(h2 << 16), __uint_as_float(h2 & 0xffff0000u)}), d = gelu_pk((f32x2){__uint_as_float(h3 << 16), __uint_as_float(h3 & 0xffff0000u)});
        float y[8] = {a.x * gdec(g0, 0), a.y * gdec(g0, 1), b.x * gdec(g0, 2), b.y * gdec(g0, 3), c.x * gdec(g1, 0), c.y * gdec(g1, 1), d.x * gdec(g1, 2), d.y * gdec(g1, 3)};
#pragma unroll
        for (int k = 0; k < 8; ++k) y[k] = fminf(fmaxf(y[k] * oscale, -440.f), 440.f);
        int lo = 0, hi = 0;
        lo = __builtin_amdgcn_cvt_pk_fp8_f32(y[0], y[1], lo, false); lo = __builtin_amdgcn_cvt_pk_fp8_f32(y[2], y[3], lo, true);
        hi = __builtin_amdgcn_cvt_pk_fp8_f32(y[4], y[5], hi, false); hi = __builtin_amdgcn_cvt_pk_fp8_f32(y[6], y[7], hi, true);
        *(u32x2*)(A2 + off) = (u32x2){(unsigned)lo, (unsigned)hi};
        *(u32x2*)(G + off) = (u32x2){0u, 0u};
    }
    __device__ __forceinline__ void flush(PG8_LAS unsigned* rec, int cnt, int lane) const {
        asm volatile("s_waitcnt lgkmcnt(0)" ::: "memory");
        if (lane < cnt) { const PG8_LAS unsigned* r = rec + lane * REC_DW;
            const u32x4 hh = *(const PG8_LAS u32x4*)r; const u32x2 gg = *(const PG8_LAS u32x2*)(r + 4); const unsigned off = r[6];
            one(hh.x, hh.y, hh.z, hh.w, gg.x, gg.y, off); }
        asm volatile("s_waitcnt lgkmcnt(0)" ::: "memory");
    }
    __device__ __forceinline__ void operator()(const f32x4 (&acc)[2][2][4][2], const Unit& u, int wr, int wc, int fr, int fq) const {
        extern __shared__ __attribute__((aligned(16))) char pg8_lds_sym[];
        const int lane = fq * 16 + fr;
        PG8_LAS unsigned* rec = (PG8_LAS unsigned*)((PG8_LAS char*)pg8_lds_sym + REC_OFF + (wr * 4 + wc) * REC_WAVE);
        const int row0 = u.pm * BM + wr * 64 + fr, col0 = u.pn * BM + wc * 32 + 8 * fq;
        int cnt = 0;
#pragma unroll
        for (int ai = 0; ai < 2; ++ai) {
            u32x2 gall[4][2];
#pragma unroll
            for (int m = 0; m < 4; ++m) { const unsigned ro = (unsigned)(row0 + ai * HALF + m * 16) * (unsigned)ldc + (unsigned)col0;
#pragma unroll
                for (int bj = 0; bj < 2; ++bj) gall[m][bj] = *(const u32x2*)(G + ro + bj * HALF); }
            asm volatile("" ::: "memory");
#pragma unroll
            for (int m = 0; m < 4; ++m) { const unsigned ro = (unsigned)(row0 + ai * HALF + m * 16) * (unsigned)ldc + (unsigned)col0;
#pragma unroll
                for (int bj = 0; bj < 2; ++bj) { const u32x2 g = gall[m][bj];
                    const bool nz = (g.x | g.y) != 0u;
                    const unsigned long long bal = __builtin_amdgcn_ballot_w64(nz);
                    const int np = __builtin_popcountll(bal);
                    if (np > CAP) {
                        if (nz) { const f32x4 v0 = acc[ai][bj][m][0] * hscale, v1 = acc[ai][bj][m][1] * hscale;
                            one(cvt_pk_bf16(v0[0], v0[1]), cvt_pk_bf16(v0[2], v0[3]), cvt_pk_bf16(v1[0], v1[1]), cvt_pk_bf16(v1[2], v1[3]), g.x, g.y, ro + bj * HALF); }
                        else *(u32x2*)(A2 + ro + bj * HALF) = (u32x2){0u, 0u};
                        continue; }
                    if (cnt + np > CAP) { flush(rec, cnt, lane); cnt = 0; }
                    if (nz) { const int slot = cnt + (int)__builtin_amdgcn_mbcnt_hi((unsigned)(bal >> 32), __builtin_amdgcn_mbcnt_lo((unsigned)bal, 0u));
                        const f32x4 v0 = acc[ai][bj][m][0] * hscale, v1 = acc[ai][bj][m][1] * hscale;
                        PG8_LAS unsigned* r = rec + slot * REC_DW;
                        *(PG8_LAS u32x4*)r = (u32x4){cvt_pk_bf16(v0[0], v0[1]), cvt_pk_bf16(v0[2], v0[3]), cvt_pk_bf16(v1[0], v1[1]), cvt_pk_bf16(v1[2], v1[3])}; *(PG8_LAS u32x2*)(r + 4) = g; r[6] = ro + bj * HALF; }
                    else *(u32x2*)(A2 + ro + bj * HALF) = (u32x2){0u, 0u};
                    cnt += np;
                } }
        }
        flush(rec, cnt, lane);
    }
};

struct EpiHead {
    static constexpr bool PERM = true, AFTER_DRAIN = false;
    static constexpr int RED_OFF = STAGE_BYTES;
    bf16_t* Kh; bf16_t* Qh; bf16_t* Vh; const float* kg; const float* qg; float scale;
    __device__ __forceinline__ void operator()(const f32x4 (&acc)[2][2][4][2], const Unit& u, int wr, int wc, int fr, int fq) const {
        extern __shared__ __attribute__((aligned(16))) char pg8_lds_sym[];
        const int colt = u.pn * BM, row0 = u.pm * BM + wr * 64 + fr, cw = wc * 32 + 8 * fq;
        if (colt >= 8192) {
            const int head0 = (colt - 8192) >> 7;
#pragma unroll
            for (int ai = 0; ai < 2; ++ai)
#pragma unroll
                for (int m = 0; m < 4; ++m) { const int t = row0 + ai * HALF + m * 16, b = t >> 12, sq = t & 4095;
#pragma unroll
                    for (int bj = 0; bj < 2; ++bj) { const f32x4 v0 = acc[ai][bj][m][0] * scale, v1 = acc[ai][bj][m][1] * scale;
                        u32x4 w; w.x = cvt_pk_bf16(v0[0], v0[1]); w.y = cvt_pk_bf16(v0[2], v0[3]); w.z = cvt_pk_bf16(v1[0], v1[1]); w.w = cvt_pk_bf16(v1[2], v1[3]);
                        *(u32x4*)(Vh + ((size_t)(b * 32 + head0 + bj) * SEQ + sq) * 128 + cw) = w; } }
            return; }
        PG8_LAS float* red = (PG8_LAS float*)((PG8_LAS char*)pg8_lds_sym + RED_OFF);
#pragma unroll
        for (int ai = 0; ai < 2; ++ai)
#pragma unroll
            for (int m = 0; m < 4; ++m)
#pragma unroll
                for (int bj = 0; bj < 2; ++bj) { const f32x4 v0 = acc[ai][bj][m][0] * scale, v1 = acc[ai][bj][m][1] * scale;
                    float s = (v0[0] * v0[0] + v0[1] * v0[1]) + (v0[2] * v0[2] + v0[3] * v0[3]) + (v1[0] * v1[0] + v1[1] * v1[1]) + (v1[2] * v1[2] + v1[3] * v1[3]);
                    s += __shfl_xor(s, 16); s += __shfl_xor(s, 32);
                    if (fq == 0) red[(((((wr * 4 + wc) * 2 + ai) * 4 + m) * 2 + bj) << 4) + fr] = s; }
        asm volatile("s_waitcnt lgkmcnt(0)\n\ts_barrier" ::: "memory");
        const bool isq = colt >= 4096; const float* gp = (isq ? qg : kg) + cw; const f32x4 g0 = *(const f32x4*)gp, g1 = *(const f32x4*)(gp + 4);
        bf16_t* dsth = isq ? Qh : Kh; const int head0 = ((isq ? colt - 4096 : colt) >> 7);
#pragma unroll
        for (int ai = 0; ai < 2; ++ai)
#pragma unroll
            for (int m = 0; m < 4; ++m) { const int t = row0 + ai * HALF + m * 16, b = t >> 12, sq = t & 4095;
#pragma unroll
                for (int bj = 0; bj < 2; ++bj) {
                    float tot = 0.f;
#pragma unroll
                    for (int w = 0; w < 4; ++w) tot += red[(((((wr * 4 + w) * 2 + ai) * 4 + m) * 2 + bj) << 4) + fr];
                    const float rn = __builtin_amdgcn_rsqf(tot * (1.f / 128.f) + EPS) * scale;
                    const f32x4 v0 = acc[ai][bj][m][0] * rn * g0, v1 = acc[ai][bj][m][1] * rn * g1;
                    u32x4 w8; w8.x = cvt_pk_bf16(v0[0], v0[1]); w8.y = cvt_pk_bf16(v0[2], v0[3]); w8.z = cvt_pk_bf16(v1[0], v1[1]); w8.w = cvt_pk_bf16(v1[2], v1[3]);
                    *(u32x4*)(dsth + ((size_t)(b * 32 + head0 + bj) * SEQ + sq) * 128 + cw) = w8; } }
    }
};

template <bool IB, bool OB> struct EpiResB {
    static constexpr bool PERM = true, AFTER_DRAIN = false;
    const void* base; void* out; int ldc; float scale;
    __device__ __forceinline__ void operator()(const f32x4 (&acc)[2][2][4][2], const Unit& u, int wr, int wc, int fr, int fq) const {
        const int row0 = u.pm * BM + wr * 64 + fr, col0 = u.pn * BM + wc * 32 + 8 * fq;
#pragma unroll
        for (int ai = 0; ai < 2; ++ai)
#pragma unroll
            for (int m = 0; m < 4; ++m) { const size_t off = (size_t)(row0 + ai * HALF + m * 16) * ldc + col0;
                f32x4 b0[2], b1[2];
#pragma unroll
                for (int bj = 0; bj < 2; ++bj) {
                    if (IB) { const u32x4 r = *(const u32x4*)((const bf16_t*)base + off + bj * HALF);
                        b0[bj] = (f32x4){__uint_as_float(r.x << 16), __uint_as_float(r.x & 0xffff0000u), __uint_as_float(r.y << 16), __uint_as_float(r.y & 0xffff0000u)};
                        b1[bj] = (f32x4){__uint_as_float(r.z << 16), __uint_as_float(r.z & 0xffff0000u), __uint_as_float(r.w << 16), __uint_as_float(r.w & 0xffff0000u)}; }
                    else { b0[bj] = *(const f32x4*)((const float*)base + off + bj * HALF); b1[bj] = *(const f32x4*)((const float*)base + off + bj * HALF + 4); } }
#pragma unroll
                for (int bj = 0; bj < 2; ++bj) { const f32x4 v0 = b0[bj] + acc[ai][bj][m][0] * scale, v1 = b1[bj] + acc[ai][bj][m][1] * scale;
                    if (OB) { u32x4 w; w.x = cvt_pk_bf16(v0[0], v0[1]); w.y = cvt_pk_bf16(v0[2], v0[3]); w.z = cvt_pk_bf16(v1[0], v1[1]); w.w = cvt_pk_bf16(v1[2], v1[3]);
                        *(u32x4*)((bf16_t*)out + off + bj * HALF) = w; }
                    else { *(f32x4*)((float*)out + off + bj * HALF) = v0; *(f32x4*)((float*)out + off + bj * HALF + 4) = v1; } }
                asm volatile("" ::: "memory"); }
    }
};

struct EpiBf16R {
    static constexpr bool PERM = true, AFTER_DRAIN = false;
    bf16_t* O; int ldc; const float* rs;
    __device__ __forceinline__ void operator()(const f32x4 (&acc)[2][2][4][2], const Unit& u, int wr, int wc, int fr, int fq) const {
        const int row0 = u.pm * BM + wr * 64 + fr, col0 = u.pn * BM + wc * 32 + 8 * fq;
#pragma unroll
        for (int ai = 0; ai < 2; ++ai)
#pragma unroll
            for (int m = 0; m < 4; ++m) { const int row = row0 + ai * HALF + m * 16; const float r = rs[row]; bf16_t* rowp = O + (size_t)row * ldc + col0;
#pragma unroll
                for (int bj = 0; bj < 2; ++bj) { const f32x4 v0 = acc[ai][bj][m][0] * r, v1 = acc[ai][bj][m][1] * r;
                    u32x4 w; w.x = cvt_pk_bf16(v0[0], v0[1]); w.y = cvt_pk_bf16(v0[2], v0[3]); w.z = cvt_pk_bf16(v1[0], v1[1]); w.w = cvt_pk_bf16(v1[2], v1[3]);
                    *(u32x4*)(rowp + bj * HALF) = w; } }
    }
};
template <class Epi, class Sched, bool ALIGN_EPI = false, bool SP2 = false, bool F8 = false>
__device__ __forceinline__ void gemm_phase(PG8_LAS unsigned char* lds, const Gemm g, const Sched& S, const Epi& E) {
    const int tid = threadIdx.x, wid = __builtin_amdgcn_readfirstlane(tid >> 6), lane = tid & 63, wr = wid >> 2, wc = wid & 3, fr = lane & 15, fq = lane >> 4;
    const int K = g.K, nt = K / BK;
    unsigned voffA[2], voffB[2];
#pragma unroll
    for (int i = 0; i < 2; ++i) { int R, C; stage_rc(tid * 16 + i * 8192, R, C); const int Rb = Epi::PERM ? ((R & ~31) + perm32(R & 31)) : R;
        voffA[i] = (unsigned)(R * K + C) * 2u; voffB[i] = (unsigned)(Rb * K + C) * 2u; }
    const size_t kstep = (size_t)(BK * 2);
    const size_t hstep = (size_t)HALF * K * 2;
    const size_t tstep = 2 * hstep;
    const unsigned ldsw = (unsigned)wid * 1024u;
    const int aoff = lds_byte(wr * 64 + fr, fq * 8), boff = lds_byte(wc * 32 + fr, fq * 8);
#define PG8_SA(b, h) (((b) * 2 + (h)) * HTB)
#define PG8_SB(b, h) ((4 + (b) * 2 + (h)) * HTB)
#define PG8_STAGE(bufoff, gbase, voff) do { _Pragma("unroll") for (int _i = 0; _i < 2; ++_i) \
        __builtin_amdgcn_global_load_lds((const unsigned*)((const char*)(gbase) + (voff)[_i]), (PG8_LAS unsigned*)(lds + (bufoff) + ldsw + _i * 8192), 16, 0, 0); } while (0)
#define PG8_LDA(dst, b, h) do { if constexpr (F8) { _Pragma("unroll") for (int m = 0; m < 4; ++m) { const i32x4 lo_ = *(const PG8_LAS i32x4*)(lds + PG8_SA(b, h) + aoff + m * 2048), hi_ = *(const PG8_LAS i32x4*)(lds + PG8_SA(b, h) + aoff + m * 2048 + 1024); \
        dst##_8[m] = __builtin_shufflevector(lo_, hi_, 0, 1, 2, 3, 4, 5, 6, 7); } } else { _Pragma("unroll") for (int m = 0; m < 4; ++m) _Pragma("unroll") for (int k = 0; k < 2; ++k) dst[m][k] = *(const PG8_LAS bf16x8*)(lds + PG8_SA(b, h) + aoff + m * 2048 + k * 1024); } } while (0)
#define PG8_LDB(dst, b, h) do { if constexpr (F8) { _Pragma("unroll") for (int n = 0; n < 2; ++n) { const i32x4 lo_ = *(const PG8_LAS i32x4*)(lds + PG8_SB(b, h) + boff + n * 2048), hi_ = *(const PG8_LAS i32x4*)(lds + PG8_SB(b, h) + boff + n * 2048 + 1024); \
        dst##_8[n] = __builtin_shufflevector(lo_, hi_, 0, 1, 2, 3, 4, 5, 6, 7); } } else { _Pragma("unroll") for (int n = 0; n < 2; ++n) _Pragma("unroll") for (int k = 0; k < 2; ++k) dst[n][k] = *(const PG8_LAS bf16x8*)(lds + PG8_SB(b, h) + boff + n * 2048 + k * 1024); } } while (0)
#define PG8_MMA(ai, bj, At, Bt) do { __builtin_amdgcn_s_setprio(1); if constexpr (F8) { _Pragma("unroll") for (int m = 0; m < 4; ++m) _Pragma("unroll") for (int n = 0; n < 2; ++n) \
        asm volatile("v_mfma_f32_16x16x128_f8f6f4 %0, %1, %2, %0" : "+v"(acc[ai][bj][m][n]) : "v"(Bt##_8[n]), "v"(At##_8[m])); } \
    else { _Pragma("unroll") for (int m = 0; m < 4; ++m) _Pragma("unroll") for (int n = 0; n < 2; ++n) _Pragma("unroll") for (int k = 0; k < 2; ++k) \
        acc[ai][bj][m][n] = __builtin_amdgcn_mfma_f32_16x16x32_bf16(Bt[n][k], At[m][k], acc[ai][bj][m][n], 0, 0, 0); } __builtin_amdgcn_s_setprio(0); } while (0)
#define PG8_WAIT_V(n) asm volatile("s_waitcnt vmcnt(" #n ")" ::: "memory")
#define PG8_WAIT_L(n) asm volatile("s_waitcnt lgkmcnt(" #n ")" ::: "memory")
#define PG8_BAR __builtin_amdgcn_s_barrier()
#define PG8_SCHED __builtin_amdgcn_sched_barrier(0)
    Unit cur, nxt; int ui = 0;
    if (!S.next(0, cur)) return;
    f32x4 acc[2][2][4][2];
#pragma unroll
    for (int a = 0; a < 2; ++a)
#pragma unroll
        for (int b = 0; b < 2; ++b)
#pragma unroll
            for (int m = 0; m < 4; ++m)
#pragma unroll
                for (int n = 0; n < 2; ++n) acc[a][b][m][n] = (f32x4){0.f, 0.f, 0.f, 0.f};
    const int f8_scale_one = 0x7F7F7F7F;
    bf16x8 At[4][2], B0[2][2], B1[2][2]; i32x8 At_8[4], B0_8[2], B1_8[2];
    const char* cA = (const char*)g.A + (size_t)cur.pm * tstep; const char* cB = (const char*)g.Bt + (size_t)cur.pn * tstep;
    S.a_ready(cur);
    if constexpr (SP2) {
        PG8_STAGE(PG8_SB(0, 0), cB, voffB); PG8_STAGE(PG8_SB(0, 1), cB + hstep, voffB); PG8_STAGE(PG8_SA(0, 0), cA, voffA); PG8_STAGE(PG8_SA(0, 1), cA + hstep, voffA);
        if (wr == 1) PG8_BAR;
        PG8_WAIT_V(2); PG8_BAR;
        PG8_STAGE(PG8_SB(1, 0), cB + kstep, voffB); PG8_STAGE(PG8_SA(1, 0), cA + kstep, voffA); PG8_STAGE(PG8_SB(1, 1), cB + hstep + kstep, voffB);
        PG8_WAIT_V(6); PG8_BAR;
    } else {
        PG8_STAGE(PG8_SB(0, 0), cB, voffB); PG8_STAGE(PG8_SA(0, 0), cA, voffA); PG8_STAGE(PG8_SB(0, 1), cB + hstep, voffB); PG8_STAGE(PG8_SA(0, 1), cA + hstep, voffA);
        if (wr == 1) PG8_BAR;
        PG8_WAIT_V(4); PG8_BAR;
        PG8_STAGE(PG8_SB(1, 0), cB + kstep, voffB); PG8_STAGE(PG8_SA(1, 0), cA + kstep, voffA); PG8_STAGE(PG8_SB(1, 1), cB + hstep + kstep, voffB);
        PG8_WAIT_V(6); PG8_BAR;
    }
    for (;;) {
        const bool has_next = S.next(ui + 1, nxt);
        const char* nA = has_next ? (const char*)g.A + (size_t)nxt.pm * tstep : cA; const char* nB = has_next ? (const char*)g.Bt + (size_t)nxt.pn * tstep : cB;
        for (int t = 0; t < nt; t += 2) {
            const bool last = (t == nt - 2);
            const char* a1 = cA + (size_t)(t + 1) * kstep;
            const char* a2 = last ? nA : cA + (size_t)(t + 2) * kstep; const char* b2 = last ? nB : cB + (size_t)(t + 2) * kstep;
            const char* a3 = a2 + kstep; const char* b3 = b2 + kstep;
            if (last && has_next) S.a_ready(nxt);
            if constexpr (SP2) {
            PG8_LDB(B0, 0, 0); PG8_LDB(B1, 0, 1); PG8_SCHED; PG8_LDA(At, 0, 0); PG8_STAGE(PG8_SA(1, 1), a1 + hstep, voffA);
            PG8_WAIT_V(8); PG8_WAIT_L(0); PG8_BAR; PG8_MMA(0, 0, At, B0); PG8_MMA(0, 1, At, B1); PG8_BAR; PG8_SCHED;
            PG8_LDA(At, 0, 1); PG8_STAGE(PG8_SB(0, 0), b2, voffB); PG8_STAGE(PG8_SB(0, 1), b2 + hstep, voffB); PG8_STAGE(PG8_SA(0, 0), a2, voffA);
            PG8_WAIT_V(8); PG8_WAIT_L(0); PG8_BAR; PG8_MMA(1, 0, At, B0); PG8_MMA(1, 1, At, B1); PG8_BAR; PG8_SCHED;
            PG8_LDB(B0, 1, 0); PG8_LDB(B1, 1, 1); PG8_SCHED; PG8_LDA(At, 1, 0); PG8_STAGE(PG8_SA(0, 1), a2 + hstep, voffA);
            PG8_WAIT_V(8); PG8_WAIT_L(0); PG8_BAR; PG8_MMA(0, 0, At, B0); PG8_MMA(0, 1, At, B1); PG8_BAR; PG8_SCHED;
            PG8_LDA(At, 1, 1); PG8_STAGE(PG8_SB(1, 0), b3, voffB); PG8_STAGE(PG8_SB(1, 1), b3 + hstep, voffB); PG8_STAGE(PG8_SA(1, 0), a3, voffA);
            PG8_WAIT_V(8); PG8_WAIT_L(0); PG8_BAR; PG8_MMA(1, 0, At, B0); PG8_MMA(1, 1, At, B1); PG8_BAR; PG8_SCHED;
            } else {
            PG8_LDB(B0, 0, 0); PG8_SCHED; PG8_LDA(At, 0, 0); PG8_STAGE(PG8_SA(1, 1), a1 + hstep, voffA);
            PG8_WAIT_L(8); PG8_BAR; PG8_WAIT_L(0); PG8_MMA(0, 0, At, B0); PG8_BAR; PG8_SCHED;
            PG8_LDB(B1, 0, 1); PG8_STAGE(PG8_SB(0, 0), b2, voffB);
            PG8_BAR; PG8_WAIT_L(0); PG8_MMA(0, 1, At, B1); PG8_BAR;
            PG8_LDA(At, 0, 1); PG8_STAGE(PG8_SA(0, 0), a2, voffA);
            PG8_BAR; PG8_WAIT_L(0); PG8_MMA(1, 0, At, B0); PG8_BAR; PG8_SCHED;
            PG8_STAGE(PG8_SB(0, 1), b2 + hstep, voffB);
            PG8_WAIT_V(6); PG8_BAR; PG8_MMA(1, 1, At, B1); PG8_BAR;
            PG8_LDB(B0, 1, 0); PG8_SCHED; PG8_LDA(At, 1, 0); PG8_STAGE(PG8_SA(0, 1), a2 + hstep, voffA);
            PG8_WAIT_L(8); PG8_BAR; PG8_WAIT_L(0); PG8_MMA(0, 0, At, B0); PG8_BAR; PG8_SCHED;
            PG8_LDB(B1, 1, 1); PG8_STAGE(PG8_SB(1, 0), b3, voffB);
            PG8_BAR; PG8_WAIT_L(0); PG8_MMA(0, 1, At, B1); PG8_BAR;
            PG8_LDA(At, 1, 1); PG8_STAGE(PG8_SA(1, 0), a3, voffA);
            PG8_BAR; PG8_WAIT_L(0); PG8_MMA(1, 0, At, B0); PG8_BAR; PG8_SCHED;
            PG8_STAGE(PG8_SB(1, 1), b3 + hstep, voffB);
            PG8_WAIT_V(6); PG8_BAR; PG8_MMA(1, 1, At, B1); PG8_BAR;
            }
        }
        if constexpr (ALIGN_EPI) { if (wr == 0) PG8_BAR; }
        if constexpr (!Epi::AFTER_DRAIN) { E(acc, cur, wr, wc, fr, fq); S.done(cur); }
        if (!has_next) break;
#pragma unroll
        for (int a = 0; a < 2; ++a)
#pragma unroll
            for (int b = 0; b < 2; ++b)
#pragma unroll
                for (int m = 0; m < 4; ++m)
#pragma unroll
                    for (int n = 0; n < 2; ++n) acc[a][b][m][n] = (f32x4){0.f, 0.f, 0.f, 0.f};
        cur = nxt; cA = nA; cB = nB; ++ui;
        if constexpr (ALIGN_EPI) { if (wr == 1) PG8_BAR; }
    }
    PG8_WAIT_V(0);
    if constexpr (!ALIGN_EPI) { if (wr == 0) PG8_BAR; }
    PG8_BAR;
    if constexpr (Epi::AFTER_DRAIN) { E.fused(acc, cur, wr, wc, fr, fq, lds, wid, lane); S.done(cur); }
#undef PG8_SA
#undef PG8_SB
#undef PG8_STAGE
#undef PG8_LDA
#undef PG8_LDB
#undef PG8_MMA
#undef PG8_WAIT_V
#undef PG8_WAIT_L
#undef PG8_BAR
#undef PG8_SCHED
}
}
namespace att {
constexpr int D = 128;
#if F8_KVQ == 1
constexpr int VSTR = 12288;
#else
constexpr int VSTR = 128;
#endif
constexpr int WINDOW = 4096;
constexpr float THR = 8.f;
constexpr bool WSKIP = false;
constexpr float SCALE = 0.08838834764831845f;
constexpr int NW = 8, QBLK = 32, KVBLK = 64, QB = NW * QBLK;
constexpr int SHM_V = KVBLK * D * 2, SHM_K = KVBLK * D * 2;
constexpr int LDS_BYTES = 2 * SHM_V + 2 * SHM_K + NW * 64 * 4;
using bf16 = __hip_bfloat16;
typedef short bf16x8 __attribute__((ext_vector_type(8)));
typedef short s16x4 __attribute__((ext_vector_type(4)));
typedef float f32x16 __attribute__((ext_vector_type(16)));
typedef float f32x4 __attribute__((ext_vector_type(4)));
typedef unsigned u32x4 __attribute__((ext_vector_type(4)));
template <class A, class Bt> struct same_t { static constexpr bool v = false; };
template <class A> struct same_t<A, A> { static constexpr bool v = true; };

#define KSWZ(row, colB) ((row) * 256 + ((colB) ^ (((row) & 7) << 4)))
#define SBAR() __builtin_amdgcn_sched_barrier(0)
__device__ __forceinline__ int v_st(int k, int c) { const int kk = (k & ~0xC) | ((k & 4) << 1) | ((k & 8) >> 1); return ((kk >> 3) * 4 + (c >> 5)) * 512 + ((kk & 7) * 32 + (c & 31)) * 2; }
__device__ __forceinline__ int v_rd_base(int lane) { return ((lane & 3) << 3) | (((lane >> 2) & 3) << 6) | (((lane >> 4) & 1) << 5) | (((lane >> 5) & 1) << 8); }
constexpr int v_rd_off(int d0, int ks, int half) { return d0 * 512 + ks * 4096 + half * 2048; }
__device__ __forceinline__ int crow(int r, int hi) { return (r & 3) + 8 * (r >> 2) + 4 * hi; }
__device__ __forceinline__ unsigned cvtpk(float lo, float hi) {
    unsigned r; asm volatile("v_cvt_pk_bf16_f32 %0, %1, %2" : "=v"(r) : "v"(lo), "v"(hi)); return r;
}
__device__ __forceinline__ bf16x8 pack8(f32x4 a, f32x4 b) {
    u32x4 w = {cvtpk(a[0], a[1]), cvtpk(a[2], a[3]), cvtpk(b[0], b[1]), cvtpk(b[2], b[3])};
    return *reinterpret_cast<bf16x8*>(&w);
}
template <class T> __device__ __forceinline__ bf16x8 load8(const T* p) {
    if constexpr (same_t<T, float>::v) { return pack8(*(const f32x4*)p, *(const f32x4*)(p + 4)); }
    else { return *reinterpret_cast<const bf16x8*>(p); }
}
__device__ __forceinline__ void mask_tile(f32x16& p0, f32x16& p1, int dq, unsigned W) {
    const float NEG = -__builtin_inff();
#pragma unroll
    for (int r = 0; r < 16; ++r) {
        const int c = (r & 3) + 8 * (r >> 2);
        if ((unsigned)(dq - c) >= W) p0[r] = NEG;
        if ((unsigned)(dq - c - 32) >= W) p1[r] = NEG;
    }
}
__device__ __forceinline__ void partialSM(f32x16& p0, f32x16& p1, float& m_reg, float& mn, float& alpha) {
    float pmax = p0[0]; for (int r = 1; r < 16; ++r) pmax = fmaxf(pmax, p0[r]); for (int r = 0; r < 16; ++r) pmax = fmaxf(pmax, p1[r]);
    { auto rr = __builtin_amdgcn_permlane32_swap(__float_as_uint(pmax), __float_as_uint(pmax), false, false);
      pmax = fmaxf(__uint_as_float(rr[0]), __uint_as_float(rr[1])); }
    constexpr float C2 = 1.4426950408889634f * SCALE;
    if (__builtin_expect(__all((pmax - m_reg) * SCALE <= THR), 1)) { mn = m_reg; alpha = 1.f; }
    else { mn = fmaxf(m_reg, pmax); alpha = __builtin_amdgcn_exp2f((m_reg - mn) * C2); m_reg = mn; }
    const float mnL = -mn * C2;
    for (int r = 0; r < 16; ++r) p0[r] = fmaf(p0[r], C2, mnL); for (int r = 0; r < 16; ++r) p1[r] = fmaf(p1[r], C2, mnL);
    for (int r = 0; r < 16; ++r) p0[r] = __builtin_amdgcn_exp2f(p0[r]);
}
__device__ __forceinline__ void finishSM(f32x16& p0, f32x16& p1, float alpha, float& l_reg, bf16x8& pa0, bf16x8& pa1, bf16x8& pa2, bf16x8& pa3) {
    for (int r = 0; r < 16; ++r) p1[r] = __builtin_amdgcn_exp2f(p1[r]);
    float ps = 0; for (int r = 0; r < 16; ++r) ps += p0[r]; for (int r = 0; r < 16; ++r) ps += p1[r];
    { auto rr = __builtin_amdgcn_permlane32_swap(__float_as_uint(ps), __float_as_uint(ps), false, false);
      ps = __uint_as_float(rr[0]) + __uint_as_float(rr[1]); }
    l_reg = l_reg * alpha + ps;
#define PK4(P, B_, OUT) do { unsigned a0 = cvtpk(P[B_+0], P[B_+1]), a1 = cvtpk(P[B_+2], P[B_+3]);                          \
        unsigned b0 = cvtpk(P[B_+4], P[B_+5]), b1 = cvtpk(P[B_+6], P[B_+7]);                                             \
        auto r0 = __builtin_amdgcn_permlane32_swap(a0, b0, false, false); auto r1 = __builtin_amdgcn_permlane32_swap(a1, b1, false, false); \
        u32x4 w = {r0[0], r1[0], r0[1], r1[1]}; OUT = *reinterpret_cast<bf16x8*>(&w); } while (0)
    PK4(p0, 0, pa0); PK4(p0, 8, pa1); PK4(p1, 0, pa2); PK4(p1, 8, pa3);
#undef PK4
}
template <int KB, bool SK>
__device__ __forceinline__ void qkt(f32x16& p0, f32x16& p1, const char* K_lds, int r32, int hi, const bf16x8* qr, bool act) {
    if (SK && !act) { const float NEG = -__builtin_inff();
#pragma unroll
        for (int r = 0; r < 16; ++r) { p0[r] = NEG; p1[r] = NEG; } return; }
    p0 = f32x16{}; p1 = f32x16{};
    const char* kb[4];
#pragma unroll
    for (int dd = 0; dd < 4; ++dd) kb[dd] = K_lds + KB * SHM_K + KSWZ(r32, (dd * 16 + hi * 8) * 2);
#pragma unroll
    for (int d0 = 0; d0 < 8; ++d0) { const char* a = kb[d0 & 3] + (d0 >> 2) * 128;
        bf16x8 b0 = *reinterpret_cast<const bf16x8*>(a);
        bf16x8 b1 = *reinterpret_cast<const bf16x8*>(a + 32 * 256);
        p0 = __builtin_amdgcn_mfma_f32_32x32x16_bf16(b0, qr[d0], p0, 0, 0, 0);
        p1 = __builtin_amdgcn_mfma_f32_32x32x16_bf16(b1, qr[d0], p1, 0, 0, 0); }
}
template <int VB, bool SK>
__device__ __forceinline__ void pv_tile(f32x16* o, int vb0, bf16x8 pa0, bf16x8 pa1, bf16x8 pa2, bf16x8 pa3, bool act) {
    if (SK && !act) return;
#define TRRD(dst, off) asm volatile("ds_read_b64_tr_b16 %0, %1 offset:%2" : "=&v"(dst) : "v"(vb0), "i"(off) : "memory")
#define PV_D0(d0) do { s16x4 l0, l1, l2, l3, h0, h1, h2, h3; constexpr int b_ = VB * SHM_V + v_rd_off(d0, 0, 0);     \
        TRRD(l0, b_); TRRD(h0, b_ + 2048); TRRD(l1, b_ + 4096); TRRD(h1, b_ + 6144); TRRD(l2, b_ + 8192); TRRD(h2, b_ + 10240); TRRD(l3, b_ + 12288); TRRD(h3, b_ + 14336); \
        asm volatile("s_waitcnt lgkmcnt(0)" ::: "memory"); SBAR();                 \
        o[d0] = __builtin_amdgcn_mfma_f32_32x32x16_bf16(pa0, (bf16x8){l0[0], l0[1], l0[2], l0[3], h0[0], h0[1], h0[2], h0[3]}, o[d0], 0, 0, 0);   \
        o[d0] = __builtin_amdgcn_mfma_f32_32x32x16_bf16(pa1, (bf16x8){l1[0], l1[1], l1[2], l1[3], h1[0], h1[1], h1[2], h1[3]}, o[d0], 0, 0, 0);   \
        o[d0] = __builtin_amdgcn_mfma_f32_32x32x16_bf16(pa2, (bf16x8){l2[0], l2[1], l2[2], l2[3], h2[0], h2[1], h2[2], h2[3]}, o[d0], 0, 0, 0);   \
        o[d0] = __builtin_amdgcn_mfma_f32_32x32x16_bf16(pa3, (bf16x8){l3[0], l3[1], l3[2], l3[3], h3[0], h3[1], h3[2], h3[3]}, o[d0], 0, 0, 0); } while (0)
    PV_D0(0); PV_D0(1); PV_D0(2); PV_D0(3);
#undef PV_D0
#undef TRRD
}

template <class TIn, class TOut> struct BlockRef { const TIn* Q; const TIn* K; const TIn* V; TOut* O; int P0; };
template <class TIn> struct Seam {
    bf16x8 qr[8];
    bf16x8 st_v0, st_v1, st_k0, st_k1; f32x4 sf0, sf1, sf2, sf3;
    f32x4 tq[16];
};
__device__ __forceinline__ int swa_jlo(int P0, int W) { const int lowk = P0 - W + 1; return lowk > 0 ? lowk / KVBLK : 0; }
#define ROW(p, k0, rr) ((p) + (size_t)((k0) + (rr)) * D + sc)
#define ROWV(p, k0, rr) ((p) + (size_t)((k0) + (rr)) * VSTR + sc)
#define VMW() asm volatile("s_waitcnt vmcnt(0)" ::: "memory")
#define VMWN(n) asm volatile("s_waitcnt vmcnt(%0)" :: "i"(n) : "memory")
#define SLOAD_H(Kp, Vp, k0) do { S.st_v0 = load8<TIn>(ROWV(Vp, k0, sr)); S.st_v1 = load8<TIn>(ROWV(Vp, k0, 32 + sr));              \
                         S.st_k0 = load8<TIn>(ROW(Kp, k0, sr)); S.st_k1 = load8<TIn>(ROW(Kp, k0, 32 + sr)); } while (0)
#define SWRITE_HK(bf) do { *(bf16x8*)(K_lds + (bf) * SHM_K + kws) = S.st_k0; *(bf16x8*)(K_lds + (bf) * SHM_K + kws + 32 * 256) = S.st_k1; } while (0)
#define SWRITE_HV(bf) do { *(bf16x8*)(V_lds + (bf) * SHM_V + vst0) = S.st_v0; *(bf16x8*)(V_lds + (bf) * SHM_V + vst1) = S.st_v1; } while (0)
#define SWRITE_H(bf) do { SWRITE_HV(bf); SWRITE_HK(bf); } while (0)
#define SLOAD_F(p, k0) do { S.sf0 = *(const f32x4*)ROW(p, k0, sr); S.sf1 = *(const f32x4*)(ROW(p, k0, sr) + 4);                \
                            S.sf2 = *(const f32x4*)ROW(p, k0, 32 + sr); S.sf3 = *(const f32x4*)(ROW(p, k0, 32 + sr) + 4); } while (0)
#define SWRITE_KF(bf) do { *(bf16x8*)(K_lds + (bf) * SHM_K + kws) = pack8(S.sf0, S.sf1); *(bf16x8*)(K_lds + (bf) * SHM_K + kws + 32 * 256) = pack8(S.sf2, S.sf3); } while (0)
#define SWRITE_VF(bf) do { *(bf16x8*)(V_lds + (bf) * SHM_V + vst0) = pack8(S.sf0, S.sf1); *(bf16x8*)(V_lds + (bf) * SHM_V + vst1) = pack8(S.sf2, S.sf3); } while (0)
template <class TIn, class TOut>
__device__ __forceinline__ void causal_swa_prime(const BlockRef<TIn, TOut>& cur, int W, char* lds, Seam<TIn>& S) {
    constexpr bool F32 = same_t<TIn, float>::v;
    const int tid = threadIdx.x, wid = __builtin_amdgcn_readfirstlane(tid >> 6), lane = tid & 63, r32 = lane & 31, hi = lane >> 5;
    const int sr = tid >> 4, sc = (tid & 15) * 8, kws = KSWZ(sr, sc * 2); char* K_lds = lds + 2 * SHM_V;
    const int kb0 = swa_jlo(cur.P0, W) * KVBLK;
    for (int d0 = 0; d0 < 8; ++d0) S.qr[d0] = load8<TIn>(cur.Q + (size_t)(wid * QBLK + r32) * D + d0 * 16 + hi * 8);
    if constexpr (F32) { SLOAD_F((const float*)cur.K, kb0); VMW(); SWRITE_KF(0); SBAR(); SLOAD_F((const float*)cur.V, kb0); }
    else { SLOAD_H(cur.K, cur.V, kb0); VMW(); SWRITE_HK(0); }
    __syncthreads();
}
template <class TIn, class TOut>
__device__ __forceinline__ void causal_swa_block(const BlockRef<TIn, TOut>& cur, const BlockRef<TIn, TOut>& nxt, int skv, int W, char* lds, Seam<TIn>& S) {
    constexpr bool F32 = same_t<TIn, float>::v;
    const int tid = threadIdx.x, wid = __builtin_amdgcn_readfirstlane(tid >> 6), lane = tid & 63, r32 = lane & 31, hi = lane >> 5;
    const int j_lo = swa_jlo(cur.P0, W);
    int j_hi = (cur.P0 + QB - 1) / KVBLK + 1; if (j_hi > skv / KVBLK) j_hi = skv / KVBLK;
    const int NT = j_hi - j_lo;
    const int kbn = swa_jlo(nxt.P0, W) * KVBLK;
    const int qlo = cur.P0 + wid * QBLK, qm = qlo + r32 - 4 * hi;
    char* V_lds = lds; char* K_lds = lds + 2 * SHM_V;
    float* ws = (float*)(lds + 2 * SHM_V + 2 * SHM_K) + wid * 64; float* li_l = ws, * al_l = ws + 32;
    float m_reg = -1e30f, l_reg = 0; f32x16 o[4] = {};
    const int sr = tid >> 4, sc = (tid & 15) * 8, vst0 = v_st(sr, sc), vst1 = v_st(32 + sr, sc), kws = KSWZ(sr, sc * 2);
    const int vb0 = (int)(uintptr_t)V_lds + v_rd_base(lane);
    const TIn* Kh = cur.K; const TIn* Vh = cur.V;
#define RESC(a) do { if (__any((a) < 1.f)) { if (hi == 0) al_l[r32] = (a); asm volatile("s_waitcnt lgkmcnt(0)" ::: "memory");              \
                     for (int d_ = 0; d_ < 4; ++d_) for (int r = 0; r < 16; ++r) o[d_][r] *= al_l[crow(r, hi)]; } } while (0)
#define KBASE(t) ((j_lo + (t)) * KVBLK)
#define ACT(t) (KBASE(t) <= qlo + QBLK - 1 && KBASE(t) + KVBLK - 1 >= qlo - W + 1)
#define MASKT(P0_, P1_, t) do { const int kb_ = KBASE(t); if ((!SK || ACT(t)) && (kb_ + KVBLK - 1 > qlo || kb_ <= qlo + QBLK - 1 - W)) mask_tile(P0_, P1_, qm - kb_, (unsigned)W); } while (0)
    constexpr int NQL = F32 ? 16 : 8;
    constexpr bool SK = WSKIP && !F32;
#define SEAM_K0() do { VMWN(NQL); if constexpr (F32) { SWRITE_KF(0); SBAR(); SLOAD_F((const float*)nxt.V, kbn); } else { SWRITE_HK(0); } SBAR(); } while (0)
    f32x16 pA0, pA1, pB0, pB1; float mnA, mnB, alA, alB; bf16x8 pa0, pa1, pa2, pa3;
    if constexpr (F32) { VMW(); SWRITE_VF(0); SBAR(); } else { SWRITE_HV(0); SBAR(); }
    if (NT > 1) { if constexpr (F32) SLOAD_F((const float*)Kh, KBASE(1)); else SLOAD_H(Kh, Vh, KBASE(1)); }
    SBAR(); qkt<0, SK>(pA0, pA1, K_lds, r32, hi, S.qr, ACT(0));
    if constexpr (F32) { if (NT > 1) { VMW(); SWRITE_KF(1); SBAR(); SLOAD_F((const float*)Vh, KBASE(1)); } }
    MASKT(pA0, pA1, 0); partialSM(pA0, pA1, m_reg, mnA, alA);
    if (NT > 1) { VMW(); if constexpr (F32) { SWRITE_VF(1); SBAR(); if (NT > 2) SLOAD_F((const float*)Kh, KBASE(2)); } else SWRITE_H(1); }
    __syncthreads();
#define HALF_STEP(PX0, PX1, mnX, alX, PY0, PY1, alY, t, KB, VB, SB) do {                                                      \
        SBAR(); qkt<KB, SK>(PX0, PX1, K_lds, r32, hi, S.qr, ACT(t));                                             \
        finishSM(PY0, PY1, alY, l_reg, pa0, pa1, pa2, pa3); SBAR();                                                           \
        if ((t) + 1 < NT) { if constexpr (F32) { VMW(); SWRITE_KF(SB); SBAR(); SLOAD_F((const float*)Vh, KBASE((t) + 1)); }  \
                            else { SLOAD_H(Kh, Vh, KBASE((t) + 1)); } SBAR(); }                                               \
        pv_tile<VB, SK>(o, vb0, pa0, pa1, pa2, pa3, ACT((t) - 1)); MASKT(PX0, PX1, (t)); partialSM(PX0, PX1, m_reg, mnX, alX);                                        \
        __syncthreads();                                                                                                      \
        if ((t) + 1 < NT) { VMW(); if constexpr (F32) { SWRITE_VF(SB); SBAR(); if ((t) + 2 < NT) SLOAD_F((const float*)Kh, KBASE((t) + 2)); } \
                            else { SWRITE_H(SB); } }                                                                          \
        RESC(alX); __syncthreads(); } while (0)
    for (int t = 1; t + 1 < NT; t += 2) {
        HALF_STEP(pB0, pB1, mnB, alB, pA0, pA1, alA, t, 1, 0, 0);
        HALF_STEP(pA0, pA1, mnA, alA, pB0, pB1, alB, t + 1, 0, 1, 1);
    }
    const bool even = (NT & 1) == 0;
    if (even) { SBAR(); qkt<1, SK>(pB0, pB1, K_lds, r32, hi, S.qr, ACT(NT - 1)); SBAR(); }
#define QROW(e) (nxt.Q + (size_t)(wid * QBLK + r32) * D + ((e) >> 1) * 16 + hi * 8 + ((e) & 1) * 4)
    if constexpr (F32) { SLOAD_F((const float*)nxt.K, kbn); SBAR();
#pragma unroll
        for (int e = 0; e < 8; ++e) S.tq[e] = *(const f32x4*)QROW(e); }
    else { SLOAD_H(nxt.K, nxt.V, kbn); SBAR();
#pragma unroll
        for (int d0 = 0; d0 < 8; ++d0) S.qr[d0] = load8<TIn>(nxt.Q + (size_t)(wid * QBLK + r32) * D + d0 * 16 + hi * 8); }
    SBAR();
    finishSM(pA0, pA1, alA, l_reg, pa0, pa1, pa2, pa3); SBAR();
    if constexpr (F32) {
#pragma unroll
        for (int e = 8; e < 16; ++e) S.tq[e] = *(const f32x4*)QROW(e); SBAR(); }
#undef QROW
    pv_tile<0, SK>(o, vb0, pa0, pa1, pa2, pa3, ACT(even ? NT - 2 : NT - 1));
    if (even) { MASKT(pB0, pB1, NT - 1); partialSM(pB0, pB1, m_reg, mnB, alB); __syncthreads(); RESC(alB);
        finishSM(pB0, pB1, alB, l_reg, pa0, pa1, pa2, pa3); SBAR(); pv_tile<1, SK>(o, vb0, pa0, pa1, pa2, pa3, ACT(NT - 1)); }
    SBAR(); SEAM_K0();
    if (hi == 0) li_l[r32] = l_reg; asm volatile("s_waitcnt lgkmcnt(0)" ::: "memory");
    float rli[16];
#pragma unroll
    for (int r = 0; r < 16; ++r) rli[r] = __builtin_amdgcn_rcpf(li_l[crow(r, hi)]);
    TOut* Ow = cur.O + (size_t)(wid * QBLK) * D;
#pragma unroll
    for (int r = 0; r < 16; ++r) { const int orow = crow(r, hi);
#pragma unroll
        for (int d0 = 0; d0 < 4; ++d0) { const float v = o[d0][r] * rli[r];
            if constexpr (same_t<TOut, float>::v) { Ow[(size_t)orow * D + d0 * 32 + r32] = v; }
            else { const float vn = __shfl_xor(v, 1);
                   if ((r32 & 1) == 0) *(unsigned*)(Ow + (size_t)orow * D + d0 * 32 + r32) = cvtpk(v, vn); } } }
    if constexpr (F32) {
#pragma unroll
        for (int d0 = 0; d0 < 8; ++d0) S.qr[d0] = pack8(S.tq[2 * d0], S.tq[2 * d0 + 1]); }
    __syncthreads();
#undef RESC
#undef KBASE
#undef ACT
#undef MASKT
#undef SEAM_K0
#undef HALF_STEP
}
#undef ROW
#undef ROWV
#undef VMW
#undef VMWN
#undef SLOAD_H
#undef SWRITE_HK
#undef SWRITE_HV
#undef SWRITE_H
#undef SLOAD_F
#undef SWRITE_KF
#undef SWRITE_VF
}
struct Ctx { LAS unsigned char* lds; int tid, lane, wave, vcu, G; };

__device__ __forceinline__ void tr_load(f4v (&v)[16], float (&gk)[16], const float* __restrict__ src, size_t ldn, const float* __restrict__ gain, int k0, int nsrc0, int lane) {
    const int r4 = lane >> 4, c4 = (lane & 15) * 4;
#pragma unroll
    for (int i = 0; i < 16; ++i) v[i] = *(const f4v*)(src + (size_t)(k0 + 4 * i + r4) * ldn + nsrc0 + c4);
#pragma unroll
    for (int i = 0; i < 16; ++i) gk[i] = gain ? gain[k0 + 4 * i + r4] : 1.f;
}
__device__ __forceinline__ void tr_item(const f4v (&v)[16], const float (&gv)[16], bfr* __restrict__ dst, int K,
                                        int k0, int drow0, LAS float* scr, int lane) {
    const int r4 = lane >> 4, c4 = (lane & 15) * 4;
#pragma unroll
    for (int i = 0; i < 16; ++i) { const int k = 4 * i + r4; const float gk = gv[i];
        LAS float* s = scr + k * 65 + c4; s[0] = v[i][0] * gk; s[1] = v[i][1] * gk; s[2] = v[i][2] * gk; s[3] = v[i][3] * gk; }
    LDS_WAIT(); asm volatile("" ::: "memory");
    const int c = lane & 7;
#pragma unroll
    for (int jj = 0; jj < 8; ++jj) { const int n = (lane >> 3) + 8 * jj; const LAS float* s = scr + (8 * c) * 65 + n;
        u4v o; o.x = cvtpk(s[0 * 65], s[1 * 65]); o.y = cvtpk(s[2 * 65], s[3 * 65]); o.z = cvtpk(s[4 * 65], s[5 * 65]); o.w = cvtpk(s[6 * 65], s[7 * 65]);
        *(u4v*)(dst + (size_t)(drow0 + n) * K + k0 + 8 * c) = o; }
    LDS_WAIT(); asm volatile("" ::: "memory");
}
__device__ __forceinline__ void tr_item8(const f4v (&v)[16], float sc, const float (&gv)[16], unsigned char* __restrict__ dst, int K, int k0, int drow0, LAS float* scr, int lane) {
    const int r4 = lane >> 4, c4 = (lane & 15) * 4;
#pragma unroll
    for (int i = 0; i < 16; ++i) { const int k = 4 * i + r4; const float gk = gv[i] * sc; LAS float* s = scr + k * 65 + c4; s[0] = v[i][0] * gk; s[1] = v[i][1] * gk; s[2] = v[i][2] * gk; s[3] = v[i][3] * gk; }
    LDS_WAIT(); asm volatile("" ::: "memory");
    const int c = lane & 3;
#pragma unroll
    for (int jj = 0; jj < 4; ++jj) { const int n = (lane >> 2) + 16 * jj; const LAS float* s = scr + (16 * c) * 65 + n;
        u4v o; o.x = cvt4_fp8(s[0 * 65], s[1 * 65], s[2 * 65], s[3 * 65]); o.y = cvt4_fp8(s[4 * 65], s[5 * 65], s[6 * 65], s[7 * 65]);
        o.z = cvt4_fp8(s[8 * 65], s[9 * 65], s[10 * 65], s[11 * 65]); o.w = cvt4_fp8(s[12 * 65], s[13 * 65], s[14 * 65], s[15 * 65]);
        *(u4v*)(dst + (size_t)(drow0 + n) * K + k0 + 16 * c) = o; }
    LDS_WAIT(); asm volatile("" ::: "memory");
}
__device__ __forceinline__ void tr_job8(const float* __restrict__ src, size_t ldn, float sc, const float* __restrict__ gain, unsigned char* __restrict__ dst, int K, int ncols, LAS float* scr, int lane, int gw, int NGW, int nsrc0 = 0) {
    const int nn = ncols / 64, ni = (K / 64) * nn;
    float ga[16], gb[16];
    f4v va[16], vb[16];
#define TRJ_LOAD(V, G_, it_) do { const int kb_ = (it_) / nn, nb_ = (it_) - kb_ * nn; tr_load(V, G_, src, ldn, gain, kb_ * 64, nsrc0 + nb_ * 64, lane); } while (0)
#define TRJ_ITEM(V, G_, it_) do { const int kb_ = (it_) / nn, nb_ = (it_) - kb_ * nn; tr_item8(V, sc, G_, dst, K, kb_ * 64, nb_ * 64, scr, lane); } while (0)
    int it = gw;
    if (it < ni) {
        TRJ_LOAD(va, ga, it);
        while (it + 2 * NGW < ni) {
            TRJ_LOAD(vb, gb, it + NGW); TRJ_ITEM(va, ga, it); TRJ_LOAD(va, ga, it + 2 * NGW); TRJ_ITEM(vb, gb, it + NGW); it += 2 * NGW; }
        if (it + NGW < ni) { TRJ_LOAD(vb, gb, it + NGW); TRJ_ITEM(va, ga, it); TRJ_ITEM(vb, gb, it + NGW); } else TRJ_ITEM(va, ga, it);
    }
#undef TRJ_LOAD
#undef TRJ_ITEM
}
__device__ __forceinline__ void tr_job(const float* __restrict__ src, size_t ldn, const float* __restrict__ gain, bfr* __restrict__ dst, int K, int ncols, int nsrc0, int drow0,
                                       LAS float* scr, int lane, int gw, int NGW) {
    const int nn = ncols / 64, ni = (K / 64) * nn;
    float ga[16], gb[16];
    f4v va[16], vb[16];
#define TRJ_LOAD(V, G_, it_) do { const int kb_ = (it_) / nn, nb_ = (it_) - kb_ * nn; tr_load(V, G_, src, ldn, gain, kb_ * 64, nsrc0 + nb_ * 64, lane); } while (0)
#define TRJ_ITEM(V, G_, it_) do { const int kb_ = (it_) / nn, nb_ = (it_) - kb_ * nn; tr_item(V, G_, dst, K, kb_ * 64, drow0 + nb_ * 64, scr, lane); } while (0)
    int it = gw;
    if (it < ni) {
        TRJ_LOAD(va, ga, it);
        while (it + 2 * NGW < ni) {
            TRJ_LOAD(vb, gb, it + NGW); TRJ_ITEM(va, ga, it); TRJ_LOAD(va, ga, it + 2 * NGW); TRJ_ITEM(vb, gb, it + NGW); it += 2 * NGW; }
        if (it + NGW < ni) { TRJ_LOAD(vb, gb, it + NGW); TRJ_ITEM(va, ga, it); TRJ_ITEM(vb, gb, it + NGW); } else TRJ_ITEM(va, ga, it);
    }
#undef TRJ_LOAD
#undef TRJ_ITEM
}
struct KArgs {
    const float* in[26]; float* out; unsigned char* ws; int ph_lo, ph_hi, li, pad;
};
struct Ptrs {
    LAS unsigned long long* tbl;
    __device__ __forceinline__ unsigned long long get(int k) const { const unsigned long long v = tbl[k];
        return ((unsigned long long)(unsigned)__builtin_amdgcn_readfirstlane((int)(unsigned)(v >> 32)) << 32) | (unsigned)__builtin_amdgcn_readfirstlane((int)(unsigned)v); }
    __device__ __forceinline__ const float* in_(int k) const { return (const float*)get(k); }
    __device__ __forceinline__ float* out_() const { return (float*)get(26); }
    __device__ __forceinline__ unsigned char* ws_() const { return (unsigned char*)get(27); }
};
__device__ __forceinline__ void p_convert(const Ctx& C, const Ptrs& P, const int part, const int vc, const int nc) {
    LAS float* scr = (LAS float*)(C.lds + C.wave * 16640);
    const int gw = vc * 8 + C.wave, NGW = nc * 8;
    unsigned char* ws = P.ws_();
    if (part == 0) {
#if F8_PROJ0 == 1
    tr_job8(P.in_(2), (size_t)GIN, SU, P.in_(1), ws + WS_WTIN, DM, 16384, scr, C.lane, gw, NGW);
#elif F8_PROJ0 == 2
    tr_job(P.in_(2), (size_t)GIN, P.in_(1), (bfr*)(ws + WS_WTIN), DM, 8192, 0, 0, scr, C.lane, gw, NGW);
    tr_job8(P.in_(2), (size_t)GIN, SU, P.in_(1), ws + WS_WTIN + (size_t)8192 * DM * 2, DM, 8192, scr, C.lane, gw, NGW, 8192);
#elif F8_PROJ0 == 5
    tr_job8(P.in_(2), (size_t)GIN, SU, P.in_(1), ws + WS_WTIN, DM, 8192, scr, C.lane, gw, NGW, 0);
    tr_job(P.in_(2), (size_t)GIN, P.in_(1), (bfr*)(ws + WS_WTIN + (size_t)32 * MiB), DM, 4096, 8192, 0, scr, C.lane, gw, NGW);
    tr_job8(P.in_(2), (size_t)GIN, SU, P.in_(1), ws + WS_WTIN + (size_t)64 * MiB, DM, 4096, scr, C.lane, gw, NGW, 12288);
#elif F8_PROJ0 == 6
    tr_job8(P.in_(2), (size_t)GIN, SU, P.in_(1), ws + WS_WTIN, DM, 12288, scr, C.lane, gw, NGW, 0);
    tr_job(P.in_(2), (size_t)GIN, P.in_(1), (bfr*)(ws + WS_WTIN + (size_t)48 * MiB), DM, 4096, 12288, 0, scr, C.lane, gw, NGW);
#elif F8_PROJ0 == 3
    tr_job8(P.in_(2), (size_t)GIN, SU, P.in_(1), ws + WS_WTIN, DM, 8192, scr, C.lane, gw, NGW, 0);
    tr_job(P.in_(2), (size_t)GIN, P.in_(1), (bfr*)(ws + WS_WTIN + (size_t)8192 * DM), DM, 8192, 8192, 0, scr, C.lane, gw, NGW);
#else
    tr_job(P.in_(2), (size_t)GIN, P.in_(1), (bfr*)(ws + WS_WTIN), DM, 16384, 0, 0, scr, C.lane, gw, NGW);
#endif
    tr_job(P.in_(2), (size_t)GIN, P.in_(1), (bfr*)(ws + WS_WTBD), DM, 64, 16384, 0, scr, C.lane, gw, NGW);
#if F8_OUT0
    tr_job8(P.in_(7), (size_t)DM, SU, nullptr, ws + WS_WTOUT, DM, DM, scr, C.lane, gw, NGW, 0);
#else
    tr_job(P.in_(7), (size_t)DM, nullptr, (bfr*)(ws + WS_WTOUT), DM, DM, 0, 0, scr, C.lane, gw, NGW);
#endif
    } else {
#if F8_KVQ
    tr_job8(P.in_(9), (size_t)8192, SU, P.in_(8), ws + WS_WTKVQ, DM, DM, scr, C.lane, gw, NGW, 0);
    tr_job8(P.in_(12), (size_t)DM, SU, P.in_(11), ws + WS_WTKVQ + (size_t)DM * DM, DM, DM, scr, C.lane, gw, NGW, 0);
#if F8_KVQ == 2
    tr_job8(P.in_(9), (size_t)8192, SU, P.in_(8), ws + WS_WTKVQ + (size_t)2 * DM * DM, DM, DM, scr, C.lane, gw, NGW, DM);
#else
    tr_job(P.in_(9), (size_t)8192, P.in_(8), (bfr*)(ws + WS_WTKVQ + (size_t)2 * DM * DM), DM, DM, DM, 0, scr, C.lane, gw, NGW);
#endif
#else
    tr_job(P.in_(9), (size_t)8192, P.in_(8), (bfr*)(ws + WS_WTKVQ), DM, 8192, 0, 0, scr, C.lane, gw, NGW);
    tr_job(P.in_(12), (size_t)DM, P.in_(11), (bfr*)(ws + WS_WTKVQ), DM, DM, 0, 8192, scr, C.lane, gw, NGW);
#endif
#if F8_OUT1
    tr_job8(P.in_(19), (size_t)DM, SU, nullptr, ws + WS_WTO, DM, DM, scr, C.lane, gw, NGW, 0);
#else
    tr_job(P.in_(19), (size_t)DM, nullptr, (bfr*)(ws + WS_WTO), DM, DM, 0, 0, scr, C.lane, gw, NGW);
#endif
    }
    tr_job(P.in_(21) + (size_t)part * DM * PQ, (size_t)PQ, P.in_(20) + part * DM, (bfr*)(ws + WS_WTQRY) + (size_t)part * PQ * DM, DM, PQ, 0, 0, scr, C.lane, gw, NGW);
    tr_job8(P.in_(25) + (size_t)part * PE * DM, (size_t)DM, SV, nullptr, ws + WS_VT + (size_t)part * DM * PE, PE, DM, scr, C.lane, gw, NGW);
    {
        const size_t gt = (size_t)vc * 512 + C.tid, GT = (size_t)nc * 512;
        for (int l = part; l <= part; ++l) {
            const float* src = P.in_(24) + (size_t)l * PE * DM; const float* gain = P.in_(20) + l * DM; unsigned char* dst = ws + WS_U + (size_t)l * PE * DM;
            constexpr size_t NIT = (size_t)PE * DM / 16; size_t i0 = gt;
            for (; i0 + 3 * GT < NIT; i0 += 4 * GT) {
                f4v x[4][4];
#pragma unroll
                for (int u = 0; u < 4; ++u) { const size_t i = i0 + (size_t)u * GT;
#pragma unroll
                    for (int j = 0; j < 4; ++j) x[u][j] = *(const f4v*)(src + i * 16 + 4 * j); }
#pragma unroll
                for (int u = 0; u < 4; ++u) { const size_t i = i0 + (size_t)u * GT; const int dd = (int)((i * 16) & (DM - 1));
                    u4v o; unsigned w[4];
#pragma unroll
                    for (int j = 0; j < 4; ++j) { const f4v g = *(const f4v*)(gain + dd + 4 * j) * SU; w[j] = cvt4_fp8(x[u][j][0] * g[0], x[u][j][1] * g[1], x[u][j][2] * g[2], x[u][j][3] * g[3]); }
                    o.x = w[0]; o.y = w[1]; o.z = w[2]; o.w = w[3];
                    *(u4v*)(dst + i * 16) = o; }
            }
            for (; i0 < NIT; i0 += GT) {
                const size_t i = i0; const int dd = (int)((i * 16) & (DM - 1)); u4v o; unsigned w[4];
#pragma unroll
                for (int j = 0; j < 4; ++j) { const f4v xx = *(const f4v*)(src + i * 16 + 4 * j); const f4v g = *(const f4v*)(gain + dd + 4 * j) * SU; w[j] = cvt4_fp8(xx[0] * g[0], xx[1] * g[1], xx[2] * g[2], xx[3] * g[3]); }
                o.x = w[0]; o.y = w[1]; o.z = w[2]; o.w = w[3];
                *(u4v*)(dst + i * 16) = o; }
        }
        for (int l = part; l <= part; ++l) {
            bfr* dst = (bfr*)(ws + WS_WTKEY) + (size_t)l * PQ * PQ;
            for (size_t i = gt; i < (size_t)PQ * PQ / 8; i += GT) {
                const int row = (int)((i * 8) / PQ), col = (int)((i * 8) % PQ); u4v o = {0u, 0u, 0u, 0u};
                if ((row >> 7) == (col >> 7)) { const int blk = row >> 7, h = blk >> 1, half = blk & 1, n = row & 127, d = col & 127;
                    const float* src = (half ? P.in_(23) : P.in_(22)) + (((size_t)l * PH + h) * PK + n) * 128 + d;
                    const f4v a = *(const f4v*)src, b = *(const f4v*)(src + 4);
                    o.x = cvtpk(a[0], a[1]); o.y = cvtpk(a[2], a[3]); o.z = cvtpk(b[0], b[1]); o.w = cvtpk(b[2], b[3]); }
                *(u4v*)(dst + i * 8) = o; }
        }
    }
}

template <bool SB = false>
__device__ __forceinline__ void p_norm_rows(const Ctx& C, const void* __restrict__ srcv, bfr* __restrict__ dst, unsigned char* __restrict__ dst8, float* __restrict__ rout = nullptr) {
    const int gw = C.vcu * 8 + C.wave, NGW = C.G * 8;
    for (int row = gw; row < NT; row += NGW) {
        f4v a[8], b[8]; float ss = 0.f;
        if (SB) { const u4v* p = (const u4v*)((const bfr*)srcv + (size_t)row * DM); u4v raw[8];
#pragma unroll
            for (int j = 0; j < 8; ++j) raw[j] = p[j * 64 + C.lane];
#pragma unroll
            for (int j = 0; j < 8; ++j) { a[j] = (f4v){bflo(raw[j].x), bfhi(raw[j].x), bflo(raw[j].y), bfhi(raw[j].y)}; b[j] = (f4v){bflo(raw[j].z), bfhi(raw[j].z), bflo(raw[j].w), bfhi(raw[j].w)}; } }
        else { const f4v* p = (const f4v*)((const float*)srcv + (size_t)row * DM);
#pragma unroll
            for (int j = 0; j < 8; ++j) { a[j] = p[j * 128 + 2 * C.lane]; b[j] = p[j * 128 + 2 * C.lane + 1]; } }
#pragma unroll
        for (int j = 0; j < 8; ++j) ss += (a[j][0] * a[j][0] + a[j][1] * a[j][1]) + (a[j][2] * a[j][2] + a[j][3] * a[j][3]) + (b[j][0] * b[j][0] + b[j][1] * b[j][1]) + (b[j][2] * b[j][2] + b[j][3] * b[j][3]);
        const float r = __builtin_amdgcn_rsqf(wave_sum(ss) * (1.f / DM) + EPS);
        if (rout && C.lane == 0) rout[row] = r;
        u4v* o = (u4v*)(dst + (size_t)row * DM);
#pragma unroll
        for (int j = 0; j < 8; ++j) { u4v w; w.x = cvtpk(a[j][0] * r, a[j][1] * r); w.y = cvtpk(a[j][2] * r, a[j][3] * r); w.z = cvtpk(b[j][0] * r, b[j][1] * r); w.w = cvtpk(b[j][2] * r, b[j][3] * r);
            if (dst) o[j * 64 + C.lane] = w;
            if (dst8) { u2v w8; w8.x = cvt4_fp8(a[j][0] * r, a[j][1] * r, a[j][2] * r, a[j][3] * r); w8.y = cvt4_fp8(b[j][0] * r, b[j][1] * r, b[j][2] * r, b[j][3] * r); ((u2v*)(dst8 + (size_t)row * DM))[j * 64 + C.lane] = w8; } }
    }
}

__device__ __forceinline__ void p_bd(const Ctx& C, const bfr* __restrict__ XN, const bfr* __restrict__ WB, float* __restrict__ BD) {
    LAS float* red = (LAS float*)C.lds;
    const int r = C.lane & 15, q = C.lane >> 4, rt = C.wave >> 2, kq = C.wave & 3;
    for (int blk = C.vcu; blk < NT / 32; blk += C.G) {
        const bfr* ap = XN + (size_t)(blk * 32 + rt * 16 + r) * DM + kq * 1024 + q * 8;
        const bfr* bp = WB + (size_t)r * DM + kq * 1024 + q * 8;
        f4v acc[4] = {zero_acc(), zero_acc(), zero_acc(), zero_acc()};
#pragma unroll 4
        for (int ks = 0; ks < 32; ++ks) {
            const s8v a = *(const s8v*)(ap + ks * 32);
#pragma unroll
            for (int nt = 0; nt < 4; ++nt) { const s8v b = *(const s8v*)(bp + (size_t)nt * 16 * DM + ks * 32); acc[nt] = __builtin_amdgcn_mfma_f32_16x16x32_bf16(a, b, acc[nt], 0, 0, 0); }
            MFMA_SETTLE(acc[0]); MFMA_SETTLE(acc[1]); MFMA_SETTLE(acc[2]); MFMA_SETTLE(acc[3]);
        }
        MFMA_SETTLE(acc[0]); MFMA_SETTLE(acc[1]); MFMA_SETTLE(acc[2]); MFMA_SETTLE(acc[3]);
#pragma unroll
        for (int nt = 0; nt < 4; ++nt)
#pragma unroll
            for (int i = 0; i < 4; ++i) red[C.wave * 1024 + (4 * q + i) * 64 + nt * 16 + r] = -acc[nt][i];
        __syncthreads();
#pragma unroll
        for (int i = 0; i < 4; ++i) { const int idx = C.tid * 4 + i, t2 = idx >> 10, rem = idx & 1023;
            const float s = -((red[(t2 * 4 + 0) * 1024 + rem] + red[(t2 * 4 + 1) * 1024 + rem]) + (red[(t2 * 4 + 2) * 1024 + rem] + red[(t2 * 4 + 3) * 1024 + rem]));
            BD[(size_t)(blk * 32 + t2 * 16 + (rem >> 6)) * 64 + (rem & 63)] = s; }
        __syncthreads();
    }
}
__device__ __forceinline__ int kq_off(int row, int chunk) { return row * 256 + ((chunk ^ (row & 7)) << 4); }
__device__ __forceinline__ int xt_off(int col, int chunk) { return col * 128 + ((chunk ^ (col & 7)) << 4); }
__device__ __forceinline__ void p_gdn_prep(const Ctx& C, const Ptrs& P, int vp, int np) {
    unsigned char* ws = P.ws_();
    const bfr* PROJ = (const bfr*)(ws + WS_BIG); const float* BD = (const float*)(ws + WS_BD);
    const float* convw = P.in_(3); const float* alog = P.in_(4); const float* dtb = P.in_(5);
    bfr* Wg = (bfr*)(ws + WS_R + R_W); bfr* Ug = (bfr*)(ws + WS_R + R_U); bfr* QGg = (bfr*)(ws + WS_R + R_QG); bfr* KDg = (bfr*)(ws + WS_R + R_KD); bfr* QKg = (bfr*)(ws + WS_R + R_QK);
    float* EGg = (float*)(ws + WS_EG);
    LAS float* sCW = (LAS float*)(C.lds + 82944);
    for (int tk = vp; tk < NB * GH * 32; tk += np) {
        const int wq = tk >> 3, it = tk & 7;
        const int bh = wq >> 2, cg = wq & 3, h = bh & 31, b = bh >> 5;
        for (int i = C.tid; i < 1536; i += 512) { const int part = i >> 9, tap = (i >> 7) & 3, ch = i & 127; sCW[i] = convw[tap * 12288 + part * 4096 + h * 128 + ch]; }
        __syncthreads();
        {
            int tid = C.tid; asm volatile("" : "+v"(tid));
            const int hw = tid >> 8, lt = tid & 255, lane = tid & 63, lw = (tid >> 6) & 3;
            const int c = cg * 16 + it * 2 + hw, unit = bh * 64 + c, t0 = b * SEQ + c * CH;
            LAS unsigned char* hb = C.lds + hw * 41472;
            LAS unsigned char* sK = hb; LAS unsigned char* sQ = hb + 16384; LAS unsigned char* sX = hb;
            LAS unsigned char* sAM = hb + 32768; LAS float* sB = (LAS float*)(hb + 40960); LAS float* sG = (LAS float*)(hb + 41216);
            LAS float* scr = (LAS float*)(C.lds + 89088 + (tid >> 6) * 4352);
            LAS float* sAD = (LAS float*)(C.lds + 123904 + hw * 4096);
            if (lt < 64) {
                const int t = t0 + lt; const float braw = BD[(size_t)t * 64 + h], araw = BD[(size_t)t * 64 + 32 + h];
                const float beta = 1.f / (1.f + expf(-braw)); const float xx = araw + dtb[h]; const float sp = fmaxf(xx, 0.f) + log1pf(expf(-fabsf(xx)));
                float g = -expf(alog[h]) * sp;
#pragma unroll
                for (int o = 1; o < 64; o <<= 1) { const float y = __shfl_up(g, o); if (lane >= o) g += y; }
                sB[lt] = beta; sG[lt] = g;
            }
            __syncthreads();
            const int tk = lt >> 2, cs = lt & 3;
            const float beta = sB[tk], gc = sG[tk], gl = sG[63]; const float eg = expf(gc), ed = expf(gl - gc), bg = beta * eg;
            u4v kbg[4], vbt[4];
#pragma unroll
            for (int part = 0; part < 3; ++part) {
                float y[32];
#pragma unroll
                for (int i = 0; i < 32; ++i) y[i] = 0.f;
#pragma unroll
                for (int j = 0; j < 4; ++j) {
                    const int s = c * CH + tk - 3 + j;
                    if (s >= 0) {
                        const bfr* row = PROJ + (size_t)(b * SEQ + s) * 16384 + part * 4096 + h * 128 + cs * 32;
#pragma unroll
                        for (int q4 = 0; q4 < 4; ++q4) { const u4v x = *(const u4v*)(row + 8 * q4); const LAS float* wp = sCW + part * 512 + j * 128 + cs * 32 + 8 * q4;
                            const f4v w0 = *(const LAS f4v*)wp, w1 = *(const LAS f4v*)(wp + 4);
                            y[8 * q4 + 0] += bflo(x.x) * w0[0]; y[8 * q4 + 1] += bfhi(x.x) * w0[1]; y[8 * q4 + 2] += bflo(x.y) * w0[2]; y[8 * q4 + 3] += bfhi(x.y) * w0[3];
                            y[8 * q4 + 4] += bflo(x.z) * w1[0]; y[8 * q4 + 5] += bfhi(x.z) * w1[1]; y[8 * q4 + 6] += bflo(x.w) * w1[2]; y[8 * q4 + 7] += bfhi(x.w) * w1[3]; }
                    }
                }
                float ss = 0.f;
#pragma unroll
                for (int i = 0; i < 32; ++i) { y[i] = y[i] * __builtin_amdgcn_rcpf(1.f + __expf(-y[i])); ss += y[i] * y[i]; }
                if (part < 2) {
                    ss += __shfl_xor(ss, 1); ss += __shfl_xor(ss, 2);
                    const float rn = __builtin_amdgcn_rsqf(ss + EPS) * (part == 0 ? 0.08838834764831845f : 1.f); const float gs = part == 0 ? eg : ed;
                    LAS unsigned char* dstl = part == 0 ? sQ : sK; bfr* dstg = (part == 0 ? QGg : KDg) + (size_t)unit * 8192 + tk * 128 + cs * 32;
#pragma unroll
                    for (int q4 = 0; q4 < 4; ++q4) { float z[8];
#pragma unroll
                        for (int i = 0; i < 8; ++i) z[i] = y[8 * q4 + i] * rn;
                        u4v w; w.x = cvtpk(z[0], z[1]); w.y = cvtpk(z[2], z[3]); w.z = cvtpk(z[4], z[5]); w.w = cvtpk(z[6], z[7]);
                        *(LAS u4v*)(dstl + kq_off(tk, cs * 4 + q4)) = w;
                        u4v g; g.x = cvtpk(z[0] * gs, z[1] * gs); g.y = cvtpk(z[2] * gs, z[3] * gs); g.z = cvtpk(z[4] * gs, z[5] * gs); g.w = cvtpk(z[6] * gs, z[7] * gs);
                        *(u4v*)(dstg + 8 * q4) = g;
                        if (part == 1) { kbg[q4].x = cvtpk(z[0] * bg, z[1] * bg); kbg[q4].y = cvtpk(z[2] * bg, z[3] * bg); kbg[q4].z = cvtpk(z[4] * bg, z[5] * bg); kbg[q4].w = cvtpk(z[6] * bg, z[7] * bg); } }
                } else {
#pragma unroll
                    for (int q4 = 0; q4 < 4; ++q4) { vbt[q4].x = cvtpk(y[8 * q4] * beta, y[8 * q4 + 1] * beta); vbt[q4].y = cvtpk(y[8 * q4 + 2] * beta, y[8 * q4 + 3] * beta);
                        vbt[q4].z = cvtpk(y[8 * q4 + 4] * beta, y[8 * q4 + 5] * beta); vbt[q4].w = cvtpk(y[8 * q4 + 6] * beta, y[8 * q4 + 7] * beta); }
                }
            }
            __syncthreads();
            {
                const int r = lane & 15, q = lane >> 4, mt = lw;
                s8v ak[4], aq[4];
#pragma unroll
                for (int ks = 0; ks < 4; ++ks) { ak[ks] = *(const LAS s8v*)(sK + kq_off(16 * mt + r, 4 * ks + q)); aq[ks] = *(const LAS s8v*)(sQ + kq_off(16 * mt + r, 4 * ks + q)); }
                float gi[4], bi[4];
#pragma unroll
                for (int e = 0; e < 4; ++e) { gi[e] = sG[16 * mt + 4 * q + e]; bi[e] = sB[16 * mt + 4 * q + e]; }
                for (int nt = 0; nt < 4; ++nt) {
                    const int j = 16 * nt + r;
                    if (nt <= mt) {
                        f4v ck = zero_acc(), cq = zero_acc();
#pragma unroll
                        for (int ks = 0; ks < 4; ++ks) { const s8v bb = *(const LAS s8v*)(sK + kq_off(16 * nt + r, 4 * ks + q));
                            ck = __builtin_amdgcn_mfma_f32_16x16x32_bf16(ak[ks], bb, ck, 0, 0, 0); cq = __builtin_amdgcn_mfma_f32_16x16x32_bf16(aq[ks], bb, cq, 0, 0, 0); }
                        MFMA_SETTLE(ck); MFMA_SETTLE(cq);
                        const float gj = sG[j];
#pragma unroll
                        for (int e = 0; e < 4; ++e) { const int i = 16 * mt + 4 * q + e; const float dec = expf(fminf(gi[e] - gj, 0.f));
                            const float av = (i > j) ? bi[e] * ck[e] * dec : 0.f;
                            *(LAS bfr*)(sAM + xt_off(i, j >> 3) + (j & 7) * 2) = f2bf1(av);
                            if (nt == mt) sAD[mt * 256 + (4 * q + e) * 16 + r] = av;
                            QKg[(size_t)unit * 4096 + i * 64 + j] = f2bf1((i >= j) ? cq[e] * dec : 0.f); }
                    } else {
#pragma unroll
                        for (int e = 0; e < 4; ++e) QKg[(size_t)unit * 4096 + (16 * mt + 4 * q + e) * 64 + j] = (bfr)0;
                    }
                }
            }
            __syncthreads();
            {
                const int ro = ((tk >> 3)), rb = (tk & 7) * 2;
#pragma unroll
                for (int q4 = 0; q4 < 4; ++q4) {
                    const unsigned vv[4] = {vbt[q4].x, vbt[q4].y, vbt[q4].z, vbt[q4].w}, kk[4] = {kbg[q4].x, kbg[q4].y, kbg[q4].z, kbg[q4].w};
#pragma unroll
                    for (int i = 0; i < 8; ++i) { const int ch = cs * 32 + q4 * 8 + i;
                        *(LAS bfr*)(sX + xt_off(ch, ro) + rb) = (bfr)((i & 1) ? (vv[i >> 1] >> 16) : (vv[i >> 1] & 0xffffu));
                        *(LAS bfr*)(sX + xt_off(128 + ch, ro) + rb) = (bfr)((i & 1) ? (kk[i >> 1] >> 16) : (kk[i >> 1] & 0xffffu)); }
                }
            }
            __syncthreads();
            {
                const int r = lane & 15, q = lane >> 4;
                float x[64];
#pragma unroll
                for (int bk = 0; bk < 4; ++bk) {
                    float corr[16];
#pragma unroll
                    for (int i = 0; i < 16; ++i) corr[i] = 0.f;
                    if (bk > 0) {
                        f4v acc[4] = {zero_acc(), zero_acc(), zero_acc(), zero_acc()};
#pragma unroll
                        for (int ks = 0; ks < (16 * bk + 31) / 32; ++ks) {
                            s8v a = *(const LAS s8v*)(sAM + xt_off(16 * bk + r, 4 * ks + q));
                            if (32 * ks + 8 * q >= 16 * bk) a = (s8v){0, 0, 0, 0, 0, 0, 0, 0};
#pragma unroll
                            for (int nt = 0; nt < 4; ++nt) { const s8v bx = *(const LAS s8v*)(sX + xt_off(64 * lw + 16 * nt + r, 4 * ks + q)); acc[nt] = __builtin_amdgcn_mfma_f32_16x16x32_bf16(a, bx, acc[nt], 0, 0, 0); }
                        }
                        MFMA_SETTLE(acc[0]); MFMA_SETTLE(acc[1]); MFMA_SETTLE(acc[2]); MFMA_SETTLE(acc[3]);
#pragma unroll
                        for (int nt = 0; nt < 4; ++nt)
#pragma unroll
                            for (int e = 0; e < 4; ++e) scr[(16 * nt + r) * 17 + 4 * q + e] = -acc[nt][e];
                        LDS_WAIT(); asm volatile("" ::: "memory");
#pragma unroll
                        for (int i = 0; i < 16; ++i) corr[i] = scr[lane * 17 + i];
                    }
                    const u4v r0 = *(const LAS u4v*)(sX + xt_off(lt, 2 * bk)), r1 = *(const LAS u4v*)(sX + xt_off(lt, 2 * bk + 1));
                    const float rhs[16] = {bflo(r0.x), bfhi(r0.x), bflo(r0.y), bfhi(r0.y), bflo(r0.z), bfhi(r0.z), bflo(r0.w), bfhi(r0.w), bflo(r1.x), bfhi(r1.x), bflo(r1.y), bfhi(r1.y), bflo(r1.z), bfhi(r1.z), bflo(r1.w), bfhi(r1.w)};
                    float xb[16];
#pragma unroll
                    for (int i = 0; i < 16; ++i) {
                        float v = rhs[i] + corr[i];
                        const u4v a0 = *(const LAS u4v*)(sAM + xt_off(16 * bk + i, 2 * bk)), a1 = *(const LAS u4v*)(sAM + xt_off(16 * bk + i, 2 * bk + 1));
                        const float am[16] = {bflo(a0.x), bfhi(a0.x), bflo(a0.y), bfhi(a0.y), bflo(a0.z), bfhi(a0.z), bflo(a0.w), bfhi(a0.w), bflo(a1.x), bfhi(a1.x), bflo(a1.y), bfhi(a1.y), bflo(a1.z), bfhi(a1.z), bflo(a1.w), bfhi(a1.w)};
#pragma unroll
                        for (int j = 0; j < 16; ++j) if (j < i) v -= am[j] * xb[j];
                        xb[i] = v; x[16 * bk + i] = v;
                    }
                    u4v w0, w1; w0.x = cvtpk(xb[0], xb[1]); w0.y = cvtpk(xb[2], xb[3]); w0.z = cvtpk(xb[4], xb[5]); w0.w = cvtpk(xb[6], xb[7]);
                    w1.x = cvtpk(xb[8], xb[9]); w1.y = cvtpk(xb[10], xb[11]); w1.z = cvtpk(xb[12], xb[13]); w1.w = cvtpk(xb[14], xb[15]);
                    *(LAS u4v*)(sX + xt_off(lt, 2 * bk)) = w0; *(LAS u4v*)(sX + xt_off(lt, 2 * bk + 1)) = w1;
                    LDS_WAIT(); asm volatile("" ::: "memory");
                }
                bfr* dst = (lt < 128 ? Ug : Wg) + (size_t)unit * 8192 + (lt & 127);
#pragma unroll
                for (int i = 0; i < 64; ++i) dst[i * 128] = f2bf1(x[i]);
                if (lt == 0) EGg[unit] = expf(sG[63]);
            }
            __syncthreads();
        }
    }
}

__device__ __forceinline__ void p_gdn_scan(const Ctx& C, const Ptrs& P) {
    unsigned char* ws = P.ws_();
    const GAS bfr* Wg = (const GAS bfr*)(ws + WS_R + R_W); const GAS bfr* Ug = (const GAS bfr*)(ws + WS_R + R_U); const GAS bfr* QGg = (const GAS bfr*)(ws + WS_R + R_QG); const GAS bfr* KDg = (const GAS bfr*)(ws + WS_R + R_KD);
    const GAS bfr* QKg = (const GAS bfr*)(ws + WS_R + R_QK); GAS bfr* Og = (GAS bfr*)(ws + WS_R + R_O); const GAS float* EGg = (const GAS float*)(ws + WS_EG);
    const int tid = C.tid, lane = C.lane, wave = C.wave, r = lane & 15, q = lane >> 4, mt = wave & 3, nt = wave >> 2;
    LAS bfr* sST = (LAS bfr*)(C.lds + 131072); LAS bfr* sVN = (LAS bfr*)(C.lds + 139776);
#define SC_W(bb)  ((LAS bfr*)(C.lds + (bb) * 65536))
#define SC_QG(bb) ((LAS bfr*)(C.lds + (bb) * 65536 + 17408))
#define SC_KD(bb) ((LAS bfr*)(C.lds + (bb) * 65536 + 34816))
#define SC_QK(bb) ((LAS bfr*)(C.lds + (bb) * 65536 + 52224))
#define SC_U(bb)  ((LAS bfr*)(C.lds + (bb) * 65536 + 61440))
#define SC_LOAD(n) do { const size_t ub = (size_t)(bh * 64 + (n)) * 8192; \
        rW0 = *(const GAS u4v*)(Wg + ub + (size_t)tid * 8); rW1 = *(const GAS u4v*)(Wg + ub + (size_t)(tid + 512) * 8); \
        rQ0 = *(const GAS u4v*)(QGg + ub + (size_t)tid * 8); rQ1 = *(const GAS u4v*)(QGg + ub + (size_t)(tid + 512) * 8); \
        rK0 = *(const GAS u4v*)(KDg + ub + (size_t)tid * 8); rK1 = *(const GAS u4v*)(KDg + ub + (size_t)(tid + 512) * 8); \
        rQK = *(const GAS u4v*)(QKg + (size_t)(bh * 64 + (n)) * 4096 + (size_t)tid * 8); \
        if (tid < 256) rU = *(const GAS u4v*)(Ug + ub + (size_t)(tid >> 2) * 128 + es * 32 + (tid & 3) * 8); } while (0)
#define SC_WRITE(bb) do { const int c0 = tid, c1 = tid + 512; \
        *(LAS u4v*)(SC_W(bb) + (c0 >> 4) * 136 + (c0 & 15) * 8) = rW0; *(LAS u4v*)(SC_W(bb) + (c1 >> 4) * 136 + (c1 & 15) * 8) = rW1; \
        *(LAS u4v*)(SC_QG(bb) + (c0 >> 4) * 136 + (c0 & 15) * 8) = rQ0; *(LAS u4v*)(SC_QG(bb) + (c1 >> 4) * 136 + (c1 & 15) * 8) = rQ1; \
        *(LAS u4v*)(SC_KD(bb) + (c0 >> 4) * 136 + (c0 & 15) * 8) = rK0; *(LAS u4v*)(SC_KD(bb) + (c1 >> 4) * 136 + (c1 & 15) * 8) = rK1; \
        *(LAS u4v*)(SC_QK(bb) + (tid >> 3) * 72 + (tid & 7) * 8) = rQK; \
        if (tid < 256) *(LAS u4v*)(SC_U(bb) + (tid >> 2) * 32 + (tid & 3) * 8) = rU; } while (0)
    for (int task = C.vcu; task < NB * GH * 4; task += C.G) {
        const int bh = task >> 2, es = task & 3, h = bh & 31, b = bh >> 5;
        u4v rW0, rW1, rQ0, rQ1, rK0, rK1, rQK, rU = {0u, 0u, 0u, 0u};
        f4v S0 = {0.f, 0.f, 0.f, 0.f}, S1 = {0.f, 0.f, 0.f, 0.f};
        LAS float* sEG = (LAS float*)(C.lds + 144384);
        if (tid < 64) sEG[tid] = EGg[bh * 64 + tid];
        SC_LOAD(0); SC_WRITE(0); SC_LOAD(1);
        for (int n = 0; n < NCH; ++n) {
            const int bb = n & 1;
            {
                MFMA_SETTLE(S0); MFMA_SETTLE(S1);
                u2v w0, w1; w0.x = cvtpk(S0[0], S0[1]); w0.y = cvtpk(S0[2], S0[3]); w1.x = cvtpk(S1[0], S1[1]); w1.y = cvtpk(S1[2], S1[3]);
                *(LAS u2v*)(sST + (r) * 136 + 16 * wave + 4 * q) = w0; *(LAS u2v*)(sST + (16 + r) * 136 + 16 * wave + 4 * q) = w1;
            }
            __syncthreads();
            if (n + 1 < NCH) { if (bb) SC_WRITE(0); else SC_WRITE(1); if (n + 2 < NCH) SC_LOAD(n + 2); }
            f4v acc1 = zero_acc(), acc2 = zero_acc();
            const LAS bfr* pW = SC_W(bb) + (16 * mt + r) * 136 + 8 * q; const LAS bfr* pQ = SC_QG(bb) + (16 * mt + r) * 136 + 8 * q; const LAS bfr* pS = sST + (16 * nt + r) * 136 + 8 * q;
#pragma unroll
            for (int ks = 0; ks < 4; ++ks) { const s8v a1 = *(const LAS s8v*)(pW + 32 * ks), a2 = *(const LAS s8v*)(pQ + 32 * ks), bs = *(const LAS s8v*)(pS + 32 * ks);
                acc1 = __builtin_amdgcn_mfma_f32_16x16x32_bf16(a1, bs, acc1, 0, 0, 0); acc2 = __builtin_amdgcn_mfma_f32_16x16x32_bf16(a2, bs, acc2, 0, 0, 0); }
            MFMA_SETTLE(acc1);
            {
                const LAS bfr* pU = SC_U(bb) + (16 * mt + 4 * q) * 32 + 16 * nt + r;
                const float v0 = bf1(pU[0]) - acc1[0], v1 = bf1(pU[32]) - acc1[1], v2 = bf1(pU[64]) - acc1[2], v3 = bf1(pU[96]) - acc1[3];
                u2v w; w.x = cvtpk(v0, v1); w.y = cvtpk(v2, v3);
                *(LAS u2v*)(sVN + (16 * nt + r) * 72 + 16 * mt + 4 * q) = w;
            }
            __syncthreads();
            {
                const LAS bfr* pA = SC_QK(bb) + (16 * mt + r) * 72 + 8 * q; const LAS bfr* pV = sVN + (16 * nt + r) * 72 + 8 * q;
#pragma unroll
                for (int ks = 0; ks < 2; ++ks) { const s8v a = *(const LAS s8v*)(pA + 32 * ks), bv = *(const LAS s8v*)(pV + 32 * ks); acc2 = __builtin_amdgcn_mfma_f32_16x16x32_bf16(a, bv, acc2, 0, 0, 0); }
                MFMA_SETTLE(acc2);
                GAS bfr* po = Og + (size_t)(b * SEQ + n * CH + 16 * mt + 4 * q) * DM + h * 128 + es * 32 + 16 * nt + r;
                po[0] = f2bf1(acc2[0]); po[DM] = f2bf1(acc2[1]); po[2 * DM] = f2bf1(acc2[2]); po[3 * DM] = f2bf1(acc2[3]);
            }
            {
                const float eg = sEG[n];
                S0 *= eg; S1 *= eg;
                const LAS bfr* pK = SC_KD(bb) + (8 * q) * 136 + 16 * wave + r; const LAS bfr* pV0 = sVN + r * 72 + 8 * q; const LAS bfr* pV1 = sVN + (16 + r) * 72 + 8 * q;
#pragma unroll
                for (int ks = 0; ks < 2; ++ks) {
                    s8v a;
#pragma unroll
                    for (int i = 0; i < 8; ++i) a[i] = (short)pK[(32 * ks + i) * 136];
                    const s8v b0 = *(const LAS s8v*)(pV0 + 32 * ks), b1 = *(const LAS s8v*)(pV1 + 32 * ks);
                    S0 = __builtin_amdgcn_mfma_f32_16x16x32_bf16(a, b0, S0, 0, 0, 0); S1 = __builtin_amdgcn_mfma_f32_16x16x32_bf16(a, b1, S1, 0, 0, 0);
                }
            }
        }
        __syncthreads();
    }
#undef SC_W
#undef SC_QG
#undef SC_KD
#undef SC_QK
#undef SC_U
#undef SC_LOAD
#undef SC_WRITE
}

#define S2_OFF_QG 17408
#define S2_OFF_QK 34816
#define S2_OFF_KT 44032
#define S2_OFF_U  62464
#define S2_BUF    66560
__device__ __forceinline__ s8v s2_frag(const LAS bfr* rowp, int q) {
    const u2v lo = *(const LAS u2v*)(rowp + 4 * q), hi = *(const LAS u2v*)(rowp + 16 + 4 * q);
    const u4v w = {lo.x, lo.y, hi.x, hi.y}; return __builtin_bit_cast(s8v, w);
}
__device__ __forceinline__ s8v s2_fragx(const LAS bfr* rowp, int g0, int g1) {
    const u2v lo = *(const LAS u2v*)(rowp + 4 * g0), hi = *(const LAS u2v*)(rowp + 4 * g1);
    const u4v w = {lo.x, lo.y, hi.x, hi.y}; return __builtin_bit_cast(s8v, w);
}
__device__ __forceinline__ s8v s2_pack(const f4v& a, const f4v& b) { const u4v w = {cvtpk(a[0], a[1]), cvtpk(a[2], a[3]), cvtpk(b[0], b[1]), cvtpk(b[2], b[3])}; return __builtin_bit_cast(s8v, w); }
template <int MODE = 0>
__device__ __forceinline__ void p_gdn_scan2(const Ctx& C, const Ptrs& P) {
    unsigned char* ws = P.ws_();
    const GAS bfr* Wg = (const GAS bfr*)(ws + WS_R + R_W); const GAS bfr* Ug = (const GAS bfr*)(ws + WS_R + R_U); const GAS bfr* QGg = (const GAS bfr*)(ws + WS_R + R_QG); const GAS bfr* KDg = (const GAS bfr*)(ws + WS_R + R_KD);
    const GAS bfr* QKg = (const GAS bfr*)(ws + WS_R + R_QK); GAS bfr* Og = (GAS bfr*)(ws + (MODE ? WS_SC : WS_R + R_O)); const GAS float* EGg = (const GAS float*)(ws + WS_EG);
    const int tid = C.tid, lane = C.lane, wave = C.wave, r = lane & 15, q = lane >> 4;
    LAS float* sEG = (LAS float*)(C.lds + 2 * S2_BUF);
    for (int task = C.vcu; task < NB * GH * 4; task += C.G) {
        const int bh = task >> 2, es = task & 3, h = bh & 31, b = bh >> 5;
        if (tid < 64) sEG[tid] = EGg[bh * 64 + tid];
        if (wave >= 2) {
            const int lw = __builtin_amdgcn_readfirstlane((tid - 128) & ~63);
            __builtin_assume(lw >= 0 && lw <= 320);
            const GAS unsigned char* RB = (const GAS unsigned char*)(ws + WS_R);
            const unsigned l16 = lane * 16, lU = (lane >> 2) * 256 + (lane & 3) * 16 + es * 64;
            const unsigned lrow = (lane >> 4) * 272 + (lane & 15) * 16, lqk = (lane >> 3) * 144 + (lane & 7) * 16, lkt = (lane & 15) * 8 * 144 + (lane >> 4) * 2;
            const int lsw = (lane & 15) >> 1;
            u4v ra[10], rb[10];
#define S2_LOAD(R, n) do { const unsigned ua_ = (unsigned)(bh * 64 + ((MODE == 2 || MODE == 4) ? 0 : (n))) * 16384u; _Pragma("unroll") for (int k_ = 0; k_ < 10; ++k_) { const int c0_ = lw + 384 * k_; \
        if (c0_ < 1024) R[k_] = *(const GAS u4v*)(RB + (size_t)((unsigned)R_W + ua_ + c0_ * 16) + l16); \
        else if (c0_ < 2048) R[k_] = *(const GAS u4v*)(RB + (size_t)((unsigned)R_QG + ua_ + (c0_ - 1024) * 16) + l16); \
        else if (c0_ < 2560) R[k_] = *(const GAS u4v*)(RB + (size_t)((unsigned)R_QK + (ua_ >> 1) + (c0_ - 2048) * 16) + l16); \
        else if (c0_ < 2816) R[k_] = *(const GAS u4v*)(RB + (size_t)((unsigned)R_U + ua_ + ((c0_ - 2560) >> 2) * 256) + lU); \
        else R[k_] = *(const GAS u4v*)(RB + (size_t)((unsigned)R_KD + ua_ + (c0_ - 2816) * 16) + l16); } } while (0)
#define S2_WRITE(R, bb) do { LAS unsigned char* B_ = C.lds + (bb) * S2_BUF; _Pragma("unroll") for (int k_ = 0; k_ < 10; ++k_) { const int c0_ = lw + 384 * k_; \
        if (c0_ < 1024) *(LAS u4v*)(B_ + (c0_ >> 4) * 272 + lrow) = R[k_]; \
        else if (c0_ < 2048) *(LAS u4v*)(B_ + S2_OFF_QG + ((c0_ - 1024) >> 4) * 272 + lrow) = R[k_]; \
        else if (c0_ < 2560) *(LAS u4v*)(B_ + S2_OFF_QK + ((c0_ - 2048) >> 3) * 144 + lqk) = R[k_]; \
        else if (c0_ < 2816) *(LAS u4v*)(B_ + S2_OFF_U + (c0_ - 2560) * 16 + l16) = R[k_]; \
        else { const int g_ = (c0_ - 2816) >> 6; LAS bfr* kt_ = (LAS bfr*)(B_ + S2_OFF_KT + lkt + ((g_ ^ lsw) << 3)); const unsigned w_[4] = {R[k_].x, R[k_].y, R[k_].z, R[k_].w}; \
            _Pragma("unroll") for (int i_ = 0; i_ < 8; ++i_) kt_[i_ * 72] = (bfr)((i_ & 1) ? (w_[i_ >> 1] >> 16) : (w_[i_ >> 1] & 0xffffu)); } } } while (0)
            u4v rc[10];
            S2_LOAD(ra, 0); S2_WRITE(ra, 0);
            S2_LOAD(rb, 1); S2_LOAD(rc, 2); S2_LOAD(ra, 3);
            __syncthreads();
#define S2_STEP(R, bb, n_) { S2_WRITE(R, bb); S2_LOAD(R, (n_) + 4); __syncthreads(); }
            for (int n = 0; n < NCH - 4; n += 6) {
                S2_STEP(rb, 1, n) S2_STEP(rc, 0, n + 1) S2_STEP(ra, 1, n + 2) S2_STEP(rb, 0, n + 3) S2_STEP(rc, 1, n + 4) S2_STEP(ra, 0, n + 5)
            }
            static_assert((NCH - 4) % 6 == 0, "scan loader schedule");
            S2_WRITE(rb, 1); __syncthreads(); S2_WRITE(rc, 0); __syncthreads(); S2_WRITE(ra, 1); __syncthreads(); __syncthreads();
#undef S2_STEP
#undef S2_LOAD
#undef S2_WRITE
        } else {
            const int nt = wave;
            f4v S[8];
#pragma unroll
            for (int w = 0; w < 8; ++w) S[w] = zero_acc();
            __syncthreads();
            for (int n = 0; n < NCH; ++n) {
                if (MODE == 3 || MODE == 4) { __syncthreads(); continue; }
                const LAS unsigned char* B = C.lds + (n & 1) * S2_BUF;
                const LAS bfr* sW = (const LAS bfr*)B; const LAS bfr* sQG = (const LAS bfr*)(B + S2_OFF_QG); const LAS bfr* sQK = (const LAS bfr*)(B + S2_OFF_QK);
                const LAS bfr* sKT = (const LAS bfr*)(B + S2_OFF_KT); const LAS bfr* sU = (const LAS bfr*)(B + S2_OFF_U);
#define S2_STAGE() asm volatile("" ::: "memory")
#define S2_LOADQ(F, mt) do { _Pragma("unroll") for (int ks = 0; ks < 4; ++ks) { F[ks] = s2_frag(sW + (16 * (mt) + r) * 136 + 32 * ks, q); F[4 + ks] = s2_frag(sQG + (16 * (mt) + r) * 136 + 32 * ks, q); } } while (0)
#define S2_MMQ(F, mt) do { _Pragma("unroll") for (int ks = 0; ks < 4; ++ks) { a1[mt] = __builtin_amdgcn_mfma_f32_16x16x32_bf16(F[ks], Bs[ks], a1[mt], 0, 0, 0); \
        a2[mt] = __builtin_amdgcn_mfma_f32_16x16x32_bf16(F[4 + ks], Bs[ks], a2[mt], 0, 0, 0); } } while (0)
                s8v fA[8], fB[8];
                S2_LOADQ(fA, 0); S2_LOADQ(fB, 1);
                s8v Bs[4];
#pragma unroll
                for (int ks = 0; ks < 4; ++ks) Bs[ks] = s2_pack(S[2 * ks], S[2 * ks + 1]);
                f4v a1[4], a2[4];
#pragma unroll
                for (int mt = 0; mt < 4; ++mt) { a1[mt] = zero_acc(); a2[mt] = zero_acc(); }
                S2_STAGE();
                S2_MMQ(fA, 0); S2_STAGE(); S2_LOADQ(fA, 2); S2_STAGE();
                S2_MMQ(fB, 1); S2_STAGE(); S2_LOADQ(fB, 3);
                bfr ur[16]; s8v fa[8];
#pragma unroll
                for (int mt = 0; mt < 4; ++mt) { const LAS bfr* pU = sU + (16 * mt + 4 * q) * 32 + 16 * nt + r; ur[4 * mt] = pU[0]; ur[4 * mt + 1] = pU[32]; ur[4 * mt + 2] = pU[64]; ur[4 * mt + 3] = pU[96]; }
                S2_STAGE();
                S2_MMQ(fA, 2); S2_STAGE();
#pragma unroll
                for (int mt = 0; mt < 4; ++mt)
#pragma unroll
                    for (int k2 = 0; k2 < 2; ++k2) fa[2 * mt + k2] = s2_frag(sQK + (16 * mt + r) * 72 + 32 * k2, q);
                S2_STAGE();
                S2_MMQ(fB, 3); S2_STAGE();
#undef S2_LOADQ
#undef S2_MMQ
                s8v fk[16];
#pragma unroll
                for (int w = 0; w < 8; ++w)
#pragma unroll
                    for (int k2 = 0; k2 < 2; ++k2) fk[2 * w + k2] = s2_fragx(sKT + (16 * w + r) * 72 + 32 * k2, q ^ w, (4 + q) ^ w);
                const float eg = sEG[n];
                S2_STAGE();
                f4v vn[4];
#pragma unroll
                for (int mt = 0; mt < 4; ++mt) vn[mt] = (f4v){bf1(ur[4 * mt]) - a1[mt][0], bf1(ur[4 * mt + 1]) - a1[mt][1], bf1(ur[4 * mt + 2]) - a1[mt][2], bf1(ur[4 * mt + 3]) - a1[mt][3]};
                s8v Bv[2];
#pragma unroll
                for (int k2 = 0; k2 < 2; ++k2) Bv[k2] = s2_pack(vn[2 * k2], vn[2 * k2 + 1]);
#pragma unroll
                for (int k2 = 0; k2 < 2; ++k2)
#pragma unroll
                    for (int mt = 0; mt < 4; ++mt) a2[mt] = __builtin_amdgcn_mfma_f32_16x16x32_bf16(fa[2 * mt + k2], Bv[k2], a2[mt], 0, 0, 0);
#pragma unroll
                for (int w = 0; w < 8; ++w) S[w] *= eg;
#pragma unroll
                for (int k2 = 0; k2 < 2; ++k2)
#pragma unroll
                    for (int w = 0; w < 8; ++w) S[w] = __builtin_amdgcn_mfma_f32_16x16x32_bf16(fk[2 * w + k2], Bv[k2], S[w], 0, 0, 0);
#pragma unroll
                for (int mt = 0; mt < 4; ++mt) {
                    GAS bfr* po = Og + (size_t)(b * SEQ + n * CH + 16 * mt + 4 * q) * DM + h * 128 + es * 32 + 16 * nt + r;
                    po[0] = f2bf1(a2[mt][0]); po[DM] = f2bf1(a2[mt][1]); po[2 * DM] = f2bf1(a2[mt][2]); po[3 * DM] = f2bf1(a2[mt][3]); }
#undef S2_STAGE
                MFMA_SETTLE(S[7]);
                __syncthreads();
            }
        }
        __syncthreads();
    }
}
#undef S2_OFF_QG
#undef S2_OFF_QK
#undef S2_OFF_KT
#undef S2_OFF_U
#undef S2_BUF

__device__ __forceinline__ void p_gdn_onorm(const Ctx& C, const Ptrs& P) {
    unsigned char* ws = P.ws_(); const bfr* Og = (const bfr*)(ws + WS_R + R_O); const bfr* PROJ = (const bfr*)(ws + WS_BIG); bfr* AO = (bfr*)(ws + WS_XN); const float* og = P.in_(6);
    const size_t gt = (size_t)C.vcu * 512 + C.tid, GT = (size_t)C.G * 512;
    for (size_t idx0 = gt; idx0 < (size_t)NT * DM / 8; idx0 += 4 * GT) {
        u4v o8[4], z8[4];
#pragma unroll
        for (int b4 = 0; b4 < 4; ++b4) { const size_t idx = idx0 + b4 * GT; const size_t t = idx >> 9; const int hh = (int)(idx >> 4) & 31, i = (int)idx & 15;
            o8[b4] = *(const u4v*)(Og + t * DM + hh * 128 + 8 * i); z8[b4] = *(const u4v*)(PROJ + t * 16384 + 12288 + hh * 128 + 8 * i); }
        const int i = (int)idx0 & 15;
        const f4v g0 = *(const f4v*)(og + 8 * i), g1 = *(const f4v*)(og + 8 * i + 4); const float g[8] = {g0[0], g0[1], g0[2], g0[3], g1[0], g1[1], g1[2], g1[3]};
#pragma unroll
        for (int b4 = 0; b4 < 4; ++b4) { const size_t idx = idx0 + b4 * GT; const size_t t = idx >> 9; const int hh = (int)(idx >> 4) & 31;
            float o[8] = {bflo(o8[b4].x), bfhi(o8[b4].x), bflo(o8[b4].y), bfhi(o8[b4].y), bflo(o8[b4].z), bfhi(o8[b4].z), bflo(o8[b4].w), bfhi(o8[b4].w)};
            float z[8] = {bflo(z8[b4].x), bfhi(z8[b4].x), bflo(z8[b4].y), bfhi(z8[b4].y), bflo(z8[b4].z), bfhi(z8[b4].z), bflo(z8[b4].w), bfhi(z8[b4].w)};
            float ss = 0.f;
#pragma unroll
            for (int k = 0; k < 8; ++k) ss += o[k] * o[k];
            ss += __shfl_xor(ss, 1); ss += __shfl_xor(ss, 2); ss += __shfl_xor(ss, 4); ss += __shfl_xor(ss, 8);
            const float rn = __builtin_amdgcn_rsqf(ss * (1.f / 128.f) + EPS);
            float y[8];
#pragma unroll
            for (int k = 0; k < 8; ++k) y[k] = o[k] * rn * g[k] * (z[k] * __builtin_amdgcn_rcpf(1.f + __expf(-z[k])));
#if F8_OUT0
#pragma unroll
            for (int k = 0; k < 8; ++k) y[k] = fminf(fmaxf(y[k] * SO, -440.f), 440.f);
            u2v w; w.x = cvt4_fp8(y[0], y[1], y[2], y[3]); w.y = cvt4_fp8(y[4], y[5], y[6], y[7]);
            *(u2v*)(ws + WS_XN8 + t * DM + hh * 128 + 8 * i) = w; }
#else
            u4v w; w.x = cvtpk(y[0], y[1]); w.y = cvtpk(y[2], y[3]); w.z = cvtpk(y[4], y[5]); w.w = cvtpk(y[6], y[7]);
            *(u4v*)(AO + t * DM + hh * 128 + 8 * i) = w; }
#endif
    }
}
__device__ __forceinline__ unsigned mono_key(float x) { const unsigned u = __float_as_uint(x); return u ^ ((unsigned)((int)u >> 31) | 0x80000000u); }
#define KEY_INS(K, key) do { unsigned x_ = (key); _Pragma("unroll") for (int s_ = 0; s_ < 16; ++s_) { const unsigned hi_ = max(K[s_], x_); x_ = min(K[s_], x_); K[s_] = hi_; } } while (0)
__device__ __forceinline__ void p_route(const Ctx& C, const Ptrs& P) {
    unsigned char* ws = P.ws_(); const float* SC = (const float*)(ws + WS_SC); bfr* G = (bfr*)(ws + WS_G);
    LAS unsigned char* wl = C.lds + C.wave * 16384;
    LAS int* sE = (LAS int*)(wl); LAS float* sGt = (LAS float*)(wl + 2048); LAS float* sV1 = (LAS float*)(wl + 4096); LAS float* sV2 = (LAS float*)(wl + 8192); LAS int* sI = (LAS int*)(wl + 12288);
    const int lane = C.lane, gw = C.vcu * 8 + C.wave, NGW = C.G * 8;
    for (int wt = gw; wt < NT / 4; wt += NGW) {
        const int tl = lane >> 4, t = wt * 4 + tl;
        unsigned k1[16];
#pragma unroll
        for (int i = 0; i < 16; ++i) k1[i] = 0u;
        const float* base = SC + (size_t)t * PQ + (lane & 15) * 128;
        for (int e = 0; e < 128; e += 4) { const f4v x4 = *(const f4v*)(base + e);
            KEY_INS(k1, (mono_key(x4[0]) & ~127u) | (unsigned)(127 - e)); KEY_INS(k1, (mono_key(x4[1]) & ~127u) | (unsigned)(126 - e));
            KEY_INS(k1, (mono_key(x4[2]) & ~127u) | (unsigned)(125 - e)); KEY_INS(k1, (mono_key(x4[3]) & ~127u) | (unsigned)(124 - e)); }
        const bool h0 = (lane & 1) == 0;
        float v1[16], v2[16];
#pragma unroll
        for (int i = 0; i < 16; ++i) { const int id = 127 - (int)(k1[i] & 127u); const float vv = base[id];
            const float ov = __shfl_xor(vv, 1); const int oi = __shfl_xor(id, 1);
            v1[i] = h0 ? vv : ov; v2[i] = h0 ? ov : vv; const int ia = h0 ? id : oi, ib = h0 ? oi : id;
            sV1[i * 64 + lane] = v1[i]; sV2[i * 64 + lane] = v2[i]; sI[i * 64 + lane] = ia | (ib << 8); }
        unsigned k2[16];
#pragma unroll
        for (int i = 0; i < 16; ++i) k2[i] = 0u;
#pragma unroll
        for (int a = 0; a < 16; ++a)
#pragma unroll
            for (int b = 0; b < 16; ++b)
                if ((a + 1) * (b + 1) <= 16) KEY_INS(k2, (mono_key(v1[a] + v2[b]) & ~255u) | (unsigned)(255 - (a * 16 + b)));
        LDS_WAIT(); asm volatile("" ::: "memory");
        float ts[16]; int te[16]; float mx = -__builtin_inff();
#pragma unroll
        for (int i = 0; i < 16; ++i) { const int code = 255 - (int)(k2[i] & 255u), a = code >> 4, b = code & 15;
            ts[i] = sV1[a * 64 + lane] + sV2[b * 64 + lane]; te[i] = (sI[a * 64 + lane] & 0xff) * 128 + (sI[b * 64 + lane] >> 8); mx = fmaxf(mx, ts[i]); }
        float sum = 0.f;
#pragma unroll
        for (int i = 0; i < 16; ++i) { ts[i] = __expf(ts[i] - mx); sum += ts[i]; }
        const float inv = 1.f / sum;
        if (h0) { const int hb = ((lane >> 1) & 7) * 16;
#pragma unroll
            for (int i = 0; i < 16; ++i) { sE[tl * 128 + hb + i] = te[i]; sGt[tl * 128 + hb + i] = ts[i] * inv; } }
        LDS_WAIT(); asm volatile("" ::: "memory");
        for (int k = 0; k < 4; ++k) {
            const size_t tt = (size_t)wt * 4 + k; u4v* row = (u4v*)(G + tt * PE); const u4v z = {0u, 0u, 0u, 0u};
#pragma unroll 8
            for (int j = 0; j < 32; ++j) row[j * 64 + lane] = z;
            const int e0 = sE[k * 128 + lane], e1 = sE[k * 128 + 64 + lane]; float t0 = 0.f, t1 = 0.f; bool f0 = true, f1 = true;
            for (int j = 0; j < 128; j += 4) { const i4v ej = *(const LAS i4v*)(sE + k * 128 + j); const f4v gj = *(const LAS f4v*)(sGt + k * 128 + j);
                if (ej.x == e0) { t0 += gj[0]; if (j + 0 < lane) f0 = false; } if (ej.y == e0) { t0 += gj[1]; if (j + 1 < lane) f0 = false; }
                if (ej.z == e0) { t0 += gj[2]; if (j + 2 < lane) f0 = false; } if (ej.w == e0) { t0 += gj[3]; if (j + 3 < lane) f0 = false; }
                if (ej.x == e1) { t1 += gj[0]; if (j + 0 < lane + 64) f1 = false; } if (ej.y == e1) { t1 += gj[1]; if (j + 1 < lane + 64) f1 = false; }
                if (ej.z == e1) { t1 += gj[2]; if (j + 2 < lane + 64) f1 = false; } if (ej.w == e1) { t1 += gj[3]; if (j + 3 < lane + 64) f1 = false; } }
            VM_WAIT();
            if (f0) G[tt * PE + e0] = f2bf1(t0);
            if (f1) G[tt * PE + e1] = f2bf1(t1);
        }
        LDS_WAIT(); asm volatile("" ::: "memory");
    }
}

typedef _Float16 h2v __attribute__((ext_vector_type(2)));
__device__ __forceinline__ unsigned char gate_code(float g) { const float c = 195.f + 20.f * __log2f(g); return (unsigned char)(int)fminf(fmaxf(c + 0.5f, 1.f), 255.f); }
__device__ __forceinline__ void p_sroute(const Ctx& C, const Ptrs& P, int layer) {
    unsigned char* ws = P.ws_(); const bfr* QRY = (const bfr*)(ws + WS_QRY); const bfr* KEY = (const bfr*)(ws + WS_WTKEY) + (size_t)layer * PQ * PQ; unsigned char* G = ws + WS_G;
    const int lane = C.lane, wave = C.wave, r = lane & 15, q = lane >> 4;
    LAS unsigned char* wl = C.lds + wave * 16640;
    LAS _Float16* sS = (LAS _Float16*)wl;
    LAS float* sV1 = (LAS float*)(wl); LAS float* sV2 = (LAS float*)(wl + 4096); LAS int* sI = (LAS int*)(wl + 8192);
    LAS int* sE = (LAS int*)(C.lds); LAS float* sGt = (LAS float*)(C.lds + 16384);
    LAS unsigned* bm = (LAS unsigned*)(C.lds + 32768 + wave * 3200); LAS unsigned* cnt = bm + 512; LAS int* le = (LAS int*)(bm + 516); LAS float* lg = (LAS float*)(bm + 516 + 128);
    for (int blk = C.vcu; blk < NT / 32; blk += C.G) {
        const int t0 = blk * 32;
#pragma unroll
        for (int hf = 0; hf < 2; ++hf) {
            const int hh = wave * 2 + hf;
            s8v a[2][4];
#pragma unroll
            for (int mt = 0; mt < 2; ++mt)
#pragma unroll
                for (int ks = 0; ks < 4; ++ks) a[mt][ks] = *(const s8v*)(QRY + (size_t)(t0 + 16 * mt + r) * PQ + hh * 128 + 32 * ks + 8 * q);
#pragma unroll
            for (int nt = 0; nt < 8; ++nt) {
                s8v b[4];
#pragma unroll
                for (int ks = 0; ks < 4; ++ks) b[ks] = *(const s8v*)(KEY + (size_t)(hh * 128 + 16 * nt + r) * PQ + hh * 128 + 32 * ks + 8 * q);
                f4v c0 = zero_acc(), c1 = zero_acc();
#pragma unroll
                for (int ks = 0; ks < 4; ++ks) { c0 = __builtin_amdgcn_mfma_f32_16x16x32_bf16(a[0][ks], b[ks], c0, 0, 0, 0); c1 = __builtin_amdgcn_mfma_f32_16x16x32_bf16(a[1][ks], b[ks], c1, 0, 0, 0); MFMA_SETTLE(c0); MFMA_SETTLE(c1); }
                MFMA_SETTLE(c0); MFMA_SETTLE(c1);
#pragma unroll
                for (int e = 0; e < 4; ++e) { sS[(32 * hf + 4 * q + e) * 130 + 16 * nt + r] = (_Float16)c0[e]; sS[(32 * hf + 16 + 4 * q + e) * 130 + 16 * nt + r] = (_Float16)c1[e]; }
            }
        }
        LDS_WAIT(); asm volatile("" ::: "memory");
        unsigned k1[16];
#pragma unroll
        for (int i = 0; i < 16; ++i) k1[i] = 0u;
        const LAS h2v* lp = (const LAS h2v*)(sS + lane * 130);
        for (int e = 0; e < 128; e += 8) {
#pragma unroll
            for (int u = 0; u < 4; ++u) { const h2v x2 = lp[(e >> 1) + u];
                KEY_INS(k1, (mono_key((float)x2[0]) & ~127u) | (unsigned)(127 - e - 2 * u)); KEY_INS(k1, (mono_key((float)x2[1]) & ~127u) | (unsigned)(126 - e - 2 * u)); }
        }
        const bool h0 = lane < 32;
        float v1[16], v2[16]; int ids[16]; float vals[16];
#pragma unroll
        for (int i = 0; i < 16; ++i) { ids[i] = 127 - (int)(k1[i] & 127u); vals[i] = (float)sS[lane * 130 + ids[i]]; }
        LDS_WAIT(); asm volatile("" ::: "memory");
#pragma unroll
        for (int i = 0; i < 16; ++i) { const float ov = __shfl_xor(vals[i], 32); const int oi = __shfl_xor(ids[i], 32);
            v1[i] = h0 ? vals[i] : ov; v2[i] = h0 ? ov : vals[i]; const int ia = h0 ? ids[i] : oi, ib = h0 ? oi : ids[i];
            sV1[i * 64 + lane] = v1[i]; sV2[i * 64 + lane] = v2[i]; sI[i * 64 + lane] = ia | (ib << 8); }
        unsigned k2[16];
#pragma unroll
        for (int b = 0; b < 16; ++b) k2[b] = (mono_key(v1[0] + v2[b]) & ~255u) | (unsigned)(255 - b);
#pragma unroll
        for (int a = 1; a < 16; ++a)
#pragma unroll
            for (int b = 0; b < 16; ++b)
                if ((a + 1) * (b + 1) <= 16) KEY_INS(k2, (mono_key(v1[a] + v2[b]) & ~255u) | (unsigned)(255 - (a * 16 + b)));
        LDS_WAIT(); asm volatile("" ::: "memory");
        float ts[16]; int te[16]; float mx = -__builtin_inff();
#pragma unroll
        for (int i = 0; i < 16; ++i) { const int code = 255 - (int)(k2[i] & 255u), a = code >> 4, b = code & 15;
            ts[i] = sV1[a * 64 + lane] + sV2[b * 64 + lane]; te[i] = (sI[a * 64 + lane] & 0xff) * 128 + (sI[b * 64 + lane] >> 8); mx = fmaxf(mx, ts[i]); }
        float sum = 0.f;
#pragma unroll
        for (int i = 0; i < 16; ++i) { ts[i] = __expf(ts[i] - mx); sum += ts[i]; }
        const float inv = 1.f / sum;
        __syncthreads();
        if (h0) {
#pragma unroll
            for (int i = 0; i < 16; ++i) { sE[lane * 128 + wave * 16 + i] = te[i]; sGt[lane * 128 + wave * 16 + i] = ts[i] * inv; } }
        __syncthreads();
        for (int k = 0; k < 4; ++k) {
            const int tl = wave * 4 + k; const size_t tt = (size_t)t0 + tl;
            if (layer == 0) { u4v* row = (u4v*)(G + tt * PE); const u4v z = {0u, 0u, 0u, 0u};
#pragma unroll 8
                for (int j = 0; j < 16; ++j) row[j * 64 + lane] = z; }
            const int e0 = sE[tl * 128 + lane], e1 = sE[tl * 128 + 64 + lane]; float t0s = sGt[tl * 128 + lane], t1s = sGt[tl * 128 + 64 + lane];
#pragma unroll
            for (int j = 0; j < 8; ++j) bm[j * 64 + lane] = 0u;
            if (lane == 0) *cnt = 0u;
            LDS_WAIT(); asm volatile("" ::: "memory");
            const unsigned b0 = 1u << (e0 & 31), b1 = 1u << (e1 & 31);
            const bool d0 = (__hip_atomic_fetch_or(bm + (e0 >> 5), b0, __ATOMIC_RELAXED, __HIP_MEMORY_SCOPE_WORKGROUP) & b0) != 0u;
            const bool d1 = (__hip_atomic_fetch_or(bm + (e1 >> 5), b1, __ATOMIC_RELAXED, __HIP_MEMORY_SCOPE_WORKGROUP) & b1) != 0u;
            if (d0) { const unsigned sl = __hip_atomic_fetch_add(cnt, 1u, __ATOMIC_RELAXED, __HIP_MEMORY_SCOPE_WORKGROUP); le[sl] = e0; lg[sl] = t0s; }
            if (d1) { const unsigned sl = __hip_atomic_fetch_add(cnt, 1u, __ATOMIC_RELAXED, __HIP_MEMORY_SCOPE_WORKGROUP); le[sl] = e1; lg[sl] = t1s; }
            LDS_WAIT(); asm volatile("" ::: "memory");
            const int nd = (int)__builtin_amdgcn_readfirstlane((int)*cnt);
            for (int j = 0; j < nd; ++j) { const int ej = le[j]; const float gj = lg[j]; if (ej == e0 && !d0) t0s += gj; if (ej == e1 && !d1) t1s += gj; }
            const bool f0 = !d0, f1 = !d1;
            VM_WAIT();
            if (f0) G[tt * PE + e0] = gate_code(t0s);
            if (f1) G[tt * PE + e1] = gate_code(t1s);
        }
        __syncthreads();
    }
}

constexpr int KIND_V = F8_KVQ ? 2 : 1;
__device__ __forceinline__ void p_headprep(const Ctx& C, const Ptrs& P) {
    unsigned char* ws = P.ws_(); const bfr* KVQ = (const bfr*)(ws + WS_BIG); bfr* Qh = (bfr*)(ws + WS_R + R_QH); bfr* Kh = (bfr*)(ws + WS_R + R_KH); bfr* Vh = (bfr*)(ws + WS_R + R_VH);
    const float* kg = P.in_(10); const float* qg = P.in_(13);
    const size_t gt = (size_t)C.vcu * 512 + C.tid, GT = (size_t)C.G * 512;
    constexpr int NV16 = F8_KVQ ? 1024 : 1536;
    for (size_t idx0 = gt; idx0 < (size_t)NT * NV16; idx0 += 4 * GT) {
        u4v x8[4];
#pragma unroll
        for (int b4 = 0; b4 < 4; ++b4) { const size_t idx = idx0 + b4 * GT; const size_t t = idx / NV16; const int rem = (int)(idx - t * NV16), vec = rem >> 4, i = rem & 15;
            x8[b4] = *(const u4v*)(KVQ + t * 12288 + vec * 128 + 8 * i); }
#pragma unroll
        for (int b4 = 0; b4 < 4; ++b4) { const size_t idx = idx0 + b4 * GT; const size_t t = idx / NV16; const int rem = (int)(idx - t * NV16), vec = rem >> 4, i = rem & 15, kind = vec >> 5, sh = vec & 31;
            float x[8] = {bflo(x8[b4].x), bfhi(x8[b4].x), bflo(x8[b4].y), bfhi(x8[b4].y), bflo(x8[b4].z), bfhi(x8[b4].z), bflo(x8[b4].w), bfhi(x8[b4].w)};
            float ss = 0.f;
#pragma unroll
            for (int k = 0; k < 8; ++k) ss += x[k] * x[k];
            ss += __shfl_xor(ss, 1); ss += __shfl_xor(ss, 2); ss += __shfl_xor(ss, 4); ss += __shfl_xor(ss, 8);
            u4v w = x8[b4];
            if (kind != KIND_V) { const float rn = __builtin_amdgcn_rsqf(ss * (1.f / 128.f) + EPS); const float* gp = (kind == 0 ? kg : qg) + 8 * i; const f4v g0 = *(const f4v*)gp, g1 = *(const f4v*)(gp + 4);
                w.x = cvtpk(x[0] * rn * g0[0], x[1] * rn * g0[1]); w.y = cvtpk(x[2] * rn * g0[2], x[3] * rn * g0[3]); w.z = cvtpk(x[4] * rn * g1[0], x[5] * rn * g1[1]); w.w = cvtpk(x[6] * rn * g1[2], x[7] * rn * g1[3]); }
            const size_t b = t >> 12, s = t & 4095; bfr* dst = (kind == 0 ? Kh : (kind == KIND_V ? Vh : Qh)) + ((b * 32 + sh) * SEQ + s) * 128 + 8 * i;
            *(u4v*)dst = w; }
    }
}

__device__ __forceinline__ att::BlockRef<att::bf16, att::bf16> attn_ref(const att::bf16* Qh, const att::bf16* Kh, const att::bf16* Vh, att::bf16* Oh, int bhp, int qb) {
    const int b = bhp >> 6, hd = (bhp >> 2) & 15, c = (bhp >> 1) & 1, vh = bhp & 1;
    att::BlockRef<att::bf16, att::bf16> r;
    r.Q = Qh + ((size_t)(b * 32 + hd * 2 + c) * SEQ + (size_t)qb * 256) * 128; r.K = Kh + (size_t)(b * 32 + hd * 2 + c) * SEQ * 128; r.V = att::VSTR == 128 ? Vh + (size_t)(b * 32 + hd * 2 + vh) * SEQ * 128 : Vh + (size_t)b * SEQ * att::VSTR + 8192 + (hd * 2 + vh) * 128;
    r.O = Oh + ((size_t)bhp * SEQ + (size_t)qb * 256) * 128; r.P0 = qb * 256;
    return r;
}
__device__ __forceinline__ void p_attn(const Ctx& C, const Ptrs& P) {
    unsigned char* ws = P.ws_(); const att::bf16* Qh = (const att::bf16*)(ws + WS_R + R_QH); const att::bf16* Kh = (const att::bf16*)(ws + WS_R + R_KH); const att::bf16* Vh = (const att::bf16*)(att::VSTR == 128 ? ws + WS_R + R_VH : ws + WS_BIG);
    att::bf16* Oh = (att::bf16*)(ws + WS_R + R_OH);
    extern __shared__ __attribute__((aligned(16))) char lds_sym[]; char* lds = lds_sym;
    constexpr int total = 128 * 8;
    int L = C.vcu; if (L >= total) return;
    int pass = 0;
    att::BlockRef<att::bf16, att::bf16> cur = attn_ref(Qh, Kh, Vh, Oh, L >> 3, L & 7);
    att::Seam<att::bf16> S;
    att::causal_swa_prime<att::bf16, att::bf16>(cur, SEQ, lds, S);
    for (;;) {
        const bool more_pass = pass == 0, more_item = L + C.G < total, last = !more_pass && !more_item;
        int passn = pass + 1, Ln = L;
        if (!more_pass) { passn = 0; Ln = more_item ? L + C.G : L; }
        const att::BlockRef<att::bf16, att::bf16> nxt = last ? cur : attn_ref(Qh, Kh, Vh, Oh, Ln >> 3, passn ? 15 - (Ln & 7) : (Ln & 7));
        att::causal_swa_block<att::bf16, att::bf16>(cur, nxt, SEQ, SEQ, lds, S);
        if (last) break;
        cur = nxt; pass = passn; L = Ln;
    }
    __syncthreads();
}

__device__ __forceinline__ void p_combine(const Ctx& C, const Ptrs& P) {
    unsigned char* ws = P.ws_(); const bfr* Oh = (const bfr*)(ws + WS_R + R_OH); bfr* AO = (bfr*)(ws + WS_XN); const float* sg = P.in_(18);
    float lam;
    { const float* q1 = P.in_(14); const float* k1 = P.in_(15); const float* q2 = P.in_(16); const float* k2 = P.in_(17); const int l = C.lane;
      const float d1 = wave_sum(q1[l] * k1[l] + q1[l + 64] * k1[l + 64]), d2 = wave_sum(q2[l] * k2[l] + q2[l + 64] * k2[l + 64]);
      lam = expf(d1) - expf(d2) + LAMBDA_INIT; }
    const size_t gt = (size_t)C.vcu * 512 + C.tid, GT = (size_t)C.G * 512;
    for (size_t idx0 = gt; idx0 < (size_t)NT * 512; idx0 += 4 * GT) {
        u4v a8[4], b8[4];
#pragma unroll
        for (int b4 = 0; b4 < 4; ++b4) { const size_t idx = idx0 + b4 * GT; const size_t t = idx >> 9, b = t >> 12, s = t & 4095; const int hd = (int)(idx >> 5) & 15, i = (int)idx & 31, vh = i >> 4, d = (8 * i) & 127;
            const size_t o0i = ((((b * 16 + hd) * 2 + 0) * 2 + vh) * SEQ + s) * 128 + d, o1i = ((((b * 16 + hd) * 2 + 1) * 2 + vh) * SEQ + s) * 128 + d;
            a8[b4] = *(const u4v*)(Oh + o0i); b8[b4] = *(const u4v*)(Oh + o1i); }
        const int i = (int)idx0 & 31;
        const f4v g0 = *(const f4v*)(sg + 8 * i), g1 = *(const f4v*)(sg + 8 * i + 4);
#pragma unroll
        for (int b4 = 0; b4 < 4; ++b4) { const size_t idx = idx0 + b4 * GT; const size_t t = idx >> 9; const int hd = (int)(idx >> 5) & 15;
            float o[8] = {bflo(a8[b4].x) - lam * bflo(b8[b4].x), bfhi(a8[b4].x) - lam * bfhi(b8[b4].x), bflo(a8[b4].y) - lam * bflo(b8[b4].y), bfhi(a8[b4].y) - lam * bfhi(b8[b4].y),
                          bflo(a8[b4].z) - lam * bflo(b8[b4].z), bfhi(a8[b4].z) - lam * bfhi(b8[b4].z), bflo(a8[b4].w) - lam * bflo(b8[b4].w), bfhi(a8[b4].w) - lam * bfhi(b8[b4].w)};
            float ss = 0.f;
#pragma unroll
            for (int k = 0; k < 8; ++k) ss += o[k] * o[k];
            ss += __shfl_xor(ss, 1); ss += __shfl_xor(ss, 2); ss += __shfl_xor(ss, 4); ss += __shfl_xor(ss, 8); ss += __shfl_xor(ss, 16);
            const float rn = __builtin_amdgcn_rsqf(ss * (1.f / 256.f) + EPS) * (1.f - LAMBDA_INIT);
#if F8_OUT1
            const float rs = rn * SO; float y[8] = {o[0] * rs * g0[0], o[1] * rs * g0[1], o[2] * rs * g0[2], o[3] * rs * g0[3], o[4] * rs * g1[0], o[5] * rs * g1[1], o[6] * rs * g1[2], o[7] * rs * g1[3]};
#pragma unroll
            for (int k = 0; k < 8; ++k) y[k] = fminf(fmaxf(y[k], -440.f), 440.f);
            u2v w; w.x = cvt4_fp8(y[0], y[1], y[2], y[3]); w.y = cvt4_fp8(y[4], y[5], y[6], y[7]);
            *(u2v*)(ws + WS_XN8 + t * DM + hd * 256 + 8 * i) = w; }
#else
            u4v w; w.x = cvtpk(o[0] * rn * g0[0], o[1] * rn * g0[1]); w.y = cvtpk(o[2] * rn * g0[2], o[3] * rn * g0[3]); w.z = cvtpk(o[4] * rn * g1[0], o[5] * rn * g1[1]); w.w = cvtpk(o[6] * rn * g1[2], o[7] * rn * g1[3]);
            *(u4v*)(AO + t * DM + hd * 256 + 8 * i) = w; }
#endif
    }
}
constexpr int NPH_LAYER = 13, NPHASE = 1 + 2 * NPH_LAYER;
#ifndef MK_PER_PHASE
#define MK_PER_PHASE 0
#endif

__global__ void __launch_bounds__(512, 2) trunk_fwd(KArgs KA) {
    extern __shared__ __attribute__((aligned(16))) unsigned char lds_raw[];
    Ctx C; C.lds = (LAS unsigned char*)lds_raw; C.tid = threadIdx.x; C.lane = C.tid & 63; C.wave = __builtin_amdgcn_readfirstlane(C.tid >> 6);
    C.G = gridDim.x; { const int bx = blockIdx.x; C.vcu = (C.G % 8 == 0) ? (bx % 8) * (C.G / 8) + bx / 8 : bx; }
    volatile LAS unsigned* MISC = (volatile LAS unsigned*)(C.lds + MISC_OFF);
    for (int u = C.tid; u < (LDS_BYTES - MISC_OFF) / 4; u += 512) MISC[u] = 0u;
    __syncthreads();
    Ptrs P; P.tbl = (LAS unsigned long long*)(C.lds + MISC_OFF + 128);
    if (C.tid < 28) P.tbl[C.tid] = ((const unsigned long long*)&KA)[C.tid];
    __syncthreads();
    unsigned* ctl = (unsigned*)(P.ws_() + WS_CTL);
    const int lo = KA.ph_lo, hi = KA.ph_hi;
    XcdBarrier bar; bar.bar = ctl + CW_BAR + KA.li * XCD_BAR_WORDS; bar.x = 0; bar.st = MISC + 8;
    if (hi - lo > 1) bar = xcd_barrier_post(ctl + CW_BAR + KA.li * XCD_BAR_WORDS, MISC + 8);
#define IN(k) (lo <= (k) && (k) < hi)
#define SEAM(k) do { if (IN(k) && IN((k) + 1)) xcd_barrier(bar); } while (0)
    unsigned char* ws = P.ws_();
    bfr* XN = (bfr*)(ws + WS_XN); bfr* BIG = (bfr*)(ws + WS_BIG);
    const int hb = (int)blockIdx.x;

    if (IN(0)) { p_convert(C, P, 0, C.vcu, C.G); __syncthreads();
#if NPREP >= 32
        p_convert(C, P, 1, C.vcu, C.G); __syncthreads();
#endif
        p_norm_rows(C, P.in_(0), XN, F8_PROJ0 != 0 ? ws + WS_XN8 : nullptr); }
    SEAM(0);
    {
        constexpr int layer = 0;
        const int pb = 1 + layer * NPH_LAYER;
        if (layer == 1 && IN(pb + 0)) p_norm_rows<true>(C, ws + WS_SC, F8_KVQ == 2 ? nullptr : XN, F8_KVQ != 0 ? ws + WS_XN8 : nullptr);
        if (layer == 1) SEAM(pb + 0);
        if (IN(pb + 1)) {
            const int N = layer == 0 ? 16384 : 12288;
            if (layer == 0 && F8_PROJ0 == 2) {
                { pg8::Gemm g{XN, (const bfr*)(ws + WS_WTIN), NT, 8192, DM}; pg8::StaticOrder S; S.init(NT, 8192, C.G, hb);
                  pg8::EpiBf16<0> E{BIG, N, nullptr, 0, 0, 1.f};
                  pg8::gemm_phase<pg8::EpiBf16<0>, pg8::StaticOrder, true, true>((PG8_LAS unsigned char*)C.lds, g, S, E); }
                __syncthreads();
                { pg8::Gemm g{(const bfr*)(ws + WS_XN8), (const bfr*)(ws + WS_WTIN + (size_t)8192 * DM * 2), NT, 8192, DM / 2}; pg8::StaticOrder S; S.init(NT, 8192, C.G, hb);
                  pg8::EpiBf16<0> E{BIG + 8192, N, nullptr, 8192, 0, 1.f / SU};
                  pg8::gemm_phase<pg8::EpiBf16<0>, pg8::StaticOrder, true, true, true>((PG8_LAS unsigned char*)C.lds, g, S, E); }
            } else if (layer == 0 && F8_PROJ0 == 5) {
                { pg8::Gemm g{(const bfr*)(ws + WS_XN8), (const bfr*)(ws + WS_WTIN), NT, 8192, DM / 2}; pg8::StaticOrder S; S.init(NT, 8192, C.G, hb);
                  pg8::EpiBf16<0> E{BIG, N, nullptr, 8192, 0, 1.f / SU};
                  pg8::gemm_phase<pg8::EpiBf16<0>, pg8::StaticOrder, true, true, true>((PG8_LAS unsigned char*)C.lds, g, S, E); }
                __syncthreads();
                { pg8::Gemm g{XN, (const bfr*)(ws + WS_WTIN + (size_t)32 * MiB), NT, 4096, DM}; pg8::StaticOrder S; S.init(NT, 4096, C.G, hb);
                  pg8::EpiBf16<0> E{BIG + 8192, N, nullptr, 0, 0, 1.f};
                  pg8::gemm_phase<pg8::EpiBf16<0>, pg8::StaticOrder, true, true>((PG8_LAS unsigned char*)C.lds, g, S, E); }
                __syncthreads();
                { pg8::Gemm g{(const bfr*)(ws + WS_XN8), (const bfr*)(ws + WS_WTIN + (size_t)64 * MiB), NT, 4096, DM / 2}; pg8::StaticOrder S; S.init(NT, 4096, C.G, hb);
                  pg8::EpiBf16<0> E{BIG + 12288, N, nullptr, 4096, 0, 1.f / SU};
                  pg8::gemm_phase<pg8::EpiBf16<0>, pg8::StaticOrder, true, true, true>((PG8_LAS unsigned char*)C.lds, g, S, E); }
            } else if (layer == 0 && F8_PROJ0 == 6) {
                { pg8::Gemm g{(const bfr*)(ws + WS_XN8), (const bfr*)(ws + WS_WTIN), NT, 12288, DM / 2}; pg8::StaticOrder S; S.init(NT, 12288, C.G, hb);
                  pg8::EpiBf16<0> E{BIG, N, nullptr, 12288, 0, 1.f / SU};
                  pg8::gemm_phase<pg8::EpiBf16<0>, pg8::StaticOrder, true, true, true>((PG8_LAS unsigned char*)C.lds, g, S, E); }
                __syncthreads();
                { pg8::Gemm g{XN, (const bfr*)(ws + WS_WTIN + (size_t)48 * MiB), NT, 4096, DM}; pg8::StaticOrder S; S.init(NT, 4096, C.G, hb);
                  pg8::EpiBf16<0> E{BIG + 12288, N, nullptr, 0, 0, 1.f};
                  pg8::gemm_phase<pg8::EpiBf16<0>, pg8::StaticOrder, true, true>((PG8_LAS unsigned char*)C.lds, g, S, E); }
            } else if (layer == 0 && F8_PROJ0 == 4) {
                { pg8::Gemm g{(const bfr*)(ws + WS_XN8), (const bfr*)(ws + WS_WTIN), NT, 4096, DM / 2}; pg8::StaticOrder S; S.init(NT, 4096, C.G, hb);
                  pg8::EpiBf16<0> E{BIG, N, nullptr, 4096, 0, 1.f / SU};
                  pg8::gemm_phase<pg8::EpiBf16<0>, pg8::StaticOrder, true, true, true>((PG8_LAS unsigned char*)C.lds, g, S, E); }
                __syncthreads();
                { pg8::Gemm g{XN, (const bfr*)(ws + WS_WTIN + (size_t)4096 * DM), NT, 12288, DM}; pg8::StaticOrder S; S.init(NT, 12288, C.G, hb);
                  pg8::EpiBf16<0> E{BIG + 4096, N, nullptr, 0, 0, 1.f};
                  pg8::gemm_phase<pg8::EpiBf16<0>, pg8::StaticOrder, true, true>((PG8_LAS unsigned char*)C.lds, g, S, E); }
            } else if (layer == 0 && F8_PROJ0 == 3) {
                { pg8::Gemm g{(const bfr*)(ws + WS_XN8), (const bfr*)(ws + WS_WTIN), NT, 8192, DM / 2}; pg8::StaticOrder S; S.init(NT, 8192, C.G, hb);
                  pg8::EpiBf16<0> E{BIG, N, nullptr, 8192, 0, 1.f / SU};
                  pg8::gemm_phase<pg8::EpiBf16<0>, pg8::StaticOrder, true, true, true>((PG8_LAS unsigned char*)C.lds, g, S, E); }
                __syncthreads();
                { pg8::Gemm g{XN, (const bfr*)(ws + WS_WTIN + (size_t)8192 * DM), NT, 8192, DM}; pg8::StaticOrder S; S.init(NT, 8192, C.G, hb);
                  pg8::EpiBf16<0> E{BIG + 8192, N, nullptr, 0, 0, 1.f};
                  pg8::gemm_phase<pg8::EpiBf16<0>, pg8::StaticOrder, true, true>((PG8_LAS unsigned char*)C.lds, g, S, E); }
            } else if (layer == 0 && F8_PROJ0 == 1) {
                pg8::Gemm g{(const bfr*)(ws + WS_XN8), (const bfr*)(ws + WS_WTIN), NT, N, DM / 2}; pg8::StaticOrder S; S.init(NT, N, C.G, hb);
                pg8::EpiBf16<0> E{BIG, N, nullptr, N, 0, 1.f / SU};
                pg8::gemm_phase<pg8::EpiBf16<0>, pg8::StaticOrder, true, true, true>((PG8_LAS unsigned char*)C.lds, g, S, E);
            } else if (layer == 1 && F8_KVQ == 2) {
                pg8::Gemm g{(const bfr*)(ws + WS_XN8), (const bfr*)(ws + WS_WTKVQ), NT, N, DM / 2}; pg8::StaticOrder S; S.init(NT, N, C.G, hb);
                pg8::EpiHead E{(bfr*)(ws + WS_R + R_KH), (bfr*)(ws + WS_R + R_QH), (bfr*)(ws + WS_R + R_VH), P.in_(10), P.in_(13), 1.f / SU};
                pg8::gemm_phase<pg8::EpiHead, pg8::StaticOrder, true, true, true>((PG8_LAS unsigned char*)C.lds, g, S, E);
            } else if (layer == 1 && F8_KVQ) {
                { pg8::Gemm g{(const bfr*)(ws + WS_XN8), (const bfr*)(ws + WS_WTKVQ), NT, 8192, DM / 2}; pg8::StaticOrder S; S.init(NT, 8192, C.G, hb);
                  pg8::EpiBf16<0> E{BIG, N, nullptr, 8192, 0, 1.f / SU};
                  pg8::gemm_phase<pg8::EpiBf16<0>, pg8::StaticOrder, true, true, true>((PG8_LAS unsigned char*)C.lds, g, S, E); }
                __syncthreads();
                { pg8::Gemm g{XN, (const bfr*)(ws + WS_WTKVQ + (size_t)2 * DM * DM), NT, DM, DM}; pg8::StaticOrder S; S.init(NT, DM, C.G, hb);
                  pg8::EpiBf16<0> E{BIG + 8192, N, nullptr, 0, 0, 1.f};
                  pg8::gemm_phase<pg8::EpiBf16<0>, pg8::StaticOrder, true, true>((PG8_LAS unsigned char*)C.lds, g, S, E); }
            } else {
                pg8::Gemm g{XN, (const bfr*)(ws + (layer == 0 ? WS_WTIN : WS_WTKVQ)), NT, N, DM}; pg8::StaticOrder S; S.init(NT, N, C.G, hb);
                pg8::EpiBf16<0> E{BIG, N, nullptr, 0, 0, 1.f};
                pg8::gemm_phase<pg8::EpiBf16<0>, pg8::StaticOrder, true, true>((PG8_LAS unsigned char*)C.lds, g, S, E);
            }
            if (layer == 0) { __syncthreads(); p_bd(C, XN, (const bfr*)(ws + WS_WTBD), (float*)(ws + WS_BD));
#ifdef BD_PROBE
                __syncthreads(); p_bd(C, XN, (const bfr*)(ws + WS_WTBD), (float*)(ws + WS_BD));
#endif
            }
        }
        SEAM(pb + 1);
        if (IN(pb + 2)) { if (layer == 1 && F8_KVQ != 2) p_headprep(C, P); }
        if (layer == 1 && F8_KVQ != 2) SEAM(pb + 2);
        if (IN(pb + 3)) { if (layer == 0) {
                if (NPREP >= 32) p_gdn_prep(C, P, C.vcu, C.G);
                else if (C.G == 256) { const int cidx = C.vcu & 31, xcd = C.vcu >> 5;
                    if (cidx < NPREP) p_gdn_prep(C, P, xcd * NPREP + cidx, 8 * NPREP); else p_convert(C, P, 1, xcd * (32 - NPREP) + (cidx - NPREP), 8 * (32 - NPREP)); }
                else { p_convert(C, P, 1, C.vcu, C.G); __syncthreads(); p_gdn_prep(C, P, C.vcu, C.G); }
            } else p_attn(C, P); }
        SEAM(pb + 3);
        if (IN(pb + 4)) { if (layer == 0) p_gdn_scan(C, P); else p_combine(C, P); }
        SEAM(pb + 4);
        if (IN(pb + 5)) { if (layer == 0) p_gdn_onorm(C, P); }
        if (layer == 0) SEAM(pb + 5);
        if (IN(pb + 6)) {
            if ((layer == 0 && F8_OUT0) || (layer == 1 && F8_OUT1)) {
                pg8::Gemm g{(const bfr*)(ws + WS_XN8), (const bfr*)(ws + (layer == 0 ? WS_WTOUT : WS_WTO)), NT, DM, DM / 2}; pg8::StaticOrder S; S.init(NT, DM, C.G, hb);
                if (layer == 0) { pg8::EpiResB<false, true> E{P.in_(0), ws + WS_SC, DM, 1.f / (SO * SU)};
                    pg8::gemm_phase<pg8::EpiResB<false, true>, pg8::StaticOrder, true, true, true>((PG8_LAS unsigned char*)C.lds, g, S, E); }
                else { pg8::EpiResB<true, true> E{ws + WS_SC, ws + WS_SC, DM, 1.f / (SO * SU)};
                    pg8::gemm_phase<pg8::EpiResB<true, true>, pg8::StaticOrder, true, true, true>((PG8_LAS unsigned char*)C.lds, g, S, E); }
            } else {
                pg8::Gemm g{XN, (const bfr*)(ws + (layer == 0 ? WS_WTOUT : WS_WTO)), NT, DM, DM}; pg8::StaticOrder S; S.init(NT, DM, C.G, hb);
                pg8::EpiRes E{layer == 0 ? P.in_(0) : (const float*)P.out_(), P.out_(), DM, 1.f};
                pg8::gemm_phase<pg8::EpiRes, pg8::StaticOrder, true, true>((PG8_LAS unsigned char*)C.lds, g, S, E);
            }
        }
        SEAM(pb + 6);
        if (IN(pb + 7)) p_norm_rows<true>(C, ws + WS_SC, nullptr, ws + WS_XN8, (float*)(ws + WS_BD));
        SEAM(pb + 7);
        if (IN(pb + 8)) {
            pg8::Gemm g{(const bfr*)(ws + WS_SC), (const bfr*)(ws + WS_WTQRY) + (size_t)layer * PQ * DM, NT, PQ, DM}; pg8::StaticOrder S; S.init(NT, PQ, C.G, hb);
            pg8::EpiBf16R E{(bfr*)(ws + WS_QRY), PQ, (const float*)(ws + WS_BD)};
            pg8::gemm_phase<pg8::EpiBf16R, pg8::StaticOrder, true, true>((PG8_LAS unsigned char*)C.lds, g, S, E);
        }
        SEAM(pb + 8);
        if (IN(pb + 9)) { p_sroute(C, P, layer); }
        SEAM(pb + 9); if (IN(pb + 9) && !IN(pb + 10) && IN(pb + 11)) xcd_barrier(bar);
        if (IN(pb + 11)) {
            pg8::Gemm g{(const bfr*)(ws + WS_XN8), (const bfr*)(ws + WS_U + (size_t)layer * PE * DM), NT, PE, DM / 2}; pg8::StaticOrder S; S.init(NT, PE, C.G, hb);
#ifdef G1_PROBE
            if (layer == 0) { pg8::StaticOrder S2; S2.init(NT, PE, C.G, hb); pg8::EpiGate8<G1_PROBE> E2{(bfr*)(ws + WS_G), ws + WS_A2, PE, 1.f / SU, SA};
                pg8::gemm_phase<pg8::EpiGate8<G1_PROBE>, pg8::StaticOrder, true, true, true>((PG8_LAS unsigned char*)C.lds, g, S2, E2); __syncthreads(); }
#endif
#if STAGGER_G1
            {
                const int sg = C.vcu & 7;
                if (sg) { const unsigned long long t0 = __builtin_amdgcn_s_memrealtime(); while (__builtin_amdgcn_s_memrealtime() - t0 < (unsigned long long)(sg * STAGGER_G1)) __builtin_amdgcn_s_sleep(4); }
            }
#endif
            pg8::EpiGate8C E{ws + WS_G, ws + WS_A2, PE, 1.f / SU, SA};
            pg8::gemm_phase<pg8::EpiGate8C, pg8::StaticOrder, true, true, true>((PG8_LAS unsigned char*)C.lds, g, S, E);
        }
        SEAM(pb + 11);
        if (IN(pb + 12)) {
            pg8::Gemm g{(const bfr*)(ws + WS_A2), (const bfr*)(ws + WS_VT + (size_t)layer * DM * PE), NT, DM, PE / 2}; pg8::StaticOrder S; S.init(NT, DM, C.G, hb);
            if (layer == 0) { pg8::EpiResB<true, true> E{ws + WS_SC, ws + WS_SC, DM, 1.f / (SA * SV)};
                pg8::gemm_phase<pg8::EpiResB<true, true>, pg8::StaticOrder, true, true, true>((PG8_LAS unsigned char*)C.lds, g, S, E); }
            else { pg8::EpiResB<true, false> E{ws + WS_SC, P.out_(), DM, 1.f / (SA * SV)};
                pg8::gemm_phase<pg8::EpiResB<true, false>, pg8::StaticOrder, true, true, true>((PG8_LAS unsigned char*)C.lds, g, S, E); }
#ifdef G2_PROBE
            if (layer == 0) { __syncthreads(); pg8::StaticOrder S2; S2.init(NT, DM, C.G, hb); pg8::EpiRes E2{(const float*)P.out_(), P.out_(), DM, 0.f};
                pg8::gemm_phase<pg8::EpiRes, pg8::StaticOrder, true, true, true>((PG8_LAS unsigned char*)C.lds, g, S2, E2); }
#endif
        }
        SEAM(pb + 12);
    }
    {
        constexpr int layer = 1;
        const int pb = 1 + layer * NPH_LAYER;
        if (layer == 1 && IN(pb + 0)) p_norm_rows<true>(C, ws + WS_SC, F8_KVQ == 2 ? nullptr : XN, F8_KVQ != 0 ? ws + WS_XN8 : nullptr);
        if (layer == 1) SEAM(pb + 0);
        if (IN(pb + 1)) {
            const int N = layer == 0 ? 16384 : 12288;
            if (layer == 0 && F8_PROJ0 == 2) {
                { pg8::Gemm g{XN, (const bfr*)(ws + WS_WTIN), NT, 8192, DM}; pg8::StaticOrder S; S.init(NT, 8192, C.G, hb);
                  pg8::EpiBf16<0> E{BIG, N, nullptr, 0, 0, 1.f};
                  pg8::gemm_phase<pg8::EpiBf16<0>, pg8::StaticOrder, true, true>((PG8_LAS unsigned char*)C.lds, g, S, E); }
                __syncthreads();
                { pg8::Gemm g{(const bfr*)(ws + WS_XN8), (const bfr*)(ws + WS_WTIN + (size_t)8192 * DM * 2), NT, 8192, DM / 2}; pg8::StaticOrder S; S.init(NT, 8192, C.G, hb);
                  pg8::EpiBf16<0> E{BIG + 8192, N, nullptr, 8192, 0, 1.f / SU};
                  pg8::gemm_phase<pg8::EpiBf16<0>, pg8::StaticOrder, true, true, true>((PG8_LAS unsigned char*)C.lds, g, S, E); }
            } else if (layer == 0 && F8_PROJ0 == 5) {
                { pg8::Gemm g{(const bfr*)(ws + WS_XN8), (const bfr*)(ws + WS_WTIN), NT, 8192, DM / 2}; pg8::StaticOrder S; S.init(NT, 8192, C.G, hb);
                  pg8::EpiBf16<0> E{BIG, N, nullptr, 8192, 0, 1.f / SU};
                  pg8::gemm_phase<pg8::EpiBf16<0>, pg8::StaticOrder, true, true, true>((PG8_LAS unsigned char*)C.lds, g, S, E); }
                __syncthreads();
                { pg8::Gemm g{XN, (const bfr*)(ws + WS_WTIN + (size_t)32 * MiB), NT, 4096, DM}; pg8::StaticOrder S; S.init(NT, 4096, C.G, hb);
                  pg8::EpiBf16<0> E{BIG + 8192, N, nullptr, 0, 0, 1.f};
                  pg8::gemm_phase<pg8::EpiBf16<0>, pg8::StaticOrder, true, true>((PG8_LAS unsigned char*)C.lds, g, S, E); }
                __syncthreads();
                { pg8::Gemm g{(const bfr*)(ws + WS_XN8), (const bfr*)(ws + WS_WTIN + (size_t)64 * MiB), NT, 4096, DM / 2}; pg8::StaticOrder S; S.init(NT, 4096, C.G, hb);
                  pg8::EpiBf16<0> E{BIG + 12288, N, nullptr, 4096, 0, 1.f / SU};
                  pg8::gemm_phase<pg8::EpiBf16<0>, pg8::StaticOrder, true, true, true>((PG8_LAS unsigned char*)C.lds, g, S, E); }
            } else if (layer == 0 && F8_PROJ0 == 6) {
                { pg8::Gemm g{(const bfr*)(ws + WS_XN8), (const bfr*)(ws + WS_WTIN), NT, 12288, DM / 2}; pg8::StaticOrder S; S.init(NT, 12288, C.G, hb);
                  pg8::EpiBf16<0> E{BIG, N, nullptr, 12288, 0, 1.f / SU};
                  pg8::gemm_phase<pg8::EpiBf16<0>, pg8::StaticOrder, true, true, true>((PG8_LAS unsigned char*)C.lds, g, S, E); }
                __syncthreads();
                { pg8::Gemm g{XN, (const bfr*)(ws + WS_WTIN + (size_t)48 * MiB), NT, 4096, DM}; pg8::StaticOrder S; S.init(NT, 4096, C.G, hb);
                  pg8::EpiBf16<0> E{BIG + 12288, N, nullptr, 0, 0, 1.f};
                  pg8::gemm_phase<pg8::EpiBf16<0>, pg8::StaticOrder, true, true>((PG8_LAS unsigned char*)C.lds, g, S, E); }
            } else if (layer == 0 && F8_PROJ0 == 4) {
                { pg8::Gemm g{(const bfr*)(ws + WS_XN8), (const bfr*)(ws + WS_WTIN), NT, 4096, DM / 2}; pg8::StaticOrder S; S.init(NT, 4096, C.G, hb);
                  pg8::EpiBf16<0> E{BIG, N, nullptr, 4096, 0, 1.f / SU};
                  pg8::gemm_phase<pg8::EpiBf16<0>, pg8::StaticOrder, true, true, true>((PG8_LAS unsigned char*)C.lds, g, S, E); }
                __syncthreads();
                { pg8::Gemm g{XN, (const bfr*)(ws + WS_WTIN + (size_t)4096 * DM), NT, 12288, DM}; pg8::StaticOrder S; S.init(NT, 12288, C.G, hb);
                  pg8::EpiBf16<0> E{BIG + 4096, N, nullptr, 0, 0, 1.f};
                  pg8::gemm_phase<pg8::EpiBf16<0>, pg8::StaticOrder, true, true>((PG8_LAS unsigned char*)C.lds, g, S, E); }
            } else if (layer == 0 && F8_PROJ0 == 3) {
                { pg8::Gemm g{(const bfr*)(ws + WS_XN8), (const bfr*)(ws + WS_WTIN), NT, 8192, DM / 2}; pg8::StaticOrder S; S.init(NT, 8192, C.G, hb);
                  pg8::EpiBf16<0> E{BIG, N, nullptr, 8192, 0, 1.f / SU};
                  pg8::gemm_phase<pg8::EpiBf16<0>, pg8::StaticOrder, true, true, true>((PG8_LAS unsigned char*)C.lds, g, S, E); }
                __syncthreads();
                { pg8::Gemm g{XN, (const bfr*)(ws + WS_WTIN + (size_t)8192 * DM), NT, 8192, DM}; pg8::StaticOrder S; S.init(NT, 8192, C.G, hb);
                  pg8::EpiBf16<0> E{BIG + 8192, N, nullptr, 0, 0, 1.f};
                  pg8::gemm_phase<pg8::EpiBf16<0>, pg8::StaticOrder, true, true>((PG8_LAS unsigned char*)C.lds, g, S, E); }
            } else if (layer == 0 && F8_PROJ0 == 1) {
                pg8::Gemm g{(const bfr*)(ws + WS_XN8), (const bfr*)(ws + WS_WTIN), NT, N, DM / 2}; pg8::StaticOrder S; S.init(NT, N, C.G, hb);
                pg8::EpiBf16<0> E{BIG, N, nullptr, N, 0, 1.f / SU};
                pg8::gemm_phase<pg8::EpiBf16<0>, pg8::StaticOrder, true, true, true>((PG8_LAS unsigned char*)C.lds, g, S, E);
            } else if (layer == 1 && F8_KVQ == 2) {
                pg8::Gemm g{(const bfr*)(ws + WS_XN8), (const bfr*)(ws + WS_WTKVQ), NT, N, DM / 2}; pg8::StaticOrder S; S.init(NT, N, C.G, hb);
                pg8::EpiHead E{(bfr*)(ws + WS_R + R_KH), (bfr*)(ws + WS_R + R_QH), (bfr*)(ws + WS_R + R_VH), P.in_(10), P.in_(13), 1.f / SU};
                pg8::gemm_phase<pg8::EpiHead, pg8::StaticOrder, true, true, true>((PG8_LAS unsigned char*)C.lds, g, S, E);
            } else if (layer == 1 && F8_KVQ) {
                { pg8::Gemm g{(const bfr*)(ws + WS_XN8), (const bfr*)(ws + WS_WTKVQ), NT, 8192, DM / 2}; pg8::StaticOrder S; S.init(NT, 8192, C.G, hb);
                  pg8::EpiBf16<0> E{BIG, N, nullptr, 8192, 0, 1.f / SU};
                  pg8::gemm_phase<pg8::EpiBf16<0>, pg8::StaticOrder, true, true, true>((PG8_LAS unsigned char*)C.lds, g, S, E); }
                __syncthreads();
                { pg8::Gemm g{XN, (const bfr*)(ws + WS_WTKVQ + (size_t)2 * DM * DM), NT, DM, DM}; pg8::StaticOrder S; S.init(NT, DM, C.G, hb);
                  pg8::EpiBf16<0> E{BIG + 8192, N, nullptr, 0, 0, 1.f};
                  pg8::gemm_phase<pg8::EpiBf16<0>, pg8::StaticOrder, true, true>((PG8_LAS unsigned char*)C.lds, g, S, E); }
            } else {
                pg8::Gemm g{XN, (const bfr*)(ws + (layer == 0 ? WS_WTIN : WS_WTKVQ)), NT, N, DM}; pg8::StaticOrder S; S.init(NT, N, C.G, hb);
                pg8::EpiBf16<0> E{BIG, N, nullptr, 0, 0, 1.f};
                pg8::gemm_phase<pg8::EpiBf16<0>, pg8::StaticOrder, true, true>((PG8_LAS unsigned char*)C.lds, g, S, E);
            }
            if (layer == 0) { __syncthreads(); p_bd(C, XN, (const bfr*)(ws + WS_WTBD), (float*)(ws + WS_BD));
#ifdef BD_PROBE
                __syncthreads(); p_bd(C, XN, (const bfr*)(ws + WS_WTBD), (float*)(ws + WS_BD));
#endif
            }
        }
        SEAM(pb + 1);
        if (IN(pb + 2)) { if (layer == 1 && F8_KVQ != 2) p_headprep(C, P); }
        if (layer == 1 && F8_KVQ != 2) SEAM(pb + 2);
        if (IN(pb + 3)) { if (layer == 0) {
                if (NPREP >= 32) p_gdn_prep(C, P, C.vcu, C.G);
                else if (C.G == 256) { const int cidx = C.vcu & 31, xcd = C.vcu >> 5;
                    if (cidx < NPREP) p_gdn_prep(C, P, xcd * NPREP + cidx, 8 * NPREP); else p_convert(C, P, 1, xcd * (32 - NPREP) + (cidx - NPREP), 8 * (32 - NPREP)); }
                else { p_convert(C, P, 1, C.vcu, C.G); __syncthreads(); p_gdn_prep(C, P, C.vcu, C.G); }
            } else p_attn(C, P); }
        SEAM(pb + 3);
        if (IN(pb + 4)) { if (layer == 0) p_gdn_scan(C, P); else p_combine(C, P); }
        SEAM(pb + 4);
        if (IN(pb + 5)) { if (layer == 0) p_gdn_onorm(C, P); }
        if (layer == 0) SEAM(pb + 5);
        if (IN(pb + 6)) {
            if ((layer == 0 && F8_OUT0) || (layer == 1 && F8_OUT1)) {
                pg8::Gemm g{(const bfr*)(ws + WS_XN8), (const bfr*)(ws + (layer == 0 ? WS_WTOUT : WS_WTO)), NT, DM, DM / 2}; pg8::StaticOrder S; S.init(NT, DM, C.G, hb);
                if (layer == 0) { pg8::EpiResB<false, true> E{P.in_(0), ws + WS_SC, DM, 1.f / (SO * SU)};
                    pg8::gemm_phase<pg8::EpiResB<false, true>, pg8::StaticOrder, true, true, true>((PG8_LAS unsigned char*)C.lds, g, S, E); }
                else { pg8::EpiResB<true, true> E{ws + WS_SC, ws + WS_SC, DM, 1.f / (SO * SU)};
                    pg8::gemm_phase<pg8::EpiResB<true, true>, pg8::StaticOrder, true, true, true>((PG8_LAS unsigned char*)C.lds, g, S, E); }
            } else {
                pg8::Gemm g{XN, (const bfr*)(ws + (layer == 0 ? WS_WTOUT : WS_WTO)), NT, DM, DM}; pg8::StaticOrder S; S.init(NT, DM, C.G, hb);
                pg8::EpiRes E{layer == 0 ? P.in_(0) : (const float*)P.out_(), P.out_(), DM, 1.f};
                pg8::gemm_phase<pg8::EpiRes, pg8::StaticOrder, true, true>((PG8_LAS unsigned char*)C.lds, g, S, E);
            }
        }
        SEAM(pb + 6);
        if (IN(pb + 7)) p_norm_rows<true>(C, ws + WS_SC, nullptr, ws + WS_XN8, (float*)(ws + WS_BD));
        SEAM(pb + 7);
        if (IN(pb + 8)) {
            pg8::Gemm g{(const bfr*)(ws + WS_SC), (const bfr*)(ws + WS_WTQRY) + (size_t)layer * PQ * DM, NT, PQ, DM}; pg8::StaticOrder S; S.init(NT, PQ, C.G, hb);
            pg8::EpiBf16R E{(bfr*)(ws + WS_QRY), PQ, (const float*)(ws + WS_BD)};
            pg8::gemm_phase<pg8::EpiBf16R, pg8::StaticOrder, true, true>((PG8_LAS unsigned char*)C.lds, g, S, E);
        }
        SEAM(pb + 8);
        if (IN(pb + 9)) { p_sroute(C, P, layer); }
        SEAM(pb + 9); if (IN(pb + 9) && !IN(pb + 10) && IN(pb + 11)) xcd_barrier(bar);
        if (IN(pb + 11)) {
            pg8::Gemm g{(const bfr*)(ws + WS_XN8), (const bfr*)(ws + WS_U + (size_t)layer * PE * DM), NT, PE, DM / 2}; pg8::StaticOrder S; S.init(NT, PE, C.G, hb);
#ifdef G1_PROBE
            if (layer == 0) { pg8::StaticOrder S2; S2.init(NT, PE, C.G, hb); pg8::EpiGate8<G1_PROBE> E2{(bfr*)(ws + WS_G), ws + WS_A2, PE, 1.f / SU, SA};
                pg8::gemm_phase<pg8::EpiGate8<G1_PROBE>, pg8::StaticOrder, true, true, true>((PG8_LAS unsigned char*)C.lds, g, S2, E2); __syncthreads(); }
#endif
#if STAGGER_G1
            {
                const int sg = C.vcu & 7;
                if (sg) { const unsigned long long t0 = __builtin_amdgcn_s_memrealtime(); while (__builtin_amdgcn_s_memrealtime() - t0 < (unsigned long long)(sg * STAGGER_G1)) __builtin_amdgcn_s_sleep(4); }
            }
#endif
            pg8::EpiGate8C E{ws + WS_G, ws + WS_A2, PE, 1.f / SU, SA};
            pg8::gemm_phase<pg8::EpiGate8C, pg8::StaticOrder, true, true, true>((PG8_LAS unsigned char*)C.lds, g, S, E);
        }
        SEAM(pb + 11);
        if (IN(pb + 12)) {
            pg8::Gemm g{(const bfr*)(ws + WS_A2), (const bfr*)(ws + WS_VT + (size_t)layer * DM * PE), NT, DM, PE / 2}; pg8::StaticOrder S; S.init(NT, DM, C.G, hb);
            if (layer == 0) { pg8::EpiResB<true, true> E{ws + WS_SC, ws + WS_SC, DM, 1.f / (SA * SV)};
                pg8::gemm_phase<pg8::EpiResB<true, true>, pg8::StaticOrder, true, true, true>((PG8_LAS unsigned char*)C.lds, g, S, E); }
            else { pg8::EpiResB<true, false> E{ws + WS_SC, P.out_(), DM, 1.f / (SA * SV)};
                pg8::gemm_phase<pg8::EpiResB<true, false>, pg8::StaticOrder, true, true, true>((PG8_LAS unsigned char*)C.lds, g, S, E); }
#ifdef G2_PROBE
            if (layer == 0) { __syncthreads(); pg8::StaticOrder S2; S2.init(NT, DM, C.G, hb); pg8::EpiRes E2{(const float*)P.out_(), P.out_(), DM, 0.f};
                pg8::gemm_phase<pg8::EpiRes, pg8::StaticOrder, true, true, true>((PG8_LAS unsigned char*)C.lds, g, S2, E2); }
#endif
        }
        SEAM(pb + 12);
    }
#undef IN
#undef SEAM
}

extern "C" void kernel_launch(void* const* d_in, const int* in_sizes, int n_in, void* d_out, int out_size, void* d_ws, size_t ws_size, hipStream_t stream) {
    static int grid = 0;
    if (grid == 0) {
        if (n_in != 26 || out_size != NT * DM || ws_size < WS_END) { fprintf(stderr, "kernel_launch: unexpected problem (n_in %d, out %d, ws %zu < %zu)\n", n_in, out_size, ws_size, (size_t)WS_END); grid = -1; return; }
        int dev = 0, cus = 0;
        if (hipGetDevice(&dev) != hipSuccess || hipDeviceGetAttribute(&cus, hipDeviceAttributeMultiprocessorCount, dev) != hipSuccess || cus <= 0) { grid = -1; return; }
        if (hipFuncSetAttribute((const void*)trunk_fwd, hipFuncAttributeMaxDynamicSharedMemorySize, LDS_BYTES) != hipSuccess) { fprintf(stderr, "kernel_launch: hipFuncSetAttribute failed\n"); grid = -1; return; }
        int per_cu = 0;
        if (hipOccupancyMaxActiveBlocksPerMultiprocessor(&per_cu, (const void*)trunk_fwd, 512, LDS_BYTES) != hipSuccess || per_cu < 1) { fprintf(stderr, "kernel_launch: occupancy query says %d blocks per CU\n", per_cu); }
        (void)hipGetLastError();
        grid = cus;
    }
    if (grid < 0) return;
    (void)in_sizes;
    if (hipMemsetAsync((char*)d_ws + WS_CTL, 0, CTL_ZERO_BYTES, stream) != hipSuccess) return;
    KArgs p{};
    for (int i = 0; i < 26; ++i) p.in[i] = (const float*)d_in[i];
    p.out = (float*)d_out; p.ws = (unsigned char*)d_ws;
#if MK_PER_PHASE
    for (int ph = 0; ph < NPHASE; ++ph) {
        if (ph == 1 + 5 + NPH_LAYER || ph == 1 + 10 || ph == 1 + 10 + NPH_LAYER) continue;
        p.ph_lo = ph; p.ph_hi = ph + 1; p.li = 0; p.pad = 0;
        hipLaunchKernelGGL(trunk_fwd, dim3(grid), dim3(512), LDS_BYTES, stream, p);
    }
#else
    p.ph_lo = 0; p.ph_hi = NPHASE; p.li = 0; p.pad = 0;
    hipLaunchKernelGGL(trunk_fwd, dim3(grid), dim3(512), LDS_BYTES, stream, p);
#endif
}
```

```cpp
#include <hip/hip_runtime.h>
#include <hip/hip_bf16.h>
#include <cstdio>
#include <cstdint>

#define LAS __attribute__((address_space(3)))
#define GAS __attribute__((address_space(1)))
typedef unsigned short bfr;
typedef short s8v __attribute__((ext_vector_type(8)));
typedef float f4v __attribute__((ext_vector_type(4)));
typedef unsigned u4v __attribute__((ext_vector_type(4)));
typedef unsigned u2v __attribute__((ext_vector_type(2)));
typedef int i4v __attribute__((ext_vector_type(4)));

#ifndef F8_PROJ0
#define F8_PROJ0 5
#endif
#ifndef F8_KVQ
#define F8_KVQ 2
#endif
#ifndef F8_OUT0
#define F8_OUT0 1
#endif
#ifndef F8_OUT1
#define F8_OUT1 1
#endif
#ifndef F8_OUT
#define F8_OUT (F8_OUT0 || F8_OUT1)
#endif
#ifndef STAGGER_G1
#define STAGGER_G1 0
#endif
#ifndef NPREP
#define NPREP 20
#endif
constexpr int NB = 2, SEQ = 4096, DM = 4096, NT = NB * SEQ;
constexpr int GH = 32, GD = 128, GIN = 16448, CH = 64, NCH = SEQ / CH;
constexpr int AH = 16, AD = 128, AV = 256;
constexpr int PH = 8, PK = 128, PE = 16384, PQ = 2048, PTOP = 16;
constexpr float EPS = 1e-6f;
constexpr float LAMBDA_INIT = 0.35550906759f;
constexpr float SU = 64.f, SA = 64.f, SV = 4.f, SO = 16.f;

constexpr size_t MiB = 1u << 20;
constexpr size_t WS_CTL   = 0;
constexpr size_t WS_WTIN  = 1 * MiB;
constexpr size_t WS_WTBD  = WS_WTIN + 128 * MiB;
constexpr size_t WS_WTOUT = WS_WTBD + 1 * MiB;
constexpr size_t WS_WTKVQ = WS_WTOUT + 32 * MiB;
constexpr size_t WS_WTO   = WS_WTKVQ + 96 * MiB;
constexpr size_t WS_WTQRY = WS_WTO + 32 * MiB;
constexpr size_t WS_WTKEY = WS_WTQRY + 32 * MiB;
constexpr size_t WS_U     = WS_WTKEY + 16 * MiB;
constexpr size_t WS_VT    = WS_U + 128 * MiB;
constexpr size_t WS_A2    = WS_VT + 128 * MiB;
constexpr size_t WS_XN8   = WS_A2 + 128 * MiB;
constexpr size_t WS_XN    = WS_XN8 + 32 * MiB;
constexpr size_t WS_BIG   = WS_XN + 64 * MiB;
constexpr size_t WS_R     = WS_BIG + 256 * MiB;
constexpr size_t WS_QRY   = WS_R + 352 * MiB;
constexpr size_t WS_SC    = WS_QRY + 32 * MiB;
constexpr size_t WS_BD    = WS_SC + 64 * MiB;
constexpr size_t WS_EG    = WS_BD + 2 * MiB;
constexpr size_t WS_G     = WS_EG + 1 * MiB;
constexpr size_t WS_END   = WS_G + 256 * MiB;
constexpr size_t R_W = 0, R_U = 64 * MiB, R_QG = 128 * MiB, R_KD = 192 * MiB, R_QK = 256 * MiB, R_O = 288 * MiB;
constexpr size_t R_QH = 0, R_KH = 64 * MiB, R_VH = 128 * MiB, R_OH = 192 * MiB;
static_assert(WS_END <= (size_t)1790 * MiB, "workspace map");

constexpr int CW_BAR = 4096;
constexpr size_t CTL_ZERO_BYTES = 1 * MiB;

constexpr int LDS_BYTES = 147456;
constexpr int MISC_OFF = 146944;

typedef float f2v_ __attribute__((ext_vector_type(2)));
typedef __bf16 b2v_ __attribute__((ext_vector_type(2)));
__device__ __forceinline__ unsigned cvtpk(float lo, float hi) { const b2v_ r = __builtin_convertvector((f2v_){lo, hi}, b2v_); return __builtin_bit_cast(unsigned, r); }
__device__ __forceinline__ unsigned cvt4_fp8(float a, float b, float c, float d) { int w = 0; w = __builtin_amdgcn_cvt_pk_fp8_f32(a, b, w, false); w = __builtin_amdgcn_cvt_pk_fp8_f32(c, d, w, true); return (unsigned)w; }
__device__ __forceinline__ float bflo(unsigned w) { return __uint_as_float(w << 16); }
__device__ __forceinline__ float bfhi(unsigned w) { return __uint_as_float(w & 0xffff0000u); }
__device__ __forceinline__ float bf1(bfr b) { return __uint_as_float(((unsigned)b) << 16); }
__device__ __forceinline__ bfr f2bf1(float f) { return (bfr)(cvtpk(f, 0.f) & 0xffffu); }
__device__ __forceinline__ float wave_sum(float v) {
#pragma unroll
    for (int o = 1; o < 64; o <<= 1) v += __shfl_xor(v, o);
    return v;
}
__device__ __forceinline__ f4v zero_acc() { f4v z = {0.f, 0.f, 0.f, 0.f}; asm volatile("" : "+v"(z)); return z; }
#define MFMA_SETTLE(acc) asm volatile("s_nop 7\n\ts_nop 7" : "+v"(acc))
#define LDS_WAIT() asm volatile("s_waitcnt lgkmcnt(0)" ::: "memory")
#define VM_WAIT() asm volatile("s_waitcnt vmcnt(0)" ::: "memory")
#define XB_TMO      128
#define XB_XCNT(j)  (256  + 64 * (j))
#define XB_XSUB(j)  (1280 + 64 * (j))
#define XB_XGEN(j)  (2304 + 64 * (j))
#define XB_TOP      3328
#define XB_TOPGEN   3392
#define XCD_BAR_WORDS 3456
#define XB_SPIN_CAP (1u << 18)

__device__ __forceinline__ unsigned xb_ld(unsigned* p)              { return __hip_atomic_load(p, __ATOMIC_RELAXED, __HIP_MEMORY_SCOPE_AGENT); }
__device__ __forceinline__ unsigned xb_add(unsigned* p, unsigned v) { return __hip_atomic_fetch_add(p, v, __ATOMIC_RELAXED, __HIP_MEMORY_SCOPE_AGENT); }
__device__ __forceinline__ unsigned xb_xcc_id() { return (unsigned)__builtin_amdgcn_s_getreg((3 << 11) | 20) & 0xFu; }
#define XB_SPIN(cond, bar) do { unsigned _sp = 0; while (cond) { __builtin_amdgcn_s_sleep(1); \
    if ((++_sp & 255u) == 0u) { if (xb_ld(&(bar)[XB_TMO])) break; if (_sp > XB_SPIN_CAP) { atomicAdd(&(bar)[XB_TMO], 1u); break; } } } } while (0)

struct XcdBarrier {
    unsigned* bar; unsigned x;
    volatile LAS unsigned* st;
};

__device__ __forceinline__ XcdBarrier xcd_barrier_post(unsigned* bar, volatile LAS unsigned* st) {
    XcdBarrier b; b.bar = bar; b.x = xb_xcc_id(); b.st = st;
    if (threadIdx.x == 0) (void)xb_add(&bar[XB_XCNT(b.x)], 1u);
    return b;
}
__device__ __forceinline__ void xcd_barrier_complete(unsigned* bar, unsigned x, unsigned& nloc, unsigned& nx) {
    const unsigned G = gridDim.x * gridDim.y * gridDim.z;
    unsigned sum, cnt, mine, sp = 0u;
    for (;;) {
        sum = 0u; cnt = 0u; mine = 0u;
#pragma unroll
        for (unsigned j = 0; j < 16; ++j) { const unsigned c = xb_ld(&bar[XB_XCNT(j)]); sum += c; cnt += (c > 0u) ? 1u : 0u; mine = (j == x) ? c : mine; }
        if (sum == G) break;
        __builtin_amdgcn_s_sleep(1);
        if ((++sp & 255u) == 0u) { if (xb_ld(&bar[XB_TMO])) break; if (sp > XB_SPIN_CAP) { atomicAdd(&bar[XB_TMO], 1u); break; } }
    }
    nloc = mine > 0u ? mine : 1u; nx = cnt > 0u ? cnt : 1u;
}

__device__ __forceinline__ void xcd_barrier(const XcdBarrier& b) {
    asm volatile("s_waitcnt vmcnt(0)" ::: "memory");
    __syncthreads();
    if (threadIdx.x == 0) {
        unsigned* bar = b.bar;
        __builtin_amdgcn_s_waitcnt(0);
        unsigned nloc = b.st[0], nx = b.st[1];
        if (nloc == 0u) { xcd_barrier_complete(bar, b.x, nloc, nx); b.st[0] = nloc; b.st[1] = nx; }
        const unsigned old = xb_add(&bar[XB_XSUB(b.x)], 1u);
        const unsigned gen = old / nloc;
        if (old + 1u == (gen + 1u) * nloc) {
            __builtin_amdgcn_fence(__ATOMIC_RELEASE, "agent");
            asm volatile("s_waitcnt vmcnt(0)" ::: "memory");
            const unsigned og = xb_add(&bar[XB_TOP], 1u);
            const unsigned tg = og / nx;
            if (og + 1u == (tg + 1u) * nx) xb_add(&bar[XB_TOPGEN], 1u);
            else XB_SPIN(xb_ld(&bar[XB_TOPGEN]) == tg, bar);
            __builtin_amdgcn_fence(__ATOMIC_ACQUIRE, "agent");
            xb_add(&bar[XB_XGEN(b.x)], 1u);
            asm volatile("s_waitcnt vmcnt(0)" ::: "memory");
        } else {
            XB_SPIN(xb_ld(&bar[XB_XGEN(b.x)]) == gen, bar);
            __builtin_amdgcn_fence(__ATOMIC_ACQUIRE, "agent");
            asm volatile("s_waitcnt vmcnt(0)" ::: "memory");
        }
    }
    __syncthreads();
}
namespace pg8 {
#define PG8_LAS __attribute__((address_space(3)))
typedef unsigned short bf16_t;
typedef short bf16x8 __attribute__((ext_vector_type(8)));
typedef float f32x4 __attribute__((ext_vector_type(4)));
typedef unsigned u32x4 __attribute__((ext_vector_type(4)));
typedef int i32x4 __attribute__((ext_vector_type(4)));
typedef int i32x8 __attribute__((ext_vector_type(8)));
typedef unsigned u32x2 __attribute__((ext_vector_type(2)));
constexpr int BM = 256, BK = 64, HALF = 128, HTB = HALF * BK * 2  , STAGE_BYTES = 8 * HTB, NXCD = 8, WGM = 8;

__host__ __device__ __forceinline__ int lds_byte(int r, int c) { const int st = (r >> 4) * 2 + (c >> 5), rr = r & 15, cc = c & 31, ob = rr * 64 + cc * 2; return st * 1024 + (ob ^ (((ob >> 9) & 1) << 5)); }
__host__ __device__ __forceinline__ void stage_rc(int b, int& R, int& C) { const int st = b / 1024, sb = b % 1024, swz = sb ^ (((sb >> 9) & 1) << 5); R = (st >> 1) * 16 + swz / 64; C = (st & 1) * 32 + (swz % 64) / 2; }
__host__ __device__ __forceinline__ int perm32(int rho) { const int n = rho >> 4, i = rho & 15; return 8 * (i >> 2) + 4 * n + (i & 3); }

struct Unit { int pm, pn; };
struct Gemm { const bf16_t* A; const bf16_t* Bt; int M, N, K; };

struct StaticOrder {
    int nM, nN, nwg, G, c;
    __host__ __device__ void init(int M, int N, int G_, int c_) { nM = M / BM; nN = N / BM; nwg = nM * nN; G = G_; c = c_; }
    __host__ __device__ bool next(int i, Unit& u) const {
        const long L = (long)i * G + c; if (L >= nwg) return false;
        int wgid = (int)L; { const int q = nwg / NXCD, r = nwg % NXCD, xcd = wgid % NXCD, off = wgid / NXCD; wgid = (xcd < r ? xcd * (q + 1) : r * (q + 1) + (xcd - r) * q) + off; }
        const int nig = WGM * nN, gid = wgid / nig, fm = gid * WGM, gsz = (nM - fm) < WGM ? (nM - fm) : WGM;
        u.pm = fm + ((wgid % nig) % gsz); u.pn = (wgid % nig) / gsz; return true;
    }
    __device__ __forceinline__ void a_ready(const Unit&) const {}
    __device__ __forceinline__ void done(const Unit&) const {}
};

__device__ __forceinline__ unsigned cvt_pk_bf16(float lo, float hi) { unsigned r; asm volatile("v_cvt_pk_bf16_f32 %0, %1, %2" : "=v"(r) : "v"(lo), "v"(hi)); return r; }
typedef float f32x2 __attribute__((ext_vector_type(2)));
__device__ __forceinline__ f32x2 gelu_pk(f32x2 v) {
    const f32x2 av = __builtin_elementwise_abs(v), d = av * 0.2316418882f + 1.0f;
    f32x2 t; t.x = __builtin_amdgcn_rcpf(d.x); t.y = __builtin_amdgcn_rcpf(d.y);
    f32x2 q = t * 0.5307027145f + (-0.7265760135f); q = q * t + 0.7107068705f; q = q * t + (-0.142248368f); q = q * t + 0.127414796f; q = q * t;
    const f32x2 s = (v * v) * (-0.72134752044f);
    f32x2 e; e.x = __builtin_amdgcn_exp2f(s.x); e.y = __builtin_amdgcn_exp2f(s.y);
    const f32x2 m = v * (q * e), r = v - m;
    f32x2 o; o.x = v.x < 0.f ? m.x : r.x; o.y = v.y < 0.f ? m.y : r.y; return o;
}

template <int ACT  > struct EpiBf16 {
    static constexpr bool PERM = true, AFTER_DRAIN = false; static_assert(ACT == 0 || ACT == 1, "EpiBf16: ACT is 0 (none) or 1 (gelu_pk)");
    bf16_t* O; int ldc; const float* bias; int split_cols; size_t split_stride; float scale0;
    __device__ __forceinline__ void operator()(const f32x4 (&acc)[2][2][4][2], const Unit& u, int wr, int wc, int fr, int fq) const {
        const int row0 = u.pm * BM + wr * 64 + fr; int colt = u.pn * BM; bf16_t* base = O;
        float sc = 1.f; if (split_cols) { const int t = colt / split_cols; base += (size_t)t * split_stride; colt -= t * split_cols; if (t == 0) sc = scale0; }
        const int col0 = colt + wc * 32 + 8 * fq, bcol0 = u.pn * BM + wc * 32 + 8 * fq;
        f32x4 bv[2][2];
#pragma unroll
        for (int bj = 0; bj < 2; ++bj)
#pragma unroll
            for (int n = 0; n < 2; ++n) bv[bj][n] = bias ? *(const f32x4*)(bias + bcol0 + bj * HALF + 4 * n) : (f32x4){0.f, 0.f, 0.f, 0.f};
#pragma unroll
        for (int ai = 0; ai < 2; ++ai)
#pragma unroll
            for (int m = 0; m < 4; ++m) { bf16_t* rowp = base + (size_t)(row0 + ai * HALF + m * 16) * ldc + col0;
#pragma unroll
                for (int bj = 0; bj < 2; ++bj) { f32x4 v0 = acc[ai][bj][m][0] + bv[bj][0], v1 = acc[ai][bj][m][1] + bv[bj][1];
                    if (ACT == 1) { f32x2 a = gelu_pk((f32x2){v0[0], v0[1]}), b = gelu_pk((f32x2){v0[2], v0[3]}), c = gelu_pk((f32x2){v1[0], v1[1]}), d = gelu_pk((f32x2){v1[2], v1[3]});
                        v0 = (f32x4){a.x, a.y, b.x, b.y}; v1 = (f32x4){c.x, c.y, d.x, d.y}; }
                    v0 = v0 * sc; v1 = v1 * sc; u32x4 w; w.x = cvt_pk_bf16(v0[0], v0[1]); w.y = cvt_pk_bf16(v0[2], v0[3]); w.z = cvt_pk_bf16(v1[0], v1[1]); w.w = cvt_pk_bf16(v1[2], v1[3]);
                    *(u32x4*)(rowp + bj * HALF) = w; } }
    }
};
struct EpiRes {
    static constexpr bool PERM = false, AFTER_DRAIN = false;
    const float* base; float* out; int ldc; float scale;
    __device__ __forceinline__ void operator()(const f32x4 (&acc)[2][2][4][2], const Unit& u, int wr, int wc, int fr, int fq) const {
        const int row0 = u.pm * BM + wr * 64 + fr, col0 = u.pn * BM + wc * 32 + 4 * fq;
#pragma unroll
        for (int ai = 0; ai < 2; ++ai)
#pragma unroll
            for (int m = 0; m < 4; ++m) { const size_t off = (size_t)(row0 + ai * HALF + m * 16) * ldc + col0;
                f32x4 bs[2][2];
#pragma unroll
                for (int bj = 0; bj < 2; ++bj)
#pragma unroll
                    for (int n = 0; n < 2; ++n) bs[bj][n] = *(const f32x4*)(base + off + bj * HALF + n * 16);
#pragma unroll
                for (int bj = 0; bj < 2; ++bj)
#pragma unroll
                    for (int n = 0; n < 2; ++n) *(f32x4*)(out + off + bj * HALF + n * 16) = bs[bj][n] + acc[ai][bj][m][n] * scale;
                asm volatile("" ::: "memory"); }
    }
};
struct EpiStF32 {
    static constexpr bool PERM = false, AFTER_DRAIN = false;
    float* C; int ldc;
    __device__ __forceinline__ void operator()(const f32x4 (&acc)[2][2][4][2], const Unit& u, int wr, int wc, int fr, int fq) const {
        const int row0 = u.pm * BM + wr * 64 + fr, col0 = u.pn * BM + wc * 32 + 4 * fq;
#pragma unroll
        for (int ai = 0; ai < 2; ++ai)
#pragma unroll
            for (int m = 0; m < 4; ++m) { float* rowp = C + (size_t)(row0 + ai * HALF + m * 16) * ldc + col0;
#pragma unroll
                for (int bj = 0; bj < 2; ++bj)
#pragma unroll
                    for (int n = 0; n < 2; ++n) *(f32x4*)(rowp + bj * HALF + n * 16) = acc[ai][bj][m][n]; }
    }
};
struct EpiGate {
    static constexpr bool PERM = true, AFTER_DRAIN = false;
    bf16_t* G; int ldc;
    __device__ __forceinline__ void operator()(const f32x4 (&acc)[2][2][4][2], const Unit& u, int wr, int wc, int fr, int fq) const {
        const int row0 = u.pm * BM + wr * 64 + fr, col0 = u.pn * BM + wc * 32 + 8 * fq;
#pragma unroll
        for (int ai = 0; ai < 2; ++ai)
#pragma unroll
            for (int m = 0; m < 4; ++m) { bf16_t* rowp = G + (size_t)(row0 + ai * HALF + m * 16) * ldc + col0;
                u32x4 g[2];
#pragma unroll
                for (int bj = 0; bj < 2; ++bj) g[bj] = *(const u32x4*)(rowp + bj * HALF);
#pragma unroll
                for (int bj = 0; bj < 2; ++bj) {
                    if ((g[bj].x | g[bj].y | g[bj].z | g[bj].w) != 0u) {
                        const f32x4 v0 = acc[ai][bj][m][0], v1 = acc[ai][bj][m][1];
                        const f32x2 a = gelu_pk((f32x2){v0[0], v0[1]}), b = gelu_pk((f32x2){v0[2], v0[3]}), c = gelu_pk((f32x2){v1[0], v1[1]}), d = gelu_pk((f32x2){v1[2], v1[3]});
                        u32x4 w;
                        w.x = cvt_pk_bf16(a.x * __uint_as_float(g[bj].x << 16), a.y * __uint_as_float(g[bj].x & 0xffff0000u));
                        w.y = cvt_pk_bf16(b.x * __uint_as_float(g[bj].y << 16), b.y * __uint_as_float(g[bj].y & 0xffff0000u));
                        w.z = cvt_pk_bf16(c.x * __uint_as_float(g[bj].z << 16), c.y * __uint_as_float(g[bj].z & 0xffff0000u));
                        w.w = cvt_pk_bf16(d.x * __uint_as_float(g[bj].w << 16), d.y * __uint_as_float(g[bj].w & 0xffff0000u));
                        *(u32x4*)(rowp + bj * HALF) = w;
                    }
                } }
    }
};
template <int MODE = 0>
struct EpiGate8 {
    static constexpr bool PERM = true, AFTER_DRAIN = false;
    bf16_t* G; unsigned char* A2; int ldc; float hscale, oscale;
    __device__ __forceinline__ void operator()(const f32x4 (&acc)[2][2][4][2], const Unit& u, int wr, int wc, int fr, int fq) const {
        const int row0 = u.pm * BM + wr * 64 + fr, col0 = u.pn * BM + wc * 32 + 8 * fq;
#pragma unroll
        for (int ai = 0; ai < 2; ++ai)
#pragma unroll
            for (int m = 0; m < 4; ++m) { const size_t ro = (size_t)(row0 + ai * HALF + m * 16) * ldc + col0;
                u32x4 g[2];
#pragma unroll
                for (int bj = 0; bj < 2; ++bj) g[bj] = (MODE == 2 || MODE == 3) ? (u32x4){0x3f803f80u, 0x3f803f80u, 0x3f803f80u, 0x3f803f80u} : *(const u32x4*)(G + ro + bj * HALF);
#pragma unroll
                for (int bj = 0; bj < 2; ++bj) {
                    u32x2 w = {0u, 0u};
                    if ((g[bj].x | g[bj].y | g[bj].z | g[bj].w) != 0u) {
                        const f32x4 v0 = acc[ai][bj][m][0] * hscale, v1 = acc[ai][bj][m][1] * hscale;
                        const f32x2 a = MODE == 3 ? (f32x2){v0[0], v0[1]} : gelu_pk((f32x2){v0[0], v0[1]}), b = MODE == 3 ? (f32x2){v0[2], v0[3]} : gelu_pk((f32x2){v0[2], v0[3]}), c = MODE == 3 ? (f32x2){v1[0], v1[1]} : gelu_pk((f32x2){v1[0], v1[1]}), d = MODE == 3 ? (f32x2){v1[2], v1[3]} : gelu_pk((f32x2){v1[2], v1[3]});
                        float y[8] = {a.x * __uint_as_float(g[bj].x << 16), a.y * __uint_as_float(g[bj].x & 0xffff0000u), b.x * __uint_as_float(g[bj].y << 16), b.y * __uint_as_float(g[bj].y & 0xffff0000u),
                                      c.x * __uint_as_float(g[bj].z << 16), c.y * __uint_as_float(g[bj].z & 0xffff0000u), d.x * __uint_as_float(g[bj].w << 16), d.y * __uint_as_float(g[bj].w & 0xffff0000u)};
#pragma unroll
                        for (int k = 0; k < 8; ++k) y[k] = fminf(fmaxf(y[k] * oscale, -440.f), 440.f);
                        int lo = 0, hi = 0;
                        lo = __builtin_amdgcn_cvt_pk_fp8_f32(y[0], y[1], lo, false); lo = __builtin_amdgcn_cvt_pk_fp8_f32(y[2], y[3], lo, true);
                        hi = __builtin_amdgcn_cvt_pk_fp8_f32(y[4], y[5], hi, false); hi = __builtin_amdgcn_cvt_pk_fp8_f32(y[6], y[7], hi, true);
                        w.x = (unsigned)lo; w.y = (unsigned)hi;
                        if (MODE == 0) *(u32x4*)(G + ro + bj * HALF) = (u32x4){0u, 0u, 0u, 0u};
                    }
                    *(u32x2*)(A2 + ro + bj * HALF) = w;
                } }
    }
};

struct EpiGate8C {
    static constexpr bool PERM = true, AFTER_DRAIN = false;
    static constexpr int REC_OFF = STAGE_BYTES, REC_WAVE = 1984, REC_DW = 8, CAP = REC_WAVE / (4 * REC_DW);
    unsigned char* G; unsigned char* A2; int ldc; float hscale, oscale;
    static __device__ __forceinline__ float gdec(unsigned w, int k) { const unsigned b = (w >> (8 * k)) & 255u; return b ? __builtin_amdgcn_exp2f(((float)b - 195.f) * 0.05f) : 0.f; }
    __device__ __forceinline__ void one(unsigned h0, unsigned h1, unsigned h2, unsigned h3, unsigned g0, unsigned g1, unsigned off) const {
        const f32x2 a = gelu_pk((f32x2){__uint_as_float(h0 << 16), __uint_as_float(h0 & 0xffff0000u)}), b = gelu_pk((f32x2){__uint_as_float(h1 << 16), __uint_as_float(h1 & 0xffff0000u)}),
                    c = gelu_pk((f32x2){__uint_as_float(h2 << 16), __uint_as_float(h2 & 0xffff0000u)}), d = gelu_pk((f32x2){__uint_as_float(h3 << 16), __uint_as_float(h3 & 0xffff0000u)});
        float y[8] = {a.x * gdec(g0, 0), a.y * gdec(g0, 1), b.x * gdec(g0, 2), b.y * gdec(g0, 3), c.x * gdec(g1, 0), c.y * gdec(g1, 1), d.x * gdec(g1, 2), d.y * gdec(g1, 3)};
#pragma unroll
        for (int k = 0; k < 8; ++k) y[k] = fminf(fmaxf(y[k] * oscale, -440.f), 440.f);
        int lo = 0, hi = 0;
        lo = __builtin_amdgcn_cvt_pk_fp8_f32(y[0], y[1], lo, false); lo = __builtin_amdgcn_cvt_pk_fp8_f32(y[2], y[3], lo, true);
        hi = __builtin_amdgcn_cvt_pk_fp8_f32(y[4], y[5], hi, false); hi = __builtin_amdgcn_cvt_pk_fp8_f32(y[6], y[7], hi, true);
        *(u32x2*)(A2 + off) = (u32x2){(unsigned)lo, (unsigned)hi};
        *(u32x2*)(G + off) = (u32x2){0u, 0u};
    }
    __device__ __forceinline__ void flush(PG8_LAS unsigned* rec, int cnt, int lane) const {
        asm volatile("s_waitcnt lgkmcnt(0)" ::: "memory");
        if (lane < cnt) { const PG8_LAS unsigned* r = rec + lane * REC_DW;
            const u32x4 hh = *(const PG8_LAS u32x4*)r; const u32x2 gg = *(const PG8_LAS u32x2*)(r + 4); const unsigned off = r[6];
            one(hh.x, hh.y, hh.z, hh.w, gg.x, gg.y, off); }
        asm volatile("s_waitcnt lgkmcnt(0)" ::: "memory");
    }
    __device__ __forceinline__ void operator()(const f32x4 (&acc)[2][2][4][2], const Unit& u, int wr, int wc, int fr, int fq) const {
        extern __shared__ __attribute__((aligned(16))) char pg8_lds_sym[];
        const int lane = fq * 16 + fr;
        PG8_LAS unsigned* rec = (PG8_LAS unsigned*)((PG8_LAS char*)pg8_lds_sym + REC_OFF + (wr * 4 + wc) * REC_WAVE);
        const int row0 = u.pm * BM + wr * 64 + fr, col0 = u.pn * BM + wc * 32 + 8 * fq;
        int cnt = 0;
        u32x2 gall2[2][4][2];
#pragma unroll
        for (int ai = 0; ai < 2; ++ai)
#pragma unroll
            for (int m = 0; m < 4; ++m) { const unsigned ro = (unsigned)(row0 + ai * HALF + m * 16) * (unsigned)ldc + (unsigned)col0;
#pragma unroll
                for (int bj = 0; bj < 2; ++bj) gall2[ai][m][bj] = *(const u32x2*)(G + ro + bj * HALF); }
        asm volatile("" ::: "memory");
#pragma unroll
        for (int ai = 0; ai < 2; ++ai) {
#pragma unroll
            for (int m = 0; m < 4; ++m) { const unsigned ro = (unsigned)(row0 + ai * HALF + m * 16) * (unsigned)ldc + (unsigned)col0;
#pragma unroll
                for (int bj = 0; bj < 2; ++bj) { const u32x2 g = gall2[ai][m][bj];
                    const bool nz = (g.x | g.y) != 0u;
                    const unsigned long long bal = __builtin_amdgcn_ballot_w64(nz);
                    const int np = __builtin_popcountll(bal);
                    if (np > CAP) {
                        if (nz) { const f32x4 v0 = acc[ai][bj][m][0] * hscale, v1 = acc[ai][bj][m][1] * hscale;
                            one(cvt_pk_bf16(v0[0], v0[1]), cvt_pk_bf16(v0[2], v0[3]), cvt_pk_bf16(v1[0], v1[1]), cvt_pk_bf16(v1[2], v1[3]), g.x, g.y, ro + bj * HALF); }
                        else *(u32x2*)(A2 + ro + bj * HALF) = (u32x2){0u, 0u};
                        continue; }
                    if (cnt + np > CAP) { flush(rec, cnt, lane); cnt = 0; }
                    if (nz) { const int slot = cnt + (int)__builtin_amdgcn_mbcnt_hi((unsigned)(bal >> 32), __builtin_amdgcn_mbcnt_lo((unsigned)bal, 0u));
                        const f32x4 v0 = acc[ai][bj][m][0] * hscale, v1 = acc[ai][bj][m][1] * hscale;
                        PG8_LAS unsigned* r = rec + slot * REC_DW;
                        *(PG8_LAS u32x4*)r = (u32x4){cvt_pk_bf16(v0[0], v0[1]), cvt_pk_bf16(v0[2], v0[3]), cvt_pk_bf16(v1[0], v1[1]), cvt_pk_bf16(v1[2], v1[3])}; *(PG8_LAS u32x2*)(r + 4) = g; r[6] = ro + bj * HALF; }
                    else *(u32x2*)(A2 + ro + bj * HALF) = (u32x2){0u, 0u};
                    cnt += np;
                } }
        }
        flush(rec, cnt, lane);
    }
};

struct EpiHead {
    static constexpr bool PERM = true, AFTER_DRAIN = false;
    static constexpr int RED_OFF = STAGE_BYTES;
    bf16_t* Kh; bf16_t* Qh; bf16_t* Vh; const float* kg; const float* qg; float scale;
    __device__ __forceinline__ void operator()(const f32x4 (&acc)[2][2][4][2], const Unit& u, int wr, int wc, int fr, int fq) const {
        extern __shared__ __attribute__((aligned(16))) char pg8_lds_sym[];
        const int colt = u.pn * BM, row0 = u.pm * BM + wr * 64 + fr, cw = wc * 32 + 8 * fq;
        if (colt >= 8192) {
            const int head0 = (colt - 8192) >> 7;
#pragma unroll
            for (int ai = 0; ai < 2; ++ai)
#pragma unroll
                for (int m = 0; m < 4; ++m) { const int t = row0 + ai * HALF + m * 16, b = t >> 12, sq = t & 4095;
#pragma unroll
                    for (int bj = 0; bj < 2; ++bj) { const f32x4 v0 = acc[ai][bj][m][0] * scale, v1 = acc[ai][bj][m][1] * scale;
                        u32x4 w; w.x = cvt_pk_bf16(v0[0], v0[1]); w.y = cvt_pk_bf16(v0[2], v0[3]); w.z = cvt_pk_bf16(v1[0], v1[1]); w.w = cvt_pk_bf16(v1[2], v1[3]);
                        *(u32x4*)(Vh + ((size_t)(b * 32 + head0 + bj) * SEQ + sq) * 128 + cw) = w; } }
            return; }
        PG8_LAS float* red = (PG8_LAS float*)((PG8_LAS char*)pg8_lds_sym + RED_OFF);
#pragma unroll
        for (int ai = 0; ai < 2; ++ai)
#pragma unroll
            for (int m = 0; m < 4; ++m)
#pragma unroll
                for (int bj = 0; bj < 2; ++bj) { const f32x4 v0 = acc[ai][bj][m][0] * scale, v1 = acc[ai][bj][m][1] * scale;
                    float s = (v0[0] * v0[0] + v0[1] * v0[1]) + (v0[2] * v0[2] + v0[3] * v0[3]) + (v1[0] * v1[0] + v1[1] * v1[1]) + (v1[2] * v1[2] + v1[3] * v1[3]);
                    s += __shfl_xor(s, 16); s += __shfl_xor(s, 32);
                    if (fq == 0) red[(((((wr * 4 + wc) * 2 + ai) * 4 + m) * 2 + bj) << 4) + fr] = s; }
        asm volatile("s_waitcnt lgkmcnt(0)\n\ts_barrier" ::: "memory");
        const bool isq = colt >= 4096; const float* gp = (isq ? qg : kg) + cw; const f32x4 g0 = *(const f32x4*)gp, g1 = *(const f32x4*)(gp + 4);
        bf16_t* dsth = isq ? Qh : Kh; const int head0 = ((isq ? colt - 4096 : colt) >> 7);
#pragma unroll
        for (int ai = 0; ai < 2; ++ai)
#pragma unroll
            for (int m = 0; m < 4; ++m) { const int t = row0 + ai * HALF + m * 16, b = t >> 12, sq = t & 4095;
#pragma unroll
                for (int bj = 0; bj < 2; ++bj) {
                    float tot = 0.f;
#pragma unroll
                    for (int w = 0; w < 4; ++w) tot += red[(((((wr * 4 + w) * 2 + ai) * 4 + m) * 2 + bj) << 4) + fr];
                    const float rn = __builtin_amdgcn_rsqf(tot * (1.f / 128.f) + EPS) * scale;
                    const f32x4 v0 = acc[ai][bj][m][0] * rn * g0, v1 = acc[ai][bj][m][1] * rn * g1;
                    u32x4 w8; w8.x = cvt_pk_bf16(v0[0], v0[1]); w8.y = cvt_pk_bf16(v0[2], v0[3]); w8.z = cvt_pk_bf16(v1[0], v1[1]); w8.w = cvt_pk_bf16(v1[2], v1[3]);
                    *(u32x4*)(dsth + ((size_t)(b * 32 + head0 + bj) * SEQ + sq) * 128 + cw) = w8; } }
    }
};

template <bool IB, bool OB> struct EpiResB {
    static constexpr bool PERM = true, AFTER_DRAIN = false;
    const void* base; void* out; int ldc; float scale;
    __device__ __forceinline__ void operator()(const f32x4 (&acc)[2][2][4][2], const Unit& u, int wr, int wc, int fr, int fq) const {
        const int row0 = u.pm * BM + wr * 64 + fr, col0 = u.pn * BM + wc * 32 + 8 * fq;
#pragma unroll
        for (int ai = 0; ai < 2; ++ai)
#pragma unroll
            for (int m = 0; m < 4; ++m) { const size_t off = (size_t)(row0 + ai * HALF + m * 16) * ldc + col0;
                f32x4 b0[2], b1[2];
#pragma unroll
                for (int bj = 0; bj < 2; ++bj) {
                    if (IB) { const u32x4 r = *(const u32x4*)((const bf16_t*)base + off + bj * HALF);
                        b0[bj] = (f32x4){__uint_as_float(r.x << 16), __uint_as_float(r.x & 0xffff0000u), __uint_as_float(r.y << 16), __uint_as_float(r.y & 0xffff0000u)};
                        b1[bj] = (f32x4){__uint_as_float(r.z << 16), __uint_as_float(r.z & 0xffff0000u), __uint_as_float(r.w << 16), __uint_as_float(r.w & 0xffff0000u)}; }
                    else { b0[bj] = *(const f32x4*)((const float*)base + off + bj * HALF); b1[bj] = *(const f32x4*)((const float*)base + off + bj * HALF + 4); } }
#pragma unroll
                for (int bj = 0; bj < 2; ++bj) { const f32x4 v0 = b0[bj] + acc[ai][bj][m][0] * scale, v1 = b1[bj] + acc[ai][bj][m][1] * scale;
                    if (OB) { u32x4 w; w.x = cvt_pk_bf16(v0[0], v0[1]); w.y = cvt_pk_bf16(v0[2], v0[3]); w.z = cvt_pk_bf16(v1[0], v1[1]); w.w = cvt_pk_bf16(v1[2], v1[3]);
                        *(u32x4*)((bf16_t*)out + off + bj * HALF) = w; }
                    else { *(f32x4*)((float*)out + off + bj * HALF) = v0; *(f32x4*)((float*)out + off + bj * HALF + 4) = v1; } }
                asm volatile("" ::: "memory"); }
    }
};

struct EpiBf16R {
    static constexpr bool PERM = true, AFTER_DRAIN = false;
    bf16_t* O; int ldc; const float* rs;
    __device__ __forceinline__ void operator()(const f32x4 (&acc)[2][2][4][2], const Unit& u, int wr, int wc, int fr, int fq) const {
        const int row0 = u.pm * BM + wr * 64 + fr, col0 = u.pn * BM + wc * 32 + 8 * fq;
#pragma unroll
        for (int ai = 0; ai < 2; ++ai)
#pragma unroll
            for (int m = 0; m < 4; ++m) { const int row = row0 + ai * HALF + m * 16; const float r = rs[row]; bf16_t* rowp = O + (size_t)row * ldc + col0;
#pragma unroll
                for (int bj = 0; bj < 2; ++bj) { const f32x4 v0 = acc[ai][bj][m][0] * r, v1 = acc[ai][bj][m][1] * r;
                    u32x4 w; w.x = cvt_pk_bf16(v0[0], v0[1]); w.y = cvt_pk_bf16(v0[2], v0[3]); w.z = cvt_pk_bf16(v1[0], v1[1]); w.w = cvt_pk_bf16(v1[2], v1[3]);
                    *(u32x4*)(rowp + bj * HALF) = w; } }
    }
};
template <class Epi, class Sched, bool ALIGN_EPI = false, bool SP2 = false, bool F8 = false>
__device__ __forceinline__ void gemm_phase(PG8_LAS unsigned char* lds, const Gemm g, const Sched& S, const Epi& E) {
    const int tid = threadIdx.x, wid = __builtin_amdgcn_readfirstlane(tid >> 6), lane = tid & 63, wr = wid >> 2, wc = wid & 3, fr = lane & 15, fq = lane >> 4;
    const int K = g.K, nt = K / BK;
    unsigned voffA[2], voffB[2];
#pragma unroll
    for (int i = 0; i < 2; ++i) { int R, C; stage_rc(tid * 16 + i * 8192, R, C); const int Rb = Epi::PERM ? ((R & ~31) + perm32(R & 31)) : R;
        voffA[i] = (unsigned)(R * K + C) * 2u; voffB[i] = (unsigned)(Rb * K + C) * 2u; }
    const size_t kstep = (size_t)(BK * 2);
    const size_t hstep = (size_t)HALF * K * 2;
    const size_t tstep = 2 * hstep;
    const unsigned ldsw = (unsigned)wid * 1024u;
    const int aoff = lds_byte(wr * 64 + fr, fq * 8), boff = lds_byte(wc * 32 + fr, fq * 8);
#define PG8_SA(b, h) (((b) * 2 + (h)) * HTB)
#define PG8_SB(b, h) ((4 + (b) * 2 + (h)) * HTB)
#define PG8_STAGE(bufoff, gbase, voff) do { _Pragma("unroll") for (int _i = 0; _i < 2; ++_i) \
        __builtin_amdgcn_global_load_lds((const unsigned*)((const char*)(gbase) + (voff)[_i]), (PG8_LAS unsigned*)(lds + (bufoff) + ldsw + _i * 8192), 16, 0, 0); } while (0)
#define PG8_LDA(dst, b, h) do { if constexpr (F8) { _Pragma("unroll") for (int m = 0; m < 4; ++m) { const i32x4 lo_ = *(const PG8_LAS i32x4*)(lds + PG8_SA(b, h) + aoff + m * 2048), hi_ = *(const PG8_LAS i32x4*)(lds + PG8_SA(b, h) + aoff + m * 2048 + 1024); \
        dst##_8[m] = __builtin_shufflevector(lo_, hi_, 0, 1, 2, 3, 4, 5, 6, 7); } } else { _Pragma("unroll") for (int m = 0; m < 4; ++m) _Pragma("unroll") for (int k = 0; k < 2; ++k) dst[m][k] = *(const PG8_LAS bf16x8*)(lds + PG8_SA(b, h) + aoff + m * 2048 + k * 1024); } } while (0)
#define PG8_LDB(dst, b, h) do { if constexpr (F8) { _Pragma("unroll") for (int n = 0; n < 2; ++n) { const i32x4 lo_ = *(const PG8_LAS i32x4*)(lds + PG8_SB(b, h) + boff + n * 2048), hi_ = *(const PG8_LAS i32x4*)(lds + PG8_SB(b, h) + boff + n * 2048 + 1024); \
        dst##_8[n] = __builtin_shufflevector(lo_, hi_, 0, 1, 2, 3, 4, 5, 6, 7); } } else { _Pragma("unroll") for (int n = 0; n < 2; ++n) _Pragma("unroll") for (int k = 0; k < 2; ++k) dst[n][k] = *(const PG8_LAS bf16x8*)(lds + PG8_SB(b, h) + boff + n * 2048 + k * 1024); } } while (0)
#define PG8_MMA(ai, bj, At, Bt) do { __builtin_amdgcn_s_setprio(1); if constexpr (F8) { _Pragma("unroll") for (int m = 0; m < 4; ++m) _Pragma("unroll") for (int n = 0; n < 2; ++n) \
        asm volatile("v_mfma_f32_16x16x128_f8f6f4 %0, %1, %2, %0" : "+v"(acc[ai][bj][m][n]) : "v"(Bt##_8[n]), "v"(At##_8[m])); } \
    else { _Pragma("unroll") for (int m = 0; m < 4; ++m) _Pragma("unroll") for (int n = 0; n < 2; ++n) _Pragma("unroll") for (int k = 0; k < 2; ++k) \
        acc[ai][bj][m][n] = __builtin_amdgcn_mfma_f32_16x16x32_bf16(Bt[n][k], At[m][k], acc[ai][bj][m][n], 0, 0, 0); } __builtin_amdgcn_s_setprio(0); } while (0)
#define PG8_WAIT_V(n) asm volatile("s_waitcnt vmcnt(" #n ")" ::: "memory")
#define PG8_WAIT_L(n) asm volatile("s_waitcnt lgkmcnt(" #n ")" ::: "memory")
#define PG8_BAR __builtin_amdgcn_s_barrier()
#define PG8_SCHED __builtin_amdgcn_sched_barrier(0)
    Unit cur, nxt; int ui = 0;
    if (!S.next(0, cur)) return;
    f32x4 acc[2][2][4][2];
#pragma unroll
    for (int a = 0; a < 2; ++a)
#pragma unroll
        for (int b = 0; b < 2; ++b)
#pragma unroll
            for (int m = 0; m < 4; ++m)
#pragma unroll
                for (int n = 0; n < 2; ++n) acc[a][b][m][n] = (f32x4){0.f, 0.f, 0.f, 0.f};
    const int f8_scale_one = 0x7F7F7F7F;
    bf16x8 At[4][2], B0[2][2], B1[2][2]; i32x8 At_8[4], B0_8[2], B1_8[2];
    const char* cA = (const char*)g.A + (size_t)cur.pm * tstep; const char* cB = (const char*)g.Bt + (size_t)cur.pn * tstep;
    S.a_ready(cur);
    if constexpr (SP2) {
        PG8_STAGE(PG8_SB(0, 0), cB, voffB); PG8_STAGE(PG8_SB(0, 1), cB + hstep, voffB); PG8_STAGE(PG8_SA(0, 0), cA, voffA); PG8_STAGE(PG8_SA(0, 1), cA + hstep, voffA);
        if (wr == 1) PG8_BAR;
        PG8_WAIT_V(2); PG8_BAR;
        PG8_STAGE(PG8_SB(1, 0), cB + kstep, voffB); PG8_STAGE(PG8_SA(1, 0), cA + kstep, voffA); PG8_STAGE(PG8_SB(1, 1), cB + hstep + kstep, voffB);
        PG8_WAIT_V(6); PG8_BAR;
    } else {
        PG8_STAGE(PG8_SB(0, 0), cB, voffB); PG8_STAGE(PG8_SA(0, 0), cA, voffA); PG8_STAGE(PG8_SB(0, 1), cB + hstep, voffB); PG8_STAGE(PG8_SA(0, 1), cA + hstep, voffA);
        if (wr == 1) PG8_BAR;
        PG8_WAIT_V(4); PG8_BAR;
        PG8_STAGE(PG8_SB(1, 0), cB + kstep, voffB); PG8_STAGE(PG8_SA(1, 0), cA + kstep, voffA); PG8_STAGE(PG8_SB(1, 1), cB + hstep + kstep, voffB);
        PG8_WAIT_V(6); PG8_BAR;
    }
    for (;;) {
        const bool has_next = S.next(ui + 1, nxt);
        const char* nA = has_next ? (const char*)g.A + (size_t)nxt.pm * tstep : cA; const char* nB = has_next ? (const char*)g.Bt + (size_t)nxt.pn * tstep : cB;
        for (int t = 0; t < nt; t += 2) {
            const bool last = (t == nt - 2);
            const char* a1 = cA + (size_t)(t + 1) * kstep;
            const char* a2 = last ? nA : cA + (size_t)(t + 2) * kstep; const char* b2 = last ? nB : cB + (size_t)(t + 2) * kstep;
            const char* a3 = a2 + kstep; const char* b3 = b2 + kstep;
            if (last && has_next) S.a_ready(nxt);
            if constexpr (SP2) {
            PG8_LDB(B0, 0, 0); PG8_LDB(B1, 0, 1); PG8_SCHED; PG8_LDA(At, 0, 0); PG8_STAGE(PG8_SA(1, 1), a1 + hstep, voffA);
            PG8_WAIT_V(8); PG8_WAIT_L(0); PG8_BAR; PG8_MMA(0, 0, At, B0); PG8_MMA(0, 1, At, B1); PG8_BAR; PG8_SCHED;
            PG8_LDA(At, 0, 1); PG8_STAGE(PG8_SB(0, 0), b2, voffB); PG8_STAGE(PG8_SB(0, 1), b2 + hstep, voffB); PG8_STAGE(PG8_SA(0, 0), a2, voffA);
            PG8_WAIT_V(8); PG8_WAIT_L(0); PG8_BAR; PG8_MMA(1, 0, At, B0); PG8_MMA(1, 1, At, B1); PG8_BAR; PG8_SCHED;
            PG8_LDB(B0, 1, 0); PG8_LDB(B1, 1, 1); PG8_SCHED; PG8_LDA(At, 1, 0); PG8_STAGE(PG8_SA(0, 1), a2 + hstep, voffA);
            PG8_WAIT_V(8); PG8_WAIT_L(0); PG8_BAR; PG8_MMA(0, 0, At, B0); PG8_MMA(0, 1, At, B1); PG8_BAR; PG8_SCHED;
            PG8_LDA(At, 1, 1); PG8_STAGE(PG8_SB(1, 0), b3, voffB); PG8_STAGE(PG8_SB(1, 1), b3 + hstep, voffB); PG8_STAGE(PG8_SA(1, 0), a3, voffA);
            PG8_WAIT_V(8); PG8_WAIT_L(0); PG8_BAR; PG8_MMA(1, 0, At, B0); PG8_MMA(1, 1, At, B1); PG8_BAR; PG8_SCHED;
            } else {
            PG8_LDB(B0, 0, 0); PG8_SCHED; PG8_LDA(At, 0, 0); PG8_STAGE(PG8_SA(1, 1), a1 + hstep, voffA);
            PG8_WAIT_L(8); PG8_BAR; PG8_WAIT_L(0); PG8_MMA(0, 0, At, B0); PG8_BAR; PG8_SCHED;
            PG8_LDB(B1, 0, 1); PG8_STAGE(PG8_SB(0, 0), b2, voffB);
            PG8_BAR; PG8_WAIT_L(0); PG8_MMA(0, 1, At, B1); PG8_BAR;
            PG8_LDA(At, 0, 1); PG8_STAGE(PG8_SA(0, 0), a2, voffA);
            PG8_BAR; PG8_WAIT_L(0); PG8_MMA(1, 0, At, B0); PG8_BAR; PG8_SCHED;
            PG8_STAGE(PG8_SB(0, 1), b2 + hstep, voffB);
            PG8_WAIT_V(6); PG8_BAR; PG8_MMA(1, 1, At, B1); PG8_BAR;
            PG8_LDB(B0, 1, 0); PG8_SCHED; PG8_LDA(At, 1, 0); PG8_STAGE(PG8_SA(0, 1), a2 + hstep, voffA);
            PG8_WAIT_L(8); PG8_BAR; PG8_WAIT_L(0); PG8_MMA(0, 0, At, B0); PG8_BAR; PG8_SCHED;
            PG8_LDB(B1, 1, 1); PG8_STAGE(PG8_SB(1, 0), b3, voffB);
            PG8_BAR; PG8_WAIT_L(0); PG8_MMA(0, 1, At, B1); PG8_BAR;
            PG8_LDA(At, 1, 1); PG8_STAGE(PG8_SA(1, 0), a3, voffA);
            PG8_BAR; PG8_WAIT_L(0); PG8_MMA(1, 0, At, B0); PG8_BAR; PG8_SCHED;
            PG8_STAGE(PG8_SB(1, 1), b3 + hstep, voffB);
            PG8_WAIT_V(6); PG8_BAR; PG8_MMA(1, 1, At, B1); PG8_BAR;
            }
        }
        if constexpr (ALIGN_EPI) { if (wr == 0) PG8_BAR; }
        if constexpr (!Epi::AFTER_DRAIN) { E(acc, cur, wr, wc, fr, fq); S.done(cur); }
        if (!has_next) break;
#pragma unroll
        for (int a = 0; a < 2; ++a)
#pragma unroll
            for (int b = 0; b < 2; ++b)
#pragma unroll
                for (int m = 0; m < 4; ++m)
#pragma unroll
                    for (int n = 0; n < 2; ++n) acc[a][b][m][n] = (f32x4){0.f, 0.f, 0.f, 0.f};
        cur = nxt; cA = nA; cB = nB; ++ui;
        if constexpr (ALIGN_EPI) { if (wr == 1) PG8_BAR; }
    }
    PG8_WAIT_V(0);
    if constexpr (!ALIGN_EPI) { if (wr == 0) PG8_BAR; }
    PG8_BAR;
    if constexpr (Epi::AFTER_DRAIN) { E.fused(acc, cur, wr, wc, fr, fq, lds, wid, lane); S.done(cur); }
#undef PG8_SA
#undef PG8_SB
#undef PG8_STAGE
#undef PG8_LDA
#undef PG8_LDB
#undef PG8_MMA
#undef PG8_WAIT_V
#undef PG8_WAIT_L
#undef PG8_BAR
#undef PG8_SCHED
}
}
namespace att {
constexpr int D = 128;
#if F8_KVQ == 1
constexpr int VSTR = 12288;
#else
constexpr int VSTR = 128;
#endif
constexpr int WINDOW = 4096;
constexpr float THR = 8.f;
constexpr bool WSKIP = false;
constexpr float SCALE = 0.08838834764831845f;
constexpr int NW = 8, QBLK = 32, KVBLK = 64, QB = NW * QBLK;
constexpr int SHM_V = KVBLK * D * 2, SHM_K = KVBLK * D * 2;
constexpr int LDS_BYTES = 2 * SHM_V + 2 * SHM_K + NW * 64 * 4;
using bf16 = __hip_bfloat16;
typedef short bf16x8 __attribute__((ext_vector_type(8)));
typedef short s16x4 __attribute__((ext_vector_type(4)));
typedef float f32x16 __attribute__((ext_vector_type(16)));
typedef float f32x4 __attribute__((ext_vector_type(4)));
typedef unsigned u32x4 __attribute__((ext_vector_type(4)));
template <class A, class Bt> struct same_t { static constexpr bool v = false; };
template <class A> struct same_t<A, A> { static constexpr bool v = true; };

#define KSWZ(row, colB) ((row) * 256 + ((colB) ^ (((row) & 7) << 4)))
#define SBAR() __builtin_amdgcn_sched_barrier(0)
__device__ __forceinline__ int v_st(int k, int c) { const int kk = (k & ~0xC) | ((k & 4) << 1) | ((k & 8) >> 1); return ((kk >> 3) * 4 + (c >> 5)) * 512 + ((kk & 7) * 32 + (c & 31)) * 2; }
__device__ __forceinline__ int v_rd_base(int lane) { return ((lane & 3) << 3) | (((lane >> 2) & 3) << 6) | (((lane >> 4) & 1) << 5) | (((lane >> 5) & 1) << 8); }
constexpr int v_rd_off(int d0, int ks, int half) { return d0 * 512 + ks * 4096 + half * 2048; }
__device__ __forceinline__ int crow(int r, int hi) { return (r & 3) + 8 * (r >> 2) + 4 * hi; }
__device__ __forceinline__ unsigned cvtpk(float lo, float hi) {
    unsigned r; asm volatile("v_cvt_pk_bf16_f32 %0, %1, %2" : "=v"(r) : "v"(lo), "v"(hi)); return r;
}
__device__ __forceinline__ bf16x8 pack8(f32x4 a, f32x4 b) {
    u32x4 w = {cvtpk(a[0], a[1]), cvtpk(a[2], a[3]), cvtpk(b[0], b[1]), cvtpk(b[2], b[3])};
    return *reinterpret_cast<bf16x8*>(&w);
}
template <class T> __device__ __forceinline__ bf16x8 load8(const T* p) {
    if constexpr (same_t<T, float>::v) { return pack8(*(const f32x4*)p, *(const f32x4*)(p + 4)); }
    else { return *reinterpret_cast<const bf16x8*>(p); }
}
__device__ __forceinline__ void mask_tile(f32x16& p0, f32x16& p1, int dq, unsigned W) {
    const float NEG = -__builtin_inff();
#pragma unroll
    for (int r = 0; r < 16; ++r) {
        const int c = (r & 3) + 8 * (r >> 2);
        if ((unsigned)(dq - c) >= W) p0[r] = NEG;
        if ((unsigned)(dq - c - 32) >= W) p1[r] = NEG;
    }
}
__device__ __forceinline__ void partialSM(f32x16& p0, f32x16& p1, float& m_reg, float& mn, float& alpha) {
    float pmax = p0[0]; for (int r = 1; r < 16; ++r) pmax = fmaxf(pmax, p0[r]); for (int r = 0; r < 16; ++r) pmax = fmaxf(pmax, p1[r]);
    { auto rr = __builtin_amdgcn_permlane32_swap(__float_as_uint(pmax), __float_as_uint(pmax), false, false);
      pmax = fmaxf(__uint_as_float(rr[0]), __uint_as_float(rr[1])); }
    constexpr float C2 = 1.4426950408889634f * SCALE;
    if (__builtin_expect(__all((pmax - m_reg) * SCALE <= THR), 1)) { mn = m_reg; alpha = 1.f; }
    else { mn = fmaxf(m_reg, pmax); alpha = __builtin_amdgcn_exp2f((m_reg - mn) * C2); m_reg = mn; }
    const float mnL = -mn * C2;
    for (int r = 0; r < 16; ++r) p0[r] = fmaf(p0[r], C2, mnL); for (int r = 0; r < 16; ++r) p1[r] = fmaf(p1[r], C2, mnL);
    for (int r = 0; r < 16; ++r) p0[r] = __builtin_amdgcn_exp2f(p0[r]);
}
__device__ __forceinline__ void finishSM(f32x16& p0, f32x16& p1, float alpha, float& l_reg, bf16x8& pa0, bf16x8& pa1, bf16x8& pa2, bf16x8& pa3) {
    for (int r = 0; r < 16; ++r) p1[r] = __builtin_amdgcn_exp2f(p1[r]);
    float ps = 0; for (int r = 0; r < 16; ++r) ps += p0[r]; for (int r = 0; r < 16; ++r) ps += p1[r];
    { auto rr = __builtin_amdgcn_permlane32_swap(__float_as_uint(ps), __float_as_uint(ps), false, false);
      ps = __uint_as_float(rr[0]) + __uint_as_float(rr[1]); }
    l_reg = l_reg * alpha + ps;
#define PK4(P, B_, OUT) do { unsigned a0 = cvtpk(P[B_+0], P[B_+1]), a1 = cvtpk(P[B_+2], P[B_+3]);                          \
        unsigned b0 = cvtpk(P[B_+4], P[B_+5]), b1 = cvtpk(P[B_+6], P[B_+7]);                                             \
        auto r0 = __builtin_amdgcn_permlane32_swap(a0, b0, false, false); auto r1 = __builtin_amdgcn_permlane32_swap(a1, b1, false, false); \
        u32x4 w = {r0[0], r1[0], r0[1], r1[1]}; OUT = *reinterpret_cast<bf16x8*>(&w); } while (0)
    PK4(p0, 0, pa0); PK4(p0, 8, pa1); PK4(p1, 0, pa2); PK4(p1, 8, pa3);
#undef PK4
}
template <int KB, bool SK>
__device__ __forceinline__ void qkt(f32x16& p0, f32x16& p1, const char* K_lds, int r32, int hi, const bf16x8* qr, bool act) {
    if (SK && !act) { const float NEG = -__builtin_inff();
#pragma unroll
        for (int r = 0; r < 16; ++r) { p0[r] = NEG; p1[r] = NEG; } return; }
    p0 = f32x16{}; p1 = f32x16{};
    const char* kb[4];
#pragma unroll
    for (int dd = 0; dd < 4; ++dd) kb[dd] = K_lds + KB * SHM_K + KSWZ(r32, (dd * 16 + hi * 8) * 2);
#pragma unroll
    for (int d0 = 0; d0 < 8; ++d0) { const char* a = kb[d0 & 3] + (d0 >> 2) * 128;
        bf16x8 b0 = *reinterpret_cast<const bf16x8*>(a);
        bf16x8 b1 = *reinterpret_cast<const bf16x8*>(a + 32 * 256);
        p0 = __builtin_amdgcn_mfma_f32_32x32x16_bf16(b0, qr[d0], p0, 0, 0, 0);
        p1 = __builtin_amdgcn_mfma_f32_32x32x16_bf16(b1, qr[d0], p1, 0, 0, 0); }
}
template <int VB, bool SK>
__device__ __forceinline__ void pv_tile(f32x16* o, int vb0, bf16x8 pa0, bf16x8 pa1, bf16x8 pa2, bf16x8 pa3, bool act) {
    if (SK && !act) return;
#define TRRD(dst, off) asm volatile("ds_read_b64_tr_b16 %0, %1 offset:%2" : "=&v"(dst) : "v"(vb0), "i"(off) : "memory")
#define PV_D0(d0) do { s16x4 l0, l1, l2, l3, h0, h1, h2, h3; constexpr int b_ = VB * SHM_V + v_rd_off(d0, 0, 0);     \
        TRRD(l0, b_); TRRD(h0, b_ + 2048); TRRD(l1, b_ + 4096); TRRD(h1, b_ + 6144); TRRD(l2, b_ + 8192); TRRD(h2, b_ + 10240); TRRD(l3, b_ + 12288); TRRD(h3, b_ + 14336); \
        asm volatile("s_waitcnt lgkmcnt(0)" ::: "memory"); SBAR();                 \
        o[d0] = __builtin_amdgcn_mfma_f32_32x32x16_bf16(pa0, (bf16x8){l0[0], l0[1], l0[2], l0[3], h0[0], h0[1], h0[2], h0[3]}, o[d0], 0, 0, 0);   \
        o[d0] = __builtin_amdgcn_mfma_f32_32x32x16_bf16(pa1, (bf16x8){l1[0], l1[1], l1[2], l1[3], h1[0], h1[1], h1[2], h1[3]}, o[d0], 0, 0, 0);   \
        o[d0] = __builtin_amdgcn_mfma_f32_32x32x16_bf16(pa2, (bf16x8){l2[0], l2[1], l2[2], l2[3], h2[0], h2[1], h2[2], h2[3]}, o[d0], 0, 0, 0);   \
        o[d0] = __builtin_amdgcn_mfma_f32_32x32x16_bf16(pa3, (bf16x8){l3[0], l3[1], l3[2], l3[3], h3[0], h3[1], h3[2], h3[3]}, o[d0], 0, 0, 0); } while (0)
    PV_D0(0); PV_D0(1); PV_D0(2); PV_D0(3);
#undef PV_D0
#undef TRRD
}

template <class TIn, class TOut> struct BlockRef { const TIn* Q; const TIn* K; const TIn* V; TOut* O; int P0; };
template <class TIn> struct Seam {
    bf16x8 qr[8];
    bf16x8 st_v0, st_v1, st_k0, st_k1; f32x4 sf0, sf1, sf2, sf3;
    f32x4 tq[16];
};
__device__ __forceinline__ int swa_jlo(int P0, int W) { const int lowk = P0 - W + 1; return lowk > 0 ? lowk / KVBLK : 0; }
#define ROW(p, k0, rr) ((p) + (size_t)((k0) + (rr)) * D + sc)
#define ROWV(p, k0, rr) ((p) + (size_t)((k0) + (rr)) * VSTR + sc)
#define VMW() asm volatile("s_waitcnt vmcnt(0)" ::: "memory")
#define VMWN(n) asm volatile("s_waitcnt vmcnt(%0)" :: "i"(n) : "memory")
#define SLOAD_H(Kp, Vp, k0) do { S.st_v0 = load8<TIn>(ROWV(Vp, k0, sr)); S.st_v1 = load8<TIn>(ROWV(Vp, k0, 32 + sr));              \
                         S.st_k0 = load8<TIn>(ROW(Kp, k0, sr)); S.st_k1 = load8<TIn>(ROW(Kp, k0, 32 + sr)); } while (0)
#define SWRITE_HK(bf) do { *(bf16x8*)(K_lds + (bf) * SHM_K + kws) = S.st_k0; *(bf16x8*)(K_lds + (bf) * SHM_K + kws + 32 * 256) = S.st_k1; } while (0)
#define SWRITE_HV(bf) do { *(bf16x8*)(V_lds + (bf) * SHM_V + vst0) = S.st_v0; *(bf16x8*)(V_lds + (bf) * SHM_V + vst1) = S.st_v1; } while (0)
#define SWRITE_H(bf) do { SWRITE_HV(bf); SWRITE_HK(bf); } while (0)
#define SLOAD_F(p, k0) do { S.sf0 = *(const f32x4*)ROW(p, k0, sr); S.sf1 = *(const f32x4*)(ROW(p, k0, sr) + 4);                \
                            S.sf2 = *(const f32x4*)ROW(p, k0, 32 + sr); S.sf3 = *(const f32x4*)(ROW(p, k0, 32 + sr) + 4); } while (0)
#define SWRITE_KF(bf) do { *(bf16x8*)(K_lds + (bf) * SHM_K + kws) = pack8(S.sf0, S.sf1); *(bf16x8*)(K_lds + (bf) * SHM_K + kws + 32 * 256) = pack8(S.sf2, S.sf3); } while (0)
#define SWRITE_VF(bf) do { *(bf16x8*)(V_lds + (bf) * SHM_V + vst0) = pack8(S.sf0, S.sf1); *(bf16x8*)(V_lds + (bf) * SHM_V + vst1) = pack8(S.sf2, S.sf3); } while (0)
template <class TIn, class TOut>
__device__ __forceinline__ void causal_swa_prime(const BlockRef<TIn, TOut>& cur, int W, char* lds, Seam<TIn>& S) {
    constexpr bool F32 = same_t<TIn, float>::v;
    const int tid = threadIdx.x, wid = __builtin_amdgcn_readfirstlane(tid >> 6), lane = tid & 63, r32 = lane & 31, hi = lane >> 5;
    const int sr = tid >> 4, sc = (tid & 15) * 8, kws = KSWZ(sr, sc * 2); char* K_lds = lds + 2 * SHM_V;
    const int kb0 = swa_jlo(cur.P0, W) * KVBLK;
    for (int d0 = 0; d0 < 8; ++d0) S.qr[d0] = load8<TIn>(cur.Q + (size_t)(wid * QBLK + r32) * D + d0 * 16 + hi * 8);
    if constexpr (F32) { SLOAD_F((const float*)cur.K, kb0); VMW(); SWRITE_KF(0); SBAR(); SLOAD_F((const float*)cur.V, kb0); }
    else { SLOAD_H(cur.K, cur.V, kb0); VMW(); SWRITE_HK(0); }
    __syncthreads();
}
template <class TIn, class TOut>
__device__ __forceinline__ void causal_swa_block(const BlockRef<TIn, TOut>& cur, const BlockRef<TIn, TOut>& nxt, int skv, int W, char* lds, Seam<TIn>& S) {
    constexpr bool F32 = same_t<TIn, float>::v;
    const int tid = threadIdx.x, wid = __builtin_amdgcn_readfirstlane(tid >> 6), lane = tid & 63, r32 = lane & 31, hi = lane >> 5;
    const int j_lo = swa_jlo(cur.P0, W);
    int j_hi = (cur.P0 + QB - 1) / KVBLK + 1; if (j_hi > skv / KVBLK) j_hi = skv / KVBLK;
    const int NT = j_hi - j_lo;
    const int kbn = swa_jlo(nxt.P0, W) * KVBLK;
    const int qlo = cur.P0 + wid * QBLK, qm = qlo + r32 - 4 * hi;
    char* V_lds = lds; char* K_lds = lds + 2 * SHM_V;
    float* ws = (float*)(lds + 2 * SHM_V + 2 * SHM_K) + wid * 64; float* li_l = ws, * al_l = ws + 32;
    float m_reg = -1e30f, l_reg = 0; f32x16 o[4] = {};
    const int sr = tid >> 4, sc = (tid & 15) * 8, vst0 = v_st(sr, sc), vst1 = v_st(32 + sr, sc), kws = KSWZ(sr, sc * 2);
    const int vb0 = (int)(uintptr_t)V_lds + v_rd_base(lane);
    const TIn* Kh = cur.K; const TIn* Vh = cur.V;
#define RESC(a) do { if (__any((a) < 1.f)) { if (hi == 0) al_l[r32] = (a); asm volatile("s_waitcnt lgkmcnt(0)" ::: "memory");              \
                     for (int d_ = 0; d_ < 4; ++d_) for (int r = 0; r < 16; ++r) o[d_][r] *= al_l[crow(r, hi)]; } } while (0)
#define KBASE(t) ((j_lo + (t)) * KVBLK)
#define ACT(t) (KBASE(t) <= qlo + QBLK - 1 && KBASE(t) + KVBLK - 1 >= qlo - W + 1)
#define MASKT(P0_, P1_, t) do { const int kb_ = KBASE(t); if ((!SK || ACT(t)) && (kb_ + KVBLK - 1 > qlo || kb_ <= qlo + QBLK - 1 - W)) mask_tile(P0_, P1_, qm - kb_, (unsigned)W); } while (0)
    constexpr int NQL = F32 ? 16 : 8;
    constexpr bool SK = WSKIP && !F32;
#define SEAM_K0() do { VMWN(NQL); if constexpr (F32) { SWRITE_KF(0); SBAR(); SLOAD_F((const float*)nxt.V, kbn); } else { SWRITE_HK(0); } SBAR(); } while (0)
    f32x16 pA0, pA1, pB0, pB1; float mnA, mnB, alA, alB; bf16x8 pa0, pa1, pa2, pa3;
    if constexpr (F32) { VMW(); SWRITE_VF(0); SBAR(); } else { SWRITE_HV(0); SBAR(); }
    if (NT > 1) { if constexpr (F32) SLOAD_F((const float*)Kh, KBASE(1)); else SLOAD_H(Kh, Vh, KBASE(1)); }
    SBAR(); qkt<0, SK>(pA0, pA1, K_lds, r32, hi, S.qr, ACT(0));
    if constexpr (F32) { if (NT > 1) { VMW(); SWRITE_KF(1); SBAR(); SLOAD_F((const float*)Vh, KBASE(1)); } }
    MASKT(pA0, pA1, 0); partialSM(pA0, pA1, m_reg, mnA, alA);
    if (NT > 1) { VMW(); if constexpr (F32) { SWRITE_VF(1); SBAR(); if (NT > 2) SLOAD_F((const float*)Kh, KBASE(2)); } else SWRITE_H(1); }
    __syncthreads();
#define HALF_STEP(PX0, PX1, mnX, alX, PY0, PY1, alY, t, KB, VB, SB) do {                                                      \
        SBAR(); qkt<KB, SK>(PX0, PX1, K_lds, r32, hi, S.qr, ACT(t));                                             \
        finishSM(PY0, PY1, alY, l_reg, pa0, pa1, pa2, pa3); SBAR();                                                           \
        if ((t) + 1 < NT) { if constexpr (F32) { VMW(); SWRITE_KF(SB); SBAR(); SLOAD_F((const float*)Vh, KBASE((t) + 1)); }  \
                            else { SLOAD_H(Kh, Vh, KBASE((t) + 1)); } SBAR(); }                                               \
        pv_tile<VB, SK>(o, vb0, pa0, pa1, pa2, pa3, ACT((t) - 1)); MASKT(PX0, PX1, (t)); partialSM(PX0, PX1, m_reg, mnX, alX);                                        \
        __syncthreads();                                                                                                      \
        if ((t) + 1 < NT) { VMW(); if constexpr (F32) { SWRITE_VF(SB); SBAR(); if ((t) + 2 < NT) SLOAD_F((const float*)Kh, KBASE((t) + 2)); } \
                            else { SWRITE_H(SB); } }                                                                          \
        RESC(alX); __syncthreads(); } while (0)
    for (int t = 1; t + 1 < NT; t += 2) {
        HALF_STEP(pB0, pB1, mnB, alB, pA0, pA1, alA, t, 1, 0, 0);
        HALF_STEP(pA0, pA1, mnA, alA, pB0, pB1, alB, t + 1, 0, 1, 1);
    }
    const bool even = (NT & 1) == 0;
    if (even) { SBAR(); qkt<1, SK>(pB0, pB1, K_lds, r32, hi, S.qr, ACT(NT - 1)); SBAR(); }
#define QROW(e) (nxt.Q + (size_t)(wid * QBLK + r32) * D + ((e) >> 1) * 16 + hi * 8 + ((e) & 1) * 4)
    if constexpr (F32) { SLOAD_F((const float*)nxt.K, kbn); SBAR();
#pragma unroll
        for (int e = 0; e < 8; ++e) S.tq[e] = *(const f32x4*)QROW(e); }
    else { SLOAD_H(nxt.K, nxt.V, kbn); SBAR();
#pragma unroll
        for (int d0 = 0; d0 < 8; ++d0) S.qr[d0] = load8<TIn>(nxt.Q + (size_t)(wid * QBLK + r32) * D + d0 * 16 + hi * 8); }
    SBAR();
    finishSM(pA0, pA1, alA, l_reg, pa0, pa1, pa2, pa3); SBAR();
    if constexpr (F32) {
#pragma unroll
        for (int e = 8; e < 16; ++e) S.tq[e] = *(const f32x4*)QROW(e); SBAR(); }
#undef QROW
    pv_tile<0, SK>(o, vb0, pa0, pa1, pa2, pa3, ACT(even ? NT - 2 : NT - 1));
    if (even) { MASKT(pB0, pB1, NT - 1); partialSM(pB0, pB1, m_reg, mnB, alB); __syncthreads(); RESC(alB);
        finishSM(pB0, pB1, alB, l_reg, pa0, pa1, pa2, pa3); SBAR(); pv_tile<1, SK>(o, vb0, pa0, pa1, pa2, pa3, ACT(NT - 1)); }
    SBAR(); SEAM_K0();
    if (hi == 0) li_l[r32] = l_reg; asm volatile("s_waitcnt lgkmcnt(0)" ::: "memory");
    float rli[16];
#pragma unroll
    for (int r = 0; r < 16; ++r) rli[r] = __builtin_amdgcn_rcpf(li_l[crow(r, hi)]);
    TOut* Ow = cur.O + (size_t)(wid * QBLK) * D;
#pragma unroll
    for (int r = 0; r < 16; ++r) { const int orow = crow(r, hi);
#pragma unroll
        for (int d0 = 0; d0 < 4; ++d0) { const float v = o[d0][r] * rli[r];
            if constexpr (same_t<TOut, float>::v) { Ow[(size_t)orow * D + d0 * 32 + r32] = v; }
            else { const float vn = __shfl_xor(v, 1);
                   if ((r32 & 1) == 0) *(unsigned*)(Ow + (size_t)orow * D + d0 * 32 + r32) = cvtpk(v, vn); } } }
    if constexpr (F32) {
#pragma unroll
        for (int d0 = 0; d0 < 8; ++d0) S.qr[d0] = pack8(S.tq[2 * d0], S.tq[2 * d0 + 1]); }
    __syncthreads();
#undef RESC
#undef KBASE
#undef ACT
#undef MASKT
#undef SEAM_K0
#undef HALF_STEP
}
#undef ROW
#undef ROWV
#undef VMW
#undef VMWN
#undef SLOAD_H
#undef SWRITE_HK
#undef SWRITE_HV
#undef SWRITE_H
#undef SLOAD_F
#undef SWRITE_KF
#undef SWRITE_VF
}
struct Ctx { LAS unsigned char* lds; int tid, lane, wave, vcu, G; };

__device__ __forceinline__ void tr_load(f4v (&v)[16], float (&gk)[16], const float* __restrict__ src, size_t ldn, const float* __restrict__ gain, int k0, int nsrc0, int lane) {
    const int r4 = lane >> 4, c4 = (lane & 15) * 4;
#pragma unroll
    for (int i = 0; i < 16; ++i) v[i] = *(const f4v*)(src + (size_t)(k0 + 4 * i + r4) * ldn + nsrc0 + c4);
#pragma unroll
    for (int i = 0; i < 16; ++i) gk[i] = gain ? gain[k0 + 4 * i + r4] : 1.f;
}
__device__ __forceinline__ void tr_item(const f4v (&v)[16], const float (&gv)[16], bfr* __restrict__ dst, int K,
                                        int k0, int drow0, LAS float* scr, int lane) {
    const int r4 = lane >> 4, c4 = (lane & 15) * 4;
#pragma unroll
    for (int i = 0; i < 16; ++i) { const int k = 4 * i + r4; const float gk = gv[i];
        LAS float* s = scr + k * 65 + c4; s[0] = v[i][0] * gk; s[1] = v[i][1] * gk; s[2] = v[i][2] * gk; s[3] = v[i][3] * gk; }
    LDS_WAIT(); asm volatile("" ::: "memory");
    const int c = lane & 7;
#pragma unroll
    for (int jj = 0; jj < 8; ++jj) { const int n = (lane >> 3) + 8 * jj; const LAS float* s = scr + (8 * c) * 65 + n;
        u4v o; o.x = cvtpk(s[0 * 65], s[1 * 65]); o.y = cvtpk(s[2 * 65], s[3 * 65]); o.z = cvtpk(s[4 * 65], s[5 * 65]); o.w = cvtpk(s[6 * 65], s[7 * 65]);
        *(u4v*)(dst + (size_t)(drow0 + n) * K + k0 + 8 * c) = o; }
    LDS_WAIT(); asm volatile("" ::: "memory");
}
__device__ __forceinline__ void tr_item8(const f4v (&v)[16], float sc, const float (&gv)[16], unsigned char* __restrict__ dst, int K, int k0, int drow0, LAS float* scr, int lane) {
    const int r4 = lane >> 4, c4 = (lane & 15) * 4;
#pragma unroll
    for (int i = 0; i < 16; ++i) { const int k = 4 * i + r4; const float gk = gv[i] * sc; LAS float* s = scr + k * 65 + c4; s[0] = v[i][0] * gk; s[1] = v[i][1] * gk; s[2] = v[i][2] * gk; s[3] = v[i][3] * gk; }
    LDS_WAIT(); asm volatile("" ::: "memory");
    const int c = lane & 3;
#pragma unroll
    for (int jj = 0; jj < 4; ++jj) { const int n = (lane >> 2) + 16 * jj; const LAS float* s = scr + (16 * c) * 65 + n;
        u4v o; o.x = cvt4_fp8(s[0 * 65], s[1 * 65], s[2 * 65], s[3 * 65]); o.y = cvt4_fp8(s[4 * 65], s[5 * 65], s[6 * 65], s[7 * 65]);
        o.z = cvt4_fp8(s[8 * 65], s[9 * 65], s[10 * 65], s[11 * 65]); o.w = cvt4_fp8(s[12 * 65], s[13 * 65], s[14 * 65], s[15 * 65]);
        *(u4v*)(dst + (size_t)(drow0 + n) * K + k0 + 16 * c) = o; }
    LDS_WAIT(); asm volatile("" ::: "memory");
}
__device__ __forceinline__ void tr_job8(const float* __restrict__ src, size_t ldn, float sc, const float* __restrict__ gain, unsigned char* __restrict__ dst, int K, int ncols, LAS float* scr, int lane, int gw, int NGW, int nsrc0 = 0) {
    const int nn = ncols / 64, ni = (K / 64) * nn;
    float ga[16], gb[16];
    f4v va[16], vb[16];
#define TRJ_LOAD(V, G_, it_) do { const int kb_ = (it_) / nn, nb_ = (it_) - kb_ * nn; tr_load(V, G_, src, ldn, gain, kb_ * 64, nsrc0 + nb_ * 64, lane); } while (0)
#define TRJ_ITEM(V, G_, it_) do { const int kb_ = (it_) / nn, nb_ = (it_) - kb_ * nn; tr_item8(V, sc, G_, dst, K, kb_ * 64, nb_ * 64, scr, lane); } while (0)
    int it = gw;
    if (it < ni) {
        TRJ_LOAD(va, ga, it);
        while (it + 2 * NGW < ni) {
            TRJ_LOAD(vb, gb, it + NGW); TRJ_ITEM(va, ga, it); TRJ_LOAD(va, ga, it + 2 * NGW); TRJ_ITEM(vb, gb, it + NGW); it += 2 * NGW; }
        if (it + NGW < ni) { TRJ_LOAD(vb, gb, it + NGW); TRJ_ITEM(va, ga, it); TRJ_ITEM(vb, gb, it + NGW); } else TRJ_ITEM(va, ga, it);
    }
#undef TRJ_LOAD
#undef TRJ_ITEM
}
__device__ __forceinline__ void tr_job(const float* __restrict__ src, size_t ldn, const float* __restrict__ gain, bfr* __restrict__ dst, int K, int ncols, int nsrc0, int drow0,
                                       LAS float* scr, int lane, int gw, int NGW) {
    const int nn = ncols / 64, ni = (K / 64) * nn;
    float ga[16], gb[16];
    f4v va[16], vb[16];
#define TRJ_LOAD(V, G_, it_) do { const int kb_ = (it_) / nn, nb_ = (it_) - kb_ * nn; tr_load(V, G_, src, ldn, gain, kb_ * 64, nsrc0 + nb_ * 64, lane); } while (0)
#define TRJ_ITEM(V, G_, it_) do { const int kb_ = (it_) / nn, nb_ = (it_) - kb_ * nn; tr_item(V, G_, dst, K, kb_ * 64, drow0 + nb_ * 64, scr, lane); } while (0)
    int it = gw;
    if (it < ni) {
        TRJ_LOAD(va, ga, it);
        while (it + 2 * NGW < ni) {
            TRJ_LOAD(vb, gb, it + NGW); TRJ_ITEM(va, ga, it); TRJ_LOAD(va, ga, it + 2 * NGW); TRJ_ITEM(vb, gb, it + NGW); it += 2 * NGW; }
        if (it + NGW < ni) { TRJ_LOAD(vb, gb, it + NGW); TRJ_ITEM(va, ga, it); TRJ_ITEM(vb, gb, it + NGW); } else TRJ_ITEM(va, ga, it);
    }
#undef TRJ_LOAD
#undef TRJ_ITEM
}
struct KArgs {
    const float* in[26]; float* out; unsigned char* ws; int ph_lo, ph_hi, li, pad;
};
struct Ptrs {
    LAS unsigned long long* tbl;
    __device__ __forceinline__ unsigned long long get(int k) const { const unsigned long long v = tbl[k];
        return ((unsigned long long)(unsigned)__builtin_amdgcn_readfirstlane((int)(unsigned)(v >> 32)) << 32) | (unsigned)__builtin_amdgcn_readfirstlane((int)(unsigned)v); }
    __device__ __forceinline__ const float* in_(int k) const { return (const float*)get(k); }
    __device__ __forceinline__ float* out_() const { return (float*)get(26); }
    __device__ __forceinline__ unsigned char* ws_() const { return (unsigned char*)get(27); }
};
__device__ __forceinline__ void p_convert(const Ctx& C, const Ptrs& P, const int part, const int vc, const int nc) {
    LAS float* scr = (LAS float*)(C.lds + C.wave * 16640);
    const int gw = vc * 8 + C.wave, NGW = nc * 8;
    unsigned char* ws = P.ws_();
    if (part == 0) {
#if F8_PROJ0 == 1
    tr_job8(P.in_(2), (size_t)GIN, SU, P.in_(1), ws + WS_WTIN, DM, 16384, scr, C.lane, gw, NGW);
#elif F8_PROJ0 == 2
    tr_job(P.in_(2), (size_t)GIN, P.in_(1), (bfr*)(ws + WS_WTIN), DM, 8192, 0, 0, scr, C.lane, gw, NGW);
    tr_job8(P.in_(2), (size_t)GIN, SU, P.in_(1), ws + WS_WTIN + (size_t)8192 * DM * 2, DM, 8192, scr, C.lane, gw, NGW, 8192);
#elif F8_PROJ0 == 5
    tr_job8(P.in_(2), (size_t)GIN, SU, P.in_(1), ws + WS_WTIN, DM, 8192, scr, C.lane, gw, NGW, 0);
    tr_job(P.in_(2), (size_t)GIN, P.in_(1), (bfr*)(ws + WS_WTIN + (size_t)32 * MiB), DM, 4096, 8192, 0, scr, C.lane, gw, NGW);
    tr_job8(P.in_(2), (size_t)GIN, SU, P.in_(1), ws + WS_WTIN + (size_t)64 * MiB, DM, 4096, scr, C.lane, gw, NGW, 12288);
#elif F8_PROJ0 == 6
    tr_job8(P.in_(2), (size_t)GIN, SU, P.in_(1), ws + WS_WTIN, DM, 12288, scr, C.lane, gw, NGW, 0);
    tr_job(P.in_(2), (size_t)GIN, P.in_(1), (bfr*)(ws + WS_WTIN + (size_t)48 * MiB), DM, 4096, 12288, 0, scr, C.lane, gw, NGW);
#elif F8_PROJ0 == 3
    tr_job8(P.in_(2), (size_t)GIN, SU, P.in_(1), ws + WS_WTIN, DM, 8192, scr, C.lane, gw, NGW, 0);
    tr_job(P.in_(2), (size_t)GIN, P.in_(1), (bfr*)(ws + WS_WTIN + (size_t)8192 * DM), DM, 8192, 8192, 0, scr, C.lane, gw, NGW);
#else
    tr_job(P.in_(2), (size_t)GIN, P.in_(1), (bfr*)(ws + WS_WTIN), DM, 16384, 0, 0, scr, C.lane, gw, NGW);
#endif
    tr_job(P.in_(2), (size_t)GIN, P.in_(1), (bfr*)(ws + WS_WTBD), DM, 64, 16384, 0, scr, C.lane, gw, NGW);
#if F8_OUT0
    tr_job8(P.in_(7), (size_t)DM, SU, nullptr, ws + WS_WTOUT, DM, DM, scr, C.lane, gw, NGW, 0);
#else
    tr_job(P.in_(7), (size_t)DM, nullptr, (bfr*)(ws + WS_WTOUT), DM, DM, 0, 0, scr, C.lane, gw, NGW);
#endif
    } else {
#if F8_KVQ
    tr_job8(P.in_(9), (size_t)8192, SU, P.in_(8), ws + WS_WTKVQ, DM, DM, scr, C.lane, gw, NGW, 0);
    tr_job8(P.in_(12), (size_t)DM, SU, P.in_(11), ws + WS_WTKVQ + (size_t)DM * DM, DM, DM, scr, C.lane, gw, NGW, 0);
#if F8_KVQ == 2
    tr_job8(P.in_(9), (size_t)8192, SU, P.in_(8), ws + WS_WTKVQ + (size_t)2 * DM * DM, DM, DM, scr, C.lane, gw, NGW, DM);
#else
    tr_job(P.in_(9), (size_t)8192, P.in_(8), (bfr*)(ws + WS_WTKVQ + (size_t)2 * DM * DM), DM, DM, DM, 0, scr, C.lane, gw, NGW);
#endif
#else
    tr_job(P.in_(9), (size_t)8192, P.in_(8), (bfr*)(ws + WS_WTKVQ), DM, 8192, 0, 0, scr, C.lane, gw, NGW);
    tr_job(P.in_(12), (size_t)DM, P.in_(11), (bfr*)(ws + WS_WTKVQ), DM, DM, 0, 8192, scr, C.lane, gw, NGW);
#endif
#if F8_OUT1
    tr_job8(P.in_(19), (size_t)DM, SU, nullptr, ws + WS_WTO, DM, DM, scr, C.lane, gw, NGW, 0);
#else
    tr_job(P.in_(19), (size_t)DM, nullptr, (bfr*)(ws + WS_WTO), DM, DM, 0, 0, scr, C.lane, gw, NGW);
#endif
    }
    tr_job(P.in_(21) + (size_t)part * DM * PQ, (size_t)PQ, P.in_(20) + part * DM, (bfr*)(ws + WS_WTQRY) + (size_t)part * PQ * DM, DM, PQ, 0, 0, scr, C.lane, gw, NGW);
    tr_job8(P.in_(25) + (size_t)part * PE * DM, (size_t)DM, SV, nullptr, ws + WS_VT + (size_t)part * DM * PE, PE, DM, scr, C.lane, gw, NGW);
    {
        const size_t gt = (size_t)vc * 512 + C.tid, GT = (size_t)nc * 512;
        for (int l = part; l <= part; ++l) {
            const float* src = P.in_(24) + (size_t)l * PE * DM; const float* gain = P.in_(20) + l * DM; unsigned char* dst = ws + WS_U + (size_t)l * PE * DM;
            constexpr size_t NIT = (size_t)PE * DM / 16; size_t i0 = gt;
            for (; i0 + 3 * GT < NIT; i0 += 4 * GT) {
                f4v x[4][4];
#pragma unroll
                for (int u = 0; u < 4; ++u) { const size_t i = i0 + (size_t)u * GT;
#pragma unroll
                    for (int j = 0; j < 4; ++j) x[u][j] = *(const f4v*)(src + i * 16 + 4 * j); }
#pragma unroll
                for (int u = 0; u < 4; ++u) { const size_t i = i0 + (size_t)u * GT; const int dd = (int)((i * 16) & (DM - 1));
                    u4v o; unsigned w[4];
#pragma unroll
                    for (int j = 0; j < 4; ++j) { const f4v g = *(const f4v*)(gain + dd + 4 * j) * SU; w[j] = cvt4_fp8(x[u][j][0] * g[0], x[u][j][1] * g[1], x[u][j][2] * g[2], x[u][j][3] * g[3]); }
                    o.x = w[0]; o.y = w[1]; o.z = w[2]; o.w = w[3];
                    *(u4v*)(dst + i * 16) = o; }
            }
            for (; i0 < NIT; i0 += GT) {
                const size_t i = i0; const int dd = (int)((i * 16) & (DM - 1)); u4v o; unsigned w[4];
#pragma unroll
                for (int j = 0; j < 4; ++j) { const f4v xx = *(const f4v*)(src + i * 16 + 4 * j); const f4v g = *(const f4v*)(gain + dd + 4 * j) * SU; w[j] = cvt4_fp8(xx[0] * g[0], xx[1] * g[1], xx[2] * g[2], xx[3] * g[3]); }
                o.x = w[0]; o.y = w[1]; o.z = w[2]; o.w = w[3];
                *(u4v*)(dst + i * 16) = o; }
        }
        for (int l = part; l <= part; ++l) {
            bfr* dst = (bfr*)(ws + WS_WTKEY) + (size_t)l * PQ * PQ;
            for (size_t i = gt; i < (size_t)PQ * PQ / 8; i += GT) {
                const int row = (int)((i * 8) / PQ), col = (int)((i * 8) % PQ); u4v o = {0u, 0u, 0u, 0u};
                if ((row >> 7) == (col >> 7)) { const int blk = row >> 7, h = blk >> 1, half = blk & 1, n = row & 127, d = col & 127;
                    const float* src = (half ? P.in_(23) : P.in_(22)) + (((size_t)l * PH + h) * PK + n) * 128 + d;
                    const f4v a = *(const f4v*)src, b = *(const f4v*)(src + 4);
                    o.x = cvtpk(a[0], a[1]); o.y = cvtpk(a[2], a[3]); o.z = cvtpk(b[0], b[1]); o.w = cvtpk(b[2], b[3]); }
                *(u4v*)(dst + i * 8) = o; }
        }
    }
}

template <bool SB = false>
__device__ __forceinline__ void p_norm_rows(const Ctx& C, const void* __restrict__ srcv, bfr* __restrict__ dst, unsigned char* __restrict__ dst8, float* __restrict__ rout = nullptr) {
    const int gw = C.vcu * 8 + C.wave, NGW = C.G * 8;
    for (int row = gw; row < NT; row += NGW) {
        f4v a[8], b[8]; float ss = 0.f;
        if (SB) { const u4v* p = (const u4v*)((const bfr*)srcv + (size_t)row * DM); u4v raw[8];
#pragma unroll
            for (int j = 0; j < 8; ++j) raw[j] = p[j * 64 + C.lane];
#pragma unroll
            for (int j = 0; j < 8; ++j) { a[j] = (f4v){bflo(raw[j].x), bfhi(raw[j].x), bflo(raw[j].y), bfhi(raw[j].y)}; b[j] = (f4v){bflo(raw[j].z), bfhi(raw[j].z), bflo(raw[j].w), bfhi(raw[j].w)}; } }
        else { const f4v* p = (const f4v*)((const float*)srcv + (size_t)row * DM);
#pragma unroll
            for (int j = 0; j < 8; ++j) { a[j] = p[j * 128 + 2 * C.lane]; b[j] = p[j * 128 + 2 * C.lane + 1]; } }
#pragma unroll
        for (int j = 0; j < 8; ++j) ss += (a[j][0] * a[j][0] + a[j][1] * a[j][1]) + (a[j][2] * a[j][2] + a[j][3] * a[j][3]) + (b[j][0] * b[j][0] + b[j][1] * b[j][1]) + (b[j][2] * b[j][2] + b[j][3] * b[j][3]);
        const float r = __builtin_amdgcn_rsqf(wave_sum(ss) * (1.f / DM) + EPS);
        if (rout && C.lane == 0) rout[row] = r;
        u4v* o = (u4v*)(dst + (size_t)row * DM);
#pragma unroll
        for (int j = 0; j < 8; ++j) { u4v w; w.x = cvtpk(a[j][0] * r, a[j][1] * r); w.y = cvtpk(a[j][2] * r, a[j][3] * r); w.z = cvtpk(b[j][0] * r, b[j][1] * r); w.w = cvtpk(b[j][2] * r, b[j][3] * r);
            if (dst) o[j * 64 + C.lane] = w;
            if (dst8) { u2v w8; w8.x = cvt4_fp8(a[j][0] * r, a[j][1] * r, a[j][2] * r, a[j][3] * r); w8.y = cvt4_fp8(b[j][0] * r, b[j][1] * r, b[j][2] * r, b[j][3] * r); ((u2v*)(dst8 + (size_t)row * DM))[j * 64 + C.lane] = w8; } }
    }
}

__device__ __forceinline__ void p_bd(const Ctx& C, const bfr* __restrict__ XN, const bfr* __restrict__ WB, float* __restrict__ BD) {
    LAS float* red = (LAS float*)C.lds;
    const int r = C.lane & 15, q = C.lane >> 4, rt = C.wave >> 2, kq = C.wave & 3;
    for (int blk = C.vcu; blk < NT / 32; blk += C.G) {
        const bfr* ap = XN + (size_t)(blk * 32 + rt * 16 + r) * DM + kq * 1024 + q * 8;
        const bfr* bp = WB + (size_t)r * DM + kq * 1024 + q * 8;
        f4v acc[4] = {zero_acc(), zero_acc(), zero_acc(), zero_acc()};
#pragma unroll 4
        for (int ks = 0; ks < 32; ++ks) {
            const s8v a = *(const s8v*)(ap + ks * 32);
#pragma unroll
            for (int nt = 0; nt < 4; ++nt) { const s8v b = *(const s8v*)(bp + (size_t)nt * 16 * DM + ks * 32); acc[nt] = __builtin_amdgcn_mfma_f32_16x16x32_bf16(a, b, acc[nt], 0, 0, 0); }
            MFMA_SETTLE(acc[0]); MFMA_SETTLE(acc[1]); MFMA_SETTLE(acc[2]); MFMA_SETTLE(acc[3]);
        }
        MFMA_SETTLE(acc[0]); MFMA_SETTLE(acc[1]); MFMA_SETTLE(acc[2]); MFMA_SETTLE(acc[3]);
#pragma unroll
        for (int nt = 0; nt < 4; ++nt)
#pragma unroll
            for (int i = 0; i < 4; ++i) red[C.wave * 1024 + (4 * q + i) * 64 + nt * 16 + r] = -acc[nt][i];
        __syncthreads();
#pragma unroll
        for (int i = 0; i < 4; ++i) { const int idx = C.tid * 4 + i, t2 = idx >> 10, rem = idx & 1023;
            const float s = -((red[(t2 * 4 + 0) * 1024 + rem] + red[(t2 * 4 + 1) * 1024 + rem]) + (red[(t2 * 4 + 2) * 1024 + rem] + red[(t2 * 4 + 3) * 1024 + rem]));
            BD[(size_t)(blk * 32 + t2 * 16 + (rem >> 6)) * 64 + (rem & 63)] = s; }
        __syncthreads();
    }
}
__device__ __forceinline__ int kq_off(int row, int chunk) { return row * 256 + ((chunk ^ (row & 7)) << 4); }
__device__ __forceinline__ int xt_off(int col, int chunk) { return col * 128 + ((chunk ^ (col & 7)) << 4); }
__device__ __forceinline__ void p_gdn_prep(const Ctx& C, const Ptrs& P, int vp, int np) {
    unsigned char* ws = P.ws_();
    const bfr* PROJ = (const bfr*)(ws + WS_BIG); const float* BD = (const float*)(ws + WS_BD);
    const float* convw = P.in_(3); const float* alog = P.in_(4); const float* dtb = P.in_(5);
    bfr* Wg = (bfr*)(ws + WS_R + R_W); bfr* Ug = (bfr*)(ws + WS_R + R_U); bfr* QGg = (bfr*)(ws + WS_R + R_QG); bfr* KDg = (bfr*)(ws + WS_R + R_KD); bfr* QKg = (bfr*)(ws + WS_R + R_QK);
    float* EGg = (float*)(ws + WS_EG);
    LAS float* sCW = (LAS float*)(C.lds + 82944);
    for (int tk = vp; tk < NB * GH * 32; tk += np) {
        const int wq = tk >> 3, it = tk & 7;
        const int bh = wq >> 2, cg = wq & 3, h = bh & 31, b = bh >> 5;
        for (int i = C.tid; i < 1536; i += 512) { const int part = i >> 9, tap = (i >> 7) & 3, ch = i & 127; sCW[i] = convw[tap * 12288 + part * 4096 + h * 128 + ch]; }
        __syncthreads();
        {
            int tid = C.tid; asm volatile("" : "+v"(tid));
            const int hw = tid >> 8, lt = tid & 255, lane = tid & 63, lw = (tid >> 6) & 3;
            const int c = cg * 16 + it * 2 + hw, unit = bh * 64 + c, t0 = b * SEQ + c * CH;
            LAS unsigned char* hb = C.lds + hw * 41472;
            LAS unsigned char* sK = hb; LAS unsigned char* sQ = hb + 16384; LAS unsigned char* sX = hb;
            LAS unsigned char* sAM = hb + 32768; LAS float* sB = (LAS float*)(hb + 40960); LAS float* sG = (LAS float*)(hb + 41216);
            LAS float* scr = (LAS float*)(C.lds + 89088 + (tid >> 6) * 4352);
            LAS float* sAD = (LAS float*)(C.lds + 123904 + hw * 4096);
            if (lt < 64) {
                const int t = t0 + lt; const float braw = BD[(size_t)t * 64 + h], araw = BD[(size_t)t * 64 + 32 + h];
                const float beta = 1.f / (1.f + expf(-braw)); const float xx = araw + dtb[h]; const float sp = fmaxf(xx, 0.f) + log1pf(expf(-fabsf(xx)));
                float g = -expf(alog[h]) * sp;
#pragma unroll
                for (int o = 1; o < 64; o <<= 1) { const float y = __shfl_up(g, o); if (lane >= o) g += y; }
                sB[lt] = beta; sG[lt] = g;
            }
            __syncthreads();
            const int tk = lt >> 2, cs = lt & 3;
            const float beta = sB[tk], gc = sG[tk], gl = sG[63]; const float eg = expf(gc), ed = expf(gl - gc), bg = beta * eg;
            u4v kbg[4], vbt[4];
#pragma unroll
            for (int part = 0; part < 3; ++part) {
                float y[32];
#pragma unroll
                for (int i = 0; i < 32; ++i) y[i] = 0.f;
#pragma unroll
                for (int j = 0; j < 4; ++j) {
                    const int s = c * CH + tk - 3 + j;
                    if (s >= 0) {
                        const bfr* row = PROJ + (size_t)(b * SEQ + s) * 16384 + part * 4096 + h * 128 + cs * 32;
#pragma unroll
                        for (int q4 = 0; q4 < 4; ++q4) { const u4v x = *(const u4v*)(row + 8 * q4); const LAS float* wp = sCW + part * 512 + j * 128 + cs * 32 + 8 * q4;
                            const f4v w0 = *(const LAS f4v*)wp, w1 = *(const LAS f4v*)(wp + 4);
                            y[8 * q4 + 0] += bflo(x.x) * w0[0]; y[8 * q4 + 1] += bfhi(x.x) * w0[1]; y[8 * q4 + 2] += bflo(x.y) * w0[2]; y[8 * q4 + 3] += bfhi(x.y) * w0[3];
                            y[8 * q4 + 4] += bflo(x.z) * w1[0]; y[8 * q4 + 5] += bfhi(x.z) * w1[1]; y[8 * q4 + 6] += bflo(x.w) * w1[2]; y[8 * q4 + 7] += bfhi(x.w) * w1[3]; }
                    }
                }
                float ss = 0.f;
#pragma unroll
                for (int i = 0; i < 32; ++i) { y[i] = y[i] * __builtin_amdgcn_rcpf(1.f + __expf(-y[i])); ss += y[i] * y[i]; }
                if (part < 2) {
                    ss += __shfl_xor(ss, 1); ss += __shfl_xor(ss, 2);
                    const float rn = __builtin_amdgcn_rsqf(ss + EPS) * (part == 0 ? 0.08838834764831845f : 1.f); const float gs = part == 0 ? eg : ed;
                    LAS unsigned char* dstl = part == 0 ? sQ : sK; bfr* dstg = (part == 0 ? QGg : KDg) + (size_t)unit * 8192 + tk * 128 + cs * 32;
#pragma unroll
                    for (int q4 = 0; q4 < 4; ++q4) { float z[8];
#pragma unroll
                        for (int i = 0; i < 8; ++i) z[i] = y[8 * q4 + i] * rn;
                        u4v w; w.x = cvtpk(z[0], z[1]); w.y = cvtpk(z[2], z[3]); w.z = cvtpk(z[4], z[5]); w.w = cvtpk(z[6], z[7]);
                        *(LAS u4v*)(dstl + kq_off(tk, cs * 4 + q4)) = w;
                        u4v g; g.x = cvtpk(z[0] * gs, z[1] * gs); g.y = cvtpk(z[2] * gs, z[3] * gs); g.z = cvtpk(z[4] * gs, z[5] * gs); g.w = cvtpk(z[6] * gs, z[7] * gs);
                        *(u4v*)(dstg + 8 * q4) = g;
                        if (part == 1) { kbg[q4].x = cvtpk(z[0] * bg, z[1] * bg); kbg[q4].y = cvtpk(z[2] * bg, z[3] * bg); kbg[q4].z = cvtpk(z[4] * bg, z[5] * bg); kbg[q4].w = cvtpk(z[6] * bg, z[7] * bg); } }
                } else {
#pragma unroll
                    for (int q4 = 0; q4 < 4; ++q4) { vbt[q4].x = cvtpk(y[8 * q4] * beta, y[8 * q4 + 1] * beta); vbt[q4].y = cvtpk(y[8 * q4 + 2] * beta, y[8 * q4 + 3] * beta);
                        vbt[q4].z = cvtpk(y[8 * q4 + 4] * beta, y[8 * q4 + 5] * beta); vbt[q4].w = cvtpk(y[8 * q4 + 6] * beta, y[8 * q4 + 7] * beta); }
                }
            }
            __syncthreads();
            {
                const int r = lane & 15, q = lane >> 4, mt = lw;
                s8v ak[4], aq[4];
#pragma unroll
                for (int ks = 0; ks < 4; ++ks) { ak[ks] = *(const LAS s8v*)(sK + kq_off(16 * mt + r, 4 * ks + q)); aq[ks] = *(const LAS s8v*)(sQ + kq_off(16 * mt + r, 4 * ks + q)); }
                float gi[4], bi[4];
#pragma unroll
                for (int e = 0; e < 4; ++e) { gi[e] = sG[16 * mt + 4 * q + e]; bi[e] = sB[16 * mt + 4 * q + e]; }
                for (int nt = 0; nt < 4; ++nt) {
                    const int j = 16 * nt + r;
                    if (nt <= mt) {
                        f4v ck = zero_acc(), cq = zero_acc();
#pragma unroll
                        for (int ks = 0; ks < 4; ++ks) { const s8v bb = *(const LAS s8v*)(sK + kq_off(16 * nt + r, 4 * ks + q));
                            ck = __builtin_amdgcn_mfma_f32_16x16x32_bf16(ak[ks], bb, ck, 0, 0, 0); cq = __builtin_amdgcn_mfma_f32_16x16x32_bf16(aq[ks], bb, cq, 0, 0, 0); }
                        MFMA_SETTLE(ck); MFMA_SETTLE(cq);
                        const float gj = sG[j];
#pragma unroll
                        for (int e = 0; e < 4; ++e) { const int i = 16 * mt + 4 * q + e; const float dec = expf(fminf(gi[e] - gj, 0.f));
                            const float av = (i > j) ? bi[e] * ck[e] * dec : 0.f;
                            *(LAS bfr*)(sAM + xt_off(i, j >> 3) + (j & 7) * 2) = f2bf1(av);
                            if (nt == mt) sAD[mt * 256 + (4 * q + e) * 16 + r] = av;
                            QKg[(size_t)unit * 4096 + i * 64 + j] = f2bf1((i >= j) ? cq[e] * dec : 0.f); }
                    } else {
#pragma unroll
                        for (int e = 0; e < 4; ++e) QKg[(size_t)unit * 4096 + (16 * mt + 4 * q + e) * 64 + j] = (bfr)0;
                    }
                }
            }
            __syncthreads();
            {
                const int ro = ((tk >> 3)), rb = (tk & 7) * 2;
#pragma unroll
                for (int q4 = 0; q4 < 4; ++q4) {
                    const unsigned vv[4] = {vbt[q4].x, vbt[q4].y, vbt[q4].z, vbt[q4].w}, kk[4] = {kbg[q4].x, kbg[q4].y, kbg[q4].z, kbg[q4].w};
#pragma unroll
                    for (int i = 0; i < 8; ++i) { const int ch = cs * 32 + q4 * 8 + i;
                        *(LAS bfr*)(sX + xt_off(ch, ro) + rb) = (bfr)((i & 1) ? (vv[i >> 1] >> 16) : (vv[i >> 1] & 0xffffu));
                        *(LAS bfr*)(sX + xt_off(128 + ch, ro) + rb) = (bfr)((i & 1) ? (kk[i >> 1] >> 16) : (kk[i >> 1] & 0xffffu)); }
                }
            }
            __syncthreads();
            {
                const int r = lane & 15, q = lane >> 4;
                float x[64];
#pragma unroll
                for (int bk = 0; bk < 4; ++bk) {
                    float corr[16];
#pragma unroll
                    for (int i = 0; i < 16; ++i) corr[i] = 0.f;
                    if (bk > 0) {
                        f4v acc[4] = {zero_acc(), zero_acc(), zero_acc(), zero_acc()};
#pragma unroll
                        for (int ks = 0; ks < (16 * bk + 31) / 32; ++ks) {
                            s8v a = *(const LAS s8v*)(sAM + xt_off(16 * bk + r, 4 * ks + q));
                            if (32 * ks + 8 * q >= 16 * bk) a = (s8v){0, 0, 0, 0, 0, 0, 0, 0};
#pragma unroll
                            for (int nt = 0; nt < 4; ++nt) { const s8v bx = *(const LAS s8v*)(sX + xt_off(64 * lw + 16 * nt + r, 4 * ks + q)); acc[nt] = __builtin_amdgcn_mfma_f32_16x16x32_bf16(a, bx, acc[nt], 0, 0, 0); }
                        }
                        MFMA_SETTLE(acc[0]); MFMA_SETTLE(acc[1]); MFMA_SETTLE(acc[2]); MFMA_SETTLE(acc[3]);
#pragma unroll
                        for (int nt = 0; nt < 4; ++nt)
#pragma unroll
                            for (int e = 0; e < 4; ++e) scr[(16 * nt + r) * 17 + 4 * q + e] = -acc[nt][e];
                        LDS_WAIT(); asm volatile("" ::: "memory");
#pragma unroll
                        for (int i = 0; i < 16; ++i) corr[i] = scr[lane * 17 + i];
                    }
                    const u4v r0 = *(const LAS u4v*)(sX + xt_off(lt, 2 * bk)), r1 = *(const LAS u4v*)(sX + xt_off(lt, 2 * bk + 1));
                    const float rhs[16] = {bflo(r0.x), bfhi(r0.x), bflo(r0.y), bfhi(r0.y), bflo(r0.z), bfhi(r0.z), bflo(r0.w), bfhi(r0.w), bflo(r1.x), bfhi(r1.x), bflo(r1.y), bfhi(r1.y), bflo(r1.z), bfhi(r1.z), bflo(r1.w), bfhi(r1.w)};
                    float xb[16];
#pragma unroll
                    for (int i = 0; i < 16; ++i) {
                        float v = rhs[i] + corr[i];
                        const u4v a0 = *(const LAS u4v*)(sAM + xt_off(16 * bk + i, 2 * bk)), a1 = *(const LAS u4v*)(sAM + xt_off(16 * bk + i, 2 * bk + 1));
                        const float am[16] = {bflo(a0.x), bfhi(a0.x), bflo(a0.y), bfhi(a0.y), bflo(a0.z), bfhi(a0.z), bflo(a0.w), bfhi(a0.w), bflo(a1.x), bfhi(a1.x), bflo(a1.y), bfhi(a1.y), bflo(a1.z), bfhi(a1.z), bflo(a1.w), bfhi(a1.w)};
#pragma unroll
                        for (int j = 0; j < 16; ++j) if (j < i) v -= am[j] * xb[j];
                        xb[i] = v; x[16 * bk + i] = v;
                    }
                    u4v w0, w1; w0.x = cvtpk(xb[0], xb[1]); w0.y = cvtpk(xb[2], xb[3]); w0.z = cvtpk(xb[4], xb[5]); w0.w = cvtpk(xb[6], xb[7]);
                    w1.x = cvtpk(xb[8], xb[9]); w1.y = cvtpk(xb[10], xb[11]); w1.z = cvtpk(xb[12], xb[13]); w1.w = cvtpk(xb[14], xb[15]);
                    *(LAS u4v*)(sX + xt_off(lt, 2 * bk)) = w0; *(LAS u4v*)(sX + xt_off(lt, 2 * bk + 1)) = w1;
                    LDS_WAIT(); asm volatile("" ::: "memory");
                }
                bfr* dst = (lt < 128 ? Ug : Wg) + (size_t)unit * 8192 + (lt & 127);
#pragma unroll
                for (int i = 0; i < 64; ++i) dst[i * 128] = f2bf1(x[i]);
                if (lt == 0) EGg[unit] = expf(sG[63]);
            }
            __syncthreads();
        }
    }
}

__device__ __forceinline__ void p_gdn_scan(const Ctx& C, const Ptrs& P) {
    unsigned char* ws = P.ws_();
    const GAS bfr* Wg = (const GAS bfr*)(ws + WS_R + R_W); const GAS bfr* Ug = (const GAS bfr*)(ws + WS_R + R_U); const GAS bfr* QGg = (const GAS bfr*)(ws + WS_R + R_QG); const GAS bfr* KDg = (const GAS bfr*)(ws + WS_R + R_KD);
    const GAS bfr* QKg = (const GAS bfr*)(ws + WS_R + R_QK); GAS bfr* Og = (GAS bfr*)(ws + WS_R + R_O); const GAS float* EGg = (const GAS float*)(ws + WS_EG);
    const int tid = C.tid, lane = C.lane, wave = C.wave, r = lane & 15, q = lane >> 4, mt = wave & 3, nt = wave >> 2;
    LAS bfr* sST = (LAS bfr*)(C.lds + 131072); LAS bfr* sVN = (LAS bfr*)(C.lds + 139776);
#define SC_W(bb)  ((LAS bfr*)(C.lds + (bb) * 65536))
#define SC_QG(bb) ((LAS bfr*)(C.lds + (bb) * 65536 + 17408))
#define SC_KD(bb) ((LAS bfr*)(C.lds + (bb) * 65536 + 34816))
#define SC_QK(bb) ((LAS bfr*)(C.lds + (bb) * 65536 + 52224))
#define SC_U(bb)  ((LAS bfr*)(C.lds + (bb) * 65536 + 61440))
#define SC_LOAD(n) do { const size_t ub = (size_t)(bh * 64 + (n)) * 8192; \
        rW0 = *(const GAS u4v*)(Wg + ub + (size_t)tid * 8); rW1 = *(const GAS u4v*)(Wg + ub + (size_t)(tid + 512) * 8); \
        rQ0 = *(const GAS u4v*)(QGg + ub + (size_t)tid * 8); rQ1 = *(const GAS u4v*)(QGg + ub + (size_t)(tid + 512) * 8); \
        rK0 = *(const GAS u4v*)(KDg + ub + (size_t)tid * 8); rK1 = *(const GAS u4v*)(KDg + ub + (size_t)(tid + 512) * 8); \
        rQK = *(const GAS u4v*)(QKg + (size_t)(bh * 64 + (n)) * 4096 + (size_t)tid * 8); \
        if (tid < 256) rU = *(const GAS u4v*)(Ug + ub + (size_t)(tid >> 2) * 128 + es * 32 + (tid & 3) * 8); } while (0)
#define SC_WRITE(bb) do { const int c0 = tid, c1 = tid + 512; \
        *(LAS u4v*)(SC_W(bb) + (c0 >> 4) * 136 + (c0 & 15) * 8) = rW0; *(LAS u4v*)(SC_W(bb) + (c1 >> 4) * 136 + (c1 & 15) * 8) = rW1; \
        *(LAS u4v*)(SC_QG(bb) + (c0 >> 4) * 136 + (c0 & 15) * 8) = rQ0; *(LAS u4v*)(SC_QG(bb) + (c1 >> 4) * 136 + (c1 & 15) * 8) = rQ1; \
        *(LAS u4v*)(SC_KD(bb) + (c0 >> 4) * 136 + (c0 & 15) * 8) = rK0; *(LAS u4v*)(SC_KD(bb) + (c1 >> 4) * 136 + (c1 & 15) * 8) = rK1; \
        *(LAS u4v*)(SC_QK(bb) + (tid >> 3) * 72 + (tid & 7) * 8) = rQK; \
        if (tid < 256) *(LAS u4v*)(SC_U(bb) + (tid >> 2) * 32 + (tid & 3) * 8) = rU; } while (0)
    for (int task = C.vcu; task < NB * GH * 4; task += C.G) {
        const int bh = task >> 2, es = task & 3, h = bh & 31, b = bh >> 5;
        u4v rW0, rW1, rQ0, rQ1, rK0, rK1, rQK, rU = {0u, 0u, 0u, 0u};
        f4v S0 = {0.f, 0.f, 0.f, 0.f}, S1 = {0.f, 0.f, 0.f, 0.f};
        LAS float* sEG = (LAS float*)(C.lds + 144384);
        if (tid < 64) sEG[tid] = EGg[bh * 64 + tid];
        SC_LOAD(0); SC_WRITE(0); SC_LOAD(1);
        for (int n = 0; n < NCH; ++n) {
            const int bb = n & 1;
            {
                MFMA_SETTLE(S0); MFMA_SETTLE(S1);
                u2v w0, w1; w0.x = cvtpk(S0[0], S0[1]); w0.y = cvtpk(S0[2], S0[3]); w1.x = cvtpk(S1[0], S1[1]); w1.y = cvtpk(S1[2], S1[3]);
                *(LAS u2v*)(sST + (r) * 136 + 16 * wave + 4 * q) = w0; *(LAS u2v*)(sST + (16 + r) * 136 + 16 * wave + 4 * q) = w1;
            }
            __syncthreads();
            if (n + 1 < NCH) { if (bb) SC_WRITE(0); else SC_WRITE(1); if (n + 2 < NCH) SC_LOAD(n + 2); }
            f4v acc1 = zero_acc(), acc2 = zero_acc();
            const LAS bfr* pW = SC_W(bb) + (16 * mt + r) * 136 + 8 * q; const LAS bfr* pQ = SC_QG(bb) + (16 * mt + r) * 136 + 8 * q; const LAS bfr* pS = sST + (16 * nt + r) * 136 + 8 * q;
#pragma unroll
            for (int ks = 0; ks < 4; ++ks) { const s8v a1 = *(const LAS s8v*)(pW + 32 * ks), a2 = *(const LAS s8v*)(pQ + 32 * ks), bs = *(const LAS s8v*)(pS + 32 * ks);
                acc1 = __builtin_amdgcn_mfma_f32_16x16x32_bf16(a1, bs, acc1, 0, 0, 0); acc2 = __builtin_amdgcn_mfma_f32_16x16x32_bf16(a2, bs, acc2, 0, 0, 0); }
            MFMA_SETTLE(acc1);
            {
                const LAS bfr* pU = SC_U(bb) + (16 * mt + 4 * q) * 32 + 16 * nt + r;
                const float v0 = bf1(pU[0]) - acc1[0], v1 = bf1(pU[32]) - acc1[1], v2 = bf1(pU[64]) - acc1[2], v3 = bf1(pU[96]) - acc1[3];
                u2v w; w.x = cvtpk(v0, v1); w.y = cvtpk(v2, v3);
                *(LAS u2v*)(sVN + (16 * nt + r) * 72 + 16 * mt + 4 * q) = w;
            }
            __syncthreads();
            {
                const LAS bfr* pA = SC_QK(bb) + (16 * mt + r) * 72 + 8 * q; const LAS bfr* pV = sVN + (16 * nt + r) * 72 + 8 * q;
#pragma unroll
                for (int ks = 0; ks < 2; ++ks) { const s8v a = *(const LAS s8v*)(pA + 32 * ks), bv = *(const LAS s8v*)(pV + 32 * ks); acc2 = __builtin_amdgcn_mfma_f32_16x16x32_bf16(a, bv, acc2, 0, 0, 0); }
                MFMA_SETTLE(acc2);
                GAS bfr* po = Og + (size_t)(b * SEQ + n * CH + 16 * mt + 4 * q) * DM + h * 128 + es * 32 + 16 * nt + r;
                po[0] = f2bf1(acc2[0]); po[DM] = f2bf1(acc2[1]); po[2 * DM] = f2bf1(acc2[2]); po[3 * DM] = f2bf1(acc2[3]);
            }
            {
                const float eg = sEG[n];
                S0 *= eg; S1 *= eg;
                const LAS bfr* pK = SC_KD(bb) + (8 * q) * 136 + 16 * wave + r; const LAS bfr* pV0 = sVN + r * 72 + 8 * q; const LAS bfr* pV1 = sVN + (16 + r) * 72 + 8 * q;
#pragma unroll
                for (int ks = 0; ks < 2; ++ks) {
                    s8v a;
#pragma unroll
                    for (int i = 0; i < 8; ++i) a[i] = (short)pK[(32 * ks + i) * 136];
                    const s8v b0 = *(const LAS s8v*)(pV0 + 32 * ks), b1 = *(const LAS s8v*)(pV1 + 32 * ks);
                    S0 = __builtin_amdgcn_mfma_f32_16x16x32_bf16(a, b0, S0, 0, 0, 0); S1 = __builtin_amdgcn_mfma_f32_16x16x32_bf16(a, b1, S1, 0, 0, 0);
                }
            }
        }
        __syncthreads();
    }
#undef SC_W
#undef SC_QG
#undef SC_KD
#undef SC_QK
#undef SC_U
#undef SC_LOAD
#undef SC_WRITE
}

#define S2_OFF_QG 17408
#define S2_OFF_QK 34816
#define S2_OFF_KT 44032
#define S2_OFF_U  62464
#define S2_BUF    66560
__device__ __forceinline__ s8v s2_frag(const LAS bfr* rowp, int q) {
    const u2v lo = *(const LAS u2v*)(rowp + 4 * q), hi = *(const LAS u2v*)(rowp + 16 + 4 * q);
    const u4v w = {lo.x, lo.y, hi.x, hi.y}; return __builtin_bit_cast(s8v, w);
}
__device__ __forceinline__ s8v s2_fragx(const LAS bfr* rowp, int g0, int g1) {
    const u2v lo = *(const LAS u2v*)(rowp + 4 * g0), hi = *(const LAS u2v*)(rowp + 4 * g1);
    const u4v w = {lo.x, lo.y, hi.x, hi.y}; return __builtin_bit_cast(s8v, w);
}
__device__ __forceinline__ s8v s2_pack(const f4v& a, const f4v& b) { const u4v w = {cvtpk(a[0], a[1]), cvtpk(a[2], a[3]), cvtpk(b[0], b[1]), cvtpk(b[2], b[3])}; return __builtin_bit_cast(s8v, w); }
template <int MODE = 0>
__device__ __forceinline__ void p_gdn_scan2(const Ctx& C, const Ptrs& P) {
    unsigned char* ws = P.ws_();
    const GAS bfr* Wg = (const GAS bfr*)(ws + WS_R + R_W); const GAS bfr* Ug = (const GAS bfr*)(ws + WS_R + R_U); const GAS bfr* QGg = (const GAS bfr*)(ws + WS_R + R_QG); const GAS bfr* KDg = (const GAS bfr*)(ws + WS_R + R_KD);
    const GAS bfr* QKg = (const GAS bfr*)(ws + WS_R + R_QK); GAS bfr* Og = (GAS bfr*)(ws + (MODE ? WS_SC : WS_R + R_O)); const GAS float* EGg = (const GAS float*)(ws + WS_EG);
    const int tid = C.tid, lane = C.lane, wave = C.wave, r = lane & 15, q = lane >> 4;
    LAS float* sEG = (LAS float*)(C.lds + 2 * S2_BUF);
    for (int task = C.vcu; task < NB * GH * 4; task += C.G) {
        const int bh = task >> 2, es = task & 3, h = bh & 31, b = bh >> 5;
        if (tid < 64) sEG[tid] = EGg[bh * 64 + tid];
        if (wave >= 2) {
            const int lw = __builtin_amdgcn_readfirstlane((tid - 128) & ~63);
            __builtin_assume(lw >= 0 && lw <= 320);
            const GAS unsigned char* RB = (const GAS unsigned char*)(ws + WS_R);
            const unsigned l16 = lane * 16, lU = (lane >> 2) * 256 + (lane & 3) * 16 + es * 64;
            const unsigned lrow = (lane >> 4) * 272 + (lane & 15) * 16, lqk = (lane >> 3) * 144 + (lane & 7) * 16, lkt = (lane & 15) * 8 * 144 + (lane >> 4) * 2;
            const int lsw = (lane & 15) >> 1;
            u4v ra[10], rb[10];
#define S2_LOAD(R, n) do { const unsigned ua_ = (unsigned)(bh * 64 + ((MODE == 2 || MODE == 4) ? 0 : (n))) * 16384u; _Pragma("unroll") for (int k_ = 0; k_ < 10; ++k_) { const int c0_ = lw + 384 * k_; \
        if (c0_ < 1024) R[k_] = *(const GAS u4v*)(RB + (size_t)((unsigned)R_W + ua_ + c0_ * 16) + l16); \
        else if (c0_ < 2048) R[k_] = *(const GAS u4v*)(RB + (size_t)((unsigned)R_QG + ua_ + (c0_ - 1024) * 16) + l16); \
        else if (c0_ < 2560) R[k_] = *(const GAS u4v*)(RB + (size_t)((unsigned)R_QK + (ua_ >> 1) + (c0_ - 2048) * 16) + l16); \
        else if (c0_ < 2816) R[k_] = *(const GAS u4v*)(RB + (size_t)((unsigned)R_U + ua_ + ((c0_ - 2560) >> 2) * 256) + lU); \
        else R[k_] = *(const GAS u4v*)(RB + (size_t)((unsigned)R_KD + ua_ + (c0_ - 2816) * 16) + l16); } } while (0)
#define S2_WRITE(R, bb) do { LAS unsigned char* B_ = C.lds + (bb) * S2_BUF; _Pragma("unroll") for (int k_ = 0; k_ < 10; ++k_) { const int c0_ = lw + 384 * k_; \
        if (c0_ < 1024) *(LAS u4v*)(B_ + (c0_ >> 4) * 272 + lrow) = R[k_]; \
        else if (c0_ < 2048) *(LAS u4v*)(B_ + S2_OFF_QG + ((c0_ - 1024) >> 4) * 272 + lrow) = R[k_]; \
        else if (c0_ < 2560) *(LAS u4v*)(B_ + S2_OFF_QK + ((c0_ - 2048) >> 3) * 144 + lqk) = R[k_]; \
        else if (c0_ < 2816) *(LAS u4v*)(B_ + S2_OFF_U + (c0_ - 2560) * 16 + l16) = R[k_]; \
        else { const int g_ = (c0_ - 2816) >> 6; LAS bfr* kt_ = (LAS bfr*)(B_ + S2_OFF_KT + lkt + ((g_ ^ lsw) << 3)); const unsigned w_[4] = {R[k_].x, R[k_].y, R[k_].z, R[k_].w}; \
            _Pragma("unroll") for (int i_ = 0; i_ < 8; ++i_) kt_[i_ * 72] = (bfr)((i_ & 1) ? (w_[i_ >> 1] >> 16) : (w_[i_ >> 1] & 0xffffu)); } } } while (0)
            u4v rc[10];
            S2_LOAD(ra, 0); S2_WRITE(ra, 0);
            S2_LOAD(rb, 1); S2_LOAD(rc, 2); S2_LOAD(ra, 3);
            __syncthreads();
#define S2_STEP(R, bb, n_) { S2_WRITE(R, bb); S2_LOAD(R, (n_) + 4); __syncthreads(); }
            for (int n = 0; n < NCH - 4; n += 6) {
                S2_STEP(rb, 1, n) S2_STEP(rc, 0, n + 1) S2_STEP(ra, 1, n + 2) S2_STEP(rb, 0, n + 3) S2_STEP(rc, 1, n + 4) S2_STEP(ra, 0, n + 5)
            }
            static_assert((NCH - 4) % 6 == 0, "scan loader schedule");
            S2_WRITE(rb, 1); __syncthreads(); S2_WRITE(rc, 0); __syncthreads(); S2_WRITE(ra, 1); __syncthreads(); __syncthreads();
#undef S2_STEP
#undef S2_LOAD
#undef S2_WRITE
        } else {
            const int nt = wave;
            f4v S[8];
#pragma unroll
            for (int w = 0; w < 8; ++w) S[w] = zero_acc();
            __syncthreads();
            for (int n = 0; n < NCH; ++n) {
                if (MODE == 3 || MODE == 4) { __syncthreads(); continue; }
                const LAS unsigned char* B = C.lds + (n & 1) * S2_BUF;
                const LAS bfr* sW = (const LAS bfr*)B; const LAS bfr* sQG = (const LAS bfr*)(B + S2_OFF_QG); const LAS bfr* sQK = (const LAS bfr*)(B + S2_OFF_QK);
                const LAS bfr* sKT = (const LAS bfr*)(B + S2_OFF_KT); const LAS bfr* sU = (const LAS bfr*)(B + S2_OFF_U);
#define S2_STAGE() asm volatile("" ::: "memory")
#define S2_LOADQ(F, mt) do { _Pragma("unroll") for (int ks = 0; ks < 4; ++ks) { F[ks] = s2_frag(sW + (16 * (mt) + r) * 136 + 32 * ks, q); F[4 + ks] = s2_frag(sQG + (16 * (mt) + r) * 136 + 32 * ks, q); } } while (0)
#define S2_MMQ(F, mt) do { _Pragma("unroll") for (int ks = 0; ks < 4; ++ks) { a1[mt] = __builtin_amdgcn_mfma_f32_16x16x32_bf16(F[ks], Bs[ks], a1[mt], 0, 0, 0); \
        a2[mt] = __builtin_amdgcn_mfma_f32_16x16x32_bf16(F[4 + ks], Bs[ks], a2[mt], 0, 0, 0); } } while (0)
                s8v fA[8], fB[8];
                S2_LOADQ(fA, 0); S2_LOADQ(fB, 1);
                s8v Bs[4];
#pragma unroll
                for (int ks = 0; ks < 4; ++ks) Bs[ks] = s2_pack(S[2 * ks], S[2 * ks + 1]);
                f4v a1[4], a2[4];
#pragma unroll
                for (int mt = 0; mt < 4; ++mt) { a1[mt] = zero_acc(); a2[mt] = zero_acc(); }
                S2_STAGE();
                S2_MMQ(fA, 0); S2_STAGE(); S2_LOADQ(fA, 2); S2_STAGE();
                S2_MMQ(fB, 1); S2_STAGE(); S2_LOADQ(fB, 3);
                bfr ur[16]; s8v fa[8];
#pragma unroll
                for (int mt = 0; mt < 4; ++mt) { const LAS bfr* pU = sU + (16 * mt + 4 * q) * 32 + 16 * nt + r; ur[4 * mt] = pU[0]; ur[4 * mt + 1] = pU[32]; ur[4 * mt + 2] = pU[64]; ur[4 * mt + 3] = pU[96]; }
                S2_STAGE();
                S2_MMQ(fA, 2); S2_STAGE();
#pragma unroll
                for (int mt = 0; mt < 4; ++mt)
#pragma unroll
                    for (int k2 = 0; k2 < 2; ++k2) fa[2 * mt + k2] = s2_frag(sQK + (16 * mt + r) * 72 + 32 * k2, q);
                S2_STAGE();
                S2_MMQ(fB, 3); S2_STAGE();
#undef S2_LOADQ
#undef S2_MMQ
                s8v fk[16];
#pragma unroll
                for (int w = 0; w < 8; ++w)
#pragma unroll
                    for (int k2 = 0; k2 < 2; ++k2) fk[2 * w + k2] = s2_fragx(sKT + (16 * w + r) * 72 + 32 * k2, q ^ w, (4 + q) ^ w);
                const float eg = sEG[n];
                S2_STAGE();
                f4v vn[4];
#pragma unroll
                for (int mt = 0; mt < 4; ++mt) vn[mt] = (f4v){bf1(ur[4 * mt]) - a1[mt][0], bf1(ur[4 * mt + 1]) - a1[mt][1], bf1(ur[4 * mt + 2]) - a1[mt][2], bf1(ur[4 * mt + 3]) - a1[mt][3]};
                s8v Bv[2];
#pragma unroll
                for (int k2 = 0; k2 < 2; ++k2) Bv[k2] = s2_pack(vn[2 * k2], vn[2 * k2 + 1]);
#pragma unroll
                for (int k2 = 0; k2 < 2; ++k2)
#pragma unroll
                    for (int mt = 0; mt < 4; ++mt) a2[mt] = __builtin_amdgcn_mfma_f32_16x16x32_bf16(fa[2 * mt + k2], Bv[k2], a2[mt], 0, 0, 0);
#pragma unroll
                for (int w = 0; w < 8; ++w) S[w] *= eg;
#pragma unroll
                for (int k2 = 0; k2 < 2; ++k2)
#pragma unroll
                    for (int w = 0; w < 8; ++w) S[w] = __builtin_amdgcn_mfma_f32_16x16x32_bf16(fk[2 * w + k2], Bv[k2], S[w], 0, 0, 0);
#pragma unroll
                for (int mt = 0; mt < 4; ++mt) {
                    GAS bfr* po = Og + (size_t)(b * SEQ + n * CH + 16 * mt + 4 * q) * DM + h * 128 + es * 32 + 16 * nt + r;
                    po[0] = f2bf1(a2[mt][0]); po[DM] = f2bf1(a2[mt][1]); po[2 * DM] = f2bf1(a2[mt][2]); po[3 * DM] = f2bf1(a2[mt][3]); }
#undef S2_STAGE
                MFMA_SETTLE(S[7]);
                __syncthreads();
            }
        }
        __syncthreads();
    }
}
#undef S2_OFF_QG
#undef S2_OFF_QK
#undef S2_OFF_KT
#undef S2_OFF_U
#undef S2_BUF

__device__ __forceinline__ void p_gdn_onorm(const Ctx& C, const Ptrs& P) {
    unsigned char* ws = P.ws_(); const bfr* Og = (const bfr*)(ws + WS_R + R_O); const bfr* PROJ = (const bfr*)(ws + WS_BIG); bfr* AO = (bfr*)(ws + WS_XN); const float* og = P.in_(6);
    const size_t gt = (size_t)C.vcu * 512 + C.tid, GT = (size_t)C.G * 512;
    for (size_t idx0 = gt; idx0 < (size_t)NT * DM / 8; idx0 += 4 * GT) {
        u4v o8[4], z8[4];
#pragma unroll
        for (int b4 = 0; b4 < 4; ++b4) { const size_t idx = idx0 + b4 * GT; const size_t t = idx >> 9; const int hh = (int)(idx >> 4) & 31, i = (int)idx & 15;
            o8[b4] = *(const u4v*)(Og + t * DM + hh * 128 + 8 * i); z8[b4] = *(const u4v*)(PROJ + t * 16384 + 12288 + hh * 128 + 8 * i); }
        const int i = (int)idx0 & 15;
        const f4v g0 = *(const f4v*)(og + 8 * i), g1 = *(const f4v*)(og + 8 * i + 4); const float g[8] = {g0[0], g0[1], g0[2], g0[3], g1[0], g1[1], g1[2], g1[3]};
#pragma unroll
        for (int b4 = 0; b4 < 4; ++b4) { const size_t idx = idx0 + b4 * GT; const size_t t = idx >> 9; const int hh = (int)(idx >> 4) & 31;
            float o[8] = {bflo(o8[b4].x), bfhi(o8[b4].x), bflo(o8[b4].y), bfhi(o8[b4].y), bflo(o8[b4].z), bfhi(o8[b4].z), bflo(o8[b4].w), bfhi(o8[b4].w)};
            float z[8] = {bflo(z8[b4].x), bfhi(z8[b4].x), bflo(z8[b4].y), bfhi(z8[b4].y), bflo(z8[b4].z), bfhi(z8[b4].z), bflo(z8[b4].w), bfhi(z8[b4].w)};
            float ss = 0.f;
#pragma unroll
            for (int k = 0; k < 8; ++k) ss += o[k] * o[k];
            ss += __shfl_xor(ss, 1); ss += __shfl_xor(ss, 2); ss += __shfl_xor(ss, 4); ss += __shfl_xor(ss, 8);
            const float rn = __builtin_amdgcn_rsqf(ss * (1.f / 128.f) + EPS);
            float y[8];
#pragma unroll
            for (int k = 0; k < 8; ++k) y[k] = o[k] * rn * g[k] * (z[k] * __builtin_amdgcn_rcpf(1.f + __expf(-z[k])));
#if F8_OUT0
#pragma unroll
            for (int k = 0; k < 8; ++k) y[k] = fminf(fmaxf(y[k] * SO, -440.f), 440.f);
            u2v w; w.x = cvt4_fp8(y[0], y[1], y[2], y[3]); w.y = cvt4_fp8(y[4], y[5], y[6], y[7]);
            *(u2v*)(ws + WS_XN8 + t * DM + hh * 128 + 8 * i) = w; }
#else
            u4v w; w.x = cvtpk(y[0], y[1]); w.y = cvtpk(y[2], y[3]); w.z = cvtpk(y[4], y[5]); w.w = cvtpk(y[6], y[7]);
            *(u4v*)(AO + t * DM + hh * 128 + 8 * i) = w; }
#endif
    }
}
__device__ __forceinline__ unsigned mono_key(float x) { const unsigned u = __float_as_uint(x); return u ^ ((unsigned)((int)u >> 31) | 0x80000000u); }
#define KEY_INS(K, key) do { unsigned x_ = (key); _Pragma("unroll") for (int s_ = 0; s_ < 16; ++s_) { const unsigned hi_ = max(K[s_], x_); x_ = min(K[s_], x_); K[s_] = hi_; } } while (0)
__device__ __forceinline__ void p_route(const Ctx& C, const Ptrs& P) {
    unsigned char* ws = P.ws_(); const float* SC = (const float*)(ws + WS_SC); bfr* G = (bfr*)(ws + WS_G);
    LAS unsigned char* wl = C.lds + C.wave * 16384;
    LAS int* sE = (LAS int*)(wl); LAS float* sGt = (LAS float*)(wl + 2048); LAS float* sV1 = (LAS float*)(wl + 4096); LAS float* sV2 = (LAS float*)(wl + 8192); LAS int* sI = (LAS int*)(wl + 12288);
    const int lane = C.lane, gw = C.vcu * 8 + C.wave, NGW = C.G * 8;
    for (int wt = gw; wt < NT / 4; wt += NGW) {
        const int tl = lane >> 4, t = wt * 4 + tl;
        unsigned k1[16];
#pragma unroll
        for (int i = 0; i < 16; ++i) k1[i] = 0u;
        const float* base = SC + (size_t)t * PQ + (lane & 15) * 128;
        for (int e = 0; e < 128; e += 4) { const f4v x4 = *(const f4v*)(base + e);
            KEY_INS(k1, (mono_key(x4[0]) & ~127u) | (unsigned)(127 - e)); KEY_INS(k1, (mono_key(x4[1]) & ~127u) | (unsigned)(126 - e));
            KEY_INS(k1, (mono_key(x4[2]) & ~127u) | (unsigned)(125 - e)); KEY_INS(k1, (mono_key(x4[3]) & ~127u) | (unsigned)(124 - e)); }
        const bool h0 = (lane & 1) == 0;
        float v1[16], v2[16];
#pragma unroll
        for (int i = 0; i < 16; ++i) { const int id = 127 - (int)(k1[i] & 127u); const float vv = base[id];
            const float ov = __shfl_xor(vv, 1); const int oi = __shfl_xor(id, 1);
            v1[i] = h0 ? vv : ov; v2[i] = h0 ? ov : vv; const int ia = h0 ? id : oi, ib = h0 ? oi : id;
            sV1[i * 64 + lane] = v1[i]; sV2[i * 64 + lane] = v2[i]; sI[i * 64 + lane] = ia | (ib << 8); }
        unsigned k2[16];
#pragma unroll
        for (int i = 0; i < 16; ++i) k2[i] = 0u;
#pragma unroll
        for (int a = 0; a < 16; ++a)
#pragma unroll
            for (int b = 0; b < 16; ++b)
                if ((a + 1) * (b + 1) <= 16) KEY_INS(k2, (mono_key(v1[a] + v2[b]) & ~255u) | (unsigned)(255 - (a * 16 + b)));
        LDS_WAIT(); asm volatile("" ::: "memory");
        float ts[16]; int te[16]; float mx = -__builtin_inff();
#pragma unroll
        for (int i = 0; i < 16; ++i) { const int code = 255 - (int)(k2[i] & 255u), a = code >> 4, b = code & 15;
            ts[i] = sV1[a * 64 + lane] + sV2[b * 64 + lane]; te[i] = (sI[a * 64 + lane] & 0xff) * 128 + (sI[b * 64 + lane] >> 8); mx = fmaxf(mx, ts[i]); }
        float sum = 0.f;
#pragma unroll
        for (int i = 0; i < 16; ++i) { ts[i] = __expf(ts[i] - mx); sum += ts[i]; }
        const float inv = 1.f / sum;
        if (h0) { const int hb = ((lane >> 1) & 7) * 16;
#pragma unroll
            for (int i = 0; i < 16; ++i) { sE[tl * 128 + hb + i] = te[i]; sGt[tl * 128 + hb + i] = ts[i] * inv; } }
        LDS_WAIT(); asm volatile("" ::: "memory");
        for (int k = 0; k < 4; ++k) {
            const size_t tt = (size_t)wt * 4 + k; u4v* row = (u4v*)(G + tt * PE); const u4v z = {0u, 0u, 0u, 0u};
#pragma unroll 8
            for (int j = 0; j < 32; ++j) row[j * 64 + lane] = z;
            const int e0 = sE[k * 128 + lane], e1 = sE[k * 128 + 64 + lane]; float t0 = 0.f, t1 = 0.f; bool f0 = true, f1 = true;
            for (int j = 0; j < 128; j += 4) { const i4v ej = *(const LAS i4v*)(sE + k * 128 + j); const f4v gj = *(const LAS f4v*)(sGt + k * 128 + j);
                if (ej.x == e0) { t0 += gj[0]; if (j + 0 < lane) f0 = false; } if (ej.y == e0) { t0 += gj[1]; if (j + 1 < lane) f0 = false; }
                if (ej.z == e0) { t0 += gj[2]; if (j + 2 < lane) f0 = false; } if (ej.w == e0) { t0 += gj[3]; if (j + 3 < lane) f0 = false; }
                if (ej.x == e1) { t1 += gj[0]; if (j + 0 < lane + 64) f1 = false; } if (ej.y == e1) { t1 += gj[1]; if (j + 1 < lane + 64) f1 = false; }
                if (ej.z == e1) { t1 += gj[2]; if (j + 2 < lane + 64) f1 = false; } if (ej.w == e1) { t1 += gj[3]; if (j + 3 < lane + 64) f1 = false; } }
            VM_WAIT();
            if (f0) G[tt * PE + e0] = f2bf1(t0);
            if (f1) G[tt * PE + e1] = f2bf1(t1);
        }
        LDS_WAIT(); asm volatile("" ::: "memory");
    }
}

typedef _Float16 h2v __attribute__((ext_vector_type(2)));
__device__ __forceinline__ unsigned char gate_code(float g) { const float c = 195.f + 20.f * __log2f(g); return (unsigned char)(int)fminf(fmaxf(c + 0.5f, 1.f), 255.f); }
__device__ __forceinline__ void p_sroute(const Ctx& C, const Ptrs& P, int layer) {
    unsigned char* ws = P.ws_(); const bfr* QRY = (const bfr*)(ws + WS_QRY); const bfr* KEY = (const bfr*)(ws + WS_WTKEY) + (size_t)layer * PQ * PQ; unsigned char* G = ws + WS_G;
    const int lane = C.lane, wave = C.wave, r = lane & 15, q = lane >> 4;
    LAS unsigned char* wl = C.lds + wave * 16640;
    LAS _Float16* sS = (LAS _Float16*)wl;
    LAS float* sV1 = (LAS float*)(wl); LAS float* sV2 = (LAS float*)(wl + 4096); LAS int* sI = (LAS int*)(wl + 8192);
    LAS int* sE = (LAS int*)(C.lds); LAS float* sGt = (LAS float*)(C.lds + 16384);
    LAS unsigned* bm = (LAS unsigned*)(C.lds + 32768 + wave * 3200); LAS unsigned* cnt = bm + 512; LAS int* le = (LAS int*)(bm + 516); LAS float* lg = (LAS float*)(bm + 516 + 128);
    for (int blk = C.vcu; blk < NT / 32; blk += C.G) {
        const int t0 = blk * 32;
#pragma unroll
        for (int hf = 0; hf < 2; ++hf) {
            const int hh = wave * 2 + hf;
            s8v a[2][4];
#pragma unroll
            for (int mt = 0; mt < 2; ++mt)
#pragma unroll
                for (int ks = 0; ks < 4; ++ks) a[mt][ks] = *(const s8v*)(QRY + (size_t)(t0 + 16 * mt + r) * PQ + hh * 128 + 32 * ks + 8 * q);
#pragma unroll
            for (int nt = 0; nt < 8; ++nt) {
                s8v b[4];
#pragma unroll
                for (int ks = 0; ks < 4; ++ks) b[ks] = *(const s8v*)(KEY + (size_t)(hh * 128 + 16 * nt + r) * PQ + hh * 128 + 32 * ks + 8 * q);
                f4v c0 = zero_acc(), c1 = zero_acc();
#pragma unroll
                for (int ks = 0; ks < 4; ++ks) { c0 = __builtin_amdgcn_mfma_f32_16x16x32_bf16(a[0][ks], b[ks], c0, 0, 0, 0); c1 = __builtin_amdgcn_mfma_f32_16x16x32_bf16(a[1][ks], b[ks], c1, 0, 0, 0); MFMA_SETTLE(c0); MFMA_SETTLE(c1); }
                MFMA_SETTLE(c0); MFMA_SETTLE(c1);
#pragma unroll
                for (int e = 0; e < 4; ++e) { sS[(32 * hf + 4 * q + e) * 130 + 16 * nt + r] = (_Float16)c0[e]; sS[(32 * hf + 16 + 4 * q + e) * 130 + 16 * nt + r] = (_Float16)c1[e]; }
            }
        }
        LDS_WAIT(); asm volatile("" ::: "memory");
        unsigned k1[16];
#pragma unroll
        for (int i = 0; i < 16; ++i) k1[i] = 0u;
        const LAS h2v* lp = (const LAS h2v*)(sS + lane * 130);
        for (int e = 0; e < 128; e += 8) {
#pragma unroll
            for (int u = 0; u < 4; ++u) { const h2v x2 = lp[(e >> 1) + u];
                KEY_INS(k1, (mono_key((float)x2[0]) & ~127u) | (unsigned)(127 - e - 2 * u)); KEY_INS(k1, (mono_key((float)x2[1]) & ~127u) | (unsigned)(126 - e - 2 * u)); }
        }
        const bool h0 = lane < 32;
        float v1[16], v2[16]; int ids[16]; float vals[16];
#pragma unroll
        for (int i = 0; i < 16; ++i) { ids[i] = 127 - (int)(k1[i] & 127u); vals[i] = (float)sS[lane * 130 + ids[i]]; }
        LDS_WAIT(); asm volatile("" ::: "memory");
#pragma unroll
        for (int i = 0; i < 16; ++i) { const float ov = __shfl_xor(vals[i], 32); const int oi = __shfl_xor(ids[i], 32);
            v1[i] = h0 ? vals[i] : ov; v2[i] = h0 ? ov : vals[i]; const int ia = h0 ? ids[i] : oi, ib = h0 ? oi : ids[i];
            sV1[i * 64 + lane] = v1[i]; sV2[i * 64 + lane] = v2[i]; sI[i * 64 + lane] = ia | (ib << 8); }
        unsigned k2[16];
#pragma unroll
        for (int b = 0; b < 16; ++b) k2[b] = (mono_key(v1[0] + v2[b]) & ~255u) | (unsigned)(255 - b);
#pragma unroll
        for (int a = 1; a < 16; ++a)
#pragma unroll
            for (int b = 0; b < 16; ++b)
                if ((a + 1) * (b + 1) <= 16) KEY_INS(k2, (mono_key(v1[a] + v2[b]) & ~255u) | (unsigned)(255 - (a * 16 + b)));
        LDS_WAIT(); asm volatile("" ::: "memory");
        float ts[16]; int te[16]; float mx = -__builtin_inff();
#pragma unroll
        for (int i = 0; i < 16; ++i) { const int code = 255 - (int)(k2[i] & 255u), a = code >> 4, b = code & 15;
            ts[i] = sV1[a * 64 + lane] + sV2[b * 64 + lane]; te[i] = (sI[a * 64 + lane] & 0xff) * 128 + (sI[b * 64 + lane] >> 8); mx = fmaxf(mx, ts[i]); }
        float sum = 0.f;
#pragma unroll
        for (int i = 0; i < 16; ++i) { ts[i] = __expf(ts[i] - mx); sum += ts[i]; }
        const float inv = 1.f / sum;
        __syncthreads();
        if (h0) {
#pragma unroll
            for (int i = 0; i < 16; ++i) { sE[lane * 128 + wave * 16 + i] = te[i]; sGt[lane * 128 + wave * 16 + i] = ts[i] * inv; } }
        __syncthreads();
        for (int k = 0; k < 4; ++k) {
            const int tl = wave * 4 + k; const size_t tt = (size_t)t0 + tl;
            if (layer == 0) { u4v* row = (u4v*)(G + tt * PE); const u4v z = {0u, 0u, 0u, 0u};
#pragma unroll 8
                for (int j = 0; j < 16; ++j) row[j * 64 + lane] = z; }
            const int e0 = sE[tl * 128 + lane], e1 = sE[tl * 128 + 64 + lane]; float t0s = sGt[tl * 128 + lane], t1s = sGt[tl * 128 + 64 + lane];
#pragma unroll
            for (int j = 0; j < 8; ++j) bm[j * 64 + lane] = 0u;
            if (lane == 0) *cnt = 0u;
            LDS_WAIT(); asm volatile("" ::: "memory");
            const unsigned b0 = 1u << (e0 & 31), b1 = 1u << (e1 & 31);
            const bool d0 = (__hip_atomic_fetch_or(bm + (e0 >> 5), b0, __ATOMIC_RELAXED, __HIP_MEMORY_SCOPE_WORKGROUP) & b0) != 0u;
            const bool d1 = (__hip_atomic_fetch_or(bm + (e1 >> 5), b1, __ATOMIC_RELAXED, __HIP_MEMORY_SCOPE_WORKGROUP) & b1) != 0u;
            if (d0) { const unsigned sl = __hip_atomic_fetch_add(cnt, 1u, __ATOMIC_RELAXED, __HIP_MEMORY_SCOPE_WORKGROUP); le[sl] = e0; lg[sl] = t0s; }
            if (d1) { const unsigned sl = __hip_atomic_fetch_add(cnt, 1u, __ATOMIC_RELAXED, __HIP_MEMORY_SCOPE_WORKGROUP); le[sl] = e1; lg[sl] = t1s; }
            LDS_WAIT(); asm volatile("" ::: "memory");
            const int nd = (int)__builtin_amdgcn_readfirstlane((int)*cnt);
            for (int j = 0; j < nd; ++j) { const int ej = le[j]; const float gj = lg[j]; if (ej == e0 && !d0) t0s += gj; if (ej == e1 && !d1) t1s += gj; }
            const bool f0 = !d0, f1 = !d1;
            if (layer == 0) VM_WAIT();
            if (f0) G[tt * PE + e0] = gate_code(t0s);
            if (f1) G[tt * PE + e1] = gate_code(t1s);
        }
        __syncthreads();
    }
}

constexpr int KIND_V = F8_KVQ ? 2 : 1;
__device__ __forceinline__ void p_headprep(const Ctx& C, const Ptrs& P) {
    unsigned char* ws = P.ws_(); const bfr* KVQ = (const bfr*)(ws + WS_BIG); bfr* Qh = (bfr*)(ws + WS_R + R_QH); bfr* Kh = (bfr*)(ws + WS_R + R_KH); bfr* Vh = (bfr*)(ws + WS_R + R_VH);
    const float* kg = P.in_(10); const float* qg = P.in_(13);
    const size_t gt = (size_t)C.vcu * 512 + C.tid, GT = (size_t)C.G * 512;
    constexpr int NV16 = F8_KVQ ? 1024 : 1536;
    for (size_t idx0 = gt; idx0 < (size_t)NT * NV16; idx0 += 4 * GT) {
        u4v x8[4];
#pragma unroll
        for (int b4 = 0; b4 < 4; ++b4) { const size_t idx = idx0 + b4 * GT; const size_t t = idx / NV16; const int rem = (int)(idx - t * NV16), vec = rem >> 4, i = rem & 15;
            x8[b4] = *(const u4v*)(KVQ + t * 12288 + vec * 128 + 8 * i); }
#pragma unroll
        for (int b4 = 0; b4 < 4; ++b4) { const size_t idx = idx0 + b4 * GT; const size_t t = idx / NV16; const int rem = (int)(idx - t * NV16), vec = rem >> 4, i = rem & 15, kind = vec >> 5, sh = vec & 31;
            float x[8] = {bflo(x8[b4].x), bfhi(x8[b4].x), bflo(x8[b4].y), bfhi(x8[b4].y), bflo(x8[b4].z), bfhi(x8[b4].z), bflo(x8[b4].w), bfhi(x8[b4].w)};
            float ss = 0.f;
#pragma unroll
            for (int k = 0; k < 8; ++k) ss += x[k] * x[k];
            ss += __shfl_xor(ss, 1); ss += __shfl_xor(ss, 2); ss += __shfl_xor(ss, 4); ss += __shfl_xor(ss, 8);
            u4v w = x8[b4];
            if (kind != KIND_V) { const float rn = __builtin_amdgcn_rsqf(ss * (1.f / 128.f) + EPS); const float* gp = (kind == 0 ? kg : qg) + 8 * i; const f4v g0 = *(const f4v*)gp, g1 = *(const f4v*)(gp + 4);
                w.x = cvtpk(x[0] * rn * g0[0], x[1] * rn * g0[1]); w.y = cvtpk(x[2] * rn * g0[2], x[3] * rn * g0[3]); w.z = cvtpk(x[4] * rn * g1[0], x[5] * rn * g1[1]); w.w = cvtpk(x[6] * rn * g1[2], x[7] * rn * g1[3]); }
            const size_t b = t >> 12, s = t & 4095; bfr* dst = (kind == 0 ? Kh : (kind == KIND_V ? Vh : Qh)) + ((b * 32 + sh) * SEQ + s) * 128 + 8 * i;
            *(u4v*)dst = w; }
    }
}

__device__ __forceinline__ att::BlockRef<att::bf16, att::bf16> attn_ref(const att::bf16* Qh, const att::bf16* Kh, const att::bf16* Vh, att::bf16* Oh, int bhp, int qb) {
    const int b = bhp >> 6, hd = (bhp >> 2) & 15, c = (bhp >> 1) & 1, vh = bhp & 1;
    att::BlockRef<att::bf16, att::bf16> r;
    r.Q = Qh + ((size_t)(b * 32 + hd * 2 + c) * SEQ + (size_t)qb * 256) * 128; r.K = Kh + (size_t)(b * 32 + hd * 2 + c) * SEQ * 128; r.V = att::VSTR == 128 ? Vh + (size_t)(b * 32 + hd * 2 + vh) * SEQ * 128 : Vh + (size_t)b * SEQ * att::VSTR + 8192 + (hd * 2 + vh) * 128;
    r.O = Oh + ((size_t)bhp * SEQ + (size_t)qb * 256) * 128; r.P0 = qb * 256;
    return r;
}
__device__ __forceinline__ void p_attn(const Ctx& C, const Ptrs& P) {
    unsigned char* ws = P.ws_(); const att::bf16* Qh = (const att::bf16*)(ws + WS_R + R_QH); const att::bf16* Kh = (const att::bf16*)(ws + WS_R + R_KH); const att::bf16* Vh = (const att::bf16*)(att::VSTR == 128 ? ws + WS_R + R_VH : ws + WS_BIG);
    att::bf16* Oh = (att::bf16*)(ws + WS_R + R_OH);
    extern __shared__ __attribute__((aligned(16))) char lds_sym[]; char* lds = lds_sym;
    constexpr int total = 128 * 8;
    int L = C.vcu; if (L >= total) return;
    int pass = 0;
    att::BlockRef<att::bf16, att::bf16> cur = attn_ref(Qh, Kh, Vh, Oh, L >> 3, L & 7);
    att::Seam<att::bf16> S;
    att::causal_swa_prime<att::bf16, att::bf16>(cur, SEQ, lds, S);
    for (;;) {
        const bool more_pass = pass == 0, more_item = L + C.G < total, last = !more_pass && !more_item;
        int passn = pass + 1, Ln = L;
        if (!more_pass) { passn = 0; Ln = more_item ? L + C.G : L; }
        const att::BlockRef<att::bf16, att::bf16> nxt = last ? cur : attn_ref(Qh, Kh, Vh, Oh, Ln >> 3, passn ? 15 - (Ln & 7) : (Ln & 7));
        att::causal_swa_block<att::bf16, att::bf16>(cur, nxt, SEQ, SEQ, lds, S);
        if (last) break;
        cur = nxt; pass = passn; L = Ln;
    }
    __syncthreads();
}

__device__ __forceinline__ void p_combine(const Ctx& C, const Ptrs& P) {
    unsigned char* ws = P.ws_(); const bfr* Oh = (const bfr*)(ws + WS_R + R_OH); bfr* AO = (bfr*)(ws + WS_XN); const float* sg = P.in_(18);
    float lam;
    { const float* q1 = P.in_(14); const float* k1 = P.in_(15); const float* q2 = P.in_(16); const float* k2 = P.in_(17); const int l = C.lane;
      const float d1 = wave_sum(q1[l] * k1[l] + q1[l + 64] * k1[l + 64]), d2 = wave_sum(q2[l] * k2[l] + q2[l + 64] * k2[l + 64]);
      lam = expf(d1) - expf(d2) + LAMBDA_INIT; }
    const size_t gt = (size_t)C.vcu * 512 + C.tid, GT = (size_t)C.G * 512;
    for (size_t idx0 = gt; idx0 < (size_t)NT * 512; idx0 += 4 * GT) {
        u4v a8[4], b8[4];
#pragma unroll
        for (int b4 = 0; b4 < 4; ++b4) { const size_t idx = idx0 + b4 * GT; const size_t t = idx >> 9, b = t >> 12, s = t & 4095; const int hd = (int)(idx >> 5) & 15, i = (int)idx & 31, vh = i >> 4, d = (8 * i) & 127;
            const size_t o0i = ((((b * 16 + hd) * 2 + 0) * 2 + vh) * SEQ + s) * 128 + d, o1i = ((((b * 16 + hd) * 2 + 1) * 2 + vh) * SEQ + s) * 128 + d;
            a8[b4] = *(const u4v*)(Oh + o0i); b8[b4] = *(const u4v*)(Oh + o1i); }
        const int i = (int)idx0 & 31;
        const f4v g0 = *(const f4v*)(sg + 8 * i), g1 = *(const f4v*)(sg + 8 * i + 4);
#pragma unroll
        for (int b4 = 0; b4 < 4; ++b4) { const size_t idx = idx0 + b4 * GT; const size_t t = idx >> 9; const int hd = (int)(idx >> 5) & 15;
            float o[8] = {bflo(a8[b4].x) - lam * bflo(b8[b4].x), bfhi(a8[b4].x) - lam * bfhi(b8[b4].x), bflo(a8[b4].y) - lam * bflo(b8[b4].y), bfhi(a8[b4].y) - lam * bfhi(b8[b4].y),
                          bflo(a8[b4].z) - lam * bflo(b8[b4].z), bfhi(a8[b4].z) - lam * bfhi(b8[b4].z), bflo(a8[b4].w) - lam * bflo(b8[b4].w), bfhi(a8[b4].w) - lam * bfhi(b8[b4].w)};
            float ss = 0.f;
#pragma unroll
            for (int k = 0; k < 8; ++k) ss += o[k] * o[k];
            ss += __shfl_xor(ss, 1); ss += __shfl_xor(ss, 2); ss += __shfl_xor(ss, 4); ss += __shfl_xor(ss, 8); ss += __shfl_xor(ss, 16);
            const float rn = __builtin_amdgcn_rsqf(ss * (1.f / 256.f) + EPS) * (1.f - LAMBDA_INIT);
#if F8_OUT1
            const float rs = rn * SO; float y[8] = {o[0] * rs * g0[0], o[1] * rs * g0[1], o[2] * rs * g0[2], o[3] * rs * g0[3], o[4] * rs * g1[0], o[5] * rs * g1[1], o[6] * rs * g1[2], o[7] * rs * g1[3]};
#pragma unroll
            for (int k = 0; k < 8; ++k) y[k] = fminf(fmaxf(y[k], -440.f), 440.f);
            u2v w; w.x = cvt4_fp8(y[0], y[1], y[2], y[3]); w.y = cvt4_fp8(y[4], y[5], y[6], y[7]);
            *(u2v*)(ws + WS_XN8 + t * DM + hd * 256 + 8 * i) = w; }
#else
            u4v w; w.x = cvtpk(o[0] * rn * g0[0], o[1] * rn * g0[1]); w.y = cvtpk(o[2] * rn * g0[2], o[3] * rn * g0[3]); w.z = cvtpk(o[4] * rn * g1[0], o[5] * rn * g1[1]); w.w = cvtpk(o[6] * rn * g1[2], o[7] * rn * g1[3]);
            *(u4v*)(AO + t * DM + hd * 256 + 8 * i) = w; }
#endif
    }
}
constexpr int NPH_LAYER = 13, NPHASE = 1 + 2 * NPH_LAYER;
#ifndef MK_PER_PHASE
#define MK_PER_PHASE 0
#endif

__global__ void __launch_bounds__(512, 2) trunk_fwd(KArgs KA) {
    extern __shared__ __attribute__((aligned(16))) unsigned char lds_raw[];
    Ctx C; C.lds = (LAS unsigned char*)lds_raw; C.tid = threadIdx.x; C.lane = C.tid & 63; C.wave = __builtin_amdgcn_readfirstlane(C.tid >> 6);
    C.G = gridDim.x; { const int bx = blockIdx.x; C.vcu = (C.G % 8 == 0) ? (bx % 8) * (C.G / 8) + bx / 8 : bx; }
    volatile LAS unsigned* MISC = (volatile LAS unsigned*)(C.lds + MISC_OFF);
    for (int u = C.tid; u < (LDS_BYTES - MISC_OFF) / 4; u += 512) MISC[u] = 0u;
    __syncthreads();
    Ptrs P; P.tbl = (LAS unsigned long long*)(C.lds + MISC_OFF + 128);
    if (C.tid < 28) P.tbl[C.tid] = ((const unsigned long long*)&KA)[C.tid];
    __syncthreads();
    unsigned* ctl = (unsigned*)(P.ws_() + WS_CTL);
    const int lo = KA.ph_lo, hi = KA.ph_hi;
    XcdBarrier bar; bar.bar = ctl + CW_BAR + KA.li * XCD_BAR_WORDS; bar.x = 0; bar.st = MISC + 8;
    if (hi - lo > 1) bar = xcd_barrier_post(ctl + CW_BAR + KA.li * XCD_BAR_WORDS, MISC + 8);
#define IN(k) (lo <= (k) && (k) < hi)
#define SEAM(k) do { if (IN(k) && IN((k) + 1)) xcd_barrier(bar); } while (0)
    unsigned char* ws = P.ws_();
    bfr* XN = (bfr*)(ws + WS_XN); bfr* BIG = (bfr*)(ws + WS_BIG);
    const int hb = (int)blockIdx.x;

    if (IN(0)) { p_convert(C, P, 0, C.vcu, C.G); __syncthreads();
#if NPREP >= 32
        p_convert(C, P, 1, C.vcu, C.G); __syncthreads();
#endif
        p_norm_rows(C, P.in_(0), XN, F8_PROJ0 != 0 ? ws + WS_XN8 : nullptr); }
    SEAM(0);
    {
        constexpr int layer = 0;
        const int pb = 1 + layer * NPH_LAYER;
        if (layer == 1 && IN(pb + 0)) p_norm_rows<true>(C, ws + WS_SC, F8_KVQ == 2 ? nullptr : XN, F8_KVQ != 0 ? ws + WS_XN8 : nullptr);
        if (layer == 1) SEAM(pb + 0);
        if (IN(pb + 1)) {
            const int N = layer == 0 ? 16384 : 12288;
            if (layer == 0 && F8_PROJ0 == 2) {
                { pg8::Gemm g{XN, (const bfr*)(ws + WS_WTIN), NT, 8192, DM}; pg8::StaticOrder S; S.init(NT, 8192, C.G, hb);
                  pg8::EpiBf16<0> E{BIG, N, nullptr, 0, 0, 1.f};
                  pg8::gemm_phase<pg8::EpiBf16<0>, pg8::StaticOrder, true, true>((PG8_LAS unsigned char*)C.lds, g, S, E); }
                __syncthreads();
                { pg8::Gemm g{(const bfr*)(ws + WS_XN8), (const bfr*)(ws + WS_WTIN + (size_t)8192 * DM * 2), NT, 8192, DM / 2}; pg8::StaticOrder S; S.init(NT, 8192, C.G, hb);
                  pg8::EpiBf16<0> E{BIG + 8192, N, nullptr, 8192, 0, 1.f / SU};
                  pg8::gemm_phase<pg8::EpiBf16<0>, pg8::StaticOrder, true, true, true>((PG8_LAS unsigned char*)C.lds, g, S, E); }
            } else if (layer == 0 && F8_PROJ0 == 5) {
                { pg8::Gemm g{(const bfr*)(ws + WS_XN8), (const bfr*)(ws + WS_WTIN), NT, 8192, DM / 2}; pg8::StaticOrder S; S.init(NT, 8192, C.G, hb);
                  pg8::EpiBf16<0> E{BIG, N, nullptr, 8192, 0, 1.f / SU};
                  pg8::gemm_phase<pg8::EpiBf16<0>, pg8::StaticOrder, true, true, true>((PG8_LAS unsigned char*)C.lds, g, S, E); }
                __syncthreads();
                { pg8::Gemm g{XN, (const bfr*)(ws + WS_WTIN + (size_t)32 * MiB), NT, 4096, DM}; pg8::StaticOrder S; S.init(NT, 4096, C.G, hb);
                  pg8::EpiBf16<0> E{BIG + 8192, N, nullptr, 0, 0, 1.f};
                  pg8::gemm_phase<pg8::EpiBf16<0>, pg8::StaticOrder, true, true>((PG8_LAS unsigned char*)C.lds, g, S, E); }
                __syncthreads();
                { pg8::Gemm g{(const bfr*)(ws + WS_XN8), (const bfr*)(ws + WS_WTIN + (size_t)64 * MiB), NT, 4096, DM / 2}; pg8::StaticOrder S; S.init(NT, 4096, C.G, hb);
                  pg8::EpiBf16<0> E{BIG + 12288, N, nullptr, 4096, 0, 1.f / SU};
                  pg8::gemm_phase<pg8::EpiBf16<0>, pg8::StaticOrder, true, true, true>((PG8_LAS unsigned char*)C.lds, g, S, E); }
            } else if (layer == 0 && F8_PROJ0 == 6) {
                { pg8::Gemm g{(const bfr*)(ws + WS_XN8), (const bfr*)(ws + WS_WTIN), NT, 12288, DM / 2}; pg8::StaticOrder S; S.init(NT, 12288, C.G, hb);
                  pg8::EpiBf16<0> E{BIG, N, nullptr, 12288, 0, 1.f / SU};
                  pg8::gemm_phase<pg8::EpiBf16<0>, pg8::StaticOrder, true, true, true>((PG8_LAS unsigned char*)C.lds, g, S, E); }
                __syncthreads();
                { pg8::Gemm g{XN, (const bfr*)(ws + WS_WTIN + (size_t)48 * MiB), NT, 4096, DM}; pg8::StaticOrder S; S.init(NT, 4096, C.G, hb);
                  pg8::EpiBf16<0> E{BIG + 12288, N, nullptr, 0, 0, 1.f};
                  pg8::gemm_phase<pg8::EpiBf16<0>, pg8::StaticOrder, true, true>((PG8_LAS unsigned char*)C.lds, g, S, E); }
            } else if (layer == 0 && F8_PROJ0 == 4) {
                { pg8::Gemm g{(const bfr*)(ws + WS_XN8), (const bfr*)(ws + WS_WTIN), NT, 4096, DM / 2}; pg8::StaticOrder S; S.init(NT, 4096, C.G, hb);
                  pg8::EpiBf16<0> E{BIG, N, nullptr, 4096, 0, 1.f / SU};
                  pg8::gemm_phase<pg8::EpiBf16<0>, pg8::StaticOrder, true, true, true>((PG8_LAS unsigned char*)C.lds, g, S, E); }
                __syncthreads();
                { pg8::Gemm g{XN, (const bfr*)(ws + WS_WTIN + (size_t)4096 * DM), NT, 12288, DM}; pg8::StaticOrder S; S.init(NT, 12288, C.G, hb);
                  pg8::EpiBf16<0> E{BIG + 4096, N, nullptr, 0, 0, 1.f};
                  pg8::gemm_phase<pg8::EpiBf16<0>, pg8::StaticOrder, true, true>((PG8_LAS unsigned char*)C.lds, g, S, E); }
            } else if (layer == 0 && F8_PROJ0 == 3) {
                { pg8::Gemm g{(const bfr*)(ws + WS_XN8), (const bfr*)(ws + WS_WTIN), NT, 8192, DM / 2}; pg8::StaticOrder S; S.init(NT, 8192, C.G, hb);
                  pg8::EpiBf16<0> E{BIG, N, nullptr, 8192, 0, 1.f / SU};
                  pg8::gemm_phase<pg8::EpiBf16<0>, pg8::StaticOrder, true, true, true>((PG8_LAS unsigned char*)C.lds, g, S, E); }
                __syncthreads();
                { pg8::Gemm g{XN, (const bfr*)(ws + WS_WTIN + (size_t)8192 * DM), NT, 8192, DM}; pg8::StaticOrder S; S.init(NT, 8192, C.G, hb);
                  pg8::EpiBf16<0> E{BIG + 8192, N, nullptr, 0, 0, 1.f};
                  pg8::gemm_phase<pg8::EpiBf16<0>, pg8::StaticOrder, true, true>((PG8_LAS unsigned char*)C.lds, g, S, E); }
            } else if (layer == 0 && F8_PROJ0 == 1) {
                pg8::Gemm g{(const bfr*)(ws + WS_XN8), (const bfr*)(ws + WS_WTIN), NT, N, DM / 2}; pg8::StaticOrder S; S.init(NT, N, C.G, hb);
                pg8::EpiBf16<0> E{BIG, N, nullptr, N, 0, 1.f / SU};
                pg8::gemm_phase<pg8::EpiBf16<0>, pg8::StaticOrder, true, true, true>((PG8_LAS unsigned char*)C.lds, g, S, E);
            } else if (layer == 1 && F8_KVQ == 2) {
                pg8::Gemm g{(const bfr*)(ws + WS_XN8), (const bfr*)(ws + WS_WTKVQ), NT, N, DM / 2}; pg8::StaticOrder S; S.init(NT, N, C.G, hb);
                pg8::EpiHead E{(bfr*)(ws + WS_R + R_KH), (bfr*)(ws + WS_R + R_QH), (bfr*)(ws + WS_R + R_VH), P.in_(10), P.in_(13), 1.f / SU};
                pg8::gemm_phase<pg8::EpiHead, pg8::StaticOrder, true, true, true>((PG8_LAS unsigned char*)C.lds, g, S, E);
            } else if (layer == 1 && F8_KVQ) {
                { pg8::Gemm g{(const bfr*)(ws + WS_XN8), (const bfr*)(ws + WS_WTKVQ), NT, 8192, DM / 2}; pg8::StaticOrder S; S.init(NT, 8192, C.G, hb);
                  pg8::EpiBf16<0> E{BIG, N, nullptr, 8192, 0, 1.f / SU};
                  pg8::gemm_phase<pg8::EpiBf16<0>, pg8::StaticOrder, true, true, true>((PG8_LAS unsigned char*)C.lds, g, S, E); }
                __syncthreads();
                { pg8::Gemm g{XN, (const bfr*)(ws + WS_WTKVQ + (size_t)2 * DM * DM), NT, DM, DM}; pg8::StaticOrder S; S.init(NT, DM, C.G, hb);
                  pg8::EpiBf16<0> E{BIG + 8192, N, nullptr, 0, 0, 1.f};
                  pg8::gemm_phase<pg8::EpiBf16<0>, pg8::StaticOrder, true, true>((PG8_LAS unsigned char*)C.lds, g, S, E); }
            } else {
                pg8::Gemm g{XN, (const bfr*)(ws + (layer == 0 ? WS_WTIN : WS_WTKVQ)), NT, N, DM}; pg8::StaticOrder S; S.init(NT, N, C.G, hb);
                pg8::EpiBf16<0> E{BIG, N, nullptr, 0, 0, 1.f};
                pg8::gemm_phase<pg8::EpiBf16<0>, pg8::StaticOrder, true, true>((PG8_LAS unsigned char*)C.lds, g, S, E);
            }
            if (layer == 0) { __syncthreads(); p_bd(C, XN, (const bfr*)(ws + WS_WTBD), (float*)(ws + WS_BD));
#ifdef BD_PROBE
                __syncthreads(); p_bd(C, XN, (const bfr*)(ws + WS_WTBD), (float*)(ws + WS_BD));
#endif
            }
        }
        SEAM(pb + 1);
        if (IN(pb + 2)) { if (layer == 1 && F8_KVQ != 2) p_headprep(C, P); }
        if (layer == 1 && F8_KVQ != 2) SEAM(pb + 2);
        if (IN(pb + 3)) { if (layer == 0) {
                if (NPREP >= 32) p_gdn_prep(C, P, C.vcu, C.G);
                else if (C.G == 256) { const int cidx = C.vcu & 31, xcd = C.vcu >> 5;
                    if (cidx < NPREP) p_gdn_prep(C, P, xcd * NPREP + cidx, 8 * NPREP); else p_convert(C, P, 1, xcd * (32 - NPREP) + (cidx - NPREP), 8 * (32 - NPREP)); }
                else { p_convert(C, P, 1, C.vcu, C.G); __syncthreads(); p_gdn_prep(C, P, C.vcu, C.G); }
            } else p_attn(C, P); }
        SEAM(pb + 3);
        if (IN(pb + 4)) { if (layer == 0) p_gdn_scan(C, P); else p_combine(C, P); }
        SEAM(pb + 4);
        if (IN(pb + 5)) { if (layer == 0) p_gdn_onorm(C, P); }
        if (layer == 0) SEAM(pb + 5);
        if (IN(pb + 6)) {
            if ((layer == 0 && F8_OUT0) || (layer == 1 && F8_OUT1)) {
                pg8::Gemm g{(const bfr*)(ws + WS_XN8), (const bfr*)(ws + (layer == 0 ? WS_WTOUT : WS_WTO)), NT, DM, DM / 2}; pg8::StaticOrder S; S.init(NT, DM, C.G, hb);
                if (layer == 0) { pg8::EpiResB<false, true> E{P.in_(0), ws + WS_SC, DM, 1.f / (SO * SU)};
                    pg8::gemm_phase<pg8::EpiResB<false, true>, pg8::StaticOrder, true, true, true>((PG8_LAS unsigned char*)C.lds, g, S, E); }
                else { pg8::EpiResB<true, true> E{ws + WS_SC, ws + WS_SC, DM, 1.f / (SO * SU)};
                    pg8::gemm_phase<pg8::EpiResB<true, true>, pg8::StaticOrder, true, true, true>((PG8_LAS unsigned char*)C.lds, g, S, E); }
            } else {
                pg8::Gemm g{XN, (const bfr*)(ws + (layer == 0 ? WS_WTOUT : WS_WTO)), NT, DM, DM}; pg8::StaticOrder S; S.init(NT, DM, C.G, hb);
                pg8::EpiRes E{layer == 0 ? P.in_(0) : (const float*)P.out_(), P.out_(), DM, 1.f};
                pg8::gemm_phase<pg8::EpiRes, pg8::StaticOrder, true, true>((PG8_LAS unsigned char*)C.lds, g, S, E);
            }
        }
        SEAM(pb + 6);
        if (IN(pb + 7)) p_norm_rows<true>(C, ws + WS_SC, nullptr, ws + WS_XN8, (float*)(ws + WS_BD));
        SEAM(pb + 7);
        if (IN(pb + 8)) {
            pg8::Gemm g{(const bfr*)(ws + WS_SC), (const bfr*)(ws + WS_WTQRY) + (size_t)layer * PQ * DM, NT, PQ, DM}; pg8::StaticOrder S; S.init(NT, PQ, C.G, hb);
            pg8::EpiBf16R E{(bfr*)(ws + WS_QRY), PQ, (const float*)(ws + WS_BD)};
            pg8::gemm_phase<pg8::EpiBf16R, pg8::StaticOrder, true, true>((PG8_LAS unsigned char*)C.lds, g, S, E);
        }
        SEAM(pb + 8);
        if (IN(pb + 9)) { p_sroute(C, P, layer); }
        SEAM(pb + 9); if (IN(pb + 9) && !IN(pb + 10) && IN(pb + 11)) xcd_barrier(bar);
        if (IN(pb + 11)) {
            pg8::Gemm g{(const bfr*)(ws + WS_XN8), (const bfr*)(ws + WS_U + (size_t)layer * PE * DM), NT, PE, DM / 2}; pg8::StaticOrder S; S.init(NT, PE, C.G, hb);
#ifdef G1_PROBE
            if (layer == 0) { pg8::StaticOrder S2; S2.init(NT, PE, C.G, hb); pg8::EpiGate8<G1_PROBE> E2{(bfr*)(ws + WS_G), ws + WS_A2, PE, 1.f / SU, SA};
                pg8::gemm_phase<pg8::EpiGate8<G1_PROBE>, pg8::StaticOrder, true, true, true>((PG8_LAS unsigned char*)C.lds, g, S2, E2); __syncthreads(); }
#endif
#if STAGGER_G1
            {
                const int sg = C.vcu & 7;
                if (sg) { const unsigned long long t0 = __builtin_amdgcn_s_memrealtime(); while (__builtin_amdgcn_s_memrealtime() - t0 < (unsigned long long)(sg * STAGGER_G1)) __builtin_amdgcn_s_sleep(4); }
            }
#endif
            pg8::EpiGate8C E{ws + WS_G, ws + WS_A2, PE, 1.f / SU, SA};
            pg8::gemm_phase<pg8::EpiGate8C, pg8::StaticOrder, true, true, true>((PG8_LAS unsigned char*)C.lds, g, S, E);
        }
        SEAM(pb + 11);
        if (IN(pb + 12)) {
            pg8::Gemm g{(const bfr*)(ws + WS_A2), (const bfr*)(ws + WS_VT + (size_t)layer * DM * PE), NT, DM, PE / 2}; pg8::StaticOrder S; S.init(NT, DM, C.G, hb);
            if (layer == 0) { pg8::EpiResB<true, true> E{ws + WS_SC, ws + WS_SC, DM, 1.f / (SA * SV)};
                pg8::gemm_phase<pg8::EpiResB<true, true>, pg8::StaticOrder, true, true, true>((PG8_LAS unsigned char*)C.lds, g, S, E); }
            else { pg8::EpiResB<true, false> E{ws + WS_SC, P.out_(), DM, 1.f / (SA * SV)};
                pg8::gemm_phase<pg8::EpiResB<true, false>, pg8::StaticOrder, true, true, true>((PG8_LAS unsigned char*)C.lds, g, S, E); }
#ifdef G2_PROBE
            if (layer == 0) { __syncthreads(); pg8::StaticOrder S2; S2.init(NT, DM, C.G, hb); pg8::EpiRes E2{(const float*)P.out_(), P.out_(), DM, 0.f};
                pg8::gemm_phase<pg8::EpiRes, pg8::StaticOrder, true, true, true>((PG8_LAS unsigned char*)C.lds, g, S2, E2); }
#endif
        }
        SEAM(pb + 12);
    }
    {
        constexpr int layer = 1;
        const int pb = 1 + layer * NPH_LAYER;
        if (layer == 1 && IN(pb + 0)) p_norm_rows<true>(C, ws + WS_SC, F8_KVQ == 2 ? nullptr : XN, F8_KVQ != 0 ? ws + WS_XN8 : nullptr);
        if (layer == 1) SEAM(pb + 0);
        if (IN(pb + 1)) {
            const int N = layer == 0 ? 16384 : 12288;
            if (layer == 0 && F8_PROJ0 == 2) {
                { pg8::Gemm g{XN, (const bfr*)(ws + WS_WTIN), NT, 8192, DM}; pg8::StaticOrder S; S.init(NT, 8192, C.G, hb);
                  pg8::EpiBf16<0> E{BIG, N, nullptr, 0, 0, 1.f};
                  pg8::gemm_phase<pg8::EpiBf16<0>, pg8::StaticOrder, true, true>((PG8_LAS unsigned char*)C.lds, g, S, E); }
                __syncthreads();
                { pg8::Gemm g{(const bfr*)(ws + WS_XN8), (const bfr*)(ws + WS_WTIN + (size_t)8192 * DM * 2), NT, 8192, DM / 2}; pg8::StaticOrder S; S.init(NT, 8192, C.G, hb);
                  pg8::EpiBf16<0> E{BIG + 8192, N, nullptr, 8192, 0, 1.f / SU};
                  pg8::gemm_phase<pg8::EpiBf16<0>, pg8::StaticOrder, true, true, true>((PG8_LAS unsigned char*)C.lds, g, S, E); }
            } else if (layer == 0 && F8_PROJ0 == 5) {
                { pg8::Gemm g{(const bfr*)(ws + WS_XN8), (const bfr*)(ws + WS_WTIN), NT, 8192, DM / 2}; pg8::StaticOrder S; S.init(NT, 8192, C.G, hb);
                  pg8::EpiBf16<0> E{BIG, N, nullptr, 8192, 0, 1.f / SU};
                  pg8::gemm_phase<pg8::EpiBf16<0>, pg8::StaticOrder, true, true, true>((PG8_LAS unsigned char*)C.lds, g, S, E); }
                __syncthreads();
                { pg8::Gemm g{XN, (const bfr*)(ws + WS_WTIN + (size_t)32 * MiB), NT, 4096, DM}; pg8::StaticOrder S; S.init(NT, 4096, C.G, hb);
                  pg8::EpiBf16<0> E{BIG + 8192, N, nullptr, 0, 0, 1.f};
                  pg8::gemm_phase<pg8::EpiBf16<0>, pg8::StaticOrder, true, true>((PG8_LAS unsigned char*)C.lds, g, S, E); }
                __syncthreads();
                { pg8::Gemm g{(const bfr*)(ws + WS_XN8), (const bfr*)(ws + WS_WTIN + (size_t)64 * MiB), NT, 4096, DM / 2}; pg8::StaticOrder S; S.init(NT, 4096, C.G, hb);
                  pg8::EpiBf16<0> E{BIG + 12288, N, nullptr, 4096, 0, 1.f / SU};
                  pg8::gemm_phase<pg8::EpiBf16<0>, pg8::StaticOrder, true, true, true>((PG8_LAS unsigned char*)C.lds, g, S, E); }
            } else if (layer == 0 && F8_PROJ0 == 6) {
                { pg8::Gemm g{(const bfr*)(ws + WS_XN8), (const bfr*)(ws + WS_WTIN), NT, 12288, DM / 2}; pg8::StaticOrder S; S.init(NT, 12288, C.G, hb);
                  pg8::EpiBf16<0> E{BIG, N, nullptr, 12288, 0, 1.f / SU};
                  pg8::gemm_phase<pg8::EpiBf16<0>, pg8::StaticOrder, true, true, true>((PG8_LAS unsigned char*)C.lds, g, S, E); }
                __syncthreads();
                { pg8::Gemm g{XN, (const bfr*)(ws + WS_WTIN + (size_t)48 * MiB), NT, 4096, DM}; pg8::StaticOrder S; S.init(NT, 4096, C.G, hb);
                  pg8::EpiBf16<0> E{BIG + 12288, N, nullptr, 0, 0, 1.f};
                  pg8::gemm_phase<pg8::EpiBf16<0>, pg8::StaticOrder, true, true>((PG8_LAS unsigned char*)C.lds, g, S, E); }
            } else if (layer == 0 && F8_PROJ0 == 4) {
                { pg8::Gemm g{(const bfr*)(ws + WS_XN8), (const bfr*)(ws + WS_WTIN), NT, 4096, DM / 2}; pg8::StaticOrder S; S.init(NT, 4096, C.G, hb);
                  pg8::EpiBf16<0> E{BIG, N, nullptr, 4096, 0, 1.f / SU};
                  pg8::gemm_phase<pg8::EpiBf16<0>, pg8::StaticOrder, true, true, true>((PG8_LAS unsigned char*)C.lds, g, S, E); }
                __syncthreads();
                { pg8::Gemm g{XN, (const bfr*)(ws + WS_WTIN + (size_t)4096 * DM), NT, 12288, DM}; pg8::StaticOrder S; S.init(NT, 12288, C.G, hb);
                  pg8::EpiBf16<0> E{BIG + 4096, N, nullptr, 0, 0, 1.f};
                  pg8::gemm_phase<pg8::EpiBf16<0>, pg8::StaticOrder, true, true>((PG8_LAS unsigned char*)C.lds, g, S, E); }
            } else if (layer == 0 && F8_PROJ0 == 3) {
                { pg8::Gemm g{(const bfr*)(ws + WS_XN8), (const bfr*)(ws + WS_WTIN), NT, 8192, DM / 2}; pg8::StaticOrder S; S.init(NT, 8192, C.G, hb);
                  pg8::EpiBf16<0> E{BIG, N, nullptr, 8192, 0, 1.f / SU};
                  pg8::gemm_phase<pg8::EpiBf16<0>, pg8::StaticOrder, true, true, true>((PG8_LAS unsigned char*)C.lds, g, S, E); }
                __syncthreads();
                { pg8::Gemm g{XN, (const bfr*)(ws + WS_WTIN + (size_t)8192 * DM), NT, 8192, DM}; pg8::StaticOrder S; S.init(NT, 8192, C.G, hb);
                  pg8::EpiBf16<0> E{BIG + 8192, N, nullptr, 0, 0, 1.f};
                  pg8::gemm_phase<pg8::EpiBf16<0>, pg8::StaticOrder, true, true>((PG8_LAS unsigned char*)C.lds, g, S, E); }
            } else if (layer == 0 && F8_PROJ0 == 1) {
                pg8::Gemm g{(const bfr*)(ws + WS_XN8), (const bfr*)(ws + WS_WTIN), NT, N, DM / 2}; pg8::StaticOrder S; S.init(NT, N, C.G, hb);
                pg8::EpiBf16<0> E{BIG, N, nullptr, N, 0, 1.f / SU};
                pg8::gemm_phase<pg8::EpiBf16<0>, pg8::StaticOrder, true, true, true>((PG8_LAS unsigned char*)C.lds, g, S, E);
            } else if (layer == 1 && F8_KVQ == 2) {
                pg8::Gemm g{(const bfr*)(ws + WS_XN8), (const bfr*)(ws + WS_WTKVQ), NT, N, DM / 2}; pg8::StaticOrder S; S.init(NT, N, C.G, hb);
                pg8::EpiHead E{(bfr*)(ws + WS_R + R_KH), (bfr*)(ws + WS_R + R_QH), (bfr*)(ws + WS_R + R_VH), P.in_(10), P.in_(13), 1.f / SU};
                pg8::gemm_phase<pg8::EpiHead, pg8::StaticOrder, true, true, true>((PG8_LAS unsigned char*)C.lds, g, S, E);
            } else if (layer == 1 && F8_KVQ) {
                { pg8::Gemm g{(const bfr*)(ws + WS_XN8), (const bfr*)(ws + WS_WTKVQ), NT, 8192, DM / 2}; pg8::StaticOrder S; S.init(NT, 8192, C.G, hb);
                  pg8::EpiBf16<0> E{BIG, N, nullptr, 8192, 0, 1.f / SU};
                  pg8::gemm_phase<pg8::EpiBf16<0>, pg8::StaticOrder, true, true, true>((PG8_LAS unsigned char*)C.lds, g, S, E); }
                __syncthreads();
                { pg8::Gemm g{XN, (const bfr*)(ws + WS_WTKVQ + (size_t)2 * DM * DM), NT, DM, DM}; pg8::StaticOrder S; S.init(NT, DM, C.G, hb);
                  pg8::EpiBf16<0> E{BIG + 8192, N, nullptr, 0, 0, 1.f};
                  pg8::gemm_phase<pg8::EpiBf16<0>, pg8::StaticOrder, true, true>((PG8_LAS unsigned char*)C.lds, g, S, E); }
            } else {
                pg8::Gemm g{XN, (const bfr*)(ws + (layer == 0 ? WS_WTIN : WS_WTKVQ)), NT, N, DM}; pg8::StaticOrder S; S.init(NT, N, C.G, hb);
                pg8::EpiBf16<0> E{BIG, N, nullptr, 0, 0, 1.f};
                pg8::gemm_phase<pg8::EpiBf16<0>, pg8::StaticOrder, true, true>((PG8_LAS unsigned char*)C.lds, g, S, E);
            }
            if (layer == 0) { __syncthreads(); p_bd(C, XN, (const bfr*)(ws + WS_WTBD), (float*)(ws + WS_BD));
#ifdef BD_PROBE
                __syncthreads(); p_bd(C, XN, (const bfr*)(ws + WS_WTBD), (float*)(ws + WS_BD));
#endif
            }
        }
        SEAM(pb + 1);
        if (IN(pb + 2)) { if (layer == 1 && F8_KVQ != 2) p_headprep(C, P); }
        if (layer == 1 && F8_KVQ != 2) SEAM(pb + 2);
        if (IN(pb + 3)) { if (layer == 0) {
                if (NPREP >= 32) p_gdn_prep(C, P, C.vcu, C.G);
                else if (C.G == 256) { const int cidx = C.vcu & 31, xcd = C.vcu >> 5;
                    if (cidx < NPREP) p_gdn_prep(C, P, xcd * NPREP + cidx, 8 * NPREP); else p_convert(C, P, 1, xcd * (32 - NPREP) + (cidx - NPREP), 8 * (32 - NPREP)); }
                else { p_convert(C, P, 1, C.vcu, C.G); __syncthreads(); p_gdn_prep(C, P, C.vcu, C.G); }
            } else p_attn(C, P); }
        SEAM(pb + 3);
        if (IN(pb + 4)) { if (layer == 0) p_gdn_scan(C, P); else p_combine(C, P); }
        SEAM(pb + 4);
        if (IN(pb + 5)) { if (layer == 0) p_gdn_onorm(C, P); }
        if (layer == 0) SEAM(pb + 5);
        if (IN(pb + 6)) {
            if ((layer == 0 && F8_OUT0) || (layer == 1 && F8_OUT1)) {
                pg8::Gemm g{(const bfr*)(ws + WS_XN8), (const bfr*)(ws + (layer == 0 ? WS_WTOUT : WS_WTO)), NT, DM, DM / 2}; pg8::StaticOrder S; S.init(NT, DM, C.G, hb);
                if (layer == 0) { pg8::EpiResB<false, true> E{P.in_(0), ws + WS_SC, DM, 1.f / (SO * SU)};
                    pg8::gemm_phase<pg8::EpiResB<false, true>, pg8::StaticOrder, true, true, true>((PG8_LAS unsigned char*)C.lds, g, S, E); }
                else { pg8::EpiResB<true, true> E{ws + WS_SC, ws + WS_SC, DM, 1.f / (SO * SU)};
                    pg8::gemm_phase<pg8::EpiResB<true, true>, pg8::StaticOrder, true, true, true>((PG8_LAS unsigned char*)C.lds, g, S, E); }
            } else {
                pg8::Gemm g{XN, (const bfr*)(ws + (layer == 0 ? WS_WTOUT : WS_WTO)), NT, DM, DM}; pg8::StaticOrder S; S.init(NT, DM, C.G, hb);
                pg8::EpiRes E{layer == 0 ? P.in_(0) : (const float*)P.out_(), P.out_(), DM, 1.f};
                pg8::gemm_phase<pg8::EpiRes, pg8::StaticOrder, true, true>((PG8_LAS unsigned char*)C.lds, g, S, E);
            }
        }
        SEAM(pb + 6);
        if (IN(pb + 7)) p_norm_rows<true>(C, ws + WS_SC, nullptr, ws + WS_XN8, (float*)(ws + WS_BD));
        SEAM(pb + 7);
        if (IN(pb + 8)) {
            pg8::Gemm g{(const bfr*)(ws + WS_SC), (const bfr*)(ws + WS_WTQRY) + (size_t)layer * PQ * DM, NT, PQ, DM}; pg8::StaticOrder S; S.init(NT, PQ, C.G, hb);
            pg8::EpiBf16R E{(bfr*)(ws + WS_QRY), PQ, (const float*)(ws + WS_BD)};
            pg8::gemm_phase<pg8::EpiBf16R, pg8::StaticOrder, true, true>((PG8_LAS unsigned char*)C.lds, g, S, E);
        }
        SEAM(pb + 8);
        if (IN(pb + 9)) { p_sroute(C, P, layer); }
        SEAM(pb + 9); if (IN(pb + 9) && !IN(pb + 10) && IN(pb + 11)) xcd_barrier(bar);
        if (IN(pb + 11)) {
            pg8::Gemm g{(const bfr*)(ws + WS_XN8), (const bfr*)(ws + WS_U + (size_t)layer * PE * DM), NT, PE, DM / 2}; pg8::StaticOrder S; S.init(NT, PE, C.G, hb);
#ifdef G1_PROBE
            if (layer == 0) { pg8::StaticOrder S2; S2.init(NT, PE, C.G, hb); pg8::EpiGate8<G1_PROBE> E2{(bfr*)(ws + WS_G), ws + WS_A2, PE, 1.f / SU, SA};
                pg8::gemm_phase<pg8::EpiGate8<G1_PROBE>, pg8::StaticOrder, true, true, true>((PG8_LAS unsigned char*)C.lds, g, S2, E2); __syncthreads(); }
#endif
#if STAGGER_G1
            {
                const int sg = C.vcu & 7;
                if (sg) { const unsigned long long t0 = __builtin_amdgcn_s_memrealtime(); while (__builtin_amdgcn_s_memrealtime() - t0 < (unsigned long long)(sg * STAGGER_G1)) __builtin_amdgcn_s_sleep(4); }
            }
#endif
            pg8::EpiGate8C E{ws + WS_G, ws + WS_A2, PE, 1.f / SU, SA};
            pg8::gemm_phase<pg8::EpiGate8C, pg8::StaticOrder, true, true, true>((PG8_LAS unsigned char*)C.lds, g, S, E);
        }
        SEAM(pb + 11);
        if (IN(pb + 12)) {
            pg8::Gemm g{(const bfr*)(ws + WS_A2), (const bfr*)(ws + WS_VT + (size_t)layer * DM * PE), NT, DM, PE / 2}; pg8::StaticOrder S; S.init(NT, DM, C.G, hb);
            if (layer == 0) { pg8::EpiResB<true, true> E{ws + WS_SC, ws + WS_SC, DM, 1.f / (SA * SV)};
                pg8::gemm_phase<pg8::EpiResB<true, true>, pg8::StaticOrder, true, true, true>((PG8_LAS unsigned char*)C.lds, g, S, E); }
            else { pg8::EpiResB<true, false> E{ws + WS_SC, P.out_(), DM, 1.f / (SA * SV)};
                pg8::gemm_phase<pg8::EpiResB<true, false>, pg8::StaticOrder, true, true, true>((PG8_LAS unsigned char*)C.lds, g, S, E); }
#ifdef G2_PROBE
            if (layer == 0) { __syncthreads(); pg8::StaticOrder S2; S2.init(NT, DM, C.G, hb); pg8::EpiRes E2{(const float*)P.out_(), P.out_(), DM, 0.f};
                pg8::gemm_phase<pg8::EpiRes, pg8::StaticOrder, true, true, true>((PG8_LAS unsigned char*)C.lds, g, S2, E2); }
#endif
        }
        SEAM(pb + 12);
    }
#undef IN
#undef SEAM
}

extern "C" void kernel_launch(void* const* d_in, const int* in_sizes, int n_in, void* d_out, int out_size, void* d_ws, size_t ws_size, hipStream_t stream) {
    static int grid = 0;
    if (grid == 0) {
        if (n_in != 26 || out_size != NT * DM || ws_size < WS_END) { fprintf(stderr, "kernel_launch: unexpected problem (n_in %d, out %d, ws %zu < %zu)\n", n_in, out_size, ws_size, (size_t)WS_END); grid = -1; return; }
        int dev = 0, cus = 0;
        if (hipGetDevice(&dev) != hipSuccess || hipDeviceGetAttribute(&cus, hipDeviceAttributeMultiprocessorCount, dev) != hipSuccess || cus <= 0) { grid = -1; return; }
        if (hipFuncSetAttribute((const void*)trunk_fwd, hipFuncAttributeMaxDynamicSharedMemorySize, LDS_BYTES) != hipSuccess) { fprintf(stderr, "kernel_launch: hipFuncSetAttribute failed\n"); grid = -1; return; }
        int per_cu = 0;
        if (hipOccupancyMaxActiveBlocksPerMultiprocessor(&per_cu, (const void*)trunk_fwd, 512, LDS_BYTES) != hipSuccess || per_cu < 1) { fprintf(stderr, "kernel_launch: occupancy query says %d blocks per CU\n", per_cu); }
        (void)hipGetLastError();
        grid = cus;
    }
    if (grid < 0) return;
    (void)in_sizes;
    if (hipMemsetAsync((char*)d_ws + WS_CTL, 0, CTL_ZERO_BYTES, stream) != hipSuccess) return;
    KArgs p{};
    for (int i = 0; i < 26; ++i) p.in[i] = (const float*)d_in[i];
    p.out = (float*)d_out; p.ws = (unsigned char*)d_ws;
#if MK_PER_PHASE
    for (int ph = 0; ph < NPHASE; ++ph) {
        if (ph == 1 + 5 + NPH_LAYER || ph == 1 + 10 || ph == 1 + 10 + NPH_LAYER) continue;
        p.ph_lo = ph; p.ph_hi = ph + 1; p.li = 0; p.pad = 0;
        hipLaunchKernelGGL(trunk_fwd, dim3(grid), dim3(512), LDS_BYTES, stream, p);
    }
#else
    p.ph_lo = 0; p.ph_hi = NPHASE; p.li = 0; p.pad = 0;
    hipLaunchKernelGGL(trunk_fwd, dim3(grid), dim3(512), LDS_BYTES, stream, p);
#endif
}
```
